# Optimizing an MI355X kernel written in HIP

```python
import math
import jax, jax.numpy as jnp
from jax import lax
import numpy as np

D_MODEL = 1024
BATCH = 8
SEQ = 4096
DEPTH = 2

DA_HEADS = 4
DA_HEAD_DIM = 64
DA_V_DIM = 2 * DA_HEAD_DIM
DA_WIDTH = DA_HEADS * DA_V_DIM
NSA_HEADS = 8
NSA_KV_GROUPS = 2
NSA_HPG = NSA_HEADS // NSA_KV_GROUPS
NSA_HEAD_DIM = 64
NSA_WIDTH = NSA_HEADS * NSA_HEAD_DIM
CMP_BLOCK = 32
CMP_STRIDE = 16
CMP_HIDDEN = 128
SEL_BLOCK = 64
SEL_TOPK = 8
SEL_FORCE = 1e4
WINDOW = 512
N_BUCKETS = 32
MAX_DISTANCE = 1024
TOTAL_HEADS = DA_HEADS + NSA_HEADS
D_FF = 2816
Q_BLOCK = 128
EPS = 1e-6
NEG_INF = -1e30
NSA_KV = NSA_KV_GROUPS * NSA_HEAD_DIM
PROJ_SIZES = (
    DA_HEADS * 2 * DA_HEAD_DIM,
    DA_HEADS * 2 * DA_HEAD_DIM,
    DA_WIDTH,
    NSA_WIDTH,
    NSA_KV, NSA_KV,
    NSA_KV, NSA_KV,
    NSA_KV, NSA_KV,
    3 * NSA_HEADS,
    2 * D_MODEL,
)
N_IN = sum(PROJ_SIZES)

kernel_name = "hybrid_diffattn_nsa_macaron"


def rmsnorm(x, g):
    xf = x.astype(jnp.float32)
    y = xf * lax.rsqrt(jnp.mean(xf * xf, axis=-1, keepdims=True) + EPS)
    return (y * g.astype(jnp.float32)).astype(x.dtype)


def swiglu(h, w1, w3, w2):
    return (jax.nn.silu(h @ w1) * (h @ w3)) @ w2


def masked_softmax(logits, mask):
    s = jnp.where(mask, logits.astype(jnp.float32), NEG_INF)
    p = jax.nn.softmax(s, axis=-1)
    return jnp.where(mask, p, 0.0)


def rel_bucket(dist):
    n = jnp.maximum(dist, 0)
    max_exact = N_BUCKETS // 2
    nf = jnp.maximum(n, 1).astype(jnp.float32)
    large = max_exact + (jnp.log(nf / max_exact) / math.log(MAX_DISTANCE / max_exact)
                         * (N_BUCKETS - max_exact)).astype(jnp.int32)
    large = jnp.minimum(large, N_BUCKETS - 1)
    return jnp.where(n < max_exact, n, large)


def diff_attention(q, k, v, lam, table):
    B, S = q.shape[:2]
    nb = S // Q_BLOCK
    scale = DA_HEAD_DIM ** -0.5
    kpos = jnp.arange(S)
    qb = q.reshape(B, nb, Q_BLOCK, DA_HEADS, 2, DA_HEAD_DIM).swapaxes(0, 1)

    def block(args):
        qi, i = args
        qpos = i * Q_BLOCK + jnp.arange(Q_BLOCK)
        dist = qpos[:, None] - kpos[None, :]
        bias = jnp.take(table, rel_bucket(dist), axis=0).transpose(2, 0, 1)
        s = jnp.einsum('bqhcd,bkhcd->bhcqk', qi, k).astype(jnp.float32) * scale
        s = s + bias[None, :, None].astype(jnp.float32)
        p = masked_softmax(s, dist >= 0)
        a = p[:, :, 0] - lam * p[:, :, 1]
        return jnp.einsum('bhqk,bkhe->bqhe', a.astype(v.dtype), v)

    out = lax.map(block, (qb, jnp.arange(nb)))
    return out.swapaxes(0, 1).reshape(B, S, DA_HEADS, DA_V_DIM)


def compress(x, pe, w1, w2):
    B, S, G, d = x.shape
    ratio = CMP_BLOCK // CMP_STRIDE
    n_cmp = S // CMP_STRIDE - ratio + 1
    c = x.reshape(B, S // CMP_STRIDE, CMP_STRIDE, G, d)
    blocks = jnp.concatenate([c[:, r:r + n_cmp] for r in range(ratio)], axis=2)
    blocks = blocks + pe[None, None, :, None, :]
    flat = blocks.transpose(0, 1, 3, 2, 4).reshape(B, n_cmp, G, CMP_BLOCK * d)
    return jax.nn.gelu(flat @ w1) @ w2


def nsa_attention(q, kc, vc, ks, vs, kw, vw, gates, table):
    B, S = q.shape[:2]
    G, P, d = NSA_KV_GROUPS, NSA_HPG, NSA_HEAD_DIM
    nb = S // Q_BLOCK
    n_cmp = kc.shape[1]
    n_sel = S // SEL_BLOCK
    topk = min(SEL_TOPK, n_sel)
    scale = d ** -0.5
    table_h = table.reshape(N_BUCKETS, G, P)
    cmp_start = jnp.arange(n_cmp) * CMP_STRIDE
    cmp_end = cmp_start + CMP_BLOCK - 1
    sel_j = jnp.arange(n_sel)
    overlap = ((cmp_start[:, None] < (sel_j[None, :] + 1) * SEL_BLOCK)
               & (cmp_end[:, None] >= sel_j[None, :] * SEL_BLOCK)).astype(jnp.float32)
    ks_blocks = ks.reshape(B, n_sel, SEL_BLOCK, G, d).transpose(0, 3, 1, 2, 4)
    vs_blocks = vs.reshape(B, n_sel, SEL_BLOCK, G, d).transpose(0, 3, 1, 2, 4)
    kw_pad = jnp.pad(kw, ((0, 0), (WINDOW, 0), (0, 0), (0, 0)))
    vw_pad = jnp.pad(vw, ((0, 0), (WINDOW, 0), (0, 0), (0, 0)))
    gather = jax.vmap(jax.vmap(lambda t, i: t[i]))
    group_bias = jax.vmap(lambda t, bk: t[bk], in_axes=(1, 1), out_axes=1)
    qb = q.reshape(B, nb, Q_BLOCK, G, P, d).swapaxes(0, 1)
    gb = gates.reshape(B, nb, Q_BLOCK, G, P, 3).swapaxes(0, 1)
    n_keys = topk * SEL_BLOCK

    def block(args):
        qi, gi, i = args
        qpos = i * Q_BLOCK + jnp.arange(Q_BLOCK)
        dist_c = qpos[:, None] - cmp_end[None, :]
        bias_c = table_h[rel_bucket(dist_c)].transpose(2, 3, 0, 1)
        s_c = jnp.einsum('bqgpd,bcgd->bgpqc', qi, kc).astype(jnp.float32) * scale + bias_c
        p_c = masked_softmax(s_c, dist_c >= 0)
        o_c = jnp.einsum('bgpqc,bcgd->bqgpd', p_c.astype(vc.dtype), vc)
        imp = jnp.einsum('bgpqc,cj->bgqj', p_c, overlap)
        cur = qpos // SEL_BLOCK
        forced = ((sel_j[None, :] == 0) | (sel_j[None, :] == cur[:, None])
                  | (sel_j[None, :] == cur[:, None] - 1))
        future = sel_j[None, :] > cur[:, None]
        score = jnp.where(future, -SEL_FORCE, imp + jnp.where(forced, SEL_FORCE, 0.0))
        _, idx = lax.top_k(score, topk)
        k_g = gather(ks_blocks, idx).reshape(B, G, Q_BLOCK, n_keys, d)
        v_g = gather(vs_blocks, idx).reshape(B, G, Q_BLOCK, n_keys, d)
        tpos = (idx[..., None] * SEL_BLOCK + jnp.arange(SEL_BLOCK)).reshape(B, G, Q_BLOCK, n_keys)
        dist_s = qpos[None, None, :, None] - tpos
        bias_s = group_bias(table_h, rel_bucket(dist_s)).transpose(0, 1, 4, 2, 3)
        s_s = jnp.einsum('bqgpd,bgqkd->bgpqk', qi, k_g).astype(jnp.float32) * scale + bias_s
        p_s = masked_softmax(s_s, (dist_s >= 0)[:, :, None])
        o_s = jnp.einsum('bgpqk,bgqkd->bqgpd', p_s.astype(v_g.dtype), v_g)
        kw_i = lax.dynamic_slice_in_dim(kw_pad, i * Q_BLOCK, Q_BLOCK + WINDOW, axis=1)
        vw_i = lax.dynamic_slice_in_dim(vw_pad, i * Q_BLOCK, Q_BLOCK + WINDOW, axis=1)
        kpos_w = i * Q_BLOCK - WINDOW + jnp.arange(Q_BLOCK + WINDOW)
        dist_w = qpos[:, None] - kpos_w[None, :]
        mask_w = (dist_w >= 0) & (dist_w < WINDOW) & (kpos_w[None, :] >= 0)
        bias_w = table_h[rel_bucket(dist_w)].transpose(2, 3, 0, 1)
        s_w = jnp.einsum('bqgpd,bkgd->bgpqk', qi, kw_i).astype(jnp.float32) * scale + bias_w
        p_w = masked_softmax(s_w, mask_w)
        o_w = jnp.einsum('bgpqk,bkgd->bqgpd', p_w.astype(vw_i.dtype), vw_i)
        return gi[..., 0:1] * o_c + gi[..., 1:2] * o_s + gi[..., 2:3] * o_w

    out = lax.map(block, (qb, gb, jnp.arange(nb)))
    return out.swapaxes(0, 1).reshape(B, S, NSA_WIDTH)


def setup_inputs(seed: int = 0) -> dict:
    key = jax.random.key(seed)
    ks = jax.random.split(key, 30)
    f32 = jnp.float32

    def nrm(k, shape, scale):
        return jax.random.normal(k, shape, f32) * scale

    def gain(k, shape):
        return 1.0 + 0.05 * jax.random.normal(k, shape, f32)

    d = D_MODEL
    return {
        "x": nrm(ks[0], (BATCH, SEQ, d), 1.0),
        "w_in": nrm(ks[1], (DEPTH, d, N_IN), d ** -0.5),
        "w_branch_a": nrm(ks[2], (DEPTH, DA_WIDTH, d), DA_WIDTH ** -0.5),
        "w_branch_b": nrm(ks[3], (DEPTH, NSA_WIDTH, d), NSA_WIDTH ** -0.5),
        "w_out": nrm(ks[4], (DEPTH, d, d), d ** -0.5),
        "norm_ffn1": gain(ks[5], (DEPTH, d)),
        "norm_mix": gain(ks[6], (DEPTH, d)),
        "norm_ffn2": gain(ks[7], (DEPTH, d)),
        "ffn1_w1": nrm(ks[8], (DEPTH, d, D_FF), d ** -0.5),
        "ffn1_w3": nrm(ks[9], (DEPTH, d, D_FF), d ** -0.5),
        "ffn1_w2": nrm(ks[10], (DEPTH, D_FF, d), D_FF ** -0.5),
        "ffn2_w1": nrm(ks[11], (DEPTH, d, D_FF), d ** -0.5),
        "ffn2_w3": nrm(ks[12], (DEPTH, d, D_FF), d ** -0.5),
        "ffn2_w2": nrm(ks[13], (DEPTH, D_FF, d), D_FF ** -0.5),
        "da_q_gain": gain(ks[14], (DEPTH, DA_HEAD_DIM)),
        "da_k_gain": gain(ks[15], (DEPTH, DA_HEAD_DIM)),
        "da_lambda_q1": nrm(ks[16], (DEPTH, DA_HEAD_DIM), 0.1),
        "da_lambda_k1": nrm(ks[17], (DEPTH, DA_HEAD_DIM), 0.1),
        "da_lambda_q2": nrm(ks[18], (DEPTH, DA_HEAD_DIM), 0.1),
        "da_lambda_k2": nrm(ks[19], (DEPTH, DA_HEAD_DIM), 0.1),
        "da_subln_gain": gain(ks[20], (DEPTH, DA_V_DIM)),
        "nsa_q_gain": gain(ks[21], (DEPTH, NSA_HEAD_DIM)),
        "nsa_k_gain": gain(ks[22], (DEPTH, 3, NSA_HEAD_DIM)),
        "cmp_pe_k": nrm(ks[23], (DEPTH, CMP_BLOCK, NSA_HEAD_DIM), 0.1),
        "cmp_w1_k": nrm(ks[24], (DEPTH, CMP_BLOCK * NSA_HEAD_DIM, CMP_HIDDEN), (CMP_BLOCK * NSA_HEAD_DIM) ** -0.5),
        "cmp_w2_k": nrm(ks[25], (DEPTH, CMP_HIDDEN, NSA_HEAD_DIM), CMP_HIDDEN ** -0.5),
        "cmp_pe_v": nrm(ks[26], (DEPTH, CMP_BLOCK, NSA_HEAD_DIM), 0.1),
        "cmp_w1_v": nrm(ks[27], (DEPTH, CMP_BLOCK * NSA_HEAD_DIM, CMP_HIDDEN), (CMP_BLOCK * NSA_HEAD_DIM) ** -0.5),
        "cmp_w2_v": nrm(ks[28], (DEPTH, CMP_HIDDEN, NSA_HEAD_DIM), CMP_HIDDEN ** -0.5),
        "rel_bias_table": nrm(ks[29], (N_BUCKETS, TOTAL_HEADS), 0.3),
    }


def reference(x, w_in, w_branch_a, w_branch_b, w_out, norm_ffn1, norm_mix, norm_ffn2,
              ffn1_w1, ffn1_w3, ffn1_w2, ffn2_w1, ffn2_w3, ffn2_w2,
              da_q_gain, da_k_gain, da_lambda_q1, da_lambda_k1, da_lambda_q2, da_lambda_k2,
              da_subln_gain, nsa_q_gain, nsa_k_gain,
              cmp_pe_k, cmp_w1_k, cmp_w2_k, cmp_pe_v, cmp_w1_v, cmp_w2_v,
              rel_bias_table):
    B, S, D = x.shape
    G, P, dh = NSA_KV_GROUPS, NSA_HPG, NSA_HEAD_DIM
    offsets = [int(o) for o in np.cumsum(PROJ_SIZES)[:-1]]
    table_a = rel_bias_table[:, :DA_HEADS]
    table_b = rel_bias_table[:, DA_HEADS:]
    for l in range(DEPTH):
        h = rmsnorm(x, norm_ffn1[l])
        x = x + 0.5 * swiglu(h, ffn1_w1[l], ffn1_w3[l], ffn1_w2[l])
        h = rmsnorm(x, norm_mix[l])
        z = h @ w_in[l]
        (dq, dk, dv, nq, kc, vc, ksel, vsel, kwin, vwin, ng, mg) = jnp.split(z, offsets, axis=-1)
        dq = rmsnorm(dq.reshape(B, S, DA_HEADS, 2, DA_HEAD_DIM), da_q_gain[l])
        dk = rmsnorm(dk.reshape(B, S, DA_HEADS, 2, DA_HEAD_DIM), da_k_gain[l])
        dv = dv.reshape(B, S, DA_HEADS, DA_V_DIM)
        lam_init = 0.8 - 0.6 * math.exp(-0.3 * l)
        lam = (jnp.exp(jnp.sum(da_lambda_q1[l].astype(jnp.float32) * da_lambda_k1[l].astype(jnp.float32)))
               - jnp.exp(jnp.sum(da_lambda_q2[l].astype(jnp.float32) * da_lambda_k2[l].astype(jnp.float32)))
               + lam_init)
        ya = diff_attention(dq, dk, dv, lam, table_a)
        ya = (rmsnorm(ya, da_subln_gain[l]) * (1.0 - lam_init)).reshape(B, S, DA_WIDTH)
        nq = rmsnorm(nq.reshape(B, S, G, P, dh), nsa_q_gain[l])
        kc = rmsnorm(compress(kc.reshape(B, S, G, dh), cmp_pe_k[l], cmp_w1_k[l], cmp_w2_k[l]), nsa_k_gain[l, 0])
        vc = compress(vc.reshape(B, S, G, dh), cmp_pe_v[l], cmp_w1_v[l], cmp_w2_v[l])
        ksel = rmsnorm(ksel.reshape(B, S, G, dh), nsa_k_gain[l, 1])
        vsel = vsel.reshape(B, S, G, dh)
        kwin = rmsnorm(kwin.reshape(B, S, G, dh), nsa_k_gain[l, 2])
        vwin = vwin.reshape(B, S, G, dh)
        ng = jax.nn.sigmoid(ng.reshape(B, S, G, P, 3))
        yb = nsa_attention(nq, kc, vc, ksel, vsel, kwin, vwin, ng, table_b)
        mg = jax.nn.sigmoid(mg.reshape(B, S, 2, D))
        merged = mg[:, :, 0] * (ya @ w_branch_a[l]) + mg[:, :, 1] * (yb @ w_branch_b[l])
        x = x + merged @ w_out[l]
        h = rmsnorm(x, norm_ffn2[l])
        x = x + 0.5 * swiglu(h, ffn2_w1[l], ffn2_w3[l], ffn2_w2[l])
    return x
```

```cpp
#include <hip/hip_runtime.h>
#include <hip/hip_cooperative_groups.h>
#include <cstdio>
#include <cstdint>
namespace cg = cooperative_groups;
namespace pg8 {
#define PG8_LAS __attribute__((address_space(3)))
typedef unsigned short bf16_t;
typedef short bf16x8 __attribute__((ext_vector_type(8)));
typedef float f32x4 __attribute__((ext_vector_type(4)));
typedef unsigned u32x4 __attribute__((ext_vector_type(4)));
constexpr int BM = 256, BK = 64, HALF = 128, HTB = HALF * BK * 2  , STAGE_BYTES = 8 * HTB, NXCD = 8, WGM = 8;

__host__ __device__ __forceinline__ int lds_byte(int r, int c) { const int st = (r >> 4) * 2 + (c >> 5), rr = r & 15, cc = c & 31, ob = rr * 64 + cc * 2; return st * 1024 + (ob ^ (((ob >> 9) & 1) << 5)); }
__host__ __device__ __forceinline__ void stage_rc(int b, int& R, int& C) { const int st = b / 1024, sb = b % 1024, swz = sb ^ (((sb >> 9) & 1) << 5); R = (st >> 1) * 16 + swz / 64; C = (st & 1) * 32 + (swz % 64) / 2; }
__host__ __device__ __forceinline__ int perm32(int rho) { const int n = rho >> 4, i = rho & 15; return 8 * (i >> 2) + 4 * n + (i & 3); }

struct Unit { int pm, pn; };
struct Gemm { const bf16_t* A; const bf16_t* Bt; int M, N, K; };

struct StaticOrder {
    int nM, nN, nwg, G, c;
    __host__ __device__ void init(int M, int N, int G_, int c_) { nM = M / BM; nN = N / BM; nwg = nM * nN; G = G_; c = c_; }
    __host__ __device__ bool next(int i, Unit& u) const {
        const long L = (long)i * G + c; if (L >= nwg) return false;
        int wgid = (int)L; { const int q = nwg / NXCD, r = nwg % NXCD, xcd = wgid % NXCD, off = wgid / NXCD; wgid = (xcd < r ? xcd * (q + 1) : r * (q + 1) + (xcd - r) * q) + off; }
        const int nig = WGM * nN, gid = wgid / nig, fm = gid * WGM, gsz = (nM - fm) < WGM ? (nM - fm) : WGM;
        u.pm = fm + ((wgid % nig) % gsz); u.pn = (wgid % nig) / gsz; return true;
    }
    __device__ __forceinline__ void a_ready(const Unit&) const {}
    __device__ __forceinline__ void done(const Unit&) const {}
};

typedef float f32x2_t __attribute__((ext_vector_type(2))); typedef __bf16 bf16x2_t __attribute__((ext_vector_type(2)));
__device__ __forceinline__ unsigned cvt_pk_bf16(float lo, float hi) { f32x2_t v = {lo, hi}; bf16x2_t b = __builtin_convertvector(v, bf16x2_t); return __builtin_bit_cast(unsigned, b); }
template <class Epi, class Sched, bool ALIGN_EPI = false, bool SP2 = false>
__device__ __forceinline__ void gemm_phase(PG8_LAS unsigned char* lds, const Gemm g, const Sched& S, const Epi& E) {
    int tid_ = threadIdx.x; asm volatile("" : "+v"(tid_)); const int tid = tid_, wid = __builtin_amdgcn_readfirstlane(tid >> 6), lane = tid & 63, wr = wid >> 2, wc = wid & 3, fr = lane & 15, fq = lane >> 4;
    const int K = g.K, nt = K / BK;
    unsigned voffA[2], voffB[2];
#pragma unroll
    for (int i = 0; i < 2; ++i) { int R, C; stage_rc(tid * 16 + i * 8192, R, C); const int Rb = Epi::PERM ? ((R & ~31) + perm32(R & 31)) : R;
        voffA[i] = (unsigned)(R * K + C) * 2u; voffB[i] = (unsigned)(Rb * K + C) * 2u; }
    const size_t kstep = (size_t)(BK * 2);
    const size_t hstep = (size_t)HALF * K * 2;
    const size_t tstep = 2 * hstep;
    const unsigned ldsw = (unsigned)wid * 1024u;
    const int aoff = lds_byte(wr * 64 + fr, fq * 8), boff = lds_byte(wc * 32 + fr, fq * 8);
#define PG8_SA(b, h) (((b) * 2 + (h)) * HTB)
#define PG8_SB(b, h) ((4 + (b) * 2 + (h)) * HTB)
#define PG8_STAGE(bufoff, gbase, voff) do { _Pragma("unroll") for (int _i = 0; _i < 2; ++_i) \
        __builtin_amdgcn_global_load_lds((const unsigned*)((const char*)(gbase) + (voff)[_i]), (PG8_LAS unsigned*)(lds + (bufoff) + ldsw + _i * 8192), 16, 0, 0); } while (0)
#define PG8_LDA(dst, b, h) do { _Pragma("unroll") for (int m = 0; m < 4; ++m) _Pragma("unroll") for (int k = 0; k < 2; ++k) dst[m][k] = *(const PG8_LAS bf16x8*)(lds + PG8_SA(b, h) + aoff + m * 2048 + k * 1024); } while (0)
#define PG8_LDB(dst, b, h) do { _Pragma("unroll") for (int n = 0; n < 2; ++n) _Pragma("unroll") for (int k = 0; k < 2; ++k) dst[n][k] = *(const PG8_LAS bf16x8*)(lds + PG8_SB(b, h) + boff + n * 2048 + k * 1024); } while (0)
#define PG8_MMA(ai, bj, At, Bt) do { __builtin_amdgcn_s_setprio(1); _Pragma("unroll") for (int m = 0; m < 4; ++m) _Pragma("unroll") for (int n = 0; n < 2; ++n) _Pragma("unroll") for (int k = 0; k < 2; ++k) \
        acc[ai][bj][m][n] = __builtin_amdgcn_mfma_f32_16x16x32_bf16(Bt[n][k], At[m][k], acc[ai][bj][m][n], 0, 0, 0); __builtin_amdgcn_s_setprio(0); } while (0)
#define PG8_WAIT_V(n) asm volatile("s_waitcnt vmcnt(" #n ")" ::: "memory")
#define PG8_WAIT_L(n) asm volatile("s_waitcnt lgkmcnt(" #n ")" ::: "memory")
#define PG8_BAR __builtin_amdgcn_s_barrier()
#define PG8_SCHED __builtin_amdgcn_sched_barrier(0)
    Unit cur, nxt; int ui = 0;
    if (!S.next(0, cur)) return;
    f32x4 acc[2][2][4][2];
#pragma unroll
    for (int a = 0; a < 2; ++a)
#pragma unroll
        for (int b = 0; b < 2; ++b)
#pragma unroll
            for (int m = 0; m < 4; ++m)
#pragma unroll
                for (int n = 0; n < 2; ++n) acc[a][b][m][n] = (f32x4){0.f, 0.f, 0.f, 0.f};
    bf16x8 At[4][2], B0[2][2], B1[2][2];
    const char* cA = (const char*)g.A + (size_t)cur.pm * tstep; const char* cB = (const char*)g.Bt + (size_t)cur.pn * tstep;
    S.a_ready(cur);
    if constexpr (SP2) {
        PG8_STAGE(PG8_SB(0, 0), cB, voffB); PG8_STAGE(PG8_SB(0, 1), cB + hstep, voffB); PG8_STAGE(PG8_SA(0, 0), cA, voffA); PG8_STAGE(PG8_SA(0, 1), cA + hstep, voffA);
        if (wr == 1) PG8_BAR;
        PG8_WAIT_V(2); PG8_BAR;
        PG8_STAGE(PG8_SB(1, 0), cB + kstep, voffB); PG8_STAGE(PG8_SA(1, 0), cA + kstep, voffA); PG8_STAGE(PG8_SB(1, 1), cB + hstep + kstep, voffB);
        PG8_WAIT_V(6); PG8_BAR;
    } else {
        PG8_STAGE(PG8_SB(0, 0), cB, voffB); PG8_STAGE(PG8_SA(0, 0), cA, voffA); PG8_STAGE(PG8_SB(0, 1), cB + hstep, voffB); PG8_STAGE(PG8_SA(0, 1), cA + hstep, voffA);
        if (wr == 1) PG8_BAR;
        PG8_WAIT_V(4); PG8_BAR;
        PG8_STAGE(PG8_SB(1, 0), cB + kstep, voffB); PG8_STAGE(PG8_SA(1, 0), cA + kstep, voffA); PG8_STAGE(PG8_SB(1, 1), cB + hstep + kstep, voffB);
        PG8_WAIT_V(6); PG8_BAR;
    }
    for (;;) {
        const bool has_next = S.next(ui + 1, nxt);
        const char* nA = has_next ? (const char*)g.A + (size_t)nxt.pm * tstep : cA; const char* nB = has_next ? (const char*)g.Bt + (size_t)nxt.pn * tstep : cB;
        for (int t = 0; t < nt; t += 2) {
            const bool last = (t == nt - 2);
            const char* a1 = cA + (size_t)(t + 1) * kstep;
            const char* a2 = last ? nA : cA + (size_t)(t + 2) * kstep; const char* b2 = last ? nB : cB + (size_t)(t + 2) * kstep;
            const char* a3 = a2 + kstep; const char* b3 = b2 + kstep;
            if (last && has_next) S.a_ready(nxt);
            if constexpr (SP2) {
            PG8_LDB(B0, 0, 0); PG8_LDB(B1, 0, 1); PG8_SCHED; PG8_LDA(At, 0, 0); PG8_STAGE(PG8_SA(1, 1), a1 + hstep, voffA);
            PG8_WAIT_V(8); PG8_WAIT_L(0); PG8_BAR; PG8_MMA(0, 0, At, B0); PG8_MMA(0, 1, At, B1); PG8_BAR; PG8_SCHED;
            PG8_LDA(At, 0, 1); PG8_STAGE(PG8_SB(0, 0), b2, voffB); PG8_STAGE(PG8_SB(0, 1), b2 + hstep, voffB); PG8_STAGE(PG8_SA(0, 0), a2, voffA);
            PG8_WAIT_V(8); PG8_WAIT_L(0); PG8_BAR; PG8_MMA(1, 0, At, B0); PG8_MMA(1, 1, At, B1); PG8_BAR; PG8_SCHED;
            PG8_LDB(B0, 1, 0); PG8_LDB(B1, 1, 1); PG8_SCHED; PG8_LDA(At, 1, 0); PG8_STAGE(PG8_SA(0, 1), a2 + hstep, voffA);
            PG8_WAIT_V(8); PG8_WAIT_L(0); PG8_BAR; PG8_MMA(0, 0, At, B0); PG8_MMA(0, 1, At, B1); PG8_BAR; PG8_SCHED;
            PG8_LDA(At, 1, 1); PG8_STAGE(PG8_SB(1, 0), b3, voffB); PG8_STAGE(PG8_SB(1, 1), b3 + hstep, voffB); PG8_STAGE(PG8_SA(1, 0), a3, voffA);
            PG8_WAIT_V(8); PG8_WAIT_L(0); PG8_BAR; PG8_MMA(1, 0, At, B0); PG8_MMA(1, 1, At, B1); PG8_BAR; PG8_SCHED;
            } else {
            PG8_LDB(B0, 0, 0); PG8_SCHED; PG8_LDA(At, 0, 0); PG8_STAGE(PG8_SA(1, 1), a1 + hstep, voffA);
            PG8_WAIT_L(8); PG8_BAR; PG8_WAIT_L(0); PG8_MMA(0, 0, At, B0); PG8_BAR; PG8_SCHED;
            PG8_LDB(B1, 0, 1); PG8_STAGE(PG8_SB(0, 0), b2, voffB);
            PG8_BAR; PG8_WAIT_L(0); PG8_MMA(0, 1, At, B1); PG8_BAR;
            PG8_LDA(At, 0, 1); PG8_STAGE(PG8_SA(0, 0), a2, voffA);
            PG8_BAR; PG8_WAIT_L(0); PG8_MMA(1, 0, At, B0); PG8_BAR; PG8_SCHED;
            PG8_STAGE(PG8_SB(0, 1), b2 + hstep, voffB);
            PG8_WAIT_V(6); PG8_BAR; PG8_MMA(1, 1, At, B1); PG8_BAR;
            PG8_LDB(B0, 1, 0); PG8_SCHED; PG8_LDA(At, 1, 0); PG8_STAGE(PG8_SA(0, 1), a2 + hstep, voffA);
            PG8_WAIT_L(8); PG8_BAR; PG8_WAIT_L(0); PG8_MMA(0, 0, At, B0); PG8_BAR; PG8_SCHED;
            PG8_LDB(B1, 1, 1); PG8_STAGE(PG8_SB(1, 0), b3, voffB);
            PG8_BAR; PG8_WAIT_L(0); PG8_MMA(0, 1, At, B1); PG8_BAR;
            PG8_LDA(At, 1, 1); PG8_STAGE(PG8_SA(1, 0), a3, voffA);
            PG8_BAR; PG8_WAIT_L(0); PG8_MMA(1, 0, At, B0); PG8_BAR; PG8_SCHED;
            PG8_STAGE(PG8_SB(1, 1), b3 + hstep, voffB);
            PG8_WAIT_V(6); PG8_BAR; PG8_MMA(1, 1, At, B1); PG8_BAR;
            }
        }
        if constexpr (ALIGN_EPI) { if (wr == 0) PG8_BAR; }
        if constexpr (!Epi::AFTER_DRAIN) { E(acc, cur, wr, wc, fr, fq); S.done(cur); }
        if (!has_next) break;
#pragma unroll
        for (int a = 0; a < 2; ++a)
#pragma unroll
            for (int b = 0; b < 2; ++b)
#pragma unroll
                for (int m = 0; m < 4; ++m)
#pragma unroll
                    for (int n = 0; n < 2; ++n) acc[a][b][m][n] = (f32x4){0.f, 0.f, 0.f, 0.f};
        cur = nxt; cA = nA; cB = nB; ++ui;
        if constexpr (ALIGN_EPI) { if (wr == 1) PG8_BAR; }
    }
    PG8_WAIT_V(0);
    if constexpr (!ALIGN_EPI) { if (wr == 0) PG8_BAR; }
    PG8_BAR;
    if constexpr (Epi::AFTER_DRAIN) { E.fused(acc, cur, wr, wc, fr, fq, lds, wid, lane); S.done(cur); }
#undef PG8_SA
#undef PG8_SB
#undef PG8_STAGE
#undef PG8_LDA
#undef PG8_LDB
#undef PG8_MMA
#undef PG8_WAIT_V
#undef PG8_WAIT_L
#undef PG8_BAR
#undef PG8_SCHED
}
}

#define LAS __attribute__((address_space(3)))
typedef unsigned short bf16_t;
typedef short bf16x8 __attribute__((ext_vector_type(8)));
typedef short bf16x4 __attribute__((ext_vector_type(4)));
typedef float f32x4 __attribute__((ext_vector_type(4)));
typedef float f32x16 __attribute__((ext_vector_type(16)));
typedef unsigned u32x4 __attribute__((ext_vector_type(4)));
typedef unsigned u32x2 __attribute__((ext_vector_type(2)));

constexpr int BATCH = 8, SEQ = 4096, DM = 1024, MTOK = BATCH * SEQ, DFF = 2816, DEPTH = 2, NIN = 4888;
constexpr int NTHR = 512, NWAVE = 8;
constexpr float EPS = 1e-6f, LOG2E = 1.4426950408889634f;
constexpr float QSCALE = 0.125f * LOG2E;
constexpr size_t MiB = 1u << 20;
constexpr size_t WS_BIAS = 0;
constexpr size_t WS_PRM = 64 * 1024;
constexpr size_t WS_CB1 = 68 * 1024;
constexpr size_t WS_W13 = 1 * MiB;
constexpr size_t W13_SZ = (size_t)5632 * 1024 * 2;
constexpr size_t WS_W2 = 45 * MiB;
constexpr size_t W2_SZ = (size_t)1024 * 2816 * 2;
constexpr size_t WS_WIN = 68 * MiB;
constexpr size_t WIN_SZ = (size_t)5120 * 1024 * 2;
constexpr size_t WS_PAB = 88 * MiB;
constexpr size_t PAB_SZ = (size_t)2048 * 1024 * 2;
constexpr size_t WS_WO = 96 * MiB;
constexpr size_t WO_SZ = (size_t)1024 * 1024 * 2;
constexpr size_t WS_CW1 = 100 * MiB;
constexpr size_t CW1_SZ = (size_t)128 * 2048 * 2;
constexpr size_t WS_CW2 = 102 * MiB;
constexpr size_t CW2_SZ = (size_t)64 * 128 * 2;
constexpr size_t WS_KCN = 103 * MiB;
constexpr size_t WS_VCT = WS_KCN + 512 * 1024;
constexpr size_t WS_XN = 104 * MiB;
constexpr size_t WS_Z = 168 * MiB;
constexpr size_t Z_DQ = WS_Z, Z_DK = WS_Z + 32 * MiB, Z_DVT = WS_Z + 64 * MiB, Z_NQ = WS_Z + 96 * MiB;
constexpr size_t Z_KCR = WS_Z + 128 * MiB, Z_VCR = WS_Z + 136 * MiB, Z_KSEL = WS_Z + 144 * MiB, Z_VSELT = WS_Z + 152 * MiB;
constexpr size_t Z_KWIN = WS_Z + 160 * MiB, Z_VWINT = WS_Z + 168 * MiB, Z_NG = WS_Z + 176 * MiB, Z_MG = WS_Z + 180 * MiB;
constexpr size_t WS_MERGED = WS_Z;
constexpr size_t WS_HID = WS_Z;
constexpr size_t WS_END = WS_Z + 308 * MiB;
constexpr int LDS_BYTES = 147456;
constexpr int KP = 144, VP = 136;
constexpr int DA_STAGE = 2 * 64 * KP + 128 * VP;
constexpr int NS_STAGE = 64 * KP + 64 * VP;
constexpr int L_BIAS = 73728;
constexpr int L_IMP = L_BIAS + 16384;
constexpr int L_SEL = L_IMP + 16384;
constexpr int L_WSF = L_SEL + 1024;
constexpr int L_END = L_WSF + 8 * 256;

struct Params {
    const float* in[30];
    float* out;
    unsigned char* ws;
};

constexpr int L_PTAB = LDS_BYTES - 512;
__device__ __forceinline__ const float* ld_ptr(const LAS unsigned char* lds, int i) {
    unsigned a = L_PTAB + 8 * i; asm volatile("" : "+v"(a));
    const LAS unsigned* t = (const LAS unsigned*)(lds + a);
    const unsigned lo = __builtin_amdgcn_readfirstlane(t[0]), hi = __builtin_amdgcn_readfirstlane(t[1]);
    return (const float*)(((unsigned long long)hi << 32) | lo);
}
#define INP(i) ld_ptr(lds, (i))
#define OUTP ((float*)ld_ptr(lds, 30))
#define WSP ((unsigned char*)ld_ptr(lds, 31))

__device__ __forceinline__ unsigned f2bf(float f) { unsigned u = __builtin_bit_cast(unsigned, f); return (u + 0x7fffu + ((u >> 16) & 1u)) >> 16; }
__device__ __forceinline__ unsigned pk2(float lo, float hi) { return f2bf(lo) | (f2bf(hi) << 16); }
__device__ __forceinline__ float sigmoidf_(float x) { return __builtin_amdgcn_rcpf(1.0f + __builtin_amdgcn_exp2f(-x * LOG2E)); }
__device__ __forceinline__ int otid() { int t = threadIdx.x; asm volatile("" : "+v"(t)); return t; }
__device__ __forceinline__ int crow(int r, int hi) { return (r & 3) + 8 * (r >> 2) + 4 * hi; }

struct EpiSwiGLU {
    static constexpr bool PERM = true, AFTER_DRAIN = false;
    bf16_t* H;
    __device__ __forceinline__ void operator()(const f32x4 (&acc)[2][2][4][2], const pg8::Unit& u, int wr, int wc, int fr, int fq) const {
        const int row0 = u.pm * 256 + wr * 64 + fr, col = u.pn * 128 + wc * 32 + 8 * fq;
#pragma unroll
        for (int ai = 0; ai < 2; ++ai)
#pragma unroll
            for (int m = 0; m < 4; ++m) {
                float h[8];
#pragma unroll
                for (int n = 0; n < 2; ++n)
#pragma unroll
                    for (int e = 0; e < 4; ++e) { const float g = acc[ai][0][m][n][e], up = acc[ai][1][m][n][e]; h[n * 4 + e] = g * sigmoidf_(g) * up; }
                u32x4 w; w.x = pg8::cvt_pk_bf16(h[0], h[1]); w.y = pg8::cvt_pk_bf16(h[2], h[3]); w.z = pg8::cvt_pk_bf16(h[4], h[5]); w.w = pg8::cvt_pk_bf16(h[6], h[7]);
                *(u32x4*)(H + (size_t)(row0 + ai * 128 + m * 16) * DFF + col) = w;
            }
    }
};
struct EpiResid {
    static constexpr bool PERM = false, AFTER_DRAIN = false;
    const float* base; float* out; float alpha;
    __device__ __forceinline__ void operator()(const f32x4 (&acc)[2][2][4][2], const pg8::Unit& u, int wr, int wc, int fr, int fq) const {
        const int row0 = u.pm * 256 + wr * 64 + fr, col0 = u.pn * 256 + wc * 32 + 4 * fq;
#pragma unroll
        for (int ai = 0; ai < 2; ++ai)
#pragma unroll
            for (int m = 0; m < 4; ++m) {
                const size_t off = (size_t)(row0 + ai * 128 + m * 16) * DM + col0;
#pragma unroll
                for (int bj = 0; bj < 2; ++bj)
#pragma unroll
                    for (int n = 0; n < 2; ++n) { const f32x4 b = *(const f32x4*)(base + off + bj * 128 + n * 16); *(f32x4*)(out + off + bj * 128 + n * 16) = b + acc[ai][bj][m][n] * alpha; }
            }
    }
};
struct EpiMerge {
    static constexpr bool PERM = true, AFTER_DRAIN = false;
    const bf16_t* MG; bf16_t* O;
    __device__ __forceinline__ void operator()(const f32x4 (&acc)[2][2][4][2], const pg8::Unit& u, int wr, int wc, int fr, int fq) const {
        const int row0 = u.pm * 256 + wr * 64 + fr, col = u.pn * 128 + wc * 32 + 8 * fq;
#pragma unroll
        for (int ai = 0; ai < 2; ++ai)
#pragma unroll
            for (int m = 0; m < 4; ++m) {
                const int row = row0 + ai * 128 + m * 16;
                const u32x4 s0 = *(const u32x4*)(MG + (size_t)row * 2048 + col), s1 = *(const u32x4*)(MG + (size_t)row * 2048 + 1024 + col);
                float h[8];
#pragma unroll
                for (int i = 0; i < 8; ++i) {
                    const unsigned w0 = s0[i >> 1], w1 = s1[i >> 1];
                    const float g0 = __builtin_bit_cast(float, (i & 1) ? (w0 & 0xffff0000u) : (w0 << 16)), g1 = __builtin_bit_cast(float, (i & 1) ? (w1 & 0xffff0000u) : (w1 << 16));
                    h[i] = g0 * acc[ai][0][m][i >> 2][i & 3] + g1 * acc[ai][1][m][i >> 2][i & 3];
                }
                u32x4 w; w.x = pg8::cvt_pk_bf16(h[0], h[1]); w.y = pg8::cvt_pk_bf16(h[2], h[3]); w.z = pg8::cvt_pk_bf16(h[4], h[5]); w.w = pg8::cvt_pk_bf16(h[6], h[7]);
                *(u32x4*)(O + (size_t)row * DM + col) = w;
            }
    }
};
struct EpiZ {
    static constexpr bool PERM = true, AFTER_DRAIN = false;
    unsigned char* ws; const float *gq, *gk, *gnq, *gnk;
    __device__ __forceinline__ void operator()(const f32x4 (&acc)[2][2][4][2], const pg8::Unit& u, int wr, int wc, int fr, int fq) const {
        const int ch = 4 * u.pn + wc;
        if (ch >= 77) return;
        const int row0 = u.pm * 256 + wr * 64 + fr;
        int kind, nh = 8, hd = 0, nd = 64, dbase = 0; size_t dst = 0; const float* gain = nullptr; float scale = 1.f;
        if (ch < 8) { kind = 0; dst = Z_DQ; hd = ch; gain = gq; scale = QSCALE; }
        else if (ch < 16) { kind = 0; dst = Z_DK; hd = ch - 8; gain = gk; }
        else if (ch < 24) { kind = 2; dst = Z_DVT; nh = 4; hd = (ch - 16) >> 1; nd = 128; dbase = ((ch - 16) & 1) * 64; }
        else if (ch < 32) { kind = 0; dst = Z_NQ; hd = ch - 24; gain = gnq; scale = QSCALE; }
        else if (ch < 34) { kind = 1; dst = Z_KCR; nh = 2; hd = ch - 32; }
        else if (ch < 36) { kind = 1; dst = Z_VCR; nh = 2; hd = ch - 34; }
        else if (ch < 38) { kind = 0; dst = Z_KSEL; nh = 2; hd = ch - 36; gain = gnk + 64; }
        else if (ch < 40) { kind = 2; dst = Z_VSELT; nh = 2; hd = ch - 38; }
        else if (ch < 42) { kind = 0; dst = Z_KWIN; nh = 2; hd = ch - 40; gain = gnk + 128; }
        else if (ch < 44) { kind = 2; dst = Z_VWINT; nh = 2; hd = ch - 42; }
        else if (ch < 76) { kind = 3; }
        else { kind = 4; }
        if (kind == 0 || kind == 1) {
            float gv[16];
#pragma unroll
            for (int i = 0; i < 16; ++i) gv[i] = (kind == 0) ? gain[(i >> 3) * 32 + 8 * fq + (i & 7)] * scale : 1.f;
#pragma unroll
            for (int ai = 0; ai < 2; ++ai)
#pragma unroll
                for (int m = 0; m < 4; ++m) {
                    const int row = row0 + ai * 128 + m * 16, b = row >> 12, s = row & 4095;
                    float v[16];
#pragma unroll
                    for (int i = 0; i < 16; ++i) v[i] = acc[ai][i >> 3][m][(i >> 2) & 1][i & 3];
                    float rs = 1.f;
                    if (kind == 0) {
                        float ss = 0.f;
#pragma unroll
                        for (int i = 0; i < 16; ++i) ss += v[i] * v[i];
                        ss += __shfl_xor(ss, 16); ss += __shfl_xor(ss, 32);
                        rs = __builtin_amdgcn_rsqf(ss * (1.f / 64.f) + EPS);
                    }
#pragma unroll
                    for (int i = 0; i < 16; ++i) v[i] *= rs * gv[i];
                    bf16_t* d = (bf16_t*)(ws + dst) + ((size_t)(b * nh + hd) * SEQ + s) * 64 + 8 * fq;
                    u32x4 w0, w1;
                    w0.x = pg8::cvt_pk_bf16(v[0], v[1]); w0.y = pg8::cvt_pk_bf16(v[2], v[3]); w0.z = pg8::cvt_pk_bf16(v[4], v[5]); w0.w = pg8::cvt_pk_bf16(v[6], v[7]);
                    w1.x = pg8::cvt_pk_bf16(v[8], v[9]); w1.y = pg8::cvt_pk_bf16(v[10], v[11]); w1.z = pg8::cvt_pk_bf16(v[12], v[13]); w1.w = pg8::cvt_pk_bf16(v[14], v[15]);
                    *(u32x4*)d = w0; *(u32x4*)(d + 32) = w1;
                }
        } else if (kind == 2) {
#pragma unroll
            for (int ai = 0; ai < 2; ++ai)
#pragma unroll
                for (int m = 0; m < 4; ++m) {
                    const int row = row0 + ai * 128 + m * 16, b = row >> 12, s = row & 4095;
                    bf16_t* d = (bf16_t*)(ws + dst) + ((size_t)(b * nh + hd) * nd + dbase + 8 * fq) * SEQ + s;
#pragma unroll
                    for (int i = 0; i < 16; ++i) d[(size_t)((i >> 3) * 32 + (i & 7)) * SEQ] = (bf16_t)f2bf(acc[ai][i >> 3][m][(i >> 2) & 1][i & 3]);
                }
        } else if (kind == 3) {
            const int col = (ch - 44) * 64 + 8 * fq;
#pragma unroll
            for (int ai = 0; ai < 2; ++ai)
#pragma unroll
                for (int m = 0; m < 4; ++m) {
                    const int row = row0 + ai * 128 + m * 16;
                    float v[16];
#pragma unroll
                    for (int i = 0; i < 16; ++i) v[i] = sigmoidf_(acc[ai][i >> 3][m][(i >> 2) & 1][i & 3]);
                    bf16_t* d = (bf16_t*)(ws + Z_MG) + (size_t)row * 2048 + col;
                    u32x4 w0, w1;
                    w0.x = pg8::cvt_pk_bf16(v[0], v[1]); w0.y = pg8::cvt_pk_bf16(v[2], v[3]); w0.z = pg8::cvt_pk_bf16(v[4], v[5]); w0.w = pg8::cvt_pk_bf16(v[6], v[7]);
                    w1.x = pg8::cvt_pk_bf16(v[8], v[9]); w1.y = pg8::cvt_pk_bf16(v[10], v[11]); w1.z = pg8::cvt_pk_bf16(v[12], v[13]); w1.w = pg8::cvt_pk_bf16(v[14], v[15]);
                    *(u32x4*)d = w0; *(u32x4*)(d + 32) = w1;
                }
        } else {
            if (fq < 3) {
#pragma unroll
                for (int ai = 0; ai < 2; ++ai)
#pragma unroll
                    for (int m = 0; m < 4; ++m) {
                        const int row = row0 + ai * 128 + m * 16;
                        float* d = (float*)(ws + Z_NG) + (size_t)row * 24 + 8 * fq;
#pragma unroll
                        for (int i = 0; i < 8; ++i) d[i] = sigmoidf_(acc[ai][0][m][i >> 2][i & 3]);
                    }
            }
        }
    }
};

__device__ __forceinline__ void tr_item(const float* src, int ld, int c0, int nvalid, int k0, bf16_t* dst, int Kdst, LAS float* scr, int lane) {
    const int n = lane & 31;
#pragma unroll 8
    for (int i = 0; i < 32; ++i) { const int kk = 2 * i + (lane >> 5); scr[kk * 33 + n] = (src && n < nvalid) ? src[(size_t)(k0 + kk) * ld + c0 + n] : 0.f; }
    asm volatile("s_waitcnt lgkmcnt(0)" ::: "memory");
    const int c = lane & 7;
#pragma unroll
    for (int j = 0; j < 4; ++j) { const int nn = (lane >> 3) + 8 * j; const LAS float* s = scr + (8 * c) * 33 + nn;
        u32x4 o; o.x = pk2(s[0 * 33], s[1 * 33]); o.y = pk2(s[2 * 33], s[3 * 33]); o.z = pk2(s[4 * 33], s[5 * 33]); o.w = pk2(s[6 * 33], s[7 * 33]);
        *(u32x4*)(dst + (size_t)nn * Kdst + 8 * c) = o; }
    asm volatile("s_waitcnt lgkmcnt(0)" ::: "memory");
}
__device__ __forceinline__ int zchunk_src(int ch) {
    if (ch < 32) return ch * 64;
    if (ch < 44) return 2048 + (ch - 32) * 64;
    if (ch < 76) return 2840 + (ch - 44) * 64;
    return 2816;
}
__device__ __forceinline__ int t5_bucket(int n) {
    if (n < 16) return n;
    int b = 16;
    b += (n >= 21); b += (n >= 27); b += (n >= 35); b += (n >= 46); b += (n >= 59); b += (n >= 77); b += (n >= 99); b += (n >= 128);
    b += (n >= 166); b += (n >= 216); b += (n >= 280); b += (n >= 363); b += (n >= 470); b += (n >= 609); b += (n >= 790);
    return b;
}
__device__ __forceinline__ void prologue(const Params& P, LAS unsigned char* lds) {
    const int tid = otid(), lane = tid & 63, wave = tid >> 6;
    LAS float* scr = (LAS float*)(lds + wave * 16384);
    const int gw = blockIdx.x * NWAVE + wave, NGW = gridDim.x * NWAVE;
    unsigned char* ws = WSP;
    constexpr int I13 = 176 * 16, I2 = 32 * 44, IIN = 160 * 16, IPAB = 64 * 16, IWO = 32 * 16, IC1 = 4 * 32, IC2 = 2 * 2;
    constexpr int PER_L = 2 * I13 + 2 * I2 + IIN + IPAB + IWO + 2 * IC1 + 2 * IC2;
    for (int it = gw; it < DEPTH * PER_L; it += NGW) {
        const int l = it / PER_L; int r = it % PER_L;
        if (r < 2 * I13) {
            const int f = r / I13; r %= I13; const int gi = r / 16, kb = r % 16;
            const int t = gi >> 3, bj = (gi >> 2) & 1, sub = gi & 3;
            const float* src = (f ? (bj ? INP(12) : INP(11)) : (bj ? INP(9) : INP(8))) + (size_t)l * DM * DFF;
            tr_item(src, DFF, 128 * t + 32 * sub, 32, 64 * kb, (bf16_t*)(ws + WS_W13 + (size_t)(l * 2 + f) * W13_SZ) + (size_t)(32 * gi) * DM + 64 * kb, DM, scr, lane);
            continue;
        }
        r -= 2 * I13;
        if (r < 2 * I2) {
            const int f = r / I2; r %= I2; const int gi = r / 44, kb = r % 44;
            const float* src = (f ? INP(13) : INP(10)) + (size_t)l * DFF * DM;
            tr_item(src, DM, 32 * gi, 32, 64 * kb, (bf16_t*)(ws + WS_W2 + (size_t)(l * 2 + f) * W2_SZ) + (size_t)(32 * gi) * DFF + 64 * kb, DFF, scr, lane);
            continue;
        }
        r -= 2 * I2;
        if (r < IIN) {
            const int gi = r / 16, kb = r % 16;
            const int t = gi >> 3, bj = (gi >> 2) & 1, wc = gi & 3, ch = 4 * t + wc;
            int nvalid = 32; if (ch == 76) nvalid = bj ? 0 : 24; if (ch > 76) nvalid = 0;
            const float* src = nvalid ? INP(1) + (size_t)l * DM * NIN : nullptr;
            tr_item(src, NIN, zchunk_src(ch) + 32 * bj, nvalid, 64 * kb, (bf16_t*)(ws + WS_WIN + (size_t)l * WIN_SZ) + (size_t)(32 * gi) * DM + 64 * kb, DM, scr, lane);
            continue;
        }
        r -= IIN;
        if (r < IPAB) {
            const int gi = r / 16, kb = r % 16;
            const int t = gi >> 3, bj = (gi >> 2) & 1, sub = gi & 3;
            const float* src = nullptr; int k0 = 0;
            if (bj == 0 && kb < 8) { src = INP(2) + (size_t)l * 512 * DM; k0 = 64 * kb; }
            if (bj == 1 && kb >= 8) { src = INP(3) + (size_t)l * 512 * DM; k0 = 64 * (kb - 8); }
            tr_item(src, DM, 128 * t + 32 * sub, 32, k0, (bf16_t*)(ws + WS_PAB + (size_t)l * PAB_SZ) + (size_t)(32 * gi) * DM + 64 * kb, DM, scr, lane);
            continue;
        }
        r -= IPAB;
        if (r < IWO) {
            const int gi = r / 16, kb = r % 16;
            tr_item(INP(4) + (size_t)l * DM * DM, DM, 32 * gi, 32, 64 * kb, (bf16_t*)(ws + WS_WO + (size_t)l * WO_SZ) + (size_t)(32 * gi) * DM + 64 * kb, DM, scr, lane);
            continue;
        }
        r -= IWO;
        if (r < 2 * IC1) {
            const int kv = r / IC1; r %= IC1; const int gi = r / 32, kb = r % 32;
            tr_item((kv ? INP(27) : INP(24)) + (size_t)l * 2048 * 128, 128, 32 * gi, 32, 64 * kb, (bf16_t*)(ws + WS_CW1 + (size_t)(l * 2 + kv) * CW1_SZ) + (size_t)(32 * gi) * 2048 + 64 * kb, 2048, scr, lane);
            continue;
        }
        r -= 2 * IC1;
        {
            const int kv = r / IC2; r %= IC2; const int gi = r / 2, kb = r % 2;
            tr_item((kv ? INP(28) : INP(25)) + (size_t)l * 128 * 64, 64, 32 * gi, 32, 64 * kb, (bf16_t*)(ws + WS_CW2 + (size_t)(l * 2 + kv) * CW2_SZ) + (size_t)(32 * gi) * 128 + 64 * kb, 128, scr, lane);
        }
    }
    const int gt = blockIdx.x * NTHR + tid, NGT = gridDim.x * NTHR;
    for (int i = gt; i < 12 * 1024; i += NGT) { const int h = i >> 10, d = i & 1023; ((float*)(ws + WS_BIAS))[i] = INP(29)[t5_bucket(d) * 12 + h] * LOG2E; }
    if (blockIdx.x == (gridDim.x > 1 ? 1 : 0) && wave < DEPTH) {
        const int l = wave;
        float a = INP(16)[l * 64 + lane] * INP(17)[l * 64 + lane], b = INP(18)[l * 64 + lane] * INP(19)[l * 64 + lane];
        float mq = fabsf(INP(14)[l * 64 + lane]), mk = fabsf(INP(15)[l * 64 + lane]), mnq = fabsf(INP(21)[l * 64 + lane]);
        float mnk = fmaxf(fmaxf(fabsf(INP(22)[l * 192 + lane]), fabsf(INP(22)[l * 192 + 64 + lane])), fabsf(INP(22)[l * 192 + 128 + lane]));
        float mb = 0.f; for (int i = lane; i < 32 * 12; i += 64) mb = fmaxf(mb, fabsf(INP(29)[i]));
#pragma unroll
        for (int o = 1; o < 64; o <<= 1) { a += __shfl_xor(a, o); b += __shfl_xor(b, o); mq = fmaxf(mq, __shfl_xor(mq, o)); mk = fmaxf(mk, __shfl_xor(mk, o)); mnq = fmaxf(mnq, __shfl_xor(mnq, o)); mnk = fmaxf(mnk, __shfl_xor(mnk, o)); mb = fmaxf(mb, __shfl_xor(mb, o)); }
        if (lane == 0) {
            float* prm = (float*)(ws + WS_PRM) + l * 8;
            const float lam_init = 0.8f - 0.6f * expf(-0.3f * (float)l);
            prm[0] = expf(a) - expf(b) + lam_init;
            prm[1] = (8.f * mq * mk * 1.02f + mb) * LOG2E;
            prm[2] = (8.f * mnq * mnk * 1.02f + mb) * LOG2E;
            prm[3] = 1.0f - lam_init;
        }
    }
    if (blockIdx.x == (gridDim.x > 2 ? 2 : 0)) {
        const int lk = tid >> 7, n = tid & 127, l = lk >> 1, kv = lk & 1;
        const float* pe = (kv ? INP(26) : INP(23)) + (size_t)l * 2048; const float* w1 = (kv ? INP(27) : INP(24)) + (size_t)l * 2048 * 128;
        float s = 0.f;
        for (int k = 0; k < 2048; ++k) s += pe[k] * w1[(size_t)k * 128 + n];
        ((float*)(ws + WS_CB1))[lk * 128 + n] = s;
    }
}

__device__ __forceinline__ void rmsnorm_phase(const float* x, const float* g, bf16_t* o) {
    const int tid = otid(), lane = tid & 63, wave = tid >> 6;
    const int gw = blockIdx.x * NWAVE + wave, NGW = gridDim.x * NWAVE;
    f32x4 gv[4];
#pragma unroll
    for (int j = 0; j < 4; ++j) gv[j] = *((const f32x4*)g + lane + 64 * j);
    for (int m = gw; m < MTOK; m += NGW) {
        const f32x4* xr = (const f32x4*)(x + (size_t)m * DM) + lane;
        f32x4 v[4]; float s = 0.f;
#pragma unroll
        for (int j = 0; j < 4; ++j) { v[j] = xr[64 * j]; s += (v[j].x * v[j].x + v[j].y * v[j].y) + (v[j].z * v[j].z + v[j].w * v[j].w); }
#pragma unroll
        for (int of = 1; of < 64; of <<= 1) s += __shfl_xor(s, of);
        const float rs = __builtin_amdgcn_rsqf(s * (1.f / DM) + EPS);
        u32x2* o8 = (u32x2*)(o + (size_t)m * DM) + lane;
#pragma unroll
        for (int j = 0; j < 4; ++j) { u32x2 w; w.x = pk2(v[j].x * rs * gv[j].x, v[j].y * rs * gv[j].y); w.y = pk2(v[j].z * rs * gv[j].z, v[j].w * rs * gv[j].w); o8[64 * j] = w; }
    }
}

__device__ __forceinline__ float gelu_tanh(float x) {
    const float y = 0.7978845608028654f * (x + 0.044715f * x * x * x);
    const float e = __builtin_amdgcn_exp2f(2.f * LOG2E * y);
    const float t = 1.f - 2.f * __builtin_amdgcn_rcpf(e + 1.f);
    return 0.5f * x * (1.f + t);
}
__device__ __forceinline__ void compress_phase(const Params& P, int l, LAS unsigned char* lds) {
    const int tid = otid(), lane = tid & 63, wave = tid >> 6, fr = lane & 15, kq = lane >> 4;
    unsigned char* ws = WSP;
    LAS bf16_t* Hs = (LAS bf16_t*)lds;
    LAS float* Os = (LAS float*)(lds + 8192);
    for (int unit = blockIdx.x; unit < 2 * 16 * 16; unit += gridDim.x) {
        const int kv = unit >> 8, bg = (unit >> 4) & 15, cblk = unit & 15, c0 = 16 * cblk;
        const bf16_t* src = (const bf16_t*)(ws + (kv ? Z_VCR : Z_KCR)) + (size_t)bg * SEQ * 64;
        const int crow_ = (c0 + fr) < 255 ? (c0 + fr) : 254;
        const bf16_t* ap = src + (size_t)1024 * crow_ + 8 * kq;
        const bf16_t* bp = (const bf16_t*)(ws + WS_CW1 + (size_t)(l * 2 + kv) * CW1_SZ) + (size_t)(16 * wave + fr) * 2048 + 8 * kq;
        f32x4 acc = {0.f, 0.f, 0.f, 0.f};
#pragma unroll 8
        for (int kk = 0; kk < 64; ++kk) { const bf16x8 a = *(const bf16x8*)(ap + 32 * kk), b = *(const bf16x8*)(bp + 32 * kk); acc = __builtin_amdgcn_mfma_f32_16x16x32_bf16(a, b, acc, 0, 0, 0); }
        const float cb = ((const float*)(ws + WS_CB1))[(l * 2 + kv) * 128 + 16 * wave + fr];
#pragma unroll
        for (int i = 0; i < 4; ++i) Hs[(4 * kq + i) * 136 + 16 * wave + fr] = (bf16_t)f2bf(gelu_tanh(acc[i] + cb));
        __syncthreads();
        if (wave < 4) {
            const bf16_t* b2 = (const bf16_t*)(ws + WS_CW2 + (size_t)(l * 2 + kv) * CW2_SZ) + (size_t)(16 * wave + fr) * 128 + 8 * kq;
            f32x4 a2 = {0.f, 0.f, 0.f, 0.f};
#pragma unroll
            for (int kk = 0; kk < 4; ++kk) { const bf16x8 a = *(const LAS bf16x8*)(Hs + fr * 136 + 32 * kk + 8 * kq), b = *(const bf16x8*)(b2 + 32 * kk); a2 = __builtin_amdgcn_mfma_f32_16x16x32_bf16(a, b, a2, 0, 0, 0); }
#pragma unroll
            for (int i = 0; i < 4; ++i) Os[(4 * kq + i) * 65 + 16 * wave + fr] = a2[i];
        }
        __syncthreads();
#pragma unroll
        for (int rep = 0; rep < 2; ++rep) {
            const int e = tid + NTHR * rep, row = e >> 6, d = e & 63, c = c0 + row;
            const float val = Os[row * 65 + d];
            if (kv == 0) {
                float ss = 0.f;
                for (int j = 0; j < 64; ++j) { const float t = Os[row * 65 + j]; ss += t * t; }
                const float o = val * __builtin_amdgcn_rsqf(ss * (1.f / 64.f) + EPS) * INP(22)[l * 192 + d];
                ((bf16_t*)(ws + WS_KCN))[((size_t)bg * 256 + c) * 64 + d] = (c < 255) ? (bf16_t)f2bf(o) : (bf16_t)0;
            } else {
                ((bf16_t*)(ws + WS_VCT))[((size_t)bg * 64 + d) * 256 + c] = (c < 255) ? (bf16_t)f2bf(val) : (bf16_t)0;
            }
        }
        __syncthreads();
    }
}

__device__ __forceinline__ void qk_tile(f32x16& p0, f32x16& p1, const LAS unsigned char* Kl, const bf16x8 (&qf)[4], int r32, int hi) {
    const LAS unsigned char* kb = Kl + r32 * KP + hi * 16;
#pragma unroll
    for (int d0 = 0; d0 < 4; ++d0) {
        const bf16x8 a0 = *(const LAS bf16x8*)(kb + d0 * 32), a1 = *(const LAS bf16x8*)(kb + 32 * KP + d0 * 32);
        p0 = __builtin_amdgcn_mfma_f32_32x32x16_bf16(a0, qf[d0], p0, 0, 0, 0);
        p1 = __builtin_amdgcn_mfma_f32_32x32x16_bf16(a1, qf[d0], p1, 0, 0, 0);
    }
}
template <int STRIDE, bool WINDOW>
__device__ __forceinline__ void score_exp(f32x16& p0, f32x16& p1, int dl, const LAS float* tb, float cfar, bool far, bool rowsel) {
#pragma unroll
    for (int blk = 0; blk < 2; ++blk) {
        f32x16& p = blk ? p1 : p0;
#pragma unroll
        for (int r = 0; r < 16; ++r) {
            const int dist = dl - STRIDE * ((r & 3) + 8 * (r >> 2) + 32 * blk);
            float e;
            if (far) { e = __builtin_amdgcn_exp2f(p[r] + cfar); }
            else {
                const unsigned idx = min((unsigned)dist, 1023u);
                e = __builtin_amdgcn_exp2f(p[r] + tb[idx]);
                bool valid = dist >= 0; if (WINDOW) valid = valid && (dist < 512);
                e = valid ? e : 0.f;
            }
            p[r] = rowsel ? e : 0.f;
        }
    }
}
__device__ __forceinline__ float sum32(const f32x16& p0, const f32x16& p1) {
    float a = 0.f, b = 0.f;
#pragma unroll
    for (int r = 0; r < 16; ++r) { a += p0[r]; b += p1[r]; }
    return a + b;
}
template <int NDB>
__device__ __forceinline__ void pv_tile(f32x16 (&o)[NDB], const f32x16& p0, const f32x16& p1, const LAS unsigned char* Vl, int r32, int hi) {
#pragma unroll
    for (int blk = 0; blk < 2; ++blk) {
        const f32x16& p = blk ? p1 : p0;
#pragma unroll
        for (int s = 0; s < 2; ++s) {
            u32x4 w; w.x = pg8::cvt_pk_bf16(p[8 * s + 0], p[8 * s + 1]); w.y = pg8::cvt_pk_bf16(p[8 * s + 2], p[8 * s + 3]); w.z = pg8::cvt_pk_bf16(p[8 * s + 4], p[8 * s + 5]); w.w = pg8::cvt_pk_bf16(p[8 * s + 6], p[8 * s + 7]);
            const bf16x8 pa = __builtin_bit_cast(bf16x8, w);
            const int kk = 32 * blk + 16 * s + 4 * hi;
#pragma unroll
            for (int db = 0; db < NDB; ++db) {
                const LAS unsigned char* vp = Vl + (r32 + 32 * db) * VP + kk * 2;
                const bf16x4 lo = *(const LAS bf16x4*)vp, hi4 = *(const LAS bf16x4*)(vp + 16);
                const bf16x8 vb = {lo[0], lo[1], lo[2], lo[3], hi4[0], hi4[1], hi4[2], hi4[3]};
                o[db] = __builtin_amdgcn_mfma_f32_32x32x16_bf16(pa, vb, o[db], 0, 0, 0);
            }
        }
    }
}
__device__ __forceinline__ u32x4 ldk(const bf16_t* g, int tid) { return *(const u32x4*)((const unsigned char*)g + tid * 16); }
__device__ __forceinline__ void stk(LAS unsigned char* Kl, u32x4 v, int tid) { *(LAS u32x4*)(Kl + (tid >> 3) * KP + (tid & 7) * 16) = v; }
__device__ __forceinline__ u32x4 ldv(const bf16_t* g, size_t rs, int row, int tid) { return *(const u32x4*)((const unsigned char*)(g + (size_t)row * rs) + (tid & 7) * 16); }
__device__ __forceinline__ void stv(LAS unsigned char* Vl, u32x4 v, int row, int tid) { LAS unsigned char* p = Vl + row * VP + (tid & 7) * 16; *(LAS u32x2*)p = (u32x2){v.x, v.y}; *(LAS u32x2*)(p + 8) = (u32x2){v.z, v.w}; }

__device__ __forceinline__ void da_unit(const Params& P, int l, int b, int h, int qb, LAS unsigned char* lds) {
    const int tid = otid(), lane = tid & 63, wave = __builtin_amdgcn_readfirstlane(tid >> 6), r32 = lane & 31, hi = lane >> 5;
    const int c = wave >> 2, qsub = wave & 3, q0 = qb * 128, qw0 = q0 + 32 * qsub;
    unsigned char* ws = WSP;
    const float* prm = (const float*)(ws + WS_PRM) + l * 8;
    const float lam = prm[0], Mb = prm[1], onem = prm[3];
    LAS float* biasL = (LAS float*)(lds + L_BIAS);
    const float* bg = (const float*)(ws + WS_BIAS) + h * 1024;
    for (int i = tid; i < 1024; i += NTHR) biasL[i] = bg[i] - Mb;
    const float cfar = bg[1023] - Mb;
    const bf16_t* Qp = (const bf16_t*)(ws + Z_DQ) + ((size_t)(b * 8 + h * 2 + c) * SEQ + qw0 + r32) * 64 + hi * 8;
    bf16x8 qf[4];
#pragma unroll
    for (int d0 = 0; d0 < 4; ++d0) qf[d0] = *(const bf16x8*)(Qp + d0 * 16);
    const bf16_t* K1g = (const bf16_t*)(ws + Z_DK) + (size_t)(b * 8 + h * 2) * SEQ * 64;
    const bf16_t* K2g = K1g + (size_t)SEQ * 64;
    const bf16_t* Vg = (const bf16_t*)(ws + Z_DVT) + (size_t)(b * 4 + h) * 128 * SEQ;
    const int NT = (q0 + 128) / 64;
    f32x16 o[4];
#pragma unroll
    for (int i = 0; i < 4; ++i) o[i] = (f32x16){};
    float lsum = 0.f;
    u32x4 rk1, rk2, rv0, rv1;
#define DA_LOAD(t) do { rk1 = ldk(K1g + (size_t)(t) * 4096, tid); rk2 = ldk(K2g + (size_t)(t) * 4096, tid); rv0 = ldv(Vg + (t) * 64, SEQ, tid >> 3, tid); rv1 = ldv(Vg + (t) * 64, SEQ, 64 + (tid >> 3), tid); } while (0)
#define DA_STORE(sb) do { LAS unsigned char* st_ = lds + (sb) * DA_STAGE; stk(st_, rk1, tid); stk(st_ + 64 * KP, rk2, tid); stv(st_ + 128 * KP, rv0, tid >> 3, tid); stv(st_ + 128 * KP, rv1, 64 + (tid >> 3), tid); } while (0)
    DA_LOAD(0); DA_STORE(0);
    __syncthreads();
    for (int t = 0; t < NT; ++t) {
        if (t + 1 < NT) DA_LOAD(t + 1);
        if (64 * t <= qw0 + 31) {
            const LAS unsigned char* st = lds + (t & 1) * DA_STAGE;
            f32x16 p0 = (f32x16){}, p1 = (f32x16){};
            qk_tile(p0, p1, st + c * 64 * KP, qf, r32, hi);
            const int dl = qw0 + r32 - 64 * t - 4 * hi;
            const bool far = (qw0 - (64 * t + 63)) >= 790;
            score_exp<1, false>(p0, p1, dl, biasL, cfar, far, true);
            lsum += sum32(p0, p1);
            pv_tile<4>(o, p0, p1, st + 128 * KP, r32, hi);
        }
        if (t + 1 < NT) DA_STORE((t + 1) & 1);
        __syncthreads();
    }
#undef DA_LOAD
#undef DA_STORE
    lsum += __shfl_xor(lsum, 32);
    LAS float* wsf = (LAS float*)(lds + L_WSF) + wave * 64;
    if (hi == 0) wsf[r32] = (lsum > 0.f) ? 1.0f / lsum : 0.f;
    asm volatile("s_waitcnt lgkmcnt(0)" ::: "memory");
    float li[16];
#pragma unroll
    for (int r = 0; r < 16; ++r) li[r] = wsf[crow(r, hi)];
    LAS float* X = (LAS float*)lds;
    if (c == 1) {
#pragma unroll
        for (int db = 0; db < 4; ++db)
#pragma unroll
            for (int r = 0; r < 16; ++r) X[(32 * qsub + crow(r, hi)) * 132 + r32 + 32 * db] = o[db][r] * li[r];
    }
    __syncthreads();
    if (c == 0) {
        const float* sg = INP(20) + l * 128;
        float gsub[4];
#pragma unroll
        for (int db = 0; db < 4; ++db) gsub[db] = sg[r32 + 32 * db] * onem;
#pragma unroll
        for (int r = 0; r < 16; ++r) {
            float y[4], ss = 0.f;
#pragma unroll
            for (int db = 0; db < 4; ++db) { y[db] = o[db][r] * li[r] - lam * X[(32 * qsub + crow(r, hi)) * 132 + r32 + 32 * db]; ss += y[db] * y[db]; }
            ss += __shfl_xor(ss, 1); ss += __shfl_xor(ss, 2); ss += __shfl_xor(ss, 4); ss += __shfl_xor(ss, 8); ss += __shfl_xor(ss, 16);
            const float rs = __builtin_amdgcn_rsqf(ss * (1.f / 128.f) + EPS);
            bf16_t* d = (bf16_t*)(ws + WS_XN) + (size_t)(b * SEQ + qw0 + crow(r, hi)) * DM + h * 128 + r32;
#pragma unroll
            for (int db = 0; db < 4; ++db) d[32 * db] = (bf16_t)f2bf(y[db] * rs * gsub[db]);
        }
    }
    __syncthreads();
}

__device__ __forceinline__ void nsa_unit(const Params& P, int l, int b, int g, int u, LAS unsigned char* lds) {
    const int tid = otid(), lane = tid & 63, wave = __builtin_amdgcn_readfirstlane(tid >> 6), r32 = lane & 31, hi = lane >> 5;
    const int qi = r32 >> 2, p = r32 & 3, qw0 = 64 * u + 8 * wave, qpos = qw0 + qi, head = g * 4 + p;
    unsigned char* ws = WSP;
    const float Mb = ((const float*)(ws + WS_PRM))[l * 8 + 2];
    LAS float* biasL = (LAS float*)(lds + L_BIAS);
    LAS float* imp = (LAS float*)(lds + L_IMP);
    LAS unsigned* selw = (LAS unsigned*)(lds + L_SEL);
    LAS float* wsf = (LAS float*)(lds + L_WSF) + wave * 64;
    const float* bgl = (const float*)(ws + WS_BIAS) + (size_t)(4 + g * 4) * 1024;
    for (int i = tid; i < 4096; i += NTHR) biasL[i] = bgl[i] - Mb;
    if (tid == 0) { unsigned z = 0u; asm volatile("" : "+v"(z)); selw[128] = z; selw[129] = z; }
    const LAS float* tb = biasL + p * 1024;
    const float cfar = bgl[p * 1024 + 1023] - Mb;
    const bf16_t* Qp = (const bf16_t*)(ws + Z_NQ) + ((size_t)(b * 8 + head) * SEQ + qpos) * 64 + hi * 8;
    bf16x8 qf[4];
#pragma unroll
    for (int d0 = 0; d0 < 4; ++d0) qf[d0] = *(const bf16x8*)(Qp + d0 * 16);
    const float* ngp = (const float*)(ws + Z_NG) + (size_t)(b * SEQ + qpos) * 24 + head * 3;
    const float gate_c = ngp[0], gate_s = ngp[1], gate_w = ngp[2];
    f32x16 oc[2]; oc[0] = (f32x16){}; oc[1] = (f32x16){};
    f32x16 o[2];
    u32x4 rk, rv;
    const int bgi = b * 2 + g;
#define NS_STORE(sb) do { LAS unsigned char* st_ = lds + (sb) * NS_STAGE; stk(st_, rk, tid); stv(st_ + 64 * KP, rv, tid >> 3, tid); } while (0)
#define NS_FOLD(gate) do { lsum += __shfl_xor(lsum, 32); if (hi == 0) wsf[r32] = (lsum > 0.f) ? (gate) / lsum : 0.f; asm volatile("s_waitcnt lgkmcnt(0)" ::: "memory"); \
        _Pragma("unroll") for (int r = 0; r < 16; ++r) { const float f_ = wsf[crow(r, hi)]; oc[0][r] += f_ * o[0][r]; oc[1][r] += f_ * o[1][r]; } asm volatile("s_waitcnt lgkmcnt(0)" ::: "memory"); } while (0)
    {
        const bf16_t* Kg = (const bf16_t*)(ws + WS_KCN) + (size_t)bgi * 256 * 64;
        const bf16_t* Vg = (const bf16_t*)(ws + WS_VCT) + (size_t)bgi * 64 * 256;
        const int ntc = (4 * u + 2) / 64 + 1;
        o[0] = (f32x16){}; o[1] = (f32x16){};
        float lsum = 0.f, carry = 0.f;
        float E[4][8];
#pragma unroll
        for (int tc = 0; tc < 4; ++tc)
#pragma unroll
            for (int i = 0; i < 8; ++i) E[tc][i] = 0.f;
        rk = ldk(Kg, tid); rv = ldv(Vg, 256, tid >> 3, tid); NS_STORE(0);
        __syncthreads();
#pragma unroll
        for (int tc = 0; tc < 4; ++tc) {
            if (tc < ntc) {
                if (tc + 1 < ntc) { rk = ldk(Kg + (size_t)(tc + 1) * 4096, tid); rv = ldv(Vg + (tc + 1) * 64, 256, tid >> 3, tid); }
                const LAS unsigned char* st = lds + (tc & 1) * NS_STAGE;
                f32x16 p0 = (f32x16){}, p1 = (f32x16){};
                qk_tile(p0, p1, st, qf, r32, hi);
                const int dl = qpos - 31 - 16 * (64 * tc + 4 * hi);
                const bool far = (qw0 - 31 - 16 * (64 * tc + 63)) >= 790;
                score_exp<16, false>(p0, p1, dl, tb, cfar, far, true);
                lsum += sum32(p0, p1);
                float Qs[2][4], PL[2][4];
#pragma unroll
                for (int blk = 0; blk < 2; ++blk)
#pragma unroll
                    for (int m = 0; m < 4; ++m) { const f32x16& pp = blk ? p1 : p0; Qs[blk][m] = (pp[4 * m] + pp[4 * m + 1]) + (pp[4 * m + 2] + pp[4 * m + 3]); PL[blk][m] = __shfl_xor(pp[4 * m + 3], 32); }
#pragma unroll
                for (int blk = 0; blk < 2; ++blk)
#pragma unroll
                    for (int m = 0; m < 4; ++m) { const float prev = (m > 0) ? PL[blk][m - 1] : (blk ? PL[0][3] : carry); E[tc][blk * 4 + m] = Qs[blk][m] + (hi ? PL[blk][m] : prev); }
                carry = PL[1][3];
                pv_tile<2>(o, p0, p1, st + 64 * KP, r32, hi);
                if (tc + 1 < ntc) NS_STORE((tc + 1) & 1);
                __syncthreads();
            }
        }
        float lt = lsum + __shfl_xor(lsum, 32);
        const float linv = (lt > 0.f) ? 1.0f / lt : 0.f;
#pragma unroll
        for (int tc = 0; tc < 4; ++tc)
#pragma unroll
            for (int i = 0; i < 8; ++i) {
                float e = E[tc][i] * linv; e += __shfl_xor(e, 1); e += __shfl_xor(e, 2);
                if (p == 0) imp[(8 * wave + qi) * 64 + 16 * tc + 8 * (i >> 2) + 2 * (i & 3) + hi] = e;
            }
        NS_FOLD(gate_c);
    }
    __syncthreads();
    if (tid < 64) {
        unsigned long long m;
        if (u < 8) m = (2ull << u) - 1ull;
        else {
            m = 1ull | (1ull << u) | (1ull << (u - 1));
            const LAS float* iq = imp + tid * 64;
            for (int k = 0; k < 5; ++k) {
                int best = 1; float bv = -1.f;
                for (int j = 1; j <= u - 2; ++j) { const float v = iq[j]; if (!((m >> j) & 1ull) && v > bv) { bv = v; best = j; } }
                m |= 1ull << best;
            }
        }
        selw[2 * tid] = (unsigned)m; selw[2 * tid + 1] = (unsigned)(m >> 32);
        atomicOr((unsigned*)&selw[128], (unsigned)m); atomicOr((unsigned*)&selw[129], (unsigned)(m >> 32));
    }
    __syncthreads();
    {
        const unsigned long long un = (unsigned long long)selw[128] | ((unsigned long long)selw[129] << 32);
        const unsigned long long mine = (unsigned long long)selw[2 * (8 * wave + qi)] | ((unsigned long long)selw[2 * (8 * wave + qi) + 1] << 32);
        const bf16_t* Kg = (const bf16_t*)(ws + Z_KSEL) + (size_t)bgi * SEQ * 64;
        const bf16_t* Vg = (const bf16_t*)(ws + Z_VSELT) + (size_t)bgi * 64 * SEQ;
        o[0] = (f32x16){}; o[1] = (f32x16){};
        float lsum = 0.f;
        unsigned long long rem = un;
        int j = __builtin_ctzll(rem); rem &= rem - 1;
        rk = ldk(Kg + (size_t)j * 4096, tid); rv = ldv(Vg + j * 64, SEQ, tid >> 3, tid); NS_STORE(0);
        __syncthreads();
        int it = 0;
        for (;;) {
            const bool more = rem != 0ull; int jn = 0;
            if (more) { jn = __builtin_ctzll(rem); rem &= rem - 1; rk = ldk(Kg + (size_t)jn * 4096, tid); rv = ldv(Vg + jn * 64, SEQ, tid >> 3, tid); }
            const bool rowsel = (mine >> j) & 1ull;
            if (__any(rowsel)) {
                const LAS unsigned char* st = lds + (it & 1) * NS_STAGE;
                f32x16 p0 = (f32x16){}, p1 = (f32x16){};
                qk_tile(p0, p1, st, qf, r32, hi);
                const int dl = qpos - 64 * j - 4 * hi;
                const bool far = (qw0 - (64 * j + 63)) >= 790;
                score_exp<1, false>(p0, p1, dl, tb, cfar, far, rowsel);
                lsum += sum32(p0, p1);
                pv_tile<2>(o, p0, p1, st + 64 * KP, r32, hi);
            }
            if (more) NS_STORE((it + 1) & 1);
            __syncthreads();
            if (!more) break;
            j = jn; ++it;
        }
        NS_FOLD(gate_s);
    }
    {
        const bf16_t* Kg = (const bf16_t*)(ws + Z_KWIN) + (size_t)bgi * SEQ * 64;
        const bf16_t* Vg = (const bf16_t*)(ws + Z_VWINT) + (size_t)bgi * 64 * SEQ;
        o[0] = (f32x16){}; o[1] = (f32x16){};
        float lsum = 0.f;
        const int t0 = (u >= 8) ? u - 8 : 0, nt = u - t0 + 1;
        rk = ldk(Kg + (size_t)t0 * 4096, tid); rv = ldv(Vg + t0 * 64, SEQ, tid >> 3, tid); NS_STORE(0);
        __syncthreads();
        for (int it = 0; it < nt; ++it) {
            const int t = t0 + it;
            if (it + 1 < nt) { rk = ldk(Kg + (size_t)(t + 1) * 4096, tid); rv = ldv(Vg + (t + 1) * 64, SEQ, tid >> 3, tid); }
            {
                const LAS unsigned char* st = lds + (it & 1) * NS_STAGE;
                f32x16 p0 = (f32x16){}, p1 = (f32x16){};
                qk_tile(p0, p1, st, qf, r32, hi);
                const int dl = qpos - 64 * t - 4 * hi;
                score_exp<1, true>(p0, p1, dl, tb, cfar, false, true);
                lsum += sum32(p0, p1);
                pv_tile<2>(o, p0, p1, st + 64 * KP, r32, hi);
            }
            if (it + 1 < nt) NS_STORE((it + 1) & 1);
            __syncthreads();
        }
        NS_FOLD(gate_w);
    }
#undef NS_STORE
#undef NS_FOLD
#pragma unroll
    for (int r = 0; r < 16; ++r) {
        const int row = crow(r, hi), q = qw0 + (row >> 2), pp = row & 3;
        bf16_t* d = (bf16_t*)(ws + WS_XN) + (size_t)(b * SEQ + q) * DM + 512 + (g * 4 + pp) * 64 + r32;
        d[0] = (bf16_t)f2bf(oc[0][r]); d[32] = (bf16_t)f2bf(oc[1][r]);
    }
    __syncthreads();
}

__device__ __forceinline__ void attention_phase(const Params& P, int l, LAS unsigned char* lds) {
    for (int it = blockIdx.x; it < 2048; it += gridDim.x) {
        if (it < 1024) { const int qb = 31 - (it >> 5), bh = it & 31;
#if defined(SKIP_DA)
            { const int b = bh >> 2, h = bh & 3; bf16_t* y = (bf16_t*)(WSP + WS_XN); for (int e = threadIdx.x; e < 128 * 128; e += NTHR) y[(size_t)(b * SEQ + qb * 128 + (e >> 7)) * DM + h * 128 + (e & 127)] = (bf16_t)0; }
#else
            da_unit(P, l, bh >> 2, bh & 3, qb, lds);
#endif
        }
        else { const int k = it - 1024, u = 63 - (k >> 4), bg = k & 15;
#if defined(SKIP_NSA)
            { const int b = bg >> 1, g = bg & 1; bf16_t* y = (bf16_t*)(WSP + WS_XN); for (int e = threadIdx.x; e < 64 * 256; e += NTHR) y[(size_t)(b * SEQ + u * 64 + (e >> 8)) * DM + 512 + g * 256 + (e & 255)] = (bf16_t)0; }
#else
            nsa_unit(P, l, bg >> 1, bg & 1, u, lds);
#endif
        }
    }
}


constexpr size_t WS_BAR = 72 * 1024;
__device__ __forceinline__ void gbar(unsigned* bar, LAS unsigned* cnt) {
    asm volatile("s_waitcnt vmcnt(0) lgkmcnt(0)" ::: "memory");
    __syncthreads();
    if (threadIdx.x == 0) {
        __builtin_amdgcn_fence(__ATOMIC_RELEASE, "agent");
        asm volatile("s_waitcnt vmcnt(0)" ::: "memory");
        const unsigned target = cnt[0] + gridDim.x; cnt[0] = target;
        __hip_atomic_fetch_add(bar, 1u, __ATOMIC_RELAXED, __HIP_MEMORY_SCOPE_AGENT);
        unsigned spins = 0;
        while (__hip_atomic_load(bar, __ATOMIC_RELAXED, __HIP_MEMORY_SCOPE_AGENT) < target) { __builtin_amdgcn_s_sleep(2); if (++spins > (1u << 26)) break; }
    }
    __syncthreads();
    __builtin_amdgcn_fence(__ATOMIC_ACQUIRE, "agent");
    asm volatile("s_waitcnt vmcnt(0) lgkmcnt(0)" ::: "memory");
}
__global__ void __launch_bounds__(NTHR, 2) hybrid_fwd(Params P) {
    extern __shared__ __attribute__((aligned(16))) unsigned char lds_raw[];
    LAS unsigned char* lds = (LAS unsigned char*)lds_raw;
    cg::grid_group grid = cg::this_grid();
#define GSYNC() gbar((unsigned*)(WSP + WS_BAR), (LAS unsigned*)(lds + L_PTAB + 384))
    if (threadIdx.x == 0) {
        LAS unsigned long long* pt = (LAS unsigned long long*)(lds + L_PTAB);
#pragma unroll
        for (int i = 0; i < 30; ++i) pt[i] = (unsigned long long)P.in[i];
        pt[30] = (unsigned long long)P.out; pt[31] = (unsigned long long)P.ws;
        *(LAS unsigned*)(lds + L_PTAB + 384) = 0u;
    }
    __syncthreads();
    const int G = gridDim.x, bx = blockIdx.x;
#define ws WSP
#define XN ((bf16_t*)(WSP + WS_XN))
#define HID ((bf16_t*)(WSP + WS_HID))
#define MERGED ((bf16_t*)(WSP + WS_MERGED))

    grid.sync();
    prologue(P, lds);
    GSYNC();
#pragma unroll
    for (int l = 0; l < DEPTH; ++l) {
        const float* xin = (l == 0) ? INP(0) : OUTP;
        rmsnorm_phase(xin, INP(5) + l * DM, XN);
        GSYNC();
        { pg8::Gemm g{XN, (const bf16_t*)(ws + WS_W13 + (size_t)(l * 2 + 0) * W13_SZ), MTOK, 5632, DM}; pg8::StaticOrder S; S.init(MTOK, 5632, G, bx);
          EpiSwiGLU E{HID}; pg8::gemm_phase<EpiSwiGLU, pg8::StaticOrder, true, true>(lds, g, S, E); }
        GSYNC();
        { pg8::Gemm g{HID, (const bf16_t*)(ws + WS_W2 + (size_t)(l * 2 + 0) * W2_SZ), MTOK, DM, DFF}; pg8::StaticOrder S; S.init(MTOK, DM, G, bx);
          EpiResid E{xin, OUTP, 0.5f}; pg8::gemm_phase<EpiResid, pg8::StaticOrder, true, true>(lds, g, S, E); }
        GSYNC();
#if defined(STOP_AFTER) && STOP_AFTER == 1
        return;
#endif
        rmsnorm_phase(OUTP, INP(6) + l * DM, XN);
        GSYNC();
        { pg8::Gemm g{XN, (const bf16_t*)(ws + WS_WIN + (size_t)l * WIN_SZ), MTOK, 5120, DM}; pg8::StaticOrder S; S.init(MTOK, 5120, G, bx);
          EpiZ E{ws, INP(14) + l * 64, INP(15) + l * 64, INP(21) + l * 64, INP(22) + l * 192}; pg8::gemm_phase<EpiZ, pg8::StaticOrder, true, true>(lds, g, S, E); }
        GSYNC();
#if defined(DUMP_Z)
        { const unsigned short* z = (const unsigned short*)(WSP + WS_Z); float* o = OUTP;
          for (size_t i = (size_t)blockIdx.x * NTHR + threadIdx.x; i < (size_t)MTOK * DM; i += (size_t)gridDim.x * NTHR) {
              unsigned v = (unsigned)z[i * 4 + (i & 3)] << 16; if ((v & 0x7f800000u) == 0x7f800000u) v = 0u; o[i] = __builtin_bit_cast(float, v); }
          return; }
#endif
        compress_phase(P, l, lds);
        GSYNC();
        attention_phase(P, l, lds);
        GSYNC();
        { pg8::Gemm g{XN, (const bf16_t*)(ws + WS_PAB + (size_t)l * PAB_SZ), MTOK, 2048, DM}; pg8::StaticOrder S; S.init(MTOK, 2048, G, bx);
          EpiMerge E{(const bf16_t*)(ws + Z_MG), MERGED}; pg8::gemm_phase<EpiMerge, pg8::StaticOrder, true, true>(lds, g, S, E); }
        GSYNC();
        { pg8::Gemm g{MERGED, (const bf16_t*)(ws + WS_WO + (size_t)l * WO_SZ), MTOK, DM, DM}; pg8::StaticOrder S; S.init(MTOK, DM, G, bx);
          EpiResid E{OUTP, OUTP, 1.0f}; pg8::gemm_phase<EpiResid, pg8::StaticOrder, true, true>(lds, g, S, E); }
        GSYNC();
#if defined(STOP_AFTER) && STOP_AFTER == 2
        return;
#endif
        rmsnorm_phase(OUTP, INP(7) + l * DM, XN);
        GSYNC();
        { pg8::Gemm g{XN, (const bf16_t*)(ws + WS_W13 + (size_t)(l * 2 + 1) * W13_SZ), MTOK, 5632, DM}; pg8::StaticOrder S; S.init(MTOK, 5632, G, bx);
          EpiSwiGLU E{HID}; pg8::gemm_phase<EpiSwiGLU, pg8::StaticOrder, true, true>(lds, g, S, E); }
        GSYNC();
        { pg8::Gemm g{HID, (const bf16_t*)(ws + WS_W2 + (size_t)(l * 2 + 1) * W2_SZ), MTOK, DM, DFF}; pg8::StaticOrder S; S.init(MTOK, DM, G, bx);
          EpiResid E{OUTP, OUTP, 0.5f}; pg8::gemm_phase<EpiResid, pg8::StaticOrder, true, true>(lds, g, S, E); }
        if (l + 1 < DEPTH) GSYNC();
    }
#undef ws
#undef XN
#undef HID
#undef MERGED
}

extern "C" void kernel_launch(void* const* d_in, const int* in_sizes, int n_in, void* d_out, int out_size, void* d_ws, size_t ws_size, hipStream_t stream) {
    static int grid = 0;
    if (grid == 0) {
        if (n_in != 30 || out_size != MTOK * DM || ws_size < WS_END) { fprintf(stderr, "kernel_launch: unexpected problem (n_in %d out %d ws %zu, need %zu)\n", n_in, out_size, ws_size, (size_t)WS_END); grid = -1; return; }
        int dev = 0, cus = 0, per_cu = 0;
        (void)hipGetDevice(&dev);
        (void)hipDeviceGetAttribute(&cus, hipDeviceAttributeMultiprocessorCount, dev);
        if (hipFuncSetAttribute((const void*)hybrid_fwd, hipFuncAttributeMaxDynamicSharedMemorySize, LDS_BYTES) != hipSuccess) { fprintf(stderr, "kernel_launch: hipFuncSetAttribute failed\n"); grid = -1; return; }
        if (hipOccupancyMaxActiveBlocksPerMultiprocessor(&per_cu, (const void*)hybrid_fwd, NTHR, LDS_BYTES) != hipSuccess || per_cu < 1) { fprintf(stderr, "kernel_launch: occupancy query gave %d\n", per_cu); per_cu = 1; }
        (void)hipGetLastError();
        grid = cus * (per_cu > 1 ? 1 : per_cu);
        if (grid <= 0) grid = 256;
    }
    if (grid < 0) return;
    Params p{};
    for (int i = 0; i < 30; ++i) p.in[i] = (const float*)d_in[i];
    p.out = (float*)d_out; p.ws = (unsigned char*)d_ws;
    (void)hipMemsetAsync((unsigned char*)d_ws + WS_BAR, 0, 256, stream);
    void* args[] = {&p};
    hipError_t e = hipLaunchCooperativeKernel((const void*)hybrid_fwd, dim3(grid), dim3(NTHR), args, LDS_BYTES, stream);
    if (e != hipSuccess) fprintf(stderr, "cooperative launch failed: %s (grid %d)\n", hipGetErrorString(e), grid);
}
```

```cpp
#include <hip/hip_runtime.h>
#include <hip/hip_cooperative_groups.h>
#include <cstdio>
#include <cstdint>
namespace cg = cooperative_groups;
namespace pg8 {
#define PG8_LAS __attribute__((address_space(3)))
typedef unsigned short bf16_t;
typedef short bf16x8 __attribute__((ext_vector_type(8)));
typedef float f32x4 __attribute__((ext_vector_type(4)));
typedef unsigned u32x4 __attribute__((ext_vector_type(4)));
constexpr int BM = 256, BK = 64, HALF = 128, HTB = HALF * BK * 2  , STAGE_BYTES = 8 * HTB, NXCD = 8, WGM = 8;

__host__ __device__ __forceinline__ int lds_byte(int r, int c) { const int st = (r >> 4) * 2 + (c >> 5), rr = r & 15, cc = c & 31, ob = rr * 64 + cc * 2; return st * 1024 + (ob ^ (((ob >> 9) & 1) << 5)); }
__host__ __device__ __forceinline__ void stage_rc(int b, int& R, int& C) { const int st = b / 1024, sb = b % 1024, swz = sb ^ (((sb >> 9) & 1) << 5); R = (st >> 1) * 16 + swz / 64; C = (st & 1) * 32 + (swz % 64) / 2; }
__host__ __device__ __forceinline__ int perm32(int rho) { const int n = rho >> 4, i = rho & 15; return 8 * (i >> 2) + 4 * n + (i & 3); }

struct Unit { int pm, pn; };
struct Gemm { const bf16_t* A; const bf16_t* Bt; int M, N, K; };

struct StaticOrder {
    int nM, nN, nwg, G, c;
    __host__ __device__ void init(int M, int N, int G_, int c_) { nM = M / BM; nN = N / BM; nwg = nM * nN; G = G_; c = c_; }
    __host__ __device__ bool next(int i, Unit& u) const {
        const long L = (long)i * G + c; if (L >= nwg) return false;
        int wgid = (int)L; { const int q = nwg / NXCD, r = nwg % NXCD, xcd = wgid % NXCD, off = wgid / NXCD; wgid = (xcd < r ? xcd * (q + 1) : r * (q + 1) + (xcd - r) * q) + off; }
        const int nig = WGM * nN, gid = wgid / nig, fm = gid * WGM, gsz = (nM - fm) < WGM ? (nM - fm) : WGM;
        u.pm = fm + ((wgid % nig) % gsz); u.pn = (wgid % nig) / gsz; return true;
    }
    __device__ __forceinline__ void a_ready(const Unit&) const {}
    __device__ __forceinline__ void done(const Unit&) const {}
};

typedef float f32x2_t __attribute__((ext_vector_type(2))); typedef __bf16 bf16x2_t __attribute__((ext_vector_type(2)));
__device__ __forceinline__ unsigned cvt_pk_bf16(float lo, float hi) { f32x2_t v = {lo, hi}; bf16x2_t b = __builtin_convertvector(v, bf16x2_t); return __builtin_bit_cast(unsigned, b); }
template <class Epi, class Sched, bool ALIGN_EPI = false, bool SP2 = false>
__device__ __forceinline__ void gemm_phase(PG8_LAS unsigned char* lds, const Gemm g, const Sched& S, const Epi& E) {
    int tid_ = threadIdx.x; asm volatile("" : "+v"(tid_)); const int tid = tid_, wid = __builtin_amdgcn_readfirstlane(tid >> 6), lane = tid & 63, wr = wid >> 2, wc = wid & 3, fr = lane & 15, fq = lane >> 4;
    const int K = g.K, nt = K / BK;
    unsigned voffA[2], voffB[2];
#pragma unroll
    for (int i = 0; i < 2; ++i) { int R, C; stage_rc(tid * 16 + i * 8192, R, C); const int Rb = Epi::PERM ? ((R & ~31) + perm32(R & 31)) : R;
        voffA[i] = (unsigned)(R * K + C) * 2u; voffB[i] = (unsigned)(Rb * K + C) * 2u; }
    const size_t kstep = (size_t)(BK * 2);
    const size_t hstep = (size_t)HALF * K * 2;
    const size_t tstep = 2 * hstep;
    const unsigned ldsw = (unsigned)wid * 1024u;
    const int aoff = lds_byte(wr * 64 + fr, fq * 8), boff = lds_byte(wc * 32 + fr, fq * 8);
#define PG8_SA(b, h) (((b) * 2 + (h)) * HTB)
#define PG8_SB(b, h) ((4 + (b) * 2 + (h)) * HTB)
#define PG8_STAGE(bufoff, gbase, voff) do { _Pragma("unroll") for (int _i = 0; _i < 2; ++_i) \
        __builtin_amdgcn_global_load_lds((const unsigned*)((const char*)(gbase) + (voff)[_i]), (PG8_LAS unsigned*)(lds + (bufoff) + ldsw + _i * 8192), 16, 0, 0); } while (0)
#define PG8_LDA(dst, b, h) do { _Pragma("unroll") for (int m = 0; m < 4; ++m) _Pragma("unroll") for (int k = 0; k < 2; ++k) dst[m][k] = *(const PG8_LAS bf16x8*)(lds + PG8_SA(b, h) + aoff + m * 2048 + k * 1024); } while (0)
#define PG8_LDB(dst, b, h) do { _Pragma("unroll") for (int n = 0; n < 2; ++n) _Pragma("unroll") for (int k = 0; k < 2; ++k) dst[n][k] = *(const PG8_LAS bf16x8*)(lds + PG8_SB(b, h) + boff + n * 2048 + k * 1024); } while (0)
#define PG8_MMA(ai, bj, At, Bt) do { __builtin_amdgcn_s_setprio(1); _Pragma("unroll") for (int m = 0; m < 4; ++m) _Pragma("unroll") for (int n = 0; n < 2; ++n) _Pragma("unroll") for (int k = 0; k < 2; ++k) \
        acc[ai][bj][m][n] = __builtin_amdgcn_mfma_f32_16x16x32_bf16(Bt[n][k], At[m][k], acc[ai][bj][m][n], 0, 0, 0); __builtin_amdgcn_s_setprio(0); } while (0)
#define PG8_WAIT_V(n) asm volatile("s_waitcnt vmcnt(" #n ")" ::: "memory")
#define PG8_WAIT_L(n) asm volatile("s_waitcnt lgkmcnt(" #n ")" ::: "memory")
#define PG8_BAR __builtin_amdgcn_s_barrier()
#define PG8_SCHED __builtin_amdgcn_sched_barrier(0)
    Unit cur, nxt; int ui = 0;
    if (!S.next(0, cur)) return;
    f32x4 acc[2][2][4][2];
#pragma unroll
    for (int a = 0; a < 2; ++a)
#pragma unroll
        for (int b = 0; b < 2; ++b)
#pragma unroll
            for (int m = 0; m < 4; ++m)
#pragma unroll
                for (int n = 0; n < 2; ++n) acc[a][b][m][n] = (f32x4){0.f, 0.f, 0.f, 0.f};
    bf16x8 At[4][2], B0[2][2], B1[2][2];
    const char* cA = (const char*)g.A + (size_t)cur.pm * tstep; const char* cB = (const char*)g.Bt + (size_t)cur.pn * tstep;
    S.a_ready(cur);
    if constexpr (SP2) {
        PG8_STAGE(PG8_SB(0, 0), cB, voffB); PG8_STAGE(PG8_SB(0, 1), cB + hstep, voffB); PG8_STAGE(PG8_SA(0, 0), cA, voffA); PG8_STAGE(PG8_SA(0, 1), cA + hstep, voffA);
        if (wr == 1) PG8_BAR;
        PG8_WAIT_V(2); PG8_BAR;
        PG8_STAGE(PG8_SB(1, 0), cB + kstep, voffB); PG8_STAGE(PG8_SA(1, 0), cA + kstep, voffA); PG8_STAGE(PG8_SB(1, 1), cB + hstep + kstep, voffB);
        PG8_WAIT_V(6); PG8_BAR;
    } else {
        PG8_STAGE(PG8_SB(0, 0), cB, voffB); PG8_STAGE(PG8_SA(0, 0), cA, voffA); PG8_STAGE(PG8_SB(0, 1), cB + hstep, voffB); PG8_STAGE(PG8_SA(0, 1), cA + hstep, voffA);
        if (wr == 1) PG8_BAR;
        PG8_WAIT_V(4); PG8_BAR;
        PG8_STAGE(PG8_SB(1, 0), cB + kstep, voffB); PG8_STAGE(PG8_SA(1, 0), cA + kstep, voffA); PG8_STAGE(PG8_SB(1, 1), cB + hstep + kstep, voffB);
        PG8_WAIT_V(6); PG8_BAR;
    }
    for (;;) {
        const bool has_next = S.next(ui + 1, nxt);
        const char* nA = has_next ? (const char*)g.A + (size_t)nxt.pm * tstep : cA; const char* nB = has_next ? (const char*)g.Bt + (size_t)nxt.pn * tstep : cB;
        for (int t = 0; t < nt; t += 2) {
            const bool last = (t == nt - 2);
            const char* a1 = cA + (size_t)(t + 1) * kstep;
            const char* a2 = last ? nA : cA + (size_t)(t + 2) * kstep; const char* b2 = last ? nB : cB + (size_t)(t + 2) * kstep;
            const char* a3 = a2 + kstep; const char* b3 = b2 + kstep;
            if (last && has_next) S.a_ready(nxt);
            if constexpr (SP2) {
            PG8_LDB(B0, 0, 0); PG8_LDB(B1, 0, 1); PG8_SCHED; PG8_LDA(At, 0, 0); PG8_STAGE(PG8_SA(1, 1), a1 + hstep, voffA);
            PG8_WAIT_V(8); PG8_WAIT_L(0); PG8_BAR; PG8_MMA(0, 0, At, B0); PG8_MMA(0, 1, At, B1); PG8_BAR; PG8_SCHED;
            PG8_LDA(At, 0, 1); PG8_STAGE(PG8_SB(0, 0), b2, voffB); PG8_STAGE(PG8_SB(0, 1), b2 + hstep, voffB); PG8_STAGE(PG8_SA(0, 0), a2, voffA);
            PG8_WAIT_V(8); PG8_WAIT_L(0); PG8_BAR; PG8_MMA(1, 0, At, B0); PG8_MMA(1, 1, At, B1); PG8_BAR; PG8_SCHED;
            PG8_LDB(B0, 1, 0); PG8_LDB(B1, 1, 1); PG8_SCHED; PG8_LDA(At, 1, 0); PG8_STAGE(PG8_SA(0, 1), a2 + hstep, voffA);
            PG8_WAIT_V(8); PG8_WAIT_L(0); PG8_BAR; PG8_MMA(0, 0, At, B0); PG8_MMA(0, 1, At, B1); PG8_BAR; PG8_SCHED;
            PG8_LDA(At, 1, 1); PG8_STAGE(PG8_SB(1, 0), b3, voffB); PG8_STAGE(PG8_SB(1, 1), b3 + hstep, voffB); PG8_STAGE(PG8_SA(1, 0), a3, voffA);
            PG8_WAIT_V(8); PG8_WAIT_L(0); PG8_BAR; PG8_MMA(1, 0, At, B0); PG8_MMA(1, 1, At, B1); PG8_BAR; PG8_SCHED;
            } else {
            PG8_LDB(B0, 0, 0); PG8_SCHED; PG8_LDA(At, 0, 0); PG8_STAGE(PG8_SA(1, 1), a1 + hstep, voffA);
            PG8_WAIT_L(8); PG8_BAR; PG8_WAIT_L(0); PG8_MMA(0, 0, At, B0); PG8_BAR; PG8_SCHED;
            PG8_LDB(B1, 0, 1); PG8_STAGE(PG8_SB(0, 0), b2, voffB);
            PG8_BAR; PG8_WAIT_L(0); PG8_MMA(0, 1, At, B1); PG8_BAR;
            PG8_LDA(At, 0, 1); PG8_STAGE(PG8_SA(0, 0), a2, voffA);
            PG8_BAR; PG8_WAIT_L(0); PG8_MMA(1, 0, At, B0); PG8_BAR; PG8_SCHED;
            PG8_STAGE(PG8_SB(0, 1), b2 + hstep, voffB);
            PG8_WAIT_V(6); PG8_BAR; PG8_MMA(1, 1, At, B1); PG8_BAR;
            PG8_LDB(B0, 1, 0); PG8_SCHED; PG8_LDA(At, 1, 0); PG8_STAGE(PG8_SA(0, 1), a2 + hstep, voffA);
            PG8_WAIT_L(8); PG8_BAR; PG8_WAIT_L(0); PG8_MMA(0, 0, At, B0); PG8_BAR; PG8_SCHED;
            PG8_LDB(B1, 1, 1); PG8_STAGE(PG8_SB(1, 0), b3, voffB);
            PG8_BAR; PG8_WAIT_L(0); PG8_MMA(0, 1, At, B1); PG8_BAR;
            PG8_LDA(At, 1, 1); PG8_STAGE(PG8_SA(1, 0), a3, voffA);
            PG8_BAR; PG8_WAIT_L(0); PG8_MMA(1, 0, At, B0); PG8_BAR; PG8_SCHED;
            PG8_STAGE(PG8_SB(1, 1), b3 + hstep, voffB);
            PG8_WAIT_V(6); PG8_BAR; PG8_MMA(1, 1, At, B1); PG8_BAR;
            }
        }
        if constexpr (ALIGN_EPI) { if (wr == 0) PG8_BAR; }
        if constexpr (!Epi::AFTER_DRAIN) { E(acc, cur, wr, wc, fr, fq); S.done(cur); }
        if (!has_next) break;
#pragma unroll
        for (int a = 0; a < 2; ++a)
#pragma unroll
            for (int b = 0; b < 2; ++b)
#pragma unroll
                for (int m = 0; m < 4; ++m)
#pragma unroll
                    for (int n = 0; n < 2; ++n) acc[a][b][m][n] = (f32x4){0.f, 0.f, 0.f, 0.f};
        cur = nxt; cA = nA; cB = nB; ++ui;
        if constexpr (ALIGN_EPI) { if (wr == 1) PG8_BAR; }
    }
    PG8_WAIT_V(0);
    if constexpr (!ALIGN_EPI) { if (wr == 0) PG8_BAR; }
    PG8_BAR;
    if constexpr (Epi::AFTER_DRAIN) { E.fused(acc, cur, wr, wc, fr, fq, lds, wid, lane); S.done(cur); }
#undef PG8_SA
#undef PG8_SB
#undef PG8_STAGE
#undef PG8_LDA
#undef PG8_LDB
#undef PG8_MMA
#undef PG8_WAIT_V
#undef PG8_WAIT_L
#undef PG8_BAR
#undef PG8_SCHED
}
}

#define LAS __attribute__((address_space(3)))
#define GAS __attribute__((address_space(1)))
#define GLD(T, p) (*(const GAS T*)(p))
#define GST(T, p, v) (*(GAS T*)(p) = (v))
typedef unsigned short bf16_t;
typedef short bf16x8 __attribute__((ext_vector_type(8)));
typedef short bf16x4 __attribute__((ext_vector_type(4)));
typedef float f32x4 __attribute__((ext_vector_type(4)));
typedef float f32x16 __attribute__((ext_vector_type(16)));
typedef unsigned u32x4 __attribute__((ext_vector_type(4)));
typedef unsigned u32x2 __attribute__((ext_vector_type(2)));

constexpr int BATCH = 8, SEQ = 4096, DM = 1024, MTOK = BATCH * SEQ, DFF = 2816, DEPTH = 2, NIN = 4888;
constexpr int NTHR = 512, NWAVE = 8;
constexpr float EPS = 1e-6f, LOG2E = 1.4426950408889634f;
constexpr float QSCALE = 0.125f * LOG2E;
constexpr size_t MiB = 1u << 20;
constexpr size_t WS_BIAS = 0;
constexpr size_t WS_PRM = 64 * 1024;
constexpr size_t WS_CB1 = 68 * 1024;
constexpr size_t WS_W13 = 1 * MiB;
constexpr size_t W13_SZ = (size_t)5632 * 1024 * 2;
constexpr size_t WS_W2 = 45 * MiB;
constexpr size_t W2_SZ = (size_t)1024 * 2816 * 2;
constexpr size_t WS_WIN = 68 * MiB;
constexpr size_t WIN_SZ = (size_t)5120 * 1024 * 2;
constexpr size_t WS_PAB = 88 * MiB;
constexpr size_t PAB_SZ = (size_t)2048 * 1024 * 2;
constexpr size_t WS_WO = 96 * MiB;
constexpr size_t WO_SZ = (size_t)1024 * 1024 * 2;
constexpr size_t WS_CW1 = 100 * MiB;
constexpr size_t CW1_SZ = (size_t)128 * 2048 * 2;
constexpr size_t WS_CW2 = 102 * MiB;
constexpr size_t CW2_SZ = (size_t)64 * 128 * 2;
constexpr size_t WS_KCN = 103 * MiB;
constexpr size_t WS_VCT = WS_KCN + 512 * 1024;
constexpr size_t WS_XN = 104 * MiB;
constexpr size_t WS_Z = 168 * MiB;
constexpr size_t Z_DQ = WS_Z, Z_DK = WS_Z + 32 * MiB, Z_DVT = WS_Z + 64 * MiB, Z_NQ = WS_Z + 96 * MiB;
constexpr size_t Z_KCR = WS_Z + 128 * MiB, Z_VCR = WS_Z + 136 * MiB, Z_KSEL = WS_Z + 144 * MiB, Z_VSELT = WS_Z + 152 * MiB;
constexpr size_t Z_KWIN = WS_Z + 160 * MiB, Z_VWINT = WS_Z + 168 * MiB, Z_NG = WS_Z + 176 * MiB, Z_MG = WS_Z + 180 * MiB;
constexpr size_t WS_MERGED = WS_Z;
constexpr size_t WS_HID = WS_Z;
constexpr size_t WS_END = WS_Z + 308 * MiB;
constexpr int LDS_BYTES = 147456;
constexpr int KP = 144, VP = 136;
constexpr int DA_STAGE = 2 * 64 * KP + 128 * VP;
constexpr int NS_STAGE = 64 * KP + 64 * VP;
constexpr int L_BIAS = 73728;
constexpr int TBN = 1216;
constexpr int L_IMP = L_BIAS + 4 * TBN * 4;
constexpr int L_SEL = L_IMP + 16384;
constexpr int L_WSF = L_SEL + 1024;
constexpr int L_END = L_WSF + 8 * 256;

struct Params {
    const float* in[30];
    float* out;
    unsigned char* ws;
};

constexpr int L_PTAB = LDS_BYTES - 1024;
__device__ __forceinline__ const float* ld_ptr(const LAS unsigned char* lds, int i) {
    unsigned a = L_PTAB + 8 * i; asm volatile("" : "+v"(a));
    const LAS unsigned* t = (const LAS unsigned*)(lds + a);
    const unsigned lo = __builtin_amdgcn_readfirstlane(t[0]), hi = __builtin_amdgcn_readfirstlane(t[1]);
    return (const float*)(((unsigned long long)hi << 32) | lo);
}
#define INP(i) ld_ptr(lds, (i))
#define OUTP ((float*)ld_ptr(lds, 30))
#define WSP ((unsigned char*)ld_ptr(lds, 31))

__device__ __forceinline__ unsigned f2bf(float f) { unsigned u = __builtin_bit_cast(unsigned, f); return (u + 0x7fffu + ((u >> 16) & 1u)) >> 16; }
__device__ __forceinline__ unsigned pk2(float lo, float hi) { return f2bf(lo) | (f2bf(hi) << 16); }
__device__ __forceinline__ float sigmoidf_(float x) { return __builtin_amdgcn_rcpf(1.0f + __builtin_amdgcn_exp2f(-x * LOG2E)); }
__device__ __forceinline__ int otid() { int t = threadIdx.x; asm volatile("" : "+v"(t)); return t; }
__device__ __forceinline__ int crow(int r, int hi) { return (r & 3) + 8 * (r >> 2) + 4 * hi; }

struct EpiSwiGLU {
    static constexpr bool PERM = true, AFTER_DRAIN = false;
    bf16_t* H;
    __device__ __forceinline__ void operator()(const f32x4 (&acc)[2][2][4][2], const pg8::Unit& u, int wr, int wc, int fr, int fq) const {
        const int row0 = u.pm * 256 + wr * 64 + fr, col = u.pn * 128 + wc * 32 + 8 * fq;
#pragma unroll
        for (int ai = 0; ai < 2; ++ai)
#pragma unroll
            for (int m = 0; m < 4; ++m) {
                float h[8];
#pragma unroll
                for (int n = 0; n < 2; ++n)
#pragma unroll
                    for (int e = 0; e < 4; ++e) { const float g = acc[ai][0][m][n][e], up = acc[ai][1][m][n][e]; h[n * 4 + e] = g * sigmoidf_(g) * up; }
                u32x4 w; w.x = pg8::cvt_pk_bf16(h[0], h[1]); w.y = pg8::cvt_pk_bf16(h[2], h[3]); w.z = pg8::cvt_pk_bf16(h[4], h[5]); w.w = pg8::cvt_pk_bf16(h[6], h[7]);
                GST(u32x4, H + (size_t)(row0 + ai * 128 + m * 16) * DFF + col, w);
            }
    }
};
struct EpiResid {
    static constexpr bool PERM = false, AFTER_DRAIN = false;
    const float* base; float* out; float alpha;
    __device__ __forceinline__ void operator()(const f32x4 (&acc)[2][2][4][2], const pg8::Unit& u, int wr, int wc, int fr, int fq) const {
        const int row0 = u.pm * 256 + wr * 64 + fr, col0 = u.pn * 256 + wc * 32 + 4 * fq;
#pragma unroll
        for (int ai = 0; ai < 2; ++ai)
#pragma unroll
            for (int m = 0; m < 4; ++m) {
                const size_t off = (size_t)(row0 + ai * 128 + m * 16) * DM + col0;
#pragma unroll
                for (int bj = 0; bj < 2; ++bj)
#pragma unroll
                    for (int n = 0; n < 2; ++n) { const f32x4 b = GLD(f32x4, base + off + bj * 128 + n * 16); GST(f32x4, out + off + bj * 128 + n * 16, b + acc[ai][bj][m][n] * alpha); }
            }
    }
};
struct EpiMerge {
    static constexpr bool PERM = true, AFTER_DRAIN = false;
    const bf16_t* MG; bf16_t* O;
    __device__ __forceinline__ void operator()(const f32x4 (&acc)[2][2][4][2], const pg8::Unit& u, int wr, int wc, int fr, int fq) const {
        const int row0 = u.pm * 256 + wr * 64 + fr, col = u.pn * 128 + wc * 32 + 8 * fq;
#pragma unroll
        for (int ai = 0; ai < 2; ++ai)
#pragma unroll
            for (int m = 0; m < 4; ++m) {
                const int row = row0 + ai * 128 + m * 16;
                const u32x4 s0 = GLD(u32x4, MG + (size_t)row * 2048 + col), s1 = GLD(u32x4, MG + (size_t)row * 2048 + 1024 + col);
                float h[8];
#pragma unroll
                for (int i = 0; i < 8; ++i) {
                    const unsigned w0 = s0[i >> 1], w1 = s1[i >> 1];
                    const float g0 = __builtin_bit_cast(float, (i & 1) ? (w0 & 0xffff0000u) : (w0 << 16)), g1 = __builtin_bit_cast(float, (i & 1) ? (w1 & 0xffff0000u) : (w1 << 16));
                    h[i] = g0 * acc[ai][0][m][i >> 2][i & 3] + g1 * acc[ai][1][m][i >> 2][i & 3];
                }
                u32x4 w; w.x = pg8::cvt_pk_bf16(h[0], h[1]); w.y = pg8::cvt_pk_bf16(h[2], h[3]); w.z = pg8::cvt_pk_bf16(h[4], h[5]); w.w = pg8::cvt_pk_bf16(h[6], h[7]);
                GST(u32x4, O + (size_t)row * DM + col, w);
            }
    }
};
struct EpiZ {
    static constexpr bool PERM = true, AFTER_DRAIN = false;
    unsigned char* ws; const float *gq, *gk, *gnq, *gnk;
    __device__ __forceinline__ void operator()(const f32x4 (&acc)[2][2][4][2], const pg8::Unit& u, int wr, int wc, int fr, int fq) const {
        const int ch = 4 * u.pn + wc;
        if (ch >= 77) return;
        const int row0 = u.pm * 256 + wr * 64 + fr;
        int kind, nh = 8, hd = 0, nd = 64, dbase = 0; size_t dst = 0; const float* gain = nullptr; float scale = 1.f;
        if (ch < 8) { kind = 0; dst = Z_DQ; hd = ch; gain = gq; scale = QSCALE; }
        else if (ch < 16) { kind = 0; dst = Z_DK; hd = ch - 8; gain = gk; }
        else if (ch < 24) { kind = 2; dst = Z_DVT; nh = 4; hd = (ch - 16) >> 1; nd = 128; dbase = ((ch - 16) & 1) * 64; }
        else if (ch < 32) { kind = 0; dst = Z_NQ; hd = ch - 24; gain = gnq; scale = QSCALE; }
        else if (ch < 34) { kind = 1; dst = Z_KCR; nh = 2; hd = ch - 32; }
        else if (ch < 36) { kind = 1; dst = Z_VCR; nh = 2; hd = ch - 34; }
        else if (ch < 38) { kind = 0; dst = Z_KSEL; nh = 2; hd = ch - 36; gain = gnk + 64; }
        else if (ch < 40) { kind = 2; dst = Z_VSELT; nh = 2; hd = ch - 38; }
        else if (ch < 42) { kind = 0; dst = Z_KWIN; nh = 2; hd = ch - 40; gain = gnk + 128; }
        else if (ch < 44) { kind = 2; dst = Z_VWINT; nh = 2; hd = ch - 42; }
        else if (ch < 76) { kind = 3; }
        else { kind = 4; }
        if (kind == 0 || kind == 1) {
            float gv[16];
#pragma unroll
            for (int i = 0; i < 16; ++i) gv[i] = (kind == 0) ? gain[(i >> 3) * 32 + 8 * fq + (i & 7)] * scale : 1.f;
#pragma unroll
            for (int ai = 0; ai < 2; ++ai)
#pragma unroll
                for (int m = 0; m < 4; ++m) {
                    const int row = row0 + ai * 128 + m * 16, b = row >> 12, s = row & 4095;
                    float v[16];
#pragma unroll
                    for (int i = 0; i < 16; ++i) v[i] = acc[ai][i >> 3][m][(i >> 2) & 1][i & 3];
                    float rs = 1.f;
                    if (kind == 0) {
                        float ss = 0.f;
#pragma unroll
                        for (int i = 0; i < 16; ++i) ss += v[i] * v[i];
                        ss += __shfl_xor(ss, 16); ss += __shfl_xor(ss, 32);
                        rs = __builtin_amdgcn_rsqf(ss * (1.f / 64.f) + EPS);
                    }
#pragma unroll
                    for (int i = 0; i < 16; ++i) v[i] *= rs * gv[i];
                    bf16_t* d = (bf16_t*)(ws + dst) + ((size_t)(b * nh + hd) * SEQ + s) * 64 + 8 * fq;
                    u32x4 w0, w1;
                    w0.x = pg8::cvt_pk_bf16(v[0], v[1]); w0.y = pg8::cvt_pk_bf16(v[2], v[3]); w0.z = pg8::cvt_pk_bf16(v[4], v[5]); w0.w = pg8::cvt_pk_bf16(v[6], v[7]);
                    w1.x = pg8::cvt_pk_bf16(v[8], v[9]); w1.y = pg8::cvt_pk_bf16(v[10], v[11]); w1.z = pg8::cvt_pk_bf16(v[12], v[13]); w1.w = pg8::cvt_pk_bf16(v[14], v[15]);
                    GST(u32x4, d, w0); GST(u32x4, d + 32, w1);
                }
        } else if (kind == 2) {
#pragma unroll
            for (int ai = 0; ai < 2; ++ai)
#pragma unroll
                for (int m = 0; m < 4; ++m) {
                    const int row = row0 + ai * 128 + m * 16, b = row >> 12, s = row & 4095;
                    bf16_t* d = (bf16_t*)(ws + dst) + ((size_t)(b * nh + hd) * nd + dbase + 8 * fq) * SEQ + s;
#pragma unroll
                    for (int i = 0; i < 16; ++i) GST(bf16_t, d + (size_t)((i >> 3) * 32 + (i & 7)) * SEQ, (bf16_t)f2bf(acc[ai][i >> 3][m][(i >> 2) & 1][i & 3]));
                }
        } else if (kind == 3) {
            const int col = (ch - 44) * 64 + 8 * fq;
#pragma unroll
            for (int ai = 0; ai < 2; ++ai)
#pragma unroll
                for (int m = 0; m < 4; ++m) {
                    const int row = row0 + ai * 128 + m * 16;
                    float v[16];
#pragma unroll
                    for (int i = 0; i < 16; ++i) v[i] = sigmoidf_(acc[ai][i >> 3][m][(i >> 2) & 1][i & 3]);
                    bf16_t* d = (bf16_t*)(ws + Z_MG) + (size_t)row * 2048 + col;
                    u32x4 w0, w1;
                    w0.x = pg8::cvt_pk_bf16(v[0], v[1]); w0.y = pg8::cvt_pk_bf16(v[2], v[3]); w0.z = pg8::cvt_pk_bf16(v[4], v[5]); w0.w = pg8::cvt_pk_bf16(v[6], v[7]);
                    w1.x = pg8::cvt_pk_bf16(v[8], v[9]); w1.y = pg8::cvt_pk_bf16(v[10], v[11]); w1.z = pg8::cvt_pk_bf16(v[12], v[13]); w1.w = pg8::cvt_pk_bf16(v[14], v[15]);
                    GST(u32x4, d, w0); GST(u32x4, d + 32, w1);
                }
        } else {
            if (fq < 3) {
#pragma unroll
                for (int ai = 0; ai < 2; ++ai)
#pragma unroll
                    for (int m = 0; m < 4; ++m) {
                        const int row = row0 + ai * 128 + m * 16;
                        float* d = (float*)(ws + Z_NG) + (size_t)row * 24 + 8 * fq;
#pragma unroll
                        for (int i = 0; i < 8; ++i) GST(float, d + i, sigmoidf_(acc[ai][0][m][i >> 2][i & 3]));
                    }
            }
        }
    }
};

__device__ __forceinline__ void tr_item(const float* src, int ld, int c0, int nvalid, int k0, bf16_t* dst, int Kdst, LAS float* scr, int lane) {
    const int n = lane & 31;
#pragma unroll
    for (int i = 0; i < 32; ++i) { const int kk = 2 * i + (lane >> 5); scr[kk * 33 + n] = (src && n < nvalid) ? GLD(float, src + (size_t)(k0 + kk) * ld + c0 + n) : 0.f; }
    asm volatile("s_waitcnt lgkmcnt(0)" ::: "memory");
    const int c = lane & 7;
#pragma unroll
    for (int j = 0; j < 4; ++j) { const int nn = (lane >> 3) + 8 * j; const LAS float* s = scr + (8 * c) * 33 + nn;
        u32x4 o; o.x = pk2(s[0 * 33], s[1 * 33]); o.y = pk2(s[2 * 33], s[3 * 33]); o.z = pk2(s[4 * 33], s[5 * 33]); o.w = pk2(s[6 * 33], s[7 * 33]);
        GST(u32x4, dst + (size_t)nn * Kdst + 8 * c, o); }
    asm volatile("s_waitcnt lgkmcnt(0)" ::: "memory");
}
__device__ __forceinline__ int zchunk_src(int ch) {
    if (ch < 32) return ch * 64;
    if (ch < 44) return 2048 + (ch - 32) * 64;
    if (ch < 76) return 2840 + (ch - 44) * 64;
    return 2816;
}
__device__ __forceinline__ int t5_bucket(int n) {
    if (n < 16) return n;
    int b = 16;
    b += (n >= 21); b += (n >= 27); b += (n >= 35); b += (n >= 46); b += (n >= 59); b += (n >= 77); b += (n >= 99); b += (n >= 128);
    b += (n >= 166); b += (n >= 216); b += (n >= 280); b += (n >= 363); b += (n >= 470); b += (n >= 609); b += (n >= 790);
    return b;
}
__device__ __forceinline__ void prologue(const Params& P, LAS unsigned char* lds) {
    const int tid = otid(), lane = tid & 63, wave = tid >> 6;
    LAS float* scr = (LAS float*)(lds + wave * 16384);
    const int gw = blockIdx.x * NWAVE + wave, NGW = gridDim.x * NWAVE;
    unsigned char* ws = WSP;
    constexpr int I13 = 176 * 16, I2 = 32 * 44, IIN = 160 * 16, IPAB = 64 * 16, IWO = 32 * 16, IC1 = 4 * 32, IC2 = 2 * 2;
    constexpr int PER_L = 2 * I13 + 2 * I2 + IIN + IPAB + IWO + 2 * IC1 + 2 * IC2;
    for (int it = gw; it < DEPTH * PER_L; it += NGW) {
        const int l = it / PER_L; int r = it % PER_L;
        if (r < 2 * I13) {
            const int f = r / I13; r %= I13; const int gi = r / 16, kb = r % 16;
            const int t = gi >> 3, bj = (gi >> 2) & 1, sub = gi & 3;
            const float* src = (f ? (bj ? INP(12) : INP(11)) : (bj ? INP(9) : INP(8))) + (size_t)l * DM * DFF;
            tr_item(src, DFF, 128 * t + 32 * sub, 32, 64 * kb, (bf16_t*)(ws + WS_W13 + (size_t)(l * 2 + f) * W13_SZ) + (size_t)(32 * gi) * DM + 64 * kb, DM, scr, lane);
            continue;
        }
        r -= 2 * I13;
        if (r < 2 * I2) {
            const int f = r / I2; r %= I2; const int gi = r / 44, kb = r % 44;
            const float* src = (f ? INP(13) : INP(10)) + (size_t)l * DFF * DM;
            tr_item(src, DM, 32 * gi, 32, 64 * kb, (bf16_t*)(ws + WS_W2 + (size_t)(l * 2 + f) * W2_SZ) + (size_t)(32 * gi) * DFF + 64 * kb, DFF, scr, lane);
            continue;
        }
        r -= 2 * I2;
        if (r < IIN) {
            const int gi = r / 16, kb = r % 16;
            const int t = gi >> 3, bj = (gi >> 2) & 1, wc = gi & 3, ch = 4 * t + wc;
            int nvalid = 32; if (ch == 76) nvalid = bj ? 0 : 24; if (ch > 76) nvalid = 0;
            const float* src = nvalid ? INP(1) + (size_t)l * DM * NIN : nullptr;
            tr_item(src, NIN, zchunk_src(ch) + 32 * bj, nvalid, 64 * kb, (bf16_t*)(ws + WS_WIN + (size_t)l * WIN_SZ) + (size_t)(32 * gi) * DM + 64 * kb, DM, scr, lane);
            continue;
        }
        r -= IIN;
        if (r < IPAB) {
            const int gi = r / 16, kb = r % 16;
            const int t = gi >> 3, bj = (gi >> 2) & 1, sub = gi & 3;
            const float* src = nullptr; int k0 = 0;
            if (bj == 0 && kb < 8) { src = INP(2) + (size_t)l * 512 * DM; k0 = 64 * kb; }
            if (bj == 1 && kb >= 8) { src = INP(3) + (size_t)l * 512 * DM; k0 = 64 * (kb - 8); }
            tr_item(src, DM, 128 * t + 32 * sub, 32, k0, (bf16_t*)(ws + WS_PAB + (size_t)l * PAB_SZ) + (size_t)(32 * gi) * DM + 64 * kb, DM, scr, lane);
            continue;
        }
        r -= IPAB;
        if (r < IWO) {
            const int gi = r / 16, kb = r % 16;
            tr_item(INP(4) + (size_t)l * DM * DM, DM, 32 * gi, 32, 64 * kb, (bf16_t*)(ws + WS_WO + (size_t)l * WO_SZ) + (size_t)(32 * gi) * DM + 64 * kb, DM, scr, lane);
            continue;
        }
        r -= IWO;
        if (r < 2 * IC1) {
            const int kv = r / IC1; r %= IC1; const int gi = r / 32, kb = r % 32;
            tr_item((kv ? INP(27) : INP(24)) + (size_t)l * 2048 * 128, 128, 32 * gi, 32, 64 * kb, (bf16_t*)(ws + WS_CW1 + (size_t)(l * 2 + kv) * CW1_SZ) + (size_t)(32 * gi) * 2048 + 64 * kb, 2048, scr, lane);
            continue;
        }
        r -= 2 * IC1;
        {
            const int kv = r / IC2; r %= IC2; const int gi = r / 2, kb = r % 2;
            tr_item((kv ? INP(28) : INP(25)) + (size_t)l * 128 * 64, 64, 32 * gi, 32, 64 * kb, (bf16_t*)(ws + WS_CW2 + (size_t)(l * 2 + kv) * CW2_SZ) + (size_t)(32 * gi) * 128 + 64 * kb, 128, scr, lane);
        }
    }
    const int gt = blockIdx.x * NTHR + tid, NGT = gridDim.x * NTHR;
    for (int i = gt; i < 12 * 1024; i += NGT) { const int h = i >> 10, d = i & 1023; ((float*)(ws + WS_BIAS))[i] = INP(29)[t5_bucket(d) * 12 + h] * LOG2E; }
    if (blockIdx.x == (gridDim.x > 1 ? 1 : 0) && wave < DEPTH) {
        const int l = wave;
        float a = INP(16)[l * 64 + lane] * INP(17)[l * 64 + lane], b = INP(18)[l * 64 + lane] * INP(19)[l * 64 + lane];
        float mq = fabsf(INP(14)[l * 64 + lane]), mk = fabsf(INP(15)[l * 64 + lane]), mnq = fabsf(INP(21)[l * 64 + lane]);
        float mnk = fmaxf(fmaxf(fabsf(INP(22)[l * 192 + lane]), fabsf(INP(22)[l * 192 + 64 + lane])), fabsf(INP(22)[l * 192 + 128 + lane]));
        float mb = 0.f; for (int i = lane; i < 32 * 12; i += 64) mb = fmaxf(mb, fabsf(INP(29)[i]));
#pragma unroll
        for (int o = 1; o < 64; o <<= 1) { a += __shfl_xor(a, o); b += __shfl_xor(b, o); mq = fmaxf(mq, __shfl_xor(mq, o)); mk = fmaxf(mk, __shfl_xor(mk, o)); mnq = fmaxf(mnq, __shfl_xor(mnq, o)); mnk = fmaxf(mnk, __shfl_xor(mnk, o)); mb = fmaxf(mb, __shfl_xor(mb, o)); }
        if (lane == 0) {
            float* prm = (float*)(ws + WS_PRM) + l * 8;
            const float lam_init = 0.8f - 0.6f * expf(-0.3f * (float)l);
            prm[0] = expf(a) - expf(b) + lam_init;
            prm[1] = (8.f * mq * mk * 1.02f + mb) * LOG2E;
            prm[2] = (8.f * mnq * mnk * 1.02f + mb) * LOG2E;
            prm[3] = 1.0f - lam_init;
        }
    }
    for (int wi = blockIdx.x; wi < 32; wi += gridDim.x) {
        const int lk = wi >> 3, n = (wi & 7) * 16 + (tid & 15), ks = tid >> 4, l = lk >> 1, kv = lk & 1;
        const float* pe = (kv ? INP(26) : INP(23)) + (size_t)l * 2048; const float* w1 = (kv ? INP(27) : INP(24)) + (size_t)l * 2048 * 128;
        float sacc = 0.f;
#pragma unroll 16
        for (int k = 64 * ks; k < 64 * ks + 64; ++k) sacc += GLD(float, pe + k) * GLD(float, w1 + (size_t)k * 128 + n);
        LAS float* red = (LAS float*)lds;
        __syncthreads();
        red[tid] = sacc;
        __syncthreads();
        if (tid < 16) { float t = 0.f; for (int i = 0; i < 32; ++i) t += red[i * 16 + tid]; ((float*)(ws + WS_CB1))[lk * 128 + (wi & 7) * 16 + tid] = t; }
        __syncthreads();
    }
}

__device__ __forceinline__ void rmsnorm_phase(const float* x, const float* g, bf16_t* o) {
    const int tid = otid(), lane = tid & 63, wave = tid >> 6;
    const int gw = blockIdx.x * NWAVE + wave, NGW = gridDim.x * NWAVE;
    f32x4 gv[4];
#pragma unroll
    for (int j = 0; j < 4; ++j) gv[j] = GLD(f32x4, (const f32x4*)g + lane + 64 * j);
    constexpr int RB = 4;
    for (int m0 = gw; m0 < MTOK; m0 += NGW * RB) {
        f32x4 v[RB][4]; float s[RB];
#pragma unroll
        for (int r = 0; r < RB; ++r) { const int m = m0 + r * NGW; const f32x4* xr = (const f32x4*)(x + (size_t)(m < MTOK ? m : m0) * DM) + lane;
#pragma unroll
            for (int j = 0; j < 4; ++j) v[r][j] = GLD(f32x4, xr + 64 * j); }
#pragma unroll
        for (int r = 0; r < RB; ++r) { s[r] = 0.f;
#pragma unroll
            for (int j = 0; j < 4; ++j) s[r] += (v[r][j].x * v[r][j].x + v[r][j].y * v[r][j].y) + (v[r][j].z * v[r][j].z + v[r][j].w * v[r][j].w); }
#pragma unroll
        for (int of = 1; of < 64; of <<= 1) {
#pragma unroll
            for (int r = 0; r < RB; ++r) s[r] += __shfl_xor(s[r], of); }
#pragma unroll
        for (int r = 0; r < RB; ++r) { const int m = m0 + r * NGW;
            if (m < MTOK) {
                const float rs = __builtin_amdgcn_rsqf(s[r] * (1.f / DM) + EPS);
                u32x2* o8 = (u32x2*)(o + (size_t)m * DM) + lane;
#pragma unroll
                for (int j = 0; j < 4; ++j) { u32x2 w; w.x = pk2(v[r][j].x * rs * gv[j].x, v[r][j].y * rs * gv[j].y); w.y = pk2(v[r][j].z * rs * gv[j].z, v[r][j].w * rs * gv[j].w); GST(u32x2, o8 + 64 * j, w); }
            }
        }
    }
}

__device__ __forceinline__ float gelu_tanh(float x) {
    const float y = 0.7978845608028654f * (x + 0.044715f * x * x * x);
    const float e = __builtin_amdgcn_exp2f(2.f * LOG2E * y);
    const float t = 1.f - 2.f * __builtin_amdgcn_rcpf(e + 1.f);
    return 0.5f * x * (1.f + t);
}
__device__ __forceinline__ void compress_phase(const Params& P, int l, LAS unsigned char* lds) {
    const int tid = otid(), lane = tid & 63, wave = tid >> 6, fr = lane & 15, kq = lane >> 4;
    unsigned char* ws = WSP;
    LAS bf16_t* Hs = (LAS bf16_t*)lds;
    LAS float* Os = (LAS float*)(lds + 8192);
    for (int unit = blockIdx.x; unit < 2 * 16 * 16; unit += gridDim.x) {
        const int kv = unit >> 8, bg = (unit >> 4) & 15, cblk = unit & 15, c0 = 16 * cblk;
        const bf16_t* src = (const bf16_t*)(ws + (kv ? Z_VCR : Z_KCR)) + (size_t)bg * SEQ * 64;
        const int crow_ = (c0 + fr) < 255 ? (c0 + fr) : 254;
        const bf16_t* ap = src + (size_t)1024 * crow_ + 8 * kq;
        const bf16_t* bp = (const bf16_t*)(ws + WS_CW1 + (size_t)(l * 2 + kv) * CW1_SZ) + (size_t)(16 * wave + fr) * 2048 + 8 * kq;
        f32x4 acc = {0.f, 0.f, 0.f, 0.f};
#pragma unroll 8
        for (int kk = 0; kk < 64; ++kk) { const bf16x8 a = GLD(bf16x8, ap + 32 * kk), b = GLD(bf16x8, bp + 32 * kk); acc = __builtin_amdgcn_mfma_f32_16x16x32_bf16(a, b, acc, 0, 0, 0); }
        const float cb = ((const float*)(ws + WS_CB1))[(l * 2 + kv) * 128 + 16 * wave + fr];
#pragma unroll
        for (int i = 0; i < 4; ++i) Hs[(4 * kq + i) * 136 + 16 * wave + fr] = (bf16_t)f2bf(gelu_tanh(acc[i] + cb));
        __syncthreads();
        if (wave < 4) {
            const bf16_t* b2 = (const bf16_t*)(ws + WS_CW2 + (size_t)(l * 2 + kv) * CW2_SZ) + (size_t)(16 * wave + fr) * 128 + 8 * kq;
            f32x4 a2 = {0.f, 0.f, 0.f, 0.f};
#pragma unroll
            for (int kk = 0; kk < 4; ++kk) { const bf16x8 a = *(const LAS bf16x8*)(Hs + fr * 136 + 32 * kk + 8 * kq), b = *(const bf16x8*)(b2 + 32 * kk); a2 = __builtin_amdgcn_mfma_f32_16x16x32_bf16(a, b, a2, 0, 0, 0); }
#pragma unroll
            for (int i = 0; i < 4; ++i) Os[(4 * kq + i) * 65 + 16 * wave + fr] = a2[i];
        }
        __syncthreads();
#pragma unroll
        for (int rep = 0; rep < 2; ++rep) {
            const int e = tid + NTHR * rep, row = e >> 6, d = e & 63, c = c0 + row;
            const float val = Os[row * 65 + d];
            if (kv == 0) {
                float ss = 0.f;
                for (int j = 0; j < 64; ++j) { const float t = Os[row * 65 + j]; ss += t * t; }
                const float o = val * __builtin_amdgcn_rsqf(ss * (1.f / 64.f) + EPS) * INP(22)[l * 192 + d];
                ((bf16_t*)(ws + WS_KCN))[((size_t)bg * 256 + c) * 64 + d] = (c < 255) ? (bf16_t)f2bf(o) : (bf16_t)0;
            } else {
                ((bf16_t*)(ws + WS_VCT))[((size_t)bg * 64 + d) * 256 + c] = (c < 255) ? (bf16_t)f2bf(val) : (bf16_t)0;
            }
        }
        __syncthreads();
    }
}

__device__ __forceinline__ void qk_tile(f32x16& p0, f32x16& p1, const LAS unsigned char* Kl, const bf16x8 (&qf)[4], int r32, int hi) {
    const LAS unsigned char* kb = Kl + r32 * KP + hi * 16;
    bf16x8 a[8];
#pragma unroll
    for (int d0 = 0; d0 < 4; ++d0) { a[2 * d0] = *(const LAS bf16x8*)(kb + d0 * 32); a[2 * d0 + 1] = *(const LAS bf16x8*)(kb + 32 * KP + d0 * 32); }
    __builtin_amdgcn_s_setprio(1);
#pragma unroll
    for (int d0 = 0; d0 < 4; ++d0) {
        p0 = __builtin_amdgcn_mfma_f32_32x32x16_bf16(a[2 * d0], qf[d0], p0, 0, 0, 0);
        p1 = __builtin_amdgcn_mfma_f32_32x32x16_bf16(a[2 * d0 + 1], qf[d0], p1, 0, 0, 0);
    }
    __builtin_amdgcn_s_setprio(0);
}
template <int STRIDE, bool WINDOW, int MODE>
__device__ __forceinline__ void score_exp(f32x16& p0, f32x16& p1, int dl, const LAS float* tb, float cfar, bool rowsel) {
    const LAS float* tl = tb + 128 + (dl < 1087 ? dl : 1087) - 59;
#pragma unroll
    for (int blk = 0; blk < 2; ++blk) {
        f32x16& p = blk ? p1 : p0;
#pragma unroll
        for (int r = 0; r < 16; ++r) {
            const int c = (r & 3) + 8 * (r >> 2) + 32 * blk;
            const int dist = dl - STRIDE * c;
            float e;
            if (MODE == 0) e = __builtin_amdgcn_exp2f(p[r] + cfar);
            else {
                float bias;
                if (STRIDE == 1) bias = tl[59 - c];
                else bias = tb[128 + min((unsigned)dist, 1023u)];
                e = __builtin_amdgcn_exp2f(p[r] + bias);
                if (MODE == 2) { bool valid = dist >= 0; if (WINDOW) valid = valid && (dist < 512); e = valid ? e : 0.f; }
            }
            p[r] = rowsel ? e : 0.f;
        }
    }
}
template <int STRIDE, bool WINDOW>
__device__ __forceinline__ void score_exp_sel(f32x16& p0, f32x16& p1, int dl, const LAS float* tb, float cfar, bool rowsel, int dmin, int dmax) {
    if (!WINDOW && dmin >= 790) score_exp<STRIDE, WINDOW, 0>(p0, p1, dl, tb, cfar, rowsel);
    else if (dmin >= 0 && (!WINDOW || dmax < 512)) score_exp<STRIDE, WINDOW, 1>(p0, p1, dl, tb, cfar, rowsel);
    else score_exp<STRIDE, WINDOW, 2>(p0, p1, dl, tb, cfar, rowsel);
}
__device__ __forceinline__ float sum32(const f32x16& p0, const f32x16& p1) {
    float a = 0.f, b = 0.f;
#pragma unroll
    for (int r = 0; r < 16; ++r) { a += p0[r]; b += p1[r]; }
    return a + b;
}
template <int NDB>
__device__ __forceinline__ void pv_tile(f32x16 (&o)[NDB], const f32x16& p0, const f32x16& p1, const LAS unsigned char* Vl, int r32, int hi) {
    const LAS unsigned char* vbase = Vl + r32 * VP + hi * 8;
    bf16x4 vf[2][NDB][2];
#define PV_LOAD(st, buf) do { _Pragma("unroll") for (int db = 0; db < NDB; ++db) { const LAS unsigned char* vp = vbase + db * 32 * VP + (st) * 32; vf[buf][db][0] = *(const LAS bf16x4*)vp; vf[buf][db][1] = *(const LAS bf16x4*)(vp + 16); } } while (0)
    PV_LOAD(0, 0);
#pragma unroll
    for (int st = 0; st < 4; ++st) {
        if (st + 1 < 4) PV_LOAD(st + 1, (st + 1) & 1);
        const f32x16& p = (st >> 1) ? p1 : p0; const int s8 = 8 * (st & 1);
        u32x4 w; w.x = pg8::cvt_pk_bf16(p[s8 + 0], p[s8 + 1]); w.y = pg8::cvt_pk_bf16(p[s8 + 2], p[s8 + 3]); w.z = pg8::cvt_pk_bf16(p[s8 + 4], p[s8 + 5]); w.w = pg8::cvt_pk_bf16(p[s8 + 6], p[s8 + 7]);
        const bf16x8 pa = __builtin_bit_cast(bf16x8, w);
        __builtin_amdgcn_s_setprio(1);
#pragma unroll
        for (int db = 0; db < NDB; ++db) {
            const bf16x4 lo = vf[st & 1][db][0], hi4 = vf[st & 1][db][1];
            const bf16x8 vb = {lo[0], lo[1], lo[2], lo[3], hi4[0], hi4[1], hi4[2], hi4[3]};
            o[db] = __builtin_amdgcn_mfma_f32_32x32x16_bf16(pa, vb, o[db], 0, 0, 0);
        }
        __builtin_amdgcn_s_setprio(0);
    }
#undef PV_LOAD
}
__device__ __forceinline__ u32x4 ldk(const bf16_t* g, int tid) { return GLD(u32x4, (const unsigned char*)g + tid * 16); }
__device__ __forceinline__ void stk(LAS unsigned char* Kl, u32x4 v, int tid) { *(LAS u32x4*)(Kl + (tid >> 3) * KP + (tid & 7) * 16) = v; }
__device__ __forceinline__ u32x4 ldv(const bf16_t* g, size_t rs, int row, int tid) { return GLD(u32x4, (const unsigned char*)(g + (size_t)row * rs) + (tid & 7) * 16); }
__device__ __forceinline__ void stv(LAS unsigned char* Vl, u32x4 v, int row, int tid) { LAS unsigned char* p = Vl + row * VP + (tid & 7) * 16; *(LAS u32x2*)p = (u32x2){v.x, v.y}; *(LAS u32x2*)(p + 8) = (u32x2){v.z, v.w}; }

__device__ __forceinline__ void da_unit(const Params& P, int l, int b, int h, int qb, LAS unsigned char* lds, bool load_tab) {
    const int tid = otid(), lane = tid & 63, wave = __builtin_amdgcn_readfirstlane(tid >> 6), r32 = lane & 31, hi = lane >> 5;
    const int c = wave >> 2, qsub = wave & 3, q0 = qb * 128, qw0 = q0 + 32 * qsub;
    unsigned char* ws = WSP;
    const float* prm = (const float*)(ws + WS_PRM) + l * 8;
    const float lam = prm[0], Mb = prm[1], onem = prm[3];
    LAS float* biasL = (LAS float*)(lds + L_BIAS);
    const float* bg = (const float*)(ws + WS_BIAS) + h * 1024;
    if (load_tab) for (int i = tid; i < TBN; i += NTHR) { const int d = i - 128; biasL[i] = GLD(float, bg + (d < 0 ? 0 : (d > 1023 ? 1023 : d))) - Mb; }
    const float cfar = bg[1023] - Mb;
    const bf16_t* Qp = (const bf16_t*)(ws + Z_DQ) + ((size_t)(b * 8 + h * 2 + c) * SEQ + qw0 + r32) * 64 + hi * 8;
    bf16x8 qf[4];
#pragma unroll
    for (int d0 = 0; d0 < 4; ++d0) qf[d0] = GLD(bf16x8, Qp + d0 * 16);
    const bf16_t* K1g = (const bf16_t*)(ws + Z_DK) + (size_t)(b * 8 + h * 2) * SEQ * 64;
    const bf16_t* K2g = K1g + (size_t)SEQ * 64;
    const bf16_t* Vg = (const bf16_t*)(ws + Z_DVT) + (size_t)(b * 4 + h) * 128 * SEQ;
    const int NT = (q0 + 128) / 64;
    f32x16 o[4];
#pragma unroll
    for (int i = 0; i < 4; ++i) o[i] = (f32x16){};
    float lsum = 0.f;
    u32x4 rk1, rk2, rv0, rv1;
#define DA_LOAD(t) do { rk1 = ldk(K1g + (size_t)(t) * 4096, tid); rk2 = ldk(K2g + (size_t)(t) * 4096, tid); rv0 = ldv(Vg + (t) * 64, SEQ, tid >> 3, tid); rv1 = ldv(Vg + (t) * 64, SEQ, 64 + (tid >> 3), tid); } while (0)
#define DA_STORE(sb) do { LAS unsigned char* st_ = lds + (sb) * DA_STAGE; stk(st_, rk1, tid); stk(st_ + 64 * KP, rk2, tid); stv(st_ + 128 * KP, rv0, tid >> 3, tid); stv(st_ + 128 * KP, rv1, 64 + (tid >> 3), tid); } while (0)
    DA_LOAD(0); DA_STORE(0);
    __syncthreads();
    for (int t = 0; t < NT; ++t) {
        if (t + 1 < NT) DA_LOAD(t + 1);
        if (64 * t <= qw0 + 31) {
            const LAS unsigned char* st = lds + (t & 1) * DA_STAGE;
            f32x16 p0 = (f32x16){}, p1 = (f32x16){};
            qk_tile(p0, p1, st + c * 64 * KP, qf, r32, hi);
            const int dl = qw0 + r32 - 64 * t - 4 * hi;
            score_exp_sel<1, false>(p0, p1, dl, biasL, cfar, true, qw0 - (64 * t + 63), qw0 + 31 - 64 * t);
            lsum += sum32(p0, p1);
            pv_tile<4>(o, p0, p1, st + 128 * KP, r32, hi);
        }
        if (t + 1 < NT) DA_STORE((t + 1) & 1);
        __syncthreads();
    }
#undef DA_LOAD
#undef DA_STORE
    lsum += __shfl_xor(lsum, 32);
    LAS float* wsf = (LAS float*)(lds + L_WSF) + wave * 64;
    if (hi == 0) wsf[r32] = (lsum > 0.f) ? 1.0f / lsum : 0.f;
    asm volatile("s_waitcnt lgkmcnt(0)" ::: "memory");
    float li[16];
#pragma unroll
    for (int r = 0; r < 16; ++r) li[r] = wsf[crow(r, hi)];
    LAS float* X = (LAS float*)lds;
    if (c == 1) {
#pragma unroll
        for (int db = 0; db < 4; ++db)
#pragma unroll
            for (int r = 0; r < 16; ++r) X[(32 * qsub + crow(r, hi)) * 132 + r32 + 32 * db] = o[db][r] * li[r];
    }
    __syncthreads();
    if (c == 0) {
        const float* sg = INP(20) + l * 128;
        float gsub[4];
#pragma unroll
        for (int db = 0; db < 4; ++db) gsub[db] = sg[r32 + 32 * db] * onem;
#pragma unroll
        for (int r = 0; r < 16; ++r) {
            float y[4], ss = 0.f;
#pragma unroll
            for (int db = 0; db < 4; ++db) { y[db] = o[db][r] * li[r] - lam * X[(32 * qsub + crow(r, hi)) * 132 + r32 + 32 * db]; ss += y[db] * y[db]; }
            ss += __shfl_xor(ss, 1); ss += __shfl_xor(ss, 2); ss += __shfl_xor(ss, 4); ss += __shfl_xor(ss, 8); ss += __shfl_xor(ss, 16);
            const float rs = __builtin_amdgcn_rsqf(ss * (1.f / 128.f) + EPS);
            bf16_t* d = (bf16_t*)(ws + WS_XN) + (size_t)(b * SEQ + qw0 + crow(r, hi)) * DM + h * 128 + r32;
#pragma unroll
            for (int db = 0; db < 4; ++db) GST(bf16_t, d + 32 * db, (bf16_t)f2bf(y[db] * rs * gsub[db]));
        }
    }
    __syncthreads();
}

__device__ __forceinline__ void nsa_unit(const Params& P, int l, int b, int g, int u, LAS unsigned char* lds, bool load_tab) {
    const int tid = otid(), lane = tid & 63, wave = __builtin_amdgcn_readfirstlane(tid >> 6), r32 = lane & 31, hi = lane >> 5;
    const int qi = r32 >> 2, p = r32 & 3, qw0 = 64 * u + 8 * wave, qpos = qw0 + qi, head = g * 4 + p;
    unsigned char* ws = WSP;
    const float Mb = ((const float*)(ws + WS_PRM))[l * 8 + 2];
    LAS float* biasL = (LAS float*)(lds + L_BIAS);
    LAS float* imp = (LAS float*)(lds + L_IMP);
    LAS unsigned* selw = (LAS unsigned*)(lds + L_SEL);
    LAS float* wsf = (LAS float*)(lds + L_WSF) + wave * 64;
    const float* bgl = (const float*)(ws + WS_BIAS) + (size_t)(4 + g * 4) * 1024;
    if (load_tab) for (int i = tid; i < 4 * TBN; i += NTHR) { const int hh = i / TBN, d = i % TBN - 128; biasL[i] = GLD(float, bgl + hh * 1024 + (d < 0 ? 0 : (d > 1023 ? 1023 : d))) - Mb; }
    if (tid == 0) { unsigned z = 0u; asm volatile("" : "+v"(z)); selw[128] = z; selw[129] = z; }
    const LAS float* tb = biasL + p * TBN;
    const float cfar = bgl[p * 1024 + 1023] - Mb;
    const bf16_t* Qp = (const bf16_t*)(ws + Z_NQ) + ((size_t)(b * 8 + head) * SEQ + qpos) * 64 + hi * 8;
    bf16x8 qf[4];
#pragma unroll
    for (int d0 = 0; d0 < 4; ++d0) qf[d0] = GLD(bf16x8, Qp + d0 * 16);
    const float* ngp = (const float*)(ws + Z_NG) + (size_t)(b * SEQ + qpos) * 24 + head * 3;
    const float gate_c = GLD(float, ngp), gate_s = GLD(float, ngp + 1), gate_w = GLD(float, ngp + 2);
    f32x16 oc[2]; oc[0] = (f32x16){}; oc[1] = (f32x16){};
    f32x16 o[2];
    u32x4 rk, rv;
    const int bgi = b * 2 + g;
#define NS_STORE(sb) do { LAS unsigned char* st_ = lds + (sb) * NS_STAGE; stk(st_, rk, tid); stv(st_ + 64 * KP, rv, tid >> 3, tid); } while (0)
#define NS_FOLD(gate) do { lsum += __shfl_xor(lsum, 32); if (hi == 0) wsf[r32] = (lsum > 0.f) ? (gate) / lsum : 0.f; asm volatile("s_waitcnt lgkmcnt(0)" ::: "memory"); \
        _Pragma("unroll") for (int r = 0; r < 16; ++r) { const float f_ = wsf[crow(r, hi)]; oc[0][r] += f_ * o[0][r]; oc[1][r] += f_ * o[1][r]; } asm volatile("s_waitcnt lgkmcnt(0)" ::: "memory"); } while (0)
    {
        const bf16_t* Kg = (const bf16_t*)(ws + WS_KCN) + (size_t)bgi * 256 * 64;
        const bf16_t* Vg = (const bf16_t*)(ws + WS_VCT) + (size_t)bgi * 64 * 256;
        const int ntc = (4 * u + 2) / 64 + 1;
        for (int tc = 0; tc < ntc; ++tc) { rk = ldk(Kg + (size_t)tc * 4096, tid); rv = ldv(Vg + tc * 64, 256, tid >> 3, tid); NS_STORE(tc); }
        __syncthreads();
        float lsum = 0.f;
        for (int tc = 0; tc < ntc; ++tc) {
            const LAS unsigned char* st = lds + tc * NS_STAGE;
            f32x16 p0 = (f32x16){}, p1 = (f32x16){};
            qk_tile(p0, p1, st, qf, r32, hi);
            const int dl = qpos - 31 - 16 * (64 * tc + 4 * hi);
            score_exp_sel<16, false>(p0, p1, dl, tb, cfar, true, qw0 - 31 - 16 * (64 * tc + 63), qw0 + 7 - 31 - 16 * 64 * tc);
            lsum += sum32(p0, p1);
        }
        const float lt = lsum + __shfl_xor(lsum, 32);
        const float linv = (lt > 0.f) ? 1.0f / lt : 0.f;
        o[0] = (f32x16){}; o[1] = (f32x16){};
        float carry = 0.f;
        for (int tc = 0; tc < ntc; ++tc) {
            const LAS unsigned char* st = lds + tc * NS_STAGE;
            f32x16 p0 = (f32x16){}, p1 = (f32x16){};
            qk_tile(p0, p1, st, qf, r32, hi);
            const int dl = qpos - 31 - 16 * (64 * tc + 4 * hi);
            score_exp_sel<16, false>(p0, p1, dl, tb, cfar, true, qw0 - 31 - 16 * (64 * tc + 63), qw0 + 7 - 31 - 16 * 64 * tc);
            float Qs[2][4], PL[2][4];
#pragma unroll
            for (int blk = 0; blk < 2; ++blk)
#pragma unroll
                for (int m = 0; m < 4; ++m) { const f32x16& pp = blk ? p1 : p0; Qs[blk][m] = (pp[4 * m] + pp[4 * m + 1]) + (pp[4 * m + 2] + pp[4 * m + 3]); PL[blk][m] = __shfl_xor(pp[4 * m + 3], 32); }
#pragma unroll
            for (int blk = 0; blk < 2; ++blk)
#pragma unroll
                for (int m = 0; m < 4; ++m) {
                    const float prev = (m > 0) ? PL[blk][m - 1] : (blk ? PL[0][3] : carry);
                    float e = (Qs[blk][m] + (hi ? PL[blk][m] : prev)) * linv;
                    e += __shfl_xor(e, 1); e += __shfl_xor(e, 2);
                    if (p == 0) imp[(8 * wave + qi) * 64 + 16 * tc + 8 * blk + 2 * m + hi] = e;
                }
            carry = PL[1][3];
            pv_tile<2>(o, p0, p1, st + 64 * KP, r32, hi);
        }
        NS_FOLD(gate_c);
    }
    __syncthreads();
    {
        const int ql = lane >> 3, sub = lane & 7, q = 8 * wave + ql;
        unsigned long long m;
        if (u < 8) m = (2ull << u) - 1ull;
        else {
            m = 1ull | (1ull << u) | (1ull << (u - 1));
            float v[8];
#pragma unroll
            for (int i = 0; i < 8; ++i) { const int j = sub + 8 * i; v[i] = (j >= 1 && j <= u - 2) ? imp[q * 64 + j] : -1.f; }
            for (int k = 0; k < 5; ++k) {
                float bv = v[0]; int bj = sub;
#pragma unroll
                for (int i = 1; i < 8; ++i) if (v[i] > bv) { bv = v[i]; bj = sub + 8 * i; }
#pragma unroll
                for (int of = 1; of < 8; of <<= 1) { const float ov = __shfl_xor(bv, of); const int oj = __shfl_xor(bj, of); if (ov > bv || (ov == bv && oj < bj)) { bv = ov; bj = oj; } }
                m |= 1ull << bj;
#pragma unroll
                for (int i = 0; i < 8; ++i) if (bj == sub + 8 * i) v[i] = -2.f;
            }
        }
        if (sub == 0) { selw[2 * q] = (unsigned)m; selw[2 * q + 1] = (unsigned)(m >> 32); atomicOr((unsigned*)&selw[128], (unsigned)m); atomicOr((unsigned*)&selw[129], (unsigned)(m >> 32)); }
    }
    __syncthreads();
    asm volatile("" : "+v"(oc[0]), "+v"(oc[1]));
    u32x4 rk2, rv2;
#define NS_LOADA(Kg_, Vg_, j_) do { rk = ldk((Kg_) + (size_t)(j_) * 4096, tid); rv = ldv((Vg_) + (j_) * 64, SEQ, tid >> 3, tid); } while (0)
#define NS_LOADB(Kg_, Vg_, j_) do { rk2 = ldk((Kg_) + (size_t)(j_) * 4096, tid); rv2 = ldv((Vg_) + (j_) * 64, SEQ, tid >> 3, tid); } while (0)
#define NS_STOREA(sb) do { LAS unsigned char* st_ = lds + (sb) * NS_STAGE; stk(st_, rk, tid); stv(st_ + 64 * KP, rv, tid >> 3, tid); } while (0)
#define NS_STOREB(sb) do { LAS unsigned char* st_ = lds + (sb) * NS_STAGE; stk(st_, rk2, tid); stv(st_ + 64 * KP, rv2, tid >> 3, tid); } while (0)
    {
        const unsigned long long un = (unsigned long long)selw[128] | ((unsigned long long)selw[129] << 32);
        const unsigned long long mine = (unsigned long long)selw[2 * (8 * wave + qi)] | ((unsigned long long)selw[2 * (8 * wave + qi) + 1] << 32);
        const bf16_t* Kg = (const bf16_t*)(ws + Z_KSEL) + (size_t)bgi * SEQ * 64;
        const bf16_t* Vg = (const bf16_t*)(ws + Z_VSELT) + (size_t)bgi * 64 * SEQ;
        o[0] = (f32x16){}; o[1] = (f32x16){};
        float lsum = 0.f;
        unsigned long long rem = un;
#define NS_NEXTJ(var, has) do { has = (rem != 0ull); var = 0; if (has) { var = __builtin_ctzll(rem); rem &= rem - 1; } } while (0)
        int jc, j1, j2; bool h1, h2;
        NS_NEXTJ(jc, h1);
        NS_NEXTJ(j1, h1);
        NS_LOADA(Kg, Vg, jc); if (h1) NS_LOADB(Kg, Vg, j1);
        NS_STOREA(0);
        __syncthreads();
        int sc = 0;
#define NS_SEL_STEP(LOADF, STOREN) { \
            NS_NEXTJ(j2, h2); if (h2) LOADF(Kg, Vg, j2); \
            const bool rowsel = (mine >> jc) & 1ull; \
            if (__any(rowsel)) { \
                const LAS unsigned char* st = lds + sc * NS_STAGE; \
                f32x16 p0 = (f32x16){}, p1 = (f32x16){}; \
                qk_tile(p0, p1, st, qf, r32, hi); \
                const int dl = qpos - 64 * jc - 4 * hi; \
                score_exp_sel<1, false>(p0, p1, dl, tb, cfar, rowsel, qw0 - (64 * jc + 63), qw0 + 7 - 64 * jc); \
                lsum += sum32(p0, p1); \
                pv_tile<2>(o, p0, p1, st + 64 * KP, r32, hi); \
            } \
            const int sn = (sc == 2) ? 0 : sc + 1; \
            if (h1) STOREN(sn); \
            __syncthreads(); \
            if (!h1) break; \
            jc = j1; j1 = j2; h1 = h2; sc = sn; }
        for (;;) { NS_SEL_STEP(NS_LOADA, NS_STOREB) NS_SEL_STEP(NS_LOADB, NS_STOREA) }
#undef NS_SEL_STEP
#undef NS_NEXTJ
        NS_FOLD(gate_s);
        asm volatile("" : "+v"(oc[0]), "+v"(oc[1]));
    }
    {
        const bf16_t* Kg = (const bf16_t*)(ws + Z_KWIN) + (size_t)bgi * SEQ * 64;
        const bf16_t* Vg = (const bf16_t*)(ws + Z_VWINT) + (size_t)bgi * 64 * SEQ;
        o[0] = (f32x16){}; o[1] = (f32x16){};
        float lsum = 0.f;
        const int t0 = (u >= 8) ? u - 8 : 0;
        int t = t0, sc = 0;
        NS_LOADA(Kg, Vg, t0); if (t0 + 1 <= u) NS_LOADB(Kg, Vg, t0 + 1);
        NS_STOREA(0);
        __syncthreads();
#define NS_WIN_STEP(LOADF, STOREN) { \
            if (t + 2 <= u) LOADF(Kg, Vg, t + 2); \
            { \
                const LAS unsigned char* st = lds + sc * NS_STAGE; \
                f32x16 p0 = (f32x16){}, p1 = (f32x16){}; \
                qk_tile(p0, p1, st, qf, r32, hi); \
                const int dl = qpos - 64 * t - 4 * hi; \
                score_exp_sel<1, true>(p0, p1, dl, tb, cfar, true, qw0 - (64 * t + 63), qw0 + 7 - 64 * t); \
                lsum += sum32(p0, p1); \
                pv_tile<2>(o, p0, p1, st + 64 * KP, r32, hi); \
            } \
            const int sn = (sc == 2) ? 0 : sc + 1; \
            if (t + 1 <= u) STOREN(sn); \
            __syncthreads(); \
            if (t + 1 > u) break; \
            ++t; sc = sn; }
        for (;;) { NS_WIN_STEP(NS_LOADA, NS_STOREB) NS_WIN_STEP(NS_LOADB, NS_STOREA) }
#undef NS_WIN_STEP
        NS_FOLD(gate_w);
    }
#undef NS_LOADA
#undef NS_LOADB
#undef NS_STOREA
#undef NS_STOREB
#undef NS_STORE
#undef NS_FOLD
#pragma unroll
    for (int r = 0; r < 16; ++r) {
        const int row = crow(r, hi), q = qw0 + (row >> 2), pp = row & 3;
        bf16_t* d = (bf16_t*)(ws + WS_XN) + (size_t)(b * SEQ + q) * DM + 512 + (g * 4 + pp) * 64 + r32;
        GST(bf16_t, d, (bf16_t)f2bf(oc[0][r])); GST(bf16_t, d + 32, (bf16_t)f2bf(oc[1][r]));
    }
    __syncthreads();
}

__device__ __forceinline__ void attention_phase(const Params& P, int l, LAS unsigned char* lds) {
    int tab_key = -1;
    for (int it = blockIdx.x; it < 2048; it += gridDim.x) {
        const int c = it & 255, sl = (it >> 8) & 3;
        if (it < 1024) { const int bh = c & 31, xg = c >> 5; const int qb = (sl == 0) ? 31 - xg : (sl == 1) ? 23 - xg : (sl == 2) ? 8 + xg : xg;
            da_unit(P, l, bh >> 2, bh & 3, qb, lds, tab_key != (bh & 3)); tab_key = bh & 3; }
        else { const int bg = c & 15, ug = c >> 4; const int u = (sl == 0) ? 63 - ug : (sl == 1) ? 47 - ug : (sl == 2) ? 16 + ug : ug;
            nsa_unit(P, l, bg >> 1, bg & 1, u, lds, tab_key != 4 + (bg & 1)); tab_key = 4 + (bg & 1); }
    }
}

constexpr size_t WS_BAR = 72 * 1024;
#define RLX_AGENT __ATOMIC_RELAXED, __HIP_MEMORY_SCOPE_AGENT
#define XB_TMO      128
#define XB_XCNT(j)  (256  + 64 * (j))
#define XB_XSUB(j)  (1280 + 64 * (j))
#define XB_XGEN(j)  (2304 + 64 * (j))
#define XB_TOP      3328
#define XB_TOPGEN   3392
#define XCD_BAR_WORDS 3456
#define XB_SPIN_CAP (1u << 18)

__device__ __forceinline__ unsigned xb_ld(unsigned* p)              { return __hip_atomic_load(p, __ATOMIC_RELAXED, __HIP_MEMORY_SCOPE_AGENT); }
__device__ __forceinline__ unsigned xb_add(unsigned* p, unsigned v) { return __hip_atomic_fetch_add(p, v, __ATOMIC_RELAXED, __HIP_MEMORY_SCOPE_AGENT); }
__device__ __forceinline__ unsigned xb_xcc_id() { return (unsigned)__builtin_amdgcn_s_getreg((3 << 11) | 20) & 0xFu; }
#define XB_SPIN(cond, bar) do { unsigned _sp = 0; while (cond) { __builtin_amdgcn_s_sleep(1); \
    if ((++_sp & 255u) == 0u) { if (xb_ld(&(bar)[XB_TMO])) break; if (_sp > XB_SPIN_CAP) { atomicAdd(&(bar)[XB_TMO], 1u); break; } } } } while (0)

struct XcdBarrier {
    unsigned* bar; unsigned x;
    volatile LAS unsigned* st;
};

__device__ __forceinline__ XcdBarrier xcd_barrier_post(unsigned* bar, volatile LAS unsigned* st) {
    XcdBarrier b; b.bar = bar; b.x = xb_xcc_id(); b.st = st;
    if (threadIdx.x == 0) (void)xb_add(&bar[XB_XCNT(b.x)], 1u);
    return b;
}
__device__ __forceinline__ void xcd_barrier_complete(unsigned* bar, unsigned x, unsigned& nloc, unsigned& nx) {
    const unsigned G = gridDim.x * gridDim.y * gridDim.z;
    unsigned sum, cnt, mine, sp = 0u;
    for (;;) {
        sum = 0u; cnt = 0u; mine = 0u;
#pragma unroll
        for (unsigned j = 0; j < 16; ++j) { const unsigned c = xb_ld(&bar[XB_XCNT(j)]); sum += c; cnt += (c > 0u) ? 1u : 0u; mine = (j == x) ? c : mine; }
        if (sum == G) break;
        __builtin_amdgcn_s_sleep(1);
        if ((++sp & 255u) == 0u) { if (xb_ld(&bar[XB_TMO])) break; if (sp > XB_SPIN_CAP) { atomicAdd(&bar[XB_TMO], 1u); break; } }
    }
    nloc = mine > 0u ? mine : 1u; nx = cnt > 0u ? cnt : 1u;
}

__device__ __forceinline__ void xcd_barrier(const XcdBarrier& b) {
    asm volatile("s_waitcnt vmcnt(0)" ::: "memory");
    __syncthreads();
    if (threadIdx.x == 0) {
        unsigned* bar = b.bar;
        __builtin_amdgcn_s_waitcnt(0);
        unsigned nloc = b.st[0], nx = b.st[1];
        if (nloc == 0u) { xcd_barrier_complete(bar, b.x, nloc, nx); b.st[0] = nloc; b.st[1] = nx; }
        const unsigned old = xb_add(&bar[XB_XSUB(b.x)], 1u);
        const unsigned gen = old / nloc;
        if (old + 1u == (gen + 1u) * nloc) {
            __builtin_amdgcn_fence(__ATOMIC_RELEASE, "agent");
            asm volatile("s_waitcnt vmcnt(0)" ::: "memory");
            const unsigned og = xb_add(&bar[XB_TOP], 1u);
            const unsigned tg = og / nx;
            if (og + 1u == (tg + 1u) * nx) xb_add(&bar[XB_TOPGEN], 1u);
            else XB_SPIN(xb_ld(&bar[XB_TOPGEN]) == tg, bar);
            __builtin_amdgcn_fence(__ATOMIC_ACQUIRE, "agent");
            xb_add(&bar[XB_XGEN(b.x)], 1u);
            asm volatile("s_waitcnt vmcnt(0)" ::: "memory");
        } else {
            XB_SPIN(xb_ld(&bar[XB_XGEN(b.x)]) == gen, bar);
            __builtin_amdgcn_fence(__ATOMIC_ACQUIRE, "agent");
            asm volatile("s_waitcnt vmcnt(0)" ::: "memory");
        }
    }
    __syncthreads();
}

__global__ void __launch_bounds__(NTHR, 2) hybrid_fwd(Params P) {
    extern __shared__ __attribute__((aligned(16))) unsigned char lds_raw[];
    LAS unsigned char* lds = (LAS unsigned char*)lds_raw;
    cg::grid_group grid = cg::this_grid();
#define GSYNC() do { XcdBarrier xb_; xb_.bar = (unsigned*)(WSP + WS_BAR); xb_.x = xb_xcc_id(); xb_.st = (volatile LAS unsigned*)(lds + L_PTAB + 384); xcd_barrier(xb_); } while (0)
    if (threadIdx.x == 0) {
        LAS unsigned long long* pt = (LAS unsigned long long*)(lds + L_PTAB);
#pragma unroll
        for (int i = 0; i < 30; ++i) pt[i] = (unsigned long long)P.in[i];
        pt[30] = (unsigned long long)P.out; pt[31] = (unsigned long long)P.ws;
        *(LAS unsigned*)(lds + L_PTAB + 384) = 0u; *(LAS unsigned*)(lds + L_PTAB + 388) = 0u;
    }
    __syncthreads();
    (void)xcd_barrier_post((unsigned*)(WSP + WS_BAR), (volatile LAS unsigned*)(lds + L_PTAB + 384));
    const int G = gridDim.x, bx = blockIdx.x;
#define ws WSP
#define XN ((bf16_t*)(WSP + WS_XN))
#define HID ((bf16_t*)(WSP + WS_HID))
#define MERGED ((bf16_t*)(WSP + WS_MERGED))

#if defined(PROBE_PHASE)
    int n_stamp = 0;
#define STAMP() do { if (blockIdx.x == 0 && threadIdx.x == 0) ((LAS unsigned long long*)(lds + L_PTAB + 512))[n_stamp] = __builtin_amdgcn_s_memrealtime(); ++n_stamp; } while (0)
#else
#define STAMP() do {} while (0)
#endif
    grid.sync();
    STAMP();
    prologue(P, lds);
#if defined(DUP_PRO)
    prologue(P, lds);
#endif
    GSYNC(); STAMP();
#pragma unroll
    for (int l = 0; l < DEPTH; ++l) {
        const float* xin = (l == 0) ? INP(0) : OUTP;
        rmsnorm_phase(xin, INP(5) + l * DM, XN);
        GSYNC(); STAMP();
        { pg8::Gemm g{XN, (const bf16_t*)(ws + WS_W13 + (size_t)(l * 2 + 0) * W13_SZ), MTOK, 5632, DM}; pg8::StaticOrder S; S.init(MTOK, 5632, G, bx);
          EpiSwiGLU E{HID}; pg8::gemm_phase<EpiSwiGLU, pg8::StaticOrder, true, true>(lds, g, S, E);
#if defined(DUP_G1)
          pg8::gemm_phase<EpiSwiGLU, pg8::StaticOrder, true, true>(lds, g, S, E);
#endif
        }
        GSYNC(); STAMP();
        { pg8::Gemm g{HID, (const bf16_t*)(ws + WS_W2 + (size_t)(l * 2 + 0) * W2_SZ), MTOK, DM, DFF}; pg8::StaticOrder S; S.init(MTOK, DM, G, bx);
          EpiResid E{xin, OUTP, 0.5f}; pg8::gemm_phase<EpiResid, pg8::StaticOrder, true, true>(lds, g, S, E); }
        GSYNC(); STAMP();
#if defined(STOP_AFTER) && STOP_AFTER == 1
        return;
#endif
        rmsnorm_phase(OUTP, INP(6) + l * DM, XN);
        GSYNC(); STAMP();
        { pg8::Gemm g{XN, (const bf16_t*)(ws + WS_WIN + (size_t)l * WIN_SZ), MTOK, 5120, DM}; pg8::StaticOrder S; S.init(MTOK, 5120, G, bx);
          EpiZ E{ws, INP(14) + l * 64, INP(15) + l * 64, INP(21) + l * 64, INP(22) + l * 192}; pg8::gemm_phase<EpiZ, pg8::StaticOrder, true, true>(lds, g, S, E);
#if defined(DUP_G3)
          pg8::gemm_phase<EpiZ, pg8::StaticOrder, true, true>(lds, g, S, E);
#endif
        }
        GSYNC(); STAMP();
#if defined(DUMP_Z)
        { const unsigned short* z = (const unsigned short*)(WSP + WS_Z); float* o = OUTP;
          for (size_t i = (size_t)blockIdx.x * NTHR + threadIdx.x; i < (size_t)MTOK * DM; i += (size_t)gridDim.x * NTHR) {
              unsigned v = (unsigned)z[i * 4 + (i & 3)] << 16; if ((v & 0x7f800000u) == 0x7f800000u) v = 0u; o[i] = __builtin_bit_cast(float, v); }
          return; }
#endif
        compress_phase(P, l, lds);
#if defined(DUP_CMP)
        for (int rep_ = 0; rep_ < 4; ++rep_) compress_phase(P, l, lds);
#endif
        GSYNC(); STAMP();
        attention_phase(P, l, lds);
#if defined(DUP_ATT)
        attention_phase(P, l, lds);
#endif
        GSYNC(); STAMP();
        { pg8::Gemm g{XN, (const bf16_t*)(ws + WS_PAB + (size_t)l * PAB_SZ), MTOK, 2048, DM}; pg8::StaticOrder S; S.init(MTOK, 2048, G, bx);
          EpiMerge E{(const bf16_t*)(ws + Z_MG), MERGED}; pg8::gemm_phase<EpiMerge, pg8::StaticOrder, true, true>(lds, g, S, E); }
        GSYNC(); STAMP();
        { pg8::Gemm g{MERGED, (const bf16_t*)(ws + WS_WO + (size_t)l * WO_SZ), MTOK, DM, DM}; pg8::StaticOrder S; S.init(MTOK, DM, G, bx);
          EpiResid E{OUTP, OUTP, 1.0f}; pg8::gemm_phase<EpiResid, pg8::StaticOrder, true, true>(lds, g, S, E); }
        GSYNC(); STAMP();
#if defined(STOP_AFTER) && STOP_AFTER == 2
        return;
#endif
        rmsnorm_phase(OUTP, INP(7) + l * DM, XN);
        GSYNC(); STAMP();
        { pg8::Gemm g{XN, (const bf16_t*)(ws + WS_W13 + (size_t)(l * 2 + 1) * W13_SZ), MTOK, 5632, DM}; pg8::StaticOrder S; S.init(MTOK, 5632, G, bx);
          EpiSwiGLU E{HID}; pg8::gemm_phase<EpiSwiGLU, pg8::StaticOrder, true, true>(lds, g, S, E); }
        GSYNC(); STAMP();
        { pg8::Gemm g{HID, (const bf16_t*)(ws + WS_W2 + (size_t)(l * 2 + 1) * W2_SZ), MTOK, DM, DFF}; pg8::StaticOrder S; S.init(MTOK, DM, G, bx);
          EpiResid E{OUTP, OUTP, 0.5f}; pg8::gemm_phase<EpiResid, pg8::StaticOrder, true, true>(lds, g, S, E); }
        if (l + 1 < DEPTH) { GSYNC(); STAMP(); }
    }
#if defined(PROBE_PHASE)
    GSYNC(); STAMP();
    if (blockIdx.x == 0 && threadIdx.x == 0) { const LAS unsigned long long* t = (const LAS unsigned long long*)(lds + L_PTAB + 512); const float ns = (float)(t[PROBE_PHASE + 1] - t[PROBE_PHASE]) * 10.0f; OUTP[0] = exp2f(rintf(log2f(ns) * 4.f) * 0.25f); }
#endif
#undef ws
#undef XN
#undef HID
#undef MERGED
}

extern "C" void kernel_launch(void* const* d_in, const int* in_sizes, int n_in, void* d_out, int out_size, void* d_ws, size_t ws_size, hipStream_t stream) {
    static int grid = 0;
    if (grid == 0) {
        if (n_in != 30 || out_size != MTOK * DM || ws_size < WS_END) { fprintf(stderr, "kernel_launch: unexpected problem (n_in %d out %d ws %zu, need %zu)\n", n_in, out_size, ws_size, (size_t)WS_END); grid = -1; return; }
        int dev = 0, cus = 0, per_cu = 0;
        (void)hipGetDevice(&dev);
        (void)hipDeviceGetAttribute(&cus, hipDeviceAttributeMultiprocessorCount, dev);
        if (hipFuncSetAttribute((const void*)hybrid_fwd, hipFuncAttributeMaxDynamicSharedMemorySize, LDS_BYTES) != hipSuccess) { fprintf(stderr, "kernel_launch: hipFuncSetAttribute failed\n"); grid = -1; return; }
        if (hipOccupancyMaxActiveBlocksPerMultiprocessor(&per_cu, (const void*)hybrid_fwd, NTHR, LDS_BYTES) != hipSuccess || per_cu < 1) { fprintf(stderr, "kernel_launch: occupancy query gave %d\n", per_cu); per_cu = 1; }
        (void)hipGetLastError();
        grid = cus * (per_cu > 1 ? 1 : per_cu);
        if (grid <= 0) grid = 256;
    }
    if (grid < 0) return;
    Params p{};
    for (int i = 0; i < 30; ++i) p.in[i] = (const float*)d_in[i];
    p.out = (float*)d_out; p.ws = (unsigned char*)d_ws;
    (void)hipMemsetAsync((unsigned char*)d_ws + WS_BAR, 0, 16384, stream);
    void* args[] = {&p};
    hipError_t e = hipLaunchCooperativeKernel((const void*)hybrid_fwd, dim3(grid), dim3(NTHR), args, LDS_BYTES, stream);
    if (e != hipSuccess) fprintf(stderr, "cooperative launch failed: %s (grid %d)\n", hipGetErrorString(e), grid);
}
```

```cpp
#include <hip/hip_runtime.h>
#include <hip/hip_cooperative_groups.h>
#include <cstdio>
#include <cstdint>
namespace cg = cooperative_groups;
namespace pg8 {
#define PG8_LAS __attribute__((address_space(3)))
typedef unsigned short bf16_t;
typedef short bf16x8 __attribute__((ext_vector_type(8)));
typedef float f32x4 __attribute__((ext_vector_type(4)));
typedef unsigned u32x4 __attribute__((ext_vector_type(4)));
constexpr int BM = 256, BK = 64, HALF = 128, HTB = HALF * BK * 2  , STAGE_BYTES = 8 * HTB, NXCD = 8, WGM = 8;

__host__ __device__ __forceinline__ int lds_byte(int r, int c) { const int st = (r >> 4) * 2 + (c >> 5), rr = r & 15, cc = c & 31, ob = rr * 64 + cc * 2; return st * 1024 + (ob ^ (((ob >> 9) & 1) << 5)); }
__host__ __device__ __forceinline__ void stage_rc(int b, int& R, int& C) { const int st = b / 1024, sb = b % 1024, swz = sb ^ (((sb >> 9) & 1) << 5); R = (st >> 1) * 16 + swz / 64; C = (st & 1) * 32 + (swz % 64) / 2; }
__host__ __device__ __forceinline__ int perm32(int rho) { const int n = rho >> 4, i = rho & 15; return 8 * (i >> 2) + 4 * n + (i & 3); }

struct Unit { int pm, pn; };
struct Gemm { const bf16_t* A; const bf16_t* Bt; int M, N, K; };

struct StaticOrder {
    int nM, nN, nwg, G, c;
    __host__ __device__ void init(int M, int N, int G_, int c_) { nM = M / BM; nN = N / BM; nwg = nM * nN; G = G_; c = c_; }
    __host__ __device__ bool next(int i, Unit& u) const {
        const long L = (long)i * G + c; if (L >= nwg) return false;
        int wgid = (int)L; { const int q = nwg / NXCD, r = nwg % NXCD, xcd = wgid % NXCD, off = wgid / NXCD; wgid = (xcd < r ? xcd * (q + 1) : r * (q + 1) + (xcd - r) * q) + off; }
        const int nig = WGM * nN, gid = wgid / nig, fm = gid * WGM, gsz = (nM - fm) < WGM ? (nM - fm) : WGM;
        u.pm = fm + ((wgid % nig) % gsz); u.pn = (wgid % nig) / gsz; return true;
    }
    __device__ __forceinline__ void a_ready(const Unit&) const {}
    __device__ __forceinline__ void done(const Unit&) const {}
};

typedef float f32x2_t __attribute__((ext_vector_type(2))); typedef __bf16 bf16x2_t __attribute__((ext_vector_type(2)));
__device__ __forceinline__ unsigned cvt_pk_bf16(float lo, float hi) { f32x2_t v = {lo, hi}; bf16x2_t b = __builtin_convertvector(v, bf16x2_t); return __builtin_bit_cast(unsigned, b); }
template <class Epi, class Sched, bool ALIGN_EPI = false, bool SP2 = false>
__device__ __forceinline__ void gemm_phase(PG8_LAS unsigned char* lds, const Gemm g, const Sched& S, const Epi& E) {
    int tid_ = threadIdx.x; asm volatile("" : "+v"(tid_)); const int tid = tid_, wid = __builtin_amdgcn_readfirstlane(tid >> 6), lane = tid & 63, wr = wid >> 2, wc = wid & 3, fr = lane & 15, fq = lane >> 4;
    const int K = g.K, nt = K / BK;
    unsigned voffA[2], voffB[2];
#pragma unroll
    for (int i = 0; i < 2; ++i) { int R, C; stage_rc(tid * 16 + i * 8192, R, C); const int Rb = Epi::PERM ? ((R & ~31) + perm32(R & 31)) : R;
        voffA[i] = (unsigned)(R * K + C) * 2u; voffB[i] = (unsigned)(Rb * K + C) * 2u; }
    const size_t kstep = (size_t)(BK * 2);
    const size_t hstep = (size_t)HALF * K * 2;
    const size_t tstep = 2 * hstep;
    const unsigned ldsw = (unsigned)wid * 1024u;
    const int aoff = lds_byte(wr * 64 + fr, fq * 8), boff = lds_byte(wc * 32 + fr, fq * 8);
#define PG8_SA(b, h) (((b) * 2 + (h)) * HTB)
#define PG8_SB(b, h) ((4 + (b) * 2 + (h)) * HTB)
#define PG8_STAGE(bufoff, gbase, voff) do { _Pragma("unroll") for (int _i = 0; _i < 2; ++_i) \
        __builtin_amdgcn_global_load_lds((const unsigned*)((const char*)(gbase) + (voff)[_i]), (PG8_LAS unsigned*)(lds + (bufoff) + ldsw + _i * 8192), 16, 0, 0); } while (0)
#define PG8_LDA(dst, b, h) do { _Pragma("unroll") for (int m = 0; m < 4; ++m) _Pragma("unroll") for (int k = 0; k < 2; ++k) dst[m][k] = *(const PG8_LAS bf16x8*)(lds + PG8_SA(b, h) + aoff + m * 2048 + k * 1024); } while (0)
#define PG8_LDB(dst, b, h) do { _Pragma("unroll") for (int n = 0; n < 2; ++n) _Pragma("unroll") for (int k = 0; k < 2; ++k) dst[n][k] = *(const PG8_LAS bf16x8*)(lds + PG8_SB(b, h) + boff + n * 2048 + k * 1024); } while (0)
#define PG8_MMA(ai, bj, At, Bt) do { __builtin_amdgcn_s_setprio(1); _Pragma("unroll") for (int m = 0; m < 4; ++m) _Pragma("unroll") for (int n = 0; n < 2; ++n) _Pragma("unroll") for (int k = 0; k < 2; ++k) \
        acc[ai][bj][m][n] = __builtin_amdgcn_mfma_f32_16x16x32_bf16(Bt[n][k], At[m][k], acc[ai][bj][m][n], 0, 0, 0); __builtin_amdgcn_s_setprio(0); } while (0)
#define PG8_WAIT_V(n) asm volatile("s_waitcnt vmcnt(" #n ")" ::: "memory")
#define PG8_WAIT_L(n) asm volatile("s_waitcnt lgkmcnt(" #n ")" ::: "memory")
#define PG8_BAR __builtin_amdgcn_s_barrier()
#define PG8_SCHED __builtin_amdgcn_sched_barrier(0)
    Unit cur, nxt; int ui = 0;
    if (!S.next(0, cur)) return;
    f32x4 acc[2][2][4][2];
#pragma unroll
    for (int a = 0; a < 2; ++a)
#pragma unroll
        for (int b = 0; b < 2; ++b)
#pragma unroll
            for (int m = 0; m < 4; ++m)
#pragma unroll
                for (int n = 0; n < 2; ++n) acc[a][b][m][n] = (f32x4){0.f, 0.f, 0.f, 0.f};
    bf16x8 At[4][2], B0[2][2], B1[2][2];
    const char* cA = (const char*)g.A + (size_t)cur.pm * tstep; const char* cB = (const char*)g.Bt + (size_t)cur.pn * tstep;
    S.a_ready(cur);
    if constexpr (SP2) {
        PG8_STAGE(PG8_SB(0, 0), cB, voffB); PG8_STAGE(PG8_SB(0, 1), cB + hstep, voffB); PG8_STAGE(PG8_SA(0, 0), cA, voffA); PG8_STAGE(PG8_SA(0, 1), cA + hstep, voffA);
        if (wr == 1) PG8_BAR;
        PG8_WAIT_V(2); PG8_BAR;
        PG8_STAGE(PG8_SB(1, 0), cB + kstep, voffB); PG8_STAGE(PG8_SA(1, 0), cA + kstep, voffA); PG8_STAGE(PG8_SB(1, 1), cB + hstep + kstep, voffB);
        PG8_WAIT_V(6); PG8_BAR;
    } else {
        PG8_STAGE(PG8_SB(0, 0), cB, voffB); PG8_STAGE(PG8_SA(0, 0), cA, voffA); PG8_STAGE(PG8_SB(0, 1), cB + hstep, voffB); PG8_STAGE(PG8_SA(0, 1), cA + hstep, voffA);
        if (wr == 1) PG8_BAR;
        PG8_WAIT_V(4); PG8_BAR;
        PG8_STAGE(PG8_SB(1, 0), cB + kstep, voffB); PG8_STAGE(PG8_SA(1, 0), cA + kstep, voffA); PG8_STAGE(PG8_SB(1, 1), cB + hstep + kstep, voffB);
        PG8_WAIT_V(6); PG8_BAR;
    }
    for (;;) {
        const bool has_next = S.next(ui + 1, nxt);
        const char* nA = has_next ? (const char*)g.A + (size_t)nxt.pm * tstep : cA; const char* nB = has_next ? (const char*)g.Bt + (size_t)nxt.pn * tstep : cB;
        for (int t = 0; t < nt; t += 2) {
            const bool last = (t == nt - 2);
            const char* a1 = cA + (size_t)(t + 1) * kstep;
            const char* a2 = last ? nA : cA + (size_t)(t + 2) * kstep; const char* b2 = last ? nB : cB + (size_t)(t + 2) * kstep;
            const char* a3 = a2 + kstep; const char* b3 = b2 + kstep;
            if (last && has_next) S.a_ready(nxt);
            if constexpr (SP2) {
            PG8_LDB(B0, 0, 0); PG8_LDB(B1, 0, 1); PG8_SCHED; PG8_LDA(At, 0, 0); PG8_STAGE(PG8_SA(1, 1), a1 + hstep, voffA);
            PG8_WAIT_V(8); PG8_WAIT_L(0); PG8_BAR; PG8_MMA(0, 0, At, B0); PG8_MMA(0, 1, At, B1); PG8_BAR; PG8_SCHED;
            PG8_LDA(At, 0, 1); PG8_STAGE(PG8_SB(0, 0), b2, voffB); PG8_STAGE(PG8_SB(0, 1), b2 + hstep, voffB); PG8_STAGE(PG8_SA(0, 0), a2, voffA);
            PG8_WAIT_V(8); PG8_WAIT_L(0); PG8_BAR; PG8_MMA(1, 0, At, B0); PG8_MMA(1, 1, At, B1); PG8_BAR; PG8_SCHED;
            PG8_LDB(B0, 1, 0); PG8_LDB(B1, 1, 1); PG8_SCHED; PG8_LDA(At, 1, 0); PG8_STAGE(PG8_SA(0, 1), a2 + hstep, voffA);
            PG8_WAIT_V(8); PG8_WAIT_L(0); PG8_BAR; PG8_MMA(0, 0, At, B0); PG8_MMA(0, 1, At, B1); PG8_BAR; PG8_SCHED;
            PG8_LDA(At, 1, 1); PG8_STAGE(PG8_SB(1, 0), b3, voffB); PG8_STAGE(PG8_SB(1, 1), b3 + hstep, voffB); PG8_STAGE(PG8_SA(1, 0), a3, voffA);
            PG8_WAIT_V(8); PG8_WAIT_L(0); PG8_BAR; PG8_MMA(1, 0, At, B0); PG8_MMA(1, 1, At, B1); PG8_BAR; PG8_SCHED;
            } else {
            PG8_LDB(B0, 0, 0); PG8_SCHED; PG8_LDA(At, 0, 0); PG8_STAGE(PG8_SA(1, 1), a1 + hstep, voffA);
            PG8_WAIT_L(8); PG8_BAR; PG8_WAIT_L(0); PG8_MMA(0, 0, At, B0); PG8_BAR; PG8_SCHED;
            PG8_LDB(B1, 0, 1); PG8_STAGE(PG8_SB(0, 0), b2, voffB);
            PG8_BAR; PG8_WAIT_L(0); PG8_MMA(0, 1, At, B1); PG8_BAR;
            PG8_LDA(At, 0, 1); PG8_STAGE(PG8_SA(0, 0), a2, voffA);
            PG8_BAR; PG8_WAIT_L(0); PG8_MMA(1, 0, At, B0); PG8_BAR; PG8_SCHED;
            PG8_STAGE(PG8_SB(0, 1), b2 + hstep, voffB);
            PG8_WAIT_V(6); PG8_BAR; PG8_MMA(1, 1, At, B1); PG8_BAR;
            PG8_LDB(B0, 1, 0); PG8_SCHED; PG8_LDA(At, 1, 0); PG8_STAGE(PG8_SA(0, 1), a2 + hstep, voffA);
            PG8_WAIT_L(8); PG8_BAR; PG8_WAIT_L(0); PG8_MMA(0, 0, At, B0); PG8_BAR; PG8_SCHED;
            PG8_LDB(B1, 1, 1); PG8_STAGE(PG8_SB(1, 0), b3, voffB);
            PG8_BAR; PG8_WAIT_L(0); PG8_MMA(0, 1, At, B1); PG8_BAR;
            PG8_LDA(At, 1, 1); PG8_STAGE(PG8_SA(1, 0), a3, voffA);
            PG8_BAR; PG8_WAIT_L(0); PG8_MMA(1, 0, At, B0); PG8_BAR; PG8_SCHED;
            PG8_STAGE(PG8_SB(1, 1), b3 + hstep, voffB);
            PG8_WAIT_V(6); PG8_BAR; PG8_MMA(1, 1, At, B1); PG8_BAR;
            }
        }
        if constexpr (ALIGN_EPI) { if (wr == 0) PG8_BAR; }
        if constexpr (!Epi::AFTER_DRAIN) { E(acc, cur, wr, wc, fr, fq); S.done(cur); }
        if (!has_next) break;
#pragma unroll
        for (int a = 0; a < 2; ++a)
#pragma unroll
            for (int b = 0; b < 2; ++b)
#pragma unroll
                for (int m = 0; m < 4; ++m)
#pragma unroll
                    for (int n = 0; n < 2; ++n) acc[a][b][m][n] = (f32x4){0.f, 0.f, 0.f, 0.f};
        cur = nxt; cA = nA; cB = nB; ++ui;
        if constexpr (ALIGN_EPI) { if (wr == 1) PG8_BAR; }
    }
    PG8_WAIT_V(0);
    if constexpr (!ALIGN_EPI) { if (wr == 0) PG8_BAR; }
    PG8_BAR;
    if constexpr (Epi::AFTER_DRAIN) { E.fused(acc, cur, wr, wc, fr, fq, lds, wid, lane); S.done(cur); }
#undef PG8_SA
#undef PG8_SB
#undef PG8_STAGE
#undef PG8_LDA
#undef PG8_LDB
#undef PG8_MMA
#undef PG8_WAIT_V
#undef PG8_WAIT_L
#undef PG8_BAR
#undef PG8_SCHED
}
}

#define LAS __attribute__((address_space(3)))
#define GAS __attribute__((address_space(1)))
#define GLD(T, p) (*(const GAS T*)(p))
#define GST(T, p, v) (*(GAS T*)(p) = (v))
typedef unsigned short bf16_t;
typedef short bf16x8 __attribute__((ext_vector_type(8)));
typedef short bf16x4 __attribute__((ext_vector_type(4)));
typedef float f32x4 __attribute__((ext_vector_type(4)));
typedef float f32x16 __attribute__((ext_vector_type(16)));
typedef unsigned u32x4 __attribute__((ext_vector_type(4)));
typedef unsigned u32x2 __attribute__((ext_vector_type(2)));

constexpr int BATCH = 8, SEQ = 4096, DM = 1024, MTOK = BATCH * SEQ, DFF = 2816, DEPTH = 2, NIN = 4888;
constexpr int NTHR = 512, NWAVE = 8;
constexpr float EPS = 1e-6f, LOG2E = 1.4426950408889634f;
constexpr float QSCALE = 0.125f * LOG2E;
constexpr size_t MiB = 1u << 20;
constexpr size_t WS_BIAS = 0;
constexpr size_t WS_PRM = 64 * 1024;
constexpr size_t WS_CB1 = 68 * 1024;
constexpr size_t WS_W13 = 1 * MiB;
constexpr size_t W13_SZ = (size_t)5632 * 1024 * 2;
constexpr size_t WS_W2 = 45 * MiB;
constexpr size_t W2_SZ = (size_t)1024 * 2816 * 2;
constexpr size_t WS_WIN = 68 * MiB;
constexpr size_t WIN_SZ = (size_t)5120 * 1024 * 2;
constexpr size_t WS_PAB = 88 * MiB;
constexpr size_t PAB_SZ = (size_t)2048 * 1024 * 2;
constexpr size_t WS_WO = 96 * MiB;
constexpr size_t WO_SZ = (size_t)1024 * 1024 * 2;
constexpr size_t WS_CW1 = 100 * MiB;
constexpr size_t CW1_SZ = (size_t)128 * 2048 * 2;
constexpr size_t WS_CW2 = 102 * MiB;
constexpr size_t CW2_SZ = (size_t)64 * 128 * 2;
constexpr size_t WS_KCN = 103 * MiB;
constexpr size_t WS_VCT = WS_KCN + 512 * 1024;
constexpr size_t WS_XN = 104 * MiB;
constexpr size_t WS_Z = 168 * MiB;
constexpr size_t Z_DQ = WS_Z, Z_DK = WS_Z + 32 * MiB, Z_DVT = WS_Z + 64 * MiB, Z_NQ = WS_Z + 96 * MiB;
constexpr size_t Z_KCR = WS_Z + 128 * MiB, Z_VCR = WS_Z + 136 * MiB, Z_KSEL = WS_Z + 144 * MiB, Z_VSELT = WS_Z + 152 * MiB;
constexpr size_t Z_KWIN = WS_Z + 160 * MiB, Z_VWINT = WS_Z + 168 * MiB, Z_NG = WS_Z + 176 * MiB, Z_MG = WS_Z + 180 * MiB;
constexpr size_t WS_MERGED = WS_Z;
constexpr size_t WS_HID = WS_Z;
constexpr size_t WS_END = WS_Z + 308 * MiB;
constexpr int LDS_BYTES = 147456;
constexpr int KP = 144, VP = 136;
constexpr int DA_STAGE = 2 * 64 * KP + 128 * VP;
constexpr int NS_STAGE = 64 * KP + 64 * VP;
constexpr int L_BIAS = 73728;
constexpr int TBN = 1216;
constexpr int L_IMP = L_BIAS + 4 * TBN * 4;
constexpr int L_SEL = L_IMP + 16384;
constexpr int L_WSF = L_SEL + 1024;
constexpr int L_END = L_WSF + 8 * 256;

struct Params {
    const float* in[30];
    float* out;
    unsigned char* ws;
};

constexpr int L_PTAB = LDS_BYTES - 1024;
__device__ __forceinline__ const float* ld_ptr(const LAS unsigned char* lds, int i) {
    unsigned a = L_PTAB + 8 * i; asm volatile("" : "+v"(a));
    const LAS unsigned* t = (const LAS unsigned*)(lds + a);
    const unsigned lo = __builtin_amdgcn_readfirstlane(t[0]), hi = __builtin_amdgcn_readfirstlane(t[1]);
    return (const float*)(((unsigned long long)hi << 32) | lo);
}
#define INP(i) ld_ptr(lds, (i))
#define OUTP ((float*)ld_ptr(lds, 30))
#define WSP ((unsigned char*)ld_ptr(lds, 31))

__device__ __forceinline__ unsigned f2bf(float f) { unsigned u = __builtin_bit_cast(unsigned, f); return (u + 0x7fffu + ((u >> 16) & 1u)) >> 16; }
__device__ __forceinline__ unsigned pk2(float lo, float hi) { return f2bf(lo) | (f2bf(hi) << 16); }
__device__ __forceinline__ float sigmoidf_(float x) { return __builtin_amdgcn_rcpf(1.0f + __builtin_amdgcn_exp2f(-x * LOG2E)); }
__device__ __forceinline__ int otid() { int t = threadIdx.x; asm volatile("" : "+v"(t)); return t; }
__device__ __forceinline__ int crow(int r, int hi) { return (r & 3) + 8 * (r >> 2) + 4 * hi; }

struct EpiSwiGLU {
    static constexpr bool PERM = true, AFTER_DRAIN = false;
    bf16_t* H;
    __device__ __forceinline__ void operator()(const f32x4 (&acc)[2][2][4][2], const pg8::Unit& u, int wr, int wc, int fr, int fq) const {
        const int row0 = u.pm * 256 + wr * 64 + fr, col = u.pn * 128 + wc * 32 + 8 * fq;
#pragma unroll
        for (int ai = 0; ai < 2; ++ai)
#pragma unroll
            for (int m = 0; m < 4; ++m) {
                float h[8];
#pragma unroll
                for (int n = 0; n < 2; ++n)
#pragma unroll
                    for (int e = 0; e < 4; ++e) { const float g = acc[ai][0][m][n][e], up = acc[ai][1][m][n][e]; h[n * 4 + e] = g * sigmoidf_(g) * up; }
                u32x4 w; w.x = pg8::cvt_pk_bf16(h[0], h[1]); w.y = pg8::cvt_pk_bf16(h[2], h[3]); w.z = pg8::cvt_pk_bf16(h[4], h[5]); w.w = pg8::cvt_pk_bf16(h[6], h[7]);
                GST(u32x4, H + (size_t)(row0 + ai * 128 + m * 16) * DFF + col, w);
            }
    }
};
struct EpiResid {
    static constexpr bool PERM = false, AFTER_DRAIN = false;
    const float* base; float* out; float alpha;
    __device__ __forceinline__ void operator()(const f32x4 (&acc)[2][2][4][2], const pg8::Unit& u, int wr, int wc, int fr, int fq) const {
        const int row0 = u.pm * 256 + wr * 64 + fr, col0 = u.pn * 256 + wc * 32 + 4 * fq;
#pragma unroll
        for (int ai = 0; ai < 2; ++ai) {
            f32x4 bv[4][2][2];
#pragma unroll
            for (int m = 0; m < 4; ++m) {
                const size_t off = (size_t)(row0 + ai * 128 + m * 16) * DM + col0;
#pragma unroll
                for (int bj = 0; bj < 2; ++bj)
#pragma unroll
                    for (int n = 0; n < 2; ++n) bv[m][bj][n] = GLD(f32x4, base + off + bj * 128 + n * 16);
            }
#pragma unroll
            for (int m = 0; m < 4; ++m) {
                const size_t off = (size_t)(row0 + ai * 128 + m * 16) * DM + col0;
#pragma unroll
                for (int bj = 0; bj < 2; ++bj)
#pragma unroll
                    for (int n = 0; n < 2; ++n) GST(f32x4, out + off + bj * 128 + n * 16, bv[m][bj][n] + acc[ai][bj][m][n] * alpha);
            }
        }
    }
};
struct EpiMerge {
    static constexpr bool PERM = true, AFTER_DRAIN = false;
    const bf16_t* MG; bf16_t* O;
    __device__ __forceinline__ void operator()(const f32x4 (&acc)[2][2][4][2], const pg8::Unit& u, int wr, int wc, int fr, int fq) const {
        const int row0 = u.pm * 256 + wr * 64 + fr, col = u.pn * 128 + wc * 32 + 8 * fq;
#pragma unroll
        for (int ai = 0; ai < 2; ++ai) {
            u32x4 g0[4], g1[4];
#pragma unroll
            for (int m = 0; m < 4; ++m) { const int row = row0 + ai * 128 + m * 16; g0[m] = GLD(u32x4, MG + (size_t)row * 2048 + col); g1[m] = GLD(u32x4, MG + (size_t)row * 2048 + 1024 + col); }
#pragma unroll
            for (int m = 0; m < 4; ++m) {
                const int row = row0 + ai * 128 + m * 16;
                float h[8];
#pragma unroll
                for (int i = 0; i < 8; ++i) {
                    const unsigned w0 = g0[m][i >> 1], w1 = g1[m][i >> 1];
                    const float a0 = __builtin_bit_cast(float, (i & 1) ? (w0 & 0xffff0000u) : (w0 << 16)), a1 = __builtin_bit_cast(float, (i & 1) ? (w1 & 0xffff0000u) : (w1 << 16));
                    h[i] = a0 * acc[ai][0][m][i >> 2][i & 3] + a1 * acc[ai][1][m][i >> 2][i & 3];
                }
                u32x4 w; w.x = pg8::cvt_pk_bf16(h[0], h[1]); w.y = pg8::cvt_pk_bf16(h[2], h[3]); w.z = pg8::cvt_pk_bf16(h[4], h[5]); w.w = pg8::cvt_pk_bf16(h[6], h[7]);
                GST(u32x4, O + (size_t)row * DM + col, w);
            }
        }
    }
};
struct EpiZ {
    static constexpr bool PERM = true, AFTER_DRAIN = false;
    unsigned char* ws; const float *gq, *gk, *gnq, *gnk;
    __device__ __forceinline__ void operator()(const f32x4 (&acc)[2][2][4][2], const pg8::Unit& u, int wr, int wc, int fr, int fq) const {
        const int ch = 4 * u.pn + wc;
        if (ch >= 77) return;
        const int row0 = u.pm * 256 + wr * 64 + fr;
        int kind, nh = 8, hd = 0, nd = 64, dbase = 0; size_t dst = 0; const float* gain = nullptr; float scale = 1.f;
        if (ch < 8) { kind = 0; dst = Z_DQ; hd = ch; gain = gq; scale = QSCALE; }
        else if (ch < 16) { kind = 0; dst = Z_DK; hd = ch - 8; gain = gk; }
        else if (ch < 24) { kind = 2; dst = Z_DVT; nh = 4; hd = (ch - 16) >> 1; nd = 128; dbase = ((ch - 16) & 1) * 64; }
        else if (ch < 32) { kind = 0; dst = Z_NQ; hd = ch - 24; gain = gnq; scale = QSCALE; }
        else if (ch < 34) { kind = 1; dst = Z_KCR; nh = 2; hd = ch - 32; }
        else if (ch < 36) { kind = 1; dst = Z_VCR; nh = 2; hd = ch - 34; }
        else if (ch < 38) { kind = 0; dst = Z_KSEL; nh = 2; hd = ch - 36; gain = gnk + 64; }
        else if (ch < 40) { kind = 2; dst = Z_VSELT; nh = 2; hd = ch - 38; }
        else if (ch < 42) { kind = 0; dst = Z_KWIN; nh = 2; hd = ch - 40; gain = gnk + 128; }
        else if (ch < 44) { kind = 2; dst = Z_VWINT; nh = 2; hd = ch - 42; }
        else if (ch < 76) { kind = 3; }
        else { kind = 4; }
        if (kind == 0 || kind == 1) {
            float gv[16];
#pragma unroll
            for (int i = 0; i < 16; ++i) gv[i] = (kind == 0) ? gain[(i >> 3) * 32 + 8 * fq + (i & 7)] * scale : 1.f;
#pragma unroll
            for (int ai = 0; ai < 2; ++ai)
#pragma unroll
                for (int m = 0; m < 4; ++m) {
                    const int row = row0 + ai * 128 + m * 16, b = row >> 12, s = row & 4095;
                    float v[16];
#pragma unroll
                    for (int i = 0; i < 16; ++i) v[i] = acc[ai][i >> 3][m][(i >> 2) & 1][i & 3];
                    float rs = 1.f;
                    if (kind == 0) {
                        float ss = 0.f;
#pragma unroll
                        for (int i = 0; i < 16; ++i) ss += v[i] * v[i];
                        ss += __shfl_xor(ss, 16); ss += __shfl_xor(ss, 32);
                        rs = __builtin_amdgcn_rsqf(ss * (1.f / 64.f) + EPS);
                    }
#pragma unroll
                    for (int i = 0; i < 16; ++i) v[i] *= rs * gv[i];
                    bf16_t* d = (bf16_t*)(ws + dst) + ((size_t)(b * nh + hd) * SEQ + s) * 64 + 8 * fq;
                    u32x4 w0, w1;
                    w0.x = pg8::cvt_pk_bf16(v[0], v[1]); w0.y = pg8::cvt_pk_bf16(v[2], v[3]); w0.z = pg8::cvt_pk_bf16(v[4], v[5]); w0.w = pg8::cvt_pk_bf16(v[6], v[7]);
                    w1.x = pg8::cvt_pk_bf16(v[8], v[9]); w1.y = pg8::cvt_pk_bf16(v[10], v[11]); w1.z = pg8::cvt_pk_bf16(v[12], v[13]); w1.w = pg8::cvt_pk_bf16(v[14], v[15]);
                    GST(u32x4, d, w0); GST(u32x4, d + 32, w1);
                }
        } else if (kind == 2) {
#pragma unroll
            for (int ai = 0; ai < 2; ++ai)
#pragma unroll
                for (int m = 0; m < 4; ++m) {
                    const int row = row0 + ai * 128 + m * 16, b = row >> 12, s = row & 4095;
                    bf16_t* d = (bf16_t*)(ws + dst) + ((size_t)(b * nh + hd) * nd + dbase + 8 * fq) * SEQ + s;
#pragma unroll
                    for (int i = 0; i < 16; ++i) GST(bf16_t, d + (size_t)((i >> 3) * 32 + (i & 7)) * SEQ, (bf16_t)f2bf(acc[ai][i >> 3][m][(i >> 2) & 1][i & 3]));
                }
        } else if (kind == 3) {
            const int col = (ch - 44) * 64 + 8 * fq;
#pragma unroll
            for (int ai = 0; ai < 2; ++ai)
#pragma unroll
                for (int m = 0; m < 4; ++m) {
                    const int row = row0 + ai * 128 + m * 16;
                    float v[16];
#pragma unroll
                    for (int i = 0; i < 16; ++i) v[i] = sigmoidf_(acc[ai][i >> 3][m][(i >> 2) & 1][i & 3]);
                    bf16_t* d = (bf16_t*)(ws + Z_MG) + (size_t)row * 2048 + col;
                    u32x4 w0, w1;
                    w0.x = pg8::cvt_pk_bf16(v[0], v[1]); w0.y = pg8::cvt_pk_bf16(v[2], v[3]); w0.z = pg8::cvt_pk_bf16(v[4], v[5]); w0.w = pg8::cvt_pk_bf16(v[6], v[7]);
                    w1.x = pg8::cvt_pk_bf16(v[8], v[9]); w1.y = pg8::cvt_pk_bf16(v[10], v[11]); w1.z = pg8::cvt_pk_bf16(v[12], v[13]); w1.w = pg8::cvt_pk_bf16(v[14], v[15]);
                    GST(u32x4, d, w0); GST(u32x4, d + 32, w1);
                }
        } else {
            if (fq < 3) {
#pragma unroll
                for (int ai = 0; ai < 2; ++ai)
#pragma unroll
                    for (int m = 0; m < 4; ++m) {
                        const int row = row0 + ai * 128 + m * 16;
                        float* d = (float*)(ws + Z_NG) + (size_t)row * 24 + 8 * fq;
#pragma unroll
                        for (int i = 0; i < 8; ++i) GST(float, d + i, sigmoidf_(acc[ai][0][m][i >> 2][i & 3]));
                    }
            }
        }
    }
};

__device__ __forceinline__ void tr_item(const float* src, int ld, int c0, int nvalid, int k0, bf16_t* dst, int Kdst, LAS float* scr, int lane) {
    const int n = lane & 31;
#pragma unroll
    for (int i = 0; i < 32; ++i) { const int kk = 2 * i + (lane >> 5); scr[kk * 33 + n] = (src && n < nvalid) ? GLD(float, src + (size_t)(k0 + kk) * ld + c0 + n) : 0.f; }
    asm volatile("s_waitcnt lgkmcnt(0)" ::: "memory");
    const int c = lane & 7;
#pragma unroll
    for (int j = 0; j < 4; ++j) { const int nn = (lane >> 3) + 8 * j; const LAS float* s = scr + (8 * c) * 33 + nn;
        u32x4 o; o.x = pk2(s[0 * 33], s[1 * 33]); o.y = pk2(s[2 * 33], s[3 * 33]); o.z = pk2(s[4 * 33], s[5 * 33]); o.w = pk2(s[6 * 33], s[7 * 33]);
        GST(u32x4, dst + (size_t)nn * Kdst + 8 * c, o); }
    asm volatile("s_waitcnt lgkmcnt(0)" ::: "memory");
}
__device__ __forceinline__ int zchunk_src(int ch) {
    if (ch < 32) return ch * 64;
    if (ch < 44) return 2048 + (ch - 32) * 64;
    if (ch < 76) return 2840 + (ch - 44) * 64;
    return 2816;
}
__device__ __forceinline__ int t5_bucket(int n) {
    if (n < 16) return n;
    int b = 16;
    b += (n >= 21); b += (n >= 27); b += (n >= 35); b += (n >= 46); b += (n >= 59); b += (n >= 77); b += (n >= 99); b += (n >= 128);
    b += (n >= 166); b += (n >= 216); b += (n >= 280); b += (n >= 363); b += (n >= 470); b += (n >= 609); b += (n >= 790);
    return b;
}
__device__ __forceinline__ void prologue(const Params& P, LAS unsigned char* lds) {
    const int tid = otid(), lane = tid & 63, wave = tid >> 6;
    LAS float* scr = (LAS float*)(lds + wave * 16384);
    const int gw = blockIdx.x * NWAVE + wave, NGW = gridDim.x * NWAVE;
    unsigned char* ws = WSP;
    constexpr int I13 = 176 * 16, I2 = 32 * 44, IIN = 160 * 16, IPAB = 64 * 16, IWO = 32 * 16, IC1 = 4 * 32, IC2 = 2 * 2;
    constexpr int PER_L = 2 * I13 + 2 * I2 + IIN + IPAB + IWO + 2 * IC1 + 2 * IC2;
    for (int it = gw; it < DEPTH * PER_L; it += NGW) {
        const int l = it / PER_L; int r = it % PER_L;
        if (r < 2 * I13) {
            const int f = r / I13; r %= I13; const int gi = r / 16, kb = r % 16;
            const int t = gi >> 3, bj = (gi >> 2) & 1, sub = gi & 3;
            const float* src = (f ? (bj ? INP(12) : INP(11)) : (bj ? INP(9) : INP(8))) + (size_t)l * DM * DFF;
            tr_item(src, DFF, 128 * t + 32 * sub, 32, 64 * kb, (bf16_t*)(ws + WS_W13 + (size_t)(l * 2 + f) * W13_SZ) + (size_t)(32 * gi) * DM + 64 * kb, DM, scr, lane);
            continue;
        }
        r -= 2 * I13;
        if (r < 2 * I2) {
            const int f = r / I2; r %= I2; const int gi = r / 44, kb = r % 44;
            const float* src = (f ? INP(13) : INP(10)) + (size_t)l * DFF * DM;
            tr_item(src, DM, 32 * gi, 32, 64 * kb, (bf16_t*)(ws + WS_W2 + (size_t)(l * 2 + f) * W2_SZ) + (size_t)(32 * gi) * DFF + 64 * kb, DFF, scr, lane);
            continue;
        }
        r -= 2 * I2;
        if (r < IIN) {
            const int gi = r / 16, kb = r % 16;
            const int t = gi >> 3, bj = (gi >> 2) & 1, wc = gi & 3, ch = 4 * t + wc;
            int nvalid = 32; if (ch == 76) nvalid = bj ? 0 : 24; if (ch > 76) nvalid = 0;
            const float* src = nvalid ? INP(1) + (size_t)l * DM * NIN : nullptr;
            tr_item(src, NIN, zchunk_src(ch) + 32 * bj, nvalid, 64 * kb, (bf16_t*)(ws + WS_WIN + (size_t)l * WIN_SZ) + (size_t)(32 * gi) * DM + 64 * kb, DM, scr, lane);
            continue;
        }
        r -= IIN;
        if (r < IPAB) {
            const int gi = r / 16, kb = r % 16;
            const int t = gi >> 3, bj = (gi >> 2) & 1, sub = gi & 3;
            const float* src = nullptr; int k0 = 0;
            if (bj == 0 && kb < 8) { src = INP(2) + (size_t)l * 512 * DM; k0 = 64 * kb; }
            if (bj == 1 && kb >= 8) { src = INP(3) + (size_t)l * 512 * DM; k0 = 64 * (kb - 8); }
            tr_item(src, DM, 128 * t + 32 * sub, 32, k0, (bf16_t*)(ws + WS_PAB + (size_t)l * PAB_SZ) + (size_t)(32 * gi) * DM + 64 * kb, DM, scr, lane);
            continue;
        }
        r -= IPAB;
        if (r < IWO) {
            const int gi = r / 16, kb = r % 16;
            tr_item(INP(4) + (size_t)l * DM * DM, DM, 32 * gi, 32, 64 * kb, (bf16_t*)(ws + WS_WO + (size_t)l * WO_SZ) + (size_t)(32 * gi) * DM + 64 * kb, DM, scr, lane);
            continue;
        }
        r -= IWO;
        if (r < 2 * IC1) {
            const int kv = r / IC1; r %= IC1; const int gi = r / 32, kb = r % 32;
            tr_item((kv ? INP(27) : INP(24)) + (size_t)l * 2048 * 128, 128, 32 * gi, 32, 64 * kb, (bf16_t*)(ws + WS_CW1 + (size_t)(l * 2 + kv) * CW1_SZ) + (size_t)(32 * gi) * 2048 + 64 * kb, 2048, scr, lane);
            continue;
        }
        r -= 2 * IC1;
        {
            const int kv = r / IC2; r %= IC2; const int gi = r / 2, kb = r % 2;
            tr_item((kv ? INP(28) : INP(25)) + (size_t)l * 128 * 64, 64, 32 * gi, 32, 64 * kb, (bf16_t*)(ws + WS_CW2 + (size_t)(l * 2 + kv) * CW2_SZ) + (size_t)(32 * gi) * 128 + 64 * kb, 128, scr, lane);
        }
    }
    const int gt = blockIdx.x * NTHR + tid, NGT = gridDim.x * NTHR;
    for (int i = gt; i < 12 * 1024; i += NGT) { const int h = i >> 10, d = i & 1023; ((float*)(ws + WS_BIAS))[i] = INP(29)[t5_bucket(d) * 12 + h] * LOG2E; }
    if (blockIdx.x == (gridDim.x > 1 ? 1 : 0) && wave < DEPTH) {
        const int l = wave;
        float a = INP(16)[l * 64 + lane] * INP(17)[l * 64 + lane], b = INP(18)[l * 64 + lane] * INP(19)[l * 64 + lane];
        float mq = fabsf(INP(14)[l * 64 + lane]), mk = fabsf(INP(15)[l * 64 + lane]), mnq = fabsf(INP(21)[l * 64 + lane]);
        float mnk = fmaxf(fmaxf(fabsf(INP(22)[l * 192 + lane]), fabsf(INP(22)[l * 192 + 64 + lane])), fabsf(INP(22)[l * 192 + 128 + lane]));
        float mb = 0.f; for (int i = lane; i < 32 * 12; i += 64) mb = fmaxf(mb, fabsf(INP(29)[i]));
#pragma unroll
        for (int o = 1; o < 64; o <<= 1) { a += __shfl_xor(a, o); b += __shfl_xor(b, o); mq = fmaxf(mq, __shfl_xor(mq, o)); mk = fmaxf(mk, __shfl_xor(mk, o)); mnq = fmaxf(mnq, __shfl_xor(mnq, o)); mnk = fmaxf(mnk, __shfl_xor(mnk, o)); mb = fmaxf(mb, __shfl_xor(mb, o)); }
        if (lane == 0) {
            float* prm = (float*)(ws + WS_PRM) + l * 8;
            const float lam_init = 0.8f - 0.6f * expf(-0.3f * (float)l);
            prm[0] = expf(a) - expf(b) + lam_init;
            prm[1] = (8.f * mq * mk * 1.02f + mb) * LOG2E;
            prm[2] = (8.f * mnq * mnk * 1.02f + mb) * LOG2E;
            prm[3] = 1.0f - lam_init;
        }
    }
    for (int wi = blockIdx.x; wi < 32; wi += gridDim.x) {
        const int lk = wi >> 3, n = (wi & 7) * 16 + (tid & 15), ks = tid >> 4, l = lk >> 1, kv = lk & 1;
        const float* pe = (kv ? INP(26) : INP(23)) + (size_t)l * 2048; const float* w1 = (kv ? INP(27) : INP(24)) + (size_t)l * 2048 * 128;
        float sacc = 0.f;
#pragma unroll 16
        for (int k = 64 * ks; k < 64 * ks + 64; ++k) sacc += GLD(float, pe + k) * GLD(float, w1 + (size_t)k * 128 + n);
        LAS float* red = (LAS float*)lds;
        __syncthreads();
        red[tid] = sacc;
        __syncthreads();
        if (tid < 16) { float t = 0.f; for (int i = 0; i < 32; ++i) t += red[i * 16 + tid]; ((float*)(ws + WS_CB1))[lk * 128 + (wi & 7) * 16 + tid] = t; }
        __syncthreads();
    }
}

__device__ __forceinline__ void rmsnorm_phase(const float* x, const float* g, bf16_t* o) {
    const int tid = otid(), lane = tid & 63, wave = tid >> 6;
    const int gw = blockIdx.x * NWAVE + wave, NGW = gridDim.x * NWAVE;
    f32x4 gv[4];
#pragma unroll
    for (int j = 0; j < 4; ++j) gv[j] = GLD(f32x4, (const f32x4*)g + lane + 64 * j);
    constexpr int RB = 4;
    for (int m0 = gw; m0 < MTOK; m0 += NGW * RB) {
        f32x4 v[RB][4]; float s[RB];
#pragma unroll
        for (int r = 0; r < RB; ++r) { const int m = m0 + r * NGW; const f32x4* xr = (const f32x4*)(x + (size_t)(m < MTOK ? m : m0) * DM) + lane;
#pragma unroll
            for (int j = 0; j < 4; ++j) v[r][j] = GLD(f32x4, xr + 64 * j); }
#pragma unroll
        for (int r = 0; r < RB; ++r) { s[r] = 0.f;
#pragma unroll
            for (int j = 0; j < 4; ++j) s[r] += (v[r][j].x * v[r][j].x + v[r][j].y * v[r][j].y) + (v[r][j].z * v[r][j].z + v[r][j].w * v[r][j].w); }
#pragma unroll
        for (int of = 1; of < 64; of <<= 1) {
#pragma unroll
            for (int r = 0; r < RB; ++r) s[r] += __shfl_xor(s[r], of); }
#pragma unroll
        for (int r = 0; r < RB; ++r) { const int m = m0 + r * NGW;
            if (m < MTOK) {
                const float rs = __builtin_amdgcn_rsqf(s[r] * (1.f / DM) + EPS);
                u32x2* o8 = (u32x2*)(o + (size_t)m * DM) + lane;
#pragma unroll
                for (int j = 0; j < 4; ++j) { u32x2 w; w.x = pk2(v[r][j].x * rs * gv[j].x, v[r][j].y * rs * gv[j].y); w.y = pk2(v[r][j].z * rs * gv[j].z, v[r][j].w * rs * gv[j].w); GST(u32x2, o8 + 64 * j, w); }
            }
        }
    }
}

__device__ __forceinline__ float gelu_tanh(float x) {
    const float y = 0.7978845608028654f * (x + 0.044715f * x * x * x);
    const float e = __builtin_amdgcn_exp2f(2.f * LOG2E * y);
    const float t = 1.f - 2.f * __builtin_amdgcn_rcpf(e + 1.f);
    return 0.5f * x * (1.f + t);
}
__device__ __forceinline__ void compress_phase(const Params& P, int l, LAS unsigned char* lds) {
    const int tid = otid(), lane = tid & 63, wave = tid >> 6, fr = lane & 15, kq = lane >> 4;
    unsigned char* ws = WSP;
    LAS bf16_t* Hs = (LAS bf16_t*)lds;
    LAS float* Os = (LAS float*)(lds + 8192);
    for (int unit = blockIdx.x; unit < 2 * 16 * 16; unit += gridDim.x) {
        const int kv = unit >> 8, bg = (unit >> 4) & 15, cblk = unit & 15, c0 = 16 * cblk;
        const bf16_t* src = (const bf16_t*)(ws + (kv ? Z_VCR : Z_KCR)) + (size_t)bg * SEQ * 64;
        const int crow_ = (c0 + fr) < 255 ? (c0 + fr) : 254;
        const bf16_t* ap = src + (size_t)1024 * crow_ + 8 * kq;
        const bf16_t* bp = (const bf16_t*)(ws + WS_CW1 + (size_t)(l * 2 + kv) * CW1_SZ) + (size_t)(16 * wave + fr) * 2048 + 8 * kq;
        f32x4 acc = {0.f, 0.f, 0.f, 0.f};
#pragma unroll 8
        for (int kk = 0; kk < 64; ++kk) { const bf16x8 a = GLD(bf16x8, ap + 32 * kk), b = GLD(bf16x8, bp + 32 * kk); acc = __builtin_amdgcn_mfma_f32_16x16x32_bf16(a, b, acc, 0, 0, 0); }
        const float cb = ((const float*)(ws + WS_CB1))[(l * 2 + kv) * 128 + 16 * wave + fr];
#pragma unroll
        for (int i = 0; i < 4; ++i) Hs[(4 * kq + i) * 136 + 16 * wave + fr] = (bf16_t)f2bf(gelu_tanh(acc[i] + cb));
        __syncthreads();
        if (wave < 4) {
            const bf16_t* b2 = (const bf16_t*)(ws + WS_CW2 + (size_t)(l * 2 + kv) * CW2_SZ) + (size_t)(16 * wave + fr) * 128 + 8 * kq;
            f32x4 a2 = {0.f, 0.f, 0.f, 0.f};
#pragma unroll
            for (int kk = 0; kk < 4; ++kk) { const bf16x8 a = *(const LAS bf16x8*)(Hs + fr * 136 + 32 * kk + 8 * kq), b = *(const bf16x8*)(b2 + 32 * kk); a2 = __builtin_amdgcn_mfma_f32_16x16x32_bf16(a, b, a2, 0, 0, 0); }
#pragma unroll
            for (int i = 0; i < 4; ++i) Os[(4 * kq + i) * 65 + 16 * wave + fr] = a2[i];
        }
        __syncthreads();
#pragma unroll
        for (int rep = 0; rep < 2; ++rep) {
            const int e = tid + NTHR * rep, row = e >> 6, d = e & 63, c = c0 + row;
            const float val = Os[row * 65 + d];
            if (kv == 0) {
                float ss = 0.f;
                for (int j = 0; j < 64; ++j) { const float t = Os[row * 65 + j]; ss += t * t; }
                const float o = val * __builtin_amdgcn_rsqf(ss * (1.f / 64.f) + EPS) * INP(22)[l * 192 + d];
                ((bf16_t*)(ws + WS_KCN))[((size_t)bg * 256 + c) * 64 + d] = (c < 255) ? (bf16_t)f2bf(o) : (bf16_t)0;
            } else {
                ((bf16_t*)(ws + WS_VCT))[((size_t)bg * 64 + d) * 256 + c] = (c < 255) ? (bf16_t)f2bf(val) : (bf16_t)0;
            }
        }
        __syncthreads();
    }
}

__device__ __forceinline__ void qk_tile(f32x16& p0, f32x16& p1, const LAS unsigned char* Kl, const bf16x8 (&qf)[4], int r32, int hi) {
    const LAS unsigned char* kb = Kl + r32 * KP + hi * 16;
    bf16x8 a[8];
#pragma unroll
    for (int d0 = 0; d0 < 4; ++d0) { a[2 * d0] = *(const LAS bf16x8*)(kb + d0 * 32); a[2 * d0 + 1] = *(const LAS bf16x8*)(kb + 32 * KP + d0 * 32); }
    __builtin_amdgcn_s_setprio(1);
#pragma unroll
    for (int d0 = 0; d0 < 4; ++d0) {
        p0 = __builtin_amdgcn_mfma_f32_32x32x16_bf16(a[2 * d0], qf[d0], p0, 0, 0, 0);
        p1 = __builtin_amdgcn_mfma_f32_32x32x16_bf16(a[2 * d0 + 1], qf[d0], p1, 0, 0, 0);
    }
    __builtin_amdgcn_s_setprio(0);
}
template <int STRIDE, bool WINDOW, int MODE>
__device__ __forceinline__ void score_exp(f32x16& p0, f32x16& p1, int dl, const LAS float* tb, float cfar, bool rowsel) {
    const LAS float* tl = tb + 128 + (dl < 1087 ? dl : 1087) - 59;
#pragma unroll
    for (int blk = 0; blk < 2; ++blk) {
        f32x16& p = blk ? p1 : p0;
#pragma unroll
        for (int r = 0; r < 16; ++r) {
            const int c = (r & 3) + 8 * (r >> 2) + 32 * blk;
            const int dist = dl - STRIDE * c;
            float e;
            if (MODE == 0) e = __builtin_amdgcn_exp2f(p[r] + cfar);
            else {
                float bias;
                if (STRIDE == 1) bias = tl[59 - c];
                else bias = tb[128 + min((unsigned)dist, 1023u)];
                e = __builtin_amdgcn_exp2f(p[r] + bias);
                if (MODE == 2) { bool valid = dist >= 0; if (WINDOW) valid = valid && (dist < 512); e = valid ? e : 0.f; }
            }
            p[r] = rowsel ? e : 0.f;
        }
    }
}
template <int STRIDE, bool WINDOW>
__device__ __forceinline__ void score_exp_sel(f32x16& p0, f32x16& p1, int dl, const LAS float* tb, float cfar, bool rowsel, int dmin, int dmax) {
    if (!WINDOW && dmin >= 790) score_exp<STRIDE, WINDOW, 0>(p0, p1, dl, tb, cfar, rowsel);
    else if (dmin >= 0 && (!WINDOW || dmax < 512)) score_exp<STRIDE, WINDOW, 1>(p0, p1, dl, tb, cfar, rowsel);
    else score_exp<STRIDE, WINDOW, 2>(p0, p1, dl, tb, cfar, rowsel);
}
__device__ __forceinline__ float sum32(const f32x16& p0, const f32x16& p1) {
    float a = 0.f, b = 0.f;
#pragma unroll
    for (int r = 0; r < 16; ++r) { a += p0[r]; b += p1[r]; }
    return a + b;
}
template <int NDB>
__device__ __forceinline__ void pv_tile(f32x16 (&o)[NDB], const f32x16& p0, const f32x16& p1, const LAS unsigned char* Vl, int r32, int hi) {
    const LAS unsigned char* vbase = Vl + r32 * VP + hi * 8;
    bf16x4 vf[2][NDB][2];
#define PV_LOAD(st, buf) do { _Pragma("unroll") for (int db = 0; db < NDB; ++db) { const LAS unsigned char* vp = vbase + db * 32 * VP + (st) * 32; vf[buf][db][0] = *(const LAS bf16x4*)vp; vf[buf][db][1] = *(const LAS bf16x4*)(vp + 16); } } while (0)
    PV_LOAD(0, 0);
#pragma unroll
    for (int st = 0; st < 4; ++st) {
        if (st + 1 < 4) PV_LOAD(st + 1, (st + 1) & 1);
        const f32x16& p = (st >> 1) ? p1 : p0; const int s8 = 8 * (st & 1);
        u32x4 w; w.x = pg8::cvt_pk_bf16(p[s8 + 0], p[s8 + 1]); w.y = pg8::cvt_pk_bf16(p[s8 + 2], p[s8 + 3]); w.z = pg8::cvt_pk_bf16(p[s8 + 4], p[s8 + 5]); w.w = pg8::cvt_pk_bf16(p[s8 + 6], p[s8 + 7]);
        const bf16x8 pa = __builtin_bit_cast(bf16x8, w);
        __builtin_amdgcn_s_setprio(1);
#pragma unroll
        for (int db = 0; db < NDB; ++db) {
            const bf16x4 lo = vf[st & 1][db][0], hi4 = vf[st & 1][db][1];
            const bf16x8 vb = {lo[0], lo[1], lo[2], lo[3], hi4[0], hi4[1], hi4[2], hi4[3]};
            o[db] = __builtin_amdgcn_mfma_f32_32x32x16_bf16(pa, vb, o[db], 0, 0, 0);
        }
        __builtin_amdgcn_s_setprio(0);
    }
#undef PV_LOAD
}
__device__ __forceinline__ u32x4 ldk(const bf16_t* g, int tid) { return GLD(u32x4, (const unsigned char*)g + tid * 16); }
__device__ __forceinline__ void stk(LAS unsigned char* Kl, u32x4 v, int tid) { *(LAS u32x4*)(Kl + (tid >> 3) * KP + (tid & 7) * 16) = v; }
__device__ __forceinline__ u32x4 ldv(const bf16_t* g, size_t rs, int row, int tid) { return GLD(u32x4, (const unsigned char*)(g + (size_t)row * rs) + (tid & 7) * 16); }
__device__ __forceinline__ void stv(LAS unsigned char* Vl, u32x4 v, int row, int tid) { LAS unsigned char* p = Vl + row * VP + (tid & 7) * 16; *(LAS u32x2*)p = (u32x2){v.x, v.y}; *(LAS u32x2*)(p + 8) = (u32x2){v.z, v.w}; }

__device__ __forceinline__ void da_unit(const Params& P, int l, int b, int h, int qb, LAS unsigned char* lds, bool load_tab) {
    const int tid = otid(), lane = tid & 63, wave = __builtin_amdgcn_readfirstlane(tid >> 6), r32 = lane & 31, hi = lane >> 5;
    const int c = wave >> 2, qsub = wave & 3, q0 = qb * 128, qw0 = q0 + 32 * qsub;
    unsigned char* ws = WSP;
    const float* prm = (const float*)(ws + WS_PRM) + l * 8;
    const float lam = prm[0], Mb = prm[1], onem = prm[3];
    LAS float* biasL = (LAS float*)(lds + L_BIAS);
    const float* bg = (const float*)(ws + WS_BIAS) + h * 1024;
    if (load_tab) for (int i = tid; i < TBN; i += NTHR) { const int d = i - 128; biasL[i] = GLD(float, bg + (d < 0 ? 0 : (d > 1023 ? 1023 : d))) - Mb; }
    const float cfar = bg[1023] - Mb;
    const bf16_t* Qp = (const bf16_t*)(ws + Z_DQ) + ((size_t)(b * 8 + h * 2 + c) * SEQ + qw0 + r32) * 64 + hi * 8;
    bf16x8 qf[4];
#pragma unroll
    for (int d0 = 0; d0 < 4; ++d0) qf[d0] = GLD(bf16x8, Qp + d0 * 16);
    const bf16_t* K1g = (const bf16_t*)(ws + Z_DK) + (size_t)(b * 8 + h * 2) * SEQ * 64;
    const bf16_t* K2g = K1g + (size_t)SEQ * 64;
    const bf16_t* Vg = (const bf16_t*)(ws + Z_DVT) + (size_t)(b * 4 + h) * 128 * SEQ;
    const int NT = (q0 + 128) / 64;
    f32x16 o[4];
#pragma unroll
    for (int i = 0; i < 4; ++i) o[i] = (f32x16){};
    float lsum = 0.f;
    u32x4 rk1, rk2, rv0, rv1;
#define DA_LOAD(t) do { rk1 = ldk(K1g + (size_t)(t) * 4096, tid); rk2 = ldk(K2g + (size_t)(t) * 4096, tid); rv0 = ldv(Vg + (t) * 64, SEQ, tid >> 3, tid); rv1 = ldv(Vg + (t) * 64, SEQ, 64 + (tid >> 3), tid); } while (0)
#define DA_STORE(sb) do { LAS unsigned char* st_ = lds + (sb) * DA_STAGE; stk(st_, rk1, tid); stk(st_ + 64 * KP, rk2, tid); stv(st_ + 128 * KP, rv0, tid >> 3, tid); stv(st_ + 128 * KP, rv1, 64 + (tid >> 3), tid); } while (0)
    DA_LOAD(0); DA_STORE(0);
    __syncthreads();
    for (int t = 0; t < NT; ++t) {
        if (t + 1 < NT) DA_LOAD(t + 1);
        if (64 * t <= qw0 + 31) {
            const LAS unsigned char* st = lds + (t & 1) * DA_STAGE;
            f32x16 p0 = (f32x16){}, p1 = (f32x16){};
            qk_tile(p0, p1, st + c * 64 * KP, qf, r32, hi);
            const int dl = qw0 + r32 - 64 * t - 4 * hi;
            score_exp_sel<1, false>(p0, p1, dl, biasL, cfar, true, qw0 - (64 * t + 63), qw0 + 31 - 64 * t);
            lsum += sum32(p0, p1);
            pv_tile<4>(o, p0, p1, st + 128 * KP, r32, hi);
        }
        if (t + 1 < NT) DA_STORE((t + 1) & 1);
        __syncthreads();
    }
#undef DA_LOAD
#undef DA_STORE
    lsum += __shfl_xor(lsum, 32);
    LAS float* wsf = (LAS float*)(lds + L_WSF) + wave * 64;
    if (hi == 0) wsf[r32] = (lsum > 0.f) ? 1.0f / lsum : 0.f;
    asm volatile("s_waitcnt lgkmcnt(0)" ::: "memory");
    float li[16];
#pragma unroll
    for (int r = 0; r < 16; ++r) li[r] = wsf[crow(r, hi)];
    LAS float* X = (LAS float*)lds;
    if (c == 1) {
#pragma unroll
        for (int db = 0; db < 4; ++db)
#pragma unroll
            for (int r = 0; r < 16; ++r) X[(32 * qsub + crow(r, hi)) * 132 + r32 + 32 * db] = o[db][r] * li[r];
    }
    __syncthreads();
    if (c == 0) {
        const float* sg = INP(20) + l * 128;
        float gsub[4];
#pragma unroll
        for (int db = 0; db < 4; ++db) gsub[db] = sg[r32 + 32 * db] * onem;
#pragma unroll
        for (int r = 0; r < 16; ++r) {
            float y[4], ss = 0.f;
#pragma unroll
            for (int db = 0; db < 4; ++db) { y[db] = o[db][r] * li[r] - lam * X[(32 * qsub + crow(r, hi)) * 132 + r32 + 32 * db]; ss += y[db] * y[db]; }
            ss += __shfl_xor(ss, 1); ss += __shfl_xor(ss, 2); ss += __shfl_xor(ss, 4); ss += __shfl_xor(ss, 8); ss += __shfl_xor(ss, 16);
            const float rs = __builtin_amdgcn_rsqf(ss * (1.f / 128.f) + EPS);
            bf16_t* d = (bf16_t*)(ws + WS_XN) + (size_t)(b * SEQ + qw0 + crow(r, hi)) * DM + h * 128 + r32;
#pragma unroll
            for (int db = 0; db < 4; ++db) GST(bf16_t, d + 32 * db, (bf16_t)f2bf(y[db] * rs * gsub[db]));
        }
    }
    __syncthreads();
}

__device__ __forceinline__ void nsa_unit(const Params& P, int l, int b, int g, int u, LAS unsigned char* lds, bool load_tab) {
    const int tid = otid(), lane = tid & 63, wave = __builtin_amdgcn_readfirstlane(tid >> 6), r32 = lane & 31, hi = lane >> 5;
    const int qi = r32 >> 2, p = r32 & 3, qw0 = 64 * u + 8 * wave, qpos = qw0 + qi, head = g * 4 + p;
    unsigned char* ws = WSP;
    const float Mb = ((const float*)(ws + WS_PRM))[l * 8 + 2];
    LAS float* biasL = (LAS float*)(lds + L_BIAS);
    LAS float* imp = (LAS float*)(lds + L_IMP);
    LAS unsigned* selw = (LAS unsigned*)(lds + L_SEL);
    LAS float* wsf = (LAS float*)(lds + L_WSF) + wave * 64;
    const float* bgl = (const float*)(ws + WS_BIAS) + (size_t)(4 + g * 4) * 1024;
    if (load_tab) for (int i = tid; i < 4 * TBN; i += NTHR) { const int hh = i / TBN, d = i % TBN - 128; biasL[i] = GLD(float, bgl + hh * 1024 + (d < 0 ? 0 : (d > 1023 ? 1023 : d))) - Mb; }
    if (tid == 0) { unsigned z = 0u; asm volatile("" : "+v"(z)); selw[128] = z; selw[129] = z; }
    const LAS float* tb = biasL + p * TBN;
    const float cfar = bgl[p * 1024 + 1023] - Mb;
    const bf16_t* Qp = (const bf16_t*)(ws + Z_NQ) + ((size_t)(b * 8 + head) * SEQ + qpos) * 64 + hi * 8;
    bf16x8 qf[4];
#pragma unroll
    for (int d0 = 0; d0 < 4; ++d0) qf[d0] = GLD(bf16x8, Qp + d0 * 16);
    const float* ngp = (const float*)(ws + Z_NG) + (size_t)(b * SEQ + qpos) * 24 + head * 3;
    const float gate_c = GLD(float, ngp), gate_s = GLD(float, ngp + 1), gate_w = GLD(float, ngp + 2);
    f32x16 oc[2]; oc[0] = (f32x16){}; oc[1] = (f32x16){};
    f32x16 o[2];
    u32x4 rk, rv;
    const int bgi = b * 2 + g;
#define NS_STORE(sb) do { LAS unsigned char* st_ = lds + (sb) * NS_STAGE; stk(st_, rk, tid); stv(st_ + 64 * KP, rv, tid >> 3, tid); } while (0)
#define NS_FOLD(gate) do { lsum += __shfl_xor(lsum, 32); if (hi == 0) wsf[r32] = (lsum > 0.f) ? (gate) / lsum : 0.f; asm volatile("s_waitcnt lgkmcnt(0)" ::: "memory"); \
        _Pragma("unroll") for (int r = 0; r < 16; ++r) { const float f_ = wsf[crow(r, hi)]; oc[0][r] += f_ * o[0][r]; oc[1][r] += f_ * o[1][r]; } asm volatile("s_waitcnt lgkmcnt(0)" ::: "memory"); } while (0)
    {
        const bf16_t* Kg = (const bf16_t*)(ws + WS_KCN) + (size_t)bgi * 256 * 64;
        const bf16_t* Vg = (const bf16_t*)(ws + WS_VCT) + (size_t)bgi * 64 * 256;
        const int ntc = (4 * u + 2) / 64 + 1;
        for (int tc = 0; tc < ntc; ++tc) { rk = ldk(Kg + (size_t)tc * 4096, tid); rv = ldv(Vg + tc * 64, 256, tid >> 3, tid); NS_STORE(tc); }
        __syncthreads();
        float lsum = 0.f;
        for (int tc = 0; tc < ntc; ++tc) {
            const LAS unsigned char* st = lds + tc * NS_STAGE;
            f32x16 p0 = (f32x16){}, p1 = (f32x16){};
            qk_tile(p0, p1, st, qf, r32, hi);
            const int dl = qpos - 31 - 16 * (64 * tc + 4 * hi);
            score_exp_sel<16, false>(p0, p1, dl, tb, cfar, true, qw0 - 31 - 16 * (64 * tc + 63), qw0 + 7 - 31 - 16 * 64 * tc);
            lsum += sum32(p0, p1);
        }
        const float lt = lsum + __shfl_xor(lsum, 32);
        const float linv = (lt > 0.f) ? 1.0f / lt : 0.f;
        o[0] = (f32x16){}; o[1] = (f32x16){};
        float carry = 0.f;
        for (int tc = 0; tc < ntc; ++tc) {
            const LAS unsigned char* st = lds + tc * NS_STAGE;
            f32x16 p0 = (f32x16){}, p1 = (f32x16){};
            qk_tile(p0, p1, st, qf, r32, hi);
            const int dl = qpos - 31 - 16 * (64 * tc + 4 * hi);
            score_exp_sel<16, false>(p0, p1, dl, tb, cfar, true, qw0 - 31 - 16 * (64 * tc + 63), qw0 + 7 - 31 - 16 * 64 * tc);
            float Qs[2][4], PL[2][4];
#pragma unroll
            for (int blk = 0; blk < 2; ++blk)
#pragma unroll
                for (int m = 0; m < 4; ++m) { const f32x16& pp = blk ? p1 : p0; Qs[blk][m] = (pp[4 * m] + pp[4 * m + 1]) + (pp[4 * m + 2] + pp[4 * m + 3]); PL[blk][m] = __shfl_xor(pp[4 * m + 3], 32); }
#pragma unroll
            for (int blk = 0; blk < 2; ++blk)
#pragma unroll
                for (int m = 0; m < 4; ++m) {
                    const float prev = (m > 0) ? PL[blk][m - 1] : (blk ? PL[0][3] : carry);
                    float e = (Qs[blk][m] + (hi ? PL[blk][m] : prev)) * linv;
                    e += __shfl_xor(e, 1); e += __shfl_xor(e, 2);
                    if (p == 0) imp[(8 * wave + qi) * 64 + 16 * tc + 8 * blk + 2 * m + hi] = e;
                }
            carry = PL[1][3];
            pv_tile<2>(o, p0, p1, st + 64 * KP, r32, hi);
        }
        NS_FOLD(gate_c);
    }
    __syncthreads();
    {
        const int ql = lane >> 3, sub = lane & 7, q = 8 * wave + ql;
        unsigned long long m;
        if (u < 8) m = (2ull << u) - 1ull;
        else {
            m = 1ull | (1ull << u) | (1ull << (u - 1));
            float v[8];
#pragma unroll
            for (int i = 0; i < 8; ++i) { const int j = sub + 8 * i; v[i] = (j >= 1 && j <= u - 2) ? imp[q * 64 + j] : -1.f; }
            for (int k = 0; k < 5; ++k) {
                float bv = v[0]; int bj = sub;
#pragma unroll
                for (int i = 1; i < 8; ++i) if (v[i] > bv) { bv = v[i]; bj = sub + 8 * i; }
#pragma unroll
                for (int of = 1; of < 8; of <<= 1) { const float ov = __shfl_xor(bv, of); const int oj = __shfl_xor(bj, of); if (ov > bv || (ov == bv && oj < bj)) { bv = ov; bj = oj; } }
                m |= 1ull << bj;
#pragma unroll
                for (int i = 0; i < 8; ++i) if (bj == sub + 8 * i) v[i] = -2.f;
            }
        }
        if (sub == 0) { selw[2 * q] = (unsigned)m; selw[2 * q + 1] = (unsigned)(m >> 32); atomicOr((unsigned*)&selw[128], (unsigned)m); atomicOr((unsigned*)&selw[129], (unsigned)(m >> 32)); }
    }
    __syncthreads();
    asm volatile("" : "+v"(oc[0]), "+v"(oc[1]));
    u32x4 rk2, rv2;
#define NS_LOADA(Kg_, Vg_, j_) do { rk = ldk((Kg_) + (size_t)(j_) * 4096, tid); rv = ldv((Vg_) + (j_) * 64, SEQ, tid >> 3, tid); } while (0)
#define NS_LOADB(Kg_, Vg_, j_) do { rk2 = ldk((Kg_) + (size_t)(j_) * 4096, tid); rv2 = ldv((Vg_) + (j_) * 64, SEQ, tid >> 3, tid); } while (0)
#define NS_STOREA(sb) do { LAS unsigned char* st_ = lds + (sb) * NS_STAGE; stk(st_, rk, tid); stv(st_ + 64 * KP, rv, tid >> 3, tid); } while (0)
#define NS_STOREB(sb) do { LAS unsigned char* st_ = lds + (sb) * NS_STAGE; stk(st_, rk2, tid); stv(st_ + 64 * KP, rv2, tid >> 3, tid); } while (0)
    {
        const unsigned long long un = (unsigned long long)selw[128] | ((unsigned long long)selw[129] << 32);
        const unsigned long long mine = (unsigned long long)selw[2 * (8 * wave + qi)] | ((unsigned long long)selw[2 * (8 * wave + qi) + 1] << 32);
        const bf16_t* Kg = (const bf16_t*)(ws + Z_KSEL) + (size_t)bgi * SEQ * 64;
        const bf16_t* Vg = (const bf16_t*)(ws + Z_VSELT) + (size_t)bgi * 64 * SEQ;
        o[0] = (f32x16){}; o[1] = (f32x16){};
        float lsum = 0.f;
        unsigned long long rem = un;
#define NS_NEXTJ(var, has) do { has = (rem != 0ull); var = 0; if (has) { var = __builtin_ctzll(rem); rem &= rem - 1; } } while (0)
        int jc, j1, j2; bool h1, h2;
        NS_NEXTJ(jc, h1);
        NS_NEXTJ(j1, h1);
        NS_LOADA(Kg, Vg, jc); if (h1) NS_LOADB(Kg, Vg, j1);
        NS_STOREA(0);
        __syncthreads();
        int sc = 0;
#define NS_SEL_STEP(LOADF, STOREN) { \
            NS_NEXTJ(j2, h2); if (h2) LOADF(Kg, Vg, j2); \
            const bool rowsel = (mine >> jc) & 1ull; \
            if (__any(rowsel)) { \
                const LAS unsigned char* st = lds + sc * NS_STAGE; \
                f32x16 p0 = (f32x16){}, p1 = (f32x16){}; \
                qk_tile(p0, p1, st, qf, r32, hi); \
                const int dl = qpos - 64 * jc - 4 * hi; \
                score_exp_sel<1, false>(p0, p1, dl, tb, cfar, rowsel, qw0 - (64 * jc + 63), qw0 + 7 - 64 * jc); \
                lsum += sum32(p0, p1); \
                pv_tile<2>(o, p0, p1, st + 64 * KP, r32, hi); \
            } \
            const int sn = (sc == 2) ? 0 : sc + 1; \
            if (h1) STOREN(sn); \
            __syncthreads(); \
            if (!h1) break; \
            jc = j1; j1 = j2; h1 = h2; sc = sn; }
        for (;;) { NS_SEL_STEP(NS_LOADA, NS_STOREB) NS_SEL_STEP(NS_LOADB, NS_STOREA) }
#undef NS_SEL_STEP
#undef NS_NEXTJ
        NS_FOLD(gate_s);
        asm volatile("" : "+v"(oc[0]), "+v"(oc[1]));
    }
    {
        const bf16_t* Kg = (const bf16_t*)(ws + Z_KWIN) + (size_t)bgi * SEQ * 64;
        const bf16_t* Vg = (const bf16_t*)(ws + Z_VWINT) + (size_t)bgi * 64 * SEQ;
        o[0] = (f32x16){}; o[1] = (f32x16){};
        float lsum = 0.f;
        const int t0 = (u >= 8) ? u - 8 : 0;
        int t = t0, sc = 0;
        NS_LOADA(Kg, Vg, t0); if (t0 + 1 <= u) NS_LOADB(Kg, Vg, t0 + 1);
        NS_STOREA(0);
        __syncthreads();
#define NS_WIN_STEP(LOADF, STOREN) { \
            if (t + 2 <= u) LOADF(Kg, Vg, t + 2); \
            { \
                const LAS unsigned char* st = lds + sc * NS_STAGE; \
                f32x16 p0 = (f32x16){}, p1 = (f32x16){}; \
                qk_tile(p0, p1, st, qf, r32, hi); \
                const int dl = qpos - 64 * t - 4 * hi; \
                score_exp_sel<1, true>(p0, p1, dl, tb, cfar, true, qw0 - (64 * t + 63), qw0 + 7 - 64 * t); \
                lsum += sum32(p0, p1); \
                pv_tile<2>(o, p0, p1, st + 64 * KP, r32, hi); \
            } \
            const int sn = (sc == 2) ? 0 : sc + 1; \
            if (t + 1 <= u) STOREN(sn); \
            __syncthreads(); \
            if (t + 1 > u) break; \
            ++t; sc = sn; }
        for (;;) { NS_WIN_STEP(NS_LOADA, NS_STOREB) NS_WIN_STEP(NS_LOADB, NS_STOREA) }
#undef NS_WIN_STEP
        NS_FOLD(gate_w);
    }
#undef NS_LOADA
#undef NS_LOADB
#undef NS_STOREA
#undef NS_STOREB
#undef NS_STORE
#undef NS_FOLD
#pragma unroll
    for (int r = 0; r < 16; ++r) {
        const int row = crow(r, hi), q = qw0 + (row >> 2), pp = row & 3;
        bf16_t* d = (bf16_t*)(ws + WS_XN) + (size_t)(b * SEQ + q) * DM + 512 + (g * 4 + pp) * 64 + r32;
        GST(bf16_t, d, (bf16_t)f2bf(oc[0][r])); GST(bf16_t, d + 32, (bf16_t)f2bf(oc[1][r]));
    }
    __syncthreads();
}

__device__ __forceinline__ void attention_phase(const Params& P, int l, LAS unsigned char* lds) {
    int tab_key = -1;
    for (int it = blockIdx.x; it < 2048; it += gridDim.x) {
        const int c = it & 255, sl = (it >> 8) & 3;
        if (it < 1024) { const int bh = c & 31, xg = c >> 5; const int qb = (sl == 0) ? 31 - xg : (sl == 1) ? 23 - xg : (sl == 2) ? 8 + xg : xg;
            da_unit(P, l, bh >> 2, bh & 3, qb, lds, tab_key != (bh & 3)); tab_key = bh & 3; }
        else { const int bg = c & 15, ug = c >> 4; const int u = (sl == 0) ? 63 - ug : (sl == 1) ? 47 - ug : (sl == 2) ? 16 + ug : ug;
            nsa_unit(P, l, bg >> 1, bg & 1, u, lds, tab_key != 4 + (bg & 1)); tab_key = 4 + (bg & 1); }
    }
}

constexpr size_t WS_BAR = 72 * 1024;
#define RLX_AGENT __ATOMIC_RELAXED, __HIP_MEMORY_SCOPE_AGENT
#define XB_TMO      128
#define XB_XCNT(j)  (256  + 64 * (j))
#define XB_XSUB(j)  (1280 + 64 * (j))
#define XB_XGEN(j)  (2304 + 64 * (j))
#define XB_TOP      3328
#define XB_TOPGEN   3392
#define XCD_BAR_WORDS 3456
#define XB_SPIN_CAP (1u << 18)

__device__ __forceinline__ unsigned xb_ld(unsigned* p)              { return __hip_atomic_load(p, __ATOMIC_RELAXED, __HIP_MEMORY_SCOPE_AGENT); }
__device__ __forceinline__ unsigned xb_add(unsigned* p, unsigned v) { return __hip_atomic_fetch_add(p, v, __ATOMIC_RELAXED, __HIP_MEMORY_SCOPE_AGENT); }
__device__ __forceinline__ unsigned xb_xcc_id() { return (unsigned)__builtin_amdgcn_s_getreg((3 << 11) | 20) & 0xFu; }
#define XB_SPIN(cond, bar) do { unsigned _sp = 0; while (cond) { __builtin_amdgcn_s_sleep(1); \
    if ((++_sp & 255u) == 0u) { if (xb_ld(&(bar)[XB_TMO])) break; if (_sp > XB_SPIN_CAP) { atomicAdd(&(bar)[XB_TMO], 1u); break; } } } } while (0)

struct XcdBarrier {
    unsigned* bar; unsigned x;
    volatile LAS unsigned* st;
};

__device__ __forceinline__ XcdBarrier xcd_barrier_post(unsigned* bar, volatile LAS unsigned* st) {
    XcdBarrier b; b.bar = bar; b.x = xb_xcc_id(); b.st = st;
    if (threadIdx.x == 0) (void)xb_add(&bar[XB_XCNT(b.x)], 1u);
    return b;
}
__device__ __forceinline__ void xcd_barrier_complete(unsigned* bar, unsigned x, unsigned& nloc, unsigned& nx) {
    const unsigned G = gridDim.x * gridDim.y * gridDim.z;
    unsigned sum, cnt, mine, sp = 0u;
    for (;;) {
        sum = 0u; cnt = 0u; mine = 0u;
#pragma unroll
        for (unsigned j = 0; j < 16; ++j) { const unsigned c = xb_ld(&bar[XB_XCNT(j)]); sum += c; cnt += (c > 0u) ? 1u : 0u; mine = (j == x) ? c : mine; }
        if (sum == G) break;
        __builtin_amdgcn_s_sleep(1);
        if ((++sp & 255u) == 0u) { if (xb_ld(&bar[XB_TMO])) break; if (sp > XB_SPIN_CAP) { atomicAdd(&bar[XB_TMO], 1u); break; } }
    }
    nloc = mine > 0u ? mine : 1u; nx = cnt > 0u ? cnt : 1u;
}

__device__ __forceinline__ void xcd_barrier(const XcdBarrier& b) {
    asm volatile("s_waitcnt vmcnt(0)" ::: "memory");
    __syncthreads();
    if (threadIdx.x == 0) {
        unsigned* bar = b.bar;
        __builtin_amdgcn_s_waitcnt(0);
        unsigned nloc = b.st[0], nx = b.st[1];
        if (nloc == 0u) { xcd_barrier_complete(bar, b.x, nloc, nx); b.st[0] = nloc; b.st[1] = nx; }
        const unsigned old = xb_add(&bar[XB_XSUB(b.x)], 1u);
        const unsigned gen = old / nloc;
        if (old + 1u == (gen + 1u) * nloc) {
            __builtin_amdgcn_fence(__ATOMIC_RELEASE, "agent");
            asm volatile("s_waitcnt vmcnt(0)" ::: "memory");
            const unsigned og = xb_add(&bar[XB_TOP], 1u);
            const unsigned tg = og / nx;
            if (og + 1u == (tg + 1u) * nx) xb_add(&bar[XB_TOPGEN], 1u);
            else XB_SPIN(xb_ld(&bar[XB_TOPGEN]) == tg, bar);
            __builtin_amdgcn_fence(__ATOMIC_ACQUIRE, "agent");
            xb_add(&bar[XB_XGEN(b.x)], 1u);
            asm volatile("s_waitcnt vmcnt(0)" ::: "memory");
        } else {
            XB_SPIN(xb_ld(&bar[XB_XGEN(b.x)]) == gen, bar);
            __builtin_amdgcn_fence(__ATOMIC_ACQUIRE, "agent");
            asm volatile("s_waitcnt vmcnt(0)" ::: "memory");
        }
    }
    __syncthreads();
}

__global__ void __launch_bounds__(NTHR, 2) hybrid_fwd(Params P) {
    extern __shared__ __attribute__((aligned(16))) unsigned char lds_raw[];
    LAS unsigned char* lds = (LAS unsigned char*)lds_raw;
    cg::grid_group grid = cg::this_grid();
#define GSYNC() do { XcdBarrier xb_; xb_.bar = (unsigned*)(WSP + WS_BAR); xb_.x = xb_xcc_id(); xb_.st = (volatile LAS unsigned*)(lds + L_PTAB + 384); xcd_barrier(xb_); } while (0)
    if (threadIdx.x == 0) {
        LAS unsigned long long* pt = (LAS unsigned long long*)(lds + L_PTAB);
#pragma unroll
        for (int i = 0; i < 30; ++i) pt[i] = (unsigned long long)P.in[i];
        pt[30] = (unsigned long long)P.out; pt[31] = (unsigned long long)P.ws;
        *(LAS unsigned*)(lds + L_PTAB + 384) = 0u; *(LAS unsigned*)(lds + L_PTAB + 388) = 0u;
    }
    __syncthreads();
    (void)xcd_barrier_post((unsigned*)(WSP + WS_BAR), (volatile LAS unsigned*)(lds + L_PTAB + 384));
    const int G = gridDim.x, bx = blockIdx.x;
#define ws WSP
#define XN ((bf16_t*)(WSP + WS_XN))
#define HID ((bf16_t*)(WSP + WS_HID))
#define MERGED ((bf16_t*)(WSP + WS_MERGED))

#if defined(PROBE_PHASE)
    int n_stamp = 0;
#define STAMP() do { if (blockIdx.x == 0 && threadIdx.x == 0) ((LAS unsigned long long*)(lds + L_PTAB + 512))[n_stamp] = __builtin_amdgcn_s_memrealtime(); ++n_stamp; } while (0)
#else
#define STAMP() do {} while (0)
#endif
    grid.sync();
    STAMP();
    prologue(P, lds);
#if defined(DUP_PRO)
    prologue(P, lds);
#endif
    GSYNC(); STAMP();
#pragma unroll
    for (int l = 0; l < DEPTH; ++l) {
        const float* xin = (l == 0) ? INP(0) : OUTP;
        rmsnorm_phase(xin, INP(5) + l * DM, XN);
        GSYNC(); STAMP();
        { pg8::Gemm g{XN, (const bf16_t*)(ws + WS_W13 + (size_t)(l * 2 + 0) * W13_SZ), MTOK, 5632, DM}; pg8::StaticOrder S; S.init(MTOK, 5632, G, bx);
          EpiSwiGLU E{HID}; pg8::gemm_phase<EpiSwiGLU, pg8::StaticOrder, true, true>(lds, g, S, E);
#if defined(DUP_G1)
          pg8::gemm_phase<EpiSwiGLU, pg8::StaticOrder, true, true>(lds, g, S, E);
#endif
        }
        GSYNC(); STAMP();
        { pg8::Gemm g{HID, (const bf16_t*)(ws + WS_W2 + (size_t)(l * 2 + 0) * W2_SZ), MTOK, DM, DFF}; pg8::StaticOrder S; S.init(MTOK, DM, G, bx);
          EpiResid E{xin, OUTP, 0.5f}; pg8::gemm_phase<EpiResid, pg8::StaticOrder, true, true>(lds, g, S, E); }
        GSYNC(); STAMP();
#if defined(STOP_AFTER) && STOP_AFTER == 1
        return;
#endif
        rmsnorm_phase(OUTP, INP(6) + l * DM, XN);
        GSYNC(); STAMP();
        { pg8::Gemm g{XN, (const bf16_t*)(ws + WS_WIN + (size_t)l * WIN_SZ), MTOK, 5120, DM}; pg8::StaticOrder S; S.init(MTOK, 5120, G, bx);
          EpiZ E{ws, INP(14) + l * 64, INP(15) + l * 64, INP(21) + l * 64, INP(22) + l * 192}; pg8::gemm_phase<EpiZ, pg8::StaticOrder, true, true>(lds, g, S, E);
#if defined(DUP_G3)
          pg8::gemm_phase<EpiZ, pg8::StaticOrder, true, true>(lds, g, S, E);
#endif
        }
        GSYNC(); STAMP();
#if defined(DUMP_Z)
        { const unsigned short* z = (const unsigned short*)(WSP + WS_Z); float* o = OUTP;
          for (size_t i = (size_t)blockIdx.x * NTHR + threadIdx.x; i < (size_t)MTOK * DM; i += (size_t)gridDim.x * NTHR) {
              unsigned v = (unsigned)z[i * 4 + (i & 3)] << 16; if ((v & 0x7f800000u) == 0x7f800000u) v = 0u; o[i] = __builtin_bit_cast(float, v); }
          return; }
#endif
        compress_phase(P, l, lds);
#if defined(DUP_CMP)
        for (int rep_ = 0; rep_ < 4; ++rep_) compress_phase(P, l, lds);
#endif
        GSYNC(); STAMP();
        attention_phase(P, l, lds);
#if defined(DUP_ATT)
        attention_phase(P, l, lds);
#endif
        GSYNC(); STAMP();
        { pg8::Gemm g{XN, (const bf16_t*)(ws + WS_PAB + (size_t)l * PAB_SZ), MTOK, 2048, DM}; pg8::StaticOrder S; S.init(MTOK, 2048, G, bx);
          EpiMerge E{(const bf16_t*)(ws + Z_MG), MERGED}; pg8::gemm_phase<EpiMerge, pg8::StaticOrder, true, true>(lds, g, S, E); }
        GSYNC(); STAMP();
        { pg8::Gemm g{MERGED, (const bf16_t*)(ws + WS_WO + (size_t)l * WO_SZ), MTOK, DM, DM}; pg8::StaticOrder S; S.init(MTOK, DM, G, bx);
          EpiResid E{OUTP, OUTP, 1.0f}; pg8::gemm_phase<EpiResid, pg8::StaticOrder, true, true>(lds, g, S, E); }
        GSYNC(); STAMP();
#if defined(STOP_AFTER) && STOP_AFTER == 2
        return;
#endif
        rmsnorm_phase(OUTP, INP(7) + l * DM, XN);
        GSYNC(); STAMP();
        { pg8::Gemm g{XN, (const bf16_t*)(ws + WS_W13 + (size_t)(l * 2 + 1) * W13_SZ), MTOK, 5632, DM}; pg8::StaticOrder S; S.init(MTOK, 5632, G, bx);
          EpiSwiGLU E{HID}; pg8::gemm_phase<EpiSwiGLU, pg8::StaticOrder, true, true>(lds, g, S, E); }
        GSYNC(); STAMP();
        { pg8::Gemm g{HID, (const bf16_t*)(ws + WS_W2 + (size_t)(l * 2 + 1) * W2_SZ), MTOK, DM, DFF}; pg8::StaticOrder S; S.init(MTOK, DM, G, bx);
          EpiResid E{OUTP, OUTP, 0.5f}; pg8::gemm_phase<EpiResid, pg8::StaticOrder, true, true>(lds, g, S, E); }
        if (l + 1 < DEPTH) { GSYNC(); STAMP(); }
    }
#if defined(PROBE_PHASE)
    GSYNC(); STAMP();
    if (blockIdx.x == 0 && threadIdx.x == 0) { const LAS unsigned long long* t = (const LAS unsigned long long*)(lds + L_PTAB + 512); const float ns = (float)(t[PROBE_PHASE + 1] - t[PROBE_PHASE]) * 10.0f; OUTP[0] = exp2f(rintf(log2f(ns) * 4.f) * 0.25f); }
#endif
#undef ws
#undef XN
#undef HID
#undef MERGED
}

extern "C" void kernel_launch(void* const* d_in, const int* in_sizes, int n_in, void* d_out, int out_size, void* d_ws, size_t ws_size, hipStream_t stream) {
    static int grid = 0;
    if (grid == 0) {
        if (n_in != 30 || out_size != MTOK * DM || ws_size < WS_END) { fprintf(stderr, "kernel_launch: unexpected problem (n_in %d out %d ws %zu, need %zu)\n", n_in, out_size, ws_size, (size_t)WS_END); grid = -1; return; }
        int dev = 0, cus = 0, per_cu = 0;
        (void)hipGetDevice(&dev);
        (void)hipDeviceGetAttribute(&cus, hipDeviceAttributeMultiprocessorCount, dev);
        if (hipFuncSetAttribute((const void*)hybrid_fwd, hipFuncAttributeMaxDynamicSharedMemorySize, LDS_BYTES) != hipSuccess) { fprintf(stderr, "kernel_launch: hipFuncSetAttribute failed\n"); grid = -1; return; }
        if (hipOccupancyMaxActiveBlocksPerMultiprocessor(&per_cu, (const void*)hybrid_fwd, NTHR, LDS_BYTES) != hipSuccess || per_cu < 1) { fprintf(stderr, "kernel_launch: occupancy query gave %d\n", per_cu); per_cu = 1; }
        (void)hipGetLastError();
        grid = cus * (per_cu > 1 ? 1 : per_cu);
        if (grid <= 0) grid = 256;
    }
    if (grid < 0) return;
    Params p{};
    for (int i = 0; i < 30; ++i) p.in[i] = (const float*)d_in[i];
    p.out = (float*)d_out; p.ws = (unsigned char*)d_ws;
    (void)hipMemsetAsync((unsigned char*)d_ws + WS_BAR, 0, 16384, stream);
    void* args[] = {&p};
    hipError_t e = hipLaunchCooperativeKernel((const void*)hybrid_fwd, dim3(grid), dim3(NTHR), args, LDS_BYTES, stream);
    if (e != hipSuccess) fprintf(stderr, "cooperative launch failed: %s (grid %d)\n", hipGetErrorString(e), grid);
}
```

```cpp
#include <hip/hip_runtime.h>
#include <hip/hip_cooperative_groups.h>
#include <cstdio>
#include <cstdint>
namespace cg = cooperative_groups;
namespace pg8 {
#define PG8_LAS __attribute__((address_space(3)))
typedef unsigned short bf16_t;
typedef short bf16x8 __attribute__((ext_vector_type(8)));
typedef float f32x4 __attribute__((ext_vector_type(4)));
typedef unsigned u32x4 __attribute__((ext_vector_type(4)));
constexpr int BM = 256, BK = 64, HALF = 128, HTB = HALF * BK * 2  , STAGE_BYTES = 8 * HTB, NXCD = 8, WGM = 8;

__host__ __device__ __forceinline__ int lds_byte(int r, int c) { const int st = (r >> 4) * 2 + (c >> 5), rr = r & 15, cc = c & 31, ob = rr * 64 + cc * 2; return st * 1024 + (ob ^ (((ob >> 9) & 1) << 5)); }
__host__ __device__ __forceinline__ void stage_rc(int b, int& R, int& C) { const int st = b / 1024, sb = b % 1024, swz = sb ^ (((sb >> 9) & 1) << 5); R = (st >> 1) * 16 + swz / 64; C = (st & 1) * 32 + (swz % 64) / 2; }
__host__ __device__ __forceinline__ int perm32(int rho) { const int n = rho >> 4, i = rho & 15; return 8 * (i >> 2) + 4 * n + (i & 3); }

struct Unit { int pm, pn; };
struct Gemm { const bf16_t* A; const bf16_t* Bt; int M, N, K; };

struct StaticOrder {
    int nM, nN, nwg, G, c;
    __host__ __device__ void init(int M, int N, int G_, int c_) { nM = M / BM; nN = N / BM; nwg = nM * nN; G = G_; c = c_; }
    __host__ __device__ bool next(int i, Unit& u) const {
        const long L = (long)i * G + c; if (L >= nwg) return false;
        int wgid = (int)L; { const int q = nwg / NXCD, r = nwg % NXCD, xcd = wgid % NXCD, off = wgid / NXCD; wgid = (xcd < r ? xcd * (q + 1) : r * (q + 1) + (xcd - r) * q) + off; }
        const int nig = WGM * nN, gid = wgid / nig, fm = gid * WGM, gsz = (nM - fm) < WGM ? (nM - fm) : WGM;
        u.pm = fm + ((wgid % nig) % gsz); u.pn = (wgid % nig) / gsz; return true;
    }
    __device__ __forceinline__ void a_ready(const Unit&) const {}
    __device__ __forceinline__ void done(const Unit&) const {}
};

typedef float f32x2_t __attribute__((ext_vector_type(2))); typedef __bf16 bf16x2_t __attribute__((ext_vector_type(2)));
__device__ __forceinline__ unsigned cvt_pk_bf16(float lo, float hi) { f32x2_t v = {lo, hi}; bf16x2_t b = __builtin_convertvector(v, bf16x2_t); return __builtin_bit_cast(unsigned, b); }
template <class Epi, class Sched, bool ALIGN_EPI = false, bool SP2 = false>
__device__ __forceinline__ void gemm_phase(PG8_LAS unsigned char* lds, const Gemm g, const Sched& S, const Epi& E) {
    int tid_ = threadIdx.x; asm volatile("" : "+v"(tid_)); const int tid = tid_, wid = __builtin_amdgcn_readfirstlane(tid >> 6), lane = tid & 63, wr = wid >> 2, wc = wid & 3, fr = lane & 15, fq = lane >> 4;
    const int K = g.K, nt = K / BK;
    unsigned voffA[2], voffB[2];
#pragma unroll
    for (int i = 0; i < 2; ++i) { int R, C; stage_rc(tid * 16 + i * 8192, R, C); const int Rb = Epi::PERM ? ((R & ~31) + perm32(R & 31)) : R;
        voffA[i] = (unsigned)(R * K + C) * 2u; voffB[i] = (unsigned)(Rb * K + C) * 2u; }
    const size_t kstep = (size_t)(BK * 2);
    const size_t hstep = (size_t)HALF * K * 2;
    const size_t tstep = 2 * hstep;
    const unsigned ldsw = (unsigned)wid * 1024u;
    const int aoff = lds_byte(wr * 64 + fr, fq * 8), boff = lds_byte(wc * 32 + fr, fq * 8);
#define PG8_SA(b, h) (((b) * 2 + (h)) * HTB)
#define PG8_SB(b, h) ((4 + (b) * 2 + (h)) * HTB)
#define PG8_STAGE(bufoff, gbase, voff) do { _Pragma("unroll") for (int _i = 0; _i < 2; ++_i) \
        __builtin_amdgcn_global_load_lds((const unsigned*)((const char*)(gbase) + (voff)[_i]), (PG8_LAS unsigned*)(lds + (bufoff) + ldsw + _i * 8192), 16, 0, 0); } while (0)
#define PG8_LDA(dst, b, h) do { _Pragma("unroll") for (int m = 0; m < 4; ++m) _Pragma("unroll") for (int k = 0; k < 2; ++k) dst[m][k] = *(const PG8_LAS bf16x8*)(lds + PG8_SA(b, h) + aoff + m * 2048 + k * 1024); } while (0)
#define PG8_LDB(dst, b, h) do { _Pragma("unroll") for (int n = 0; n < 2; ++n) _Pragma("unroll") for (int k = 0; k < 2; ++k) dst[n][k] = *(const PG8_LAS bf16x8*)(lds + PG8_SB(b, h) + boff + n * 2048 + k * 1024); } while (0)
#define PG8_MMA(ai, bj, At, Bt) do { __builtin_amdgcn_s_setprio(1); _Pragma("unroll") for (int m = 0; m < 4; ++m) _Pragma("unroll") for (int n = 0; n < 2; ++n) _Pragma("unroll") for (int k = 0; k < 2; ++k) \
        acc[ai][bj][m][n] = __builtin_amdgcn_mfma_f32_16x16x32_bf16(Bt[n][k], At[m][k], acc[ai][bj][m][n], 0, 0, 0); __builtin_amdgcn_s_setprio(0); } while (0)
#define PG8_WAIT_V(n) asm volatile("s_waitcnt vmcnt(" #n ")" ::: "memory")
#define PG8_WAIT_L(n) asm volatile("s_waitcnt lgkmcnt(" #n ")" ::: "memory")
#define PG8_BAR __builtin_amdgcn_s_barrier()
#define PG8_SCHED __builtin_amdgcn_sched_barrier(0)
    Unit cur, nxt; int ui = 0;
    if (!S.next(0, cur)) return;
    f32x4 acc[2][2][4][2];
#pragma unroll
    for (int a = 0; a < 2; ++a)
#pragma unroll
        for (int b = 0; b < 2; ++b)
#pragma unroll
            for (int m = 0; m < 4; ++m)
#pragma unroll
                for (int n = 0; n < 2; ++n) acc[a][b][m][n] = (f32x4){0.f, 0.f, 0.f, 0.f};
    bf16x8 At[4][2], B0[2][2], B1[2][2];
    const char* cA = (const char*)g.A + (size_t)cur.pm * tstep; const char* cB = (const char*)g.Bt + (size_t)cur.pn * tstep;
    S.a_ready(cur);
    if constexpr (SP2) {
        PG8_STAGE(PG8_SB(0, 0), cB, voffB); PG8_STAGE(PG8_SB(0, 1), cB + hstep, voffB); PG8_STAGE(PG8_SA(0, 0), cA, voffA); PG8_STAGE(PG8_SA(0, 1), cA + hstep, voffA);
        if (wr == 1) PG8_BAR;
        PG8_WAIT_V(2); PG8_BAR;
        PG8_STAGE(PG8_SB(1, 0), cB + kstep, voffB); PG8_STAGE(PG8_SA(1, 0), cA + kstep, voffA); PG8_STAGE(PG8_SB(1, 1), cB + hstep + kstep, voffB);
        PG8_WAIT_V(6); PG8_BAR;
    } else {
        PG8_STAGE(PG8_SB(0, 0), cB, voffB); PG8_STAGE(PG8_SA(0, 0), cA, voffA); PG8_STAGE(PG8_SB(0, 1), cB + hstep, voffB); PG8_STAGE(PG8_SA(0, 1), cA + hstep, voffA);
        if (wr == 1) PG8_BAR;
        PG8_WAIT_V(4); PG8_BAR;
        PG8_STAGE(PG8_SB(1, 0), cB + kstep, voffB); PG8_STAGE(PG8_SA(1, 0), cA + kstep, voffA); PG8_STAGE(PG8_SB(1, 1), cB + hstep + kstep, voffB);
        PG8_WAIT_V(6); PG8_BAR;
    }
    for (;;) {
        const bool has_next = S.next(ui + 1, nxt);
        const char* nA = has_next ? (const char*)g.A + (size_t)nxt.pm * tstep : cA; const char* nB = has_next ? (const char*)g.Bt + (size_t)nxt.pn * tstep : cB;
        for (int t = 0; t < nt; t += 2) {
            const bool last = (t == nt - 2);
            const char* a1 = cA + (size_t)(t + 1) * kstep;
            const char* a2 = last ? nA : cA + (size_t)(t + 2) * kstep; const char* b2 = last ? nB : cB + (size_t)(t + 2) * kstep;
            const char* a3 = a2 + kstep; const char* b3 = b2 + kstep;
            if (last && has_next) S.a_ready(nxt);
            if constexpr (SP2) {
            PG8_LDB(B0, 0, 0); PG8_LDB(B1, 0, 1); PG8_SCHED; PG8_LDA(At, 0, 0); PG8_STAGE(PG8_SA(1, 1), a1 + hstep, voffA);
            PG8_WAIT_V(8); PG8_WAIT_L(0); PG8_BAR; PG8_MMA(0, 0, At, B0); PG8_MMA(0, 1, At, B1); PG8_BAR; PG8_SCHED;
            PG8_LDA(At, 0, 1); PG8_STAGE(PG8_SB(0, 0), b2, voffB); PG8_STAGE(PG8_SB(0, 1), b2 + hstep, voffB); PG8_STAGE(PG8_SA(0, 0), a2, voffA);
            PG8_WAIT_V(8); PG8_WAIT_L(0); PG8_BAR; PG8_MMA(1, 0, At, B0); PG8_MMA(1, 1, At, B1); PG8_BAR; PG8_SCHED;
            PG8_LDB(B0, 1, 0); PG8_LDB(B1, 1, 1); PG8_SCHED; PG8_LDA(At, 1, 0); PG8_STAGE(PG8_SA(0, 1), a2 + hstep, voffA);
            PG8_WAIT_V(8); PG8_WAIT_L(0); PG8_BAR; PG8_MMA(0, 0, At, B0); PG8_MMA(0, 1, At, B1); PG8_BAR; PG8_SCHED;
            PG8_LDA(At, 1, 1); PG8_STAGE(PG8_SB(1, 0), b3, voffB); PG8_STAGE(PG8_SB(1, 1), b3 + hstep, voffB); PG8_STAGE(PG8_SA(1, 0), a3, voffA);
            PG8_WAIT_V(8); PG8_WAIT_L(0); PG8_BAR; PG8_MMA(1, 0, At, B0); PG8_MMA(1, 1, At, B1); PG8_BAR; PG8_SCHED;
            } else {
            PG8_LDB(B0, 0, 0); PG8_SCHED; PG8_LDA(At, 0, 0); PG8_STAGE(PG8_SA(1, 1), a1 + hstep, voffA);
            PG8_WAIT_L(8); PG8_BAR; PG8_WAIT_L(0); PG8_MMA(0, 0, At, B0); PG8_BAR; PG8_SCHED;
            PG8_LDB(B1, 0, 1); PG8_STAGE(PG8_SB(0, 0), b2, voffB);
            PG8_BAR; PG8_WAIT_L(0); PG8_MMA(0, 1, At, B1); PG8_BAR;
            PG8_LDA(At, 0, 1); PG8_STAGE(PG8_SA(0, 0), a2, voffA);
            PG8_BAR; PG8_WAIT_L(0); PG8_MMA(1, 0, At, B0); PG8_BAR; PG8_SCHED;
            PG8_STAGE(PG8_SB(0, 1), b2 + hstep, voffB);
            PG8_WAIT_V(6); PG8_BAR; PG8_MMA(1, 1, At, B1); PG8_BAR;
            PG8_LDB(B0, 1, 0); PG8_SCHED; PG8_LDA(At, 1, 0); PG8_STAGE(PG8_SA(0, 1), a2 + hstep, voffA);
            PG8_WAIT_L(8); PG8_BAR; PG8_WAIT_L(0); PG8_MMA(0, 0, At, B0); PG8_BAR; PG8_SCHED;
            PG8_LDB(B1, 1, 1); PG8_STAGE(PG8_SB(1, 0), b3, voffB);
            PG8_BAR; PG8_WAIT_L(0); PG8_MMA(0, 1, At, B1); PG8_BAR;
            PG8_LDA(At, 1, 1); PG8_STAGE(PG8_SA(1, 0), a3, voffA);
            PG8_BAR; PG8_WAIT_L(0); PG8_MMA(1, 0, At, B0); PG8_BAR; PG8_SCHED;
            PG8_STAGE(PG8_SB(1, 1), b3 + hstep, voffB);
            PG8_WAIT_V(6); PG8_BAR; PG8_MMA(1, 1, At, B1); PG8_BAR;
            }
        }
        if constexpr (ALIGN_EPI) { if (wr == 0) PG8_BAR; }
        if constexpr (!Epi::AFTER_DRAIN) { E(acc, cur, wr, wc, fr, fq); S.done(cur); }
        if (!has_next) break;
#pragma unroll
        for (int a = 0; a < 2; ++a)
#pragma unroll
            for (int b = 0; b < 2; ++b)
#pragma unroll
                for (int m = 0; m < 4; ++m)
#pragma unroll
                    for (int n = 0; n < 2; ++n) acc[a][b][m][n] = (f32x4){0.f, 0.f, 0.f, 0.f};
        cur = nxt; cA = nA; cB = nB; ++ui;
        if constexpr (ALIGN_EPI) { if (wr == 1) PG8_BAR; }
    }
    PG8_WAIT_V(0);
    if constexpr (!ALIGN_EPI) { if (wr == 0) PG8_BAR; }
    PG8_BAR;
    if constexpr (Epi::AFTER_DRAIN) { E.fused(acc, cur, wr, wc, fr, fq, lds, wid, lane); S.done(cur); }
#undef PG8_SA
#undef PG8_SB
#undef PG8_STAGE
#undef PG8_LDA
#undef PG8_LDB
#undef PG8_MMA
#undef PG8_WAIT_V
#undef PG8_WAIT_L
#undef PG8_BAR
#undef PG8_SCHED
}
}

#define LAS __attribute__((address_space(3)))
#define GAS __attribute__((address_space(1)))
#define GLD(T, p) (*(const GAS T*)(p))
#define GST(T, p, v) (*(GAS T*)(p) = (v))
typedef unsigned short bf16_t;
typedef short bf16x8 __attribute__((ext_vector_type(8)));
typedef short bf16x4 __attribute__((ext_vector_type(4)));
typedef float f32x4 __attribute__((ext_vector_type(4)));
typedef float f32x16 __attribute__((ext_vector_type(16)));
typedef unsigned u32x4 __attribute__((ext_vector_type(4)));
typedef unsigned u32x2 __attribute__((ext_vector_type(2)));

constexpr int BATCH = 8, SEQ = 4096, DM = 1024, MTOK = BATCH * SEQ, DFF = 2816, DEPTH = 2, NIN = 4888;
constexpr int NTHR = 512, NWAVE = 8;
constexpr float EPS = 1e-6f, LOG2E = 1.4426950408889634f;
constexpr float QSCALE = 0.125f * LOG2E;
constexpr size_t MiB = 1u << 20;
constexpr size_t WS_BIAS = 0;
constexpr size_t WS_PRM = 64 * 1024;
constexpr size_t WS_CB1 = 68 * 1024;
constexpr size_t WS_W13 = 1 * MiB;
constexpr size_t W13_SZ = (size_t)5632 * 1024 * 2;
constexpr size_t WS_W2 = 45 * MiB;
constexpr size_t W2_SZ = (size_t)1024 * 2816 * 2;
constexpr size_t WS_WIN = 68 * MiB;
constexpr size_t WIN_SZ = (size_t)5120 * 1024 * 2;
constexpr size_t WS_PAB = 88 * MiB;
constexpr size_t PAB_SZ = (size_t)2048 * 1024 * 2;
constexpr size_t WS_WO = 96 * MiB;
constexpr size_t WO_SZ = (size_t)1024 * 1024 * 2;
constexpr size_t WS_CW1 = 100 * MiB;
constexpr size_t CW1_SZ = (size_t)128 * 2048 * 2;
constexpr size_t WS_CW2 = 102 * MiB;
constexpr size_t CW2_SZ = (size_t)64 * 128 * 2;
constexpr size_t WS_KCN = 103 * MiB;
constexpr size_t WS_VCT = WS_KCN + 512 * 1024;
constexpr size_t WS_XN = 104 * MiB;
constexpr size_t WS_Z = 168 * MiB;
constexpr size_t Z_DQ = WS_Z, Z_DK = WS_Z + 32 * MiB, Z_DVT = WS_Z + 64 * MiB, Z_NQ = WS_Z + 96 * MiB;
constexpr size_t Z_KCR = WS_Z + 128 * MiB, Z_VCR = WS_Z + 136 * MiB, Z_KSEL = WS_Z + 144 * MiB, Z_VSELT = WS_Z + 152 * MiB;
constexpr size_t Z_KWIN = WS_Z + 160 * MiB, Z_VWINT = WS_Z + 168 * MiB, Z_NG = WS_Z + 176 * MiB, Z_MG = WS_Z + 180 * MiB;
constexpr size_t WS_MERGED = WS_Z;
constexpr size_t WS_HID = WS_Z;
constexpr size_t WS_END = WS_Z + 308 * MiB;
constexpr int LDS_BYTES = 147456;
constexpr int KP = 144, VP = 136;
constexpr int DA_STAGE = 2 * 64 * KP + 128 * VP;
constexpr int NS_STAGE = 64 * KP + 64 * VP;
constexpr int L_BIAS = 73728;
constexpr int TBN = 1216;
constexpr int L_IMP = L_BIAS + 4 * TBN * 4;
constexpr int L_SEL = L_IMP + 16384;
constexpr int L_WSF = L_SEL + 1024;
constexpr int L_END = L_WSF + 8 * 256;

struct Params {
    const float* in[30];
    float* out;
    unsigned char* ws;
};

constexpr int L_PTAB = LDS_BYTES - 1024;
__device__ __forceinline__ const float* ld_ptr(const LAS unsigned char* lds, int i) {
    unsigned a = L_PTAB + 8 * i; asm volatile("" : "+v"(a));
    const LAS unsigned* t = (const LAS unsigned*)(lds + a);
    const unsigned lo = __builtin_amdgcn_readfirstlane(t[0]), hi = __builtin_amdgcn_readfirstlane(t[1]);
    return (const float*)(((unsigned long long)hi << 32) | lo);
}
#define INP(i) ld_ptr(lds, (i))
#define OUTP ((float*)ld_ptr(lds, 30))
#define WSP ((unsigned char*)ld_ptr(lds, 31))

__device__ __forceinline__ unsigned f2bf(float f) { unsigned u = __builtin_bit_cast(unsigned, f); return (u + 0x7fffu + ((u >> 16) & 1u)) >> 16; }
__device__ __forceinline__ unsigned pk2(float lo, float hi) { return f2bf(lo) | (f2bf(hi) << 16); }
__device__ __forceinline__ float sigmoidf_(float x) { return __builtin_amdgcn_rcpf(1.0f + __builtin_amdgcn_exp2f(-x * LOG2E)); }
__device__ __forceinline__ int otid() { int t = threadIdx.x; asm volatile("" : "+v"(t)); return t; }
__device__ __forceinline__ int crow(int r, int hi) { return (r & 3) + 8 * (r >> 2) + 4 * hi; }

struct EpiSwiGLU {
    static constexpr bool PERM = true, AFTER_DRAIN = false;
    bf16_t* H;
    __device__ __forceinline__ void operator()(const f32x4 (&acc)[2][2][4][2], const pg8::Unit& u, int wr, int wc, int fr, int fq) const {
        const int row0 = u.pm * 256 + wr * 64 + fr, col = u.pn * 128 + wc * 32 + 8 * fq;
#pragma unroll
        for (int ai = 0; ai < 2; ++ai)
#pragma unroll
            for (int m = 0; m < 4; ++m) {
                float h[8];
#pragma unroll
                for (int n = 0; n < 2; ++n)
#pragma unroll
                    for (int e = 0; e < 4; ++e) { const float g = acc[ai][0][m][n][e], up = acc[ai][1][m][n][e]; h[n * 4 + e] = g * sigmoidf_(g) * up; }
                u32x4 w; w.x = pg8::cvt_pk_bf16(h[0], h[1]); w.y = pg8::cvt_pk_bf16(h[2], h[3]); w.z = pg8::cvt_pk_bf16(h[4], h[5]); w.w = pg8::cvt_pk_bf16(h[6], h[7]);
                GST(u32x4, H + (size_t)(row0 + ai * 128 + m * 16) * DFF + col, w);
            }
    }
};
struct EpiResid {
    static constexpr bool PERM = false, AFTER_DRAIN = false;
    const float* base; float* out; float alpha;
    __device__ __forceinline__ void operator()(const f32x4 (&acc)[2][2][4][2], const pg8::Unit& u, int wr, int wc, int fr, int fq) const {
        const int row0 = u.pm * 256 + wr * 64 + fr, col0 = u.pn * 256 + wc * 32 + 4 * fq;
#pragma unroll
        for (int ai = 0; ai < 2; ++ai) {
            f32x4 bv[4][2][2];
#pragma unroll
            for (int m = 0; m < 4; ++m) {
                const size_t off = (size_t)(row0 + ai * 128 + m * 16) * DM + col0;
#pragma unroll
                for (int bj = 0; bj < 2; ++bj)
#pragma unroll
                    for (int n = 0; n < 2; ++n) bv[m][bj][n] = GLD(f32x4, base + off + bj * 128 + n * 16);
            }
#pragma unroll
            for (int m = 0; m < 4; ++m) {
                const size_t off = (size_t)(row0 + ai * 128 + m * 16) * DM + col0;
#pragma unroll
                for (int bj = 0; bj < 2; ++bj)
#pragma unroll
                    for (int n = 0; n < 2; ++n) GST(f32x4, out + off + bj * 128 + n * 16, bv[m][bj][n] + acc[ai][bj][m][n] * alpha);
            }
        }
    }
};
struct EpiMerge {
    static constexpr bool PERM = true, AFTER_DRAIN = false;
    const bf16_t* MG; bf16_t* O;
    __device__ __forceinline__ void operator()(const f32x4 (&acc)[2][2][4][2], const pg8::Unit& u, int wr, int wc, int fr, int fq) const {
        const int row0 = u.pm * 256 + wr * 64 + fr, col = u.pn * 128 + wc * 32 + 8 * fq;
#pragma unroll
        for (int ai = 0; ai < 2; ++ai) {
            u32x4 g0[4], g1[4];
#pragma unroll
            for (int m = 0; m < 4; ++m) { const int row = row0 + ai * 128 + m * 16; g0[m] = GLD(u32x4, MG + (size_t)row * 2048 + col); g1[m] = GLD(u32x4, MG + (size_t)row * 2048 + 1024 + col); }
#pragma unroll
            for (int m = 0; m < 4; ++m) {
                const int row = row0 + ai * 128 + m * 16;
                float h[8];
#pragma unroll
                for (int i = 0; i < 8; ++i) {
                    const unsigned w0 = g0[m][i >> 1], w1 = g1[m][i >> 1];
                    const float a0 = __builtin_bit_cast(float, (i & 1) ? (w0 & 0xffff0000u) : (w0 << 16)), a1 = __builtin_bit_cast(float, (i & 1) ? (w1 & 0xffff0000u) : (w1 << 16));
                    h[i] = a0 * acc[ai][0][m][i >> 2][i & 3] + a1 * acc[ai][1][m][i >> 2][i & 3];
                }
                u32x4 w; w.x = pg8::cvt_pk_bf16(h[0], h[1]); w.y = pg8::cvt_pk_bf16(h[2], h[3]); w.z = pg8::cvt_pk_bf16(h[4], h[5]); w.w = pg8::cvt_pk_bf16(h[6], h[7]);
                GST(u32x4, O + (size_t)row * DM + col, w);
            }
        }
    }
};
struct EpiZ {
    static constexpr bool PERM = true, AFTER_DRAIN = false;
    unsigned char* ws; const float *gq, *gk, *gnq, *gnk;
    __device__ __forceinline__ void operator()(const f32x4 (&acc)[2][2][4][2], const pg8::Unit& u, int wr, int wc, int fr, int fq) const {
        const int ch = 4 * u.pn + wc;
        if (ch >= 77) return;
        const int row0 = u.pm * 256 + wr * 64 + fr;
        int kind, nh = 8, hd = 0, nd = 64, dbase = 0; size_t dst = 0; const float* gain = nullptr; float scale = 1.f;
        if (ch < 8) { kind = 0; dst = Z_DQ; hd = ch; gain = gq; scale = QSCALE; }
        else if (ch < 16) { kind = 0; dst = Z_DK; hd = ch - 8; gain = gk; }
        else if (ch < 24) { kind = 2; dst = Z_DVT; nh = 4; hd = (ch - 16) >> 1; nd = 128; dbase = ((ch - 16) & 1) * 64; }
        else if (ch < 32) { kind = 0; dst = Z_NQ; hd = ch - 24; gain = gnq; scale = QSCALE; }
        else if (ch < 34) { kind = 1; dst = Z_KCR; nh = 2; hd = ch - 32; }
        else if (ch < 36) { kind = 1; dst = Z_VCR; nh = 2; hd = ch - 34; }
        else if (ch < 38) { kind = 0; dst = Z_KSEL; nh = 2; hd = ch - 36; gain = gnk + 64; }
        else if (ch < 40) { kind = 2; dst = Z_VSELT; nh = 2; hd = ch - 38; }
        else if (ch < 42) { kind = 0; dst = Z_KWIN; nh = 2; hd = ch - 40; gain = gnk + 128; }
        else if (ch < 44) { kind = 2; dst = Z_VWINT; nh = 2; hd = ch - 42; }
        else if (ch < 76) { kind = 3; }
        else { kind = 4; }
        if (kind == 0 || kind == 1) {
            float gv[16];
#pragma unroll
            for (int i = 0; i < 16; ++i) gv[i] = (kind == 0) ? gain[(i >> 3) * 32 + 8 * fq + (i & 7)] * scale : 1.f;
#pragma unroll
            for (int ai = 0; ai < 2; ++ai)
#pragma unroll
                for (int m = 0; m < 4; ++m) {
                    const int row = row0 + ai * 128 + m * 16, b = row >> 12, s = row & 4095;
                    float v[16];
#pragma unroll
                    for (int i = 0; i < 16; ++i) v[i] = acc[ai][i >> 3][m][(i >> 2) & 1][i & 3];
                    float rs = 1.f;
                    if (kind == 0) {
                        float ss = 0.f;
#pragma unroll
                        for (int i = 0; i < 16; ++i) ss += v[i] * v[i];
                        ss += __shfl_xor(ss, 16); ss += __shfl_xor(ss, 32);
                        rs = __builtin_amdgcn_rsqf(ss * (1.f / 64.f) + EPS);
                    }
#pragma unroll
                    for (int i = 0; i < 16; ++i) v[i] *= rs * gv[i];
                    bf16_t* d = (bf16_t*)(ws + dst) + ((size_t)(b * nh + hd) * SEQ + s) * 64 + 8 * fq;
                    u32x4 w0, w1;
                    w0.x = pg8::cvt_pk_bf16(v[0], v[1]); w0.y = pg8::cvt_pk_bf16(v[2], v[3]); w0.z = pg8::cvt_pk_bf16(v[4], v[5]); w0.w = pg8::cvt_pk_bf16(v[6], v[7]);
                    w1.x = pg8::cvt_pk_bf16(v[8], v[9]); w1.y = pg8::cvt_pk_bf16(v[10], v[11]); w1.z = pg8::cvt_pk_bf16(v[12], v[13]); w1.w = pg8::cvt_pk_bf16(v[14], v[15]);
                    GST(u32x4, d, w0); GST(u32x4, d + 32, w1);
                }
        } else if (kind == 2) {
#pragma unroll
            for (int ai = 0; ai < 2; ++ai)
#pragma unroll
                for (int m = 0; m < 4; ++m) {
                    const int row = row0 + ai * 128 + m * 16, b = row >> 12, s = row & 4095;
                    bf16_t* d = (bf16_t*)(ws + dst) + ((size_t)(b * nh + hd) * nd + dbase + 8 * fq) * SEQ + s;
#pragma unroll
                    for (int i = 0; i < 16; ++i) GST(bf16_t, d + (size_t)((i >> 3) * 32 + (i & 7)) * SEQ, (bf16_t)f2bf(acc[ai][i >> 3][m][(i >> 2) & 1][i & 3]));
                }
        } else if (kind == 3) {
            const int col = (ch - 44) * 64 + 8 * fq;
#pragma unroll
            for (int ai = 0; ai < 2; ++ai)
#pragma unroll
                for (int m = 0; m < 4; ++m) {
                    const int row = row0 + ai * 128 + m * 16;
                    float v[16];
#pragma unroll
                    for (int i = 0; i < 16; ++i) v[i] = sigmoidf_(acc[ai][i >> 3][m][(i >> 2) & 1][i & 3]);
                    bf16_t* d = (bf16_t*)(ws + Z_MG) + (size_t)row * 2048 + col;
                    u32x4 w0, w1;
                    w0.x = pg8::cvt_pk_bf16(v[0], v[1]); w0.y = pg8::cvt_pk_bf16(v[2], v[3]); w0.z = pg8::cvt_pk_bf16(v[4], v[5]); w0.w = pg8::cvt_pk_bf16(v[6], v[7]);
                    w1.x = pg8::cvt_pk_bf16(v[8], v[9]); w1.y = pg8::cvt_pk_bf16(v[10], v[11]); w1.z = pg8::cvt_pk_bf16(v[12], v[13]); w1.w = pg8::cvt_pk_bf16(v[14], v[15]);
                    GST(u32x4, d, w0); GST(u32x4, d + 32, w1);
                }
        } else {
            if (fq < 3) {
#pragma unroll
                for (int ai = 0; ai < 2; ++ai)
#pragma unroll
                    for (int m = 0; m < 4; ++m) {
                        const int row = row0 + ai * 128 + m * 16;
                        float* d = (float*)(ws + Z_NG) + (size_t)row * 24 + 8 * fq;
#pragma unroll
                        for (int i = 0; i < 8; ++i) GST(float, d + i, sigmoidf_(acc[ai][0][m][i >> 2][i & 3]));
                    }
            }
        }
    }
};

__device__ __forceinline__ void tr_item(const float* src, int ld, int c0, int nvalid, int k0, bf16_t* dst, int Kdst, LAS float* scr, int lane) {
    const int n = lane & 31;
#pragma unroll
    for (int i = 0; i < 32; ++i) { const int kk = 2 * i + (lane >> 5); scr[kk * 33 + n] = (src && n < nvalid) ? GLD(float, src + (size_t)(k0 + kk) * ld + c0 + n) : 0.f; }
    asm volatile("s_waitcnt lgkmcnt(0)" ::: "memory");
    const int c = lane & 7;
#pragma unroll
    for (int j = 0; j < 4; ++j) { const int nn = (lane >> 3) + 8 * j; const LAS float* s = scr + (8 * c) * 33 + nn;
        u32x4 o; o.x = pk2(s[0 * 33], s[1 * 33]); o.y = pk2(s[2 * 33], s[3 * 33]); o.z = pk2(s[4 * 33], s[5 * 33]); o.w = pk2(s[6 * 33], s[7 * 33]);
        GST(u32x4, dst + (size_t)nn * Kdst + 8 * c, o); }
    asm volatile("s_waitcnt lgkmcnt(0)" ::: "memory");
}
__device__ __forceinline__ int zchunk_src(int ch) {
    if (ch < 32) return ch * 64;
    if (ch < 44) return 2048 + (ch - 32) * 64;
    if (ch < 76) return 2840 + (ch - 44) * 64;
    return 2816;
}
__device__ __forceinline__ int t5_bucket(int n) {
    if (n < 16) return n;
    int b = 16;
    b += (n >= 21); b += (n >= 27); b += (n >= 35); b += (n >= 46); b += (n >= 59); b += (n >= 77); b += (n >= 99); b += (n >= 128);
    b += (n >= 166); b += (n >= 216); b += (n >= 280); b += (n >= 363); b += (n >= 470); b += (n >= 609); b += (n >= 790);
    return b;
}
__device__ __forceinline__ void prologue(const Params& P, LAS unsigned char* lds) {
    const int tid = otid(), lane = tid & 63, wave = tid >> 6;
    LAS float* scr = (LAS float*)(lds + wave * 16384);
    const int gw = blockIdx.x * NWAVE + wave, NGW = gridDim.x * NWAVE;
    unsigned char* ws = WSP;
    constexpr int I13 = 176 * 16, I2 = 32 * 44, IIN = 160 * 16, IPAB = 64 * 16, IWO = 32 * 16, IC1 = 4 * 32, IC2 = 2 * 2;
    constexpr int PER_L = 2 * I13 + 2 * I2 + IIN + IPAB + IWO + 2 * IC1 + 2 * IC2;
    for (int it = gw; it < DEPTH * PER_L; it += NGW) {
        const int l = it / PER_L; int r = it % PER_L;
        if (r < 2 * I13) {
            const int f = r / I13; r %= I13; const int gi = r / 16, kb = r % 16;
            const int t = gi >> 3, bj = (gi >> 2) & 1, sub = gi & 3;
            const float* src = (f ? (bj ? INP(12) : INP(11)) : (bj ? INP(9) : INP(8))) + (size_t)l * DM * DFF;
            tr_item(src, DFF, 128 * t + 32 * sub, 32, 64 * kb, (bf16_t*)(ws + WS_W13 + (size_t)(l * 2 + f) * W13_SZ) + (size_t)(32 * gi) * DM + 64 * kb, DM, scr, lane);
            continue;
        }
        r -= 2 * I13;
        if (r < 2 * I2) {
            const int f = r / I2; r %= I2; const int gi = r / 44, kb = r % 44;
            const float* src = (f ? INP(13) : INP(10)) + (size_t)l * DFF * DM;
            tr_item(src, DM, 32 * gi, 32, 64 * kb, (bf16_t*)(ws + WS_W2 + (size_t)(l * 2 + f) * W2_SZ) + (size_t)(32 * gi) * DFF + 64 * kb, DFF, scr, lane);
            continue;
        }
        r -= 2 * I2;
        if (r < IIN) {
            const int gi = r / 16, kb = r % 16;
            const int t = gi >> 3, bj = (gi >> 2) & 1, wc = gi & 3, ch = 4 * t + wc;
            int nvalid = 32; if (ch == 76) nvalid = bj ? 0 : 24; if (ch > 76) nvalid = 0;
            const float* src = nvalid ? INP(1) + (size_t)l * DM * NIN : nullptr;
            tr_item(src, NIN, zchunk_src(ch) + 32 * bj, nvalid, 64 * kb, (bf16_t*)(ws + WS_WIN + (size_t)l * WIN_SZ) + (size_t)(32 * gi) * DM + 64 * kb, DM, scr, lane);
            continue;
        }
        r -= IIN;
        if (r < IPAB) {
            const int gi = r / 16, kb = r % 16;
            const int t = gi >> 3, bj = (gi >> 2) & 1, sub = gi & 3;
            const float* src = nullptr; int k0 = 0;
            if (bj == 0 && kb < 8) { src = INP(2) + (size_t)l * 512 * DM; k0 = 64 * kb; }
            if (bj == 1 && kb >= 8) { src = INP(3) + (size_t)l * 512 * DM; k0 = 64 * (kb - 8); }
            tr_item(src, DM, 128 * t + 32 * sub, 32, k0, (bf16_t*)(ws + WS_PAB + (size_t)l * PAB_SZ) + (size_t)(32 * gi) * DM + 64 * kb, DM, scr, lane);
            continue;
        }
        r -= IPAB;
        if (r < IWO) {
            const int gi = r / 16, kb = r % 16;
            tr_item(INP(4) + (size_t)l * DM * DM, DM, 32 * gi, 32, 64 * kb, (bf16_t*)(ws + WS_WO + (size_t)l * WO_SZ) + (size_t)(32 * gi) * DM + 64 * kb, DM, scr, lane);
            continue;
        }
        r -= IWO;
        if (r < 2 * IC1) {
            const int kv = r / IC1; r %= IC1; const int gi = r / 32, kb = r % 32;
            tr_item((kv ? INP(27) : INP(24)) + (size_t)l * 2048 * 128, 128, 32 * gi, 32, 64 * kb, (bf16_t*)(ws + WS_CW1 + (size_t)(l * 2 + kv) * CW1_SZ) + (size_t)(32 * gi) * 2048 + 64 * kb, 2048, scr, lane);
            continue;
        }
        r -= 2 * IC1;
        {
            const int kv = r / IC2; r %= IC2; const int gi = r / 2, kb = r % 2;
            tr_item((kv ? INP(28) : INP(25)) + (size_t)l * 128 * 64, 64, 32 * gi, 32, 64 * kb, (bf16_t*)(ws + WS_CW2 + (size_t)(l * 2 + kv) * CW2_SZ) + (size_t)(32 * gi) * 128 + 64 * kb, 128, scr, lane);
        }
    }
    const int gt = blockIdx.x * NTHR + tid, NGT = gridDim.x * NTHR;
    for (int i = gt; i < 12 * 1024; i += NGT) { const int h = i >> 10, d = i & 1023; ((float*)(ws + WS_BIAS))[i] = INP(29)[t5_bucket(d) * 12 + h] * LOG2E; }
    if (blockIdx.x == (gridDim.x > 1 ? 1 : 0) && wave < DEPTH) {
        const int l = wave;
        float a = INP(16)[l * 64 + lane] * INP(17)[l * 64 + lane], b = INP(18)[l * 64 + lane] * INP(19)[l * 64 + lane];
        float mq = fabsf(INP(14)[l * 64 + lane]), mk = fabsf(INP(15)[l * 64 + lane]), mnq = fabsf(INP(21)[l * 64 + lane]);
        float mnk = fmaxf(fmaxf(fabsf(INP(22)[l * 192 + lane]), fabsf(INP(22)[l * 192 + 64 + lane])), fabsf(INP(22)[l * 192 + 128 + lane]));
        float mb = 0.f; for (int i = lane; i < 32 * 12; i += 64) mb = fmaxf(mb, fabsf(INP(29)[i]));
#pragma unroll
        for (int o = 1; o < 64; o <<= 1) { a += __shfl_xor(a, o); b += __shfl_xor(b, o); mq = fmaxf(mq, __shfl_xor(mq, o)); mk = fmaxf(mk, __shfl_xor(mk, o)); mnq = fmaxf(mnq, __shfl_xor(mnq, o)); mnk = fmaxf(mnk, __shfl_xor(mnk, o)); mb = fmaxf(mb, __shfl_xor(mb, o)); }
        if (lane == 0) {
            float* prm = (float*)(ws + WS_PRM) + l * 8;
            const float lam_init = 0.8f - 0.6f * expf(-0.3f * (float)l);
            prm[0] = expf(a) - expf(b) + lam_init;
            prm[1] = (8.f * mq * mk * 1.02f + mb) * LOG2E;
            prm[2] = (8.f * mnq * mnk * 1.02f + mb) * LOG2E;
            prm[3] = 1.0f - lam_init;
        }
    }
    for (int wi = blockIdx.x; wi < 32; wi += gridDim.x) {
        const int lk = wi >> 3, n = (wi & 7) * 16 + (tid & 15), ks = tid >> 4, l = lk >> 1, kv = lk & 1;
        const float* pe = (kv ? INP(26) : INP(23)) + (size_t)l * 2048; const float* w1 = (kv ? INP(27) : INP(24)) + (size_t)l * 2048 * 128;
        float sacc = 0.f;
#pragma unroll 16
        for (int k = 64 * ks; k < 64 * ks + 64; ++k) sacc += GLD(float, pe + k) * GLD(float, w1 + (size_t)k * 128 + n);
        LAS float* red = (LAS float*)lds;
        __syncthreads();
        red[tid] = sacc;
        __syncthreads();
        if (tid < 16) { float t = 0.f; for (int i = 0; i < 32; ++i) t += red[i * 16 + tid]; ((float*)(ws + WS_CB1))[lk * 128 + (wi & 7) * 16 + tid] = t; }
        __syncthreads();
    }
}

__device__ __forceinline__ void rmsnorm_phase(const float* x, const float* g, bf16_t* o) {
    const int tid = otid(), lane = tid & 63, wave = tid >> 6;
    const int gw = blockIdx.x * NWAVE + wave, NGW = gridDim.x * NWAVE;
    f32x4 gv[4];
#pragma unroll
    for (int j = 0; j < 4; ++j) gv[j] = GLD(f32x4, (const f32x4*)g + lane + 64 * j);
    constexpr int RB = 4;
    for (int m0 = gw; m0 < MTOK; m0 += NGW * RB) {
        f32x4 v[RB][4]; float s[RB];
#pragma unroll
        for (int r = 0; r < RB; ++r) { const int m = m0 + r * NGW; const f32x4* xr = (const f32x4*)(x + (size_t)(m < MTOK ? m : m0) * DM) + lane;
#pragma unroll
            for (int j = 0; j < 4; ++j) v[r][j] = GLD(f32x4, xr + 64 * j); }
#pragma unroll
        for (int r = 0; r < RB; ++r) { s[r] = 0.f;
#pragma unroll
            for (int j = 0; j < 4; ++j) s[r] += (v[r][j].x * v[r][j].x + v[r][j].y * v[r][j].y) + (v[r][j].z * v[r][j].z + v[r][j].w * v[r][j].w); }
#pragma unroll
        for (int of = 1; of < 64; of <<= 1) {
#pragma unroll
            for (int r = 0; r < RB; ++r) s[r] += __shfl_xor(s[r], of); }
#pragma unroll
        for (int r = 0; r < RB; ++r) { const int m = m0 + r * NGW;
            if (m < MTOK) {
                const float rs = __builtin_amdgcn_rsqf(s[r] * (1.f / DM) + EPS);
                u32x2* o8 = (u32x2*)(o + (size_t)m * DM) + lane;
#pragma unroll
                for (int j = 0; j < 4; ++j) { u32x2 w; w.x = pk2(v[r][j].x * rs * gv[j].x, v[r][j].y * rs * gv[j].y); w.y = pk2(v[r][j].z * rs * gv[j].z, v[r][j].w * rs * gv[j].w); GST(u32x2, o8 + 64 * j, w); }
            }
        }
    }
}

__device__ __forceinline__ float gelu_tanh(float x) {
    const float y = 0.7978845608028654f * (x + 0.044715f * x * x * x);
    const float e = __builtin_amdgcn_exp2f(2.f * LOG2E * y);
    const float t = 1.f - 2.f * __builtin_amdgcn_rcpf(e + 1.f);
    return 0.5f * x * (1.f + t);
}
__device__ __forceinline__ void compress_phase(const Params& P, int l, LAS unsigned char* lds) {
    const int tid = otid(), lane = tid & 63, wave = tid >> 6, fr = lane & 15, kq = lane >> 4;
    unsigned char* ws = WSP;
    LAS bf16_t* Hs = (LAS bf16_t*)lds;
    LAS float* Os = (LAS float*)(lds + 8192);
    for (int unit = blockIdx.x; unit < 2 * 16 * 16; unit += gridDim.x) {
        const int kv = unit >> 8, bg = (unit >> 4) & 15, cblk = unit & 15, c0 = 16 * cblk;
        const bf16_t* src = (const bf16_t*)(ws + (kv ? Z_VCR : Z_KCR)) + (size_t)bg * SEQ * 64;
        const int crow_ = (c0 + fr) < 255 ? (c0 + fr) : 254;
        const bf16_t* ap = src + (size_t)1024 * crow_ + 8 * kq;
        const bf16_t* bp = (const bf16_t*)(ws + WS_CW1 + (size_t)(l * 2 + kv) * CW1_SZ) + (size_t)(16 * wave + fr) * 2048 + 8 * kq;
        f32x4 acc = {0.f, 0.f, 0.f, 0.f};
#pragma unroll 8
        for (int kk = 0; kk < 64; ++kk) { const bf16x8 a = GLD(bf16x8, ap + 32 * kk), b = GLD(bf16x8, bp + 32 * kk); acc = __builtin_amdgcn_mfma_f32_16x16x32_bf16(a, b, acc, 0, 0, 0); }
        const float cb = ((const float*)(ws + WS_CB1))[(l * 2 + kv) * 128 + 16 * wave + fr];
#pragma unroll
        for (int i = 0; i < 4; ++i) Hs[(4 * kq + i) * 136 + 16 * wave + fr] = (bf16_t)f2bf(gelu_tanh(acc[i] + cb));
        __syncthreads();
        if (wave < 4) {
            const bf16_t* b2 = (const bf16_t*)(ws + WS_CW2 + (size_t)(l * 2 + kv) * CW2_SZ) + (size_t)(16 * wave + fr) * 128 + 8 * kq;
            f32x4 a2 = {0.f, 0.f, 0.f, 0.f};
#pragma unroll
            for (int kk = 0; kk < 4; ++kk) { const bf16x8 a = *(const LAS bf16x8*)(Hs + fr * 136 + 32 * kk + 8 * kq), b = *(const bf16x8*)(b2 + 32 * kk); a2 = __builtin_amdgcn_mfma_f32_16x16x32_bf16(a, b, a2, 0, 0, 0); }
#pragma unroll
            for (int i = 0; i < 4; ++i) Os[(4 * kq + i) * 65 + 16 * wave + fr] = a2[i];
        }
        __syncthreads();
#pragma unroll
        for (int rep = 0; rep < 2; ++rep) {
            const int e = tid + NTHR * rep, row = e >> 6, d = e & 63, c = c0 + row;
            const float val = Os[row * 65 + d];
            if (kv == 0) {
                float ss = 0.f;
                for (int j = 0; j < 64; ++j) { const float t = Os[row * 65 + j]; ss += t * t; }
                const float o = val * __builtin_amdgcn_rsqf(ss * (1.f / 64.f) + EPS) * INP(22)[l * 192 + d];
                ((bf16_t*)(ws + WS_KCN))[((size_t)bg * 256 + c) * 64 + d] = (c < 255) ? (bf16_t)f2bf(o) : (bf16_t)0;
            } else {
                ((bf16_t*)(ws + WS_VCT))[((size_t)bg * 64 + d) * 256 + c] = (c < 255) ? (bf16_t)f2bf(val) : (bf16_t)0;
            }
        }
        __syncthreads();
    }
}

__device__ __forceinline__ void qk_tile(f32x16& p0, f32x16& p1, const LAS unsigned char* Kl, const bf16x8 (&qf)[4], int r32, int hi) {
    const LAS unsigned char* kb = Kl + r32 * KP + hi * 16;
    bf16x8 a[8];
#pragma unroll
    for (int d0 = 0; d0 < 4; ++d0) { a[2 * d0] = *(const LAS bf16x8*)(kb + d0 * 32); a[2 * d0 + 1] = *(const LAS bf16x8*)(kb + 32 * KP + d0 * 32); }
    __builtin_amdgcn_s_setprio(1);
#pragma unroll
    for (int d0 = 0; d0 < 4; ++d0) {
        p0 = __builtin_amdgcn_mfma_f32_32x32x16_bf16(a[2 * d0], qf[d0], p0, 0, 0, 0);
        p1 = __builtin_amdgcn_mfma_f32_32x32x16_bf16(a[2 * d0 + 1], qf[d0], p1, 0, 0, 0);
    }
    __builtin_amdgcn_s_setprio(0);
}
template <int STRIDE, bool WINDOW, int MODE>
__device__ __forceinline__ void score_exp(f32x16& p0, f32x16& p1, int dl, const LAS float* tb, float cfar, bool rowsel) {
    const LAS float* tl = tb + 128 + (dl < 1087 ? dl : 1087) - 59;
#pragma unroll
    for (int blk = 0; blk < 2; ++blk) {
        f32x16& p = blk ? p1 : p0;
#pragma unroll
        for (int r = 0; r < 16; ++r) {
            const int c = (r & 3) + 8 * (r >> 2) + 32 * blk;
            const int dist = dl - STRIDE * c;
            float e;
            if (MODE == 0) e = __builtin_amdgcn_exp2f(p[r] + cfar);
            else {
                float bias;
                if (STRIDE == 1) bias = tl[59 - c];
                else bias = tb[128 + min((unsigned)dist, 1023u)];
                e = __builtin_amdgcn_exp2f(p[r] + bias);
                if (MODE == 2) { bool valid = dist >= 0; if (WINDOW) valid = valid && (dist < 512); e = valid ? e : 0.f; }
            }
            p[r] = rowsel ? e : 0.f;
        }
    }
}
template <int STRIDE, bool WINDOW>
__device__ __forceinline__ void score_exp_sel(f32x16& p0, f32x16& p1, int dl, const LAS float* tb, float cfar, bool rowsel, int dmin, int dmax) {
    if (!WINDOW && dmin >= 790) score_exp<STRIDE, WINDOW, 0>(p0, p1, dl, tb, cfar, rowsel);
    else if (dmin >= 0 && (!WINDOW || dmax < 512)) score_exp<STRIDE, WINDOW, 1>(p0, p1, dl, tb, cfar, rowsel);
    else score_exp<STRIDE, WINDOW, 2>(p0, p1, dl, tb, cfar, rowsel);
}
__device__ __forceinline__ float sum32(const f32x16& p0, const f32x16& p1) {
    float a = 0.f, b = 0.f;
#pragma unroll
    for (int r = 0; r < 16; ++r) { a += p0[r]; b += p1[r]; }
    return a + b;
}
template <int NDB>
__device__ __forceinline__ void pv_tile(f32x16 (&o)[NDB], const f32x16& p0, const f32x16& p1, const LAS unsigned char* Vl, int r32, int hi) {
    const LAS unsigned char* vbase = Vl + r32 * VP + hi * 8;
    bf16x4 vf[2][NDB][2];
#define PV_LOAD(st, buf) do { _Pragma("unroll") for (int db = 0; db < NDB; ++db) { const LAS unsigned char* vp = vbase + db * 32 * VP + (st) * 32; vf[buf][db][0] = *(const LAS bf16x4*)vp; vf[buf][db][1] = *(const LAS bf16x4*)(vp + 16); } } while (0)
    PV_LOAD(0, 0);
#pragma unroll
    for (int st = 0; st < 4; ++st) {
        if (st + 1 < 4) PV_LOAD(st + 1, (st + 1) & 1);
        const f32x16& p = (st >> 1) ? p1 : p0; const int s8 = 8 * (st & 1);
        u32x4 w; w.x = pg8::cvt_pk_bf16(p[s8 + 0], p[s8 + 1]); w.y = pg8::cvt_pk_bf16(p[s8 + 2], p[s8 + 3]); w.z = pg8::cvt_pk_bf16(p[s8 + 4], p[s8 + 5]); w.w = pg8::cvt_pk_bf16(p[s8 + 6], p[s8 + 7]);
        const bf16x8 pa = __builtin_bit_cast(bf16x8, w);
        __builtin_amdgcn_s_setprio(1);
#pragma unroll
        for (int db = 0; db < NDB; ++db) {
            const bf16x4 lo = vf[st & 1][db][0], hi4 = vf[st & 1][db][1];
            const bf16x8 vb = {lo[0], lo[1], lo[2], lo[3], hi4[0], hi4[1], hi4[2], hi4[3]};
            o[db] = __builtin_amdgcn_mfma_f32_32x32x16_bf16(pa, vb, o[db], 0, 0, 0);
        }
        __builtin_amdgcn_s_setprio(0);
    }
#undef PV_LOAD
}
__device__ __forceinline__ u32x4 ldk(const bf16_t* g, int tid) { return GLD(u32x4, (const unsigned char*)g + tid * 16); }
__device__ __forceinline__ void stk(LAS unsigned char* Kl, u32x4 v, int tid) { *(LAS u32x4*)(Kl + (tid >> 3) * KP + (tid & 7) * 16) = v; }
__device__ __forceinline__ u32x4 ldv(const bf16_t* g, size_t rs, int row, int tid) { return GLD(u32x4, (const unsigned char*)(g + (size_t)row * rs) + (tid & 7) * 16); }
__device__ __forceinline__ void stv(LAS unsigned char* Vl, u32x4 v, int row, int tid) { LAS unsigned char* p = Vl + row * VP + (tid & 7) * 16; *(LAS u32x2*)p = (u32x2){v.x, v.y}; *(LAS u32x2*)(p + 8) = (u32x2){v.z, v.w}; }

__device__ __forceinline__ void da_unit(const Params& P, int l, int b, int h, int qb, LAS unsigned char* lds, bool load_tab) {
    const int tid = otid(), lane = tid & 63, wave = __builtin_amdgcn_readfirstlane(tid >> 6), r32 = lane & 31, hi = lane >> 5;
    const int c = wave >> 2, qsub = wave & 3, q0 = qb * 128, qw0 = q0 + 32 * qsub;
    unsigned char* ws = WSP;
    const float* prm = (const float*)(ws + WS_PRM) + l * 8;
    const float lam = prm[0], Mb = prm[1], onem = prm[3];
    LAS float* biasL = (LAS float*)(lds + L_BIAS);
    const float* bg = (const float*)(ws + WS_BIAS) + h * 1024;
    if (load_tab) for (int i = tid; i < TBN; i += NTHR) { const int d = i - 128; biasL[i] = GLD(float, bg + (d < 0 ? 0 : (d > 1023 ? 1023 : d))) - Mb; }
    const float cfar = bg[1023] - Mb;
    const bf16_t* Qp = (const bf16_t*)(ws + Z_DQ) + ((size_t)(b * 8 + h * 2 + c) * SEQ + qw0 + r32) * 64 + hi * 8;
    bf16x8 qf[4];
#pragma unroll
    for (int d0 = 0; d0 < 4; ++d0) qf[d0] = GLD(bf16x8, Qp + d0 * 16);
    const bf16_t* K1g = (const bf16_t*)(ws + Z_DK) + (size_t)(b * 8 + h * 2) * SEQ * 64;
    const bf16_t* K2g = K1g + (size_t)SEQ * 64;
    const bf16_t* Vg = (const bf16_t*)(ws + Z_DVT) + (size_t)(b * 4 + h) * 128 * SEQ;
    const int NT = (q0 + 128) / 64;
    f32x16 o[4];
#pragma unroll
    for (int i = 0; i < 4; ++i) o[i] = (f32x16){};
    float lsum = 0.f;
    u32x4 rk1, rk2, rv0, rv1;
#define DA_LOAD(t) do { rk1 = ldk(K1g + (size_t)(t) * 4096, tid); rk2 = ldk(K2g + (size_t)(t) * 4096, tid); rv0 = ldv(Vg + (t) * 64, SEQ, tid >> 3, tid); rv1 = ldv(Vg + (t) * 64, SEQ, 64 + (tid >> 3), tid); } while (0)
#define DA_STORE(sb) do { LAS unsigned char* st_ = lds + (sb) * DA_STAGE; stk(st_, rk1, tid); stk(st_ + 64 * KP, rk2, tid); stv(st_ + 128 * KP, rv0, tid >> 3, tid); stv(st_ + 128 * KP, rv1, 64 + (tid >> 3), tid); } while (0)
    DA_LOAD(0); DA_STORE(0);
    __syncthreads();
    for (int t = 0; t < NT; ++t) {
        if (t + 1 < NT) DA_LOAD(t + 1);
        if (64 * t <= qw0 + 31) {
            const LAS unsigned char* st = lds + (t & 1) * DA_STAGE;
            f32x16 p0 = (f32x16){}, p1 = (f32x16){};
            qk_tile(p0, p1, st + c * 64 * KP, qf, r32, hi);
            const int dl = qw0 + r32 - 64 * t - 4 * hi;
            score_exp_sel<1, false>(p0, p1, dl, biasL, cfar, true, qw0 - (64 * t + 63), qw0 + 31 - 64 * t);
            lsum += sum32(p0, p1);
            pv_tile<4>(o, p0, p1, st + 128 * KP, r32, hi);
        }
        if (t + 1 < NT) DA_STORE((t + 1) & 1);
        __syncthreads();
    }
#undef DA_LOAD
#undef DA_STORE
    lsum += __shfl_xor(lsum, 32);
    LAS float* wsf = (LAS float*)(lds + L_WSF) + wave * 64;
    if (hi == 0) wsf[r32] = (lsum > 0.f) ? 1.0f / lsum : 0.f;
    asm volatile("s_waitcnt lgkmcnt(0)" ::: "memory");
    float li[16];
#pragma unroll
    for (int r = 0; r < 16; ++r) li[r] = wsf[crow(r, hi)];
    LAS float* X = (LAS float*)lds;
    if (c == 1) {
#pragma unroll
        for (int db = 0; db < 4; ++db)
#pragma unroll
            for (int r = 0; r < 16; ++r) X[(32 * qsub + crow(r, hi)) * 132 + r32 + 32 * db] = o[db][r] * li[r];
    }
    __syncthreads();
    if (c == 0) {
        const float* sg = INP(20) + l * 128;
        float gsub[4];
#pragma unroll
        for (int db = 0; db < 4; ++db) gsub[db] = sg[r32 + 32 * db] * onem;
#pragma unroll
        for (int r = 0; r < 16; ++r) {
            float y[4], ss = 0.f;
#pragma unroll
            for (int db = 0; db < 4; ++db) { y[db] = o[db][r] * li[r] - lam * X[(32 * qsub + crow(r, hi)) * 132 + r32 + 32 * db]; ss += y[db] * y[db]; }
            ss += __shfl_xor(ss, 1); ss += __shfl_xor(ss, 2); ss += __shfl_xor(ss, 4); ss += __shfl_xor(ss, 8); ss += __shfl_xor(ss, 16);
            const float rs = __builtin_amdgcn_rsqf(ss * (1.f / 128.f) + EPS);
            bf16_t* d = (bf16_t*)(ws + WS_XN) + (size_t)(b * SEQ + qw0 + crow(r, hi)) * DM + h * 128 + r32;
#pragma unroll
            for (int db = 0; db < 4; ++db) GST(bf16_t, d + 32 * db, (bf16_t)f2bf(y[db] * rs * gsub[db]));
        }
    }
    __syncthreads();
}

__device__ __forceinline__ void nsa_unit(const Params& P, int l, int b, int g, int u, LAS unsigned char* lds, bool load_tab) {
    const int tid = otid(), lane = tid & 63, wave = __builtin_amdgcn_readfirstlane(tid >> 6), r32 = lane & 31, hi = lane >> 5;
    const int qi = r32 >> 2, p = r32 & 3, qw0 = 64 * u + 8 * wave, qpos = qw0 + qi, head = g * 4 + p;
    unsigned char* ws = WSP;
    const float Mb = ((const float*)(ws + WS_PRM))[l * 8 + 2];
    LAS float* biasL = (LAS float*)(lds + L_BIAS);
    LAS float* imp = (LAS float*)(lds + L_IMP);
    LAS unsigned* selw = (LAS unsigned*)(lds + L_SEL);
    LAS float* wsf = (LAS float*)(lds + L_WSF) + wave * 64;
    const float* bgl = (const float*)(ws + WS_BIAS) + (size_t)(4 + g * 4) * 1024;
    if (load_tab) for (int i = tid; i < 4 * TBN; i += NTHR) { const int hh = i / TBN, d = i % TBN - 128; biasL[i] = GLD(float, bgl + hh * 1024 + (d < 0 ? 0 : (d > 1023 ? 1023 : d))) - Mb; }
    if (tid == 0) { unsigned z = 0u; asm volatile("" : "+v"(z)); selw[128] = z; selw[129] = z; }
    const LAS float* tb = biasL + p * TBN;
    const float cfar = bgl[p * 1024 + 1023] - Mb;
    const bf16_t* Qp = (const bf16_t*)(ws + Z_NQ) + ((size_t)(b * 8 + head) * SEQ + qpos) * 64 + hi * 8;
    bf16x8 qf[4];
#pragma unroll
    for (int d0 = 0; d0 < 4; ++d0) qf[d0] = GLD(bf16x8, Qp + d0 * 16);
    const float* ngp = (const float*)(ws + Z_NG) + (size_t)(b * SEQ + qpos) * 24 + head * 3;
    const float gate_c = GLD(float, ngp), gate_s = GLD(float, ngp + 1), gate_w = GLD(float, ngp + 2);
    f32x16 oc[2]; oc[0] = (f32x16){}; oc[1] = (f32x16){};
    f32x16 o[2];
    u32x4 rk, rv;
    const int bgi = b * 2 + g;
#define NS_STORE(sb) do { LAS unsigned char* st_ = lds + (sb) * NS_STAGE; stk(st_, rk, tid); stv(st_ + 64 * KP, rv, tid >> 3, tid); } while (0)
#define NS_FOLD(gate) do { lsum += __shfl_xor(lsum, 32); if (hi == 0) wsf[r32] = (lsum > 0.f) ? (gate) / lsum : 0.f; asm volatile("s_waitcnt lgkmcnt(0)" ::: "memory"); \
        _Pragma("unroll") for (int r = 0; r < 16; ++r) { const float f_ = wsf[crow(r, hi)]; oc[0][r] += f_ * o[0][r]; oc[1][r] += f_ * o[1][r]; } asm volatile("s_waitcnt lgkmcnt(0)" ::: "memory"); } while (0)
    {
        const bf16_t* Kg = (const bf16_t*)(ws + WS_KCN) + (size_t)bgi * 256 * 64;
        const bf16_t* Vg = (const bf16_t*)(ws + WS_VCT) + (size_t)bgi * 64 * 256;
        const int ntc = (4 * u + 2) / 64 + 1;
        for (int tc = 0; tc < ntc; ++tc) { rk = ldk(Kg + (size_t)tc * 4096, tid); rv = ldv(Vg + tc * 64, 256, tid >> 3, tid); NS_STORE(tc); }
        __syncthreads();
        float lsum = 0.f;
        for (int tc = 0; tc < ntc; ++tc) {
            const LAS unsigned char* st = lds + tc * NS_STAGE;
            f32x16 p0 = (f32x16){}, p1 = (f32x16){};
            qk_tile(p0, p1, st, qf, r32, hi);
            const int dl = qpos - 31 - 16 * (64 * tc + 4 * hi);
            score_exp_sel<16, false>(p0, p1, dl, tb, cfar, true, qw0 - 31 - 16 * (64 * tc + 63), qw0 + 7 - 31 - 16 * 64 * tc);
            lsum += sum32(p0, p1);
        }
        const float lt = lsum + __shfl_xor(lsum, 32);
        const float linv = (lt > 0.f) ? 1.0f / lt : 0.f;
        o[0] = (f32x16){}; o[1] = (f32x16){};
        float carry = 0.f;
        for (int tc = 0; tc < ntc; ++tc) {
            const LAS unsigned char* st = lds + tc * NS_STAGE;
            f32x16 p0 = (f32x16){}, p1 = (f32x16){};
            qk_tile(p0, p1, st, qf, r32, hi);
            const int dl = qpos - 31 - 16 * (64 * tc + 4 * hi);
            score_exp_sel<16, false>(p0, p1, dl, tb, cfar, true, qw0 - 31 - 16 * (64 * tc + 63), qw0 + 7 - 31 - 16 * 64 * tc);
            float Qs[2][4], PL[2][4];
#pragma unroll
            for (int blk = 0; blk < 2; ++blk)
#pragma unroll
                for (int m = 0; m < 4; ++m) { const f32x16& pp = blk ? p1 : p0; Qs[blk][m] = (pp[4 * m] + pp[4 * m + 1]) + (pp[4 * m + 2] + pp[4 * m + 3]); PL[blk][m] = __shfl_xor(pp[4 * m + 3], 32); }
#pragma unroll
            for (int blk = 0; blk < 2; ++blk)
#pragma unroll
                for (int m = 0; m < 4; ++m) {
                    const float prev = (m > 0) ? PL[blk][m - 1] : (blk ? PL[0][3] : carry);
                    float e = (Qs[blk][m] + (hi ? PL[blk][m] : prev)) * linv;
                    e += __shfl_xor(e, 1); e += __shfl_xor(e, 2);
                    if (p == 0) imp[(8 * wave + qi) * 64 + 16 * tc + 8 * blk + 2 * m + hi] = e;
                }
            carry = PL[1][3];
            pv_tile<2>(o, p0, p1, st + 64 * KP, r32, hi);
        }
        NS_FOLD(gate_c);
    }
    __syncthreads();
    {
        const int ql = lane >> 3, sub = lane & 7, q = 8 * wave + ql;
        unsigned long long m;
        if (u < 8) m = (2ull << u) - 1ull;
        else {
            m = 1ull | (1ull << u) | (1ull << (u - 1));
            float v[8];
#pragma unroll
            for (int i = 0; i < 8; ++i) { const int j = sub + 8 * i; v[i] = (j >= 1 && j <= u - 2) ? imp[q * 64 + j] : -1.f; }
            for (int k = 0; k < 5; ++k) {
                float bv = v[0]; int bj = sub;
#pragma unroll
                for (int i = 1; i < 8; ++i) if (v[i] > bv) { bv = v[i]; bj = sub + 8 * i; }
#pragma unroll
                for (int of = 1; of < 8; of <<= 1) { const float ov = __shfl_xor(bv, of); const int oj = __shfl_xor(bj, of); if (ov > bv || (ov == bv && oj < bj)) { bv = ov; bj = oj; } }
                m |= 1ull << bj;
#pragma unroll
                for (int i = 0; i < 8; ++i) if (bj == sub + 8 * i) v[i] = -2.f;
            }
        }
        if (sub == 0) { selw[2 * q] = (unsigned)m; selw[2 * q + 1] = (unsigned)(m >> 32); atomicOr((unsigned*)&selw[128], (unsigned)m); atomicOr((unsigned*)&selw[129], (unsigned)(m >> 32)); }
    }
    __syncthreads();
    asm volatile("" : "+v"(oc[0]), "+v"(oc[1]));
    u32x4 rk2, rv2;
#define NS_LOADA(Kg_, Vg_, j_) do { rk = ldk((Kg_) + (size_t)(j_) * 4096, tid); rv = ldv((Vg_) + (j_) * 64, SEQ, tid >> 3, tid); } while (0)
#define NS_LOADB(Kg_, Vg_, j_) do { rk2 = ldk((Kg_) + (size_t)(j_) * 4096, tid); rv2 = ldv((Vg_) + (j_) * 64, SEQ, tid >> 3, tid); } while (0)
#define NS_STOREA(sb) do { LAS unsigned char* st_ = lds + (sb) * NS_STAGE; stk(st_, rk, tid); stv(st_ + 64 * KP, rv, tid >> 3, tid); } while (0)
#define NS_STOREB(sb) do { LAS unsigned char* st_ = lds + (sb) * NS_STAGE; stk(st_, rk2, tid); stv(st_ + 64 * KP, rv2, tid >> 3, tid); } while (0)
    {
        const unsigned long long un = (unsigned long long)selw[128] | ((unsigned long long)selw[129] << 32);
        const unsigned long long mine = (unsigned long long)selw[2 * (8 * wave + qi)] | ((unsigned long long)selw[2 * (8 * wave + qi) + 1] << 32);
        const bf16_t* Kg = (const bf16_t*)(ws + Z_KSEL) + (size_t)bgi * SEQ * 64;
        const bf16_t* Vg = (const bf16_t*)(ws + Z_VSELT) + (size_t)bgi * 64 * SEQ;
        o[0] = (f32x16){}; o[1] = (f32x16){};
        float lsum = 0.f;
        unsigned long long rem = un;
#define NS_NEXTJ(var, has) do { has = (rem != 0ull); var = 0; if (has) { var = __builtin_ctzll(rem); rem &= rem - 1; } } while (0)
        int jc, j1, j2; bool h1, h2;
        NS_NEXTJ(jc, h1);
        NS_NEXTJ(j1, h1);
        NS_LOADA(Kg, Vg, jc); if (h1) NS_LOADB(Kg, Vg, j1);
        NS_STOREA(0);
        __syncthreads();
        int sc = 0;
#define NS_SEL_STEP(LOADF, STOREN) { \
            NS_NEXTJ(j2, h2); if (h2) LOADF(Kg, Vg, j2); \
            const bool rowsel = (mine >> jc) & 1ull; \
            if (__any(rowsel)) { \
                const LAS unsigned char* st = lds + sc * NS_STAGE; \
                f32x16 p0 = (f32x16){}, p1 = (f32x16){}; \
                qk_tile(p0, p1, st, qf, r32, hi); \
                const int dl = qpos - 64 * jc - 4 * hi; \
                score_exp_sel<1, false>(p0, p1, dl, tb, cfar, rowsel, qw0 - (64 * jc + 63), qw0 + 7 - 64 * jc); \
                lsum += sum32(p0, p1); \
                pv_tile<2>(o, p0, p1, st + 64 * KP, r32, hi); \
            } \
            const int sn = (sc == 2) ? 0 : sc + 1; \
            if (h1) STOREN(sn); \
            __syncthreads(); \
            if (!h1) break; \
            jc = j1; j1 = j2; h1 = h2; sc = sn; }
        for (;;) { NS_SEL_STEP(NS_LOADA, NS_STOREB) NS_SEL_STEP(NS_LOADB, NS_STOREA) }
#undef NS_SEL_STEP
#undef NS_NEXTJ
        NS_FOLD(gate_s);
        asm volatile("" : "+v"(oc[0]), "+v"(oc[1]));
    }
    {
        const bf16_t* Kg = (const bf16_t*)(ws + Z_KWIN) + (size_t)bgi * SEQ * 64;
        const bf16_t* Vg = (const bf16_t*)(ws + Z_VWINT) + (size_t)bgi * 64 * SEQ;
        o[0] = (f32x16){}; o[1] = (f32x16){};
        float lsum = 0.f;
        const int t0 = (u >= 8) ? u - 8 : 0;
        int t = t0, sc = 0;
        NS_LOADA(Kg, Vg, t0); if (t0 + 1 <= u) NS_LOADB(Kg, Vg, t0 + 1);
        NS_STOREA(0);
        __syncthreads();
#define NS_WIN_STEP(LOADF, STOREN) { \
            if (t + 2 <= u) LOADF(Kg, Vg, t + 2); \
            { \
                const LAS unsigned char* st = lds + sc * NS_STAGE; \
                f32x16 p0 = (f32x16){}, p1 = (f32x16){}; \
                qk_tile(p0, p1, st, qf, r32, hi); \
                const int dl = qpos - 64 * t - 4 * hi; \
                score_exp_sel<1, true>(p0, p1, dl, tb, cfar, true, qw0 - (64 * t + 63), qw0 + 7 - 64 * t); \
                lsum += sum32(p0, p1); \
                pv_tile<2>(o, p0, p1, st + 64 * KP, r32, hi); \
            } \
            const int sn = (sc == 2) ? 0 : sc + 1; \
            if (t + 1 <= u) STOREN(sn); \
            __syncthreads(); \
            if (t + 1 > u) break; \
            ++t; sc = sn; }
        for (;;) { NS_WIN_STEP(NS_LOADA, NS_STOREB) NS_WIN_STEP(NS_LOADB, NS_STOREA) }
#undef NS_WIN_STEP
        NS_FOLD(gate_w);
    }
#undef NS_LOADA
#undef NS_LOADB
#undef NS_STOREA
#undef NS_STOREB
#undef NS_STORE
#undef NS_FOLD
#pragma unroll
    for (int r = 0; r < 16; ++r) {
        const int row = crow(r, hi), q = qw0 + (row >> 2), pp = row & 3;
        bf16_t* d = (bf16_t*)(ws + WS_XN) + (size_t)(b * SEQ + q) * DM + 512 + (g * 4 + pp) * 64 + r32;
        GST(bf16_t, d, (bf16_t)f2bf(oc[0][r])); GST(bf16_t, d + 32, (bf16_t)f2bf(oc[1][r]));
    }
    __syncthreads();
}

__device__ __forceinline__ void attention_phase(const Params& P, int l, LAS unsigned char* lds) {
    int tab_key = -1;
    for (int it = blockIdx.x; it < 2048; it += gridDim.x) {
        const int c = it & 255, sl = (it >> 8) & 3;
        if (it < 1024) { const int bh = c & 31, xg = c >> 5; const int qb = (sl == 0) ? 31 - xg : (sl == 1) ? 23 - xg : (sl == 2) ? 8 + xg : xg;
            da_unit(P, l, bh >> 2, bh & 3, qb, lds, tab_key != (bh & 3)); tab_key = bh & 3; }
        else { const int bg = c & 15, ug = c >> 4; const int u = (sl == 0) ? 63 - ug : (sl == 1) ? 47 - ug : (sl == 2) ? 16 + ug : ug;
            nsa_unit(P, l, bg >> 1, bg & 1, u, lds, tab_key != 4 + (bg & 1)); tab_key = 4 + (bg & 1); }
    }
}

constexpr size_t WS_BAR = 72 * 1024;
#define RLX_AGENT __ATOMIC_RELAXED, __HIP_MEMORY_SCOPE_AGENT
#define XB_TMO      128
#define XB_XCNT(j)  (256  + 64 * (j))
#define XB_XSUB(j)  (1280 + 64 * (j))
#define XB_XGEN(j)  (2304 + 64 * (j))
#define XB_TOP      3328
#define XB_TOPGEN   3392
#define XCD_BAR_WORDS 3456
#define XB_SPIN_CAP (1u << 18)

__device__ __forceinline__ unsigned xb_ld(unsigned* p)              { return __hip_atomic_load(p, __ATOMIC_RELAXED, __HIP_MEMORY_SCOPE_AGENT); }
__device__ __forceinline__ unsigned xb_add(unsigned* p, unsigned v) { return __hip_atomic_fetch_add(p, v, __ATOMIC_RELAXED, __HIP_MEMORY_SCOPE_AGENT); }
__device__ __forceinline__ unsigned xb_xcc_id() { return (unsigned)__builtin_amdgcn_s_getreg((3 << 11) | 20) & 0xFu; }
#define XB_SPIN(cond, bar) do { unsigned _sp = 0; while (cond) { __builtin_amdgcn_s_sleep(1); \
    if ((++_sp & 255u) == 0u) { if (xb_ld(&(bar)[XB_TMO])) break; if (_sp > XB_SPIN_CAP) { atomicAdd(&(bar)[XB_TMO], 1u); break; } } } } while (0)

struct XcdBarrier {
    unsigned* bar; unsigned x;
    volatile LAS unsigned* st;
};

__device__ __forceinline__ XcdBarrier xcd_barrier_post(unsigned* bar, volatile LAS unsigned* st) {
    XcdBarrier b; b.bar = bar; b.x = xb_xcc_id(); b.st = st;
    if (threadIdx.x == 0) (void)xb_add(&bar[XB_XCNT(b.x)], 1u);
    return b;
}
__device__ __forceinline__ void xcd_barrier_complete(unsigned* bar, unsigned x, unsigned& nloc, unsigned& nx) {
    const unsigned G = gridDim.x * gridDim.y * gridDim.z;
    unsigned sum, cnt, mine, sp = 0u;
    for (;;) {
        sum = 0u; cnt = 0u; mine = 0u;
#pragma unroll
        for (unsigned j = 0; j < 16; ++j) { const unsigned c = xb_ld(&bar[XB_XCNT(j)]); sum += c; cnt += (c > 0u) ? 1u : 0u; mine = (j == x) ? c : mine; }
        if (sum == G) break;
        __builtin_amdgcn_s_sleep(1);
        if ((++sp & 255u) == 0u) { if (xb_ld(&bar[XB_TMO])) break; if (sp > XB_SPIN_CAP) { atomicAdd(&bar[XB_TMO], 1u); break; } }
    }
    nloc = mine > 0u ? mine : 1u; nx = cnt > 0u ? cnt : 1u;
}

__device__ __forceinline__ void xcd_barrier(const XcdBarrier& b) {
    asm volatile("s_waitcnt vmcnt(0)" ::: "memory");
    __syncthreads();
    if (threadIdx.x == 0) {
        unsigned* bar = b.bar;
        __builtin_amdgcn_s_waitcnt(0);
        unsigned nloc = b.st[0], nx = b.st[1];
        if (nloc == 0u) { xcd_barrier_complete(bar, b.x, nloc, nx); b.st[0] = nloc; b.st[1] = nx; }
        const unsigned old = xb_add(&bar[XB_XSUB(b.x)], 1u);
        const unsigned gen = old / nloc;
        if (old + 1u == (gen + 1u) * nloc) {
            __builtin_amdgcn_fence(__ATOMIC_RELEASE, "agent");
            asm volatile("s_waitcnt vmcnt(0)" ::: "memory");
            const unsigned og = xb_add(&bar[XB_TOP], 1u);
            const unsigned tg = og / nx;
            if (og + 1u == (tg + 1u) * nx) xb_add(&bar[XB_TOPGEN], 1u);
            else XB_SPIN(xb_ld(&bar[XB_TOPGEN]) == tg, bar);
            __builtin_amdgcn_fence(__ATOMIC_ACQUIRE, "agent");
            xb_add(&bar[XB_XGEN(b.x)], 1u);
            asm volatile("s_waitcnt vmcnt(0)" ::: "memory");
        } else {
            XB_SPIN(xb_ld(&bar[XB_XGEN(b.x)]) == gen, bar);
            __builtin_amdgcn_fence(__ATOMIC_ACQUIRE, "agent");
            asm volatile("s_waitcnt vmcnt(0)" ::: "memory");
        }
    }
    __syncthreads();
}

__global__ void __launch_bounds__(NTHR, 2) hybrid_fwd(Params P) {
    extern __shared__ __attribute__((aligned(16))) unsigned char lds_raw[];
    LAS unsigned char* lds = (LAS unsigned char*)lds_raw;
    cg::grid_group grid = cg::this_grid();
#define GSYNC() do { XcdBarrier xb_; xb_.bar = (unsigned*)(WSP + WS_BAR); xb_.x = xb_xcc_id(); xb_.st = (volatile LAS unsigned*)(lds + L_PTAB + 384); xcd_barrier(xb_); } while (0)
    if (threadIdx.x == 0) {
        LAS unsigned long long* pt = (LAS unsigned long long*)(lds + L_PTAB);
#pragma unroll
        for (int i = 0; i < 30; ++i) pt[i] = (unsigned long long)P.in[i];
        pt[30] = (unsigned long long)P.out; pt[31] = (unsigned long long)P.ws;
        *(LAS unsigned*)(lds + L_PTAB + 384) = 0u; *(LAS unsigned*)(lds + L_PTAB + 388) = 0u;
    }
    __syncthreads();
    (void)xcd_barrier_post((unsigned*)(WSP + WS_BAR), (volatile LAS unsigned*)(lds + L_PTAB + 384));
    const int G = gridDim.x, bx = blockIdx.x;
#define ws WSP
#define XN ((bf16_t*)(WSP + WS_XN))
#define HID ((bf16_t*)(WSP + WS_HID))
#define MERGED ((bf16_t*)(WSP + WS_MERGED))

#if defined(PROBE_PHASE)
    int n_stamp = 0;
#define STAMP() do { if (blockIdx.x == 0 && threadIdx.x == 0) ((LAS unsigned long long*)(lds + L_PTAB + 512))[n_stamp] = __builtin_amdgcn_s_memrealtime(); ++n_stamp; } while (0)
#else
#define STAMP() do {} while (0)
#endif
    if (P.out == nullptr) grid.sync();
    STAMP();
    prologue(P, lds);
    rmsnorm_phase(INP(0), INP(5), (bf16_t*)(WSP + WS_XN));
#if defined(DUP_PRO)
    prologue(P, lds);
#endif
    GSYNC(); STAMP();
#pragma unroll
    for (int l = 0; l < DEPTH; ++l) {
        const float* xin = (l == 0) ? INP(0) : OUTP;
        if (l > 0) { rmsnorm_phase(xin, INP(5) + l * DM, XN); GSYNC(); STAMP(); }
        { pg8::Gemm g{XN, (const bf16_t*)(ws + WS_W13 + (size_t)(l * 2 + 0) * W13_SZ), MTOK, 5632, DM}; pg8::StaticOrder S; S.init(MTOK, 5632, G, bx);
          EpiSwiGLU E{HID}; pg8::gemm_phase<EpiSwiGLU, pg8::StaticOrder, true, true>(lds, g, S, E);
#if defined(DUP_G1)
          pg8::gemm_phase<EpiSwiGLU, pg8::StaticOrder, true, true>(lds, g, S, E);
#endif
        }
        GSYNC(); STAMP();
        { pg8::Gemm g{HID, (const bf16_t*)(ws + WS_W2 + (size_t)(l * 2 + 0) * W2_SZ), MTOK, DM, DFF}; pg8::StaticOrder S; S.init(MTOK, DM, G, bx);
          EpiResid E{xin, OUTP, 0.5f}; pg8::gemm_phase<EpiResid, pg8::StaticOrder, true, true>(lds, g, S, E); }
        GSYNC(); STAMP();
#if defined(STOP_AFTER) && STOP_AFTER == 1
        return;
#endif
        rmsnorm_phase(OUTP, INP(6) + l * DM, XN);
        GSYNC(); STAMP();
        { pg8::Gemm g{XN, (const bf16_t*)(ws + WS_WIN + (size_t)l * WIN_SZ), MTOK, 5120, DM}; pg8::StaticOrder S; S.init(MTOK, 5120, G, bx);
          EpiZ E{ws, INP(14) + l * 64, INP(15) + l * 64, INP(21) + l * 64, INP(22) + l * 192}; pg8::gemm_phase<EpiZ, pg8::StaticOrder, true, true>(lds, g, S, E);
#if defined(DUP_G3)
          pg8::gemm_phase<EpiZ, pg8::StaticOrder, true, true>(lds, g, S, E);
#endif
        }
        GSYNC(); STAMP();
#if defined(DUMP_Z)
        { const unsigned short* z = (const unsigned short*)(WSP + WS_Z); float* o = OUTP;
          for (size_t i = (size_t)blockIdx.x * NTHR + threadIdx.x; i < (size_t)MTOK * DM; i += (size_t)gridDim.x * NTHR) {
              unsigned v = (unsigned)z[i * 4 + (i & 3)] << 16; if ((v & 0x7f800000u) == 0x7f800000u) v = 0u; o[i] = __builtin_bit_cast(float, v); }
          return; }
#endif
        compress_phase(P, l, lds);
#if defined(DUP_CMP)
        for (int rep_ = 0; rep_ < 4; ++rep_) compress_phase(P, l, lds);
#endif
        GSYNC(); STAMP();
        attention_phase(P, l, lds);
#if defined(DUP_ATT)
        attention_phase(P, l, lds);
#endif
        GSYNC(); STAMP();
        { pg8::Gemm g{XN, (const bf16_t*)(ws + WS_PAB + (size_t)l * PAB_SZ), MTOK, 2048, DM}; pg8::StaticOrder S; S.init(MTOK, 2048, G, bx);
          EpiMerge E{(const bf16_t*)(ws + Z_MG), MERGED}; pg8::gemm_phase<EpiMerge, pg8::StaticOrder, true, true>(lds, g, S, E); }
        GSYNC(); STAMP();
        { pg8::Gemm g{MERGED, (const bf16_t*)(ws + WS_WO + (size_t)l * WO_SZ), MTOK, DM, DM}; pg8::StaticOrder S; S.init(MTOK, DM, G, bx);
          EpiResid E{OUTP, OUTP, 1.0f}; pg8::gemm_phase<EpiResid, pg8::StaticOrder, true, true>(lds, g, S, E); }
        GSYNC(); STAMP();
#if defined(STOP_AFTER) && STOP_AFTER == 2
        return;
#endif
        rmsnorm_phase(OUTP, INP(7) + l * DM, XN);
        GSYNC(); STAMP();
        { pg8::Gemm g{XN, (const bf16_t*)(ws + WS_W13 + (size_t)(l * 2 + 1) * W13_SZ), MTOK, 5632, DM}; pg8::StaticOrder S; S.init(MTOK, 5632, G, bx);
          EpiSwiGLU E{HID}; pg8::gemm_phase<EpiSwiGLU, pg8::StaticOrder, true, true>(lds, g, S, E); }
        GSYNC(); STAMP();
        { pg8::Gemm g{HID, (const bf16_t*)(ws + WS_W2 + (size_t)(l * 2 + 1) * W2_SZ), MTOK, DM, DFF}; pg8::StaticOrder S; S.init(MTOK, DM, G, bx);
          EpiResid E{OUTP, OUTP, 0.5f}; pg8::gemm_phase<EpiResid, pg8::StaticOrder, true, true>(lds, g, S, E); }
        if (l + 1 < DEPTH) { GSYNC(); STAMP(); }
    }
#if defined(PROBE_PHASE)
    GSYNC(); STAMP();
    if (blockIdx.x == 0 && threadIdx.x == 0) { const LAS unsigned long long* t = (const LAS unsigned long long*)(lds + L_PTAB + 512); const float ns = (float)(t[PROBE_PHASE + 1] - t[PROBE_PHASE]) * 10.0f; OUTP[0] = exp2f(rintf(log2f(ns) * 4.f) * 0.25f); }
#endif
#undef ws
#undef XN
#undef HID
#undef MERGED
}

extern "C" void kernel_launch(void* const* d_in, const int* in_sizes, int n_in, void* d_out, int out_size, void* d_ws, size_t ws_size, hipStream_t stream) {
    static int grid = 0;
    if (grid == 0) {
        if (n_in != 30 || out_size != MTOK * DM || ws_size < WS_END) { fprintf(stderr, "kernel_launch: unexpected problem (n_in %d out %d ws %zu, need %zu)\n", n_in, out_size, ws_size, (size_t)WS_END); grid = -1; return; }
        int dev = 0, cus = 0, per_cu = 0;
        (void)hipGetDevice(&dev);
        (void)hipDeviceGetAttribute(&cus, hipDeviceAttributeMultiprocessorCount, dev);
        if (hipFuncSetAttribute((const void*)hybrid_fwd, hipFuncAttributeMaxDynamicSharedMemorySize, LDS_BYTES) != hipSuccess) { fprintf(stderr, "kernel_launch: hipFuncSetAttribute failed\n"); grid = -1; return; }
        if (hipOccupancyMaxActiveBlocksPerMultiprocessor(&per_cu, (const void*)hybrid_fwd, NTHR, LDS_BYTES) != hipSuccess || per_cu < 1) { fprintf(stderr, "kernel_launch: occupancy query gave %d\n", per_cu); per_cu = 1; }
        (void)hipGetLastError();
        grid = cus * (per_cu > 1 ? 1 : per_cu);
        if (grid <= 0) grid = 256;
    }
    if (grid < 0) return;
    Params p{};
    for (int i = 0; i < 30; ++i) p.in[i] = (const float*)d_in[i];
    p.out = (float*)d_out; p.ws = (unsigned char*)d_ws;
    (void)hipMemsetAsync((unsigned char*)d_ws + WS_BAR, 0, 16384, stream);
    void* args[] = {&p};
    hipError_t e = hipLaunchCooperativeKernel((const void*)hybrid_fwd, dim3(grid), dim3(NTHR), args, LDS_BYTES, stream);
    if (e != hipSuccess) fprintf(stderr, "cooperative launch failed: %s (grid %d)\n", hipGetErrorString(e), grid);
}
```

```cpp
#include <hip/hip_runtime.h>
#include <hip/hip_cooperative_groups.h>
#include <cstdio>
#include <cstdint>
namespace cg = cooperative_groups;
namespace pg8 {
#define PG8_LAS __attribute__((address_space(3)))
typedef unsigned short bf16_t;
typedef short bf16x8 __attribute__((ext_vector_type(8)));
typedef float f32x4 __attribute__((ext_vector_type(4)));
typedef unsigned u32x4 __attribute__((ext_vector_type(4)));
constexpr int BM = 256, BK = 64, HALF = 128, HTB = HALF * BK * 2  , STAGE_BYTES = 8 * HTB, NXCD = 8, WGM = 8;

__host__ __device__ __forceinline__ int lds_byte(int r, int c) { const int st = (r >> 4) * 2 + (c >> 5), rr = r & 15, cc = c & 31, ob = rr * 64 + cc * 2; return st * 1024 + (ob ^ (((ob >> 9) & 1) << 5)); }
__host__ __device__ __forceinline__ void stage_rc(int b, int& R, int& C) { const int st = b / 1024, sb = b % 1024, swz = sb ^ (((sb >> 9) & 1) << 5); R = (st >> 1) * 16 + swz / 64; C = (st & 1) * 32 + (swz % 64) / 2; }
__host__ __device__ __forceinline__ int perm32(int rho) { const int n = rho >> 4, i = rho & 15; return 8 * (i >> 2) + 4 * n + (i & 3); }

struct Unit { int pm, pn; };
struct Gemm { const bf16_t* A; const bf16_t* Bt; int M, N, K; };

struct StaticOrder {
    int nM, nN, nwg, G, c;
    __host__ __device__ void init(int M, int N, int G_, int c_) { nM = M / BM; nN = N / BM; nwg = nM * nN; G = G_; c = c_; }
    __host__ __device__ bool next(int i, Unit& u) const {
        const long L = (long)i * G + c; if (L >= nwg) return false;
        int wgid = (int)L; { const int q = nwg / NXCD, r = nwg % NXCD, xcd = wgid % NXCD, off = wgid / NXCD; wgid = (xcd < r ? xcd * (q + 1) : r * (q + 1) + (xcd - r) * q) + off; }
        const int nig = WGM * nN, gid = wgid / nig, fm = gid * WGM, gsz = (nM - fm) < WGM ? (nM - fm) : WGM;
        u.pm = fm + ((wgid % nig) % gsz); u.pn = (wgid % nig) / gsz; return true;
    }
    __device__ __forceinline__ void a_ready(const Unit&) const {}
    __device__ __forceinline__ void done(const Unit&) const {}
};

typedef float f32x2_t __attribute__((ext_vector_type(2))); typedef __bf16 bf16x2_t __attribute__((ext_vector_type(2)));
__device__ __forceinline__ unsigned cvt_pk_bf16(float lo, float hi) { f32x2_t v = {lo, hi}; bf16x2_t b = __builtin_convertvector(v, bf16x2_t); return __builtin_bit_cast(unsigned, b); }
template <class Epi, class Sched, bool ALIGN_EPI = false, bool SP2 = false>
__device__ __forceinline__ void gemm_phase(PG8_LAS unsigned char* lds, const Gemm g, const Sched& S, const Epi& E) {
    int tid_ = threadIdx.x; asm volatile("" : "+v"(tid_)); const int tid = tid_, wid = __builtin_amdgcn_readfirstlane(tid >> 6), lane = tid & 63, wr = wid >> 2, wc = wid & 3, fr = lane & 15, fq = lane >> 4;
    const int K = g.K, nt = K / BK;
    unsigned voffA[2], voffB[2];
#pragma unroll
    for (int i = 0; i < 2; ++i) { int R, C; stage_rc(tid * 16 + i * 8192, R, C); const int Rb = Epi::PERM ? ((R & ~31) + perm32(R & 31)) : R;
        voffA[i] = (unsigned)(R * K + C) * 2u; voffB[i] = (unsigned)(Rb * K + C) * 2u; }
    const size_t kstep = (size_t)(BK * 2);
    const size_t hstep = (size_t)HALF * K * 2;
    const size_t tstep = 2 * hstep;
    const unsigned ldsw = (unsigned)wid * 1024u;
    const int aoff = lds_byte(wr * 64 + fr, fq * 8), boff = lds_byte(wc * 32 + fr, fq * 8);
#define PG8_SA(b, h) (((b) * 2 + (h)) * HTB)
#define PG8_SB(b, h) ((4 + (b) * 2 + (h)) * HTB)
#define PG8_STAGE(bufoff, gbase, voff) do { _Pragma("unroll") for (int _i = 0; _i < 2; ++_i) \
        __builtin_amdgcn_global_load_lds((const unsigned*)((const char*)(gbase) + (voff)[_i]), (PG8_LAS unsigned*)(lds + (bufoff) + ldsw + _i * 8192), 16, 0, 0); } while (0)
#define PG8_LDA(dst, b, h) do { _Pragma("unroll") for (int m = 0; m < 4; ++m) _Pragma("unroll") for (int k = 0; k < 2; ++k) dst[m][k] = *(const PG8_LAS bf16x8*)(lds + PG8_SA(b, h) + aoff + m * 2048 + k * 1024); } while (0)
#define PG8_LDB(dst, b, h) do { _Pragma("unroll") for (int n = 0; n < 2; ++n) _Pragma("unroll") for (int k = 0; k < 2; ++k) dst[n][k] = *(const PG8_LAS bf16x8*)(lds + PG8_SB(b, h) + boff + n * 2048 + k * 1024); } while (0)
#define PG8_MMA(ai, bj, At, Bt) do { __builtin_amdgcn_s_setprio(1); _Pragma("unroll") for (int m = 0; m < 4; ++m) _Pragma("unroll") for (int n = 0; n < 2; ++n) _Pragma("unroll") for (int k = 0; k < 2; ++k) \
        acc[ai][bj][m][n] = __builtin_amdgcn_mfma_f32_16x16x32_bf16(Bt[n][k], At[m][k], acc[ai][bj][m][n], 0, 0, 0); __builtin_amdgcn_s_setprio(0); } while (0)
#define PG8_WAIT_V(n) asm volatile("s_waitcnt vmcnt(" #n ")" ::: "memory")
#define PG8_WAIT_L(n) asm volatile("s_waitcnt lgkmcnt(" #n ")" ::: "memory")
#define PG8_BAR __builtin_amdgcn_s_barrier()
#define PG8_SCHED __builtin_amdgcn_sched_barrier(0)
    Unit cur, nxt; int ui = 0;
    if (!S.next(0, cur)) return;
    f32x4 acc[2][2][4][2];
#pragma unroll
    for (int a = 0; a < 2; ++a)
#pragma unroll
        for (int b = 0; b < 2; ++b)
#pragma unroll
            for (int m = 0; m < 4; ++m)
#pragma unroll
                for (int n = 0; n < 2; ++n) acc[a][b][m][n] = (f32x4){0.f, 0.f, 0.f, 0.f};
    bf16x8 At[4][2], B0[2][2], B1[2][2];
    const char* cA = (const char*)g.A + (size_t)cur.pm * tstep; const char* cB = (const char*)g.Bt + (size_t)cur.pn * tstep;
    S.a_ready(cur);
    if constexpr (SP2) {
        PG8_STAGE(PG8_SB(0, 0), cB, voffB); PG8_STAGE(PG8_SB(0, 1), cB + hstep, voffB); PG8_STAGE(PG8_SA(0, 0), cA, voffA); PG8_STAGE(PG8_SA(0, 1), cA + hstep, voffA);
        if (wr == 1) PG8_BAR;
        PG8_WAIT_V(2); PG8_BAR;
        PG8_STAGE(PG8_SB(1, 0), cB + kstep, voffB); PG8_STAGE(PG8_SA(1, 0), cA + kstep, voffA); PG8_STAGE(PG8_SB(1, 1), cB + hstep + kstep, voffB);
        PG8_WAIT_V(6); PG8_BAR;
    } else {
        PG8_STAGE(PG8_SB(0, 0), cB, voffB); PG8_STAGE(PG8_SA(0, 0), cA, voffA); PG8_STAGE(PG8_SB(0, 1), cB + hstep, voffB); PG8_STAGE(PG8_SA(0, 1), cA + hstep, voffA);
        if (wr == 1) PG8_BAR;
        PG8_WAIT_V(4); PG8_BAR;
        PG8_STAGE(PG8_SB(1, 0), cB + kstep, voffB); PG8_STAGE(PG8_SA(1, 0), cA + kstep, voffA); PG8_STAGE(PG8_SB(1, 1), cB + hstep + kstep, voffB);
        PG8_WAIT_V(6); PG8_BAR;
    }
    for (;;) {
        const bool has_next = S.next(ui + 1, nxt);
        const char* nA = has_next ? (const char*)g.A + (size_t)nxt.pm * tstep : cA; const char* nB = has_next ? (const char*)g.Bt + (size_t)nxt.pn * tstep : cB;
        for (int t = 0; t < nt; t += 2) {
            const bool last = (t == nt - 2);
            const char* a1 = cA + (size_t)(t + 1) * kstep;
            const char* a2 = last ? nA : cA + (size_t)(t + 2) * kstep; const char* b2 = last ? nB : cB + (size_t)(t + 2) * kstep;
            const char* a3 = a2 + kstep; const char* b3 = b2 + kstep;
            if (last && has_next) S.a_ready(nxt);
            if constexpr (SP2) {
            PG8_LDB(B0, 0, 0); PG8_LDB(B1, 0, 1); PG8_SCHED; PG8_LDA(At, 0, 0); PG8_STAGE(PG8_SA(1, 1), a1 + hstep, voffA);
            PG8_WAIT_V(8); PG8_WAIT_L(0); PG8_BAR; PG8_MMA(0, 0, At, B0); PG8_MMA(0, 1, At, B1); PG8_BAR; PG8_SCHED;
            PG8_LDA(At, 0, 1); PG8_STAGE(PG8_SB(0, 0), b2, voffB); PG8_STAGE(PG8_SB(0, 1), b2 + hstep, voffB); PG8_STAGE(PG8_SA(0, 0), a2, voffA);
            PG8_WAIT_V(8); PG8_WAIT_L(0); PG8_BAR; PG8_MMA(1, 0, At, B0); PG8_MMA(1, 1, At, B1); PG8_BAR; PG8_SCHED;
            PG8_LDB(B0, 1, 0); PG8_LDB(B1, 1, 1); PG8_SCHED; PG8_LDA(At, 1, 0); PG8_STAGE(PG8_SA(0, 1), a2 + hstep, voffA);
            PG8_WAIT_V(8); PG8_WAIT_L(0); PG8_BAR; PG8_MMA(0, 0, At, B0); PG8_MMA(0, 1, At, B1); PG8_BAR; PG8_SCHED;
            PG8_LDA(At, 1, 1); PG8_STAGE(PG8_SB(1, 0), b3, voffB); PG8_STAGE(PG8_SB(1, 1), b3 + hstep, voffB); PG8_STAGE(PG8_SA(1, 0), a3, voffA);
            PG8_WAIT_V(8); PG8_WAIT_L(0); PG8_BAR; PG8_MMA(1, 0, At, B0); PG8_MMA(1, 1, At, B1); PG8_BAR; PG8_SCHED;
            } else {
            PG8_LDB(B0, 0, 0); PG8_SCHED; PG8_LDA(At, 0, 0); PG8_STAGE(PG8_SA(1, 1), a1 + hstep, voffA);
            PG8_WAIT_L(8); PG8_BAR; PG8_WAIT_L(0); PG8_MMA(0, 0, At, B0); PG8_BAR; PG8_SCHED;
            PG8_LDB(B1, 0, 1); PG8_STAGE(PG8_SB(0, 0), b2, voffB);
            PG8_BAR; PG8_WAIT_L(0); PG8_MMA(0, 1, At, B1); PG8_BAR;
            PG8_LDA(At, 0, 1); PG8_STAGE(PG8_SA(0, 0), a2, voffA);
            PG8_BAR; PG8_WAIT_L(0); PG8_MMA(1, 0, At, B0); PG8_BAR; PG8_SCHED;
            PG8_STAGE(PG8_SB(0, 1), b2 + hstep, voffB);
            PG8_WAIT_V(6); PG8_BAR; PG8_MMA(1, 1, At, B1); PG8_BAR;
            PG8_LDB(B0, 1, 0); PG8_SCHED; PG8_LDA(At, 1, 0); PG8_STAGE(PG8_SA(0, 1), a2 + hstep, voffA);
            PG8_WAIT_L(8); PG8_BAR; PG8_WAIT_L(0); PG8_MMA(0, 0, At, B0); PG8_BAR; PG8_SCHED;
            PG8_LDB(B1, 1, 1); PG8_STAGE(PG8_SB(1, 0), b3, voffB);
            PG8_BAR; PG8_WAIT_L(0); PG8_MMA(0, 1, At, B1); PG8_BAR;
            PG8_LDA(At, 1, 1); PG8_STAGE(PG8_SA(1, 0), a3, voffA);
            PG8_BAR; PG8_WAIT_L(0); PG8_MMA(1, 0, At, B0); PG8_BAR; PG8_SCHED;
            PG8_STAGE(PG8_SB(1, 1), b3 + hstep, voffB);
            PG8_WAIT_V(6); PG8_BAR; PG8_MMA(1, 1, At, B1); PG8_BAR;
            }
        }
        if constexpr (ALIGN_EPI) { if (wr == 0) PG8_BAR; }
        if constexpr (!Epi::AFTER_DRAIN) { E(acc, cur, wr, wc, fr, fq); S.done(cur); }
        if (!has_next) break;
#pragma unroll
        for (int a = 0; a < 2; ++a)
#pragma unroll
            for (int b = 0; b < 2; ++b)
#pragma unroll
                for (int m = 0; m < 4; ++m)
#pragma unroll
                    for (int n = 0; n < 2; ++n) acc[a][b][m][n] = (f32x4){0.f, 0.f, 0.f, 0.f};
        cur = nxt; cA = nA; cB = nB; ++ui;
        if constexpr (ALIGN_EPI) { if (wr == 1) PG8_BAR; }
    }
    PG8_WAIT_V(0);
    if constexpr (!ALIGN_EPI) { if (wr == 0) PG8_BAR; }
    PG8_BAR;
    if constexpr (Epi::AFTER_DRAIN) { E.fused(acc, cur, wr, wc, fr, fq, lds, wid, lane); S.done(cur); }
#undef PG8_SA
#undef PG8_SB
#undef PG8_STAGE
#undef PG8_LDA
#undef PG8_LDB
#undef PG8_MMA
#undef PG8_WAIT_V
#undef PG8_WAIT_L
#undef PG8_BAR
#undef PG8_SCHED
}
}

#define LAS __attribute__((address_space(3)))
#define GAS __attribute__((address_space(1)))
#define GLD(T, p) (*(const GAS T*)(p))
#define GST(T, p, v) (*(GAS T*)(p) = (v))
typedef unsigned short bf16_t;
typedef short bf16x8 __attribute__((ext_vector_type(8)));
typedef short bf16x4 __attribute__((ext_vector_type(4)));
typedef float f32x4 __attribute__((ext_vector_type(4)));
typedef float f32x16 __attribute__((ext_vector_type(16)));
typedef unsigned u32x4 __attribute__((ext_vector_type(4)));
typedef unsigned u32x2 __attribute__((ext_vector_type(2)));

constexpr int BATCH = 8, SEQ = 4096, DM = 1024, MTOK = BATCH * SEQ, DFF = 2816, DEPTH = 2, NIN = 4888;
constexpr int NTHR = 512, NWAVE = 8;
constexpr float EPS = 1e-6f, LOG2E = 1.4426950408889634f;
constexpr float QSCALE = 0.125f * LOG2E;
constexpr size_t MiB = 1u << 20;
constexpr size_t WS_BIAS = 0;
constexpr size_t WS_PRM = 64 * 1024;
constexpr size_t WS_CB1 = 68 * 1024;
constexpr size_t WS_W13 = 1 * MiB;
constexpr size_t W13_SZ = (size_t)5632 * 1024 * 2;
constexpr size_t WS_W2 = 45 * MiB;
constexpr size_t W2_SZ = (size_t)1024 * 2816 * 2;
constexpr size_t WS_WIN = 68 * MiB;
constexpr size_t WIN_SZ = (size_t)5120 * 1024 * 2;
constexpr size_t WS_PAB = 88 * MiB;
constexpr size_t PAB_SZ = (size_t)2048 * 1024 * 2;
constexpr size_t WS_WO = 96 * MiB;
constexpr size_t WO_SZ = (size_t)1024 * 1024 * 2;
constexpr size_t WS_CW1 = 100 * MiB;
constexpr size_t CW1_SZ = (size_t)128 * 2048 * 2;
constexpr size_t WS_CW2 = 102 * MiB;
constexpr size_t CW2_SZ = (size_t)64 * 128 * 2;
constexpr size_t WS_KCN = 103 * MiB;
constexpr size_t WS_VCT = WS_KCN + 512 * 1024;
constexpr size_t WS_XN = 104 * MiB;
constexpr size_t WS_Z = 168 * MiB;
constexpr size_t Z_DQ = WS_Z, Z_DK = WS_Z + 32 * MiB, Z_DVT = WS_Z + 64 * MiB, Z_NQ = WS_Z + 96 * MiB;
constexpr size_t Z_KCR = WS_Z + 128 * MiB, Z_VCR = WS_Z + 136 * MiB, Z_KSEL = WS_Z + 144 * MiB, Z_VSELT = WS_Z + 152 * MiB;
constexpr size_t Z_KWIN = WS_Z + 160 * MiB, Z_VWINT = WS_Z + 168 * MiB, Z_NG = WS_Z + 176 * MiB, Z_MG = WS_Z + 180 * MiB;
constexpr size_t WS_MERGED = WS_Z;
constexpr size_t WS_HID = WS_Z;
constexpr size_t WS_END = WS_Z + 308 * MiB;
constexpr int LDS_BYTES = 147456;
constexpr int KP = 144, VP = 136;
constexpr int DA_STAGE = 2 * 64 * KP + 128 * VP;
constexpr int NS_STAGE = 64 * KP + 64 * VP;
constexpr int L_BIAS = 73728;
constexpr int TBN = 1216;
constexpr int L_IMP = L_BIAS + 4 * TBN * 4;
constexpr int L_SEL = L_IMP + 16384;
constexpr int L_WSF = L_SEL + 1024;
constexpr int L_END = L_WSF + 8 * 256;

struct Params {
    const float* in[30];
    float* out;
    unsigned char* ws;
};

constexpr int L_PTAB = LDS_BYTES - 1024;
__device__ __forceinline__ const float* ld_ptr(const LAS unsigned char* lds, int i) {
    unsigned a = L_PTAB + 8 * i; asm volatile("" : "+v"(a));
    const LAS unsigned* t = (const LAS unsigned*)(lds + a);
    const unsigned lo = __builtin_amdgcn_readfirstlane(t[0]), hi = __builtin_amdgcn_readfirstlane(t[1]);
    return (const float*)(((unsigned long long)hi << 32) | lo);
}
#define INP(i) ld_ptr(lds, (i))
#define OUTP ((float*)ld_ptr(lds, 30))
#define WSP ((unsigned char*)ld_ptr(lds, 31))

__device__ __forceinline__ unsigned f2bf(float f) { unsigned u = __builtin_bit_cast(unsigned, f); return (u + 0x7fffu + ((u >> 16) & 1u)) >> 16; }
__device__ __forceinline__ unsigned pk2(float lo, float hi) { return f2bf(lo) | (f2bf(hi) << 16); }
__device__ __forceinline__ float sigmoidf_(float x) { return __builtin_amdgcn_rcpf(1.0f + __builtin_amdgcn_exp2f(-x * LOG2E)); }
__device__ __forceinline__ int otid() { int t = threadIdx.x; asm volatile("" : "+v"(t)); return t; }
__device__ __forceinline__ int crow(int r, int hi) { return (r & 3) + 8 * (r >> 2) + 4 * hi; }

struct EpiSwiGLU {
    static constexpr bool PERM = true, AFTER_DRAIN = false;
    bf16_t* H;
    __device__ __forceinline__ void operator()(const f32x4 (&acc)[2][2][4][2], const pg8::Unit& u, int wr, int wc, int fr, int fq) const {
        const int row0 = u.pm * 256 + wr * 64 + fr, col = u.pn * 128 + wc * 32 + 8 * fq;
#pragma unroll
        for (int ai = 0; ai < 2; ++ai)
#pragma unroll
            for (int m = 0; m < 4; ++m) {
                float h[8];
#pragma unroll
                for (int n = 0; n < 2; ++n)
#pragma unroll
                    for (int e = 0; e < 4; ++e) { const float g = acc[ai][0][m][n][e], up = acc[ai][1][m][n][e]; h[n * 4 + e] = g * sigmoidf_(g) * up; }
                u32x4 w; w.x = pg8::cvt_pk_bf16(h[0], h[1]); w.y = pg8::cvt_pk_bf16(h[2], h[3]); w.z = pg8::cvt_pk_bf16(h[4], h[5]); w.w = pg8::cvt_pk_bf16(h[6], h[7]);
                GST(u32x4, H + (size_t)(row0 + ai * 128 + m * 16) * DFF + col, w);
            }
    }
};
template <bool BF32, bool OF32> struct EpiResidT {
    static constexpr bool PERM = false, AFTER_DRAIN = false;
    const void* base; void* out; float alpha;
    __device__ __forceinline__ void operator()(const f32x4 (&acc)[2][2][4][2], const pg8::Unit& u, int wr, int wc, int fr, int fq) const {
        const int row0 = u.pm * 256 + wr * 64 + fr, col0 = u.pn * 256 + wc * 32 + 4 * fq;
#pragma unroll
        for (int ai = 0; ai < 2; ++ai) {
            f32x4 bv[4][2][2];
#pragma unroll
            for (int m = 0; m < 4; ++m) {
                const size_t off = (size_t)(row0 + ai * 128 + m * 16) * DM + col0;
#pragma unroll
                for (int bj = 0; bj < 2; ++bj)
#pragma unroll
                    for (int n = 0; n < 2; ++n) {
                        if (BF32) bv[m][bj][n] = GLD(f32x4, (const float*)base + off + bj * 128 + n * 16);
                        else { const u32x2 w = GLD(u32x2, (const bf16_t*)base + off + bj * 128 + n * 16);
                               bv[m][bj][n] = (f32x4){__builtin_bit_cast(float, w.x << 16), __builtin_bit_cast(float, w.x & 0xffff0000u), __builtin_bit_cast(float, w.y << 16), __builtin_bit_cast(float, w.y & 0xffff0000u)}; }
                    }
            }
#pragma unroll
            for (int m = 0; m < 4; ++m) {
                const size_t off = (size_t)(row0 + ai * 128 + m * 16) * DM + col0;
#pragma unroll
                for (int bj = 0; bj < 2; ++bj)
#pragma unroll
                    for (int n = 0; n < 2; ++n) {
                        const f32x4 o = bv[m][bj][n] + acc[ai][bj][m][n] * alpha;
                        if (OF32) GST(f32x4, (float*)out + off + bj * 128 + n * 16, o);
                        else { u32x2 w; w.x = pg8::cvt_pk_bf16(o.x, o.y); w.y = pg8::cvt_pk_bf16(o.z, o.w); GST(u32x2, (bf16_t*)out + off + bj * 128 + n * 16, w); }
                    }
            }
        }
    }
};
struct EpiMerge {
    static constexpr bool PERM = true, AFTER_DRAIN = false;
    const bf16_t* MG; bf16_t* O;
    __device__ __forceinline__ void operator()(const f32x4 (&acc)[2][2][4][2], const pg8::Unit& u, int wr, int wc, int fr, int fq) const {
        const int row0 = u.pm * 256 + wr * 64 + fr, col = u.pn * 128 + wc * 32 + 8 * fq;
#pragma unroll
        for (int ai = 0; ai < 2; ++ai) {
            u32x4 g0[4], g1[4];
#pragma unroll
            for (int m = 0; m < 4; ++m) { const int row = row0 + ai * 128 + m * 16; g0[m] = GLD(u32x4, MG + (size_t)row * 2048 + col); g1[m] = GLD(u32x4, MG + (size_t)row * 2048 + 1024 + col); }
#pragma unroll
            for (int m = 0; m < 4; ++m) {
                const int row = row0 + ai * 128 + m * 16;
                float h[8];
#pragma unroll
                for (int i = 0; i < 8; ++i) {
                    const unsigned w0 = g0[m][i >> 1], w1 = g1[m][i >> 1];
                    const float a0 = __builtin_bit_cast(float, (i & 1) ? (w0 & 0xffff0000u) : (w0 << 16)), a1 = __builtin_bit_cast(float, (i & 1) ? (w1 & 0xffff0000u) : (w1 << 16));
                    h[i] = a0 * acc[ai][0][m][i >> 2][i & 3] + a1 * acc[ai][1][m][i >> 2][i & 3];
                }
                u32x4 w; w.x = pg8::cvt_pk_bf16(h[0], h[1]); w.y = pg8::cvt_pk_bf16(h[2], h[3]); w.z = pg8::cvt_pk_bf16(h[4], h[5]); w.w = pg8::cvt_pk_bf16(h[6], h[7]);
                GST(u32x4, O + (size_t)row * DM + col, w);
            }
        }
    }
};
struct EpiZ {
    static constexpr bool PERM = true, AFTER_DRAIN = false;
    unsigned char* ws; const float *gq, *gk, *gnq, *gnk;
    __device__ __forceinline__ void operator()(const f32x4 (&acc)[2][2][4][2], const pg8::Unit& u, int wr, int wc, int fr, int fq) const {
        const int ch = 4 * u.pn + wc;
        if (ch >= 77) return;
        const int row0 = u.pm * 256 + wr * 64 + fr;
        int kind, nh = 8, hd = 0, nd = 64, dbase = 0; size_t dst = 0; const float* gain = nullptr; float scale = 1.f;
        if (ch < 8) { kind = 0; dst = Z_DQ; hd = ch; gain = gq; scale = QSCALE; }
        else if (ch < 16) { kind = 0; dst = Z_DK; hd = ch - 8; gain = gk; }
        else if (ch < 24) { kind = 2; dst = Z_DVT; nh = 4; hd = (ch - 16) >> 1; nd = 128; dbase = ((ch - 16) & 1) * 64; }
        else if (ch < 32) { kind = 0; dst = Z_NQ; hd = ch - 24; gain = gnq; scale = QSCALE; }
        else if (ch < 34) { kind = 1; dst = Z_KCR; nh = 2; hd = ch - 32; }
        else if (ch < 36) { kind = 1; dst = Z_VCR; nh = 2; hd = ch - 34; }
        else if (ch < 38) { kind = 0; dst = Z_KSEL; nh = 2; hd = ch - 36; gain = gnk + 64; }
        else if (ch < 40) { kind = 2; dst = Z_VSELT; nh = 2; hd = ch - 38; }
        else if (ch < 42) { kind = 0; dst = Z_KWIN; nh = 2; hd = ch - 40; gain = gnk + 128; }
        else if (ch < 44) { kind = 2; dst = Z_VWINT; nh = 2; hd = ch - 42; }
        else if (ch < 76) { kind = 3; }
        else { kind = 4; }
        if (kind == 0 || kind == 1) {
            float gv[16];
#pragma unroll
            for (int i = 0; i < 16; ++i) gv[i] = (kind == 0) ? gain[(i >> 3) * 32 + 8 * fq + (i & 7)] * scale : 1.f;
#pragma unroll
            for (int ai = 0; ai < 2; ++ai)
#pragma unroll
                for (int m = 0; m < 4; ++m) {
                    const int row = row0 + ai * 128 + m * 16, b = row >> 12, s = row & 4095;
                    float v[16];
#pragma unroll
                    for (int i = 0; i < 16; ++i) v[i] = acc[ai][i >> 3][m][(i >> 2) & 1][i & 3];
                    float rs = 1.f;
                    if (kind == 0) {
                        float ss = 0.f;
#pragma unroll
                        for (int i = 0; i < 16; ++i) ss += v[i] * v[i];
                        ss += __shfl_xor(ss, 16); ss += __shfl_xor(ss, 32);
                        rs = __builtin_amdgcn_rsqf(ss * (1.f / 64.f) + EPS);
                    }
#pragma unroll
                    for (int i = 0; i < 16; ++i) v[i] *= rs * gv[i];
                    bf16_t* d = (bf16_t*)(ws + dst) + ((size_t)(b * nh + hd) * SEQ + s) * 64 + 8 * fq;
                    u32x4 w0, w1;
                    w0.x = pg8::cvt_pk_bf16(v[0], v[1]); w0.y = pg8::cvt_pk_bf16(v[2], v[3]); w0.z = pg8::cvt_pk_bf16(v[4], v[5]); w0.w = pg8::cvt_pk_bf16(v[6], v[7]);
                    w1.x = pg8::cvt_pk_bf16(v[8], v[9]); w1.y = pg8::cvt_pk_bf16(v[10], v[11]); w1.z = pg8::cvt_pk_bf16(v[12], v[13]); w1.w = pg8::cvt_pk_bf16(v[14], v[15]);
                    GST(u32x4, d, w0); GST(u32x4, d + 32, w1);
                }
        } else if (kind == 2) {
#pragma unroll
            for (int ai = 0; ai < 2; ++ai)
#pragma unroll
                for (int m = 0; m < 4; ++m) {
                    const int row = row0 + ai * 128 + m * 16, b = row >> 12, s = row & 4095;
                    bf16_t* d = (bf16_t*)(ws + dst) + ((size_t)(b * nh + hd) * nd + dbase + 8 * fq) * SEQ + s;
#pragma unroll
                    for (int i = 0; i < 16; ++i) GST(bf16_t, d + (size_t)((i >> 3) * 32 + (i & 7)) * SEQ, (bf16_t)f2bf(acc[ai][i >> 3][m][(i >> 2) & 1][i & 3]));
                }
        } else if (kind == 3) {
            const int col = (ch - 44) * 64 + 8 * fq;
#pragma unroll
            for (int ai = 0; ai < 2; ++ai)
#pragma unroll
                for (int m = 0; m < 4; ++m) {
                    const int row = row0 + ai * 128 + m * 16;
                    float v[16];
#pragma unroll
                    for (int i = 0; i < 16; ++i) v[i] = sigmoidf_(acc[ai][i >> 3][m][(i >> 2) & 1][i & 3]);
                    bf16_t* d = (bf16_t*)(ws + Z_MG) + (size_t)row * 2048 + col;
                    u32x4 w0, w1;
                    w0.x = pg8::cvt_pk_bf16(v[0], v[1]); w0.y = pg8::cvt_pk_bf16(v[2], v[3]); w0.z = pg8::cvt_pk_bf16(v[4], v[5]); w0.w = pg8::cvt_pk_bf16(v[6], v[7]);
                    w1.x = pg8::cvt_pk_bf16(v[8], v[9]); w1.y = pg8::cvt_pk_bf16(v[10], v[11]); w1.z = pg8::cvt_pk_bf16(v[12], v[13]); w1.w = pg8::cvt_pk_bf16(v[14], v[15]);
                    GST(u32x4, d, w0); GST(u32x4, d + 32, w1);
                }
        } else {
            if (fq < 3) {
#pragma unroll
                for (int ai = 0; ai < 2; ++ai)
#pragma unroll
                    for (int m = 0; m < 4; ++m) {
                        const int row = row0 + ai * 128 + m * 16;
                        float* d = (float*)(ws + Z_NG) + (size_t)row * 24 + 8 * fq;
#pragma unroll
                        for (int i = 0; i < 8; ++i) GST(float, d + i, sigmoidf_(acc[ai][0][m][i >> 2][i & 3]));
                    }
            }
        }
    }
};

__device__ __forceinline__ void tr_item(const float* src, int ld, int c0, int nvalid, int k0, bf16_t* dst, int Kdst, LAS float* scr, int lane) {
    const int n = lane & 31;
#pragma unroll
    for (int i = 0; i < 32; ++i) { const int kk = 2 * i + (lane >> 5); scr[kk * 33 + n] = (src && n < nvalid) ? GLD(float, src + (size_t)(k0 + kk) * ld + c0 + n) : 0.f; }
    asm volatile("s_waitcnt lgkmcnt(0)" ::: "memory");
    const int c = lane & 7;
#pragma unroll
    for (int j = 0; j < 4; ++j) { const int nn = (lane >> 3) + 8 * j; const LAS float* s = scr + (8 * c) * 33 + nn;
        u32x4 o; o.x = pk2(s[0 * 33], s[1 * 33]); o.y = pk2(s[2 * 33], s[3 * 33]); o.z = pk2(s[4 * 33], s[5 * 33]); o.w = pk2(s[6 * 33], s[7 * 33]);
        GST(u32x4, dst + (size_t)nn * Kdst + 8 * c, o); }
    asm volatile("s_waitcnt lgkmcnt(0)" ::: "memory");
}
__device__ __forceinline__ int zchunk_src(int ch) {
    if (ch < 32) return ch * 64;
    if (ch < 44) return 2048 + (ch - 32) * 64;
    if (ch < 76) return 2840 + (ch - 44) * 64;
    return 2816;
}
__device__ __forceinline__ int t5_bucket(int n) {
    if (n < 16) return n;
    int b = 16;
    b += (n >= 21); b += (n >= 27); b += (n >= 35); b += (n >= 46); b += (n >= 59); b += (n >= 77); b += (n >= 99); b += (n >= 128);
    b += (n >= 166); b += (n >= 216); b += (n >= 280); b += (n >= 363); b += (n >= 470); b += (n >= 609); b += (n >= 790);
    return b;
}
__device__ __forceinline__ void prologue(const Params& P, LAS unsigned char* lds) {
    const int tid = otid(), lane = tid & 63, wave = tid >> 6;
    LAS float* scr = (LAS float*)(lds + wave * 16384);
    const int gw = blockIdx.x * NWAVE + wave, NGW = gridDim.x * NWAVE;
    unsigned char* ws = WSP;
    constexpr int I13 = 176 * 16, I2 = 32 * 44, IIN = 160 * 16, IPAB = 64 * 16, IWO = 32 * 16, IC1 = 4 * 32, IC2 = 2 * 2;
    constexpr int PER_L = 2 * I13 + 2 * I2 + IIN + IPAB + IWO + 2 * IC1 + 2 * IC2;
    for (int it = gw; it < DEPTH * PER_L; it += NGW) {
        const int l = it / PER_L; int r = it % PER_L;
        if (r < 2 * I13) {
            const int f = r / I13; r %= I13; const int gi = r / 16, kb = r % 16;
            const int t = gi >> 3, bj = (gi >> 2) & 1, sub = gi & 3;
            const float* src = (f ? (bj ? INP(12) : INP(11)) : (bj ? INP(9) : INP(8))) + (size_t)l * DM * DFF;
            tr_item(src, DFF, 128 * t + 32 * sub, 32, 64 * kb, (bf16_t*)(ws + WS_W13 + (size_t)(l * 2 + f) * W13_SZ) + (size_t)(32 * gi) * DM + 64 * kb, DM, scr, lane);
            continue;
        }
        r -= 2 * I13;
        if (r < 2 * I2) {
            const int f = r / I2; r %= I2; const int gi = r / 44, kb = r % 44;
            const float* src = (f ? INP(13) : INP(10)) + (size_t)l * DFF * DM;
            tr_item(src, DM, 32 * gi, 32, 64 * kb, (bf16_t*)(ws + WS_W2 + (size_t)(l * 2 + f) * W2_SZ) + (size_t)(32 * gi) * DFF + 64 * kb, DFF, scr, lane);
            continue;
        }
        r -= 2 * I2;
        if (r < IIN) {
            const int gi = r / 16, kb = r % 16;
            const int t = gi >> 3, bj = (gi >> 2) & 1, wc = gi & 3, ch = 4 * t + wc;
            int nvalid = 32; if (ch == 76) nvalid = bj ? 0 : 24; if (ch > 76) nvalid = 0;
            const float* src = nvalid ? INP(1) + (size_t)l * DM * NIN : nullptr;
            tr_item(src, NIN, zchunk_src(ch) + 32 * bj, nvalid, 64 * kb, (bf16_t*)(ws + WS_WIN + (size_t)l * WIN_SZ) + (size_t)(32 * gi) * DM + 64 * kb, DM, scr, lane);
            continue;
        }
        r -= IIN;
        if (r < IPAB) {
            const int gi = r / 16, kb = r % 16;
            const int t = gi >> 3, bj = (gi >> 2) & 1, sub = gi & 3;
            const float* src = nullptr; int k0 = 0;
            if (bj == 0 && kb < 8) { src = INP(2) + (size_t)l * 512 * DM; k0 = 64 * kb; }
            if (bj == 1 && kb >= 8) { src = INP(3) + (size_t)l * 512 * DM; k0 = 64 * (kb - 8); }
            tr_item(src, DM, 128 * t + 32 * sub, 32, k0, (bf16_t*)(ws + WS_PAB + (size_t)l * PAB_SZ) + (size_t)(32 * gi) * DM + 64 * kb, DM, scr, lane);
            continue;
        }
        r -= IPAB;
        if (r < IWO) {
            const int gi = r / 16, kb = r % 16;
            tr_item(INP(4) + (size_t)l * DM * DM, DM, 32 * gi, 32, 64 * kb, (bf16_t*)(ws + WS_WO + (size_t)l * WO_SZ) + (size_t)(32 * gi) * DM + 64 * kb, DM, scr, lane);
            continue;
        }
        r -= IWO;
        if (r < 2 * IC1) {
            const int kv = r / IC1; r %= IC1; const int gi = r / 32, kb = r % 32;
            tr_item((kv ? INP(27) : INP(24)) + (size_t)l * 2048 * 128, 128, 32 * gi, 32, 64 * kb, (bf16_t*)(ws + WS_CW1 + (size_t)(l * 2 + kv) * CW1_SZ) + (size_t)(32 * gi) * 2048 + 64 * kb, 2048, scr, lane);
            continue;
        }
        r -= 2 * IC1;
        {
            const int kv = r / IC2; r %= IC2; const int gi = r / 2, kb = r % 2;
            tr_item((kv ? INP(28) : INP(25)) + (size_t)l * 128 * 64, 64, 32 * gi, 32, 64 * kb, (bf16_t*)(ws + WS_CW2 + (size_t)(l * 2 + kv) * CW2_SZ) + (size_t)(32 * gi) * 128 + 64 * kb, 128, scr, lane);
        }
    }
    const int gt = blockIdx.x * NTHR + tid, NGT = gridDim.x * NTHR;
    for (int i = gt; i < 12 * 1024; i += NGT) { const int h = i >> 10, d = i & 1023; ((float*)(ws + WS_BIAS))[i] = INP(29)[t5_bucket(d) * 12 + h] * LOG2E; }
    if (blockIdx.x == (gridDim.x > 1 ? 1 : 0) && wave < DEPTH) {
        const int l = wave;
        float a = INP(16)[l * 64 + lane] * INP(17)[l * 64 + lane], b = INP(18)[l * 64 + lane] * INP(19)[l * 64 + lane];
        float mq = fabsf(INP(14)[l * 64 + lane]), mk = fabsf(INP(15)[l * 64 + lane]), mnq = fabsf(INP(21)[l * 64 + lane]);
        float mnk = fmaxf(fmaxf(fabsf(INP(22)[l * 192 + lane]), fabsf(INP(22)[l * 192 + 64 + lane])), fabsf(INP(22)[l * 192 + 128 + lane]));
        float mb = 0.f; for (int i = lane; i < 32 * 12; i += 64) mb = fmaxf(mb, fabsf(INP(29)[i]));
#pragma unroll
        for (int o = 1; o < 64; o <<= 1) { a += __shfl_xor(a, o); b += __shfl_xor(b, o); mq = fmaxf(mq, __shfl_xor(mq, o)); mk = fmaxf(mk, __shfl_xor(mk, o)); mnq = fmaxf(mnq, __shfl_xor(mnq, o)); mnk = fmaxf(mnk, __shfl_xor(mnk, o)); mb = fmaxf(mb, __shfl_xor(mb, o)); }
        if (lane == 0) {
            float* prm = (float*)(ws + WS_PRM) + l * 8;
            const float lam_init = 0.8f - 0.6f * expf(-0.3f * (float)l);
            prm[0] = expf(a) - expf(b) + lam_init;
            prm[1] = (8.f * mq * mk * 1.02f + mb) * LOG2E;
            prm[2] = (8.f * mnq * mnk * 1.02f + mb) * LOG2E;
            prm[3] = 1.0f - lam_init;
        }
    }
    for (int wi = blockIdx.x; wi < 32; wi += gridDim.x) {
        const int lk = wi >> 3, n = (wi & 7) * 16 + (tid & 15), ks = tid >> 4, l = lk >> 1, kv = lk & 1;
        const float* pe = (kv ? INP(26) : INP(23)) + (size_t)l * 2048; const float* w1 = (kv ? INP(27) : INP(24)) + (size_t)l * 2048 * 128;
        float sacc = 0.f;
#pragma unroll 16
        for (int k = 64 * ks; k < 64 * ks + 64; ++k) sacc += GLD(float, pe + k) * GLD(float, w1 + (size_t)k * 128 + n);
        LAS float* red = (LAS float*)lds;
        __syncthreads();
        red[tid] = sacc;
        __syncthreads();
        if (tid < 16) { float t = 0.f; for (int i = 0; i < 32; ++i) t += red[i * 16 + tid]; ((float*)(ws + WS_CB1))[lk * 128 + (wi & 7) * 16 + tid] = t; }
        __syncthreads();
    }
}

template <bool INBF16, bool COPYRAW>
__device__ __forceinline__ void rmsnorm_phase(const void* x, const float* g, bf16_t* o, bf16_t* xraw = nullptr) {
    const int tid = otid(), lane = tid & 63, wave = tid >> 6;
    const int gw = blockIdx.x * NWAVE + wave, NGW = gridDim.x * NWAVE;
    f32x4 gv[4];
#pragma unroll
    for (int j = 0; j < 4; ++j) gv[j] = GLD(f32x4, (const f32x4*)g + lane + 64 * j);
    constexpr int RB = 4;
    for (int m0 = gw; m0 < MTOK; m0 += NGW * RB) {
        f32x4 v[RB][4]; float s[RB];
#pragma unroll
        for (int r = 0; r < RB; ++r) { const int m = m0 + r * NGW; const size_t ro = (size_t)(m < MTOK ? m : m0) * DM;
#pragma unroll
            for (int j = 0; j < 4; ++j) {
                if (!INBF16) v[r][j] = GLD(f32x4, (const f32x4*)((const float*)x + ro) + lane + 64 * j);
                else { const u32x2 w = GLD(u32x2, (const u32x2*)((const bf16_t*)x + ro) + lane + 64 * j);
                       if (COPYRAW && m < MTOK) GST(u32x2, (u32x2*)(xraw + ro) + lane + 64 * j, w);
                       v[r][j] = (f32x4){__builtin_bit_cast(float, w.x << 16), __builtin_bit_cast(float, w.x & 0xffff0000u), __builtin_bit_cast(float, w.y << 16), __builtin_bit_cast(float, w.y & 0xffff0000u)}; }
            } }
#pragma unroll
        for (int r = 0; r < RB; ++r) { s[r] = 0.f;
#pragma unroll
            for (int j = 0; j < 4; ++j) s[r] += (v[r][j].x * v[r][j].x + v[r][j].y * v[r][j].y) + (v[r][j].z * v[r][j].z + v[r][j].w * v[r][j].w); }
#pragma unroll
        for (int of = 1; of < 64; of <<= 1) {
#pragma unroll
            for (int r = 0; r < RB; ++r) s[r] += __shfl_xor(s[r], of); }
#pragma unroll
        for (int r = 0; r < RB; ++r) { const int m = m0 + r * NGW;
            if (m < MTOK) {
                const float rs = __builtin_amdgcn_rsqf(s[r] * (1.f / DM) + EPS);
                u32x2* o8 = (u32x2*)(o + (size_t)m * DM) + lane;
#pragma unroll
                for (int j = 0; j < 4; ++j) { u32x2 w; w.x = pk2(v[r][j].x * rs * gv[j].x, v[r][j].y * rs * gv[j].y); w.y = pk2(v[r][j].z * rs * gv[j].z, v[r][j].w * rs * gv[j].w); GST(u32x2, o8 + 64 * j, w); }
            }
        }
    }
}

__device__ __forceinline__ float gelu_tanh(float x) {
    const float y = 0.7978845608028654f * (x + 0.044715f * x * x * x);
    const float e = __builtin_amdgcn_exp2f(2.f * LOG2E * y);
    const float t = 1.f - 2.f * __builtin_amdgcn_rcpf(e + 1.f);
    return 0.5f * x * (1.f + t);
}
__device__ __forceinline__ void compress_phase(const Params& P, int l, LAS unsigned char* lds) {
    const int tid = otid(), lane = tid & 63, wave = tid >> 6, fr = lane & 15, kq = lane >> 4;
    unsigned char* ws = WSP;
    LAS bf16_t* Hs = (LAS bf16_t*)lds;
    LAS float* Os = (LAS float*)(lds + 8192);
    for (int unit = blockIdx.x; unit < 2 * 16 * 16; unit += gridDim.x) {
        const int kv = unit >> 8, bg = (unit >> 4) & 15, cblk = unit & 15, c0 = 16 * cblk;
        const bf16_t* src = (const bf16_t*)(ws + (kv ? Z_VCR : Z_KCR)) + (size_t)bg * SEQ * 64;
        const int crow_ = (c0 + fr) < 255 ? (c0 + fr) : 254;
        const bf16_t* ap = src + (size_t)1024 * crow_ + 8 * kq;
        const bf16_t* bp = (const bf16_t*)(ws + WS_CW1 + (size_t)(l * 2 + kv) * CW1_SZ) + (size_t)(16 * wave + fr) * 2048 + 8 * kq;
        f32x4 acc = {0.f, 0.f, 0.f, 0.f};
#pragma unroll 8
        for (int kk = 0; kk < 64; ++kk) { const bf16x8 a = GLD(bf16x8, ap + 32 * kk), b = GLD(bf16x8, bp + 32 * kk); acc = __builtin_amdgcn_mfma_f32_16x16x32_bf16(a, b, acc, 0, 0, 0); }
        const float cb = ((const float*)(ws + WS_CB1))[(l * 2 + kv) * 128 + 16 * wave + fr];
#pragma unroll
        for (int i = 0; i < 4; ++i) Hs[(4 * kq + i) * 136 + 16 * wave + fr] = (bf16_t)f2bf(gelu_tanh(acc[i] + cb));
        __syncthreads();
        if (wave < 4) {
            const bf16_t* b2 = (const bf16_t*)(ws + WS_CW2 + (size_t)(l * 2 + kv) * CW2_SZ) + (size_t)(16 * wave + fr) * 128 + 8 * kq;
            f32x4 a2 = {0.f, 0.f, 0.f, 0.f};
#pragma unroll
            for (int kk = 0; kk < 4; ++kk) { const bf16x8 a = *(const LAS bf16x8*)(Hs + fr * 136 + 32 * kk + 8 * kq), b = *(const bf16x8*)(b2 + 32 * kk); a2 = __builtin_amdgcn_mfma_f32_16x16x32_bf16(a, b, a2, 0, 0, 0); }
#pragma unroll
            for (int i = 0; i < 4; ++i) Os[(4 * kq + i) * 65 + 16 * wave + fr] = a2[i];
        }
        __syncthreads();
#pragma unroll
        for (int rep = 0; rep < 2; ++rep) {
            const int e = tid + NTHR * rep, row = e >> 6, d = e & 63, c = c0 + row;
            const float val = Os[row * 65 + d];
            if (kv == 0) {
                float ss = 0.f;
                for (int j = 0; j < 64; ++j) { const float t = Os[row * 65 + j]; ss += t * t; }
                const float o = val * __builtin_amdgcn_rsqf(ss * (1.f / 64.f) + EPS) * INP(22)[l * 192 + d];
                ((bf16_t*)(ws + WS_KCN))[((size_t)bg * 256 + c) * 64 + d] = (c < 255) ? (bf16_t)f2bf(o) : (bf16_t)0;
            } else {
                ((bf16_t*)(ws + WS_VCT))[((size_t)bg * 64 + d) * 256 + c] = (c < 255) ? (bf16_t)f2bf(val) : (bf16_t)0;
            }
        }
        __syncthreads();
    }
}

__device__ __forceinline__ void qk_tile(f32x16& p0, f32x16& p1, const LAS unsigned char* Kl, const bf16x8 (&qf)[4], int r32, int hi) {
    const LAS unsigned char* kb = Kl + r32 * KP + hi * 16;
    bf16x8 a[8];
#pragma unroll
    for (int d0 = 0; d0 < 4; ++d0) { a[2 * d0] = *(const LAS bf16x8*)(kb + d0 * 32); a[2 * d0 + 1] = *(const LAS bf16x8*)(kb + 32 * KP + d0 * 32); }
    __builtin_amdgcn_s_setprio(1);
#pragma unroll
    for (int d0 = 0; d0 < 4; ++d0) {
        p0 = __builtin_amdgcn_mfma_f32_32x32x16_bf16(a[2 * d0], qf[d0], p0, 0, 0, 0);
        p1 = __builtin_amdgcn_mfma_f32_32x32x16_bf16(a[2 * d0 + 1], qf[d0], p1, 0, 0, 0);
    }
    __builtin_amdgcn_s_setprio(0);
}
template <int STRIDE, bool WINDOW, int MODE>
__device__ __forceinline__ void score_exp(f32x16& p0, f32x16& p1, int dl, const LAS float* tb, float cfar, bool rowsel) {
    const LAS float* tl = tb + 128 + (dl < 1087 ? dl : 1087) - 59;
#pragma unroll
    for (int blk = 0; blk < 2; ++blk) {
        f32x16& p = blk ? p1 : p0;
#pragma unroll
        for (int r = 0; r < 16; ++r) {
            const int c = (r & 3) + 8 * (r >> 2) + 32 * blk;
            const int dist = dl - STRIDE * c;
            float e;
            if (MODE == 0) e = __builtin_amdgcn_exp2f(p[r] + cfar);
            else {
                float bias;
                if (STRIDE == 1) bias = tl[59 - c];
                else bias = tb[128 + min((unsigned)dist, 1023u)];
                e = __builtin_amdgcn_exp2f(p[r] + bias);
                if (MODE == 2) { bool valid = dist >= 0; if (WINDOW) valid = valid && (dist < 512); e = valid ? e : 0.f; }
            }
            p[r] = rowsel ? e : 0.f;
        }
    }
}
template <int STRIDE, bool WINDOW>
__device__ __forceinline__ void score_exp_sel(f32x16& p0, f32x16& p1, int dl, const LAS float* tb, float cfar, bool rowsel, int dmin, int dmax) {
    if (!WINDOW && dmin >= 790) score_exp<STRIDE, WINDOW, 0>(p0, p1, dl, tb, cfar, rowsel);
    else if (dmin >= 0 && (!WINDOW || dmax < 512)) score_exp<STRIDE, WINDOW, 1>(p0, p1, dl, tb, cfar, rowsel);
    else score_exp<STRIDE, WINDOW, 2>(p0, p1, dl, tb, cfar, rowsel);
}
__device__ __forceinline__ float sum32(const f32x16& p0, const f32x16& p1) {
    float a = 0.f, b = 0.f;
#pragma unroll
    for (int r = 0; r < 16; ++r) { a += p0[r]; b += p1[r]; }
    return a + b;
}
template <int NDB>
__device__ __forceinline__ void pv_tile(f32x16 (&o)[NDB], const f32x16& p0, const f32x16& p1, const LAS unsigned char* Vl, int r32, int hi) {
    const LAS unsigned char* vbase = Vl + r32 * VP + hi * 8;
    bf16x4 vf[2][NDB][2];
#define PV_LOAD(st, buf) do { _Pragma("unroll") for (int db = 0; db < NDB; ++db) { const LAS unsigned char* vp = vbase + db * 32 * VP + (st) * 32; vf[buf][db][0] = *(const LAS bf16x4*)vp; vf[buf][db][1] = *(const LAS bf16x4*)(vp + 16); } } while (0)
    PV_LOAD(0, 0);
#pragma unroll
    for (int st = 0; st < 4; ++st) {
        if (st + 1 < 4) PV_LOAD(st + 1, (st + 1) & 1);
        const f32x16& p = (st >> 1) ? p1 : p0; const int s8 = 8 * (st & 1);
        u32x4 w; w.x = pg8::cvt_pk_bf16(p[s8 + 0], p[s8 + 1]); w.y = pg8::cvt_pk_bf16(p[s8 + 2], p[s8 + 3]); w.z = pg8::cvt_pk_bf16(p[s8 + 4], p[s8 + 5]); w.w = pg8::cvt_pk_bf16(p[s8 + 6], p[s8 + 7]);
        const bf16x8 pa = __builtin_bit_cast(bf16x8, w);
        __builtin_amdgcn_s_setprio(1);
#pragma unroll
        for (int db = 0; db < NDB; ++db) {
            const bf16x4 lo = vf[st & 1][db][0], hi4 = vf[st & 1][db][1];
            const bf16x8 vb = {lo[0], lo[1], lo[2], lo[3], hi4[0], hi4[1], hi4[2], hi4[3]};
            o[db] = __builtin_amdgcn_mfma_f32_32x32x16_bf16(pa, vb, o[db], 0, 0, 0);
        }
        __builtin_amdgcn_s_setprio(0);
    }
#undef PV_LOAD
}
__device__ __forceinline__ u32x4 ldk(const bf16_t* g, int tid) { return GLD(u32x4, (const unsigned char*)g + tid * 16); }
__device__ __forceinline__ void stk(LAS unsigned char* Kl, u32x4 v, int tid) { *(LAS u32x4*)(Kl + (tid >> 3) * KP + (tid & 7) * 16) = v; }
__device__ __forceinline__ u32x4 ldv(const bf16_t* g, size_t rs, int row, int tid) { return GLD(u32x4, (const unsigned char*)(g + (size_t)row * rs) + (tid & 7) * 16); }
__device__ __forceinline__ void stv(LAS unsigned char* Vl, u32x4 v, int row, int tid) { LAS unsigned char* p = Vl + row * VP + (tid & 7) * 16; *(LAS u32x2*)p = (u32x2){v.x, v.y}; *(LAS u32x2*)(p + 8) = (u32x2){v.z, v.w}; }

__device__ __forceinline__ void da_unit(const Params& P, int l, int b, int h, int qb, LAS unsigned char* lds, bool load_tab) {
    const int tid = otid(), lane = tid & 63, wave = __builtin_amdgcn_readfirstlane(tid >> 6), r32 = lane & 31, hi = lane >> 5;
    const int c = wave >> 2, qsub = wave & 3, q0 = qb * 128, qw0 = q0 + 32 * qsub;
    unsigned char* ws = WSP;
    const float* prm = (const float*)(ws + WS_PRM) + l * 8;
    const float lam = prm[0], Mb = prm[1], onem = prm[3];
    LAS float* biasL = (LAS float*)(lds + L_BIAS);
    const float* bg = (const float*)(ws + WS_BIAS) + h * 1024;
    if (load_tab) for (int i = tid; i < TBN; i += NTHR) { const int d = i - 128; biasL[i] = GLD(float, bg + (d < 0 ? 0 : (d > 1023 ? 1023 : d))) - Mb; }
    const float cfar = bg[1023] - Mb;
    const bf16_t* Qp = (const bf16_t*)(ws + Z_DQ) + ((size_t)(b * 8 + h * 2 + c) * SEQ + qw0 + r32) * 64 + hi * 8;
    bf16x8 qf[4];
#pragma unroll
    for (int d0 = 0; d0 < 4; ++d0) qf[d0] = GLD(bf16x8, Qp + d0 * 16);
    const bf16_t* K1g = (const bf16_t*)(ws + Z_DK) + (size_t)(b * 8 + h * 2) * SEQ * 64;
    const bf16_t* K2g = K1g + (size_t)SEQ * 64;
    const bf16_t* Vg = (const bf16_t*)(ws + Z_DVT) + (size_t)(b * 4 + h) * 128 * SEQ;
    const int NT = (q0 + 128) / 64;
    f32x16 o[4];
#pragma unroll
    for (int i = 0; i < 4; ++i) o[i] = (f32x16){};
    float lsum = 0.f;
    u32x4 rk1, rk2, rv0, rv1;
#define DA_LOAD(t) do { rk1 = ldk(K1g + (size_t)(t) * 4096, tid); rk2 = ldk(K2g + (size_t)(t) * 4096, tid); rv0 = ldv(Vg + (t) * 64, SEQ, tid >> 3, tid); rv1 = ldv(Vg + (t) * 64, SEQ, 64 + (tid >> 3), tid); } while (0)
#define DA_STORE(sb) do { LAS unsigned char* st_ = lds + (sb) * DA_STAGE; stk(st_, rk1, tid); stk(st_ + 64 * KP, rk2, tid); stv(st_ + 128 * KP, rv0, tid >> 3, tid); stv(st_ + 128 * KP, rv1, 64 + (tid >> 3), tid); } while (0)
    DA_LOAD(0); DA_STORE(0);
    __syncthreads();
    for (int t = 0; t < NT; ++t) {
        if (t + 1 < NT) DA_LOAD(t + 1);
        if (64 * t <= qw0 + 31) {
            const LAS unsigned char* st = lds + (t & 1) * DA_STAGE;
            f32x16 p0 = (f32x16){}, p1 = (f32x16){};
            qk_tile(p0, p1, st + c * 64 * KP, qf, r32, hi);
            const int dl = qw0 + r32 - 64 * t - 4 * hi;
            score_exp_sel<1, false>(p0, p1, dl, biasL, cfar, true, qw0 - (64 * t + 63), qw0 + 31 - 64 * t);
            lsum += sum32(p0, p1);
            pv_tile<4>(o, p0, p1, st + 128 * KP, r32, hi);
        }
        if (t + 1 < NT) DA_STORE((t + 1) & 1);
        __syncthreads();
    }
#undef DA_LOAD
#undef DA_STORE
    lsum += __shfl_xor(lsum, 32);
    LAS float* wsf = (LAS float*)(lds + L_WSF) + wave * 64;
    if (hi == 0) wsf[r32] = (lsum > 0.f) ? 1.0f / lsum : 0.f;
    asm volatile("s_waitcnt lgkmcnt(0)" ::: "memory");
    float li[16];
#pragma unroll
    for (int r = 0; r < 16; ++r) li[r] = wsf[crow(r, hi)];
    LAS float* X = (LAS float*)lds;
    if (c == 1) {
#pragma unroll
        for (int db = 0; db < 4; ++db)
#pragma unroll
            for (int r = 0; r < 16; ++r) X[(32 * qsub + crow(r, hi)) * 132 + r32 + 32 * db] = o[db][r] * li[r];
    }
    __syncthreads();
    if (c == 0) {
        const float* sg = INP(20) + l * 128;
        float gsub[4];
#pragma unroll
        for (int db = 0; db < 4; ++db) gsub[db] = sg[r32 + 32 * db] * onem;
#pragma unroll
        for (int r = 0; r < 16; ++r) {
            float y[4], ss = 0.f;
#pragma unroll
            for (int db = 0; db < 4; ++db) { y[db] = o[db][r] * li[r] - lam * X[(32 * qsub + crow(r, hi)) * 132 + r32 + 32 * db]; ss += y[db] * y[db]; }
            ss += __shfl_xor(ss, 1); ss += __shfl_xor(ss, 2); ss += __shfl_xor(ss, 4); ss += __shfl_xor(ss, 8); ss += __shfl_xor(ss, 16);
            const float rs = __builtin_amdgcn_rsqf(ss * (1.f / 128.f) + EPS);
            bf16_t* d = (bf16_t*)(ws + WS_XN) + (size_t)(b * SEQ + qw0 + crow(r, hi)) * DM + h * 128 + r32;
#pragma unroll
            for (int db = 0; db < 4; ++db) GST(bf16_t, d + 32 * db, (bf16_t)f2bf(y[db] * rs * gsub[db]));
        }
    }
    __syncthreads();
}

__device__ __forceinline__ void nsa_unit(const Params& P, int l, int b, int g, int u, LAS unsigned char* lds, bool load_tab) {
    const int tid = otid(), lane = tid & 63, wave = __builtin_amdgcn_readfirstlane(tid >> 6), r32 = lane & 31, hi = lane >> 5;
    const int qi = r32 >> 2, p = r32 & 3, qw0 = 64 * u + 8 * wave, qpos = qw0 + qi, head = g * 4 + p;
    unsigned char* ws = WSP;
    const float Mb = ((const float*)(ws + WS_PRM))[l * 8 + 2];
    LAS float* biasL = (LAS float*)(lds + L_BIAS);
    LAS float* imp = (LAS float*)(lds + L_IMP);
    LAS unsigned* selw = (LAS unsigned*)(lds + L_SEL);
    LAS float* wsf = (LAS float*)(lds + L_WSF) + wave * 64;
    const float* bgl = (const float*)(ws + WS_BIAS) + (size_t)(4 + g * 4) * 1024;
    if (load_tab) for (int i = tid; i < 4 * TBN; i += NTHR) { const int hh = i / TBN, d = i % TBN - 128; biasL[i] = GLD(float, bgl + hh * 1024 + (d < 0 ? 0 : (d > 1023 ? 1023 : d))) - Mb; }
    if (tid == 0) { unsigned z = 0u; asm volatile("" : "+v"(z)); selw[128] = z; selw[129] = z; }
    const LAS float* tb = biasL + p * TBN;
    const float cfar = bgl[p * 1024 + 1023] - Mb;
    const bf16_t* Qp = (const bf16_t*)(ws + Z_NQ) + ((size_t)(b * 8 + head) * SEQ + qpos) * 64 + hi * 8;
    bf16x8 qf[4];
#pragma unroll
    for (int d0 = 0; d0 < 4; ++d0) qf[d0] = GLD(bf16x8, Qp + d0 * 16);
    const float* ngp = (const float*)(ws + Z_NG) + (size_t)(b * SEQ + qpos) * 24 + head * 3;
    const float gate_c = GLD(float, ngp), gate_s = GLD(float, ngp + 1), gate_w = GLD(float, ngp + 2);
    f32x16 oc[2]; oc[0] = (f32x16){}; oc[1] = (f32x16){};
    f32x16 o[2];
    u32x4 rk, rv;
    const int bgi = b * 2 + g;
#define NS_STORE(sb) do { LAS unsigned char* st_ = lds + (sb) * NS_STAGE; stk(st_, rk, tid); stv(st_ + 64 * KP, rv, tid >> 3, tid); } while (0)
#define NS_FOLD(gate) do { lsum += __shfl_xor(lsum, 32); if (hi == 0) wsf[r32] = (lsum > 0.f) ? (gate) / lsum : 0.f; asm volatile("s_waitcnt lgkmcnt(0)" ::: "memory"); \
        _Pragma("unroll") for (int r = 0; r < 16; ++r) { const float f_ = wsf[crow(r, hi)]; oc[0][r] += f_ * o[0][r]; oc[1][r] += f_ * o[1][r]; } asm volatile("s_waitcnt lgkmcnt(0)" ::: "memory"); } while (0)
    {
        const bf16_t* Kg = (const bf16_t*)(ws + WS_KCN) + (size_t)bgi * 256 * 64;
        const bf16_t* Vg = (const bf16_t*)(ws + WS_VCT) + (size_t)bgi * 64 * 256;
        const int ntc = (4 * u + 2) / 64 + 1;
        for (int tc = 0; tc < ntc; ++tc) { rk = ldk(Kg + (size_t)tc * 4096, tid); rv = ldv(Vg + tc * 64, 256, tid >> 3, tid); NS_STORE(tc); }
        __syncthreads();
        float lsum = 0.f;
        for (int tc = 0; tc < ntc; ++tc) {
            const LAS unsigned char* st = lds + tc * NS_STAGE;
            f32x16 p0 = (f32x16){}, p1 = (f32x16){};
            qk_tile(p0, p1, st, qf, r32, hi);
            const int dl = qpos - 31 - 16 * (64 * tc + 4 * hi);
            score_exp_sel<16, false>(p0, p1, dl, tb, cfar, true, qw0 - 31 - 16 * (64 * tc + 63), qw0 + 7 - 31 - 16 * 64 * tc);
            lsum += sum32(p0, p1);
        }
        const float lt = lsum + __shfl_xor(lsum, 32);
        const float linv = (lt > 0.f) ? 1.0f / lt : 0.f;
        o[0] = (f32x16){}; o[1] = (f32x16){};
        float carry = 0.f;
        for (int tc = 0; tc < ntc; ++tc) {
            const LAS unsigned char* st = lds + tc * NS_STAGE;
            f32x16 p0 = (f32x16){}, p1 = (f32x16){};
            qk_tile(p0, p1, st, qf, r32, hi);
            const int dl = qpos - 31 - 16 * (64 * tc + 4 * hi);
            score_exp_sel<16, false>(p0, p1, dl, tb, cfar, true, qw0 - 31 - 16 * (64 * tc + 63), qw0 + 7 - 31 - 16 * 64 * tc);
            float Qs[2][4], PL[2][4];
#pragma unroll
            for (int blk = 0; blk < 2; ++blk)
#pragma unroll
                for (int m = 0; m < 4; ++m) { const f32x16& pp = blk ? p1 : p0; Qs[blk][m] = (pp[4 * m] + pp[4 * m + 1]) + (pp[4 * m + 2] + pp[4 * m + 3]); PL[blk][m] = __shfl_xor(pp[4 * m + 3], 32); }
#pragma unroll
            for (int blk = 0; blk < 2; ++blk)
#pragma unroll
                for (int m = 0; m < 4; ++m) {
                    const float prev = (m > 0) ? PL[blk][m - 1] : (blk ? PL[0][3] : carry);
                    float e = (Qs[blk][m] + (hi ? PL[blk][m] : prev)) * linv;
                    e += __shfl_xor(e, 1); e += __shfl_xor(e, 2);
                    if (p == 0) imp[(8 * wave + qi) * 64 + 16 * tc + 8 * blk + 2 * m + hi] = e;
                }
            carry = PL[1][3];
            pv_tile<2>(o, p0, p1, st + 64 * KP, r32, hi);
        }
        NS_FOLD(gate_c);
    }
    __syncthreads();
    {
        const int ql = lane >> 3, sub = lane & 7, q = 8 * wave + ql;
        unsigned long long m;
        if (u < 8) m = (2ull << u) - 1ull;
        else {
            m = 1ull | (1ull << u) | (1ull << (u - 1));
            float v[8];
#pragma unroll
            for (int i = 0; i < 8; ++i) { const int j = sub + 8 * i; v[i] = (j >= 1 && j <= u - 2) ? imp[q * 64 + j] : -1.f; }
            for (int k = 0; k < 5; ++k) {
                float bv = v[0]; int bj = sub;
#pragma unroll
                for (int i = 1; i < 8; ++i) if (v[i] > bv) { bv = v[i]; bj = sub + 8 * i; }
#pragma unroll
                for (int of = 1; of < 8; of <<= 1) { const float ov = __shfl_xor(bv, of); const int oj = __shfl_xor(bj, of); if (ov > bv || (ov == bv && oj < bj)) { bv = ov; bj = oj; } }
                m |= 1ull << bj;
#pragma unroll
                for (int i = 0; i < 8; ++i) if (bj == sub + 8 * i) v[i] = -2.f;
            }
        }
        if (sub == 0) { selw[2 * q] = (unsigned)m; selw[2 * q + 1] = (unsigned)(m >> 32); atomicOr((unsigned*)&selw[128], (unsigned)m); atomicOr((unsigned*)&selw[129], (unsigned)(m >> 32)); }
    }
    __syncthreads();
    asm volatile("" : "+v"(oc[0]), "+v"(oc[1]));
    u32x4 rk2, rv2;
#define NS_LOADA(Kg_, Vg_, j_) do { rk = ldk((Kg_) + (size_t)(j_) * 4096, tid); rv = ldv((Vg_) + (j_) * 64, SEQ, tid >> 3, tid); } while (0)
#define NS_LOADB(Kg_, Vg_, j_) do { rk2 = ldk((Kg_) + (size_t)(j_) * 4096, tid); rv2 = ldv((Vg_) + (j_) * 64, SEQ, tid >> 3, tid); } while (0)
#define NS_STOREA(sb) do { LAS unsigned char* st_ = lds + (sb) * NS_STAGE; stk(st_, rk, tid); stv(st_ + 64 * KP, rv, tid >> 3, tid); } while (0)
#define NS_STOREB(sb) do { LAS unsigned char* st_ = lds + (sb) * NS_STAGE; stk(st_, rk2, tid); stv(st_ + 64 * KP, rv2, tid >> 3, tid); } while (0)
    {
        const unsigned long long un = (unsigned long long)selw[128] | ((unsigned long long)selw[129] << 32);
        const unsigned long long mine = (unsigned long long)selw[2 * (8 * wave + qi)] | ((unsigned long long)selw[2 * (8 * wave + qi) + 1] << 32);
        const bf16_t* Kg = (const bf16_t*)(ws + Z_KSEL) + (size_t)bgi * SEQ * 64;
        const bf16_t* Vg = (const bf16_t*)(ws + Z_VSELT) + (size_t)bgi * 64 * SEQ;
        o[0] = (f32x16){}; o[1] = (f32x16){};
        float lsum = 0.f;
        unsigned long long rem = un;
#define NS_NEXTJ(var, has) do { has = (rem != 0ull); var = 0; if (has) { var = __builtin_ctzll(rem); rem &= rem - 1; } } while (0)
        int jc, j1, j2; bool h1, h2;
        NS_NEXTJ(jc, h1);
        NS_NEXTJ(j1, h1);
        NS_LOADA(Kg, Vg, jc); if (h1) NS_LOADB(Kg, Vg, j1);
        NS_STOREA(0);
        __syncthreads();
        int sc = 0;
#define NS_SEL_STEP(LOADF, STOREN) { \
            NS_NEXTJ(j2, h2); if (h2) LOADF(Kg, Vg, j2); \
            const bool rowsel = (mine >> jc) & 1ull; \
            if (__any(rowsel)) { \
                const LAS unsigned char* st = lds + sc * NS_STAGE; \
                f32x16 p0 = (f32x16){}, p1 = (f32x16){}; \
                qk_tile(p0, p1, st, qf, r32, hi); \
                const int dl = qpos - 64 * jc - 4 * hi; \
                score_exp_sel<1, false>(p0, p1, dl, tb, cfar, rowsel, qw0 - (64 * jc + 63), qw0 + 7 - 64 * jc); \
                lsum += sum32(p0, p1); \
                pv_tile<2>(o, p0, p1, st + 64 * KP, r32, hi); \
            } \
            const int sn = (sc == 2) ? 0 : sc + 1; \
            if (h1) STOREN(sn); \
            __syncthreads(); \
            if (!h1) break; \
            jc = j1; j1 = j2; h1 = h2; sc = sn; }
        for (;;) { NS_SEL_STEP(NS_LOADA, NS_STOREB) NS_SEL_STEP(NS_LOADB, NS_STOREA) }
#undef NS_SEL_STEP
#undef NS_NEXTJ
        NS_FOLD(gate_s);
        asm volatile("" : "+v"(oc[0]), "+v"(oc[1]));
    }
    {
        const bf16_t* Kg = (const bf16_t*)(ws + Z_KWIN) + (size_t)bgi * SEQ * 64;
        const bf16_t* Vg = (const bf16_t*)(ws + Z_VWINT) + (size_t)bgi * 64 * SEQ;
        o[0] = (f32x16){}; o[1] = (f32x16){};
        float lsum = 0.f;
        const int t0 = (u >= 8) ? u - 8 : 0;
        int t = t0, sc = 0;
        NS_LOADA(Kg, Vg, t0); if (t0 + 1 <= u) NS_LOADB(Kg, Vg, t0 + 1);
        NS_STOREA(0);
        __syncthreads();
#define NS_WIN_STEP(LOADF, STOREN) { \
            if (t + 2 <= u) LOADF(Kg, Vg, t + 2); \
            { \
                const LAS unsigned char* st = lds + sc * NS_STAGE; \
                f32x16 p0 = (f32x16){}, p1 = (f32x16){}; \
                qk_tile(p0, p1, st, qf, r32, hi); \
                const int dl = qpos - 64 * t - 4 * hi; \
                score_exp_sel<1, true>(p0, p1, dl, tb, cfar, true, qw0 - (64 * t + 63), qw0 + 7 - 64 * t); \
                lsum += sum32(p0, p1); \
                pv_tile<2>(o, p0, p1, st + 64 * KP, r32, hi); \
            } \
            const int sn = (sc == 2) ? 0 : sc + 1; \
            if (t + 1 <= u) STOREN(sn); \
            __syncthreads(); \
            if (t + 1 > u) break; \
            ++t; sc = sn; }
        for (;;) { NS_WIN_STEP(NS_LOADA, NS_STOREB) NS_WIN_STEP(NS_LOADB, NS_STOREA) }
#undef NS_WIN_STEP
        NS_FOLD(gate_w);
    }
#undef NS_LOADA
#undef NS_LOADB
#undef NS_STOREA
#undef NS_STOREB
#undef NS_STORE
#undef NS_FOLD
#pragma unroll
    for (int r = 0; r < 16; ++r) {
        const int row = crow(r, hi), q = qw0 + (row >> 2), pp = row & 3;
        bf16_t* d = (bf16_t*)(ws + WS_XN) + (size_t)(b * SEQ + q) * DM + 512 + (g * 4 + pp) * 64 + r32;
        GST(bf16_t, d, (bf16_t)f2bf(oc[0][r])); GST(bf16_t, d + 32, (bf16_t)f2bf(oc[1][r]));
    }
    __syncthreads();
}

__device__ __forceinline__ void attention_phase(const Params& P, int l, LAS unsigned char* lds) {
    int tab_key = -1;
    for (int it = blockIdx.x; it < 2048; it += gridDim.x) {
        const int c = it & 255, sl = (it >> 8) & 3;
        if (it < 1024) { const int bh = c & 31, xg = c >> 5; const int qb = (sl == 0) ? 31 - xg : (sl == 1) ? 23 - xg : (sl == 2) ? 8 + xg : xg;
            da_unit(P, l, bh >> 2, bh & 3, qb, lds, tab_key != (bh & 3)); tab_key = bh & 3; }
        else { const int bg = c & 15, ug = c >> 4; const int u = (sl == 0) ? 63 - ug : (sl == 1) ? 47 - ug : (sl == 2) ? 16 + ug : ug;
            nsa_unit(P, l, bg >> 1, bg & 1, u, lds, tab_key != 4 + (bg & 1)); tab_key = 4 + (bg & 1); }
    }
}

constexpr size_t WS_BAR = 72 * 1024;
#define RLX_AGENT __ATOMIC_RELAXED, __HIP_MEMORY_SCOPE_AGENT
#define XB_TMO      128
#define XB_XCNT(j)  (256  + 64 * (j))
#define XB_XSUB(j)  (1280 + 64 * (j))
#define XB_XGEN(j)  (2304 + 64 * (j))
#define XB_TOP      3328
#define XB_TOPGEN   3392
#define XCD_BAR_WORDS 3456
#define XB_SPIN_CAP (1u << 18)

__device__ __forceinline__ unsigned xb_ld(unsigned* p)              { return __hip_atomic_load(p, __ATOMIC_RELAXED, __HIP_MEMORY_SCOPE_AGENT); }
__device__ __forceinline__ unsigned xb_add(unsigned* p, unsigned v) { return __hip_atomic_fetch_add(p, v, __ATOMIC_RELAXED, __HIP_MEMORY_SCOPE_AGENT); }
__device__ __forceinline__ unsigned xb_xcc_id() { return (unsigned)__builtin_amdgcn_s_getreg((3 << 11) | 20) & 0xFu; }
#define XB_SPIN(cond, bar) do { unsigned _sp = 0; while (cond) { __builtin_amdgcn_s_sleep(1); \
    if ((++_sp & 255u) == 0u) { if (xb_ld(&(bar)[XB_TMO])) break; if (_sp > XB_SPIN_CAP) { atomicAdd(&(bar)[XB_TMO], 1u); break; } } } } while (0)

struct XcdBarrier {
    unsigned* bar; unsigned x;
    volatile LAS unsigned* st;
};

__device__ __forceinline__ XcdBarrier xcd_barrier_post(unsigned* bar, volatile LAS unsigned* st) {
    XcdBarrier b; b.bar = bar; b.x = xb_xcc_id(); b.st = st;
    if (threadIdx.x == 0) (void)xb_add(&bar[XB_XCNT(b.x)], 1u);
    return b;
}
__device__ __forceinline__ void xcd_barrier_complete(unsigned* bar, unsigned x, unsigned& nloc, unsigned& nx) {
    const unsigned G = gridDim.x * gridDim.y * gridDim.z;
    unsigned sum, cnt, mine, sp = 0u;
    for (;;) {
        sum = 0u; cnt = 0u; mine = 0u;
#pragma unroll
        for (unsigned j = 0; j < 16; ++j) { const unsigned c = xb_ld(&bar[XB_XCNT(j)]); sum += c; cnt += (c > 0u) ? 1u : 0u; mine = (j == x) ? c : mine; }
        if (sum == G) break;
        __builtin_amdgcn_s_sleep(1);
        if ((++sp & 255u) == 0u) { if (xb_ld(&bar[XB_TMO])) break; if (sp > XB_SPIN_CAP) { atomicAdd(&bar[XB_TMO], 1u); break; } }
    }
    nloc = mine > 0u ? mine : 1u; nx = cnt > 0u ? cnt : 1u;
}

__device__ __forceinline__ void xcd_barrier(const XcdBarrier& b) {
    asm volatile("s_waitcnt vmcnt(0)" ::: "memory");
    __syncthreads();
    if (threadIdx.x == 0) {
        unsigned* bar = b.bar;
        __builtin_amdgcn_s_waitcnt(0);
        unsigned nloc = b.st[0], nx = b.st[1];
        if (nloc == 0u) { xcd_barrier_complete(bar, b.x, nloc, nx); b.st[0] = nloc; b.st[1] = nx; }
        const unsigned old = xb_add(&bar[XB_XSUB(b.x)], 1u);
        const unsigned gen = old / nloc;
        if (old + 1u == (gen + 1u) * nloc) {
            __builtin_amdgcn_fence(__ATOMIC_RELEASE, "agent");
            asm volatile("s_waitcnt vmcnt(0)" ::: "memory");
            const unsigned og = xb_add(&bar[XB_TOP], 1u);
            const unsigned tg = og / nx;
            if (og + 1u == (tg + 1u) * nx) xb_add(&bar[XB_TOPGEN], 1u);
            else XB_SPIN(xb_ld(&bar[XB_TOPGEN]) == tg, bar);
            __builtin_amdgcn_fence(__ATOMIC_ACQUIRE, "agent");
            xb_add(&bar[XB_XGEN(b.x)], 1u);
            asm volatile("s_waitcnt vmcnt(0)" ::: "memory");
        } else {
            XB_SPIN(xb_ld(&bar[XB_XGEN(b.x)]) == gen, bar);
            __builtin_amdgcn_fence(__ATOMIC_ACQUIRE, "agent");
            asm volatile("s_waitcnt vmcnt(0)" ::: "memory");
        }
    }
    __syncthreads();
}

__global__ void __launch_bounds__(NTHR, 2) hybrid_fwd(Params P) {
    extern __shared__ __attribute__((aligned(16))) unsigned char lds_raw[];
    LAS unsigned char* lds = (LAS unsigned char*)lds_raw;
    cg::grid_group grid = cg::this_grid();
#define GSYNC() do { XcdBarrier xb_; xb_.bar = (unsigned*)(WSP + WS_BAR); xb_.x = xb_xcc_id(); xb_.st = (volatile LAS unsigned*)(lds + L_PTAB + 384); xcd_barrier(xb_); } while (0)
    if (threadIdx.x == 0) {
        LAS unsigned long long* pt = (LAS unsigned long long*)(lds + L_PTAB);
#pragma unroll
        for (int i = 0; i < 30; ++i) pt[i] = (unsigned long long)P.in[i];
        pt[30] = (unsigned long long)P.out; pt[31] = (unsigned long long)P.ws;
        *(LAS unsigned*)(lds + L_PTAB + 384) = 0u; *(LAS unsigned*)(lds + L_PTAB + 388) = 0u;
    }
    __syncthreads();
    (void)xcd_barrier_post((unsigned*)(WSP + WS_BAR), (volatile LAS unsigned*)(lds + L_PTAB + 384));
    const int G = gridDim.x, bx = blockIdx.x;
#define ws WSP
#define XN ((bf16_t*)(WSP + WS_XN))
#define HID ((bf16_t*)(WSP + WS_HID))
#define MERGED ((bf16_t*)(WSP + WS_MERGED))
#define XB ((bf16_t*)OUTP)
#define XRAW ((bf16_t*)(WSP + WS_Z + 192 * MiB))

#if defined(PROBE_PHASE)
    int n_stamp = 0;
#define STAMP() do { if (blockIdx.x == 0 && threadIdx.x == 0) ((LAS unsigned long long*)(lds + L_PTAB + 512))[n_stamp] = __builtin_amdgcn_s_memrealtime(); ++n_stamp; } while (0)
#else
#define STAMP() do {} while (0)
#endif
    if (P.out == nullptr) grid.sync();
    STAMP();
    prologue(P, lds);
    rmsnorm_phase<false, false>(INP(0), INP(5), (bf16_t*)(WSP + WS_XN));
#if defined(DUP_PRO)
    prologue(P, lds);
#endif
    GSYNC(); STAMP();
#pragma unroll
    for (int l = 0; l < DEPTH; ++l) {
        const float* xin = (l == 0) ? INP(0) : OUTP;
        if (l > 0) { rmsnorm_phase<true, false>(XB, INP(5) + l * DM, XN); GSYNC(); STAMP(); }
        { pg8::Gemm g{XN, (const bf16_t*)(ws + WS_W13 + (size_t)(l * 2 + 0) * W13_SZ), MTOK, 5632, DM}; pg8::StaticOrder S; S.init(MTOK, 5632, G, bx);
          EpiSwiGLU E{HID}; pg8::gemm_phase<EpiSwiGLU, pg8::StaticOrder, true, true>(lds, g, S, E);
#if defined(DUP_G1)
          pg8::gemm_phase<EpiSwiGLU, pg8::StaticOrder, true, true>(lds, g, S, E);
#endif
        }
        GSYNC(); STAMP();
        { pg8::Gemm g{HID, (const bf16_t*)(ws + WS_W2 + (size_t)(l * 2 + 0) * W2_SZ), MTOK, DM, DFF}; pg8::StaticOrder S; S.init(MTOK, DM, G, bx);
          if (l == 0) { EpiResidT<true, false> E{xin, XB, 0.5f}; pg8::gemm_phase<EpiResidT<true, false>, pg8::StaticOrder, true, true>(lds, g, S, E); }
          else { EpiResidT<false, false> E{XB, XB, 0.5f}; pg8::gemm_phase<EpiResidT<false, false>, pg8::StaticOrder, true, true>(lds, g, S, E); } }
        GSYNC(); STAMP();
#if defined(STOP_AFTER) && STOP_AFTER == 1
        return;
#endif
        rmsnorm_phase<true, false>(XB, INP(6) + l * DM, XN);
        GSYNC(); STAMP();
        { pg8::Gemm g{XN, (const bf16_t*)(ws + WS_WIN + (size_t)l * WIN_SZ), MTOK, 5120, DM}; pg8::StaticOrder S; S.init(MTOK, 5120, G, bx);
          EpiZ E{ws, INP(14) + l * 64, INP(15) + l * 64, INP(21) + l * 64, INP(22) + l * 192}; pg8::gemm_phase<EpiZ, pg8::StaticOrder, true, true>(lds, g, S, E);
#if defined(DUP_G3)
          pg8::gemm_phase<EpiZ, pg8::StaticOrder, true, true>(lds, g, S, E);
#endif
        }
        GSYNC(); STAMP();
#if defined(DUMP_Z)
        { const unsigned short* z = (const unsigned short*)(WSP + WS_Z); float* o = OUTP;
          for (size_t i = (size_t)blockIdx.x * NTHR + threadIdx.x; i < (size_t)MTOK * DM; i += (size_t)gridDim.x * NTHR) {
              unsigned v = (unsigned)z[i * 4 + (i & 3)] << 16; if ((v & 0x7f800000u) == 0x7f800000u) v = 0u; o[i] = __builtin_bit_cast(float, v); }
          return; }
#endif
        compress_phase(P, l, lds);
#if defined(DUP_CMP)
        for (int rep_ = 0; rep_ < 4; ++rep_) compress_phase(P, l, lds);
#endif
        GSYNC(); STAMP();
        attention_phase(P, l, lds);
#if defined(DUP_ATT)
        attention_phase(P, l, lds);
#endif
        GSYNC(); STAMP();
        { pg8::Gemm g{XN, (const bf16_t*)(ws + WS_PAB + (size_t)l * PAB_SZ), MTOK, 2048, DM}; pg8::StaticOrder S; S.init(MTOK, 2048, G, bx);
          EpiMerge E{(const bf16_t*)(ws + Z_MG), MERGED}; pg8::gemm_phase<EpiMerge, pg8::StaticOrder, true, true>(lds, g, S, E); }
        GSYNC(); STAMP();
        { pg8::Gemm g{MERGED, (const bf16_t*)(ws + WS_WO + (size_t)l * WO_SZ), MTOK, DM, DM}; pg8::StaticOrder S; S.init(MTOK, DM, G, bx);
          EpiResidT<false, false> E{XB, XB, 1.0f}; pg8::gemm_phase<EpiResidT<false, false>, pg8::StaticOrder, true, true>(lds, g, S, E); }
        GSYNC(); STAMP();
#if defined(STOP_AFTER) && STOP_AFTER == 2
        return;
#endif
        if (l + 1 < DEPTH) rmsnorm_phase<true, false>(XB, INP(7) + l * DM, XN);
        else rmsnorm_phase<true, true>(XB, INP(7) + l * DM, XN, XRAW);
        GSYNC(); STAMP();
        { pg8::Gemm g{XN, (const bf16_t*)(ws + WS_W13 + (size_t)(l * 2 + 1) * W13_SZ), MTOK, 5632, DM}; pg8::StaticOrder S; S.init(MTOK, 5632, G, bx);
          EpiSwiGLU E{HID}; pg8::gemm_phase<EpiSwiGLU, pg8::StaticOrder, true, true>(lds, g, S, E); }
        GSYNC(); STAMP();
        { pg8::Gemm g{HID, (const bf16_t*)(ws + WS_W2 + (size_t)(l * 2 + 1) * W2_SZ), MTOK, DM, DFF}; pg8::StaticOrder S; S.init(MTOK, DM, G, bx);
          if (l + 1 < DEPTH) { EpiResidT<false, false> E{XB, XB, 0.5f}; pg8::gemm_phase<EpiResidT<false, false>, pg8::StaticOrder, true, true>(lds, g, S, E); }
          else { EpiResidT<false, true> E{XRAW, OUTP, 0.5f}; pg8::gemm_phase<EpiResidT<false, true>, pg8::StaticOrder, true, true>(lds, g, S, E); } }
        if (l + 1 < DEPTH) { GSYNC(); STAMP(); }
    }
#if defined(PROBE_PHASE)
    GSYNC(); STAMP();
    if (blockIdx.x == 0 && threadIdx.x == 0) { const LAS unsigned long long* t = (const LAS unsigned long long*)(lds + L_PTAB + 512); const float ns = (float)(t[PROBE_PHASE + 1] - t[PROBE_PHASE]) * 10.0f; OUTP[0] = exp2f(rintf(log2f(ns) * 4.f) * 0.25f); }
#endif
#undef ws
#undef XN
#undef HID
#undef MERGED
#undef XB
#undef XRAW
}

extern "C" void kernel_launch(void* const* d_in, const int* in_sizes, int n_in, void* d_out, int out_size, void* d_ws, size_t ws_size, hipStream_t stream) {
    static int grid = 0;
    if (grid == 0) {
        if (n_in != 30 || out_size != MTOK * DM || ws_size < WS_END) { fprintf(stderr, "kernel_launch: unexpected problem (n_in %d out %d ws %zu, need %zu)\n", n_in, out_size, ws_size, (size_t)WS_END); grid = -1; return; }
        int dev = 0, cus = 0, per_cu = 0;
        (void)hipGetDevice(&dev);
        (void)hipDeviceGetAttribute(&cus, hipDeviceAttributeMultiprocessorCount, dev);
        if (hipFuncSetAttribute((const void*)hybrid_fwd, hipFuncAttributeMaxDynamicSharedMemorySize, LDS_BYTES) != hipSuccess) { fprintf(stderr, "kernel_launch: hipFuncSetAttribute failed\n"); grid = -1; return; }
        if (hipOccupancyMaxActiveBlocksPerMultiprocessor(&per_cu, (const void*)hybrid_fwd, NTHR, LDS_BYTES) != hipSuccess || per_cu < 1) { fprintf(stderr, "kernel_launch: occupancy query gave %d\n", per_cu); per_cu = 1; }
        (void)hipGetLastError();
        grid = cus * (per_cu > 1 ? 1 : per_cu);
        if (grid <= 0) grid = 256;
    }
    if (grid < 0) return;
    Params p{};
    for (int i = 0; i < 30; ++i) p.in[i] = (const float*)d_in[i];
    p.out = (float*)d_out; p.ws = (unsigned char*)d_ws;
    (void)hipMemsetAsync((unsigned char*)d_ws + WS_BAR, 0, 16384, stream);
    void* args[] = {&p};
    hipError_t e = hipLaunchCooperativeKernel((const void*)hybrid_fwd, dim3(grid), dim3(NTHR), args, LDS_BYTES, stream);
    if (e != hipSuccess) fprintf(stderr, "cooperative launch failed: %s (grid %d)\n", hipGetErrorString(e), grid);
}
```

```cpp
#include <hip/hip_runtime.h>
#include <hip/hip_cooperative_groups.h>
#include <cstdio>
#include <cstdint>
namespace cg = cooperative_groups;
namespace pg8 {
#define PG8_LAS __attribute__((address_space(3)))
typedef unsigned short bf16_t;
typedef short bf16x8 __attribute__((ext_vector_type(8)));
typedef float f32x4 __attribute__((ext_vector_type(4)));
typedef unsigned u32x4 __attribute__((ext_vector_type(4)));
constexpr int BM = 256, BK = 64, HALF = 128, HTB = HALF * BK * 2  , STAGE_BYTES = 8 * HTB, NXCD = 8, WGM = 8;

__host__ __device__ __forceinline__ int lds_byte(int r, int c) { const int st = (r >> 4) * 2 + (c >> 5), rr = r & 15, cc = c & 31, ob = rr * 64 + cc * 2; return st * 1024 + (ob ^ (((ob >> 9) & 1) << 5)); }
__host__ __device__ __forceinline__ void stage_rc(int b, int& R, int& C) { const int st = b / 1024, sb = b % 1024, swz = sb ^ (((sb >> 9) & 1) << 5); R = (st >> 1) * 16 + swz / 64; C = (st & 1) * 32 + (swz % 64) / 2; }
__host__ __device__ __forceinline__ int perm32(int rho) { const int n = rho >> 4, i = rho & 15; return 8 * (i >> 2) + 4 * n + (i & 3); }

struct Unit { int pm, pn; };
struct Gemm { const bf16_t* A; const bf16_t* Bt; int M, N, K; };

struct StaticOrder {
    int nM, nN, nwg, G, c;
    __host__ __device__ void init(int M, int N, int G_, int c_) { nM = M / BM; nN = N / BM; nwg = nM * nN; G = G_; c = c_; }
    __host__ __device__ bool next(int i, Unit& u) const {
        const long L = (long)i * G + c; if (L >= nwg) return false;
        int wgid = (int)L; { const int q = nwg / NXCD, r = nwg % NXCD, xcd = wgid % NXCD, off = wgid / NXCD; wgid = (xcd < r ? xcd * (q + 1) : r * (q + 1) + (xcd - r) * q) + off; }
        const int nig = WGM * nN, gid = wgid / nig, fm = gid * WGM, gsz = (nM - fm) < WGM ? (nM - fm) : WGM;
        u.pm = fm + ((wgid % nig) % gsz); u.pn = (wgid % nig) / gsz; return true;
    }
    __device__ __forceinline__ void a_ready(const Unit&) const {}
    __device__ __forceinline__ void done(const Unit&) const {}
};

typedef float f32x2_t __attribute__((ext_vector_type(2))); typedef __bf16 bf16x2_t __attribute__((ext_vector_type(2)));
__device__ __forceinline__ unsigned cvt_pk_bf16(float lo, float hi) { f32x2_t v = {lo, hi}; bf16x2_t b = __builtin_convertvector(v, bf16x2_t); return __builtin_bit_cast(unsigned, b); }
template <class Epi, class Sched, bool ALIGN_EPI = false, bool SP2 = false>
__device__ __forceinline__ void gemm_phase(PG8_LAS unsigned char* lds, const Gemm g, const Sched& S, const Epi& E) {
    int tid_ = threadIdx.x; asm volatile("" : "+v"(tid_)); const int tid = tid_, wid = __builtin_amdgcn_readfirstlane(tid >> 6), lane = tid & 63, wr = wid >> 2, wc = wid & 3, fr = lane & 15, fq = lane >> 4;
    const int K = g.K, nt = K / BK;
    unsigned voffA[2], voffB[2];
#pragma unroll
    for (int i = 0; i < 2; ++i) { int R, C; stage_rc(tid * 16 + i * 8192, R, C); const int Rb = Epi::PERM ? ((R & ~31) + perm32(R & 31)) : R;
        voffA[i] = (unsigned)(R * K + C) * 2u; voffB[i] = (unsigned)(Rb * K + C) * 2u; }
    const size_t kstep = (size_t)(BK * 2);
    const size_t hstep = (size_t)HALF * K * 2;
    const size_t tstep = 2 * hstep;
    const unsigned ldsw = (unsigned)wid * 1024u;
    const int aoff = lds_byte(wr * 64 + fr, fq * 8), boff = lds_byte(wc * 32 + fr, fq * 8);
#define PG8_SA(b, h) (((b) * 2 + (h)) * HTB)
#define PG8_SB(b, h) ((4 + (b) * 2 + (h)) * HTB)
#define PG8_STAGE(bufoff, gbase, voff) do { _Pragma("unroll") for (int _i = 0; _i < 2; ++_i) \
        __builtin_amdgcn_global_load_lds((const unsigned*)((const char*)(gbase) + (voff)[_i]), (PG8_LAS unsigned*)(lds + (bufoff) + ldsw + _i * 8192), 16, 0, 0); } while (0)
#define PG8_LDA(dst, b, h) do { _Pragma("unroll") for (int m = 0; m < 4; ++m) _Pragma("unroll") for (int k = 0; k < 2; ++k) dst[m][k] = *(const PG8_LAS bf16x8*)(lds + PG8_SA(b, h) + aoff + m * 2048 + k * 1024); } while (0)
#define PG8_LDB(dst, b, h) do { _Pragma("unroll") for (int n = 0; n < 2; ++n) _Pragma("unroll") for (int k = 0; k < 2; ++k) dst[n][k] = *(const PG8_LAS bf16x8*)(lds + PG8_SB(b, h) + boff + n * 2048 + k * 1024); } while (0)
#define PG8_MMA(ai, bj, At, Bt) do { __builtin_amdgcn_s_setprio(1); _Pragma("unroll") for (int m = 0; m < 4; ++m) _Pragma("unroll") for (int n = 0; n < 2; ++n) _Pragma("unroll") for (int k = 0; k < 2; ++k) \
        acc[ai][bj][m][n] = __builtin_amdgcn_mfma_f32_16x16x32_bf16(Bt[n][k], At[m][k], acc[ai][bj][m][n], 0, 0, 0); __builtin_amdgcn_s_setprio(0); } while (0)
#define PG8_WAIT_V(n) asm volatile("s_waitcnt vmcnt(" #n ")" ::: "memory")
#define PG8_WAIT_L(n) asm volatile("s_waitcnt lgkmcnt(" #n ")" ::: "memory")
#define PG8_BAR __builtin_amdgcn_s_barrier()
#define PG8_SCHED __builtin_amdgcn_sched_barrier(0)
    Unit cur, nxt; int ui = 0;
    if (!S.next(0, cur)) return;
    f32x4 acc[2][2][4][2];
#pragma unroll
    for (int a = 0; a < 2; ++a)
#pragma unroll
        for (int b = 0; b < 2; ++b)
#pragma unroll
            for (int m = 0; m < 4; ++m)
#pragma unroll
                for (int n = 0; n < 2; ++n) acc[a][b][m][n] = (f32x4){0.f, 0.f, 0.f, 0.f};
    bf16x8 At[4][2], B0[2][2], B1[2][2];
    const char* cA = (const char*)g.A + (size_t)cur.pm * tstep; const char* cB = (const char*)g.Bt + (size_t)cur.pn * tstep;
    S.a_ready(cur);
    if constexpr (Epi::ROWSCALE) { f32x4 pa_, pb_; E.rs_issue(cur, tid, pa_, pb_); E.rs_write(tid, pa_, pb_, (PG8_LAS float*)(lds + STAGE_BYTES)); }
    if constexpr (SP2) {
        PG8_STAGE(PG8_SB(0, 0), cB, voffB); PG8_STAGE(PG8_SB(0, 1), cB + hstep, voffB); PG8_STAGE(PG8_SA(0, 0), cA, voffA); PG8_STAGE(PG8_SA(0, 1), cA + hstep, voffA);
        if (wr == 1) PG8_BAR;
        PG8_WAIT_V(2); PG8_BAR;
        PG8_STAGE(PG8_SB(1, 0), cB + kstep, voffB); PG8_STAGE(PG8_SA(1, 0), cA + kstep, voffA); PG8_STAGE(PG8_SB(1, 1), cB + hstep + kstep, voffB);
        PG8_WAIT_V(6); PG8_BAR;
    } else {
        PG8_STAGE(PG8_SB(0, 0), cB, voffB); PG8_STAGE(PG8_SA(0, 0), cA, voffA); PG8_STAGE(PG8_SB(0, 1), cB + hstep, voffB); PG8_STAGE(PG8_SA(0, 1), cA + hstep, voffA);
        if (wr == 1) PG8_BAR;
        PG8_WAIT_V(4); PG8_BAR;
        PG8_STAGE(PG8_SB(1, 0), cB + kstep, voffB); PG8_STAGE(PG8_SA(1, 0), cA + kstep, voffA); PG8_STAGE(PG8_SB(1, 1), cB + hstep + kstep, voffB);
        PG8_WAIT_V(6); PG8_BAR;
    }
    for (;;) {
        const bool has_next = S.next(ui + 1, nxt);
        const char* nA = has_next ? (const char*)g.A + (size_t)nxt.pm * tstep : cA; const char* nB = has_next ? (const char*)g.Bt + (size_t)nxt.pn * tstep : cB;
        for (int t = 0; t < nt; t += 2) {
            const bool last = (t == nt - 2);
            const char* a1 = cA + (size_t)(t + 1) * kstep;
            const char* a2 = last ? nA : cA + (size_t)(t + 2) * kstep; const char* b2 = last ? nB : cB + (size_t)(t + 2) * kstep;
            const char* a3 = a2 + kstep; const char* b3 = b2 + kstep;
            if (last && has_next) S.a_ready(nxt);
            if constexpr (SP2) {
            PG8_LDB(B0, 0, 0); PG8_LDB(B1, 0, 1); PG8_SCHED; PG8_LDA(At, 0, 0); PG8_STAGE(PG8_SA(1, 1), a1 + hstep, voffA);
            PG8_WAIT_V(8); PG8_WAIT_L(0); PG8_BAR; PG8_MMA(0, 0, At, B0); PG8_MMA(0, 1, At, B1); PG8_BAR; PG8_SCHED;
            PG8_LDA(At, 0, 1); PG8_STAGE(PG8_SB(0, 0), b2, voffB); PG8_STAGE(PG8_SB(0, 1), b2 + hstep, voffB); PG8_STAGE(PG8_SA(0, 0), a2, voffA);
            PG8_WAIT_V(8); PG8_WAIT_L(0); PG8_BAR; PG8_MMA(1, 0, At, B0); PG8_MMA(1, 1, At, B1); PG8_BAR; PG8_SCHED;
            PG8_LDB(B0, 1, 0); PG8_LDB(B1, 1, 1); PG8_SCHED; PG8_LDA(At, 1, 0); PG8_STAGE(PG8_SA(0, 1), a2 + hstep, voffA);
            PG8_WAIT_V(8); PG8_WAIT_L(0); PG8_BAR; PG8_MMA(0, 0, At, B0); PG8_MMA(0, 1, At, B1); PG8_BAR; PG8_SCHED;
            PG8_LDA(At, 1, 1); PG8_STAGE(PG8_SB(1, 0), b3, voffB); PG8_STAGE(PG8_SB(1, 1), b3 + hstep, voffB); PG8_STAGE(PG8_SA(1, 0), a3, voffA);
            PG8_WAIT_V(8); PG8_WAIT_L(0); PG8_BAR; PG8_MMA(1, 0, At, B0); PG8_MMA(1, 1, At, B1); PG8_BAR; PG8_SCHED;
            } else {
            PG8_LDB(B0, 0, 0); PG8_SCHED; PG8_LDA(At, 0, 0); PG8_STAGE(PG8_SA(1, 1), a1 + hstep, voffA);
            PG8_WAIT_L(8); PG8_BAR; PG8_WAIT_L(0); PG8_MMA(0, 0, At, B0); PG8_BAR; PG8_SCHED;
            PG8_LDB(B1, 0, 1); PG8_STAGE(PG8_SB(0, 0), b2, voffB);
            PG8_BAR; PG8_WAIT_L(0); PG8_MMA(0, 1, At, B1); PG8_BAR;
            PG8_LDA(At, 0, 1); PG8_STAGE(PG8_SA(0, 0), a2, voffA);
            PG8_BAR; PG8_WAIT_L(0); PG8_MMA(1, 0, At, B0); PG8_BAR; PG8_SCHED;
            PG8_STAGE(PG8_SB(0, 1), b2 + hstep, voffB);
            PG8_WAIT_V(6); PG8_BAR; PG8_MMA(1, 1, At, B1); PG8_BAR;
            PG8_LDB(B0, 1, 0); PG8_SCHED; PG8_LDA(At, 1, 0); PG8_STAGE(PG8_SA(0, 1), a2 + hstep, voffA);
            PG8_WAIT_L(8); PG8_BAR; PG8_WAIT_L(0); PG8_MMA(0, 0, At, B0); PG8_BAR; PG8_SCHED;
            PG8_LDB(B1, 1, 1); PG8_STAGE(PG8_SB(1, 0), b3, voffB);
            PG8_BAR; PG8_WAIT_L(0); PG8_MMA(0, 1, At, B1); PG8_BAR;
            PG8_LDA(At, 1, 1); PG8_STAGE(PG8_SA(1, 0), a3, voffA);
            PG8_BAR; PG8_WAIT_L(0); PG8_MMA(1, 0, At, B0); PG8_BAR; PG8_SCHED;
            PG8_STAGE(PG8_SB(1, 1), b3 + hstep, voffB);
            PG8_WAIT_V(6); PG8_BAR; PG8_MMA(1, 1, At, B1); PG8_BAR;
            }
        }
        if constexpr (ALIGN_EPI) { if (wr == 0) PG8_BAR; }
        if constexpr (!Epi::AFTER_DRAIN) {
            if constexpr (Epi::ROWSCALE) {
                f32x4 pa_ = {0.f, 0.f, 0.f, 0.f}, pb_ = {0.f, 0.f, 0.f, 0.f};
                if (has_next) E.rs_issue(nxt, tid, pa_, pb_);
                E(acc, cur, wr, wc, fr, fq, (const PG8_LAS float*)(lds + STAGE_BYTES + (ui & 1) * 1024));
                if (has_next) E.rs_write(tid, pa_, pb_, (PG8_LAS float*)(lds + STAGE_BYTES + ((ui + 1) & 1) * 1024));
            } else E(acc, cur, wr, wc, fr, fq);
            S.done(cur); }
        if (!has_next) break;
#pragma unroll
        for (int a = 0; a < 2; ++a)
#pragma unroll
            for (int b = 0; b < 2; ++b)
#pragma unroll
                for (int m = 0; m < 4; ++m)
#pragma unroll
                    for (int n = 0; n < 2; ++n) acc[a][b][m][n] = (f32x4){0.f, 0.f, 0.f, 0.f};
        cur = nxt; cA = nA; cB = nB; ++ui;
        if constexpr (ALIGN_EPI) { if (wr == 1) PG8_BAR; }
    }
    PG8_WAIT_V(0);
    if constexpr (!ALIGN_EPI) { if (wr == 0) PG8_BAR; }
    PG8_BAR;
    if constexpr (Epi::AFTER_DRAIN) { E.fused(acc, cur, wr, wc, fr, fq, lds, wid, lane); S.done(cur); }
#undef PG8_SA
#undef PG8_SB
#undef PG8_STAGE
#undef PG8_LDA
#undef PG8_LDB
#undef PG8_MMA
#undef PG8_WAIT_V
#undef PG8_WAIT_L
#undef PG8_BAR
#undef PG8_SCHED
}
}

#define LAS __attribute__((address_space(3)))
#define GAS __attribute__((address_space(1)))
#define GLD(T, p) (*(const GAS T*)(p))
#define GST(T, p, v) (*(GAS T*)(p) = (v))
typedef unsigned short bf16_t;
typedef short bf16x8 __attribute__((ext_vector_type(8)));
typedef short bf16x4 __attribute__((ext_vector_type(4)));
typedef float f32x4 __attribute__((ext_vector_type(4)));
typedef float f32x16 __attribute__((ext_vector_type(16)));
typedef unsigned u32x4 __attribute__((ext_vector_type(4)));
typedef unsigned u32x2 __attribute__((ext_vector_type(2)));

constexpr int BATCH = 8, SEQ = 4096, DM = 1024, MTOK = BATCH * SEQ, DFF = 2816, DEPTH = 2, NIN = 4888;
constexpr int NTHR = 512, NWAVE = 8;
constexpr float EPS = 1e-6f, LOG2E = 1.4426950408889634f;
constexpr float QSCALE = 0.125f * LOG2E;
constexpr size_t MiB = 1u << 20;
constexpr size_t WS_BIAS = 0;
constexpr size_t WS_PRM = 64 * 1024;
constexpr size_t WS_CB1 = 68 * 1024;
constexpr size_t WS_W13 = 1 * MiB;
constexpr size_t W13_SZ = (size_t)5632 * 1024 * 2;
constexpr size_t WS_W2 = 45 * MiB;
constexpr size_t W2_SZ = (size_t)1024 * 2816 * 2;
constexpr size_t WS_WIN = 68 * MiB;
constexpr size_t WIN_SZ = (size_t)5120 * 1024 * 2;
constexpr size_t WS_PAB = 88 * MiB;
constexpr size_t PAB_SZ = (size_t)2048 * 1024 * 2;
constexpr size_t WS_WO = 96 * MiB;
constexpr size_t WO_SZ = (size_t)1024 * 1024 * 2;
constexpr size_t WS_CW1 = 100 * MiB;
constexpr size_t CW1_SZ = (size_t)128 * 2048 * 2;
constexpr size_t WS_CW2 = 102 * MiB;
constexpr size_t CW2_SZ = (size_t)64 * 128 * 2;
constexpr size_t WS_KCN = 103 * MiB;
constexpr size_t WS_VCT = WS_KCN + 512 * 1024;
constexpr size_t WS_XN = 104 * MiB;
constexpr size_t WS_Z = 168 * MiB;
constexpr size_t Z_DQ = WS_Z, Z_DK = WS_Z + 32 * MiB, Z_DVT = WS_Z + 64 * MiB, Z_NQ = WS_Z + 96 * MiB;
constexpr size_t Z_KCR = WS_Z + 128 * MiB, Z_VCR = WS_Z + 136 * MiB, Z_KSEL = WS_Z + 144 * MiB, Z_VSELT = WS_Z + 152 * MiB;
constexpr size_t Z_KWIN = WS_Z + 160 * MiB, Z_VWINT = WS_Z + 168 * MiB, Z_NG = WS_Z + 176 * MiB, Z_MG = WS_Z + 180 * MiB;
constexpr size_t WS_MERGED = WS_Z;
constexpr size_t WS_HID = WS_Z;
constexpr size_t WS_SS = WS_Z + 308 * MiB;
constexpr size_t WS_END = WS_SS + 2 * MiB;
constexpr int LDS_BYTES = 147456;
constexpr int KP = 144, VP = 136;
constexpr int DA_STAGE = 2 * 64 * KP + 128 * VP;
constexpr int NS_STAGE = 64 * KP + 64 * VP;
constexpr int L_BIAS = 73728;
constexpr int TBN = 1216;
constexpr int L_IMP = L_BIAS + 4 * TBN * 4;
constexpr int L_SEL = L_IMP + 16384;
constexpr int L_WSF = L_SEL + 1024;
constexpr int L_END = L_WSF + 8 * 256;

struct Params {
    const float* in[30];
    float* out;
    unsigned char* ws;
};

constexpr int L_PTAB = LDS_BYTES - 1024;
__device__ __forceinline__ const float* ld_ptr(const LAS unsigned char* lds, int i) {
    unsigned a = L_PTAB + 8 * i; asm volatile("" : "+v"(a));
    const LAS unsigned* t = (const LAS unsigned*)(lds + a);
    const unsigned lo = __builtin_amdgcn_readfirstlane(t[0]), hi = __builtin_amdgcn_readfirstlane(t[1]);
    return (const float*)(((unsigned long long)hi << 32) | lo);
}
#define INP(i) ld_ptr(lds, (i))
#define OUTP ((float*)ld_ptr(lds, 30))
#define WSP ((unsigned char*)ld_ptr(lds, 31))

__device__ __forceinline__ unsigned f2bf(float f) { unsigned u = __builtin_bit_cast(unsigned, f); return (u + 0x7fffu + ((u >> 16) & 1u)) >> 16; }
__device__ __forceinline__ unsigned pk2(float lo, float hi) { return f2bf(lo) | (f2bf(hi) << 16); }
__device__ __forceinline__ float sigmoidf_(float x) { return __builtin_amdgcn_rcpf(1.0f + __builtin_amdgcn_exp2f(-x * LOG2E)); }
__device__ __forceinline__ int otid() { int t = threadIdx.x; asm volatile("" : "+v"(t)); return t; }
__device__ __forceinline__ int crow(int r, int hi) { return (r & 3) + 8 * (r >> 2) + 4 * hi; }


struct RowScale {
    const float* ss;
    __device__ __forceinline__ void rs_issue(const pg8::Unit& u, int tid, f32x4& pa, f32x4& pb) const {
        const float* p = ss + (size_t)(u.pm * 256 + (tid >> 1)) * 16 + (tid & 1) * 8; pa = GLD(f32x4, p); pb = GLD(f32x4, p + 4); }
    __device__ __forceinline__ void rs_write(int tid, const f32x4& pa, const f32x4& pb, LAS float* tab) const {
        float t = ((pa.x + pa.y) + (pa.z + pa.w)) + ((pb.x + pb.y) + (pb.z + pb.w)); t += __shfl_xor(t, 1);
        if (!(tid & 1)) tab[tid >> 1] = __builtin_amdgcn_rsqf(t * (1.f / DM) + EPS); }
};
struct EpiSwiGLU : RowScale {
    static constexpr bool PERM = true, AFTER_DRAIN = false, ROWSCALE = true;
    bf16_t* H;
    __device__ __forceinline__ void operator()(const f32x4 (&acc)[2][2][4][2], const pg8::Unit& u, int wr, int wc, int fr, int fq, const LAS float* rst) const {
        const int row0 = u.pm * 256 + wr * 64 + fr, col = u.pn * 128 + wc * 32 + 8 * fq;
#pragma unroll
        for (int ai = 0; ai < 2; ++ai)
#pragma unroll
            for (int m = 0; m < 4; ++m) {
                float h[8];
                const float rs = rst[ai * 128 + wr * 64 + m * 16 + fr];
#pragma unroll
                for (int n = 0; n < 2; ++n)
#pragma unroll
                    for (int e = 0; e < 4; ++e) { const float g = acc[ai][0][m][n][e] * rs, up = acc[ai][1][m][n][e] * rs; h[n * 4 + e] = g * sigmoidf_(g) * up; }
                u32x4 w; w.x = pg8::cvt_pk_bf16(h[0], h[1]); w.y = pg8::cvt_pk_bf16(h[2], h[3]); w.z = pg8::cvt_pk_bf16(h[4], h[5]); w.w = pg8::cvt_pk_bf16(h[6], h[7]);
                GST(u32x4, H + (size_t)(row0 + ai * 128 + m * 16) * DFF + col, w);
            }
    }
};
template <bool BF32, bool OF32> struct EpiResidT {
    static constexpr bool PERM = false, AFTER_DRAIN = false, ROWSCALE = false;
    const void* base; void* out; float alpha; float* ss;
    __device__ __forceinline__ void operator()(const f32x4 (&acc)[2][2][4][2], const pg8::Unit& u, int wr, int wc, int fr, int fq) const {
        const int row0 = u.pm * 256 + wr * 64 + fr, col0 = u.pn * 256 + wc * 32 + 4 * fq;
#pragma unroll
        for (int ai = 0; ai < 2; ++ai) {
            f32x4 bv[4][2][2];
#pragma unroll
            for (int m = 0; m < 4; ++m) {
                const size_t off = (size_t)(row0 + ai * 128 + m * 16) * DM + col0;
#pragma unroll
                for (int bj = 0; bj < 2; ++bj)
#pragma unroll
                    for (int n = 0; n < 2; ++n) {
                        if (BF32) bv[m][bj][n] = GLD(f32x4, (const float*)base + off + bj * 128 + n * 16);
                        else { const u32x2 w = GLD(u32x2, (const bf16_t*)base + off + bj * 128 + n * 16);
                               bv[m][bj][n] = (f32x4){__builtin_bit_cast(float, w.x << 16), __builtin_bit_cast(float, w.x & 0xffff0000u), __builtin_bit_cast(float, w.y << 16), __builtin_bit_cast(float, w.y & 0xffff0000u)}; }
                    }
            }
#pragma unroll
            for (int m = 0; m < 4; ++m) {
                const int row = row0 + ai * 128 + m * 16;
                const size_t off = (size_t)row * DM + col0;
                float sq = 0.f;
#pragma unroll
                for (int bj = 0; bj < 2; ++bj)
#pragma unroll
                    for (int n = 0; n < 2; ++n) {
                        const f32x4 o = bv[m][bj][n] + acc[ai][bj][m][n] * alpha;
                        sq += (o.x * o.x + o.y * o.y) + (o.z * o.z + o.w * o.w);
                        if (OF32) GST(f32x4, (float*)out + off + bj * 128 + n * 16, o);
                        else { u32x2 w; w.x = pg8::cvt_pk_bf16(o.x, o.y); w.y = pg8::cvt_pk_bf16(o.z, o.w); GST(u32x2, (bf16_t*)out + off + bj * 128 + n * 16, w); }
                    }
                if (!OF32) { sq += __shfl_xor(sq, 16); sq += __shfl_xor(sq, 32); if (fq == 0) GST(float, ss + (size_t)row * 16 + u.pn * 4 + wc, sq); }
            }
        }
    }
};
struct EpiMerge {
    static constexpr bool PERM = true, AFTER_DRAIN = false, ROWSCALE = false;
    const bf16_t* MG; bf16_t* O;
    __device__ __forceinline__ void operator()(const f32x4 (&acc)[2][2][4][2], const pg8::Unit& u, int wr, int wc, int fr, int fq) const {
        const int row0 = u.pm * 256 + wr * 64 + fr, col = u.pn * 128 + wc * 32 + 8 * fq;
#pragma unroll
        for (int ai = 0; ai < 2; ++ai) {
            u32x4 g0[4], g1[4];
#pragma unroll
            for (int m = 0; m < 4; ++m) { const int row = row0 + ai * 128 + m * 16; g0[m] = GLD(u32x4, MG + (size_t)row * 2048 + col); g1[m] = GLD(u32x4, MG + (size_t)row * 2048 + 1024 + col); }
#pragma unroll
            for (int m = 0; m < 4; ++m) {
                const int row = row0 + ai * 128 + m * 16;
                float h[8];
#pragma unroll
                for (int i = 0; i < 8; ++i) {
                    const unsigned w0 = g0[m][i >> 1], w1 = g1[m][i >> 1];
                    const float a0 = __builtin_bit_cast(float, (i & 1) ? (w0 & 0xffff0000u) : (w0 << 16)), a1 = __builtin_bit_cast(float, (i & 1) ? (w1 & 0xffff0000u) : (w1 << 16));
                    h[i] = a0 * acc[ai][0][m][i >> 2][i & 3] + a1 * acc[ai][1][m][i >> 2][i & 3];
                }
                u32x4 w; w.x = pg8::cvt_pk_bf16(h[0], h[1]); w.y = pg8::cvt_pk_bf16(h[2], h[3]); w.z = pg8::cvt_pk_bf16(h[4], h[5]); w.w = pg8::cvt_pk_bf16(h[6], h[7]);
                GST(u32x4, O + (size_t)row * DM + col, w);
            }
        }
    }
};
struct EpiZ : RowScale {
    static constexpr bool PERM = true, AFTER_DRAIN = false, ROWSCALE = true;
    unsigned char* ws; const float *gq, *gk, *gnq, *gnk;
    __device__ __forceinline__ void operator()(const f32x4 (&acc)[2][2][4][2], const pg8::Unit& u, int wr, int wc, int fr, int fq, const LAS float* rst) const {
        const int ch = 4 * u.pn + wc;
        if (ch >= 77) return;
        const int row0 = u.pm * 256 + wr * 64 + fr;
        int kind, nh = 8, hd = 0, nd = 64, dbase = 0; size_t dst = 0; const float* gain = nullptr; float scale = 1.f;
        if (ch < 8) { kind = 0; dst = Z_DQ; hd = ch; gain = gq; scale = QSCALE; }
        else if (ch < 16) { kind = 0; dst = Z_DK; hd = ch - 8; gain = gk; }
        else if (ch < 24) { kind = 2; dst = Z_DVT; nh = 4; hd = (ch - 16) >> 1; nd = 128; dbase = ((ch - 16) & 1) * 64; }
        else if (ch < 32) { kind = 0; dst = Z_NQ; hd = ch - 24; gain = gnq; scale = QSCALE; }
        else if (ch < 34) { kind = 1; dst = Z_KCR; nh = 2; hd = ch - 32; }
        else if (ch < 36) { kind = 1; dst = Z_VCR; nh = 2; hd = ch - 34; }
        else if (ch < 38) { kind = 0; dst = Z_KSEL; nh = 2; hd = ch - 36; gain = gnk + 64; }
        else if (ch < 40) { kind = 2; dst = Z_VSELT; nh = 2; hd = ch - 38; }
        else if (ch < 42) { kind = 0; dst = Z_KWIN; nh = 2; hd = ch - 40; gain = gnk + 128; }
        else if (ch < 44) { kind = 2; dst = Z_VWINT; nh = 2; hd = ch - 42; }
        else if (ch < 76) { kind = 3; }
        else { kind = 4; }
        if (kind == 0 || kind == 1) {
            float gv[16];
#pragma unroll
            for (int i = 0; i < 16; ++i) gv[i] = (kind == 0) ? gain[(i >> 3) * 32 + 8 * fq + (i & 7)] * scale : 1.f;
#pragma unroll
            for (int ai = 0; ai < 2; ++ai)
#pragma unroll
                for (int m = 0; m < 4; ++m) {
                    const int row = row0 + ai * 128 + m * 16, b = row >> 12, s = row & 4095;
                    float v[16];
                    const float rrs = rst[ai * 128 + wr * 64 + m * 16 + fr];
#pragma unroll
                    for (int i = 0; i < 16; ++i) v[i] = acc[ai][i >> 3][m][(i >> 2) & 1][i & 3] * rrs;
                    float rs = 1.f;
                    if (kind == 0) {
                        float ss = 0.f;
#pragma unroll
                        for (int i = 0; i < 16; ++i) ss += v[i] * v[i];
                        ss += __shfl_xor(ss, 16); ss += __shfl_xor(ss, 32);
                        rs = __builtin_amdgcn_rsqf(ss * (1.f / 64.f) + EPS);
                    }
#pragma unroll
                    for (int i = 0; i < 16; ++i) v[i] *= rs * gv[i];
                    bf16_t* d = (bf16_t*)(ws + dst) + ((size_t)(b * nh + hd) * SEQ + s) * 64 + 8 * fq;
                    u32x4 w0, w1;
                    w0.x = pg8::cvt_pk_bf16(v[0], v[1]); w0.y = pg8::cvt_pk_bf16(v[2], v[3]); w0.z = pg8::cvt_pk_bf16(v[4], v[5]); w0.w = pg8::cvt_pk_bf16(v[6], v[7]);
                    w1.x = pg8::cvt_pk_bf16(v[8], v[9]); w1.y = pg8::cvt_pk_bf16(v[10], v[11]); w1.z = pg8::cvt_pk_bf16(v[12], v[13]); w1.w = pg8::cvt_pk_bf16(v[14], v[15]);
                    GST(u32x4, d, w0); GST(u32x4, d + 32, w1);
                }
        } else if (kind == 2) {
#pragma unroll
            for (int ai = 0; ai < 2; ++ai)
#pragma unroll
                for (int m = 0; m < 4; ++m) {
                    const int row = row0 + ai * 128 + m * 16, b = row >> 12, s = row & 4095;
                    bf16_t* d = (bf16_t*)(ws + dst) + ((size_t)(b * nh + hd) * nd + dbase + 8 * fq) * SEQ + s;
                    const float rrs = rst[ai * 128 + wr * 64 + m * 16 + fr];
#pragma unroll
                    for (int i = 0; i < 16; ++i) GST(bf16_t, d + (size_t)((i >> 3) * 32 + (i & 7)) * SEQ, (bf16_t)f2bf(acc[ai][i >> 3][m][(i >> 2) & 1][i & 3] * rrs));
                }
        } else if (kind == 3) {
            const int col = (ch - 44) * 64 + 8 * fq;
#pragma unroll
            for (int ai = 0; ai < 2; ++ai)
#pragma unroll
                for (int m = 0; m < 4; ++m) {
                    const int row = row0 + ai * 128 + m * 16;
                    float v[16];
                    const float rrs = rst[ai * 128 + wr * 64 + m * 16 + fr];
#pragma unroll
                    for (int i = 0; i < 16; ++i) v[i] = sigmoidf_(acc[ai][i >> 3][m][(i >> 2) & 1][i & 3] * rrs);
                    bf16_t* d = (bf16_t*)(ws + Z_MG) + (size_t)row * 2048 + col;
                    u32x4 w0, w1;
                    w0.x = pg8::cvt_pk_bf16(v[0], v[1]); w0.y = pg8::cvt_pk_bf16(v[2], v[3]); w0.z = pg8::cvt_pk_bf16(v[4], v[5]); w0.w = pg8::cvt_pk_bf16(v[6], v[7]);
                    w1.x = pg8::cvt_pk_bf16(v[8], v[9]); w1.y = pg8::cvt_pk_bf16(v[10], v[11]); w1.z = pg8::cvt_pk_bf16(v[12], v[13]); w1.w = pg8::cvt_pk_bf16(v[14], v[15]);
                    GST(u32x4, d, w0); GST(u32x4, d + 32, w1);
                }
        } else {
            if (fq < 3) {
#pragma unroll
                for (int ai = 0; ai < 2; ++ai)
#pragma unroll
                    for (int m = 0; m < 4; ++m) {
                        const int row = row0 + ai * 128 + m * 16;
                        float* d = (float*)(ws + Z_NG) + (size_t)row * 24 + 8 * fq;
                        const float rrs = rst[ai * 128 + wr * 64 + m * 16 + fr];
#pragma unroll
                        for (int i = 0; i < 8; ++i) GST(float, d + i, sigmoidf_(acc[ai][0][m][i >> 2][i & 3] * rrs));
                    }
            }
        }
    }
};

__device__ __forceinline__ void tr_item(const float* src, int ld, int c0, int nvalid, int k0, bf16_t* dst, int Kdst, LAS float* scr, int lane, const float* rsc = nullptr) {
    const int n = lane & 31;
#pragma unroll
    for (int i = 0; i < 32; ++i) { const int kk = 2 * i + (lane >> 5); scr[kk * 33 + n] = (src && n < nvalid) ? GLD(float, src + (size_t)(k0 + kk) * ld + c0 + n) * (rsc ? GLD(float, rsc + k0 + kk) : 1.f) : 0.f; }
    asm volatile("s_waitcnt lgkmcnt(0)" ::: "memory");
    const int c = lane & 7;
#pragma unroll
    for (int j = 0; j < 4; ++j) { const int nn = (lane >> 3) + 8 * j; const LAS float* s = scr + (8 * c) * 33 + nn;
        u32x4 o; o.x = pk2(s[0 * 33], s[1 * 33]); o.y = pk2(s[2 * 33], s[3 * 33]); o.z = pk2(s[4 * 33], s[5 * 33]); o.w = pk2(s[6 * 33], s[7 * 33]);
        GST(u32x4, dst + (size_t)nn * Kdst + 8 * c, o); }
    asm volatile("s_waitcnt lgkmcnt(0)" ::: "memory");
}
__device__ __forceinline__ int zchunk_src(int ch) {
    if (ch < 32) return ch * 64;
    if (ch < 44) return 2048 + (ch - 32) * 64;
    if (ch < 76) return 2840 + (ch - 44) * 64;
    return 2816;
}
__device__ __forceinline__ int t5_bucket(int n) {
    if (n < 16) return n;
    int b = 16;
    b += (n >= 21); b += (n >= 27); b += (n >= 35); b += (n >= 46); b += (n >= 59); b += (n >= 77); b += (n >= 99); b += (n >= 128);
    b += (n >= 166); b += (n >= 216); b += (n >= 280); b += (n >= 363); b += (n >= 470); b += (n >= 609); b += (n >= 790);
    return b;
}
__device__ __forceinline__ void prologue(const Params& P, LAS unsigned char* lds) {
    const int tid = otid(), lane = tid & 63, wave = tid >> 6;
    LAS float* scr = (LAS float*)(lds + wave * 16384);
    const int gw = blockIdx.x * NWAVE + wave, NGW = gridDim.x * NWAVE;
    unsigned char* ws = WSP;
    constexpr int I13 = 176 * 16, I2 = 32 * 44, IIN = 160 * 16, IPAB = 64 * 16, IWO = 32 * 16, IC1 = 4 * 32, IC2 = 2 * 2;
    constexpr int PER_L = 2 * I13 + 2 * I2 + IIN + IPAB + IWO + 2 * IC1 + 2 * IC2;
    for (int it = gw; it < DEPTH * PER_L; it += NGW) {
        const int l = it / PER_L; int r = it % PER_L;
        if (r < 2 * I13) {
            const int f = r / I13; r %= I13; const int gi = r / 16, kb = r % 16;
            const int t = gi >> 3, bj = (gi >> 2) & 1, sub = gi & 3;
            const float* src = (f ? (bj ? INP(12) : INP(11)) : (bj ? INP(9) : INP(8))) + (size_t)l * DM * DFF;
            tr_item(src, DFF, 128 * t + 32 * sub, 32, 64 * kb, (bf16_t*)(ws + WS_W13 + (size_t)(l * 2 + f) * W13_SZ) + (size_t)(32 * gi) * DM + 64 * kb, DM, scr, lane, (f ? INP(7) : INP(5)) + l * DM);
            continue;
        }
        r -= 2 * I13;
        if (r < 2 * I2) {
            const int f = r / I2; r %= I2; const int gi = r / 44, kb = r % 44;
            const float* src = (f ? INP(13) : INP(10)) + (size_t)l * DFF * DM;
            tr_item(src, DM, 32 * gi, 32, 64 * kb, (bf16_t*)(ws + WS_W2 + (size_t)(l * 2 + f) * W2_SZ) + (size_t)(32 * gi) * DFF + 64 * kb, DFF, scr, lane);
            continue;
        }
        r -= 2 * I2;
        if (r < IIN) {
            const int gi = r / 16, kb = r % 16;
            const int t = gi >> 3, bj = (gi >> 2) & 1, wc = gi & 3, ch = 4 * t + wc;
            int nvalid = 32; if (ch == 76) nvalid = bj ? 0 : 24; if (ch > 76) nvalid = 0;
            const float* src = nvalid ? INP(1) + (size_t)l * DM * NIN : nullptr;
            tr_item(src, NIN, zchunk_src(ch) + 32 * bj, nvalid, 64 * kb, (bf16_t*)(ws + WS_WIN + (size_t)l * WIN_SZ) + (size_t)(32 * gi) * DM + 64 * kb, DM, scr, lane, INP(6) + l * DM);
            continue;
        }
        r -= IIN;
        if (r < IPAB) {
            const int gi = r / 16, kb = r % 16;
            const int t = gi >> 3, bj = (gi >> 2) & 1, sub = gi & 3;
            const float* src = nullptr; int k0 = 0;
            if (bj == 0 && kb < 8) { src = INP(2) + (size_t)l * 512 * DM; k0 = 64 * kb; }
            if (bj == 1 && kb >= 8) { src = INP(3) + (size_t)l * 512 * DM; k0 = 64 * (kb - 8); }
            tr_item(src, DM, 128 * t + 32 * sub, 32, k0, (bf16_t*)(ws + WS_PAB + (size_t)l * PAB_SZ) + (size_t)(32 * gi) * DM + 64 * kb, DM, scr, lane);
            continue;
        }
        r -= IPAB;
        if (r < IWO) {
            const int gi = r / 16, kb = r % 16;
            tr_item(INP(4) + (size_t)l * DM * DM, DM, 32 * gi, 32, 64 * kb, (bf16_t*)(ws + WS_WO + (size_t)l * WO_SZ) + (size_t)(32 * gi) * DM + 64 * kb, DM, scr, lane);
            continue;
        }
        r -= IWO;
        if (r < 2 * IC1) {
            const int kv = r / IC1; r %= IC1; const int gi = r / 32, kb = r % 32;
            tr_item((kv ? INP(27) : INP(24)) + (size_t)l * 2048 * 128, 128, 32 * gi, 32, 64 * kb, (bf16_t*)(ws + WS_CW1 + (size_t)(l * 2 + kv) * CW1_SZ) + (size_t)(32 * gi) * 2048 + 64 * kb, 2048, scr, lane);
            continue;
        }
        r -= 2 * IC1;
        {
            const int kv = r / IC2; r %= IC2; const int gi = r / 2, kb = r % 2;
            tr_item((kv ? INP(28) : INP(25)) + (size_t)l * 128 * 64, 64, 32 * gi, 32, 64 * kb, (bf16_t*)(ws + WS_CW2 + (size_t)(l * 2 + kv) * CW2_SZ) + (size_t)(32 * gi) * 128 + 64 * kb, 128, scr, lane);
        }
    }
    const int gt = blockIdx.x * NTHR + tid, NGT = gridDim.x * NTHR;
    for (int i = gt; i < 12 * 1024; i += NGT) { const int h = i >> 10, d = i & 1023; ((float*)(ws + WS_BIAS))[i] = INP(29)[t5_bucket(d) * 12 + h] * LOG2E; }
    if (blockIdx.x == (gridDim.x > 1 ? 1 : 0) && wave < DEPTH) {
        const int l = wave;
        float a = INP(16)[l * 64 + lane] * INP(17)[l * 64 + lane], b = INP(18)[l * 64 + lane] * INP(19)[l * 64 + lane];
        float mq = fabsf(INP(14)[l * 64 + lane]), mk = fabsf(INP(15)[l * 64 + lane]), mnq = fabsf(INP(21)[l * 64 + lane]);
        float mnk = fmaxf(fmaxf(fabsf(INP(22)[l * 192 + lane]), fabsf(INP(22)[l * 192 + 64 + lane])), fabsf(INP(22)[l * 192 + 128 + lane]));
        float mb = 0.f; for (int i = lane; i < 32 * 12; i += 64) mb = fmaxf(mb, fabsf(INP(29)[i]));
#pragma unroll
        for (int o = 1; o < 64; o <<= 1) { a += __shfl_xor(a, o); b += __shfl_xor(b, o); mq = fmaxf(mq, __shfl_xor(mq, o)); mk = fmaxf(mk, __shfl_xor(mk, o)); mnq = fmaxf(mnq, __shfl_xor(mnq, o)); mnk = fmaxf(mnk, __shfl_xor(mnk, o)); mb = fmaxf(mb, __shfl_xor(mb, o)); }
        if (lane == 0) {
            float* prm = (float*)(ws + WS_PRM) + l * 8;
            const float lam_init = 0.8f - 0.6f * expf(-0.3f * (float)l);
            prm[0] = expf(a) - expf(b) + lam_init;
            prm[1] = (8.f * mq * mk * 1.02f + mb) * LOG2E;
            prm[2] = (8.f * mnq * mnk * 1.02f + mb) * LOG2E;
            prm[3] = 1.0f - lam_init;
        }
    }
    for (int wi = blockIdx.x; wi < 32; wi += gridDim.x) {
        const int lk = wi >> 3, n = (wi & 7) * 16 + (tid & 15), ks = tid >> 4, l = lk >> 1, kv = lk & 1;
        const float* pe = (kv ? INP(26) : INP(23)) + (size_t)l * 2048; const float* w1 = (kv ? INP(27) : INP(24)) + (size_t)l * 2048 * 128;
        float sacc = 0.f;
#pragma unroll 16
        for (int k = 64 * ks; k < 64 * ks + 64; ++k) sacc += GLD(float, pe + k) * GLD(float, w1 + (size_t)k * 128 + n);
        LAS float* red = (LAS float*)lds;
        __syncthreads();
        red[tid] = sacc;
        __syncthreads();
        if (tid < 16) { float t = 0.f; for (int i = 0; i < 32; ++i) t += red[i * 16 + tid]; ((float*)(ws + WS_CB1))[lk * 128 + (wi & 7) * 16 + tid] = t; }
        __syncthreads();
    }
}

template <bool INBF16, bool COPYRAW>
__device__ __forceinline__ void rmsnorm_phase(const void* x, const float* g, bf16_t* o, bf16_t* xraw = nullptr) {
    const int tid = otid(), lane = tid & 63, wave = tid >> 6;
    const int gw = blockIdx.x * NWAVE + wave, NGW = gridDim.x * NWAVE;
    f32x4 gv[4];
#pragma unroll
    for (int j = 0; j < 4; ++j) gv[j] = GLD(f32x4, (const f32x4*)g + lane + 64 * j);
    constexpr int RB = 4;
    for (int m0 = gw; m0 < MTOK; m0 += NGW * RB) {
        f32x4 v[RB][4]; float s[RB];
#pragma unroll
        for (int r = 0; r < RB; ++r) { const int m = m0 + r * NGW; const size_t ro = (size_t)(m < MTOK ? m : m0) * DM;
#pragma unroll
            for (int j = 0; j < 4; ++j) {
                if (!INBF16) v[r][j] = GLD(f32x4, (const f32x4*)((const float*)x + ro) + lane + 64 * j);
                else { const u32x2 w = GLD(u32x2, (const u32x2*)((const bf16_t*)x + ro) + lane + 64 * j);
                       if (COPYRAW && m < MTOK) GST(u32x2, (u32x2*)(xraw + ro) + lane + 64 * j, w);
                       v[r][j] = (f32x4){__builtin_bit_cast(float, w.x << 16), __builtin_bit_cast(float, w.x & 0xffff0000u), __builtin_bit_cast(float, w.y << 16), __builtin_bit_cast(float, w.y & 0xffff0000u)}; }
            } }
#pragma unroll
        for (int r = 0; r < RB; ++r) { s[r] = 0.f;
#pragma unroll
            for (int j = 0; j < 4; ++j) s[r] += (v[r][j].x * v[r][j].x + v[r][j].y * v[r][j].y) + (v[r][j].z * v[r][j].z + v[r][j].w * v[r][j].w); }
#pragma unroll
        for (int of = 1; of < 64; of <<= 1) {
#pragma unroll
            for (int r = 0; r < RB; ++r) s[r] += __shfl_xor(s[r], of); }
#pragma unroll
        for (int r = 0; r < RB; ++r) { const int m = m0 + r * NGW;
            if (m < MTOK) {
                const float rs = __builtin_amdgcn_rsqf(s[r] * (1.f / DM) + EPS);
                u32x2* o8 = (u32x2*)(o + (size_t)m * DM) + lane;
#pragma unroll
                for (int j = 0; j < 4; ++j) { u32x2 w; w.x = pk2(v[r][j].x * rs * gv[j].x, v[r][j].y * rs * gv[j].y); w.y = pk2(v[r][j].z * rs * gv[j].z, v[r][j].w * rs * gv[j].w); GST(u32x2, o8 + 64 * j, w); }
            }
        }
    }
}

__device__ __forceinline__ void xprep_phase(const float* x, bf16_t* o, float* ss) {
    const int tid = otid(), lane = tid & 63, wave = tid >> 6;
    const int gw = blockIdx.x * NWAVE + wave, NGW = gridDim.x * NWAVE;
    for (int m = gw; m < MTOK; m += NGW) {
        const f32x4* xr = (const f32x4*)(x + (size_t)m * DM) + lane;
        f32x4 v[4]; float s = 0.f;
#pragma unroll
        for (int j = 0; j < 4; ++j) { v[j] = GLD(f32x4, xr + 64 * j); s += (v[j].x * v[j].x + v[j].y * v[j].y) + (v[j].z * v[j].z + v[j].w * v[j].w); }
#pragma unroll
        for (int of = 1; of < 64; of <<= 1) s += __shfl_xor(s, of);
        u32x2* o8 = (u32x2*)(o + (size_t)m * DM) + lane;
#pragma unroll
        for (int j = 0; j < 4; ++j) { u32x2 w; w.x = pk2(v[j].x, v[j].y); w.y = pk2(v[j].z, v[j].w); GST(u32x2, o8 + 64 * j, w); }
        if (lane < 16) GST(float, ss + (size_t)m * 16 + lane, lane == 0 ? s : 0.f);
    }
}

__device__ __forceinline__ float gelu_tanh(float x) {
    const float y = 0.7978845608028654f * (x + 0.044715f * x * x * x);
    const float e = __builtin_amdgcn_exp2f(2.f * LOG2E * y);
    const float t = 1.f - 2.f * __builtin_amdgcn_rcpf(e + 1.f);
    return 0.5f * x * (1.f + t);
}
__device__ __forceinline__ void compress_phase(const Params& P, int l, LAS unsigned char* lds) {
    const int tid = otid(), lane = tid & 63, wave = tid >> 6, fr = lane & 15, kq = lane >> 4;
    unsigned char* ws = WSP;
    LAS bf16_t* Hs = (LAS bf16_t*)lds;
    LAS float* Os = (LAS float*)(lds + 8192);
    for (int unit = blockIdx.x; unit < 2 * 16 * 16; unit += gridDim.x) {
        const int kv = unit >> 8, bg = (unit >> 4) & 15, cblk = unit & 15, c0 = 16 * cblk;
        const bf16_t* src = (const bf16_t*)(ws + (kv ? Z_VCR : Z_KCR)) + (size_t)bg * SEQ * 64;
        const int crow_ = (c0 + fr) < 255 ? (c0 + fr) : 254;
        const bf16_t* ap = src + (size_t)1024 * crow_ + 8 * kq;
        const bf16_t* bp = (const bf16_t*)(ws + WS_CW1 + (size_t)(l * 2 + kv) * CW1_SZ) + (size_t)(16 * wave + fr) * 2048 + 8 * kq;
        f32x4 acc = {0.f, 0.f, 0.f, 0.f};
#pragma unroll 8
        for (int kk = 0; kk < 64; ++kk) { const bf16x8 a = GLD(bf16x8, ap + 32 * kk), b = GLD(bf16x8, bp + 32 * kk); acc = __builtin_amdgcn_mfma_f32_16x16x32_bf16(a, b, acc, 0, 0, 0); }
        const float cb = ((const float*)(ws + WS_CB1))[(l * 2 + kv) * 128 + 16 * wave + fr];
#pragma unroll
        for (int i = 0; i < 4; ++i) Hs[(4 * kq + i) * 136 + 16 * wave + fr] = (bf16_t)f2bf(gelu_tanh(acc[i] + cb));
        __syncthreads();
        if (wave < 4) {
            const bf16_t* b2 = (const bf16_t*)(ws + WS_CW2 + (size_t)(l * 2 + kv) * CW2_SZ) + (size_t)(16 * wave + fr) * 128 + 8 * kq;
            f32x4 a2 = {0.f, 0.f, 0.f, 0.f};
#pragma unroll
            for (int kk = 0; kk < 4; ++kk) { const bf16x8 a = *(const LAS bf16x8*)(Hs + fr * 136 + 32 * kk + 8 * kq), b = *(const bf16x8*)(b2 + 32 * kk); a2 = __builtin_amdgcn_mfma_f32_16x16x32_bf16(a, b, a2, 0, 0, 0); }
#pragma unroll
            for (int i = 0; i < 4; ++i) Os[(4 * kq + i) * 65 + 16 * wave + fr] = a2[i];
        }
        __syncthreads();
#pragma unroll
        for (int rep = 0; rep < 2; ++rep) {
            const int e = tid + NTHR * rep, row = e >> 6, d = e & 63, c = c0 + row;
            const float val = Os[row * 65 + d];
            if (kv == 0) {
                float ss = 0.f;
                for (int j = 0; j < 64; ++j) { const float t = Os[row * 65 + j]; ss += t * t; }
                const float o = val * __builtin_amdgcn_rsqf(ss * (1.f / 64.f) + EPS) * INP(22)[l * 192 + d];
                ((bf16_t*)(ws + WS_KCN))[((size_t)bg * 256 + c) * 64 + d] = (c < 255) ? (bf16_t)f2bf(o) : (bf16_t)0;
            } else {
                ((bf16_t*)(ws + WS_VCT))[((size_t)bg * 64 + d) * 256 + c] = (c < 255) ? (bf16_t)f2bf(val) : (bf16_t)0;
            }
        }
        __syncthreads();
    }
}

__device__ __forceinline__ void qk_tile(f32x16& p0, f32x16& p1, const LAS unsigned char* Kl, const bf16x8 (&qf)[4], int r32, int hi) {
    const LAS unsigned char* kb = Kl + r32 * KP + hi * 16;
    bf16x8 a[8];
#pragma unroll
    for (int d0 = 0; d0 < 4; ++d0) { a[2 * d0] = *(const LAS bf16x8*)(kb + d0 * 32); a[2 * d0 + 1] = *(const LAS bf16x8*)(kb + 32 * KP + d0 * 32); }
    __builtin_amdgcn_s_setprio(1);
#pragma unroll
    for (int d0 = 0; d0 < 4; ++d0) {
        p0 = __builtin_amdgcn_mfma_f32_32x32x16_bf16(a[2 * d0], qf[d0], p0, 0, 0, 0);
        p1 = __builtin_amdgcn_mfma_f32_32x32x16_bf16(a[2 * d0 + 1], qf[d0], p1, 0, 0, 0);
    }
    __builtin_amdgcn_s_setprio(0);
}
template <int STRIDE, bool WINDOW, int MODE>
__device__ __forceinline__ void score_exp(f32x16& p0, f32x16& p1, int dl, const LAS float* tb, float cfar, bool rowsel) {
    const LAS float* tl = tb + 128 + (dl < 1087 ? dl : 1087) - 59;
#pragma unroll
    for (int blk = 0; blk < 2; ++blk) {
        f32x16& p = blk ? p1 : p0;
#pragma unroll
        for (int r = 0; r < 16; ++r) {
            const int c = (r & 3) + 8 * (r >> 2) + 32 * blk;
            const int dist = dl - STRIDE * c;
            float e;
            if (MODE == 0) e = __builtin_amdgcn_exp2f(p[r] + cfar);
            else {
                float bias;
                if (STRIDE == 1) bias = tl[59 - c];
                else bias = tb[128 + min((unsigned)dist, 1023u)];
                e = __builtin_amdgcn_exp2f(p[r] + bias);
                if (MODE == 2) { bool valid = dist >= 0; if (WINDOW) valid = valid && (dist < 512); e = valid ? e : 0.f; }
            }
            p[r] = rowsel ? e : 0.f;
        }
    }
}
template <int STRIDE, bool WINDOW>
__device__ __forceinline__ void score_exp_sel(f32x16& p0, f32x16& p1, int dl, const LAS float* tb, float cfar, bool rowsel, int dmin, int dmax) {
    if (!WINDOW && dmin >= 790) score_exp<STRIDE, WINDOW, 0>(p0, p1, dl, tb, cfar, rowsel);
    else if (dmin >= 0 && (!WINDOW || dmax < 512)) score_exp<STRIDE, WINDOW, 1>(p0, p1, dl, tb, cfar, rowsel);
    else score_exp<STRIDE, WINDOW, 2>(p0, p1, dl, tb, cfar, rowsel);
}
__device__ __forceinline__ float sum32(const f32x16& p0, const f32x16& p1) {
    float a = 0.f, b = 0.f;
#pragma unroll
    for (int r = 0; r < 16; ++r) { a += p0[r]; b += p1[r]; }
    return a + b;
}
template <int NDB>
__device__ __forceinline__ void pv_tile(f32x16 (&o)[NDB], const f32x16& p0, const f32x16& p1, const LAS unsigned char* Vl, int r32, int hi) {
    const LAS unsigned char* vbase = Vl + r32 * VP + hi * 8;
    bf16x4 vf[2][NDB][2];
#define PV_LOAD(st, buf) do { _Pragma("unroll") for (int db = 0; db < NDB; ++db) { const LAS unsigned char* vp = vbase + db * 32 * VP + (st) * 32; vf[buf][db][0] = *(const LAS bf16x4*)vp; vf[buf][db][1] = *(const LAS bf16x4*)(vp + 16); } } while (0)
    PV_LOAD(0, 0);
#pragma unroll
    for (int st = 0; st < 4; ++st) {
        if (st + 1 < 4) PV_LOAD(st + 1, (st + 1) & 1);
        const f32x16& p = (st >> 1) ? p1 : p0; const int s8 = 8 * (st & 1);
        u32x4 w; w.x = pg8::cvt_pk_bf16(p[s8 + 0], p[s8 + 1]); w.y = pg8::cvt_pk_bf16(p[s8 + 2], p[s8 + 3]); w.z = pg8::cvt_pk_bf16(p[s8 + 4], p[s8 + 5]); w.w = pg8::cvt_pk_bf16(p[s8 + 6], p[s8 + 7]);
        const bf16x8 pa = __builtin_bit_cast(bf16x8, w);
        __builtin_amdgcn_s_setprio(1);
#pragma unroll
        for (int db = 0; db < NDB; ++db) {
            const bf16x4 lo = vf[st & 1][db][0], hi4 = vf[st & 1][db][1];
            const bf16x8 vb = {lo[0], lo[1], lo[2], lo[3], hi4[0], hi4[1], hi4[2], hi4[3]};
            o[db] = __builtin_amdgcn_mfma_f32_32x32x16_bf16(pa, vb, o[db], 0, 0, 0);
        }
        __builtin_amdgcn_s_setprio(0);
    }
#undef PV_LOAD
}
__device__ __forceinline__ u32x4 ldk(const bf16_t* g, int tid) { return GLD(u32x4, (const unsigned char*)g + tid * 16); }
__device__ __forceinline__ void stk(LAS unsigned char* Kl, u32x4 v, int tid) { *(LAS u32x4*)(Kl + (tid >> 3) * KP + (tid & 7) * 16) = v; }
__device__ __forceinline__ u32x4 ldv(const bf16_t* g, size_t rs, int row, int tid) { return GLD(u32x4, (const unsigned char*)(g + (size_t)row * rs) + (tid & 7) * 16); }
__device__ __forceinline__ void stv(LAS unsigned char* Vl, u32x4 v, int row, int tid) { LAS unsigned char* p = Vl + row * VP + (tid & 7) * 16; *(LAS u32x2*)p = (u32x2){v.x, v.y}; *(LAS u32x2*)(p + 8) = (u32x2){v.z, v.w}; }

__device__ __forceinline__ void da_unit(const Params& P, int l, int b, int h, int qb, LAS unsigned char* lds, bool load_tab) {
    const int tid = otid(), lane = tid & 63, wave = __builtin_amdgcn_readfirstlane(tid >> 6), r32 = lane & 31, hi = lane >> 5;
    const int c = wave >> 2, qsub = wave & 3, q0 = qb * 128, qw0 = q0 + 32 * qsub;
    unsigned char* ws = WSP;
    const float* prm = (const float*)(ws + WS_PRM) + l * 8;
    const float lam = prm[0], Mb = prm[1], onem = prm[3];
    LAS float* biasL = (LAS float*)(lds + L_BIAS);
    const float* bg = (const float*)(ws + WS_BIAS) + h * 1024;
    if (load_tab) for (int i = tid; i < TBN; i += NTHR) { const int d = i - 128; biasL[i] = GLD(float, bg + (d < 0 ? 0 : (d > 1023 ? 1023 : d))) - Mb; }
    const float cfar = bg[1023] - Mb;
    const bf16_t* Qp = (const bf16_t*)(ws + Z_DQ) + ((size_t)(b * 8 + h * 2 + c) * SEQ + qw0 + r32) * 64 + hi * 8;
    bf16x8 qf[4];
#pragma unroll
    for (int d0 = 0; d0 < 4; ++d0) qf[d0] = GLD(bf16x8, Qp + d0 * 16);
    const bf16_t* K1g = (const bf16_t*)(ws + Z_DK) + (size_t)(b * 8 + h * 2) * SEQ * 64;
    const bf16_t* K2g = K1g + (size_t)SEQ * 64;
    const bf16_t* Vg = (const bf16_t*)(ws + Z_DVT) + (size_t)(b * 4 + h) * 128 * SEQ;
    const int NT = (q0 + 128) / 64;
    f32x16 o[4];
#pragma unroll
    for (int i = 0; i < 4; ++i) o[i] = (f32x16){};
    float lsum = 0.f;
    u32x4 rk1, rk2, rv0, rv1;
#define DA_LOAD(t) do { rk1 = ldk(K1g + (size_t)(t) * 4096, tid); rk2 = ldk(K2g + (size_t)(t) * 4096, tid); rv0 = ldv(Vg + (t) * 64, SEQ, tid >> 3, tid); rv1 = ldv(Vg + (t) * 64, SEQ, 64 + (tid >> 3), tid); } while (0)
#define DA_STORE(sb) do { LAS unsigned char* st_ = lds + (sb) * DA_STAGE; stk(st_, rk1, tid); stk(st_ + 64 * KP, rk2, tid); stv(st_ + 128 * KP, rv0, tid >> 3, tid); stv(st_ + 128 * KP, rv1, 64 + (tid >> 3), tid); } while (0)
    DA_LOAD(0); DA_STORE(0);
    __syncthreads();
    for (int t = 0; t < NT; ++t) {
        if (t + 1 < NT) DA_LOAD(t + 1);
        if (64 * t <= qw0 + 31) {
            const LAS unsigned char* st = lds + (t & 1) * DA_STAGE;
            f32x16 p0 = (f32x16){}, p1 = (f32x16){};
            qk_tile(p0, p1, st + c * 64 * KP, qf, r32, hi);
            const int dl = qw0 + r32 - 64 * t - 4 * hi;
            score_exp_sel<1, false>(p0, p1, dl, biasL, cfar, true, qw0 - (64 * t + 63), qw0 + 31 - 64 * t);
            lsum += sum32(p0, p1);
            pv_tile<4>(o, p0, p1, st + 128 * KP, r32, hi);
        }
        if (t + 1 < NT) DA_STORE((t + 1) & 1);
        __syncthreads();
    }
#undef DA_LOAD
#undef DA_STORE
    lsum += __shfl_xor(lsum, 32);
    LAS float* wsf = (LAS float*)(lds + L_WSF) + wave * 64;
    if (hi == 0) wsf[r32] = (lsum > 0.f) ? 1.0f / lsum : 0.f;
    asm volatile("s_waitcnt lgkmcnt(0)" ::: "memory");
    float li[16];
#pragma unroll
    for (int r = 0; r < 16; ++r) li[r] = wsf[crow(r, hi)];
    LAS float* X = (LAS float*)lds;
    if (c == 1) {
#pragma unroll
        for (int db = 0; db < 4; ++db)
#pragma unroll
            for (int r = 0; r < 16; ++r) X[(32 * qsub + crow(r, hi)) * 132 + r32 + 32 * db] = o[db][r] * li[r];
    }
    __syncthreads();
    if (c == 0) {
        const float* sg = INP(20) + l * 128;
        float gsub[4];
#pragma unroll
        for (int db = 0; db < 4; ++db) gsub[db] = sg[r32 + 32 * db] * onem;
#pragma unroll
        for (int r = 0; r < 16; ++r) {
            float y[4], ss = 0.f;
#pragma unroll
            for (int db = 0; db < 4; ++db) { y[db] = o[db][r] * li[r] - lam * X[(32 * qsub + crow(r, hi)) * 132 + r32 + 32 * db]; ss += y[db] * y[db]; }
            ss += __shfl_xor(ss, 1); ss += __shfl_xor(ss, 2); ss += __shfl_xor(ss, 4); ss += __shfl_xor(ss, 8); ss += __shfl_xor(ss, 16);
            const float rs = __builtin_amdgcn_rsqf(ss * (1.f / 128.f) + EPS);
            bf16_t* d = (bf16_t*)(ws + WS_XN) + (size_t)(b * SEQ + qw0 + crow(r, hi)) * DM + h * 128 + r32;
#pragma unroll
            for (int db = 0; db < 4; ++db) GST(bf16_t, d + 32 * db, (bf16_t)f2bf(y[db] * rs * gsub[db]));
        }
    }
    __syncthreads();
}

__device__ __forceinline__ void nsa_unit(const Params& P, int l, int b, int g, int u, LAS unsigned char* lds, bool load_tab) {
    const int tid = otid(), lane = tid & 63, wave = __builtin_amdgcn_readfirstlane(tid >> 6), r32 = lane & 31, hi = lane >> 5;
    const int qi = r32 >> 2, p = r32 & 3, qw0 = 64 * u + 8 * wave, qpos = qw0 + qi, head = g * 4 + p;
    unsigned char* ws = WSP;
    const float Mb = ((const float*)(ws + WS_PRM))[l * 8 + 2];
    LAS float* biasL = (LAS float*)(lds + L_BIAS);
    LAS float* imp = (LAS float*)(lds + L_IMP);
    LAS unsigned* selw = (LAS unsigned*)(lds + L_SEL);
    LAS float* wsf = (LAS float*)(lds + L_WSF) + wave * 64;
    const float* bgl = (const float*)(ws + WS_BIAS) + (size_t)(4 + g * 4) * 1024;
    if (load_tab) for (int i = tid; i < 4 * TBN; i += NTHR) { const int hh = i / TBN, d = i % TBN - 128; biasL[i] = GLD(float, bgl + hh * 1024 + (d < 0 ? 0 : (d > 1023 ? 1023 : d))) - Mb; }
    if (tid == 0) { unsigned z = 0u; asm volatile("" : "+v"(z)); selw[128] = z; selw[129] = z; }
    const LAS float* tb = biasL + p * TBN;
    const float cfar = bgl[p * 1024 + 1023] - Mb;
    const bf16_t* Qp = (const bf16_t*)(ws + Z_NQ) + ((size_t)(b * 8 + head) * SEQ + qpos) * 64 + hi * 8;
    bf16x8 qf[4];
#pragma unroll
    for (int d0 = 0; d0 < 4; ++d0) qf[d0] = GLD(bf16x8, Qp + d0 * 16);
    const float* ngp = (const float*)(ws + Z_NG) + (size_t)(b * SEQ + qpos) * 24 + head * 3;
    const float gate_c = GLD(float, ngp), gate_s = GLD(float, ngp + 1), gate_w = GLD(float, ngp + 2);
    f32x16 oc[2]; oc[0] = (f32x16){}; oc[1] = (f32x16){};
    f32x16 o[2];
    u32x4 rk, rv;
    const int bgi = b * 2 + g;
#define NS_STORE(sb) do { LAS unsigned char* st_ = lds + (sb) * NS_STAGE; stk(st_, rk, tid); stv(st_ + 64 * KP, rv, tid >> 3, tid); } while (0)
#define NS_FOLD(gate) do { lsum += __shfl_xor(lsum, 32); if (hi == 0) wsf[r32] = (lsum > 0.f) ? (gate) / lsum : 0.f; asm volatile("s_waitcnt lgkmcnt(0)" ::: "memory"); \
        _Pragma("unroll") for (int r = 0; r < 16; ++r) { const float f_ = wsf[crow(r, hi)]; oc[0][r] += f_ * o[0][r]; oc[1][r] += f_ * o[1][r]; } asm volatile("s_waitcnt lgkmcnt(0)" ::: "memory"); } while (0)
    {
        const bf16_t* Kg = (const bf16_t*)(ws + WS_KCN) + (size_t)bgi * 256 * 64;
        const bf16_t* Vg = (const bf16_t*)(ws + WS_VCT) + (size_t)bgi * 64 * 256;
        const int ntc = (4 * u + 2) / 64 + 1;
        for (int tc = 0; tc < ntc; ++tc) { rk = ldk(Kg + (size_t)tc * 4096, tid); rv = ldv(Vg + tc * 64, 256, tid >> 3, tid); NS_STORE(tc); }
        __syncthreads();
        float lsum = 0.f;
        for (int tc = 0; tc < ntc; ++tc) {
            const LAS unsigned char* st = lds + tc * NS_STAGE;
            f32x16 p0 = (f32x16){}, p1 = (f32x16){};
            qk_tile(p0, p1, st, qf, r32, hi);
            const int dl = qpos - 31 - 16 * (64 * tc + 4 * hi);
            score_exp_sel<16, false>(p0, p1, dl, tb, cfar, true, qw0 - 31 - 16 * (64 * tc + 63), qw0 + 7 - 31 - 16 * 64 * tc);
            lsum += sum32(p0, p1);
        }
        const float lt = lsum + __shfl_xor(lsum, 32);
        const float linv = (lt > 0.f) ? 1.0f / lt : 0.f;
        o[0] = (f32x16){}; o[1] = (f32x16){};
        float carry = 0.f;
        for (int tc = 0; tc < ntc; ++tc) {
            const LAS unsigned char* st = lds + tc * NS_STAGE;
            f32x16 p0 = (f32x16){}, p1 = (f32x16){};
            qk_tile(p0, p1, st, qf, r32, hi);
            const int dl = qpos - 31 - 16 * (64 * tc + 4 * hi);
            score_exp_sel<16, false>(p0, p1, dl, tb, cfar, true, qw0 - 31 - 16 * (64 * tc + 63), qw0 + 7 - 31 - 16 * 64 * tc);
            float Qs[2][4], PL[2][4];
#pragma unroll
            for (int blk = 0; blk < 2; ++blk)
#pragma unroll
                for (int m = 0; m < 4; ++m) { const f32x16& pp = blk ? p1 : p0; Qs[blk][m] = (pp[4 * m] + pp[4 * m + 1]) + (pp[4 * m + 2] + pp[4 * m + 3]); PL[blk][m] = __shfl_xor(pp[4 * m + 3], 32); }
#pragma unroll
            for (int blk = 0; blk < 2; ++blk)
#pragma unroll
                for (int m = 0; m < 4; ++m) {
                    const float prev = (m > 0) ? PL[blk][m - 1] : (blk ? PL[0][3] : carry);
                    float e = (Qs[blk][m] + (hi ? PL[blk][m] : prev)) * linv;
                    e += __shfl_xor(e, 1); e += __shfl_xor(e, 2);
                    if (p == 0) imp[(8 * wave + qi) * 64 + 16 * tc + 8 * blk + 2 * m + hi] = e;
                }
            carry = PL[1][3];
            pv_tile<2>(o, p0, p1, st + 64 * KP, r32, hi);
        }
        NS_FOLD(gate_c);
    }
    __syncthreads();
    {
        const int ql = lane >> 3, sub = lane & 7, q = 8 * wave + ql;
        unsigned long long m;
        if (u < 8) m = (2ull << u) - 1ull;
        else {
            m = 1ull | (1ull << u) | (1ull << (u - 1));
            float v[8];
#pragma unroll
            for (int i = 0; i < 8; ++i) { const int j = sub + 8 * i; v[i] = (j >= 1 && j <= u - 2) ? imp[q * 64 + j] : -1.f; }
            for (int k = 0; k < 5; ++k) {
                float bv = v[0]; int bj = sub;
#pragma unroll
                for (int i = 1; i < 8; ++i) if (v[i] > bv) { bv = v[i]; bj = sub + 8 * i; }
#pragma unroll
                for (int of = 1; of < 8; of <<= 1) { const float ov = __shfl_xor(bv, of); const int oj = __shfl_xor(bj, of); if (ov > bv || (ov == bv && oj < bj)) { bv = ov; bj = oj; } }
                m |= 1ull << bj;
#pragma unroll
                for (int i = 0; i < 8; ++i) if (bj == sub + 8 * i) v[i] = -2.f;
            }
        }
        if (sub == 0) { selw[2 * q] = (unsigned)m; selw[2 * q + 1] = (unsigned)(m >> 32); atomicOr((unsigned*)&selw[128], (unsigned)m); atomicOr((unsigned*)&selw[129], (unsigned)(m >> 32)); }
    }
    __syncthreads();
    asm volatile("" : "+v"(oc[0]), "+v"(oc[1]));
    u32x4 rk2, rv2;
#define NS_LOADA(Kg_, Vg_, j_) do { rk = ldk((Kg_) + (size_t)(j_) * 4096, tid); rv = ldv((Vg_) + (j_) * 64, SEQ, tid >> 3, tid); } while (0)
#define NS_LOADB(Kg_, Vg_, j_) do { rk2 = ldk((Kg_) + (size_t)(j_) * 4096, tid); rv2 = ldv((Vg_) + (j_) * 64, SEQ, tid >> 3, tid); } while (0)
#define NS_STOREA(sb) do { LAS unsigned char* st_ = lds + (sb) * NS_STAGE; stk(st_, rk, tid); stv(st_ + 64 * KP, rv, tid >> 3, tid); } while (0)
#define NS_STOREB(sb) do { LAS unsigned char* st_ = lds + (sb) * NS_STAGE; stk(st_, rk2, tid); stv(st_ + 64 * KP, rv2, tid >> 3, tid); } while (0)
    {
        const unsigned long long un = (unsigned long long)selw[128] | ((unsigned long long)selw[129] << 32);
        const unsigned long long mine = (unsigned long long)selw[2 * (8 * wave + qi)] | ((unsigned long long)selw[2 * (8 * wave + qi) + 1] << 32);
        const bf16_t* Kg = (const bf16_t*)(ws + Z_KSEL) + (size_t)bgi * SEQ * 64;
        const bf16_t* Vg = (const bf16_t*)(ws + Z_VSELT) + (size_t)bgi * 64 * SEQ;
        o[0] = (f32x16){}; o[1] = (f32x16){};
        float lsum = 0.f;
        unsigned long long rem = un;
#define NS_NEXTJ(var, has) do { has = (rem != 0ull); var = 0; if (has) { var = __builtin_ctzll(rem); rem &= rem - 1; } } while (0)
        int jc, j1, j2; bool h1, h2;
        NS_NEXTJ(jc, h1);
        NS_NEXTJ(j1, h1);
        NS_LOADA(Kg, Vg, jc); if (h1) NS_LOADB(Kg, Vg, j1);
        NS_STOREA(0);
        __syncthreads();
        int sc = 0;
#define NS_SEL_STEP(LOADF, STOREN) { \
            NS_NEXTJ(j2, h2); if (h2) LOADF(Kg, Vg, j2); \
            const bool rowsel = (mine >> jc) & 1ull; \
            if (__any(rowsel)) { \
                const LAS unsigned char* st = lds + sc * NS_STAGE; \
                f32x16 p0 = (f32x16){}, p1 = (f32x16){}; \
                qk_tile(p0, p1, st, qf, r32, hi); \
                const int dl = qpos - 64 * jc - 4 * hi; \
                score_exp_sel<1, false>(p0, p1, dl, tb, cfar, rowsel, qw0 - (64 * jc + 63), qw0 + 7 - 64 * jc); \
                lsum += sum32(p0, p1); \
                pv_tile<2>(o, p0, p1, st + 64 * KP, r32, hi); \
            } \
            const int sn = (sc == 2) ? 0 : sc + 1; \
            if (h1) STOREN(sn); \
            __syncthreads(); \
            if (!h1) break; \
            jc = j1; j1 = j2; h1 = h2; sc = sn; }
        for (;;) { NS_SEL_STEP(NS_LOADA, NS_STOREB) NS_SEL_STEP(NS_LOADB, NS_STOREA) }
#undef NS_SEL_STEP
#undef NS_NEXTJ
        NS_FOLD(gate_s);
        asm volatile("" : "+v"(oc[0]), "+v"(oc[1]));
    }
    {
        const bf16_t* Kg = (const bf16_t*)(ws + Z_KWIN) + (size_t)bgi * SEQ * 64;
        const bf16_t* Vg = (const bf16_t*)(ws + Z_VWINT) + (size_t)bgi * 64 * SEQ;
        o[0] = (f32x16){}; o[1] = (f32x16){};
        float lsum = 0.f;
        const int t0 = (u >= 8) ? u - 8 : 0;
        int t = t0, sc = 0;
        NS_LOADA(Kg, Vg, t0); if (t0 + 1 <= u) NS_LOADB(Kg, Vg, t0 + 1);
        NS_STOREA(0);
        __syncthreads();
#define NS_WIN_STEP(LOADF, STOREN) { \
            if (t + 2 <= u) LOADF(Kg, Vg, t + 2); \
            { \
                const LAS unsigned char* st = lds + sc * NS_STAGE; \
                f32x16 p0 = (f32x16){}, p1 = (f32x16){}; \
                qk_tile(p0, p1, st, qf, r32, hi); \
                const int dl = qpos - 64 * t - 4 * hi; \
                score_exp_sel<1, true>(p0, p1, dl, tb, cfar, true, qw0 - (64 * t + 63), qw0 + 7 - 64 * t); \
                lsum += sum32(p0, p1); \
                pv_tile<2>(o, p0, p1, st + 64 * KP, r32, hi); \
            } \
            const int sn = (sc == 2) ? 0 : sc + 1; \
            if (t + 1 <= u) STOREN(sn); \
            __syncthreads(); \
            if (t + 1 > u) break; \
            ++t; sc = sn; }
        for (;;) { NS_WIN_STEP(NS_LOADA, NS_STOREB) NS_WIN_STEP(NS_LOADB, NS_STOREA) }
#undef NS_WIN_STEP
        NS_FOLD(gate_w);
    }
#undef NS_LOADA
#undef NS_LOADB
#undef NS_STOREA
#undef NS_STOREB
#undef NS_STORE
#undef NS_FOLD
#pragma unroll
    for (int r = 0; r < 16; ++r) {
        const int row = crow(r, hi), q = qw0 + (row >> 2), pp = row & 3;
        bf16_t* d = (bf16_t*)(ws + WS_XN) + (size_t)(b * SEQ + q) * DM + 512 + (g * 4 + pp) * 64 + r32;
        GST(bf16_t, d, (bf16_t)f2bf(oc[0][r])); GST(bf16_t, d + 32, (bf16_t)f2bf(oc[1][r]));
    }
    __syncthreads();
}

__device__ __forceinline__ void attention_phase(const Params& P, int l, LAS unsigned char* lds) {
    int tab_key = -1;
    for (int it = blockIdx.x; it < 2048; it += gridDim.x) {
        const int c = it & 255, sl = (it >> 8) & 3;
        if (it < 1024) { const int bh = c & 31, xg = c >> 5; const int qb = (sl == 0) ? 31 - xg : (sl == 1) ? 23 - xg : (sl == 2) ? 8 + xg : xg;
            da_unit(P, l, bh >> 2, bh & 3, qb, lds, tab_key != (bh & 3)); tab_key = bh & 3; }
        else { const int bg = c & 15, ug = c >> 4; const int u = (sl == 0) ? 63 - ug : (sl == 1) ? 47 - ug : (sl == 2) ? 16 + ug : ug;
            nsa_unit(P, l, bg >> 1, bg & 1, u, lds, tab_key != 4 + (bg & 1)); tab_key = 4 + (bg & 1); }
    }
}

constexpr size_t WS_BAR = 72 * 1024;
#define RLX_AGENT __ATOMIC_RELAXED, __HIP_MEMORY_SCOPE_AGENT
#define XB_TMO      128
#define XB_XCNT(j)  (256  + 64 * (j))
#define XB_XSUB(j)  (1280 + 64 * (j))
#define XB_XGEN(j)  (2304 + 64 * (j))
#define XB_TOP      3328
#define XB_TOPGEN   3392
#define XCD_BAR_WORDS 3456
#define XB_SPIN_CAP (1u << 18)

__device__ __forceinline__ unsigned xb_ld(unsigned* p)              { return __hip_atomic_load(p, __ATOMIC_RELAXED, __HIP_MEMORY_SCOPE_AGENT); }
__device__ __forceinline__ unsigned xb_add(unsigned* p, unsigned v) { return __hip_atomic_fetch_add(p, v, __ATOMIC_RELAXED, __HIP_MEMORY_SCOPE_AGENT); }
__device__ __forceinline__ unsigned xb_xcc_id() { return (unsigned)__builtin_amdgcn_s_getreg((3 << 11) | 20) & 0xFu; }
#define XB_SPIN(cond, bar) do { unsigned _sp = 0; while (cond) { __builtin_amdgcn_s_sleep(1); \
    if ((++_sp & 255u) == 0u) { if (xb_ld(&(bar)[XB_TMO])) break; if (_sp > XB_SPIN_CAP) { atomicAdd(&(bar)[XB_TMO], 1u); break; } } } } while (0)

struct XcdBarrier {
    unsigned* bar; unsigned x;
    volatile LAS unsigned* st;
};

__device__ __forceinline__ XcdBarrier xcd_barrier_post(unsigned* bar, volatile LAS unsigned* st) {
    XcdBarrier b; b.bar = bar; b.x = xb_xcc_id(); b.st = st;
    if (threadIdx.x == 0) (void)xb_add(&bar[XB_XCNT(b.x)], 1u);
    return b;
}
__device__ __forceinline__ void xcd_barrier_complete(unsigned* bar, unsigned x, unsigned& nloc, unsigned& nx) {
    const unsigned G = gridDim.x * gridDim.y * gridDim.z;
    unsigned sum, cnt, mine, sp = 0u;
    for (;;) {
        sum = 0u; cnt = 0u; mine = 0u;
#pragma unroll
        for (unsigned j = 0; j < 16; ++j) { const unsigned c = xb_ld(&bar[XB_XCNT(j)]); sum += c; cnt += (c > 0u) ? 1u : 0u; mine = (j == x) ? c : mine; }
        if (sum == G) break;
        __builtin_amdgcn_s_sleep(1);
        if ((++sp & 255u) == 0u) { if (xb_ld(&bar[XB_TMO])) break; if (sp > XB_SPIN_CAP) { atomicAdd(&bar[XB_TMO], 1u); break; } }
    }
    nloc = mine > 0u ? mine : 1u; nx = cnt > 0u ? cnt : 1u;
}

__device__ __forceinline__ void xcd_barrier(const XcdBarrier& b) {
    asm volatile("s_waitcnt vmcnt(0)" ::: "memory");
    __syncthreads();
    if (threadIdx.x == 0) {
        unsigned* bar = b.bar;
        __builtin_amdgcn_s_waitcnt(0);
        unsigned nloc = b.st[0], nx = b.st[1];
        if (nloc == 0u) { xcd_barrier_complete(bar, b.x, nloc, nx); b.st[0] = nloc; b.st[1] = nx; }
        const unsigned old = xb_add(&bar[XB_XSUB(b.x)], 1u);
        const unsigned gen = old / nloc;
        if (old + 1u == (gen + 1u) * nloc) {
            __builtin_amdgcn_fence(__ATOMIC_RELEASE, "agent");
            asm volatile("s_waitcnt vmcnt(0)" ::: "memory");
            const unsigned og = xb_add(&bar[XB_TOP], 1u);
            const unsigned tg = og / nx;
            if (og + 1u == (tg + 1u) * nx) xb_add(&bar[XB_TOPGEN], 1u);
            else XB_SPIN(xb_ld(&bar[XB_TOPGEN]) == tg, bar);
            __builtin_amdgcn_fence(__ATOMIC_ACQUIRE, "agent");
            xb_add(&bar[XB_XGEN(b.x)], 1u);
            asm volatile("s_waitcnt vmcnt(0)" ::: "memory");
        } else {
            XB_SPIN(xb_ld(&bar[XB_XGEN(b.x)]) == gen, bar);
            __builtin_amdgcn_fence(__ATOMIC_ACQUIRE, "agent");
            asm volatile("s_waitcnt vmcnt(0)" ::: "memory");
        }
    }
    __syncthreads();
}

__global__ void __launch_bounds__(NTHR, 2) hybrid_fwd(Params P) {
    extern __shared__ __attribute__((aligned(16))) unsigned char lds_raw[];
    LAS unsigned char* lds = (LAS unsigned char*)lds_raw;
    cg::grid_group grid = cg::this_grid();
#define GSYNC() do { XcdBarrier xb_; xb_.bar = (unsigned*)(WSP + WS_BAR); xb_.x = xb_xcc_id(); xb_.st = (volatile LAS unsigned*)(lds + L_PTAB + 384); xcd_barrier(xb_); } while (0)
    if (threadIdx.x == 0) {
        LAS unsigned long long* pt = (LAS unsigned long long*)(lds + L_PTAB);
#pragma unroll
        for (int i = 0; i < 30; ++i) pt[i] = (unsigned long long)P.in[i];
        pt[30] = (unsigned long long)P.out; pt[31] = (unsigned long long)P.ws;
        *(LAS unsigned*)(lds + L_PTAB + 384) = 0u; *(LAS unsigned*)(lds + L_PTAB + 388) = 0u;
    }
    __syncthreads();
    (void)xcd_barrier_post((unsigned*)(WSP + WS_BAR), (volatile LAS unsigned*)(lds + L_PTAB + 384));
    const int G = gridDim.x, bx = blockIdx.x;
#define ws WSP
#define XN ((bf16_t*)(WSP + WS_XN))
#define HID ((bf16_t*)(WSP + WS_HID))
#define MERGED ((bf16_t*)(WSP + WS_MERGED))
#define XB ((bf16_t*)OUTP)
#define XS ((bf16_t*)(WSP + WS_Z + 192 * MiB))
#define SSP ((float*)(WSP + WS_SS))

#if defined(PROBE_PHASE)
    int n_stamp = 0;
#define STAMP() do { if (blockIdx.x == 0 && threadIdx.x == 0) ((LAS unsigned long long*)(lds + L_PTAB + 512))[n_stamp] = __builtin_amdgcn_s_memrealtime(); ++n_stamp; } while (0)
#else
#define STAMP() do {} while (0)
#endif
    if (P.out == nullptr) grid.sync();
    STAMP();
    prologue(P, lds);
    xprep_phase(INP(0), (bf16_t*)OUTP, (float*)(WSP + WS_SS));
#if defined(DUP_PRO)
    prologue(P, lds);
#endif
    GSYNC(); STAMP();
#pragma unroll
    for (int l = 0; l < DEPTH; ++l) {
        const float* xin = (l == 0) ? INP(0) : OUTP;
        { pg8::Gemm g{XB, (const bf16_t*)(ws + WS_W13 + (size_t)(l * 2 + 0) * W13_SZ), MTOK, 5632, DM}; pg8::StaticOrder S; S.init(MTOK, 5632, G, bx);
          EpiSwiGLU E{{SSP}, HID}; pg8::gemm_phase<EpiSwiGLU, pg8::StaticOrder, true, true>(lds, g, S, E);
#if defined(DUP_G1)
          pg8::gemm_phase<EpiSwiGLU, pg8::StaticOrder, true, true>(lds, g, S, E);
#endif
        }
        GSYNC(); STAMP();
        { pg8::Gemm g{HID, (const bf16_t*)(ws + WS_W2 + (size_t)(l * 2 + 0) * W2_SZ), MTOK, DM, DFF}; pg8::StaticOrder S; S.init(MTOK, DM, G, bx);
          if (l == 0) { EpiResidT<true, false> E{xin, XB, 0.5f, SSP}; pg8::gemm_phase<EpiResidT<true, false>, pg8::StaticOrder, true, true>(lds, g, S, E); }
          else { EpiResidT<false, false> E{XB, XB, 0.5f, SSP}; pg8::gemm_phase<EpiResidT<false, false>, pg8::StaticOrder, true, true>(lds, g, S, E); } }
        GSYNC(); STAMP();
#if defined(STOP_AFTER) && STOP_AFTER == 1
        return;
#endif
        { pg8::Gemm g{XB, (const bf16_t*)(ws + WS_WIN + (size_t)l * WIN_SZ), MTOK, 5120, DM}; pg8::StaticOrder S; S.init(MTOK, 5120, G, bx);
          EpiZ E{{SSP}, ws, INP(14) + l * 64, INP(15) + l * 64, INP(21) + l * 64, INP(22) + l * 192}; pg8::gemm_phase<EpiZ, pg8::StaticOrder, true, true>(lds, g, S, E);
#if defined(DUP_G3)
          pg8::gemm_phase<EpiZ, pg8::StaticOrder, true, true>(lds, g, S, E);
#endif
        }
        GSYNC(); STAMP();
#if defined(DUMP_Z)
        { const unsigned short* z = (const unsigned short*)(WSP + WS_Z); float* o = OUTP;
          for (size_t i = (size_t)blockIdx.x * NTHR + threadIdx.x; i < (size_t)MTOK * DM; i += (size_t)gridDim.x * NTHR) {
              unsigned v = (unsigned)z[i * 4 + (i & 3)] << 16; if ((v & 0x7f800000u) == 0x7f800000u) v = 0u; o[i] = __builtin_bit_cast(float, v); }
          return; }
#endif
        compress_phase(P, l, lds);
#if defined(DUP_CMP)
        for (int rep_ = 0; rep_ < 4; ++rep_) compress_phase(P, l, lds);
#endif
        GSYNC(); STAMP();
        attention_phase(P, l, lds);
#if defined(DUP_ATT)
        attention_phase(P, l, lds);
#endif
        GSYNC(); STAMP();
        { pg8::Gemm g{XN, (const bf16_t*)(ws + WS_PAB + (size_t)l * PAB_SZ), MTOK, 2048, DM}; pg8::StaticOrder S; S.init(MTOK, 2048, G, bx);
          EpiMerge E{(const bf16_t*)(ws + Z_MG), MERGED}; pg8::gemm_phase<EpiMerge, pg8::StaticOrder, true, true>(lds, g, S, E); }
        GSYNC(); STAMP();
        { pg8::Gemm g{MERGED, (const bf16_t*)(ws + WS_WO + (size_t)l * WO_SZ), MTOK, DM, DM}; pg8::StaticOrder S; S.init(MTOK, DM, G, bx);
          EpiResidT<false, false> E{XB, (l + 1 < DEPTH) ? XB : XS, 1.0f, SSP}; pg8::gemm_phase<EpiResidT<false, false>, pg8::StaticOrder, true, true>(lds, g, S, E); }
        GSYNC(); STAMP();
#if defined(STOP_AFTER) && STOP_AFTER == 2
        return;
#endif
        { pg8::Gemm g{(l + 1 < DEPTH) ? XB : XS, (const bf16_t*)(ws + WS_W13 + (size_t)(l * 2 + 1) * W13_SZ), MTOK, 5632, DM}; pg8::StaticOrder S; S.init(MTOK, 5632, G, bx);
          EpiSwiGLU E{{SSP}, HID}; pg8::gemm_phase<EpiSwiGLU, pg8::StaticOrder, true, true>(lds, g, S, E); }
        GSYNC(); STAMP();
        { pg8::Gemm g{HID, (const bf16_t*)(ws + WS_W2 + (size_t)(l * 2 + 1) * W2_SZ), MTOK, DM, DFF}; pg8::StaticOrder S; S.init(MTOK, DM, G, bx);
          if (l + 1 < DEPTH) { EpiResidT<false, false> E{XB, XB, 0.5f, SSP}; pg8::gemm_phase<EpiResidT<false, false>, pg8::StaticOrder, true, true>(lds, g, S, E); }
          else { EpiResidT<false, true> E{XS, OUTP, 0.5f, nullptr}; pg8::gemm_phase<EpiResidT<false, true>, pg8::StaticOrder, true, true>(lds, g, S, E); } }
        if (l + 1 < DEPTH) { GSYNC(); STAMP(); }
    }
#if defined(PROBE_PHASE)
    GSYNC(); STAMP();
    if (blockIdx.x == 0 && threadIdx.x == 0) { const LAS unsigned long long* t = (const LAS unsigned long long*)(lds + L_PTAB + 512); const float ns = (float)(t[PROBE_PHASE + 1] - t[PROBE_PHASE]) * 10.0f; OUTP[0] = exp2f(rintf(log2f(ns) * 4.f) * 0.25f); }
#endif
#undef ws
#undef XN
#undef HID
#undef MERGED
#undef XB
#undef XS
#undef SSP
}

extern "C" void kernel_launch(void* const* d_in, const int* in_sizes, int n_in, void* d_out, int out_size, void* d_ws, size_t ws_size, hipStream_t stream) {
    static int grid = 0;
    if (grid == 0) {
        if (n_in != 30 || out_size != MTOK * DM || ws_size < WS_END) { fprintf(stderr, "kernel_launch: unexpected problem (n_in %d out %d ws %zu, need %zu)\n", n_in, out_size, ws_size, (size_t)WS_END); grid = -1; return; }
        int dev = 0, cus = 0, per_cu = 0;
        (void)hipGetDevice(&dev);
        (void)hipDeviceGetAttribute(&cus, hipDeviceAttributeMultiprocessorCount, dev);
        if (hipFuncSetAttribute((const void*)hybrid_fwd, hipFuncAttributeMaxDynamicSharedMemorySize, LDS_BYTES) != hipSuccess) { fprintf(stderr, "kernel_launch: hipFuncSetAttribute failed\n"); grid = -1; return; }
        if (hipOccupancyMaxActiveBlocksPerMultiprocessor(&per_cu, (const void*)hybrid_fwd, NTHR, LDS_BYTES) != hipSuccess || per_cu < 1) { fprintf(stderr, "kernel_launch: occupancy query gave %d\n", per_cu); per_cu = 1; }
        (void)hipGetLastError();
        grid = cus * (per_cu > 1 ? 1 : per_cu);
        if (grid <= 0) grid = 256;
    }
    if (grid < 0) return;
    Params p{};
    for (int i = 0; i < 30; ++i) p.in[i] = (const float*)d_in[i];
    p.out = (float*)d_out; p.ws = (unsigned char*)d_ws;
    (void)hipMemsetAsync((unsigned char*)d_ws + WS_BAR, 0, 16384, stream);
    void* args[] = {&p};
    hipError_t e = hipLaunchCooperativeKernel((const void*)hybrid_fwd, dim3(grid), dim3(NTHR), args, LDS_BYTES, stream);
    if (e != hipSuccess) fprintf(stderr, "cooperative launch failed: %s (grid %d)\n", hipGetErrorString(e), grid);
}
```

```cpp
#include <hip/hip_runtime.h>
#include <hip/hip_cooperative_groups.h>
#include <cstdio>
#include <cstdint>
namespace cg = cooperative_groups;
namespace pg8 {
#define PG8_LAS __attribute__((address_space(3)))
typedef unsigned short bf16_t;
typedef short bf16x8 __attribute__((ext_vector_type(8)));
typedef float f32x4 __attribute__((ext_vector_type(4)));
typedef unsigned u32x4 __attribute__((ext_vector_type(4)));
constexpr int BM = 256, BK = 64, HALF = 128, HTB = HALF * BK * 2  , STAGE_BYTES = 8 * HTB, NXCD = 8, WGM = 8;

__host__ __device__ __forceinline__ int lds_byte(int r, int c) { const int st = (r >> 4) * 2 + (c >> 5), rr = r & 15, cc = c & 31, ob = rr * 64 + cc * 2; return st * 1024 + (ob ^ (((ob >> 9) & 1) << 5)); }
__host__ __device__ __forceinline__ void stage_rc(int b, int& R, int& C) { const int st = b / 1024, sb = b % 1024, swz = sb ^ (((sb >> 9) & 1) << 5); R = (st >> 1) * 16 + swz / 64; C = (st & 1) * 32 + (swz % 64) / 2; }
__host__ __device__ __forceinline__ int perm32(int rho) { const int n = rho >> 4, i = rho & 15; return 8 * (i >> 2) + 4 * n + (i & 3); }

struct Unit { int pm, pn; };
struct Gemm { const bf16_t* A; const bf16_t* Bt; int M, N, K; };

struct StaticOrder {
    int nM, nN, nwg, G, c;
    __host__ __device__ void init(int M, int N, int G_, int c_) { nM = M / BM; nN = N / BM; nwg = nM * nN; G = G_; c = c_; }
    __host__ __device__ bool next(int i, Unit& u) const {
        const long L = (long)i * G + c; if (L >= nwg) return false;
        int wgid = (int)L; { const int q = nwg / NXCD, r = nwg % NXCD, xcd = wgid % NXCD, off = wgid / NXCD; wgid = (xcd < r ? xcd * (q + 1) : r * (q + 1) + (xcd - r) * q) + off; }
        const int nig = WGM * nN, gid = wgid / nig, fm = gid * WGM, gsz = (nM - fm) < WGM ? (nM - fm) : WGM;
        u.pm = fm + ((wgid % nig) % gsz); u.pn = (wgid % nig) / gsz; return true;
    }
    __device__ __forceinline__ void a_ready(const Unit&) const {}
    __device__ __forceinline__ void done(const Unit&) const {}
};

typedef float f32x2_t __attribute__((ext_vector_type(2))); typedef __bf16 bf16x2_t __attribute__((ext_vector_type(2)));
__device__ __forceinline__ unsigned cvt_pk_bf16(float lo, float hi) { f32x2_t v = {lo, hi}; bf16x2_t b = __builtin_convertvector(v, bf16x2_t); return __builtin_bit_cast(unsigned, b); }
template <class Epi, class Sched, bool ALIGN_EPI = false, bool SP2 = false>
__device__ __forceinline__ void gemm_phase(PG8_LAS unsigned char* lds, const Gemm g, const Sched& S, const Epi& E) {
    int tid_ = threadIdx.x; asm volatile("" : "+v"(tid_)); const int tid = tid_, wid = __builtin_amdgcn_readfirstlane(tid >> 6), lane = tid & 63, wr = wid >> 2, wc = wid & 3, fr = lane & 15, fq = lane >> 4;
    const int K = g.K, nt = K / BK;
    unsigned voffA[2], voffB[2];
#pragma unroll
    for (int i = 0; i < 2; ++i) { int R, C; stage_rc(tid * 16 + i * 8192, R, C); const int Rb = Epi::PERM ? ((R & ~31) + perm32(R & 31)) : R;
        voffA[i] = (unsigned)(R * K + C) * 2u; voffB[i] = (unsigned)(Rb * K + C) * 2u; }
    const size_t kstep = (size_t)(BK * 2);
    const size_t hstep = (size_t)HALF * K * 2;
    const size_t tstep = 2 * hstep;
    const unsigned ldsw = (unsigned)wid * 1024u;
    const int aoff = lds_byte(wr * 64 + fr, fq * 8), boff = lds_byte(wc * 32 + fr, fq * 8);
#define PG8_SA(b, h) (((b) * 2 + (h)) * HTB)
#define PG8_SB(b, h) ((4 + (b) * 2 + (h)) * HTB)
#define PG8_STAGE(bufoff, gbase, voff) do { _Pragma("unroll") for (int _i = 0; _i < 2; ++_i) \
        __builtin_amdgcn_global_load_lds((const unsigned*)((const char*)(gbase) + (voff)[_i]), (PG8_LAS unsigned*)(lds + (bufoff) + ldsw + _i * 8192), 16, 0, 0); } while (0)
#define PG8_LDA(dst, b, h) do { _Pragma("unroll") for (int m = 0; m < 4; ++m) _Pragma("unroll") for (int k = 0; k < 2; ++k) dst[m][k] = *(const PG8_LAS bf16x8*)(lds + PG8_SA(b, h) + aoff + m * 2048 + k * 1024); } while (0)
#define PG8_LDB(dst, b, h) do { _Pragma("unroll") for (int n = 0; n < 2; ++n) _Pragma("unroll") for (int k = 0; k < 2; ++k) dst[n][k] = *(const PG8_LAS bf16x8*)(lds + PG8_SB(b, h) + boff + n * 2048 + k * 1024); } while (0)
#define PG8_MMA(ai, bj, At, Bt) do { __builtin_amdgcn_s_setprio(1); _Pragma("unroll") for (int m = 0; m < 4; ++m) _Pragma("unroll") for (int n = 0; n < 2; ++n) _Pragma("unroll") for (int k = 0; k < 2; ++k) \
        acc[ai][bj][m][n] = __builtin_amdgcn_mfma_f32_16x16x32_bf16(Bt[n][k], At[m][k], acc[ai][bj][m][n], 0, 0, 0); __builtin_amdgcn_s_setprio(0); } while (0)
#define PG8_WAIT_V(n) asm volatile("s_waitcnt vmcnt(" #n ")" ::: "memory")
#define PG8_WAIT_L(n) asm volatile("s_waitcnt lgkmcnt(" #n ")" ::: "memory")
#define PG8_BAR __builtin_amdgcn_s_barrier()
#define PG8_SCHED __builtin_amdgcn_sched_barrier(0)
    Unit cur, nxt; int ui = 0;
    if (!S.next(0, cur)) return;
    f32x4 acc[2][2][4][2];
#pragma unroll
    for (int a = 0; a < 2; ++a)
#pragma unroll
        for (int b = 0; b < 2; ++b)
#pragma unroll
            for (int m = 0; m < 4; ++m)
#pragma unroll
                for (int n = 0; n < 2; ++n) acc[a][b][m][n] = (f32x4){0.f, 0.f, 0.f, 0.f};
    bf16x8 At[4][2], B0[2][2], B1[2][2];
    const char* cA = (const char*)g.A + (size_t)cur.pm * tstep; const char* cB = (const char*)g.Bt + (size_t)cur.pn * tstep;
    S.a_ready(cur);
    if constexpr (Epi::ROWSCALE) {
        int pmB = -1, pmC = -1, pmD = -1; Unit uu;
        for (int i = 1; S.next(i, uu); ++i) if (uu.pm != cur.pm && uu.pm != pmB && uu.pm != pmC && uu.pm != pmD) { if (pmB < 0) pmB = uu.pm; else if (pmC < 0) pmC = uu.pm; else if (pmD < 0) pmD = uu.pm; }
        f32x4 a0, b0, a1, b1, a2, b2, a3, b3; Unit t0 = cur, t1 = cur, t2 = cur, t3 = cur; t1.pm = pmB < 0 ? cur.pm : pmB; t2.pm = pmC < 0 ? cur.pm : pmC; t3.pm = pmD < 0 ? cur.pm : pmD;
        E.rs_issue(t0, tid, a0, b0); E.rs_issue(t1, tid, a1, b1); E.rs_issue(t2, tid, a2, b2); E.rs_issue(t3, tid, a3, b3);
        E.rs_write(tid, a3, b3, (PG8_LAS float*)(lds + STAGE_BYTES + ((t3.pm >> 3) & 3) * 1024));
        E.rs_write(tid, a2, b2, (PG8_LAS float*)(lds + STAGE_BYTES + ((t2.pm >> 3) & 3) * 1024));
        E.rs_write(tid, a1, b1, (PG8_LAS float*)(lds + STAGE_BYTES + ((t1.pm >> 3) & 3) * 1024));
        E.rs_write(tid, a0, b0, (PG8_LAS float*)(lds + STAGE_BYTES + ((t0.pm >> 3) & 3) * 1024));
    }
    if constexpr (SP2) {
        PG8_STAGE(PG8_SB(0, 0), cB, voffB); PG8_STAGE(PG8_SB(0, 1), cB + hstep, voffB); PG8_STAGE(PG8_SA(0, 0), cA, voffA); PG8_STAGE(PG8_SA(0, 1), cA + hstep, voffA);
        if (wr == 1) PG8_BAR;
        PG8_WAIT_V(2); PG8_BAR;
        PG8_STAGE(PG8_SB(1, 0), cB + kstep, voffB); PG8_STAGE(PG8_SA(1, 0), cA + kstep, voffA); PG8_STAGE(PG8_SB(1, 1), cB + hstep + kstep, voffB);
        PG8_WAIT_V(6); PG8_BAR;
    } else {
        PG8_STAGE(PG8_SB(0, 0), cB, voffB); PG8_STAGE(PG8_SA(0, 0), cA, voffA); PG8_STAGE(PG8_SB(0, 1), cB + hstep, voffB); PG8_STAGE(PG8_SA(0, 1), cA + hstep, voffA);
        if (wr == 1) PG8_BAR;
        PG8_WAIT_V(4); PG8_BAR;
        PG8_STAGE(PG8_SB(1, 0), cB + kstep, voffB); PG8_STAGE(PG8_SA(1, 0), cA + kstep, voffA); PG8_STAGE(PG8_SB(1, 1), cB + hstep + kstep, voffB);
        PG8_WAIT_V(6); PG8_BAR;
    }
    for (;;) {
        const bool has_next = S.next(ui + 1, nxt);
        const char* nA = has_next ? (const char*)g.A + (size_t)nxt.pm * tstep : cA; const char* nB = has_next ? (const char*)g.Bt + (size_t)nxt.pn * tstep : cB;
        for (int t = 0; t < nt; t += 2) {
            const bool last = (t == nt - 2);
            const char* a1 = cA + (size_t)(t + 1) * kstep;
            const char* a2 = last ? nA : cA + (size_t)(t + 2) * kstep; const char* b2 = last ? nB : cB + (size_t)(t + 2) * kstep;
            const char* a3 = a2 + kstep; const char* b3 = b2 + kstep;
            if (last && has_next) S.a_ready(nxt);
            if constexpr (SP2) {
            PG8_LDB(B0, 0, 0); PG8_LDB(B1, 0, 1); PG8_SCHED; PG8_LDA(At, 0, 0); PG8_STAGE(PG8_SA(1, 1), a1 + hstep, voffA);
            PG8_WAIT_V(8); PG8_WAIT_L(0); PG8_BAR; PG8_MMA(0, 0, At, B0); PG8_MMA(0, 1, At, B1); PG8_BAR; PG8_SCHED;
            PG8_LDA(At, 0, 1); PG8_STAGE(PG8_SB(0, 0), b2, voffB); PG8_STAGE(PG8_SB(0, 1), b2 + hstep, voffB); PG8_STAGE(PG8_SA(0, 0), a2, voffA);
            PG8_WAIT_V(8); PG8_WAIT_L(0); PG8_BAR; PG8_MMA(1, 0, At, B0); PG8_MMA(1, 1, At, B1); PG8_BAR; PG8_SCHED;
            PG8_LDB(B0, 1, 0); PG8_LDB(B1, 1, 1); PG8_SCHED; PG8_LDA(At, 1, 0); PG8_STAGE(PG8_SA(0, 1), a2 + hstep, voffA);
            PG8_WAIT_V(8); PG8_WAIT_L(0); PG8_BAR; PG8_MMA(0, 0, At, B0); PG8_MMA(0, 1, At, B1); PG8_BAR; PG8_SCHED;
            PG8_LDA(At, 1, 1); PG8_STAGE(PG8_SB(1, 0), b3, voffB); PG8_STAGE(PG8_SB(1, 1), b3 + hstep, voffB); PG8_STAGE(PG8_SA(1, 0), a3, voffA);
            PG8_WAIT_V(8); PG8_WAIT_L(0); PG8_BAR; PG8_MMA(1, 0, At, B0); PG8_MMA(1, 1, At, B1); PG8_BAR; PG8_SCHED;
            } else {
            PG8_LDB(B0, 0, 0); PG8_SCHED; PG8_LDA(At, 0, 0); PG8_STAGE(PG8_SA(1, 1), a1 + hstep, voffA);
            PG8_WAIT_L(8); PG8_BAR; PG8_WAIT_L(0); PG8_MMA(0, 0, At, B0); PG8_BAR; PG8_SCHED;
            PG8_LDB(B1, 0, 1); PG8_STAGE(PG8_SB(0, 0), b2, voffB);
            PG8_BAR; PG8_WAIT_L(0); PG8_MMA(0, 1, At, B1); PG8_BAR;
            PG8_LDA(At, 0, 1); PG8_STAGE(PG8_SA(0, 0), a2, voffA);
            PG8_BAR; PG8_WAIT_L(0); PG8_MMA(1, 0, At, B0); PG8_BAR; PG8_SCHED;
            PG8_STAGE(PG8_SB(0, 1), b2 + hstep, voffB);
            PG8_WAIT_V(6); PG8_BAR; PG8_MMA(1, 1, At, B1); PG8_BAR;
            PG8_LDB(B0, 1, 0); PG8_SCHED; PG8_LDA(At, 1, 0); PG8_STAGE(PG8_SA(0, 1), a2 + hstep, voffA);
            PG8_WAIT_L(8); PG8_BAR; PG8_WAIT_L(0); PG8_MMA(0, 0, At, B0); PG8_BAR; PG8_SCHED;
            PG8_LDB(B1, 1, 1); PG8_STAGE(PG8_SB(1, 0), b3, voffB);
            PG8_BAR; PG8_WAIT_L(0); PG8_MMA(0, 1, At, B1); PG8_BAR;
            PG8_LDA(At, 1, 1); PG8_STAGE(PG8_SA(1, 0), a3, voffA);
            PG8_BAR; PG8_WAIT_L(0); PG8_MMA(1, 0, At, B0); PG8_BAR; PG8_SCHED;
            PG8_STAGE(PG8_SB(1, 1), b3 + hstep, voffB);
            PG8_WAIT_V(6); PG8_BAR; PG8_MMA(1, 1, At, B1); PG8_BAR;
            }
        }
        if constexpr (ALIGN_EPI) { if (wr == 0) PG8_BAR; }
        if constexpr (!Epi::AFTER_DRAIN) {
            if constexpr (Epi::ROWSCALE) E(acc, cur, wr, wc, fr, fq, (const PG8_LAS float*)(lds + STAGE_BYTES + ((cur.pm >> 3) & 3) * 1024));
            else E(acc, cur, wr, wc, fr, fq);
            S.done(cur); }
        if (!has_next) break;
#pragma unroll
        for (int a = 0; a < 2; ++a)
#pragma unroll
            for (int b = 0; b < 2; ++b)
#pragma unroll
                for (int m = 0; m < 4; ++m)
#pragma unroll
                    for (int n = 0; n < 2; ++n) acc[a][b][m][n] = (f32x4){0.f, 0.f, 0.f, 0.f};
        cur = nxt; cA = nA; cB = nB; ++ui;
        if constexpr (ALIGN_EPI) { if (wr == 1) PG8_BAR; }
    }
    PG8_WAIT_V(0);
    if constexpr (!ALIGN_EPI) { if (wr == 0) PG8_BAR; }
    PG8_BAR;
    if constexpr (Epi::AFTER_DRAIN) { E.fused(acc, cur, wr, wc, fr, fq, lds, wid, lane); S.done(cur); }
#undef PG8_SA
#undef PG8_SB
#undef PG8_STAGE
#undef PG8_LDA
#undef PG8_LDB
#undef PG8_MMA
#undef PG8_WAIT_V
#undef PG8_WAIT_L
#undef PG8_BAR
#undef PG8_SCHED
}
}

#define LAS __attribute__((address_space(3)))
#define GAS __attribute__((address_space(1)))
#define GLD(T, p) (*(const GAS T*)(p))
#define GST(T, p, v) (*(GAS T*)(p) = (v))
typedef unsigned short bf16_t;
typedef short bf16x8 __attribute__((ext_vector_type(8)));
typedef short bf16x4 __attribute__((ext_vector_type(4)));
typedef float f32x4 __attribute__((ext_vector_type(4)));
typedef float f32x16 __attribute__((ext_vector_type(16)));
typedef unsigned u32x4 __attribute__((ext_vector_type(4)));
typedef unsigned u32x2 __attribute__((ext_vector_type(2)));

constexpr int BATCH = 8, SEQ = 4096, DM = 1024, MTOK = BATCH * SEQ, DFF = 2816, DEPTH = 2, NIN = 4888;
constexpr int NTHR = 512, NWAVE = 8;
constexpr float EPS = 1e-6f, LOG2E = 1.4426950408889634f;
constexpr float QSCALE = 0.125f * LOG2E;
constexpr size_t MiB = 1u << 20;
constexpr size_t WS_BIAS = 0;
constexpr size_t WS_PRM = 64 * 1024;
constexpr size_t WS_CB1 = 68 * 1024;
constexpr size_t WS_W13 = 1 * MiB;
constexpr size_t W13_SZ = (size_t)5632 * 1024 * 2;
constexpr size_t WS_W2 = 45 * MiB;
constexpr size_t W2_SZ = (size_t)1024 * 2816 * 2;
constexpr size_t WS_WIN = 68 * MiB;
constexpr size_t WIN_SZ = (size_t)5120 * 1024 * 2;
constexpr size_t WS_PAB = 88 * MiB;
constexpr size_t PAB_SZ = (size_t)2048 * 1024 * 2;
constexpr size_t WS_WO = 96 * MiB;
constexpr size_t WO_SZ = (size_t)1024 * 1024 * 2;
constexpr size_t WS_CW1 = 100 * MiB;
constexpr size_t CW1_SZ = (size_t)128 * 2048 * 2;
constexpr size_t WS_CW2 = 102 * MiB;
constexpr size_t CW2_SZ = (size_t)64 * 128 * 2;
constexpr size_t WS_KCN = 103 * MiB;
constexpr size_t WS_VCT = WS_KCN + 512 * 1024;
constexpr size_t WS_XN = 104 * MiB;
constexpr size_t WS_Z = 168 * MiB;
constexpr size_t Z_DQ = WS_Z, Z_DK = WS_Z + 32 * MiB, Z_DVT = WS_Z + 64 * MiB, Z_NQ = WS_Z + 96 * MiB;
constexpr size_t Z_KCR = WS_Z + 128 * MiB, Z_VCR = WS_Z + 136 * MiB, Z_KSEL = WS_Z + 144 * MiB, Z_VSELT = WS_Z + 152 * MiB;
constexpr size_t Z_KWIN = WS_Z + 160 * MiB, Z_VWINT = WS_Z + 168 * MiB, Z_NG = WS_Z + 176 * MiB, Z_MG = WS_Z + 180 * MiB;
constexpr size_t WS_MERGED = WS_Z;
constexpr size_t WS_HID = WS_Z;
constexpr size_t WS_SS = WS_Z + 308 * MiB;
constexpr size_t WS_END = WS_SS + 2 * MiB;
constexpr int LDS_BYTES = 147456;
constexpr int KP = 144, VP = 136;
constexpr int DA_STAGE = 2 * 64 * KP + 128 * VP;
constexpr int NS_STAGE = 64 * KP + 64 * VP;
constexpr int L_BIAS = 73728;
constexpr int TBN = 1216;
constexpr int L_IMP = L_BIAS + 4 * TBN * 4;
constexpr int L_SEL = L_IMP + 16384;
constexpr int L_WSF = L_SEL + 1024;
constexpr int L_END = L_WSF + 8 * 256;

struct Params {
    const float* in[30];
    float* out;
    unsigned char* ws;
};

constexpr int L_PTAB = LDS_BYTES - 1024;
__device__ __forceinline__ const float* ld_ptr(const LAS unsigned char* lds, int i) {
    unsigned a = L_PTAB + 8 * i; asm volatile("" : "+v"(a));
    const LAS unsigned* t = (const LAS unsigned*)(lds + a);
    const unsigned lo = __builtin_amdgcn_readfirstlane(t[0]), hi = __builtin_amdgcn_readfirstlane(t[1]);
    return (const float*)(((unsigned long long)hi << 32) | lo);
}
#define INP(i) ld_ptr(lds, (i))
#define OUTP ((float*)ld_ptr(lds, 30))
#define WSP ((unsigned char*)ld_ptr(lds, 31))

__device__ __forceinline__ unsigned f2bf(float f) { unsigned u = __builtin_bit_cast(unsigned, f); return (u + 0x7fffu + ((u >> 16) & 1u)) >> 16; }
__device__ __forceinline__ unsigned pk2(float lo, float hi) { return f2bf(lo) | (f2bf(hi) << 16); }
__device__ __forceinline__ float sigmoidf_(float x) { return __builtin_amdgcn_rcpf(1.0f + __builtin_amdgcn_exp2f(-x * LOG2E)); }
__device__ __forceinline__ int otid() { int t = threadIdx.x; asm volatile("" : "+v"(t)); return t; }
__device__ __forceinline__ int crow(int r, int hi) { return (r & 3) + 8 * (r >> 2) + 4 * hi; }


struct RowScale {
    const float* ss;
    __device__ __forceinline__ void rs_issue(const pg8::Unit& u, int tid, f32x4& pa, f32x4& pb) const {
        const float* p = ss + (size_t)(u.pm * 256 + (tid >> 1)) * 16 + (tid & 1) * 8; pa = GLD(f32x4, p); pb = GLD(f32x4, p + 4); }
    __device__ __forceinline__ void rs_write(int tid, const f32x4& pa, const f32x4& pb, LAS float* tab) const {
        float t = ((pa.x + pa.y) + (pa.z + pa.w)) + ((pb.x + pb.y) + (pb.z + pb.w)); t += __shfl_xor(t, 1);
        if (!(tid & 1)) tab[tid >> 1] = __builtin_amdgcn_rsqf(t * (1.f / DM) + EPS); }
};
struct EpiSwiGLU : RowScale {
    static constexpr bool PERM = true, AFTER_DRAIN = false, ROWSCALE = true;
    bf16_t* H;
    __device__ __forceinline__ void operator()(const f32x4 (&acc)[2][2][4][2], const pg8::Unit& u, int wr, int wc, int fr, int fq, const LAS float* rst) const {
        const int row0 = u.pm * 256 + wr * 64 + fr, col = u.pn * 128 + wc * 32 + 8 * fq;
#pragma unroll
        for (int ai = 0; ai < 2; ++ai)
#pragma unroll
            for (int m = 0; m < 4; ++m) {
                float h[8];
                const float rs = rst[ai * 128 + wr * 64 + m * 16 + fr];
#pragma unroll
                for (int n = 0; n < 2; ++n)
#pragma unroll
                    for (int e = 0; e < 4; ++e) { const float g = acc[ai][0][m][n][e] * rs, up = acc[ai][1][m][n][e] * rs; h[n * 4 + e] = g * sigmoidf_(g) * up; }
                u32x4 w; w.x = pg8::cvt_pk_bf16(h[0], h[1]); w.y = pg8::cvt_pk_bf16(h[2], h[3]); w.z = pg8::cvt_pk_bf16(h[4], h[5]); w.w = pg8::cvt_pk_bf16(h[6], h[7]);
                GST(u32x4, H + (size_t)(row0 + ai * 128 + m * 16) * DFF + col, w);
            }
    }
};
template <bool BF32, bool OF32> struct EpiResidT {
    static constexpr bool PERM = false, AFTER_DRAIN = false, ROWSCALE = false;
    const void* base; void* out; float alpha; float* ss;
    __device__ __forceinline__ void operator()(const f32x4 (&acc)[2][2][4][2], const pg8::Unit& u, int wr, int wc, int fr, int fq) const {
        const int row0 = u.pm * 256 + wr * 64 + fr, col0 = u.pn * 256 + wc * 32 + 4 * fq;
#pragma unroll
        for (int ai = 0; ai < 2; ++ai) {
            f32x4 bv[4][2][2];
#pragma unroll
            for (int m = 0; m < 4; ++m) {
                const size_t off = (size_t)(row0 + ai * 128 + m * 16) * DM + col0;
#pragma unroll
                for (int bj = 0; bj < 2; ++bj)
#pragma unroll
                    for (int n = 0; n < 2; ++n) {
                        if (BF32) bv[m][bj][n] = GLD(f32x4, (const float*)base + off + bj * 128 + n * 16);
                        else { const u32x2 w = GLD(u32x2, (const bf16_t*)base + off + bj * 128 + n * 16);
                               bv[m][bj][n] = (f32x4){__builtin_bit_cast(float, w.x << 16), __builtin_bit_cast(float, w.x & 0xffff0000u), __builtin_bit_cast(float, w.y << 16), __builtin_bit_cast(float, w.y & 0xffff0000u)}; }
                    }
            }
#pragma unroll
            for (int m = 0; m < 4; ++m) {
                const int row = row0 + ai * 128 + m * 16;
                const size_t off = (size_t)row * DM + col0;
                float sq = 0.f;
#pragma unroll
                for (int bj = 0; bj < 2; ++bj)
#pragma unroll
                    for (int n = 0; n < 2; ++n) {
                        const f32x4 o = bv[m][bj][n] + acc[ai][bj][m][n] * alpha;
                        sq += (o.x * o.x + o.y * o.y) + (o.z * o.z + o.w * o.w);
                        if (OF32) GST(f32x4, (float*)out + off + bj * 128 + n * 16, o);
                        else { u32x2 w; w.x = pg8::cvt_pk_bf16(o.x, o.y); w.y = pg8::cvt_pk_bf16(o.z, o.w); GST(u32x2, (bf16_t*)out + off + bj * 128 + n * 16, w); }
                    }
                if (!OF32) { sq += __shfl_xor(sq, 16); sq += __shfl_xor(sq, 32); if (fq == 0) GST(float, ss + (size_t)row * 16 + u.pn * 4 + wc, sq); }
            }
        }
    }
};
struct EpiMerge {
    static constexpr bool PERM = true, AFTER_DRAIN = false, ROWSCALE = false;
    const bf16_t* MG; bf16_t* O;
    __device__ __forceinline__ void operator()(const f32x4 (&acc)[2][2][4][2], const pg8::Unit& u, int wr, int wc, int fr, int fq) const {
        const int row0 = u.pm * 256 + wr * 64 + fr, col = u.pn * 128 + wc * 32 + 8 * fq;
#pragma unroll
        for (int ai = 0; ai < 2; ++ai) {
            u32x4 g0[4], g1[4];
#pragma unroll
            for (int m = 0; m < 4; ++m) { const int row = row0 + ai * 128 + m * 16; g0[m] = GLD(u32x4, MG + (size_t)row * 2048 + col); g1[m] = GLD(u32x4, MG + (size_t)row * 2048 + 1024 + col); }
#pragma unroll
            for (int m = 0; m < 4; ++m) {
                const int row = row0 + ai * 128 + m * 16;
                float h[8];
#pragma unroll
                for (int i = 0; i < 8; ++i) {
                    const unsigned w0 = g0[m][i >> 1], w1 = g1[m][i >> 1];
                    const float a0 = __builtin_bit_cast(float, (i & 1) ? (w0 & 0xffff0000u) : (w0 << 16)), a1 = __builtin_bit_cast(float, (i & 1) ? (w1 & 0xffff0000u) : (w1 << 16));
                    h[i] = a0 * acc[ai][0][m][i >> 2][i & 3] + a1 * acc[ai][1][m][i >> 2][i & 3];
                }
                u32x4 w; w.x = pg8::cvt_pk_bf16(h[0], h[1]); w.y = pg8::cvt_pk_bf16(h[2], h[3]); w.z = pg8::cvt_pk_bf16(h[4], h[5]); w.w = pg8::cvt_pk_bf16(h[6], h[7]);
                GST(u32x4, O + (size_t)row * DM + col, w);
            }
        }
    }
};
struct EpiZ : RowScale {
    static constexpr bool PERM = true, AFTER_DRAIN = false, ROWSCALE = true;
    unsigned char* ws; const float *gq, *gk, *gnq, *gnk;
    __device__ __forceinline__ void operator()(const f32x4 (&acc)[2][2][4][2], const pg8::Unit& u, int wr, int wc, int fr, int fq, const LAS float* rst) const {
        const int ch = 4 * u.pn + wc;
        if (ch >= 77) return;
        const int row0 = u.pm * 256 + wr * 64 + fr;
        int kind, nh = 8, hd = 0, nd = 64, dbase = 0; size_t dst = 0; const float* gain = nullptr; float scale = 1.f;
        if (ch < 8) { kind = 0; dst = Z_DQ; hd = ch; gain = gq; scale = QSCALE; }
        else if (ch < 16) { kind = 0; dst = Z_DK; hd = ch - 8; gain = gk; }
        else if (ch < 24) { kind = 2; dst = Z_DVT; nh = 4; hd = (ch - 16) >> 1; nd = 128; dbase = ((ch - 16) & 1) * 64; }
        else if (ch < 32) { kind = 0; dst = Z_NQ; hd = ch - 24; gain = gnq; scale = QSCALE; }
        else if (ch < 34) { kind = 1; dst = Z_KCR; nh = 2; hd = ch - 32; }
        else if (ch < 36) { kind = 1; dst = Z_VCR; nh = 2; hd = ch - 34; }
        else if (ch < 38) { kind = 0; dst = Z_KSEL; nh = 2; hd = ch - 36; gain = gnk + 64; }
        else if (ch < 40) { kind = 2; dst = Z_VSELT; nh = 2; hd = ch - 38; }
        else if (ch < 42) { kind = 0; dst = Z_KWIN; nh = 2; hd = ch - 40; gain = gnk + 128; }
        else if (ch < 44) { kind = 2; dst = Z_VWINT; nh = 2; hd = ch - 42; }
        else if (ch < 76) { kind = 3; }
        else { kind = 4; }
        if (kind == 0 || kind == 1) {
            float gv[16];
#pragma unroll
            for (int i = 0; i < 16; ++i) gv[i] = (kind == 0) ? gain[(i >> 3) * 32 + 8 * fq + (i & 7)] * scale : 1.f;
#pragma unroll
            for (int ai = 0; ai < 2; ++ai)
#pragma unroll
                for (int m = 0; m < 4; ++m) {
                    const int row = row0 + ai * 128 + m * 16, b = row >> 12, s = row & 4095;
                    float v[16];
                    const float rrs = rst[ai * 128 + wr * 64 + m * 16 + fr];
#pragma unroll
                    for (int i = 0; i < 16; ++i) v[i] = acc[ai][i >> 3][m][(i >> 2) & 1][i & 3] * rrs;
                    float rs = 1.f;
                    if (kind == 0) {
                        float ss = 0.f;
#pragma unroll
                        for (int i = 0; i < 16; ++i) ss += v[i] * v[i];
                        ss += __shfl_xor(ss, 16); ss += __shfl_xor(ss, 32);
                        rs = __builtin_amdgcn_rsqf(ss * (1.f / 64.f) + EPS);
                    }
#pragma unroll
                    for (int i = 0; i < 16; ++i) v[i] *= rs * gv[i];
                    bf16_t* d = (bf16_t*)(ws + dst) + ((size_t)(b * nh + hd) * SEQ + s) * 64 + 8 * fq;
                    u32x4 w0, w1;
                    w0.x = pg8::cvt_pk_bf16(v[0], v[1]); w0.y = pg8::cvt_pk_bf16(v[2], v[3]); w0.z = pg8::cvt_pk_bf16(v[4], v[5]); w0.w = pg8::cvt_pk_bf16(v[6], v[7]);
                    w1.x = pg8::cvt_pk_bf16(v[8], v[9]); w1.y = pg8::cvt_pk_bf16(v[10], v[11]); w1.z = pg8::cvt_pk_bf16(v[12], v[13]); w1.w = pg8::cvt_pk_bf16(v[14], v[15]);
                    GST(u32x4, d, w0); GST(u32x4, d + 32, w1);
                }
        } else if (kind == 2) {
#pragma unroll
            for (int ai = 0; ai < 2; ++ai)
#pragma unroll
                for (int m = 0; m < 4; ++m) {
                    const int row = row0 + ai * 128 + m * 16, b = row >> 12, s = row & 4095;
                    bf16_t* d = (bf16_t*)(ws + dst) + ((size_t)(b * nh + hd) * nd + dbase + 8 * fq) * SEQ + s;
                    const float rrs = rst[ai * 128 + wr * 64 + m * 16 + fr];
#pragma unroll
                    for (int i = 0; i < 16; ++i) GST(bf16_t, d + (size_t)((i >> 3) * 32 + (i & 7)) * SEQ, (bf16_t)f2bf(acc[ai][i >> 3][m][(i >> 2) & 1][i & 3] * rrs));
                }
        } else if (kind == 3) {
            const int col = (ch - 44) * 64 + 8 * fq;
#pragma unroll
            for (int ai = 0; ai < 2; ++ai)
#pragma unroll
                for (int m = 0; m < 4; ++m) {
                    const int row = row0 + ai * 128 + m * 16;
                    float v[16];
                    const float rrs = rst[ai * 128 + wr * 64 + m * 16 + fr];
#pragma unroll
                    for (int i = 0; i < 16; ++i) v[i] = sigmoidf_(acc[ai][i >> 3][m][(i >> 2) & 1][i & 3] * rrs);
                    bf16_t* d = (bf16_t*)(ws + Z_MG) + (size_t)row * 2048 + col;
                    u32x4 w0, w1;
                    w0.x = pg8::cvt_pk_bf16(v[0], v[1]); w0.y = pg8::cvt_pk_bf16(v[2], v[3]); w0.z = pg8::cvt_pk_bf16(v[4], v[5]); w0.w = pg8::cvt_pk_bf16(v[6], v[7]);
                    w1.x = pg8::cvt_pk_bf16(v[8], v[9]); w1.y = pg8::cvt_pk_bf16(v[10], v[11]); w1.z = pg8::cvt_pk_bf16(v[12], v[13]); w1.w = pg8::cvt_pk_bf16(v[14], v[15]);
                    GST(u32x4, d, w0); GST(u32x4, d + 32, w1);
                }
        } else {
            if (fq < 3) {
#pragma unroll
                for (int ai = 0; ai < 2; ++ai)
#pragma unroll
                    for (int m = 0; m < 4; ++m) {
                        const int row = row0 + ai * 128 + m * 16;
                        float* d = (float*)(ws + Z_NG) + (size_t)row * 24 + 8 * fq;
                        const float rrs = rst[ai * 128 + wr * 64 + m * 16 + fr];
#pragma unroll
                        for (int i = 0; i < 8; ++i) GST(float, d + i, sigmoidf_(acc[ai][0][m][i >> 2][i & 3] * rrs));
                    }
            }
        }
    }
};

__device__ __forceinline__ void tr_item(const float* src, int ld, int c0, int nvalid, int k0, bf16_t* dst, int Kdst, LAS float* scr, int lane, const float* rsc = nullptr) {
    const int n = lane & 31;
#pragma unroll
    for (int i = 0; i < 32; ++i) { const int kk = 2 * i + (lane >> 5); scr[kk * 33 + n] = (src && n < nvalid) ? GLD(float, src + (size_t)(k0 + kk) * ld + c0 + n) * (rsc ? GLD(float, rsc + k0 + kk) : 1.f) : 0.f; }
    asm volatile("s_waitcnt lgkmcnt(0)" ::: "memory");
    const int c = lane & 7;
#pragma unroll
    for (int j = 0; j < 4; ++j) { const int nn = (lane >> 3) + 8 * j; const LAS float* s = scr + (8 * c) * 33 + nn;
        u32x4 o; o.x = pk2(s[0 * 33], s[1 * 33]); o.y = pk2(s[2 * 33], s[3 * 33]); o.z = pk2(s[4 * 33], s[5 * 33]); o.w = pk2(s[6 * 33], s[7 * 33]);
        GST(u32x4, dst + (size_t)nn * Kdst + 8 * c, o); }
    asm volatile("s_waitcnt lgkmcnt(0)" ::: "memory");
}
__device__ __forceinline__ int zchunk_src(int ch) {
    if (ch < 32) return ch * 64;
    if (ch < 44) return 2048 + (ch - 32) * 64;
    if (ch < 76) return 2840 + (ch - 44) * 64;
    return 2816;
}
__device__ __forceinline__ int t5_bucket(int n) {
    if (n < 16) return n;
    int b = 16;
    b += (n >= 21); b += (n >= 27); b += (n >= 35); b += (n >= 46); b += (n >= 59); b += (n >= 77); b += (n >= 99); b += (n >= 128);
    b += (n >= 166); b += (n >= 216); b += (n >= 280); b += (n >= 363); b += (n >= 470); b += (n >= 609); b += (n >= 790);
    return b;
}
__device__ __forceinline__ void prologue(const Params& P, LAS unsigned char* lds) {
    const int tid = otid(), lane = tid & 63, wave = tid >> 6;
    LAS float* scr = (LAS float*)(lds + wave * 16384);
    const int gw = blockIdx.x * NWAVE + wave, NGW = gridDim.x * NWAVE;
    unsigned char* ws = WSP;
    constexpr int I13 = 176 * 16, I2 = 32 * 44, IIN = 160 * 16, IPAB = 64 * 16, IWO = 32 * 16, IC1 = 4 * 32, IC2 = 2 * 2;
    constexpr int PER_L = 2 * I13 + 2 * I2 + IIN + IPAB + IWO + 2 * IC1 + 2 * IC2;
    for (int it = gw; it < DEPTH * PER_L; it += NGW) {
        const int l = it / PER_L; int r = it % PER_L;
        if (r < 2 * I13) {
            const int f = r / I13; r %= I13; const int gi = r / 16, kb = r % 16;
            const int t = gi >> 3, bj = (gi >> 2) & 1, sub = gi & 3;
            const float* src = (f ? (bj ? INP(12) : INP(11)) : (bj ? INP(9) : INP(8))) + (size_t)l * DM * DFF;
            tr_item(src, DFF, 128 * t + 32 * sub, 32, 64 * kb, (bf16_t*)(ws + WS_W13 + (size_t)(l * 2 + f) * W13_SZ) + (size_t)(32 * gi) * DM + 64 * kb, DM, scr, lane, (f ? INP(7) : INP(5)) + l * DM);
            continue;
        }
        r -= 2 * I13;
        if (r < 2 * I2) {
            const int f = r / I2; r %= I2; const int gi = r / 44, kb = r % 44;
            const float* src = (f ? INP(13) : INP(10)) + (size_t)l * DFF * DM;
            tr_item(src, DM, 32 * gi, 32, 64 * kb, (bf16_t*)(ws + WS_W2 + (size_t)(l * 2 + f) * W2_SZ) + (size_t)(32 * gi) * DFF + 64 * kb, DFF, scr, lane);
            continue;
        }
        r -= 2 * I2;
        if (r < IIN) {
            const int gi = r / 16, kb = r % 16;
            const int t = gi >> 3, bj = (gi >> 2) & 1, wc = gi & 3, ch = 4 * t + wc;
            int nvalid = 32; if (ch == 76) nvalid = bj ? 0 : 24; if (ch > 76) nvalid = 0;
            const float* src = nvalid ? INP(1) + (size_t)l * DM * NIN : nullptr;
            tr_item(src, NIN, zchunk_src(ch) + 32 * bj, nvalid, 64 * kb, (bf16_t*)(ws + WS_WIN + (size_t)l * WIN_SZ) + (size_t)(32 * gi) * DM + 64 * kb, DM, scr, lane, INP(6) + l * DM);
            continue;
        }
        r -= IIN;
        if (r < IPAB) {
            const int gi = r / 16, kb = r % 16;
            const int t = gi >> 3, bj = (gi >> 2) & 1, sub = gi & 3;
            const float* src = nullptr; int k0 = 0;
            if (bj == 0 && kb < 8) { src = INP(2) + (size_t)l * 512 * DM; k0 = 64 * kb; }
            if (bj == 1 && kb >= 8) { src = INP(3) + (size_t)l * 512 * DM; k0 = 64 * (kb - 8); }
            tr_item(src, DM, 128 * t + 32 * sub, 32, k0, (bf16_t*)(ws + WS_PAB + (size_t)l * PAB_SZ) + (size_t)(32 * gi) * DM + 64 * kb, DM, scr, lane);
            continue;
        }
        r -= IPAB;
        if (r < IWO) {
            const int gi = r / 16, kb = r % 16;
            tr_item(INP(4) + (size_t)l * DM * DM, DM, 32 * gi, 32, 64 * kb, (bf16_t*)(ws + WS_WO + (size_t)l * WO_SZ) + (size_t)(32 * gi) * DM + 64 * kb, DM, scr, lane);
            continue;
        }
        r -= IWO;
        if (r < 2 * IC1) {
            const int kv = r / IC1; r %= IC1; const int gi = r / 32, kb = r % 32;
            tr_item((kv ? INP(27) : INP(24)) + (size_t)l * 2048 * 128, 128, 32 * gi, 32, 64 * kb, (bf16_t*)(ws + WS_CW1 + (size_t)(l * 2 + kv) * CW1_SZ) + (size_t)(32 * gi) * 2048 + 64 * kb, 2048, scr, lane);
            continue;
        }
        r -= 2 * IC1;
        {
            const int kv = r / IC2; r %= IC2; const int gi = r / 2, kb = r % 2;
            tr_item((kv ? INP(28) : INP(25)) + (size_t)l * 128 * 64, 64, 32 * gi, 32, 64 * kb, (bf16_t*)(ws + WS_CW2 + (size_t)(l * 2 + kv) * CW2_SZ) + (size_t)(32 * gi) * 128 + 64 * kb, 128, scr, lane);
        }
    }
    const int gt = blockIdx.x * NTHR + tid, NGT = gridDim.x * NTHR;
    for (int i = gt; i < 12 * 1024; i += NGT) { const int h = i >> 10, d = i & 1023; ((float*)(ws + WS_BIAS))[i] = INP(29)[t5_bucket(d) * 12 + h] * LOG2E; }
    if (blockIdx.x == (gridDim.x > 1 ? 1 : 0) && wave < DEPTH) {
        const int l = wave;
        float a = INP(16)[l * 64 + lane] * INP(17)[l * 64 + lane], b = INP(18)[l * 64 + lane] * INP(19)[l * 64 + lane];
        float mq = fabsf(INP(14)[l * 64 + lane]), mk = fabsf(INP(15)[l * 64 + lane]), mnq = fabsf(INP(21)[l * 64 + lane]);
        float mnk = fmaxf(fmaxf(fabsf(INP(22)[l * 192 + lane]), fabsf(INP(22)[l * 192 + 64 + lane])), fabsf(INP(22)[l * 192 + 128 + lane]));
        float mb = 0.f; for (int i = lane; i < 32 * 12; i += 64) mb = fmaxf(mb, fabsf(INP(29)[i]));
#pragma unroll
        for (int o = 1; o < 64; o <<= 1) { a += __shfl_xor(a, o); b += __shfl_xor(b, o); mq = fmaxf(mq, __shfl_xor(mq, o)); mk = fmaxf(mk, __shfl_xor(mk, o)); mnq = fmaxf(mnq, __shfl_xor(mnq, o)); mnk = fmaxf(mnk, __shfl_xor(mnk, o)); mb = fmaxf(mb, __shfl_xor(mb, o)); }
        if (lane == 0) {
            float* prm = (float*)(ws + WS_PRM) + l * 8;
            const float lam_init = 0.8f - 0.6f * expf(-0.3f * (float)l);
            prm[0] = expf(a) - expf(b) + lam_init;
            prm[1] = (8.f * mq * mk * 1.02f + mb) * LOG2E;
            prm[2] = (8.f * mnq * mnk * 1.02f + mb) * LOG2E;
            prm[3] = 1.0f - lam_init;
        }
    }
    for (int wi = blockIdx.x; wi < 32; wi += gridDim.x) {
        const int lk = wi >> 3, n = (wi & 7) * 16 + (tid & 15), ks = tid >> 4, l = lk >> 1, kv = lk & 1;
        const float* pe = (kv ? INP(26) : INP(23)) + (size_t)l * 2048; const float* w1 = (kv ? INP(27) : INP(24)) + (size_t)l * 2048 * 128;
        float sacc = 0.f;
#pragma unroll 16
        for (int k = 64 * ks; k < 64 * ks + 64; ++k) sacc += GLD(float, pe + k) * GLD(float, w1 + (size_t)k * 128 + n);
        LAS float* red = (LAS float*)lds;
        __syncthreads();
        red[tid] = sacc;
        __syncthreads();
        if (tid < 16) { float t = 0.f; for (int i = 0; i < 32; ++i) t += red[i * 16 + tid]; ((float*)(ws + WS_CB1))[lk * 128 + (wi & 7) * 16 + tid] = t; }
        __syncthreads();
    }
}

template <bool INBF16, bool COPYRAW>
__device__ __forceinline__ void rmsnorm_phase(const void* x, const float* g, bf16_t* o, bf16_t* xraw = nullptr) {
    const int tid = otid(), lane = tid & 63, wave = tid >> 6;
    const int gw = blockIdx.x * NWAVE + wave, NGW = gridDim.x * NWAVE;
    f32x4 gv[4];
#pragma unroll
    for (int j = 0; j < 4; ++j) gv[j] = GLD(f32x4, (const f32x4*)g + lane + 64 * j);
    constexpr int RB = 4;
    for (int m0 = gw; m0 < MTOK; m0 += NGW * RB) {
        f32x4 v[RB][4]; float s[RB];
#pragma unroll
        for (int r = 0; r < RB; ++r) { const int m = m0 + r * NGW; const size_t ro = (size_t)(m < MTOK ? m : m0) * DM;
#pragma unroll
            for (int j = 0; j < 4; ++j) {
                if (!INBF16) v[r][j] = GLD(f32x4, (const f32x4*)((const float*)x + ro) + lane + 64 * j);
                else { const u32x2 w = GLD(u32x2, (const u32x2*)((const bf16_t*)x + ro) + lane + 64 * j);
                       if (COPYRAW && m < MTOK) GST(u32x2, (u32x2*)(xraw + ro) + lane + 64 * j, w);
                       v[r][j] = (f32x4){__builtin_bit_cast(float, w.x << 16), __builtin_bit_cast(float, w.x & 0xffff0000u), __builtin_bit_cast(float, w.y << 16), __builtin_bit_cast(float, w.y & 0xffff0000u)}; }
            } }
#pragma unroll
        for (int r = 0; r < RB; ++r) { s[r] = 0.f;
#pragma unroll
            for (int j = 0; j < 4; ++j) s[r] += (v[r][j].x * v[r][j].x + v[r][j].y * v[r][j].y) + (v[r][j].z * v[r][j].z + v[r][j].w * v[r][j].w); }
#pragma unroll
        for (int of = 1; of < 64; of <<= 1) {
#pragma unroll
            for (int r = 0; r < RB; ++r) s[r] += __shfl_xor(s[r], of); }
#pragma unroll
        for (int r = 0; r < RB; ++r) { const int m = m0 + r * NGW;
            if (m < MTOK) {
                const float rs = __builtin_amdgcn_rsqf(s[r] * (1.f / DM) + EPS);
                u32x2* o8 = (u32x2*)(o + (size_t)m * DM) + lane;
#pragma unroll
                for (int j = 0; j < 4; ++j) { u32x2 w; w.x = pk2(v[r][j].x * rs * gv[j].x, v[r][j].y * rs * gv[j].y); w.y = pk2(v[r][j].z * rs * gv[j].z, v[r][j].w * rs * gv[j].w); GST(u32x2, o8 + 64 * j, w); }
            }
        }
    }
}

__device__ __forceinline__ void xprep_phase(const float* x, bf16_t* o, float* ss) {
    const int tid = otid(), lane = tid & 63, wave = tid >> 6;
    const int gw = blockIdx.x * NWAVE + wave, NGW = gridDim.x * NWAVE;
    for (int m = gw; m < MTOK; m += NGW) {
        const f32x4* xr = (const f32x4*)(x + (size_t)m * DM) + lane;
        f32x4 v[4]; float s = 0.f;
#pragma unroll
        for (int j = 0; j < 4; ++j) { v[j] = GLD(f32x4, xr + 64 * j); s += (v[j].x * v[j].x + v[j].y * v[j].y) + (v[j].z * v[j].z + v[j].w * v[j].w); }
#pragma unroll
        for (int of = 1; of < 64; of <<= 1) s += __shfl_xor(s, of);
        u32x2* o8 = (u32x2*)(o + (size_t)m * DM) + lane;
#pragma unroll
        for (int j = 0; j < 4; ++j) { u32x2 w; w.x = pk2(v[j].x, v[j].y); w.y = pk2(v[j].z, v[j].w); GST(u32x2, o8 + 64 * j, w); }
        if (lane < 16) GST(float, ss + (size_t)m * 16 + lane, lane == 0 ? s : 0.f);
    }
}

__device__ __forceinline__ float gelu_tanh(float x) {
    const float y = 0.7978845608028654f * (x + 0.044715f * x * x * x);
    const float e = __builtin_amdgcn_exp2f(2.f * LOG2E * y);
    const float t = 1.f - 2.f * __builtin_amdgcn_rcpf(e + 1.f);
    return 0.5f * x * (1.f + t);
}
__device__ __forceinline__ void compress_phase(const Params& P, int l, LAS unsigned char* lds) {
    const int tid = otid(), lane = tid & 63, wave = tid >> 6, fr = lane & 15, kq = lane >> 4;
    unsigned char* ws = WSP;
    LAS bf16_t* Hs = (LAS bf16_t*)lds;
    LAS float* Os = (LAS float*)(lds + 8192);
    for (int unit = blockIdx.x; unit < 2 * 16 * 16; unit += gridDim.x) {
        const int kv = unit >> 8, bg = (unit >> 4) & 15, cblk = unit & 15, c0 = 16 * cblk;
        const bf16_t* src = (const bf16_t*)(ws + (kv ? Z_VCR : Z_KCR)) + (size_t)bg * SEQ * 64;
        const int crow_ = (c0 + fr) < 255 ? (c0 + fr) : 254;
        const bf16_t* ap = src + (size_t)1024 * crow_ + 8 * kq;
        const bf16_t* bp = (const bf16_t*)(ws + WS_CW1 + (size_t)(l * 2 + kv) * CW1_SZ) + (size_t)(16 * wave + fr) * 2048 + 8 * kq;
        f32x4 acc = {0.f, 0.f, 0.f, 0.f};
#pragma unroll 8
        for (int kk = 0; kk < 64; ++kk) { const bf16x8 a = GLD(bf16x8, ap + 32 * kk), b = GLD(bf16x8, bp + 32 * kk); acc = __builtin_amdgcn_mfma_f32_16x16x32_bf16(a, b, acc, 0, 0, 0); }
        const float cb = ((const float*)(ws + WS_CB1))[(l * 2 + kv) * 128 + 16 * wave + fr];
#pragma unroll
        for (int i = 0; i < 4; ++i) Hs[(4 * kq + i) * 136 + 16 * wave + fr] = (bf16_t)f2bf(gelu_tanh(acc[i] + cb));
        __syncthreads();
        if (wave < 4) {
            const bf16_t* b2 = (const bf16_t*)(ws + WS_CW2 + (size_t)(l * 2 + kv) * CW2_SZ) + (size_t)(16 * wave + fr) * 128 + 8 * kq;
            f32x4 a2 = {0.f, 0.f, 0.f, 0.f};
#pragma unroll
            for (int kk = 0; kk < 4; ++kk) { const bf16x8 a = *(const LAS bf16x8*)(Hs + fr * 136 + 32 * kk + 8 * kq), b = *(const bf16x8*)(b2 + 32 * kk); a2 = __builtin_amdgcn_mfma_f32_16x16x32_bf16(a, b, a2, 0, 0, 0); }
#pragma unroll
            for (int i = 0; i < 4; ++i) Os[(4 * kq + i) * 65 + 16 * wave + fr] = a2[i];
        }
        __syncthreads();
#pragma unroll
        for (int rep = 0; rep < 2; ++rep) {
            const int e = tid + NTHR * rep, row = e >> 6, d = e & 63, c = c0 + row;
            const float val = Os[row * 65 + d];
            if (kv == 0) {
                float ss = 0.f;
                for (int j = 0; j < 64; ++j) { const float t = Os[row * 65 + j]; ss += t * t; }
                const float o = val * __builtin_amdgcn_rsqf(ss * (1.f / 64.f) + EPS) * INP(22)[l * 192 + d];
                ((bf16_t*)(ws + WS_KCN))[((size_t)bg * 256 + c) * 64 + d] = (c < 255) ? (bf16_t)f2bf(o) : (bf16_t)0;
            } else {
                ((bf16_t*)(ws + WS_VCT))[((size_t)bg * 64 + d) * 256 + c] = (c < 255) ? (bf16_t)f2bf(val) : (bf16_t)0;
            }
        }
        __syncthreads();
    }
}

__device__ __forceinline__ void qk_tile(f32x16& p0, f32x16& p1, const LAS unsigned char* Kl, const bf16x8 (&qf)[4], int r32, int hi) {
    const LAS unsigned char* kb = Kl + r32 * KP + hi * 16;
    bf16x8 a[8];
#pragma unroll
    for (int d0 = 0; d0 < 4; ++d0) { a[2 * d0] = *(const LAS bf16x8*)(kb + d0 * 32); a[2 * d0 + 1] = *(const LAS bf16x8*)(kb + 32 * KP + d0 * 32); }
    __builtin_amdgcn_s_setprio(1);
#pragma unroll
    for (int d0 = 0; d0 < 4; ++d0) {
        p0 = __builtin_amdgcn_mfma_f32_32x32x16_bf16(a[2 * d0], qf[d0], p0, 0, 0, 0);
        p1 = __builtin_amdgcn_mfma_f32_32x32x16_bf16(a[2 * d0 + 1], qf[d0], p1, 0, 0, 0);
    }
    __builtin_amdgcn_s_setprio(0);
}
template <int STRIDE, bool WINDOW, int MODE>
__device__ __forceinline__ void score_exp(f32x16& p0, f32x16& p1, int dl, const LAS float* tb, float cfar, bool rowsel) {
    const LAS float* tl = tb + 128 + (dl < 1087 ? dl : 1087) - 59;
#pragma unroll
    for (int blk = 0; blk < 2; ++blk) {
        f32x16& p = blk ? p1 : p0;
#pragma unroll
        for (int r = 0; r < 16; ++r) {
            const int c = (r & 3) + 8 * (r >> 2) + 32 * blk;
            const int dist = dl - STRIDE * c;
            float e;
            if (MODE == 0) e = __builtin_amdgcn_exp2f(p[r] + cfar);
            else {
                float bias;
                if (STRIDE == 1) bias = tl[59 - c];
                else bias = tb[128 + min((unsigned)dist, 1023u)];
                e = __builtin_amdgcn_exp2f(p[r] + bias);
                if (MODE == 2) { bool valid = dist >= 0; if (WINDOW) valid = valid && (dist < 512); e = valid ? e : 0.f; }
            }
            p[r] = rowsel ? e : 0.f;
        }
    }
}
template <int STRIDE, bool WINDOW>
__device__ __forceinline__ void score_exp_sel(f32x16& p0, f32x16& p1, int dl, const LAS float* tb, float cfar, bool rowsel, int dmin, int dmax) {
    if (!WINDOW && dmin >= 790) score_exp<STRIDE, WINDOW, 0>(p0, p1, dl, tb, cfar, rowsel);
    else if (dmin >= 0 && (!WINDOW || dmax < 512)) score_exp<STRIDE, WINDOW, 1>(p0, p1, dl, tb, cfar, rowsel);
    else score_exp<STRIDE, WINDOW, 2>(p0, p1, dl, tb, cfar, rowsel);
}
__device__ __forceinline__ float sum32(const f32x16& p0, const f32x16& p1) {
    float a = 0.f, b = 0.f;
#pragma unroll
    for (int r = 0; r < 16; ++r) { a += p0[r]; b += p1[r]; }
    return a + b;
}
template <int NDB>
__device__ __forceinline__ void pv_tile(f32x16 (&o)[NDB], const f32x16& p0, const f32x16& p1, const LAS unsigned char* Vl, int r32, int hi) {
    const LAS unsigned char* vbase = Vl + r32 * VP + hi * 8;
    bf16x4 vf[2][NDB][2];
#define PV_LOAD(st, buf) do { _Pragma("unroll") for (int db = 0; db < NDB; ++db) { const LAS unsigned char* vp = vbase + db * 32 * VP + (st) * 32; vf[buf][db][0] = *(const LAS bf16x4*)vp; vf[buf][db][1] = *(const LAS bf16x4*)(vp + 16); } } while (0)
    PV_LOAD(0, 0);
#pragma unroll
    for (int st = 0; st < 4; ++st) {
        if (st + 1 < 4) PV_LOAD(st + 1, (st + 1) & 1);
        const f32x16& p = (st >> 1) ? p1 : p0; const int s8 = 8 * (st & 1);
        u32x4 w; w.x = pg8::cvt_pk_bf16(p[s8 + 0], p[s8 + 1]); w.y = pg8::cvt_pk_bf16(p[s8 + 2], p[s8 + 3]); w.z = pg8::cvt_pk_bf16(p[s8 + 4], p[s8 + 5]); w.w = pg8::cvt_pk_bf16(p[s8 + 6], p[s8 + 7]);
        const bf16x8 pa = __builtin_bit_cast(bf16x8, w);
        __builtin_amdgcn_s_setprio(1);
#pragma unroll
        for (int db = 0; db < NDB; ++db) {
            const bf16x4 lo = vf[st & 1][db][0], hi4 = vf[st & 1][db][1];
            const bf16x8 vb = {lo[0], lo[1], lo[2], lo[3], hi4[0], hi4[1], hi4[2], hi4[3]};
            o[db] = __builtin_amdgcn_mfma_f32_32x32x16_bf16(pa, vb, o[db], 0, 0, 0);
        }
        __builtin_amdgcn_s_setprio(0);
    }
#undef PV_LOAD
}
__device__ __forceinline__ u32x4 ldk(const bf16_t* g, int tid) { return GLD(u32x4, (const unsigned char*)g + tid * 16); }
__device__ __forceinline__ void stk(LAS unsigned char* Kl, u32x4 v, int tid) { *(LAS u32x4*)(Kl + (tid >> 3) * KP + (tid & 7) * 16) = v; }
__device__ __forceinline__ u32x4 ldv(const bf16_t* g, size_t rs, int row, int tid) { return GLD(u32x4, (const unsigned char*)(g + (size_t)row * rs) + (tid & 7) * 16); }
__device__ __forceinline__ void stv(LAS unsigned char* Vl, u32x4 v, int row, int tid) { LAS unsigned char* p = Vl + row * VP + (tid & 7) * 16; *(LAS u32x2*)p = (u32x2){v.x, v.y}; *(LAS u32x2*)(p + 8) = (u32x2){v.z, v.w}; }

__device__ __forceinline__ void da_unit(const Params& P, int l, int b, int h, int qb, LAS unsigned char* lds, bool load_tab) {
    const int tid = otid(), lane = tid & 63, wave = __builtin_amdgcn_readfirstlane(tid >> 6), r32 = lane & 31, hi = lane >> 5;
    const int c = wave >> 2, qsub = wave & 3, q0 = qb * 128, qw0 = q0 + 32 * qsub;
    unsigned char* ws = WSP;
    const float* prm = (const float*)(ws + WS_PRM) + l * 8;
    const float lam = prm[0], Mb = prm[1], onem = prm[3];
    LAS float* biasL = (LAS float*)(lds + L_BIAS);
    const float* bg = (const float*)(ws + WS_BIAS) + h * 1024;
    if (load_tab) for (int i = tid; i < TBN; i += NTHR) { const int d = i - 128; biasL[i] = GLD(float, bg + (d < 0 ? 0 : (d > 1023 ? 1023 : d))) - Mb; }
    const float cfar = bg[1023] - Mb;
    const bf16_t* Qp = (const bf16_t*)(ws + Z_DQ) + ((size_t)(b * 8 + h * 2 + c) * SEQ + qw0 + r32) * 64 + hi * 8;
    bf16x8 qf[4];
#pragma unroll
    for (int d0 = 0; d0 < 4; ++d0) qf[d0] = GLD(bf16x8, Qp + d0 * 16);
    const bf16_t* K1g = (const bf16_t*)(ws + Z_DK) + (size_t)(b * 8 + h * 2) * SEQ * 64;
    const bf16_t* K2g = K1g + (size_t)SEQ * 64;
    const bf16_t* Vg = (const bf16_t*)(ws + Z_DVT) + (size_t)(b * 4 + h) * 128 * SEQ;
    const int NT = (q0 + 128) / 64;
    f32x16 o[4];
#pragma unroll
    for (int i = 0; i < 4; ++i) o[i] = (f32x16){};
    float lsum = 0.f;
    u32x4 rk1, rk2, rv0, rv1;
#define DA_LOAD(t) do { rk1 = ldk(K1g + (size_t)(t) * 4096, tid); rk2 = ldk(K2g + (size_t)(t) * 4096, tid); rv0 = ldv(Vg + (t) * 64, SEQ, tid >> 3, tid); rv1 = ldv(Vg + (t) * 64, SEQ, 64 + (tid >> 3), tid); } while (0)
#define DA_STORE(sb) do { LAS unsigned char* st_ = lds + (sb) * DA_STAGE; stk(st_, rk1, tid); stk(st_ + 64 * KP, rk2, tid); stv(st_ + 128 * KP, rv0, tid >> 3, tid); stv(st_ + 128 * KP, rv1, 64 + (tid >> 3), tid); } while (0)
    DA_LOAD(0); DA_STORE(0);
    __syncthreads();
    for (int t = 0; t < NT; ++t) {
        if (t + 1 < NT) DA_LOAD(t + 1);
        if (64 * t <= qw0 + 31) {
            const LAS unsigned char* st = lds + (t & 1) * DA_STAGE;
            f32x16 p0 = (f32x16){}, p1 = (f32x16){};
            qk_tile(p0, p1, st + c * 64 * KP, qf, r32, hi);
            const int dl = qw0 + r32 - 64 * t - 4 * hi;
            score_exp_sel<1, false>(p0, p1, dl, biasL, cfar, true, qw0 - (64 * t + 63), qw0 + 31 - 64 * t);
            lsum += sum32(p0, p1);
            pv_tile<4>(o, p0, p1, st + 128 * KP, r32, hi);
        }
        if (t + 1 < NT) DA_STORE((t + 1) & 1);
        __syncthreads();
    }
#undef DA_LOAD
#undef DA_STORE
    lsum += __shfl_xor(lsum, 32);
    LAS float* wsf = (LAS float*)(lds + L_WSF) + wave * 64;
    if (hi == 0) wsf[r32] = (lsum > 0.f) ? 1.0f / lsum : 0.f;
    asm volatile("s_waitcnt lgkmcnt(0)" ::: "memory");
    float li[16];
#pragma unroll
    for (int r = 0; r < 16; ++r) li[r] = wsf[crow(r, hi)];
    LAS float* X = (LAS float*)lds;
    if (c == 1) {
#pragma unroll
        for (int db = 0; db < 4; ++db)
#pragma unroll
            for (int r = 0; r < 16; ++r) X[(32 * qsub + crow(r, hi)) * 132 + r32 + 32 * db] = o[db][r] * li[r];
    }
    __syncthreads();
    if (c == 0) {
        const float* sg = INP(20) + l * 128;
        float gsub[4];
#pragma unroll
        for (int db = 0; db < 4; ++db) gsub[db] = sg[r32 + 32 * db] * onem;
#pragma unroll
        for (int r = 0; r < 16; ++r) {
            float y[4], ss = 0.f;
#pragma unroll
            for (int db = 0; db < 4; ++db) { y[db] = o[db][r] * li[r] - lam * X[(32 * qsub + crow(r, hi)) * 132 + r32 + 32 * db]; ss += y[db] * y[db]; }
            ss += __shfl_xor(ss, 1); ss += __shfl_xor(ss, 2); ss += __shfl_xor(ss, 4); ss += __shfl_xor(ss, 8); ss += __shfl_xor(ss, 16);
            const float rs = __builtin_amdgcn_rsqf(ss * (1.f / 128.f) + EPS);
            bf16_t* d = (bf16_t*)(ws + WS_XN) + (size_t)(b * SEQ + qw0 + crow(r, hi)) * DM + h * 128 + r32;
#pragma unroll
            for (int db = 0; db < 4; ++db) GST(bf16_t, d + 32 * db, (bf16_t)f2bf(y[db] * rs * gsub[db]));
        }
    }
    __syncthreads();
}

__device__ __forceinline__ void nsa_unit(const Params& P, int l, int b, int g, int u, LAS unsigned char* lds, bool load_tab) {
    const int tid = otid(), lane = tid & 63, wave = __builtin_amdgcn_readfirstlane(tid >> 6), r32 = lane & 31, hi = lane >> 5;
    const int qi = r32 >> 2, p = r32 & 3, qw0 = 64 * u + 8 * wave, qpos = qw0 + qi, head = g * 4 + p;
    unsigned char* ws = WSP;
    const float Mb = ((const float*)(ws + WS_PRM))[l * 8 + 2];
    LAS float* biasL = (LAS float*)(lds + L_BIAS);
    LAS float* imp = (LAS float*)(lds + L_IMP);
    LAS unsigned* selw = (LAS unsigned*)(lds + L_SEL);
    LAS float* wsf = (LAS float*)(lds + L_WSF) + wave * 64;
    const float* bgl = (const float*)(ws + WS_BIAS) + (size_t)(4 + g * 4) * 1024;
    if (load_tab) for (int i = tid; i < 4 * TBN; i += NTHR) { const int hh = i / TBN, d = i % TBN - 128; biasL[i] = GLD(float, bgl + hh * 1024 + (d < 0 ? 0 : (d > 1023 ? 1023 : d))) - Mb; }
    if (tid == 0) { unsigned z = 0u; asm volatile("" : "+v"(z)); selw[128] = z; selw[129] = z; }
    const LAS float* tb = biasL + p * TBN;
    const float cfar = bgl[p * 1024 + 1023] - Mb;
    const bf16_t* Qp = (const bf16_t*)(ws + Z_NQ) + ((size_t)(b * 8 + head) * SEQ + qpos) * 64 + hi * 8;
    bf16x8 qf[4];
#pragma unroll
    for (int d0 = 0; d0 < 4; ++d0) qf[d0] = GLD(bf16x8, Qp + d0 * 16);
    const float* ngp = (const float*)(ws + Z_NG) + (size_t)(b * SEQ + qpos) * 24 + head * 3;
    const float gate_c = GLD(float, ngp), gate_s = GLD(float, ngp + 1), gate_w = GLD(float, ngp + 2);
    f32x16 oc[2]; oc[0] = (f32x16){}; oc[1] = (f32x16){};
    f32x16 o[2];
    u32x4 rk, rv;
    const int bgi = b * 2 + g;
#define NS_STORE(sb) do { LAS unsigned char* st_ = lds + (sb) * NS_STAGE; stk(st_, rk, tid); stv(st_ + 64 * KP, rv, tid >> 3, tid); } while (0)
#define NS_FOLD(gate) do { lsum += __shfl_xor(lsum, 32); if (hi == 0) wsf[r32] = (lsum > 0.f) ? (gate) / lsum : 0.f; asm volatile("s_waitcnt lgkmcnt(0)" ::: "memory"); \
        _Pragma("unroll") for (int r = 0; r < 16; ++r) { const float f_ = wsf[crow(r, hi)]; oc[0][r] += f_ * o[0][r]; oc[1][r] += f_ * o[1][r]; } asm volatile("s_waitcnt lgkmcnt(0)" ::: "memory"); } while (0)
    {
        const bf16_t* Kg = (const bf16_t*)(ws + WS_KCN) + (size_t)bgi * 256 * 64;
        const bf16_t* Vg = (const bf16_t*)(ws + WS_VCT) + (size_t)bgi * 64 * 256;
        const int ntc = (4 * u + 2) / 64 + 1;
        for (int tc = 0; tc < ntc; ++tc) { rk = ldk(Kg + (size_t)tc * 4096, tid); rv = ldv(Vg + tc * 64, 256, tid >> 3, tid); NS_STORE(tc); }
        __syncthreads();
        float lsum = 0.f;
        for (int tc = 0; tc < ntc; ++tc) {
            const LAS unsigned char* st = lds + tc * NS_STAGE;
            f32x16 p0 = (f32x16){}, p1 = (f32x16){};
            qk_tile(p0, p1, st, qf, r32, hi);
            const int dl = qpos - 31 - 16 * (64 * tc + 4 * hi);
            score_exp_sel<16, false>(p0, p1, dl, tb, cfar, true, qw0 - 31 - 16 * (64 * tc + 63), qw0 + 7 - 31 - 16 * 64 * tc);
            lsum += sum32(p0, p1);
        }
        const float lt = lsum + __shfl_xor(lsum, 32);
        const float linv = (lt > 0.f) ? 1.0f / lt : 0.f;
        o[0] = (f32x16){}; o[1] = (f32x16){};
        float carry = 0.f;
        for (int tc = 0; tc < ntc; ++tc) {
            const LAS unsigned char* st = lds + tc * NS_STAGE;
            f32x16 p0 = (f32x16){}, p1 = (f32x16){};
            qk_tile(p0, p1, st, qf, r32, hi);
            const int dl = qpos - 31 - 16 * (64 * tc + 4 * hi);
            score_exp_sel<16, false>(p0, p1, dl, tb, cfar, true, qw0 - 31 - 16 * (64 * tc + 63), qw0 + 7 - 31 - 16 * 64 * tc);
            float Qs[2][4], PL[2][4];
#pragma unroll
            for (int blk = 0; blk < 2; ++blk)
#pragma unroll
                for (int m = 0; m < 4; ++m) { const f32x16& pp = blk ? p1 : p0; Qs[blk][m] = (pp[4 * m] + pp[4 * m + 1]) + (pp[4 * m + 2] + pp[4 * m + 3]); PL[blk][m] = __shfl_xor(pp[4 * m + 3], 32); }
#pragma unroll
            for (int blk = 0; blk < 2; ++blk)
#pragma unroll
                for (int m = 0; m < 4; ++m) {
                    const float prev = (m > 0) ? PL[blk][m - 1] : (blk ? PL[0][3] : carry);
                    float e = (Qs[blk][m] + (hi ? PL[blk][m] : prev)) * linv;
                    e += __shfl_xor(e, 1); e += __shfl_xor(e, 2);
                    if (p == 0) imp[(8 * wave + qi) * 64 + 16 * tc + 8 * blk + 2 * m + hi] = e;
                }
            carry = PL[1][3];
            pv_tile<2>(o, p0, p1, st + 64 * KP, r32, hi);
        }
        NS_FOLD(gate_c);
    }
    __syncthreads();
    {
        const int ql = lane >> 3, sub = lane & 7, q = 8 * wave + ql;
        unsigned long long m;
        if (u < 8) m = (2ull << u) - 1ull;
        else {
            m = 1ull | (1ull << u) | (1ull << (u - 1));
            float v[8];
#pragma unroll
            for (int i = 0; i < 8; ++i) { const int j = sub + 8 * i; v[i] = (j >= 1 && j <= u - 2) ? imp[q * 64 + j] : -1.f; }
            for (int k = 0; k < 5; ++k) {
                float bv = v[0]; int bj = sub;
#pragma unroll
                for (int i = 1; i < 8; ++i) if (v[i] > bv) { bv = v[i]; bj = sub + 8 * i; }
#pragma unroll
                for (int of = 1; of < 8; of <<= 1) { const float ov = __shfl_xor(bv, of); const int oj = __shfl_xor(bj, of); if (ov > bv || (ov == bv && oj < bj)) { bv = ov; bj = oj; } }
                m |= 1ull << bj;
#pragma unroll
                for (int i = 0; i < 8; ++i) if (bj == sub + 8 * i) v[i] = -2.f;
            }
        }
        if (sub == 0) { selw[2 * q] = (unsigned)m; selw[2 * q + 1] = (unsigned)(m >> 32); atomicOr((unsigned*)&selw[128], (unsigned)m); atomicOr((unsigned*)&selw[129], (unsigned)(m >> 32)); }
    }
    __syncthreads();
    asm volatile("" : "+v"(oc[0]), "+v"(oc[1]));
    u32x4 rk2, rv2;
#define NS_LOADA(Kg_, Vg_, j_) do { rk = ldk((Kg_) + (size_t)(j_) * 4096, tid); rv = ldv((Vg_) + (j_) * 64, SEQ, tid >> 3, tid); } while (0)
#define NS_LOADB(Kg_, Vg_, j_) do { rk2 = ldk((Kg_) + (size_t)(j_) * 4096, tid); rv2 = ldv((Vg_) + (j_) * 64, SEQ, tid >> 3, tid); } while (0)
#define NS_STOREA(sb) do { LAS unsigned char* st_ = lds + (sb) * NS_STAGE; stk(st_, rk, tid); stv(st_ + 64 * KP, rv, tid >> 3, tid); } while (0)
#define NS_STOREB(sb) do { LAS unsigned char* st_ = lds + (sb) * NS_STAGE; stk(st_, rk2, tid); stv(st_ + 64 * KP, rv2, tid >> 3, tid); } while (0)
    {
        const unsigned long long un = (unsigned long long)selw[128] | ((unsigned long long)selw[129] << 32);
        const unsigned long long mine = (unsigned long long)selw[2 * (8 * wave + qi)] | ((unsigned long long)selw[2 * (8 * wave + qi) + 1] << 32);
        const bf16_t* Kg = (const bf16_t*)(ws + Z_KSEL) + (size_t)bgi * SEQ * 64;
        const bf16_t* Vg = (const bf16_t*)(ws + Z_VSELT) + (size_t)bgi * 64 * SEQ;
        o[0] = (f32x16){}; o[1] = (f32x16){};
        float lsum = 0.f;
        unsigned long long rem = un;
#define NS_NEXTJ(var, has) do { has = (rem != 0ull); var = 0; if (has) { var = __builtin_ctzll(rem); rem &= rem - 1; } } while (0)
        int jc, j1, j2; bool h1, h2;
        NS_NEXTJ(jc, h1);
        NS_NEXTJ(j1, h1);
        NS_LOADA(Kg, Vg, jc); if (h1) NS_LOADB(Kg, Vg, j1);
        NS_STOREA(0);
        __syncthreads();
        int sc = 0;
#define NS_SEL_STEP(LOADF, STOREN) { \
            NS_NEXTJ(j2, h2); if (h2) LOADF(Kg, Vg, j2); \
            const bool rowsel = (mine >> jc) & 1ull; \
            if (__any(rowsel)) { \
                const LAS unsigned char* st = lds + sc * NS_STAGE; \
                f32x16 p0 = (f32x16){}, p1 = (f32x16){}; \
                qk_tile(p0, p1, st, qf, r32, hi); \
                const int dl = qpos - 64 * jc - 4 * hi; \
                score_exp_sel<1, false>(p0, p1, dl, tb, cfar, rowsel, qw0 - (64 * jc + 63), qw0 + 7 - 64 * jc); \
                lsum += sum32(p0, p1); \
                pv_tile<2>(o, p0, p1, st + 64 * KP, r32, hi); \
            } \
            const int sn = (sc == 2) ? 0 : sc + 1; \
            if (h1) STOREN(sn); \
            __syncthreads(); \
            if (!h1) break; \
            jc = j1; j1 = j2; h1 = h2; sc = sn; }
        for (;;) { NS_SEL_STEP(NS_LOADA, NS_STOREB) NS_SEL_STEP(NS_LOADB, NS_STOREA) }
#undef NS_SEL_STEP
#undef NS_NEXTJ
        NS_FOLD(gate_s);
        asm volatile("" : "+v"(oc[0]), "+v"(oc[1]));
    }
    {
        const bf16_t* Kg = (const bf16_t*)(ws + Z_KWIN) + (size_t)bgi * SEQ * 64;
        const bf16_t* Vg = (const bf16_t*)(ws + Z_VWINT) + (size_t)bgi * 64 * SEQ;
        o[0] = (f32x16){}; o[1] = (f32x16){};
        float lsum = 0.f;
        const int t0 = (u >= 8) ? u - 8 : 0;
        int t = t0, sc = 0;
        NS_LOADA(Kg, Vg, t0); if (t0 + 1 <= u) NS_LOADB(Kg, Vg, t0 + 1);
        NS_STOREA(0);
        __syncthreads();
#define NS_WIN_STEP(LOADF, STOREN) { \
            if (t + 2 <= u) LOADF(Kg, Vg, t + 2); \
            { \
                const LAS unsigned char* st = lds + sc * NS_STAGE; \
                f32x16 p0 = (f32x16){}, p1 = (f32x16){}; \
                qk_tile(p0, p1, st, qf, r32, hi); \
                const int dl = qpos - 64 * t - 4 * hi; \
                score_exp_sel<1, true>(p0, p1, dl, tb, cfar, true, qw0 - (64 * t + 63), qw0 + 7 - 64 * t); \
                lsum += sum32(p0, p1); \
                pv_tile<2>(o, p0, p1, st + 64 * KP, r32, hi); \
            } \
            const int sn = (sc == 2) ? 0 : sc + 1; \
            if (t + 1 <= u) STOREN(sn); \
            __syncthreads(); \
            if (t + 1 > u) break; \
            ++t; sc = sn; }
        for (;;) { NS_WIN_STEP(NS_LOADA, NS_STOREB) NS_WIN_STEP(NS_LOADB, NS_STOREA) }
#undef NS_WIN_STEP
        NS_FOLD(gate_w);
    }
#undef NS_LOADA
#undef NS_LOADB
#undef NS_STOREA
#undef NS_STOREB
#undef NS_STORE
#undef NS_FOLD
#pragma unroll
    for (int r = 0; r < 16; ++r) {
        const int row = crow(r, hi), q = qw0 + (row >> 2), pp = row & 3;
        bf16_t* d = (bf16_t*)(ws + WS_XN) + (size_t)(b * SEQ + q) * DM + 512 + (g * 4 + pp) * 64 + r32;
        GST(bf16_t, d, (bf16_t)f2bf(oc[0][r])); GST(bf16_t, d + 32, (bf16_t)f2bf(oc[1][r]));
    }
    __syncthreads();
}

__device__ __forceinline__ void attention_phase(const Params& P, int l, LAS unsigned char* lds) {
    int tab_key = -1;
    for (int it = blockIdx.x; it < 2048; it += gridDim.x) {
        const int c = it & 255, sl = (it >> 8) & 3;
        if (it < 1024) { const int bh = c & 31, xg = c >> 5; const int qb = (sl == 0) ? 31 - xg : (sl == 1) ? 23 - xg : (sl == 2) ? 8 + xg : xg;
            da_unit(P, l, bh >> 2, bh & 3, qb, lds, tab_key != (bh & 3)); tab_key = bh & 3; }
        else { const int bg = c & 15, ug = c >> 4; const int u = (sl == 0) ? 63 - ug : (sl == 1) ? 47 - ug : (sl == 2) ? 16 + ug : ug;
            nsa_unit(P, l, bg >> 1, bg & 1, u, lds, tab_key != 4 + (bg & 1)); tab_key = 4 + (bg & 1); }
    }
}

constexpr size_t WS_BAR = 72 * 1024;
#define RLX_AGENT __ATOMIC_RELAXED, __HIP_MEMORY_SCOPE_AGENT
#define XB_TMO      128
#define XB_XCNT(j)  (256  + 64 * (j))
#define XB_XSUB(j)  (1280 + 64 * (j))
#define XB_XGEN(j)  (2304 + 64 * (j))
#define XB_TOP      3328
#define XB_TOPGEN   3392
#define XCD_BAR_WORDS 3456
#define XB_SPIN_CAP (1u << 18)

__device__ __forceinline__ unsigned xb_ld(unsigned* p)              { return __hip_atomic_load(p, __ATOMIC_RELAXED, __HIP_MEMORY_SCOPE_AGENT); }
__device__ __forceinline__ unsigned xb_add(unsigned* p, unsigned v) { return __hip_atomic_fetch_add(p, v, __ATOMIC_RELAXED, __HIP_MEMORY_SCOPE_AGENT); }
__device__ __forceinline__ unsigned xb_xcc_id() { return (unsigned)__builtin_amdgcn_s_getreg((3 << 11) | 20) & 0xFu; }
#define XB_SPIN(cond, bar) do { unsigned _sp = 0; while (cond) { __builtin_amdgcn_s_sleep(1); \
    if ((++_sp & 255u) == 0u) { if (xb_ld(&(bar)[XB_TMO])) break; if (_sp > XB_SPIN_CAP) { atomicAdd(&(bar)[XB_TMO], 1u); break; } } } } while (0)

struct XcdBarrier {
    unsigned* bar; unsigned x;
    volatile LAS unsigned* st;
};

__device__ __forceinline__ XcdBarrier xcd_barrier_post(unsigned* bar, volatile LAS unsigned* st) {
    XcdBarrier b; b.bar = bar; b.x = xb_xcc_id(); b.st = st;
    if (threadIdx.x == 0) (void)xb_add(&bar[XB_XCNT(b.x)], 1u);
    return b;
}
__device__ __forceinline__ void xcd_barrier_complete(unsigned* bar, unsigned x, unsigned& nloc, unsigned& nx) {
    const unsigned G = gridDim.x * gridDim.y * gridDim.z;
    unsigned sum, cnt, mine, sp = 0u;
    for (;;) {
        sum = 0u; cnt = 0u; mine = 0u;
#pragma unroll
        for (unsigned j = 0; j < 16; ++j) { const unsigned c = xb_ld(&bar[XB_XCNT(j)]); sum += c; cnt += (c > 0u) ? 1u : 0u; mine = (j == x) ? c : mine; }
        if (sum == G) break;
        __builtin_amdgcn_s_sleep(1);
        if ((++sp & 255u) == 0u) { if (xb_ld(&bar[XB_TMO])) break; if (sp > XB_SPIN_CAP) { atomicAdd(&bar[XB_TMO], 1u); break; } }
    }
    nloc = mine > 0u ? mine : 1u; nx = cnt > 0u ? cnt : 1u;
}

__device__ __forceinline__ void xcd_barrier(const XcdBarrier& b) {
    asm volatile("s_waitcnt vmcnt(0)" ::: "memory");
    __syncthreads();
    if (threadIdx.x == 0) {
        unsigned* bar = b.bar;
        __builtin_amdgcn_s_waitcnt(0);
        unsigned nloc = b.st[0], nx = b.st[1];
        if (nloc == 0u) { xcd_barrier_complete(bar, b.x, nloc, nx); b.st[0] = nloc; b.st[1] = nx; }
        const unsigned old = xb_add(&bar[XB_XSUB(b.x)], 1u);
        const unsigned gen = old / nloc;
        if (old + 1u == (gen + 1u) * nloc) {
            __builtin_amdgcn_fence(__ATOMIC_RELEASE, "agent");
            asm volatile("s_waitcnt vmcnt(0)" ::: "memory");
            const unsigned og = xb_add(&bar[XB_TOP], 1u);
            const unsigned tg = og / nx;
            if (og + 1u == (tg + 1u) * nx) xb_add(&bar[XB_TOPGEN], 1u);
            else XB_SPIN(xb_ld(&bar[XB_TOPGEN]) == tg, bar);
            __builtin_amdgcn_fence(__ATOMIC_ACQUIRE, "agent");
            xb_add(&bar[XB_XGEN(b.x)], 1u);
            asm volatile("s_waitcnt vmcnt(0)" ::: "memory");
        } else {
            XB_SPIN(xb_ld(&bar[XB_XGEN(b.x)]) == gen, bar);
            __builtin_amdgcn_fence(__ATOMIC_ACQUIRE, "agent");
            asm volatile("s_waitcnt vmcnt(0)" ::: "memory");
        }
    }
    __syncthreads();
}

__global__ void __launch_bounds__(NTHR, 2) hybrid_fwd(Params P) {
    extern __shared__ __attribute__((aligned(16))) unsigned char lds_raw[];
    LAS unsigned char* lds = (LAS unsigned char*)lds_raw;
    cg::grid_group grid = cg::this_grid();
#define GSYNC() do { XcdBarrier xb_; xb_.bar = (unsigned*)(WSP + WS_BAR); xb_.x = xb_xcc_id(); xb_.st = (volatile LAS unsigned*)(lds + L_PTAB + 384); xcd_barrier(xb_); } while (0)
    if (threadIdx.x == 0) {
        LAS unsigned long long* pt = (LAS unsigned long long*)(lds + L_PTAB);
#pragma unroll
        for (int i = 0; i < 30; ++i) pt[i] = (unsigned long long)P.in[i];
        pt[30] = (unsigned long long)P.out; pt[31] = (unsigned long long)P.ws;
        *(LAS unsigned*)(lds + L_PTAB + 384) = 0u; *(LAS unsigned*)(lds + L_PTAB + 388) = 0u;
    }
    __syncthreads();
    (void)xcd_barrier_post((unsigned*)(WSP + WS_BAR), (volatile LAS unsigned*)(lds + L_PTAB + 384));
    const int G = gridDim.x, bx = blockIdx.x;
#define ws WSP
#define XN ((bf16_t*)(WSP + WS_XN))
#define HID ((bf16_t*)(WSP + WS_HID))
#define MERGED ((bf16_t*)(WSP + WS_MERGED))
#define XB ((bf16_t*)OUTP)
#define XS ((bf16_t*)(WSP + WS_Z + 192 * MiB))
#define SSP ((float*)(WSP + WS_SS))

#if defined(PROBE_PHASE)
    int n_stamp = 0;
#define STAMP() do { if (blockIdx.x == 0 && threadIdx.x == 0) ((LAS unsigned long long*)(lds + L_PTAB + 512))[n_stamp] = __builtin_amdgcn_s_memrealtime(); ++n_stamp; } while (0)
#else
#define STAMP() do {} while (0)
#endif
    if (P.out == nullptr) grid.sync();
    STAMP();
    prologue(P, lds);
    xprep_phase(INP(0), (bf16_t*)OUTP, (float*)(WSP + WS_SS));
#if defined(DUP_PRO)
    prologue(P, lds);
#endif
    GSYNC(); STAMP();
#pragma unroll
    for (int l = 0; l < DEPTH; ++l) {
        const float* xin = (l == 0) ? INP(0) : OUTP;
        { pg8::Gemm g{XB, (const bf16_t*)(ws + WS_W13 + (size_t)(l * 2 + 0) * W13_SZ), MTOK, 5632, DM}; pg8::StaticOrder S; S.init(MTOK, 5632, G, bx);
          EpiSwiGLU E{{SSP}, HID}; pg8::gemm_phase<EpiSwiGLU, pg8::StaticOrder, true, true>(lds, g, S, E);
#if defined(DUP_G1)
          pg8::gemm_phase<EpiSwiGLU, pg8::StaticOrder, true, true>(lds, g, S, E);
#endif
        }
        GSYNC(); STAMP();
        { pg8::Gemm g{HID, (const bf16_t*)(ws + WS_W2 + (size_t)(l * 2 + 0) * W2_SZ), MTOK, DM, DFF}; pg8::StaticOrder S; S.init(MTOK, DM, G, bx);
          if (l == 0) { EpiResidT<true, false> E{xin, XB, 0.5f, SSP}; pg8::gemm_phase<EpiResidT<true, false>, pg8::StaticOrder, true, true>(lds, g, S, E); }
          else { EpiResidT<false, false> E{XB, XB, 0.5f, SSP}; pg8::gemm_phase<EpiResidT<false, false>, pg8::StaticOrder, true, true>(lds, g, S, E); } }
        GSYNC(); STAMP();
#if defined(STOP_AFTER) && STOP_AFTER == 1
        return;
#endif
        { pg8::Gemm g{XB, (const bf16_t*)(ws + WS_WIN + (size_t)l * WIN_SZ), MTOK, 5120, DM}; pg8::StaticOrder S; S.init(MTOK, 5120, G, bx);
          EpiZ E{{SSP}, ws, INP(14) + l * 64, INP(15) + l * 64, INP(21) + l * 64, INP(22) + l * 192}; pg8::gemm_phase<EpiZ, pg8::StaticOrder, true, true>(lds, g, S, E);
#if defined(DUP_G3)
          pg8::gemm_phase<EpiZ, pg8::StaticOrder, true, true>(lds, g, S, E);
#endif
        }
        GSYNC(); STAMP();
#if defined(DUMP_Z)
        { const unsigned short* z = (const unsigned short*)(WSP + WS_Z); float* o = OUTP;
          for (size_t i = (size_t)blockIdx.x * NTHR + threadIdx.x; i < (size_t)MTOK * DM; i += (size_t)gridDim.x * NTHR) {
              unsigned v = (unsigned)z[i * 4 + (i & 3)] << 16; if ((v & 0x7f800000u) == 0x7f800000u) v = 0u; o[i] = __builtin_bit_cast(float, v); }
          return; }
#endif
        compress_phase(P, l, lds);
#if defined(DUP_CMP)
        for (int rep_ = 0; rep_ < 4; ++rep_) compress_phase(P, l, lds);
#endif
        GSYNC(); STAMP();
        attention_phase(P, l, lds);
#if defined(DUP_ATT)
        attention_phase(P, l, lds);
#endif
        GSYNC(); STAMP();
        { pg8::Gemm g{XN, (const bf16_t*)(ws + WS_PAB + (size_t)l * PAB_SZ), MTOK, 2048, DM}; pg8::StaticOrder S; S.init(MTOK, 2048, G, bx);
          EpiMerge E{(const bf16_t*)(ws + Z_MG), MERGED}; pg8::gemm_phase<EpiMerge, pg8::StaticOrder, true, true>(lds, g, S, E); }
        GSYNC(); STAMP();
        { pg8::Gemm g{MERGED, (const bf16_t*)(ws + WS_WO + (size_t)l * WO_SZ), MTOK, DM, DM}; pg8::StaticOrder S; S.init(MTOK, DM, G, bx);
          EpiResidT<false, false> E{XB, (l + 1 < DEPTH) ? XB : XS, 1.0f, SSP}; pg8::gemm_phase<EpiResidT<false, false>, pg8::StaticOrder, true, true>(lds, g, S, E); }
        GSYNC(); STAMP();
#if defined(STOP_AFTER) && STOP_AFTER == 2
        return;
#endif
        { pg8::Gemm g{(l + 1 < DEPTH) ? XB : XS, (const bf16_t*)(ws + WS_W13 + (size_t)(l * 2 + 1) * W13_SZ), MTOK, 5632, DM}; pg8::StaticOrder S; S.init(MTOK, 5632, G, bx);
          EpiSwiGLU E{{SSP}, HID}; pg8::gemm_phase<EpiSwiGLU, pg8::StaticOrder, true, true>(lds, g, S, E); }
        GSYNC(); STAMP();
        { pg8::Gemm g{HID, (const bf16_t*)(ws + WS_W2 + (size_t)(l * 2 + 1) * W2_SZ), MTOK, DM, DFF}; pg8::StaticOrder S; S.init(MTOK, DM, G, bx);
          if (l + 1 < DEPTH) { EpiResidT<false, false> E{XB, XB, 0.5f, SSP}; pg8::gemm_phase<EpiResidT<false, false>, pg8::StaticOrder, true, true>(lds, g, S, E); }
          else { EpiResidT<false, true> E{XS, OUTP, 0.5f, nullptr}; pg8::gemm_phase<EpiResidT<false, true>, pg8::StaticOrder, true, true>(lds, g, S, E); } }
        if (l + 1 < DEPTH) { GSYNC(); STAMP(); }
    }
#if defined(PROBE_PHASE)
    GSYNC(); STAMP();
    if (blockIdx.x == 0 && threadIdx.x == 0) { const LAS unsigned long long* t = (const LAS unsigned long long*)(lds + L_PTAB + 512); const float ns = (float)(t[PROBE_PHASE + 1] - t[PROBE_PHASE]) * 10.0f; OUTP[0] = exp2f(rintf(log2f(ns) * 4.f) * 0.25f); }
#endif
#undef ws
#undef XN
#undef HID
#undef MERGED
#undef XB
#undef XS
#undef SSP
}

extern "C" void kernel_launch(void* const* d_in, const int* in_sizes, int n_in, void* d_out, int out_size, void* d_ws, size_t ws_size, hipStream_t stream) {
    static int grid = 0;
    if (grid == 0) {
        if (n_in != 30 || out_size != MTOK * DM || ws_size < WS_END) { fprintf(stderr, "kernel_launch: unexpected problem (n_in %d out %d ws %zu, need %zu)\n", n_in, out_size, ws_size, (size_t)WS_END); grid = -1; return; }
        int dev = 0, cus = 0, per_cu = 0;
        (void)hipGetDevice(&dev);
        (void)hipDeviceGetAttribute(&cus, hipDeviceAttributeMultiprocessorCount, dev);
        if (hipFuncSetAttribute((const void*)hybrid_fwd, hipFuncAttributeMaxDynamicSharedMemorySize, LDS_BYTES) != hipSuccess) { fprintf(stderr, "kernel_launch: hipFuncSetAttribute failed\n"); grid = -1; return; }
        if (hipOccupancyMaxActiveBlocksPerMultiprocessor(&per_cu, (const void*)hybrid_fwd, NTHR, LDS_BYTES) != hipSuccess || per_cu < 1) { fprintf(stderr, "kernel_launch: occupancy query gave %d\n", per_cu); per_cu = 1; }
        (void)hipGetLastError();
        grid = cus * (per_cu > 1 ? 1 : per_cu);
        if (grid <= 0) grid = 256;
    }
    if (grid < 0) return;
    Params p{};
    for (int i = 0; i < 30; ++i) p.in[i] = (const float*)d_in[i];
    p.out = (float*)d_out; p.ws = (unsigned char*)d_ws;
    (void)hipMemsetAsync((unsigned char*)d_ws + WS_BAR, 0, 16384, stream);
    void* args[] = {&p};
    hipError_t e = hipLaunchCooperativeKernel((const void*)hybrid_fwd, dim3(grid), dim3(NTHR), args, LDS_BYTES, stream);
    if (e != hipSuccess) fprintf(stderr, "cooperative launch failed: %s (grid %d)\n", hipGetErrorString(e), grid);
}
```

```cpp
#include <hip/hip_runtime.h>
#include <hip/hip_cooperative_groups.h>
#include <cstdio>
#include <cstdint>
namespace cg = cooperative_groups;
namespace pg8 {
#define PG8_LAS __attribute__((address_space(3)))
typedef unsigned short bf16_t;
typedef short bf16x8 __attribute__((ext_vector_type(8)));
typedef float f32x4 __attribute__((ext_vector_type(4)));
typedef unsigned u32x4 __attribute__((ext_vector_type(4)));
constexpr int BM = 256, BK = 64, HALF = 128, HTB = HALF * BK * 2  , STAGE_BYTES = 8 * HTB, NXCD = 8, WGM = 8;

__host__ __device__ __forceinline__ int lds_byte(int r, int c) { const int st = (r >> 4) * 2 + (c >> 5), rr = r & 15, cc = c & 31, ob = rr * 64 + cc * 2; return st * 1024 + (ob ^ (((ob >> 9) & 1) << 5)); }
__host__ __device__ __forceinline__ void stage_rc(int b, int& R, int& C) { const int st = b / 1024, sb = b % 1024, swz = sb ^ (((sb >> 9) & 1) << 5); R = (st >> 1) * 16 + swz / 64; C = (st & 1) * 32 + (swz % 64) / 2; }
__host__ __device__ __forceinline__ int perm32(int rho) { const int n = rho >> 4, i = rho & 15; return 8 * (i >> 2) + 4 * n + (i & 3); }

struct Unit { int pm, pn; };
struct Gemm { const bf16_t* A; const bf16_t* Bt; int M, N, K; };

struct StaticOrder {
    int nM, nN, nwg, G, c;
    __host__ __device__ void init(int M, int N, int G_, int c_) { nM = M / BM; nN = N / BM; nwg = nM * nN; G = G_; c = c_; }
    __host__ __device__ bool next(int i, Unit& u) const {
        const long L = (long)i * G + c; if (L >= nwg) return false;
        int wgid = (int)L; { const int q = nwg / NXCD, r = nwg % NXCD, xcd = wgid % NXCD, off = wgid / NXCD; wgid = (xcd < r ? xcd * (q + 1) : r * (q + 1) + (xcd - r) * q) + off; }
        const int nig = WGM * nN, gid = wgid / nig, fm = gid * WGM, gsz = (nM - fm) < WGM ? (nM - fm) : WGM;
        u.pm = fm + ((wgid % nig) % gsz); u.pn = (wgid % nig) / gsz; return true;
    }
    __device__ __forceinline__ void a_ready(const Unit&) const {}
    __device__ __forceinline__ void done(const Unit&) const {}
};

typedef float f32x2_t __attribute__((ext_vector_type(2))); typedef __bf16 bf16x2_t __attribute__((ext_vector_type(2)));
__device__ __forceinline__ unsigned cvt_pk_bf16(float lo, float hi) { f32x2_t v = {lo, hi}; bf16x2_t b = __builtin_convertvector(v, bf16x2_t); return __builtin_bit_cast(unsigned, b); }
template <class Epi, class Sched, bool ALIGN_EPI = false, bool SP2 = false>
__device__ __forceinline__ void gemm_phase(PG8_LAS unsigned char* lds, const Gemm g, const Sched& S, const Epi& E) {
    int tid_ = threadIdx.x; asm volatile("" : "+v"(tid_)); const int tid = tid_, wid = __builtin_amdgcn_readfirstlane(tid >> 6), lane = tid & 63, wr = wid >> 2, wc = wid & 3, fr = lane & 15, fq = lane >> 4;
    const int K = g.K, nt = K / BK;
    unsigned voffA[2], voffB[2];
#pragma unroll
    for (int i = 0; i < 2; ++i) { int R, C; stage_rc(tid * 16 + i * 8192, R, C); const int Rb = Epi::PERM ? ((R & ~31) + perm32(R & 31)) : R;
        voffA[i] = (unsigned)(R * K + C) * 2u; voffB[i] = (unsigned)(Rb * K + C) * 2u; }
    const size_t kstep = (size_t)(BK * 2);
    const size_t hstep = (size_t)HALF * K * 2;
    const size_t tstep = 2 * hstep;
    const unsigned ldsw = (unsigned)wid * 1024u;
    const int aoff = lds_byte(wr * 64 + fr, fq * 8), boff = lds_byte(wc * 32 + fr, fq * 8);
#define PG8_SA(b, h) (((b) * 2 + (h)) * HTB)
#define PG8_SB(b, h) ((4 + (b) * 2 + (h)) * HTB)
#define PG8_STAGE(bufoff, gbase, voff) do { _Pragma("unroll") for (int _i = 0; _i < 2; ++_i) \
        __builtin_amdgcn_global_load_lds((const unsigned*)((const char*)(gbase) + (voff)[_i]), (PG8_LAS unsigned*)(lds + (bufoff) + ldsw + _i * 8192), 16, 0, 0); } while (0)
#define PG8_LDA(dst, b, h) do { _Pragma("unroll") for (int m = 0; m < 4; ++m) _Pragma("unroll") for (int k = 0; k < 2; ++k) dst[m][k] = *(const PG8_LAS bf16x8*)(lds + PG8_SA(b, h) + aoff + m * 2048 + k * 1024); } while (0)
#define PG8_LDB(dst, b, h) do { _Pragma("unroll") for (int n = 0; n < 2; ++n) _Pragma("unroll") for (int k = 0; k < 2; ++k) dst[n][k] = *(const PG8_LAS bf16x8*)(lds + PG8_SB(b, h) + boff + n * 2048 + k * 1024); } while (0)
#define PG8_MMA(ai, bj, At, Bt) do { __builtin_amdgcn_s_setprio(1); _Pragma("unroll") for (int m = 0; m < 4; ++m) _Pragma("unroll") for (int n = 0; n < 2; ++n) _Pragma("unroll") for (int k = 0; k < 2; ++k) \
        acc[ai][bj][m][n] = __builtin_amdgcn_mfma_f32_16x16x32_bf16(Bt[n][k], At[m][k], acc[ai][bj][m][n], 0, 0, 0); __builtin_amdgcn_s_setprio(0); } while (0)
#define PG8_WAIT_V(n) asm volatile("s_waitcnt vmcnt(" #n ")" ::: "memory")
#define PG8_WAIT_L(n) asm volatile("s_waitcnt lgkmcnt(" #n ")" ::: "memory")
#define PG8_BAR __builtin_amdgcn_s_barrier()
#define PG8_SCHED __builtin_amdgcn_sched_barrier(0)
    Unit cur, nxt; int ui = 0;
    if (!S.next(0, cur)) return;
    f32x4 acc[2][2][4][2];
#pragma unroll
    for (int a = 0; a < 2; ++a)
#pragma unroll
        for (int b = 0; b < 2; ++b)
#pragma unroll
            for (int m = 0; m < 4; ++m)
#pragma unroll
                for (int n = 0; n < 2; ++n) acc[a][b][m][n] = (f32x4){0.f, 0.f, 0.f, 0.f};
    bf16x8 At[4][2], B0[2][2], B1[2][2];
    const char* cA = (const char*)g.A + (size_t)cur.pm * tstep; const char* cB = (const char*)g.Bt + (size_t)cur.pn * tstep;
    S.a_ready(cur);
    if constexpr (Epi::ROWSCALE) {
        int pmB = -1, pmC = -1, pmD = -1; Unit uu;
        for (int i = 1; S.next(i, uu); ++i) if (uu.pm != cur.pm && uu.pm != pmB && uu.pm != pmC && uu.pm != pmD) { if (pmB < 0) pmB = uu.pm; else if (pmC < 0) pmC = uu.pm; else if (pmD < 0) pmD = uu.pm; }
        f32x4 a0, b0, a1, b1, a2, b2, a3, b3; Unit t0 = cur, t1 = cur, t2 = cur, t3 = cur; t1.pm = pmB < 0 ? cur.pm : pmB; t2.pm = pmC < 0 ? cur.pm : pmC; t3.pm = pmD < 0 ? cur.pm : pmD;
        E.rs_issue(t0, tid, a0, b0); E.rs_issue(t1, tid, a1, b1); E.rs_issue(t2, tid, a2, b2); E.rs_issue(t3, tid, a3, b3);
        E.rs_write(tid, a3, b3, (PG8_LAS float*)(lds + STAGE_BYTES + ((t3.pm >> 3) & 3) * 1024));
        E.rs_write(tid, a2, b2, (PG8_LAS float*)(lds + STAGE_BYTES + ((t2.pm >> 3) & 3) * 1024));
        E.rs_write(tid, a1, b1, (PG8_LAS float*)(lds + STAGE_BYTES + ((t1.pm >> 3) & 3) * 1024));
        E.rs_write(tid, a0, b0, (PG8_LAS float*)(lds + STAGE_BYTES + ((t0.pm >> 3) & 3) * 1024));
    }
    if constexpr (SP2) {
        PG8_STAGE(PG8_SB(0, 0), cB, voffB); PG8_STAGE(PG8_SB(0, 1), cB + hstep, voffB); PG8_STAGE(PG8_SA(0, 0), cA, voffA); PG8_STAGE(PG8_SA(0, 1), cA + hstep, voffA);
        if (wr == 1) PG8_BAR;
        PG8_WAIT_V(2); PG8_BAR;
        PG8_STAGE(PG8_SB(1, 0), cB + kstep, voffB); PG8_STAGE(PG8_SA(1, 0), cA + kstep, voffA); PG8_STAGE(PG8_SB(1, 1), cB + hstep + kstep, voffB);
        PG8_WAIT_V(6); PG8_BAR;
    } else {
        PG8_STAGE(PG8_SB(0, 0), cB, voffB); PG8_STAGE(PG8_SA(0, 0), cA, voffA); PG8_STAGE(PG8_SB(0, 1), cB + hstep, voffB); PG8_STAGE(PG8_SA(0, 1), cA + hstep, voffA);
        if (wr == 1) PG8_BAR;
        PG8_WAIT_V(4); PG8_BAR;
        PG8_STAGE(PG8_SB(1, 0), cB + kstep, voffB); PG8_STAGE(PG8_SA(1, 0), cA + kstep, voffA); PG8_STAGE(PG8_SB(1, 1), cB + hstep + kstep, voffB);
        PG8_WAIT_V(6); PG8_BAR;
    }
    for (;;) {
        const bool has_next = S.next(ui + 1, nxt);
        const char* nA = has_next ? (const char*)g.A + (size_t)nxt.pm * tstep : cA; const char* nB = has_next ? (const char*)g.Bt + (size_t)nxt.pn * tstep : cB;
        for (int t = 0; t < nt; t += 2) {
            const bool last = (t == nt - 2);
            const char* a1 = cA + (size_t)(t + 1) * kstep;
            const char* a2 = last ? nA : cA + (size_t)(t + 2) * kstep; const char* b2 = last ? nB : cB + (size_t)(t + 2) * kstep;
            const char* a3 = a2 + kstep; const char* b3 = b2 + kstep;
            if (last && has_next) S.a_ready(nxt);
            if constexpr (SP2) {
            PG8_LDB(B0, 0, 0); PG8_LDB(B1, 0, 1); PG8_SCHED; PG8_LDA(At, 0, 0); PG8_STAGE(PG8_SA(1, 1), a1 + hstep, voffA);
            PG8_WAIT_V(8); PG8_WAIT_L(0); PG8_BAR; PG8_MMA(0, 0, At, B0); PG8_MMA(0, 1, At, B1); PG8_BAR; PG8_SCHED;
            PG8_LDA(At, 0, 1); PG8_STAGE(PG8_SB(0, 0), b2, voffB); PG8_STAGE(PG8_SB(0, 1), b2 + hstep, voffB); PG8_STAGE(PG8_SA(0, 0), a2, voffA);
            PG8_WAIT_V(8); PG8_WAIT_L(0); PG8_BAR; PG8_MMA(1, 0, At, B0); PG8_MMA(1, 1, At, B1); PG8_BAR; PG8_SCHED;
            PG8_LDB(B0, 1, 0); PG8_LDB(B1, 1, 1); PG8_SCHED; PG8_LDA(At, 1, 0); PG8_STAGE(PG8_SA(0, 1), a2 + hstep, voffA);
            PG8_WAIT_V(8); PG8_WAIT_L(0); PG8_BAR; PG8_MMA(0, 0, At, B0); PG8_MMA(0, 1, At, B1); PG8_BAR; PG8_SCHED;
            PG8_LDA(At, 1, 1); PG8_STAGE(PG8_SB(1, 0), b3, voffB); PG8_STAGE(PG8_SB(1, 1), b3 + hstep, voffB); PG8_STAGE(PG8_SA(1, 0), a3, voffA);
            PG8_WAIT_V(8); PG8_WAIT_L(0); PG8_BAR; PG8_MMA(1, 0, At, B0); PG8_MMA(1, 1, At, B1); PG8_BAR; PG8_SCHED;
            } else {
            PG8_LDB(B0, 0, 0); PG8_SCHED; PG8_LDA(At, 0, 0); PG8_STAGE(PG8_SA(1, 1), a1 + hstep, voffA);
            PG8_WAIT_L(8); PG8_BAR; PG8_WAIT_L(0); PG8_MMA(0, 0, At, B0); PG8_BAR; PG8_SCHED;
            PG8_LDB(B1, 0, 1); PG8_STAGE(PG8_SB(0, 0), b2, voffB);
            PG8_BAR; PG8_WAIT_L(0); PG8_MMA(0, 1, At, B1); PG8_BAR;
            PG8_LDA(At, 0, 1); PG8_STAGE(PG8_SA(0, 0), a2, voffA);
            PG8_BAR; PG8_WAIT_L(0); PG8_MMA(1, 0, At, B0); PG8_BAR; PG8_SCHED;
            PG8_STAGE(PG8_SB(0, 1), b2 + hstep, voffB);
            PG8_WAIT_V(6); PG8_BAR; PG8_MMA(1, 1, At, B1); PG8_BAR;
            PG8_LDB(B0, 1, 0); PG8_SCHED; PG8_LDA(At, 1, 0); PG8_STAGE(PG8_SA(0, 1), a2 + hstep, voffA);
            PG8_WAIT_L(8); PG8_BAR; PG8_WAIT_L(0); PG8_MMA(0, 0, At, B0); PG8_BAR; PG8_SCHED;
            PG8_LDB(B1, 1, 1); PG8_STAGE(PG8_SB(1, 0), b3, voffB);
            PG8_BAR; PG8_WAIT_L(0); PG8_MMA(0, 1, At, B1); PG8_BAR;
            PG8_LDA(At, 1, 1); PG8_STAGE(PG8_SA(1, 0), a3, voffA);
            PG8_BAR; PG8_WAIT_L(0); PG8_MMA(1, 0, At, B0); PG8_BAR; PG8_SCHED;
            PG8_STAGE(PG8_SB(1, 1), b3 + hstep, voffB);
            PG8_WAIT_V(6); PG8_BAR; PG8_MMA(1, 1, At, B1); PG8_BAR;
            }
        }
        if constexpr (ALIGN_EPI) { if (wr == 0) PG8_BAR; }
        if constexpr (!Epi::AFTER_DRAIN) {
            if constexpr (Epi::ROWSCALE) E(acc, cur, wr, wc, fr, fq, (const PG8_LAS float*)(lds + STAGE_BYTES + ((cur.pm >> 3) & 3) * 1024));
            else E(acc, cur, wr, wc, fr, fq);
            S.done(cur); }
        if (!has_next) break;
#pragma unroll
        for (int a = 0; a < 2; ++a)
#pragma unroll
            for (int b = 0; b < 2; ++b)
#pragma unroll
                for (int m = 0; m < 4; ++m)
#pragma unroll
                    for (int n = 0; n < 2; ++n) acc[a][b][m][n] = (f32x4){0.f, 0.f, 0.f, 0.f};
        cur = nxt; cA = nA; cB = nB; ++ui;
        if constexpr (ALIGN_EPI) { if (wr == 1) PG8_BAR; }
    }
    PG8_WAIT_V(0);
    if constexpr (!ALIGN_EPI) { if (wr == 0) PG8_BAR; }
    PG8_BAR;
    if constexpr (Epi::AFTER_DRAIN) { E.fused(acc, cur, wr, wc, fr, fq, lds, wid, lane); S.done(cur); }
#undef PG8_SA
#undef PG8_SB
#undef PG8_STAGE
#undef PG8_LDA
#undef PG8_LDB
#undef PG8_MMA
#undef PG8_WAIT_V
#undef PG8_WAIT_L
#undef PG8_BAR
#undef PG8_SCHED
}
}

#define LAS __attribute__((address_space(3)))
#define GAS __attribute__((address_space(1)))
#define GLD(T, p) (*(const GAS T*)(p))
#define GST(T, p, v) (*(GAS T*)(p) = (v))
typedef unsigned short bf16_t;
typedef short bf16x8 __attribute__((ext_vector_type(8)));
typedef short bf16x4 __attribute__((ext_vector_type(4)));
typedef float f32x4 __attribute__((ext_vector_type(4)));
typedef float f32x16 __attribute__((ext_vector_type(16)));
typedef unsigned u32x4 __attribute__((ext_vector_type(4)));
typedef unsigned u32x2 __attribute__((ext_vector_type(2)));

constexpr int BATCH = 8, SEQ = 4096, DM = 1024, MTOK = BATCH * SEQ, DFF = 2816, DEPTH = 2, NIN = 4888;
constexpr int NTHR = 512, NWAVE = 8;
constexpr float EPS = 1e-6f, LOG2E = 1.4426950408889634f;
constexpr float QSCALE = 0.125f * LOG2E;
constexpr size_t MiB = 1u << 20;
constexpr size_t WS_BIAS = 0;
constexpr size_t WS_PRM = 64 * 1024;
constexpr size_t WS_CB1 = 68 * 1024;
constexpr size_t WS_W13 = 1 * MiB;
constexpr size_t W13_SZ = (size_t)5632 * 1024 * 2;
constexpr size_t WS_W2 = 45 * MiB;
constexpr size_t W2_SZ = (size_t)1024 * 2816 * 2;
constexpr size_t WS_WIN = 68 * MiB;
constexpr size_t WIN_SZ = (size_t)5120 * 1024 * 2;
constexpr size_t WS_PAB = 88 * MiB;
constexpr size_t PAB_SZ = (size_t)2048 * 1024 * 2;
constexpr size_t WS_WO = 96 * MiB;
constexpr size_t WO_SZ = (size_t)1024 * 1024 * 2;
constexpr size_t WS_CW1 = 100 * MiB;
constexpr size_t CW1_SZ = (size_t)128 * 2048 * 2;
constexpr size_t WS_CW2 = 102 * MiB;
constexpr size_t CW2_SZ = (size_t)64 * 128 * 2;
constexpr size_t WS_KCN = 103 * MiB;
constexpr size_t WS_VCT = WS_KCN + 512 * 1024;
constexpr size_t WS_XN = 104 * MiB;
constexpr size_t WS_Z = 168 * MiB;
constexpr size_t Z_DQ = WS_Z, Z_DK = WS_Z + 32 * MiB, Z_DVT = WS_Z + 64 * MiB, Z_NQ = WS_Z + 96 * MiB;
constexpr size_t Z_KCR = WS_Z + 128 * MiB, Z_VCR = WS_Z + 136 * MiB, Z_KSEL = WS_Z + 144 * MiB, Z_VSELT = WS_Z + 152 * MiB;
constexpr size_t Z_KWIN = WS_Z + 160 * MiB, Z_VWINT = WS_Z + 168 * MiB, Z_NG = WS_Z + 176 * MiB, Z_MG = WS_Z + 180 * MiB;
constexpr size_t WS_MERGED = WS_Z;
constexpr size_t WS_HID = WS_Z;
constexpr size_t WS_SS = WS_Z + 308 * MiB;
constexpr size_t WS_END = WS_SS + 2 * MiB;
constexpr int LDS_BYTES = 147456;
constexpr int KP = 144, VP = 136;
constexpr int DA_STAGE = 2 * 64 * KP + 128 * VP;
constexpr int NS_STAGE = 64 * KP + 64 * VP;
constexpr int L_BIAS = 73728;
constexpr int TBN = 1216;
constexpr int L_IMP = L_BIAS + 4 * TBN * 4;
constexpr int L_SEL = L_IMP + 16384;
constexpr int L_WSF = L_SEL + 1024;
constexpr int L_END = L_WSF + 8 * 256;

struct Params {
    const float* in[30];
    float* out;
    unsigned char* ws;
};

constexpr int L_PTAB = LDS_BYTES - 1024;
__device__ __forceinline__ const float* ld_ptr(const LAS unsigned char* lds, int i) {
    unsigned a = L_PTAB + 8 * i; asm volatile("" : "+v"(a));
    const LAS unsigned* t = (const LAS unsigned*)(lds + a);
    const unsigned lo = __builtin_amdgcn_readfirstlane(t[0]), hi = __builtin_amdgcn_readfirstlane(t[1]);
    return (const float*)(((unsigned long long)hi << 32) | lo);
}
#define INP(i) ld_ptr(lds, (i))
#define OUTP ((float*)ld_ptr(lds, 30))
#define WSP ((unsigned char*)ld_ptr(lds, 31))

__device__ __forceinline__ unsigned f2bf(float f) { unsigned u = __builtin_bit_cast(unsigned, f); return (u + 0x7fffu + ((u >> 16) & 1u)) >> 16; }
__device__ __forceinline__ unsigned pk2(float lo, float hi) { return f2bf(lo) | (f2bf(hi) << 16); }
__device__ __forceinline__ float sigmoidf_(float x) { return __builtin_amdgcn_rcpf(1.0f + __builtin_amdgcn_exp2f(-x * LOG2E)); }
__device__ __forceinline__ int otid() { int t = threadIdx.x; asm volatile("" : "+v"(t)); return t; }
__device__ __forceinline__ int crow(int r, int hi) { return (r & 3) + 8 * (r >> 2) + 4 * hi; }


struct RowScale {
    const float* ss;
    __device__ __forceinline__ void rs_issue(const pg8::Unit& u, int tid, f32x4& pa, f32x4& pb) const {
        const float* p = ss + (size_t)(u.pm * 256 + (tid >> 1)) * 16 + (tid & 1) * 8; pa = GLD(f32x4, p); pb = GLD(f32x4, p + 4); }
    __device__ __forceinline__ void rs_write(int tid, const f32x4& pa, const f32x4& pb, LAS float* tab) const {
        float t = ((pa.x + pa.y) + (pa.z + pa.w)) + ((pb.x + pb.y) + (pb.z + pb.w)); t += __shfl_xor(t, 1);
        if (!(tid & 1)) tab[tid >> 1] = __builtin_amdgcn_rsqf(t * (1.f / DM) + EPS); }
};
struct EpiSwiGLU : RowScale {
    static constexpr bool PERM = true, AFTER_DRAIN = false, ROWSCALE = true;
    bf16_t* H;
    __device__ __forceinline__ void operator()(const f32x4 (&acc)[2][2][4][2], const pg8::Unit& u, int wr, int wc, int fr, int fq, const LAS float* rst) const {
        const int row0 = u.pm * 256 + wr * 64 + fr, col = u.pn * 128 + wc * 32 + 8 * fq;
#pragma unroll
        for (int ai = 0; ai < 2; ++ai)
#pragma unroll
            for (int m = 0; m < 4; ++m) {
                float h[8];
                const float rs = rst[ai * 128 + wr * 64 + m * 16 + fr];
#pragma unroll
                for (int n = 0; n < 2; ++n)
#pragma unroll
                    for (int e = 0; e < 4; ++e) { const float g = acc[ai][0][m][n][e] * rs, up = acc[ai][1][m][n][e] * rs; h[n * 4 + e] = g * sigmoidf_(g) * up; }
                u32x4 w; w.x = pg8::cvt_pk_bf16(h[0], h[1]); w.y = pg8::cvt_pk_bf16(h[2], h[3]); w.z = pg8::cvt_pk_bf16(h[4], h[5]); w.w = pg8::cvt_pk_bf16(h[6], h[7]);
                GST(u32x4, H + (size_t)(row0 + ai * 128 + m * 16) * DFF + col, w);
            }
    }
};
template <bool BF32, bool OF32> struct EpiResidT {
    static constexpr bool PERM = false, AFTER_DRAIN = false, ROWSCALE = false;
    const void* base; void* out; float alpha; float* ss;
    __device__ __forceinline__ void operator()(const f32x4 (&acc)[2][2][4][2], const pg8::Unit& u, int wr, int wc, int fr, int fq) const {
        const int row0 = u.pm * 256 + wr * 64 + fr, col0 = u.pn * 256 + wc * 32 + 4 * fq;
#pragma unroll
        for (int ai = 0; ai < 2; ++ai) {
            f32x4 bv[4][2][2];
#pragma unroll
            for (int m = 0; m < 4; ++m) {
                const size_t off = (size_t)(row0 + ai * 128 + m * 16) * DM + col0;
#pragma unroll
                for (int bj = 0; bj < 2; ++bj)
#pragma unroll
                    for (int n = 0; n < 2; ++n) {
                        if (BF32) bv[m][bj][n] = GLD(f32x4, (const float*)base + off + bj * 128 + n * 16);
                        else { const u32x2 w = GLD(u32x2, (const bf16_t*)base + off + bj * 128 + n * 16);
                               bv[m][bj][n] = (f32x4){__builtin_bit_cast(float, w.x << 16), __builtin_bit_cast(float, w.x & 0xffff0000u), __builtin_bit_cast(float, w.y << 16), __builtin_bit_cast(float, w.y & 0xffff0000u)}; }
                    }
            }
#pragma unroll
            for (int m = 0; m < 4; ++m) {
                const int row = row0 + ai * 128 + m * 16;
                const size_t off = (size_t)row * DM + col0;
                float sq = 0.f;
#pragma unroll
                for (int bj = 0; bj < 2; ++bj)
#pragma unroll
                    for (int n = 0; n < 2; ++n) {
                        const f32x4 o = bv[m][bj][n] + acc[ai][bj][m][n] * alpha;
                        sq += (o.x * o.x + o.y * o.y) + (o.z * o.z + o.w * o.w);
                        if (OF32) GST(f32x4, (float*)out + off + bj * 128 + n * 16, o);
                        else { u32x2 w; w.x = pg8::cvt_pk_bf16(o.x, o.y); w.y = pg8::cvt_pk_bf16(o.z, o.w); GST(u32x2, (bf16_t*)out + off + bj * 128 + n * 16, w); }
                    }
                if (!OF32) { sq += __shfl_xor(sq, 16); sq += __shfl_xor(sq, 32); if (fq == 0) GST(float, ss + (size_t)row * 16 + u.pn * 4 + wc, sq); }
            }
        }
    }
};
struct EpiMerge {
    static constexpr bool PERM = true, AFTER_DRAIN = false, ROWSCALE = false;
    const bf16_t* MG; bf16_t* O;
    __device__ __forceinline__ void operator()(const f32x4 (&acc)[2][2][4][2], const pg8::Unit& u, int wr, int wc, int fr, int fq) const {
        const int row0 = u.pm * 256 + wr * 64 + fr, col = u.pn * 128 + wc * 32 + 8 * fq;
#pragma unroll
        for (int ai = 0; ai < 2; ++ai) {
            u32x4 g0[4], g1[4];
#pragma unroll
            for (int m = 0; m < 4; ++m) { const int row = row0 + ai * 128 + m * 16; g0[m] = GLD(u32x4, MG + (size_t)row * 2048 + col); g1[m] = GLD(u32x4, MG + (size_t)row * 2048 + 1024 + col); }
#pragma unroll
            for (int m = 0; m < 4; ++m) {
                const int row = row0 + ai * 128 + m * 16;
                float h[8];
#pragma unroll
                for (int i = 0; i < 8; ++i) {
                    const unsigned w0 = g0[m][i >> 1], w1 = g1[m][i >> 1];
                    const float a0 = __builtin_bit_cast(float, (i & 1) ? (w0 & 0xffff0000u) : (w0 << 16)), a1 = __builtin_bit_cast(float, (i & 1) ? (w1 & 0xffff0000u) : (w1 << 16));
                    h[i] = a0 * acc[ai][0][m][i >> 2][i & 3] + a1 * acc[ai][1][m][i >> 2][i & 3];
                }
                u32x4 w; w.x = pg8::cvt_pk_bf16(h[0], h[1]); w.y = pg8::cvt_pk_bf16(h[2], h[3]); w.z = pg8::cvt_pk_bf16(h[4], h[5]); w.w = pg8::cvt_pk_bf16(h[6], h[7]);
                GST(u32x4, O + (size_t)row * DM + col, w);
            }
        }
    }
};
struct EpiZ : RowScale {
    static constexpr bool PERM = true, AFTER_DRAIN = false, ROWSCALE = true;
    unsigned char* ws; const float *gq, *gk, *gnq, *gnk;
    __device__ __forceinline__ void operator()(const f32x4 (&acc)[2][2][4][2], const pg8::Unit& u, int wr, int wc, int fr, int fq, const LAS float* rst) const {
        const int ch = 4 * u.pn + wc;
        if (ch >= 77) return;
        const int row0 = u.pm * 256 + wr * 64 + fr;
        int kind, nh = 8, hd = 0, nd = 64, dbase = 0; size_t dst = 0; const float* gain = nullptr; float scale = 1.f;
        if (ch < 8) { kind = 0; dst = Z_DQ; hd = ch; gain = gq; scale = QSCALE; }
        else if (ch < 16) { kind = 0; dst = Z_DK; hd = ch - 8; gain = gk; }
        else if (ch < 24) { kind = 2; dst = Z_DVT; nh = 4; hd = (ch - 16) >> 1; nd = 128; dbase = ((ch - 16) & 1) * 64; }
        else if (ch < 32) { kind = 0; dst = Z_NQ; hd = ch - 24; gain = gnq; scale = QSCALE; }
        else if (ch < 34) { kind = 1; dst = Z_KCR; nh = 2; hd = ch - 32; }
        else if (ch < 36) { kind = 1; dst = Z_VCR; nh = 2; hd = ch - 34; }
        else if (ch < 38) { kind = 0; dst = Z_KSEL; nh = 2; hd = ch - 36; gain = gnk + 64; }
        else if (ch < 40) { kind = 2; dst = Z_VSELT; nh = 2; hd = ch - 38; }
        else if (ch < 42) { kind = 0; dst = Z_KWIN; nh = 2; hd = ch - 40; gain = gnk + 128; }
        else if (ch < 44) { kind = 2; dst = Z_VWINT; nh = 2; hd = ch - 42; }
        else if (ch < 76) { kind = 3; }
        else { kind = 4; }
        if (kind == 0 || kind == 1) {
            float gv[16];
#pragma unroll
            for (int i = 0; i < 16; ++i) gv[i] = (kind == 0) ? gain[(i >> 3) * 32 + 8 * fq + (i & 7)] * scale : 1.f;
#pragma unroll
            for (int ai = 0; ai < 2; ++ai)
#pragma unroll
                for (int m = 0; m < 4; ++m) {
                    const int row = row0 + ai * 128 + m * 16, b = row >> 12, s = row & 4095;
                    float v[16];
                    const float rrs = rst[ai * 128 + wr * 64 + m * 16 + fr];
#pragma unroll
                    for (int i = 0; i < 16; ++i) v[i] = acc[ai][i >> 3][m][(i >> 2) & 1][i & 3] * rrs;
                    float rs = 1.f;
                    if (kind == 0) {
                        float ss = 0.f;
#pragma unroll
                        for (int i = 0; i < 16; ++i) ss += v[i] * v[i];
                        ss += __shfl_xor(ss, 16); ss += __shfl_xor(ss, 32);
                        rs = __builtin_amdgcn_rsqf(ss * (1.f / 64.f) + EPS);
                    }
#pragma unroll
                    for (int i = 0; i < 16; ++i) v[i] *= rs * gv[i];
                    bf16_t* d = (bf16_t*)(ws + dst) + ((size_t)(b * nh + hd) * SEQ + s) * 64 + 8 * fq;
                    u32x4 w0, w1;
                    w0.x = pg8::cvt_pk_bf16(v[0], v[1]); w0.y = pg8::cvt_pk_bf16(v[2], v[3]); w0.z = pg8::cvt_pk_bf16(v[4], v[5]); w0.w = pg8::cvt_pk_bf16(v[6], v[7]);
                    w1.x = pg8::cvt_pk_bf16(v[8], v[9]); w1.y = pg8::cvt_pk_bf16(v[10], v[11]); w1.z = pg8::cvt_pk_bf16(v[12], v[13]); w1.w = pg8::cvt_pk_bf16(v[14], v[15]);
                    GST(u32x4, d, w0); GST(u32x4, d + 32, w1);
                }
        } else if (kind == 2) {
#pragma unroll
            for (int ai = 0; ai < 2; ++ai)
#pragma unroll
                for (int m = 0; m < 4; ++m) {
                    const int row = row0 + ai * 128 + m * 16, b = row >> 12, s = row & 4095;
                    bf16_t* d = (bf16_t*)(ws + dst) + ((size_t)(b * nh + hd) * nd + dbase + 8 * fq) * SEQ + s;
                    const float rrs = rst[ai * 128 + wr * 64 + m * 16 + fr];
#pragma unroll
                    for (int i = 0; i < 16; ++i) GST(bf16_t, d + (size_t)((i >> 3) * 32 + (i & 7)) * SEQ, (bf16_t)f2bf(acc[ai][i >> 3][m][(i >> 2) & 1][i & 3] * rrs));
                }
        } else if (kind == 3) {
            const int col = (ch - 44) * 64 + 8 * fq;
#pragma unroll
            for (int ai = 0; ai < 2; ++ai)
#pragma unroll
                for (int m = 0; m < 4; ++m) {
                    const int row = row0 + ai * 128 + m * 16;
                    float v[16];
                    const float rrs = rst[ai * 128 + wr * 64 + m * 16 + fr];
#pragma unroll
                    for (int i = 0; i < 16; ++i) v[i] = sigmoidf_(acc[ai][i >> 3][m][(i >> 2) & 1][i & 3] * rrs);
                    bf16_t* d = (bf16_t*)(ws + Z_MG) + (size_t)row * 2048 + col;
                    u32x4 w0, w1;
                    w0.x = pg8::cvt_pk_bf16(v[0], v[1]); w0.y = pg8::cvt_pk_bf16(v[2], v[3]); w0.z = pg8::cvt_pk_bf16(v[4], v[5]); w0.w = pg8::cvt_pk_bf16(v[6], v[7]);
                    w1.x = pg8::cvt_pk_bf16(v[8], v[9]); w1.y = pg8::cvt_pk_bf16(v[10], v[11]); w1.z = pg8::cvt_pk_bf16(v[12], v[13]); w1.w = pg8::cvt_pk_bf16(v[14], v[15]);
                    GST(u32x4, d, w0); GST(u32x4, d + 32, w1);
                }
        } else {
            if (fq < 3) {
#pragma unroll
                for (int ai = 0; ai < 2; ++ai)
#pragma unroll
                    for (int m = 0; m < 4; ++m) {
                        const int row = row0 + ai * 128 + m * 16;
                        float* d = (float*)(ws + Z_NG) + (size_t)row * 24 + 8 * fq;
                        const float rrs = rst[ai * 128 + wr * 64 + m * 16 + fr];
#pragma unroll
                        for (int i = 0; i < 8; ++i) GST(float, d + i, sigmoidf_(acc[ai][0][m][i >> 2][i & 3] * rrs));
                    }
            }
        }
    }
};

__device__ __forceinline__ void tr_item(const float* src, int ld, int c0, int nvalid, int k0, bf16_t* dst, int Kdst, LAS float* scr, int lane, const float* rsc = nullptr) {
    const int n = lane & 31;
#pragma unroll
    for (int i = 0; i < 32; ++i) { const int kk = 2 * i + (lane >> 5); scr[kk * 33 + n] = (src && n < nvalid) ? GLD(float, src + (size_t)(k0 + kk) * ld + c0 + n) * (rsc ? GLD(float, rsc + k0 + kk) : 1.f) : 0.f; }
    asm volatile("s_waitcnt lgkmcnt(0)" ::: "memory");
    const int c = lane & 7;
#pragma unroll
    for (int j = 0; j < 4; ++j) { const int nn = (lane >> 3) + 8 * j; const LAS float* s = scr + (8 * c) * 33 + nn;
        u32x4 o; o.x = pk2(s[0 * 33], s[1 * 33]); o.y = pk2(s[2 * 33], s[3 * 33]); o.z = pk2(s[4 * 33], s[5 * 33]); o.w = pk2(s[6 * 33], s[7 * 33]);
        GST(u32x4, dst + (size_t)nn * Kdst + 8 * c, o); }
    asm volatile("s_waitcnt lgkmcnt(0)" ::: "memory");
}
__device__ __forceinline__ int zchunk_src(int ch) {
    if (ch < 32) return ch * 64;
    if (ch < 44) return 2048 + (ch - 32) * 64;
    if (ch < 76) return 2840 + (ch - 44) * 64;
    return 2816;
}
__device__ __forceinline__ int t5_bucket(int n) {
    if (n < 16) return n;
    int b = 16;
    b += (n >= 21); b += (n >= 27); b += (n >= 35); b += (n >= 46); b += (n >= 59); b += (n >= 77); b += (n >= 99); b += (n >= 128);
    b += (n >= 166); b += (n >= 216); b += (n >= 280); b += (n >= 363); b += (n >= 470); b += (n >= 609); b += (n >= 790);
    return b;
}
__device__ __forceinline__ void prologue(const Params& P, LAS unsigned char* lds) {
    const int tid = otid(), lane = tid & 63, wave = tid >> 6;
    LAS float* scr = (LAS float*)(lds + wave * 16384);
    const int gw = blockIdx.x * NWAVE + wave, NGW = gridDim.x * NWAVE;
    unsigned char* ws = WSP;
    constexpr int I13 = 176 * 16, I2 = 32 * 44, IIN = 160 * 16, IPAB = 64 * 16, IWO = 32 * 16, IC1 = 4 * 32, IC2 = 2 * 2;
    constexpr int PER_L = 2 * I13 + 2 * I2 + IIN + IPAB + IWO + 2 * IC1 + 2 * IC2;
    for (int it = gw; it < DEPTH * PER_L; it += NGW) {
        const int l = it / PER_L; int r = it % PER_L;
        if (r < 2 * I13) {
            const int f = r / I13; r %= I13; const int gi = r / 16, kb = r % 16;
            const int t = gi >> 3, bj = (gi >> 2) & 1, sub = gi & 3;
            const float* src = (f ? (bj ? INP(12) : INP(11)) : (bj ? INP(9) : INP(8))) + (size_t)l * DM * DFF;
            tr_item(src, DFF, 128 * t + 32 * sub, 32, 64 * kb, (bf16_t*)(ws + WS_W13 + (size_t)(l * 2 + f) * W13_SZ) + (size_t)(32 * gi) * DM + 64 * kb, DM, scr, lane, (f ? INP(7) : INP(5)) + l * DM);
            continue;
        }
        r -= 2 * I13;
        if (r < 2 * I2) {
            const int f = r / I2; r %= I2; const int gi = r / 44, kb = r % 44;
            const float* src = (f ? INP(13) : INP(10)) + (size_t)l * DFF * DM;
            tr_item(src, DM, 32 * gi, 32, 64 * kb, (bf16_t*)(ws + WS_W2 + (size_t)(l * 2 + f) * W2_SZ) + (size_t)(32 * gi) * DFF + 64 * kb, DFF, scr, lane);
            continue;
        }
        r -= 2 * I2;
        if (r < IIN) {
            const int gi = r / 16, kb = r % 16;
            const int t = gi >> 3, bj = (gi >> 2) & 1, wc = gi & 3, ch = 4 * t + wc;
            int nvalid = 32; if (ch == 76) nvalid = bj ? 0 : 24; if (ch > 76) nvalid = 0;
            const float* src = nvalid ? INP(1) + (size_t)l * DM * NIN : nullptr;
            tr_item(src, NIN, zchunk_src(ch) + 32 * bj, nvalid, 64 * kb, (bf16_t*)(ws + WS_WIN + (size_t)l * WIN_SZ) + (size_t)(32 * gi) * DM + 64 * kb, DM, scr, lane, INP(6) + l * DM);
            continue;
        }
        r -= IIN;
        if (r < IPAB) {
            const int gi = r / 16, kb = r % 16;
            const int t = gi >> 3, bj = (gi >> 2) & 1, sub = gi & 3;
            const float* src = nullptr; int k0 = 0;
            if (bj == 0 && kb < 8) { src = INP(2) + (size_t)l * 512 * DM; k0 = 64 * kb; }
            if (bj == 1 && kb >= 8) { src = INP(3) + (size_t)l * 512 * DM; k0 = 64 * (kb - 8); }
            tr_item(src, DM, 128 * t + 32 * sub, 32, k0, (bf16_t*)(ws + WS_PAB + (size_t)l * PAB_SZ) + (size_t)(32 * gi) * DM + 64 * kb, DM, scr, lane);
            continue;
        }
        r -= IPAB;
        if (r < IWO) {
            const int gi = r / 16, kb = r % 16;
            tr_item(INP(4) + (size_t)l * DM * DM, DM, 32 * gi, 32, 64 * kb, (bf16_t*)(ws + WS_WO + (size_t)l * WO_SZ) + (size_t)(32 * gi) * DM + 64 * kb, DM, scr, lane);
            continue;
        }
        r -= IWO;
        if (r < 2 * IC1) {
            const int kv = r / IC1; r %= IC1; const int gi = r / 32, kb = r % 32;
            tr_item((kv ? INP(27) : INP(24)) + (size_t)l * 2048 * 128, 128, 32 * gi, 32, 64 * kb, (bf16_t*)(ws + WS_CW1 + (size_t)(l * 2 + kv) * CW1_SZ) + (size_t)(32 * gi) * 2048 + 64 * kb, 2048, scr, lane);
            continue;
        }
        r -= 2 * IC1;
        {
            const int kv = r / IC2; r %= IC2; const int gi = r / 2, kb = r % 2;
            tr_item((kv ? INP(28) : INP(25)) + (size_t)l * 128 * 64, 64, 32 * gi, 32, 64 * kb, (bf16_t*)(ws + WS_CW2 + (size_t)(l * 2 + kv) * CW2_SZ) + (size_t)(32 * gi) * 128 + 64 * kb, 128, scr, lane);
        }
    }
    const int gt = blockIdx.x * NTHR + tid, NGT = gridDim.x * NTHR;
    for (int i = gt; i < 12 * 1024; i += NGT) { const int h = i >> 10, d = i & 1023; ((float*)(ws + WS_BIAS))[i] = INP(29)[t5_bucket(d) * 12 + h] * LOG2E; }
    if (blockIdx.x == (gridDim.x > 1 ? 1 : 0) && wave < DEPTH) {
        const int l = wave;
        float a = INP(16)[l * 64 + lane] * INP(17)[l * 64 + lane], b = INP(18)[l * 64 + lane] * INP(19)[l * 64 + lane];
        float mq = fabsf(INP(14)[l * 64 + lane]), mk = fabsf(INP(15)[l * 64 + lane]), mnq = fabsf(INP(21)[l * 64 + lane]);
        float mnk = fmaxf(fmaxf(fabsf(INP(22)[l * 192 + lane]), fabsf(INP(22)[l * 192 + 64 + lane])), fabsf(INP(22)[l * 192 + 128 + lane]));
        float mb = 0.f; for (int i = lane; i < 32 * 12; i += 64) mb = fmaxf(mb, fabsf(INP(29)[i]));
#pragma unroll
        for (int o = 1; o < 64; o <<= 1) { a += __shfl_xor(a, o); b += __shfl_xor(b, o); mq = fmaxf(mq, __shfl_xor(mq, o)); mk = fmaxf(mk, __shfl_xor(mk, o)); mnq = fmaxf(mnq, __shfl_xor(mnq, o)); mnk = fmaxf(mnk, __shfl_xor(mnk, o)); mb = fmaxf(mb, __shfl_xor(mb, o)); }
        if (lane == 0) {
            float* prm = (float*)(ws + WS_PRM) + l * 8;
            const float lam_init = 0.8f - 0.6f * expf(-0.3f * (float)l);
            prm[0] = expf(a) - expf(b) + lam_init;
            prm[1] = (8.f * mq * mk * 1.02f + mb) * LOG2E;
            prm[2] = (8.f * mnq * mnk * 1.02f + mb) * LOG2E;
            prm[3] = 1.0f - lam_init;
        }
    }
    for (int wi = blockIdx.x; wi < 32; wi += gridDim.x) {
        const int lk = wi >> 3, n = (wi & 7) * 16 + (tid & 15), ks = tid >> 4, l = lk >> 1, kv = lk & 1;
        const float* pe = (kv ? INP(26) : INP(23)) + (size_t)l * 2048; const float* w1 = (kv ? INP(27) : INP(24)) + (size_t)l * 2048 * 128;
        float sacc = 0.f;
#pragma unroll 16
        for (int k = 64 * ks; k < 64 * ks + 64; ++k) sacc += GLD(float, pe + k) * GLD(float, w1 + (size_t)k * 128 + n);
        LAS float* red = (LAS float*)lds;
        __syncthreads();
        red[tid] = sacc;
        __syncthreads();
        if (tid < 16) { float t = 0.f; for (int i = 0; i < 32; ++i) t += red[i * 16 + tid]; ((float*)(ws + WS_CB1))[lk * 128 + (wi & 7) * 16 + tid] = t; }
        __syncthreads();
    }
}

template <bool INBF16, bool COPYRAW>
__device__ __forceinline__ void rmsnorm_phase(const void* x, const float* g, bf16_t* o, bf16_t* xraw = nullptr) {
    const int tid = otid(), lane = tid & 63, wave = tid >> 6;
    const int gw = blockIdx.x * NWAVE + wave, NGW = gridDim.x * NWAVE;
    f32x4 gv[4];
#pragma unroll
    for (int j = 0; j < 4; ++j) gv[j] = GLD(f32x4, (const f32x4*)g + lane + 64 * j);
    constexpr int RB = 4;
    for (int m0 = gw; m0 < MTOK; m0 += NGW * RB) {
        f32x4 v[RB][4]; float s[RB];
#pragma unroll
        for (int r = 0; r < RB; ++r) { const int m = m0 + r * NGW; const size_t ro = (size_t)(m < MTOK ? m : m0) * DM;
#pragma unroll
            for (int j = 0; j < 4; ++j) {
                if (!INBF16) v[r][j] = GLD(f32x4, (const f32x4*)((const float*)x + ro) + lane + 64 * j);
                else { const u32x2 w = GLD(u32x2, (const u32x2*)((const bf16_t*)x + ro) + lane + 64 * j);
                       if (COPYRAW && m < MTOK) GST(u32x2, (u32x2*)(xraw + ro) + lane + 64 * j, w);
                       v[r][j] = (f32x4){__builtin_bit_cast(float, w.x << 16), __builtin_bit_cast(float, w.x & 0xffff0000u), __builtin_bit_cast(float, w.y << 16), __builtin_bit_cast(float, w.y & 0xffff0000u)}; }
            } }
#pragma unroll
        for (int r = 0; r < RB; ++r) { s[r] = 0.f;
#pragma unroll
            for (int j = 0; j < 4; ++j) s[r] += (v[r][j].x * v[r][j].x + v[r][j].y * v[r][j].y) + (v[r][j].z * v[r][j].z + v[r][j].w * v[r][j].w); }
#pragma unroll
        for (int of = 1; of < 64; of <<= 1) {
#pragma unroll
            for (int r = 0; r < RB; ++r) s[r] += __shfl_xor(s[r], of); }
#pragma unroll
        for (int r = 0; r < RB; ++r) { const int m = m0 + r * NGW;
            if (m < MTOK) {
                const float rs = __builtin_amdgcn_rsqf(s[r] * (1.f / DM) + EPS);
                u32x2* o8 = (u32x2*)(o + (size_t)m * DM) + lane;
#pragma unroll
                for (int j = 0; j < 4; ++j) { u32x2 w; w.x = pk2(v[r][j].x * rs * gv[j].x, v[r][j].y * rs * gv[j].y); w.y = pk2(v[r][j].z * rs * gv[j].z, v[r][j].w * rs * gv[j].w); GST(u32x2, o8 + 64 * j, w); }
            }
        }
    }
}

__device__ __forceinline__ void xprep_phase(const float* x, bf16_t* o, float* ss) {
    const int tid = otid(), lane = tid & 63, wave = tid >> 6;
    const int gw = blockIdx.x * NWAVE + wave, NGW = gridDim.x * NWAVE;
    for (int m = gw; m < MTOK; m += NGW) {
        const f32x4* xr = (const f32x4*)(x + (size_t)m * DM) + lane;
        f32x4 v[4]; float s = 0.f;
#pragma unroll
        for (int j = 0; j < 4; ++j) { v[j] = GLD(f32x4, xr + 64 * j); s += (v[j].x * v[j].x + v[j].y * v[j].y) + (v[j].z * v[j].z + v[j].w * v[j].w); }
#pragma unroll
        for (int of = 1; of < 64; of <<= 1) s += __shfl_xor(s, of);
        u32x2* o8 = (u32x2*)(o + (size_t)m * DM) + lane;
#pragma unroll
        for (int j = 0; j < 4; ++j) { u32x2 w; w.x = pk2(v[j].x, v[j].y); w.y = pk2(v[j].z, v[j].w); GST(u32x2, o8 + 64 * j, w); }
        if (lane < 16) GST(float, ss + (size_t)m * 16 + lane, lane == 0 ? s : 0.f);
    }
}

__device__ __forceinline__ float gelu_tanh(float x) {
    const float y = 0.7978845608028654f * (x + 0.044715f * x * x * x);
    const float e = __builtin_amdgcn_exp2f(2.f * LOG2E * y);
    const float t = 1.f - 2.f * __builtin_amdgcn_rcpf(e + 1.f);
    return 0.5f * x * (1.f + t);
}
__device__ __forceinline__ void compress_phase(const Params& P, int l, LAS unsigned char* lds) {
    const int tid = otid(), lane = tid & 63, wave = tid >> 6, fr = lane & 15, kq = lane >> 4;
    unsigned char* ws = WSP;
    LAS bf16_t* Hs = (LAS bf16_t*)lds;
    LAS float* Os = (LAS float*)(lds + 8704);
    LAS unsigned char* As = lds + 17408;
    for (int unit = blockIdx.x; unit < 2 * 16 * 8; unit += gridDim.x) {
        const int kv = unit >> 7, bg = (unit >> 3) & 15, c0 = 32 * (unit & 7);
        const bf16_t* src = (const bf16_t*)(ws + (kv ? Z_VCR : Z_KCR)) + (size_t)bg * SEQ * 64;
        for (int i = tid; i < 33 * 128; i += NTHR) {
            const int j = i >> 7, pc = i & 127;
            u32x4 v = {0u, 0u, 0u, 0u};
            if (c0 + j <= 255) v = GLD(u32x4, (const unsigned char*)(src + (size_t)1024 * (c0 + j)) + pc * 16);
            *(LAS u32x4*)(As + j * 2064 + pc * 16) = v;
        }
        __syncthreads();
        const bf16_t* bp = (const bf16_t*)(ws + WS_CW1 + (size_t)(l * 2 + kv) * CW1_SZ) + (size_t)(16 * wave + fr) * 2048 + 8 * kq;
        f32x4 acc0 = {0.f, 0.f, 0.f, 0.f}, acc1 = {0.f, 0.f, 0.f, 0.f};
#pragma unroll
        for (int kb = 0; kb < 4; ++kb) {
            bf16x8 bfr[16];
#pragma unroll
            for (int i = 0; i < 16; ++i) bfr[i] = GLD(bf16x8, bp + 32 * (16 * kb + i));
#pragma unroll
            for (int i = 0; i < 16; ++i) {
                const int k = 32 * (16 * kb + i) + 8 * kq;
                const LAS unsigned char* ar = As + (fr + (k >> 10)) * 2064 + (k & 1023) * 2;
                const bf16x8 a0 = *(const LAS bf16x8*)ar, a1 = *(const LAS bf16x8*)(ar + 16 * 2064);
                acc0 = __builtin_amdgcn_mfma_f32_16x16x32_bf16(a0, bfr[i], acc0, 0, 0, 0);
                acc1 = __builtin_amdgcn_mfma_f32_16x16x32_bf16(a1, bfr[i], acc1, 0, 0, 0);
            }
        }
        const float cb = ((const float*)(ws + WS_CB1))[(l * 2 + kv) * 128 + 16 * wave + fr];
#pragma unroll
        for (int i = 0; i < 4; ++i) { Hs[(4 * kq + i) * 136 + 16 * wave + fr] = (bf16_t)f2bf(gelu_tanh(acc0[i] + cb)); Hs[(16 + 4 * kq + i) * 136 + 16 * wave + fr] = (bf16_t)f2bf(gelu_tanh(acc1[i] + cb)); }
        __syncthreads();
        {
            const int mt = wave >> 2, ns = wave & 3;
            const bf16_t* b2 = (const bf16_t*)(ws + WS_CW2 + (size_t)(l * 2 + kv) * CW2_SZ) + (size_t)(16 * ns + fr) * 128 + 8 * kq;
            f32x4 a2 = {0.f, 0.f, 0.f, 0.f};
#pragma unroll
            for (int kk = 0; kk < 4; ++kk) { const bf16x8 a = *(const LAS bf16x8*)(Hs + (16 * mt + fr) * 136 + 32 * kk + 8 * kq), b = GLD(bf16x8, b2 + 32 * kk); a2 = __builtin_amdgcn_mfma_f32_16x16x32_bf16(a, b, a2, 0, 0, 0); }
#pragma unroll
            for (int i = 0; i < 4; ++i) Os[(16 * mt + 4 * kq + i) * 65 + 16 * ns + fr] = a2[i];
        }
        __syncthreads();
#pragma unroll
        for (int rep = 0; rep < 4; ++rep) {
            const int e = tid + NTHR * rep, row = e >> 6, d = e & 63, c = c0 + row;
            const float val = Os[row * 65 + d];
            if (kv == 0) {
                float ss = 0.f;
#pragma unroll 16
                for (int j = 0; j < 64; ++j) { const float t = Os[row * 65 + j]; ss += t * t; }
                const float o = val * __builtin_amdgcn_rsqf(ss * (1.f / 64.f) + EPS) * GLD(float, INP(22) + l * 192 + d);
                GST(bf16_t, (bf16_t*)(ws + WS_KCN) + ((size_t)bg * 256 + c) * 64 + d, (c < 255) ? (bf16_t)f2bf(o) : (bf16_t)0);
            } else {
                GST(bf16_t, (bf16_t*)(ws + WS_VCT) + ((size_t)bg * 64 + d) * 256 + c, (c < 255) ? (bf16_t)f2bf(val) : (bf16_t)0);
            }
        }
        __syncthreads();
    }
}

__device__ __forceinline__ void qk_tile(f32x16& p0, f32x16& p1, const LAS unsigned char* Kl, const bf16x8 (&qf)[4], int r32, int hi) {
    const LAS unsigned char* kb = Kl + r32 * KP + hi * 16;
    bf16x8 a[8];
#pragma unroll
    for (int d0 = 0; d0 < 4; ++d0) { a[2 * d0] = *(const LAS bf16x8*)(kb + d0 * 32); a[2 * d0 + 1] = *(const LAS bf16x8*)(kb + 32 * KP + d0 * 32); }
    __builtin_amdgcn_s_setprio(1);
#pragma unroll
    for (int d0 = 0; d0 < 4; ++d0) {
        p0 = __builtin_amdgcn_mfma_f32_32x32x16_bf16(a[2 * d0], qf[d0], p0, 0, 0, 0);
        p1 = __builtin_amdgcn_mfma_f32_32x32x16_bf16(a[2 * d0 + 1], qf[d0], p1, 0, 0, 0);
    }
    __builtin_amdgcn_s_setprio(0);
}
template <int STRIDE, bool WINDOW, int MODE>
__device__ __forceinline__ void score_exp(f32x16& p0, f32x16& p1, int dl, const LAS float* tb, float cfar, bool rowsel) {
    const LAS float* tl = tb + 128 + (dl < 1087 ? dl : 1087) - 59;
#pragma unroll
    for (int blk = 0; blk < 2; ++blk) {
        f32x16& p = blk ? p1 : p0;
#pragma unroll
        for (int r = 0; r < 16; ++r) {
            const int c = (r & 3) + 8 * (r >> 2) + 32 * blk;
            const int dist = dl - STRIDE * c;
            float e;
            if (MODE == 0) e = __builtin_amdgcn_exp2f(p[r] + cfar);
            else {
                float bias;
                if (STRIDE == 1) bias = tl[59 - c];
                else bias = tb[128 + min((unsigned)dist, 1023u)];
                e = __builtin_amdgcn_exp2f(p[r] + bias);
                if (MODE == 2) { bool valid = dist >= 0; if (WINDOW) valid = valid && (dist < 512); e = valid ? e : 0.f; }
            }
            p[r] = rowsel ? e : 0.f;
        }
    }
}
template <int STRIDE, bool WINDOW>
__device__ __forceinline__ void score_exp_sel(f32x16& p0, f32x16& p1, int dl, const LAS float* tb, float cfar, bool rowsel, int dmin, int dmax) {
    if (!WINDOW && dmin >= 790) score_exp<STRIDE, WINDOW, 0>(p0, p1, dl, tb, cfar, rowsel);
    else if (dmin >= 0 && (!WINDOW || dmax < 512)) score_exp<STRIDE, WINDOW, 1>(p0, p1, dl, tb, cfar, rowsel);
    else score_exp<STRIDE, WINDOW, 2>(p0, p1, dl, tb, cfar, rowsel);
}
__device__ __forceinline__ float sum32(const f32x16& p0, const f32x16& p1) {
    float a = 0.f, b = 0.f;
#pragma unroll
    for (int r = 0; r < 16; ++r) { a += p0[r]; b += p1[r]; }
    return a + b;
}
template <int NDB>
__device__ __forceinline__ void pv_tile(f32x16 (&o)[NDB], const f32x16& p0, const f32x16& p1, const LAS unsigned char* Vl, int r32, int hi) {
    const LAS unsigned char* vbase = Vl + r32 * VP + hi * 8;
    bf16x4 vf[2][NDB][2];
#define PV_LOAD(st, buf) do { _Pragma("unroll") for (int db = 0; db < NDB; ++db) { const LAS unsigned char* vp = vbase + db * 32 * VP + (st) * 32; vf[buf][db][0] = *(const LAS bf16x4*)vp; vf[buf][db][1] = *(const LAS bf16x4*)(vp + 16); } } while (0)
    PV_LOAD(0, 0);
#pragma unroll
    for (int st = 0; st < 4; ++st) {
        if (st + 1 < 4) PV_LOAD(st + 1, (st + 1) & 1);
        const f32x16& p = (st >> 1) ? p1 : p0; const int s8 = 8 * (st & 1);
        u32x4 w; w.x = pg8::cvt_pk_bf16(p[s8 + 0], p[s8 + 1]); w.y = pg8::cvt_pk_bf16(p[s8 + 2], p[s8 + 3]); w.z = pg8::cvt_pk_bf16(p[s8 + 4], p[s8 + 5]); w.w = pg8::cvt_pk_bf16(p[s8 + 6], p[s8 + 7]);
        const bf16x8 pa = __builtin_bit_cast(bf16x8, w);
        __builtin_amdgcn_s_setprio(1);
#pragma unroll
        for (int db = 0; db < NDB; ++db) {
            const bf16x4 lo = vf[st & 1][db][0], hi4 = vf[st & 1][db][1];
            const bf16x8 vb = {lo[0], lo[1], lo[2], lo[3], hi4[0], hi4[1], hi4[2], hi4[3]};
            o[db] = __builtin_amdgcn_mfma_f32_32x32x16_bf16(pa, vb, o[db], 0, 0, 0);
        }
        __builtin_amdgcn_s_setprio(0);
    }
#undef PV_LOAD
}
__device__ __forceinline__ u32x4 ldk(const bf16_t* g, int tid) { return GLD(u32x4, (const unsigned char*)g + tid * 16); }
__device__ __forceinline__ void stk(LAS unsigned char* Kl, u32x4 v, int tid) { *(LAS u32x4*)(Kl + (tid >> 3) * KP + (tid & 7) * 16) = v; }
__device__ __forceinline__ u32x4 ldv(const bf16_t* g, size_t rs, int row, int tid) { return GLD(u32x4, (const unsigned char*)(g + (size_t)row * rs) + (tid & 7) * 16); }
__device__ __forceinline__ void stv(LAS unsigned char* Vl, u32x4 v, int row, int tid) { LAS unsigned char* p = Vl + row * VP + (tid & 7) * 16; *(LAS u32x2*)p = (u32x2){v.x, v.y}; *(LAS u32x2*)(p + 8) = (u32x2){v.z, v.w}; }

__device__ __forceinline__ void da_unit(const Params& P, int l, int b, int h, int qb, LAS unsigned char* lds, bool load_tab) {
    const int tid = otid(), lane = tid & 63, wave = __builtin_amdgcn_readfirstlane(tid >> 6), r32 = lane & 31, hi = lane >> 5;
    const int c = wave >> 2, qsub = wave & 3, q0 = qb * 128, qw0 = q0 + 32 * qsub;
    unsigned char* ws = WSP;
    const float* prm = (const float*)(ws + WS_PRM) + l * 8;
    const float lam = prm[0], Mb = prm[1], onem = prm[3];
    LAS float* biasL = (LAS float*)(lds + L_BIAS);
    const float* bg = (const float*)(ws + WS_BIAS) + h * 1024;
    if (load_tab) for (int i = tid; i < TBN; i += NTHR) { const int d = i - 128; biasL[i] = GLD(float, bg + (d < 0 ? 0 : (d > 1023 ? 1023 : d))) - Mb; }
    const float cfar = bg[1023] - Mb;
    const bf16_t* Qp = (const bf16_t*)(ws + Z_DQ) + ((size_t)(b * 8 + h * 2 + c) * SEQ + qw0 + r32) * 64 + hi * 8;
    bf16x8 qf[4];
#pragma unroll
    for (int d0 = 0; d0 < 4; ++d0) qf[d0] = GLD(bf16x8, Qp + d0 * 16);
    const bf16_t* K1g = (const bf16_t*)(ws + Z_DK) + (size_t)(b * 8 + h * 2) * SEQ * 64;
    const bf16_t* K2g = K1g + (size_t)SEQ * 64;
    const bf16_t* Vg = (const bf16_t*)(ws + Z_DVT) + (size_t)(b * 4 + h) * 128 * SEQ;
    const int NT = (q0 + 128) / 64;
    f32x16 o[4];
#pragma unroll
    for (int i = 0; i < 4; ++i) o[i] = (f32x16){};
    float lsum = 0.f;
    u32x4 rk1, rk2, rv0, rv1;
#define DA_LOAD(t) do { rk1 = ldk(K1g + (size_t)(t) * 4096, tid); rk2 = ldk(K2g + (size_t)(t) * 4096, tid); rv0 = ldv(Vg + (t) * 64, SEQ, tid >> 3, tid); rv1 = ldv(Vg + (t) * 64, SEQ, 64 + (tid >> 3), tid); } while (0)
#define DA_STORE(sb) do { LAS unsigned char* st_ = lds + (sb) * DA_STAGE; stk(st_, rk1, tid); stk(st_ + 64 * KP, rk2, tid); stv(st_ + 128 * KP, rv0, tid >> 3, tid); stv(st_ + 128 * KP, rv1, 64 + (tid >> 3), tid); } while (0)
    DA_LOAD(0); DA_STORE(0);
    __syncthreads();
    for (int t = 0; t < NT; ++t) {
        if (t + 1 < NT) DA_LOAD(t + 1);
        if (64 * t <= qw0 + 31) {
            const LAS unsigned char* st = lds + (t & 1) * DA_STAGE;
            f32x16 p0 = (f32x16){}, p1 = (f32x16){};
            qk_tile(p0, p1, st + c * 64 * KP, qf, r32, hi);
            const int dl = qw0 + r32 - 64 * t - 4 * hi;
            score_exp_sel<1, false>(p0, p1, dl, biasL, cfar, true, qw0 - (64 * t + 63), qw0 + 31 - 64 * t);
            lsum += sum32(p0, p1);
            pv_tile<4>(o, p0, p1, st + 128 * KP, r32, hi);
        }
        if (t + 1 < NT) DA_STORE((t + 1) & 1);
        __syncthreads();
    }
#undef DA_LOAD
#undef DA_STORE
    lsum += __shfl_xor(lsum, 32);
    LAS float* wsf = (LAS float*)(lds + L_WSF) + wave * 64;
    if (hi == 0) wsf[r32] = (lsum > 0.f) ? 1.0f / lsum : 0.f;
    asm volatile("s_waitcnt lgkmcnt(0)" ::: "memory");
    float li[16];
#pragma unroll
    for (int r = 0; r < 16; ++r) li[r] = wsf[crow(r, hi)];
    LAS float* X = (LAS float*)lds;
    if (c == 1) {
#pragma unroll
        for (int db = 0; db < 4; ++db)
#pragma unroll
            for (int r = 0; r < 16; ++r) X[(32 * qsub + crow(r, hi)) * 132 + r32 + 32 * db] = o[db][r] * li[r];
    }
    __syncthreads();
    if (c == 0) {
        const float* sg = INP(20) + l * 128;
        float gsub[4];
#pragma unroll
        for (int db = 0; db < 4; ++db) gsub[db] = sg[r32 + 32 * db] * onem;
#pragma unroll
        for (int r = 0; r < 16; ++r) {
            float y[4], ss = 0.f;
#pragma unroll
            for (int db = 0; db < 4; ++db) { y[db] = o[db][r] * li[r] - lam * X[(32 * qsub + crow(r, hi)) * 132 + r32 + 32 * db]; ss += y[db] * y[db]; }
            ss += __shfl_xor(ss, 1); ss += __shfl_xor(ss, 2); ss += __shfl_xor(ss, 4); ss += __shfl_xor(ss, 8); ss += __shfl_xor(ss, 16);
            const float rs = __builtin_amdgcn_rsqf(ss * (1.f / 128.f) + EPS);
            bf16_t* d = (bf16_t*)(ws + WS_XN) + (size_t)(b * SEQ + qw0 + crow(r, hi)) * DM + h * 128 + r32;
#pragma unroll
            for (int db = 0; db < 4; ++db) GST(bf16_t, d + 32 * db, (bf16_t)f2bf(y[db] * rs * gsub[db]));
        }
    }
    __syncthreads();
}

__device__ __forceinline__ void nsa_unit(const Params& P, int l, int b, int g, int u, LAS unsigned char* lds, bool load_tab) {
    const int tid = otid(), lane = tid & 63, wave = __builtin_amdgcn_readfirstlane(tid >> 6), r32 = lane & 31, hi = lane >> 5;
    const int qi = r32 >> 2, p = r32 & 3, qw0 = 64 * u + 8 * wave, qpos = qw0 + qi, head = g * 4 + p;
    unsigned char* ws = WSP;
    const float Mb = ((const float*)(ws + WS_PRM))[l * 8 + 2];
    LAS float* biasL = (LAS float*)(lds + L_BIAS);
    LAS float* imp = (LAS float*)(lds + L_IMP);
    LAS unsigned* selw = (LAS unsigned*)(lds + L_SEL);
    LAS float* wsf = (LAS float*)(lds + L_WSF) + wave * 64;
    const float* bgl = (const float*)(ws + WS_BIAS) + (size_t)(4 + g * 4) * 1024;
    if (load_tab) for (int i = tid; i < 4 * TBN; i += NTHR) { const int hh = i / TBN, d = i % TBN - 128; biasL[i] = GLD(float, bgl + hh * 1024 + (d < 0 ? 0 : (d > 1023 ? 1023 : d))) - Mb; }
    if (tid == 0) { unsigned z = 0u; asm volatile("" : "+v"(z)); selw[128] = z; selw[129] = z; }
    const LAS float* tb = biasL + p * TBN;
    const float cfar = bgl[p * 1024 + 1023] - Mb;
    const bf16_t* Qp = (const bf16_t*)(ws + Z_NQ) + ((size_t)(b * 8 + head) * SEQ + qpos) * 64 + hi * 8;
    bf16x8 qf[4];
#pragma unroll
    for (int d0 = 0; d0 < 4; ++d0) qf[d0] = GLD(bf16x8, Qp + d0 * 16);
    const float* ngp = (const float*)(ws + Z_NG) + (size_t)(b * SEQ + qpos) * 24 + head * 3;
    const float gate_c = GLD(float, ngp), gate_s = GLD(float, ngp + 1), gate_w = GLD(float, ngp + 2);
    f32x16 oc[2]; oc[0] = (f32x16){}; oc[1] = (f32x16){};
    f32x16 o[2];
    u32x4 rk, rv;
    const int bgi = b * 2 + g;
#define NS_STORE(sb) do { LAS unsigned char* st_ = lds + (sb) * NS_STAGE; stk(st_, rk, tid); stv(st_ + 64 * KP, rv, tid >> 3, tid); } while (0)
#define NS_FOLD(gate) do { lsum += __shfl_xor(lsum, 32); if (hi == 0) wsf[r32] = (lsum > 0.f) ? (gate) / lsum : 0.f; asm volatile("s_waitcnt lgkmcnt(0)" ::: "memory"); \
        _Pragma("unroll") for (int r = 0; r < 16; ++r) { const float f_ = wsf[crow(r, hi)]; oc[0][r] += f_ * o[0][r]; oc[1][r] += f_ * o[1][r]; } asm volatile("s_waitcnt lgkmcnt(0)" ::: "memory"); } while (0)
    {
        const bf16_t* Kg = (const bf16_t*)(ws + WS_KCN) + (size_t)bgi * 256 * 64;
        const bf16_t* Vg = (const bf16_t*)(ws + WS_VCT) + (size_t)bgi * 64 * 256;
        const int ntc = (4 * u + 2) / 64 + 1;
        for (int tc = 0; tc < ntc; ++tc) { rk = ldk(Kg + (size_t)tc * 4096, tid); rv = ldv(Vg + tc * 64, 256, tid >> 3, tid); NS_STORE(tc); }
        __syncthreads();
        float lsum = 0.f;
        for (int tc = 0; tc < ntc; ++tc) {
            const LAS unsigned char* st = lds + tc * NS_STAGE;
            f32x16 p0 = (f32x16){}, p1 = (f32x16){};
            qk_tile(p0, p1, st, qf, r32, hi);
            const int dl = qpos - 31 - 16 * (64 * tc + 4 * hi);
            score_exp_sel<16, false>(p0, p1, dl, tb, cfar, true, qw0 - 31 - 16 * (64 * tc + 63), qw0 + 7 - 31 - 16 * 64 * tc);
            lsum += sum32(p0, p1);
        }
        const float lt = lsum + __shfl_xor(lsum, 32);
        const float linv = (lt > 0.f) ? 1.0f / lt : 0.f;
        o[0] = (f32x16){}; o[1] = (f32x16){};
        float carry = 0.f;
        for (int tc = 0; tc < ntc; ++tc) {
            const LAS unsigned char* st = lds + tc * NS_STAGE;
            f32x16 p0 = (f32x16){}, p1 = (f32x16){};
            qk_tile(p0, p1, st, qf, r32, hi);
            const int dl = qpos - 31 - 16 * (64 * tc + 4 * hi);
            score_exp_sel<16, false>(p0, p1, dl, tb, cfar, true, qw0 - 31 - 16 * (64 * tc + 63), qw0 + 7 - 31 - 16 * 64 * tc);
            float Qs[2][4], PL[2][4];
#pragma unroll
            for (int blk = 0; blk < 2; ++blk)
#pragma unroll
                for (int m = 0; m < 4; ++m) { const f32x16& pp = blk ? p1 : p0; Qs[blk][m] = (pp[4 * m] + pp[4 * m + 1]) + (pp[4 * m + 2] + pp[4 * m + 3]); PL[blk][m] = __shfl_xor(pp[4 * m + 3], 32); }
#pragma unroll
            for (int blk = 0; blk < 2; ++blk)
#pragma unroll
                for (int m = 0; m < 4; ++m) {
                    const float prev = (m > 0) ? PL[blk][m - 1] : (blk ? PL[0][3] : carry);
                    float e = (Qs[blk][m] + (hi ? PL[blk][m] : prev)) * linv;
                    e += __shfl_xor(e, 1); e += __shfl_xor(e, 2);
                    if (p == 0) imp[(8 * wave + qi) * 64 + 16 * tc + 8 * blk + 2 * m + hi] = e;
                }
            carry = PL[1][3];
            pv_tile<2>(o, p0, p1, st + 64 * KP, r32, hi);
        }
        NS_FOLD(gate_c);
    }
    __syncthreads();
    {
        const int ql = lane >> 3, sub = lane & 7, q = 8 * wave + ql;
        unsigned long long m;
        if (u < 8) m = (2ull << u) - 1ull;
        else {
            m = 1ull | (1ull << u) | (1ull << (u - 1));
            float v[8];
#pragma unroll
            for (int i = 0; i < 8; ++i) { const int j = sub + 8 * i; v[i] = (j >= 1 && j <= u - 2) ? imp[q * 64 + j] : -1.f; }
            for (int k = 0; k < 5; ++k) {
                float bv = v[0]; int bj = sub;
#pragma unroll
                for (int i = 1; i < 8; ++i) if (v[i] > bv) { bv = v[i]; bj = sub + 8 * i; }
#pragma unroll
                for (int of = 1; of < 8; of <<= 1) { const float ov = __shfl_xor(bv, of); const int oj = __shfl_xor(bj, of); if (ov > bv || (ov == bv && oj < bj)) { bv = ov; bj = oj; } }
                m |= 1ull << bj;
#pragma unroll
                for (int i = 0; i < 8; ++i) if (bj == sub + 8 * i) v[i] = -2.f;
            }
        }
        if (sub == 0) { selw[2 * q] = (unsigned)m; selw[2 * q + 1] = (unsigned)(m >> 32); atomicOr((unsigned*)&selw[128], (unsigned)m); atomicOr((unsigned*)&selw[129], (unsigned)(m >> 32)); }
    }
    __syncthreads();
    asm volatile("" : "+v"(oc[0]), "+v"(oc[1]));
    u32x4 rk2, rv2;
#define NS_LOADA(Kg_, Vg_, j_) do { rk = ldk((Kg_) + (size_t)(j_) * 4096, tid); rv = ldv((Vg_) + (j_) * 64, SEQ, tid >> 3, tid); } while (0)
#define NS_LOADB(Kg_, Vg_, j_) do { rk2 = ldk((Kg_) + (size_t)(j_) * 4096, tid); rv2 = ldv((Vg_) + (j_) * 64, SEQ, tid >> 3, tid); } while (0)
#define NS_STOREA(sb) do { LAS unsigned char* st_ = lds + (sb) * NS_STAGE; stk(st_, rk, tid); stv(st_ + 64 * KP, rv, tid >> 3, tid); } while (0)
#define NS_STOREB(sb) do { LAS unsigned char* st_ = lds + (sb) * NS_STAGE; stk(st_, rk2, tid); stv(st_ + 64 * KP, rv2, tid >> 3, tid); } while (0)
    {
        const unsigned long long un = (unsigned long long)selw[128] | ((unsigned long long)selw[129] << 32);
        const unsigned long long mine = (unsigned long long)selw[2 * (8 * wave + qi)] | ((unsigned long long)selw[2 * (8 * wave + qi) + 1] << 32);
        const bf16_t* Kg = (const bf16_t*)(ws + Z_KSEL) + (size_t)bgi * SEQ * 64;
        const bf16_t* Vg = (const bf16_t*)(ws + Z_VSELT) + (size_t)bgi * 64 * SEQ;
        o[0] = (f32x16){}; o[1] = (f32x16){};
        float lsum = 0.f;
        unsigned long long rem = un;
#define NS_NEXTJ(var, has) do { has = (rem != 0ull); var = 0; if (has) { var = __builtin_ctzll(rem); rem &= rem - 1; } } while (0)
        int jc, j1, j2; bool h1, h2;
        NS_NEXTJ(jc, h1);
        NS_NEXTJ(j1, h1);
        NS_LOADA(Kg, Vg, jc); if (h1) NS_LOADB(Kg, Vg, j1);
        NS_STOREA(0);
        __syncthreads();
        int sc = 0;
#define NS_SEL_STEP(LOADF, STOREN) { \
            NS_NEXTJ(j2, h2); if (h2) LOADF(Kg, Vg, j2); \
            const bool rowsel = (mine >> jc) & 1ull; \
            if (__any(rowsel)) { \
                const LAS unsigned char* st = lds + sc * NS_STAGE; \
                f32x16 p0 = (f32x16){}, p1 = (f32x16){}; \
                qk_tile(p0, p1, st, qf, r32, hi); \
                const int dl = qpos - 64 * jc - 4 * hi; \
                score_exp_sel<1, false>(p0, p1, dl, tb, cfar, rowsel, qw0 - (64 * jc + 63), qw0 + 7 - 64 * jc); \
                lsum += sum32(p0, p1); \
                pv_tile<2>(o, p0, p1, st + 64 * KP, r32, hi); \
            } \
            const int sn = (sc == 2) ? 0 : sc + 1; \
            if (h1) STOREN(sn); \
            __syncthreads(); \
            if (!h1) break; \
            jc = j1; j1 = j2; h1 = h2; sc = sn; }
        for (;;) { NS_SEL_STEP(NS_LOADA, NS_STOREB) NS_SEL_STEP(NS_LOADB, NS_STOREA) }
#undef NS_SEL_STEP
#undef NS_NEXTJ
        NS_FOLD(gate_s);
        asm volatile("" : "+v"(oc[0]), "+v"(oc[1]));
    }
    {
        const bf16_t* Kg = (const bf16_t*)(ws + Z_KWIN) + (size_t)bgi * SEQ * 64;
        const bf16_t* Vg = (const bf16_t*)(ws + Z_VWINT) + (size_t)bgi * 64 * SEQ;
        o[0] = (f32x16){}; o[1] = (f32x16){};
        float lsum = 0.f;
        const int t0 = (u >= 8) ? u - 8 : 0;
        int t = t0, sc = 0;
        NS_LOADA(Kg, Vg, t0); if (t0 + 1 <= u) NS_LOADB(Kg, Vg, t0 + 1);
        NS_STOREA(0);
        __syncthreads();
#define NS_WIN_STEP(LOADF, STOREN) { \
            if (t + 2 <= u) LOADF(Kg, Vg, t + 2); \
            { \
                const LAS unsigned char* st = lds + sc * NS_STAGE; \
                f32x16 p0 = (f32x16){}, p1 = (f32x16){}; \
                qk_tile(p0, p1, st, qf, r32, hi); \
                const int dl = qpos - 64 * t - 4 * hi; \
                score_exp_sel<1, true>(p0, p1, dl, tb, cfar, true, qw0 - (64 * t + 63), qw0 + 7 - 64 * t); \
                lsum += sum32(p0, p1); \
                pv_tile<2>(o, p0, p1, st + 64 * KP, r32, hi); \
            } \
            const int sn = (sc == 2) ? 0 : sc + 1; \
            if (t + 1 <= u) STOREN(sn); \
            __syncthreads(); \
            if (t + 1 > u) break; \
            ++t; sc = sn; }
        for (;;) { NS_WIN_STEP(NS_LOADA, NS_STOREB) NS_WIN_STEP(NS_LOADB, NS_STOREA) }
#undef NS_WIN_STEP
        NS_FOLD(gate_w);
    }
#undef NS_LOADA
#undef NS_LOADB
#undef NS_STOREA
#undef NS_STOREB
#undef NS_STORE
#undef NS_FOLD
#pragma unroll
    for (int r = 0; r < 16; ++r) {
        const int row = crow(r, hi), q = qw0 + (row >> 2), pp = row & 3;
        bf16_t* d = (bf16_t*)(ws + WS_XN) + (size_t)(b * SEQ + q) * DM + 512 + (g * 4 + pp) * 64 + r32;
        GST(bf16_t, d, (bf16_t)f2bf(oc[0][r])); GST(bf16_t, d + 32, (bf16_t)f2bf(oc[1][r]));
    }
    __syncthreads();
}

__device__ __forceinline__ void attention_phase(const Params& P, int l, LAS unsigned char* lds) {
    int tab_key = -1;
    for (int it = blockIdx.x; it < 2048; it += gridDim.x) {
        const int c = it & 255, sl = (it >> 8) & 3;
        if (it < 1024) { const int bh = c & 31, xg = c >> 5; const int qb = (sl == 0) ? 31 - xg : (sl == 1) ? 23 - xg : (sl == 2) ? 8 + xg : xg;
            da_unit(P, l, bh >> 2, bh & 3, qb, lds, tab_key != (bh & 3)); tab_key = bh & 3; }
        else { const int bg = c & 15, ug = c >> 4; const int u = (sl == 0) ? 63 - ug : (sl == 1) ? 47 - ug : (sl == 2) ? 16 + ug : ug;
            nsa_unit(P, l, bg >> 1, bg & 1, u, lds, tab_key != 4 + (bg & 1)); tab_key = 4 + (bg & 1); }
    }
}

constexpr size_t WS_BAR = 72 * 1024;
#define RLX_AGENT __ATOMIC_RELAXED, __HIP_MEMORY_SCOPE_AGENT
#define XB_TMO      128
#define XB_XCNT(j)  (256  + 64 * (j))
#define XB_XSUB(j)  (1280 + 64 * (j))
#define XB_XGEN(j)  (2304 + 64 * (j))
#define XB_TOP      3328
#define XB_TOPGEN   3392
#define XCD_BAR_WORDS 3456
#define XB_SPIN_CAP (1u << 18)

__device__ __forceinline__ unsigned xb_ld(unsigned* p)              { return __hip_atomic_load(p, __ATOMIC_RELAXED, __HIP_MEMORY_SCOPE_AGENT); }
__device__ __forceinline__ unsigned xb_add(unsigned* p, unsigned v) { return __hip_atomic_fetch_add(p, v, __ATOMIC_RELAXED, __HIP_MEMORY_SCOPE_AGENT); }
__device__ __forceinline__ unsigned xb_xcc_id() { return (unsigned)__builtin_amdgcn_s_getreg((3 << 11) | 20) & 0xFu; }
#define XB_SPIN(cond, bar) do { unsigned _sp = 0; while (cond) { __builtin_amdgcn_s_sleep(1); \
    if ((++_sp & 255u) == 0u) { if (xb_ld(&(bar)[XB_TMO])) break; if (_sp > XB_SPIN_CAP) { atomicAdd(&(bar)[XB_TMO], 1u); break; } } } } while (0)

struct XcdBarrier {
    unsigned* bar; unsigned x;
    volatile LAS unsigned* st;
};

__device__ __forceinline__ XcdBarrier xcd_barrier_post(unsigned* bar, volatile LAS unsigned* st) {
    XcdBarrier b; b.bar = bar; b.x = xb_xcc_id(); b.st = st;
    if (threadIdx.x == 0) (void)xb_add(&bar[XB_XCNT(b.x)], 1u);
    return b;
}
__device__ __forceinline__ void xcd_barrier_complete(unsigned* bar, unsigned x, unsigned& nloc, unsigned& nx) {
    const unsigned G = gridDim.x * gridDim.y * gridDim.z;
    unsigned sum, cnt, mine, sp = 0u;
    for (;;) {
        sum = 0u; cnt = 0u; mine = 0u;
#pragma unroll
        for (unsigned j = 0; j < 16; ++j) { const unsigned c = xb_ld(&bar[XB_XCNT(j)]); sum += c; cnt += (c > 0u) ? 1u : 0u; mine = (j == x) ? c : mine; }
        if (sum == G) break;
        __builtin_amdgcn_s_sleep(1);
        if ((++sp & 255u) == 0u) { if (xb_ld(&bar[XB_TMO])) break; if (sp > XB_SPIN_CAP) { atomicAdd(&bar[XB_TMO], 1u); break; } }
    }
    nloc = mine > 0u ? mine : 1u; nx = cnt > 0u ? cnt : 1u;
}

__device__ __forceinline__ void xcd_barrier(const XcdBarrier& b) {
    asm volatile("s_waitcnt vmcnt(0)" ::: "memory");
    __syncthreads();
    if (threadIdx.x == 0) {
        unsigned* bar = b.bar;
        __builtin_amdgcn_s_waitcnt(0);
        unsigned nloc = b.st[0], nx = b.st[1];
        if (nloc == 0u) { xcd_barrier_complete(bar, b.x, nloc, nx); b.st[0] = nloc; b.st[1] = nx; }
        const unsigned old = xb_add(&bar[XB_XSUB(b.x)], 1u);
        const unsigned gen = old / nloc;
        if (old + 1u == (gen + 1u) * nloc) {
            __builtin_amdgcn_fence(__ATOMIC_RELEASE, "agent");
            asm volatile("s_waitcnt vmcnt(0)" ::: "memory");
            const unsigned og = xb_add(&bar[XB_TOP], 1u);
            const unsigned tg = og / nx;
            if (og + 1u == (tg + 1u) * nx) xb_add(&bar[XB_TOPGEN], 1u);
            else XB_SPIN(xb_ld(&bar[XB_TOPGEN]) == tg, bar);
            __builtin_amdgcn_fence(__ATOMIC_ACQUIRE, "agent");
            xb_add(&bar[XB_XGEN(b.x)], 1u);
            asm volatile("s_waitcnt vmcnt(0)" ::: "memory");
        } else {
            XB_SPIN(xb_ld(&bar[XB_XGEN(b.x)]) == gen, bar);
            __builtin_amdgcn_fence(__ATOMIC_ACQUIRE, "agent");
            asm volatile("s_waitcnt vmcnt(0)" ::: "memory");
        }
    }
    __syncthreads();
}

__global__ void __launch_bounds__(NTHR, 2) hybrid_fwd(Params P) {
    extern __shared__ __attribute__((aligned(16))) unsigned char lds_raw[];
    LAS unsigned char* lds = (LAS unsigned char*)lds_raw;
    cg::grid_group grid = cg::this_grid();
#define GSYNC() do { XcdBarrier xb_; xb_.bar = (unsigned*)(WSP + WS_BAR); xb_.x = xb_xcc_id(); xb_.st = (volatile LAS unsigned*)(lds + L_PTAB + 384); xcd_barrier(xb_); } while (0)
    if (threadIdx.x == 0) {
        LAS unsigned long long* pt = (LAS unsigned long long*)(lds + L_PTAB);
#pragma unroll
        for (int i = 0; i < 30; ++i) pt[i] = (unsigned long long)P.in[i];
        pt[30] = (unsigned long long)P.out; pt[31] = (unsigned long long)P.ws;
        *(LAS unsigned*)(lds + L_PTAB + 384) = 0u; *(LAS unsigned*)(lds + L_PTAB + 388) = 0u;
    }
    __syncthreads();
    (void)xcd_barrier_post((unsigned*)(WSP + WS_BAR), (volatile LAS unsigned*)(lds + L_PTAB + 384));
    const int G = gridDim.x, bx = blockIdx.x;
#define ws WSP
#define XN ((bf16_t*)(WSP + WS_XN))
#define HID ((bf16_t*)(WSP + WS_HID))
#define MERGED ((bf16_t*)(WSP + WS_MERGED))
#define XB ((bf16_t*)OUTP)
#define XS ((bf16_t*)(WSP + WS_Z + 192 * MiB))
#define SSP ((float*)(WSP + WS_SS))

#if defined(PROBE_PHASE)
    int n_stamp = 0;
#define STAMP() do { if (blockIdx.x == 0 && threadIdx.x == 0) ((LAS unsigned long long*)(lds + L_PTAB + 512))[n_stamp] = __builtin_amdgcn_s_memrealtime(); ++n_stamp; } while (0)
#else
#define STAMP() do {} while (0)
#endif
    if (P.out == nullptr) grid.sync();
    STAMP();
    prologue(P, lds);
    xprep_phase(INP(0), (bf16_t*)OUTP, (float*)(WSP + WS_SS));
#if defined(DUP_PRO)
    prologue(P, lds);
#endif
    GSYNC(); STAMP();
#pragma unroll
    for (int l = 0; l < DEPTH; ++l) {
        const float* xin = (l == 0) ? INP(0) : OUTP;
        { pg8::Gemm g{XB, (const bf16_t*)(ws + WS_W13 + (size_t)(l * 2 + 0) * W13_SZ), MTOK, 5632, DM}; pg8::StaticOrder S; S.init(MTOK, 5632, G, bx);
          EpiSwiGLU E{{SSP}, HID}; pg8::gemm_phase<EpiSwiGLU, pg8::StaticOrder, true, true>(lds, g, S, E);
#if defined(DUP_G1)
          pg8::gemm_phase<EpiSwiGLU, pg8::StaticOrder, true, true>(lds, g, S, E);
#endif
        }
        GSYNC(); STAMP();
        { pg8::Gemm g{HID, (const bf16_t*)(ws + WS_W2 + (size_t)(l * 2 + 0) * W2_SZ), MTOK, DM, DFF}; pg8::StaticOrder S; S.init(MTOK, DM, G, bx);
          if (l == 0) { EpiResidT<true, false> E{xin, XB, 0.5f, SSP}; pg8::gemm_phase<EpiResidT<true, false>, pg8::StaticOrder, true, true>(lds, g, S, E); }
          else { EpiResidT<false, false> E{XB, XB, 0.5f, SSP}; pg8::gemm_phase<EpiResidT<false, false>, pg8::StaticOrder, true, true>(lds, g, S, E); } }
        GSYNC(); STAMP();
#if defined(STOP_AFTER) && STOP_AFTER == 1
        return;
#endif
        { pg8::Gemm g{XB, (const bf16_t*)(ws + WS_WIN + (size_t)l * WIN_SZ), MTOK, 5120, DM}; pg8::StaticOrder S; S.init(MTOK, 5120, G, bx);
          EpiZ E{{SSP}, ws, INP(14) + l * 64, INP(15) + l * 64, INP(21) + l * 64, INP(22) + l * 192}; pg8::gemm_phase<EpiZ, pg8::StaticOrder, true, true>(lds, g, S, E);
#if defined(DUP_G3)
          pg8::gemm_phase<EpiZ, pg8::StaticOrder, true, true>(lds, g, S, E);
#endif
        }
        GSYNC(); STAMP();
#if defined(DUMP_Z)
        { const unsigned short* z = (const unsigned short*)(WSP + WS_Z); float* o = OUTP;
          for (size_t i = (size_t)blockIdx.x * NTHR + threadIdx.x; i < (size_t)MTOK * DM; i += (size_t)gridDim.x * NTHR) {
              unsigned v = (unsigned)z[i * 4 + (i & 3)] << 16; if ((v & 0x7f800000u) == 0x7f800000u) v = 0u; o[i] = __builtin_bit_cast(float, v); }
          return; }
#endif
        compress_phase(P, l, lds);
#if defined(DUP_CMP)
        for (int rep_ = 0; rep_ < 4; ++rep_) compress_phase(P, l, lds);
#endif
        GSYNC(); STAMP();
        attention_phase(P, l, lds);
#if defined(DUP_ATT)
        attention_phase(P, l, lds);
#endif
        GSYNC(); STAMP();
        { pg8::Gemm g{XN, (const bf16_t*)(ws + WS_PAB + (size_t)l * PAB_SZ), MTOK, 2048, DM}; pg8::StaticOrder S; S.init(MTOK, 2048, G, bx);
          EpiMerge E{(const bf16_t*)(ws + Z_MG), MERGED}; pg8::gemm_phase<EpiMerge, pg8::StaticOrder, true, true>(lds, g, S, E); }
        GSYNC(); STAMP();
        { pg8::Gemm g{MERGED, (const bf16_t*)(ws + WS_WO + (size_t)l * WO_SZ), MTOK, DM, DM}; pg8::StaticOrder S; S.init(MTOK, DM, G, bx);
          EpiResidT<false, false> E{XB, (l + 1 < DEPTH) ? XB : XS, 1.0f, SSP}; pg8::gemm_phase<EpiResidT<false, false>, pg8::StaticOrder, true, true>(lds, g, S, E); }
        GSYNC(); STAMP();
#if defined(STOP_AFTER) && STOP_AFTER == 2
        return;
#endif
        { pg8::Gemm g{(l + 1 < DEPTH) ? XB : XS, (const bf16_t*)(ws + WS_W13 + (size_t)(l * 2 + 1) * W13_SZ), MTOK, 5632, DM}; pg8::StaticOrder S; S.init(MTOK, 5632, G, bx);
          EpiSwiGLU E{{SSP}, HID}; pg8::gemm_phase<EpiSwiGLU, pg8::StaticOrder, true, true>(lds, g, S, E); }
        GSYNC(); STAMP();
        { pg8::Gemm g{HID, (const bf16_t*)(ws + WS_W2 + (size_t)(l * 2 + 1) * W2_SZ), MTOK, DM, DFF}; pg8::StaticOrder S; S.init(MTOK, DM, G, bx);
          if (l + 1 < DEPTH) { EpiResidT<false, false> E{XB, XB, 0.5f, SSP}; pg8::gemm_phase<EpiResidT<false, false>, pg8::StaticOrder, true, true>(lds, g, S, E); }
          else { EpiResidT<false, true> E{XS, OUTP, 0.5f, nullptr}; pg8::gemm_phase<EpiResidT<false, true>, pg8::StaticOrder, true, true>(lds, g, S, E); } }
        if (l + 1 < DEPTH) { GSYNC(); STAMP(); }
    }
#if defined(PROBE_PHASE)
    GSYNC(); STAMP();
    if (blockIdx.x == 0 && threadIdx.x == 0) { const LAS unsigned long long* t = (const LAS unsigned long long*)(lds + L_PTAB + 512); const float ns = (float)(t[PROBE_PHASE + 1] - t[PROBE_PHASE]) * 10.0f; OUTP[0] = exp2f(rintf(log2f(ns) * 4.f) * 0.25f); }
#endif
#undef ws
#undef XN
#undef HID
#undef MERGED
#undef XB
#undef XS
#undef SSP
}

extern "C" void kernel_launch(void* const* d_in, const int* in_sizes, int n_in, void* d_out, int out_size, void* d_ws, size_t ws_size, hipStream_t stream) {
    static int grid = 0;
    if (grid == 0) {
        if (n_in != 30 || out_size != MTOK * DM || ws_size < WS_END) { fprintf(stderr, "kernel_launch: unexpected problem (n_in %d out %d ws %zu, need %zu)\n", n_in, out_size, ws_size, (size_t)WS_END); grid = -1; return; }
        int dev = 0, cus = 0, per_cu = 0;
        (void)hipGetDevice(&dev);
        (void)hipDeviceGetAttribute(&cus, hipDeviceAttributeMultiprocessorCount, dev);
        if (hipFuncSetAttribute((const void*)hybrid_fwd, hipFuncAttributeMaxDynamicSharedMemorySize, LDS_BYTES) != hipSuccess) { fprintf(stderr, "kernel_launch: hipFuncSetAttribute failed\n"); grid = -1; return; }
        if (hipOccupancyMaxActiveBlocksPerMultiprocessor(&per_cu, (const void*)hybrid_fwd, NTHR, LDS_BYTES) != hipSuccess || per_cu < 1) { fprintf(stderr, "kernel_launch: occupancy query gave %d\n", per_cu); per_cu = 1; }
        (void)hipGetLastError();
        grid = cus * (per_cu > 1 ? 1 : per_cu);
        if (grid <= 0) grid = 256;
    }
    if (grid < 0) return;
    Params p{};
    for (int i = 0; i < 30; ++i) p.in[i] = (const float*)d_in[i];
    p.out = (float*)d_out; p.ws = (unsigned char*)d_ws;
    (void)hipMemsetAsync((unsigned char*)d_ws + WS_BAR, 0, 16384, stream);
    void* args[] = {&p};
    hipError_t e = hipLaunchCooperativeKernel((const void*)hybrid_fwd, dim3(grid), dim3(NTHR), args, LDS_BYTES, stream);
    if (e != hipSuccess) fprintf(stderr, "cooperative launch failed: %s (grid %d)\n", hipGetErrorString(e), grid);
}
```

```cpp
#include <hip/hip_runtime.h>
#include <hip/hip_cooperative_groups.h>
#include <cstdio>
#include <cstdint>
namespace cg = cooperative_groups;
namespace pg8 {
#define PG8_LAS __attribute__((address_space(3)))
typedef unsigned short bf16_t;
typedef short bf16x8 __attribute__((ext_vector_type(8)));
typedef float f32x4 __attribute__((ext_vector_type(4)));
typedef unsigned u32x4 __attribute__((ext_vector_type(4)));
constexpr int BM = 256, BK = 64, HALF = 128, HTB = HALF * BK * 2  , STAGE_BYTES = 8 * HTB, NXCD = 8, WGM = 8;

__host__ __device__ __forceinline__ int lds_byte(int r, int c) { const int st = (r >> 4) * 2 + (c >> 5), rr = r & 15, cc = c & 31, ob = rr * 64 + cc * 2; return st * 1024 + (ob ^ (((ob >> 9) & 1) << 5)); }
__host__ __device__ __forceinline__ void stage_rc(int b, int& R, int& C) { const int st = b / 1024, sb = b % 1024, swz = sb ^ (((sb >> 9) & 1) << 5); R = (st >> 1) * 16 + swz / 64; C = (st & 1) * 32 + (swz % 64) / 2; }
__host__ __device__ __forceinline__ int perm32(int rho) { const int n = rho >> 4, i = rho & 15; return 8 * (i >> 2) + 4 * n + (i & 3); }

struct Unit { int pm, pn; };
struct Gemm { const bf16_t* A; const bf16_t* Bt; int M, N, K; };

struct StaticOrder {
    int nM, nN, nwg, G, c;
    __host__ __device__ void init(int M, int N, int G_, int c_) { nM = M / BM; nN = N / BM; nwg = nM * nN; G = G_; c = c_; }
    __host__ __device__ bool next(int i, Unit& u) const {
        const long L = (long)i * G + c; if (L >= nwg) return false;
        int wgid = (int)L; { const int q = nwg / NXCD, r = nwg % NXCD, xcd = wgid % NXCD, off = wgid / NXCD; wgid = (xcd < r ? xcd * (q + 1) : r * (q + 1) + (xcd - r) * q) + off; }
        const int nig = WGM * nN, gid = wgid / nig, fm = gid * WGM, gsz = (nM - fm) < WGM ? (nM - fm) : WGM;
        u.pm = fm + ((wgid % nig) % gsz); u.pn = (wgid % nig) / gsz; return true;
    }
    __device__ __forceinline__ void a_ready(const Unit&) const {}
    __device__ __forceinline__ void done(const Unit&) const {}
};

typedef float f32x2_t __attribute__((ext_vector_type(2))); typedef __bf16 bf16x2_t __attribute__((ext_vector_type(2)));
__device__ __forceinline__ unsigned cvt_pk_bf16(float lo, float hi) { f32x2_t v = {lo, hi}; bf16x2_t b = __builtin_convertvector(v, bf16x2_t); return __builtin_bit_cast(unsigned, b); }
template <class Epi, class Sched, bool ALIGN_EPI = false, bool SP2 = false>
__device__ __forceinline__ void gemm_phase(PG8_LAS unsigned char* lds, const Gemm g, const Sched& S, const Epi& E) {
    int tid_ = threadIdx.x; asm volatile("" : "+v"(tid_)); const int tid = tid_, wid = __builtin_amdgcn_readfirstlane(tid >> 6), lane = tid & 63, wr = wid >> 2, wc = wid & 3, fr = lane & 15, fq = lane >> 4;
    const int K = g.K, nt = K / BK;
    unsigned voffA[2], voffB[2];
#pragma unroll
    for (int i = 0; i < 2; ++i) { int R, C; stage_rc(tid * 16 + i * 8192, R, C); const int Rb = Epi::PERM ? ((R & ~31) + perm32(R & 31)) : R;
        voffA[i] = (unsigned)(R * K + C) * 2u; voffB[i] = (unsigned)(Rb * K + C) * 2u; }
    const size_t kstep = (size_t)(BK * 2);
    const size_t hstep = (size_t)HALF * K * 2;
    const size_t tstep = 2 * hstep;
    const unsigned ldsw = (unsigned)wid * 1024u;
    const int aoff = lds_byte(wr * 64 + fr, fq * 8), boff = lds_byte(wc * 32 + fr, fq * 8);
#define PG8_SA(b, h) (((b) * 2 + (h)) * HTB)
#define PG8_SB(b, h) ((4 + (b) * 2 + (h)) * HTB)
#define PG8_STAGE(bufoff, gbase, voff) do { _Pragma("unroll") for (int _i = 0; _i < 2; ++_i) \
        __builtin_amdgcn_global_load_lds((const unsigned*)((const char*)(gbase) + (voff)[_i]), (PG8_LAS unsigned*)(lds + (bufoff) + ldsw + _i * 8192), 16, 0, 0); } while (0)
#define PG8_LDA(dst, b, h) do { _Pragma("unroll") for (int m = 0; m < 4; ++m) _Pragma("unroll") for (int k = 0; k < 2; ++k) dst[m][k] = *(const PG8_LAS bf16x8*)(lds + PG8_SA(b, h) + aoff + m * 2048 + k * 1024); } while (0)
#define PG8_LDB(dst, b, h) do { _Pragma("unroll") for (int n = 0; n < 2; ++n) _Pragma("unroll") for (int k = 0; k < 2; ++k) dst[n][k] = *(const PG8_LAS bf16x8*)(lds + PG8_SB(b, h) + boff + n * 2048 + k * 1024); } while (0)
#define PG8_MMA(ai, bj, At, Bt) do { __builtin_amdgcn_s_setprio(1); _Pragma("unroll") for (int m = 0; m < 4; ++m) _Pragma("unroll") for (int n = 0; n < 2; ++n) _Pragma("unroll") for (int k = 0; k < 2; ++k) \
        acc[ai][bj][m][n] = __builtin_amdgcn_mfma_f32_16x16x32_bf16(Bt[n][k], At[m][k], acc[ai][bj][m][n], 0, 0, 0); __builtin_amdgcn_s_setprio(0); } while (0)
#define PG8_WAIT_V(n) asm volatile("s_waitcnt vmcnt(" #n ")" ::: "memory")
#define PG8_WAIT_L(n) asm volatile("s_waitcnt lgkmcnt(" #n ")" ::: "memory")
#define PG8_BAR __builtin_amdgcn_s_barrier()
#define PG8_SCHED __builtin_amdgcn_sched_barrier(0)
    Unit cur, nxt; int ui = 0;
    if (!S.next(0, cur)) return;
    f32x4 acc[2][2][4][2];
#pragma unroll
    for (int a = 0; a < 2; ++a)
#pragma unroll
        for (int b = 0; b < 2; ++b)
#pragma unroll
            for (int m = 0; m < 4; ++m)
#pragma unroll
                for (int n = 0; n < 2; ++n) acc[a][b][m][n] = (f32x4){0.f, 0.f, 0.f, 0.f};
    bf16x8 At[4][2], B0[2][2], B1[2][2];
    const char* cA = (const char*)g.A + (size_t)cur.pm * tstep; const char* cB = (const char*)g.Bt + (size_t)cur.pn * tstep;
    S.a_ready(cur);
    if constexpr (Epi::ROWSCALE) {
        int pmB = -1, pmC = -1, pmD = -1; Unit uu;
        for (int i = 1; S.next(i, uu); ++i) if (uu.pm != cur.pm && uu.pm != pmB && uu.pm != pmC && uu.pm != pmD) { if (pmB < 0) pmB = uu.pm; else if (pmC < 0) pmC = uu.pm; else if (pmD < 0) pmD = uu.pm; }
        f32x4 a0, b0, a1, b1, a2, b2, a3, b3; Unit t0 = cur, t1 = cur, t2 = cur, t3 = cur; t1.pm = pmB < 0 ? cur.pm : pmB; t2.pm = pmC < 0 ? cur.pm : pmC; t3.pm = pmD < 0 ? cur.pm : pmD;
        E.rs_issue(t0, tid, a0, b0); E.rs_issue(t1, tid, a1, b1); E.rs_issue(t2, tid, a2, b2); E.rs_issue(t3, tid, a3, b3);
        E.rs_write(tid, a3, b3, (PG8_LAS float*)(lds + STAGE_BYTES + ((t3.pm >> 3) & 3) * 1024));
        E.rs_write(tid, a2, b2, (PG8_LAS float*)(lds + STAGE_BYTES + ((t2.pm >> 3) & 3) * 1024));
        E.rs_write(tid, a1, b1, (PG8_LAS float*)(lds + STAGE_BYTES + ((t1.pm >> 3) & 3) * 1024));
        E.rs_write(tid, a0, b0, (PG8_LAS float*)(lds + STAGE_BYTES + ((t0.pm >> 3) & 3) * 1024));
    }
    if constexpr (SP2) {
        PG8_STAGE(PG8_SB(0, 0), cB, voffB); PG8_STAGE(PG8_SB(0, 1), cB + hstep, voffB); PG8_STAGE(PG8_SA(0, 0), cA, voffA); PG8_STAGE(PG8_SA(0, 1), cA + hstep, voffA);
        if (wr == 1) PG8_BAR;
        PG8_WAIT_V(2); PG8_BAR;
        PG8_STAGE(PG8_SB(1, 0), cB + kstep, voffB); PG8_STAGE(PG8_SA(1, 0), cA + kstep, voffA); PG8_STAGE(PG8_SB(1, 1), cB + hstep + kstep, voffB);
        PG8_WAIT_V(6); PG8_BAR;
    } else {
        PG8_STAGE(PG8_SB(0, 0), cB, voffB); PG8_STAGE(PG8_SA(0, 0), cA, voffA); PG8_STAGE(PG8_SB(0, 1), cB + hstep, voffB); PG8_STAGE(PG8_SA(0, 1), cA + hstep, voffA);
        if (wr == 1) PG8_BAR;
        PG8_WAIT_V(4); PG8_BAR;
        PG8_STAGE(PG8_SB(1, 0), cB + kstep, voffB); PG8_STAGE(PG8_SA(1, 0), cA + kstep, voffA); PG8_STAGE(PG8_SB(1, 1), cB + hstep + kstep, voffB);
        PG8_WAIT_V(6); PG8_BAR;
    }
    for (;;) {
        const bool has_next = S.next(ui + 1, nxt);
        const char* nA = has_next ? (const char*)g.A + (size_t)nxt.pm * tstep : cA; const char* nB = has_next ? (const char*)g.Bt + (size_t)nxt.pn * tstep : cB;
        for (int t = 0; t < nt; t += 2) {
            const bool last = (t == nt - 2);
            const char* a1 = cA + (size_t)(t + 1) * kstep;
            const char* a2 = last ? nA : cA + (size_t)(t + 2) * kstep; const char* b2 = last ? nB : cB + (size_t)(t + 2) * kstep;
            const char* a3 = a2 + kstep; const char* b3 = b2 + kstep;
            if (last && has_next) S.a_ready(nxt);
            if constexpr (SP2) {
            PG8_LDB(B0, 0, 0); PG8_LDB(B1, 0, 1); PG8_SCHED; PG8_LDA(At, 0, 0); PG8_STAGE(PG8_SA(1, 1), a1 + hstep, voffA);
            PG8_WAIT_V(8); PG8_WAIT_L(0); PG8_BAR; PG8_MMA(0, 0, At, B0); PG8_MMA(0, 1, At, B1); PG8_BAR; PG8_SCHED;
            PG8_LDA(At, 0, 1); PG8_STAGE(PG8_SB(0, 0), b2, voffB); PG8_STAGE(PG8_SB(0, 1), b2 + hstep, voffB); PG8_STAGE(PG8_SA(0, 0), a2, voffA);
            PG8_WAIT_V(8); PG8_WAIT_L(0); PG8_BAR; PG8_MMA(1, 0, At, B0); PG8_MMA(1, 1, At, B1); PG8_BAR; PG8_SCHED;
            PG8_LDB(B0, 1, 0); PG8_LDB(B1, 1, 1); PG8_SCHED; PG8_LDA(At, 1, 0); PG8_STAGE(PG8_SA(0, 1), a2 + hstep, voffA);
            PG8_WAIT_V(8); PG8_WAIT_L(0); PG8_BAR; PG8_MMA(0, 0, At, B0); PG8_MMA(0, 1, At, B1); PG8_BAR; PG8_SCHED;
            PG8_LDA(At, 1, 1); PG8_STAGE(PG8_SB(1, 0), b3, voffB); PG8_STAGE(PG8_SB(1, 1), b3 + hstep, voffB); PG8_STAGE(PG8_SA(1, 0), a3, voffA);
            PG8_WAIT_V(8); PG8_WAIT_L(0); PG8_BAR; PG8_MMA(1, 0, At, B0); PG8_MMA(1, 1, At, B1); PG8_BAR; PG8_SCHED;
            } else {
            PG8_LDB(B0, 0, 0); PG8_SCHED; PG8_LDA(At, 0, 0); PG8_STAGE(PG8_SA(1, 1), a1 + hstep, voffA);
            PG8_WAIT_L(8); PG8_BAR; PG8_WAIT_L(0); PG8_MMA(0, 0, At, B0); PG8_BAR; PG8_SCHED;
            PG8_LDB(B1, 0, 1); PG8_STAGE(PG8_SB(0, 0), b2, voffB);
            PG8_BAR; PG8_WAIT_L(0); PG8_MMA(0, 1, At, B1); PG8_BAR;
            PG8_LDA(At, 0, 1); PG8_STAGE(PG8_SA(0, 0), a2, voffA);
            PG8_BAR; PG8_WAIT_L(0); PG8_MMA(1, 0, At, B0); PG8_BAR; PG8_SCHED;
            PG8_STAGE(PG8_SB(0, 1), b2 + hstep, voffB);
            PG8_WAIT_V(6); PG8_BAR; PG8_MMA(1, 1, At, B1); PG8_BAR;
            PG8_LDB(B0, 1, 0); PG8_SCHED; PG8_LDA(At, 1, 0); PG8_STAGE(PG8_SA(0, 1), a2 + hstep, voffA);
            PG8_WAIT_L(8); PG8_BAR; PG8_WAIT_L(0); PG8_MMA(0, 0, At, B0); PG8_BAR; PG8_SCHED;
            PG8_LDB(B1, 1, 1); PG8_STAGE(PG8_SB(1, 0), b3, voffB);
            PG8_BAR; PG8_WAIT_L(0); PG8_MMA(0, 1, At, B1); PG8_BAR;
            PG8_LDA(At, 1, 1); PG8_STAGE(PG8_SA(1, 0), a3, voffA);
            PG8_BAR; PG8_WAIT_L(0); PG8_MMA(1, 0, At, B0); PG8_BAR; PG8_SCHED;
            PG8_STAGE(PG8_SB(1, 1), b3 + hstep, voffB);
            PG8_WAIT_V(6); PG8_BAR; PG8_MMA(1, 1, At, B1); PG8_BAR;
            }
        }
        if constexpr (ALIGN_EPI) { if (wr == 0) PG8_BAR; }
        if constexpr (!Epi::AFTER_DRAIN) {
            if constexpr (Epi::ROWSCALE) E(acc, cur, wr, wc, fr, fq, (const PG8_LAS float*)(lds + STAGE_BYTES + ((cur.pm >> 3) & 3) * 1024));
            else E(acc, cur, wr, wc, fr, fq);
            S.done(cur); }
        if (!has_next) break;
#pragma unroll
        for (int a = 0; a < 2; ++a)
#pragma unroll
            for (int b = 0; b < 2; ++b)
#pragma unroll
                for (int m = 0; m < 4; ++m)
#pragma unroll
                    for (int n = 0; n < 2; ++n) acc[a][b][m][n] = (f32x4){0.f, 0.f, 0.f, 0.f};
        cur = nxt; cA = nA; cB = nB; ++ui;
        if constexpr (ALIGN_EPI) { if (wr == 1) PG8_BAR; }
    }
    PG8_WAIT_V(0);
    if constexpr (!ALIGN_EPI) { if (wr == 0) PG8_BAR; }
    PG8_BAR;
    if constexpr (Epi::AFTER_DRAIN) { E.fused(acc, cur, wr, wc, fr, fq, lds, wid, lane); S.done(cur); }
#undef PG8_SA
#undef PG8_SB
#undef PG8_STAGE
#undef PG8_LDA
#undef PG8_LDB
#undef PG8_MMA
#undef PG8_WAIT_V
#undef PG8_WAIT_L
#undef PG8_BAR
#undef PG8_SCHED
}
}

#define LAS __attribute__((address_space(3)))
#define GAS __attribute__((address_space(1)))
#define GLD(T, p) (*(const GAS T*)(p))
#define GST(T, p, v) (*(GAS T*)(p) = (v))
typedef unsigned short bf16_t;
typedef short bf16x8 __attribute__((ext_vector_type(8)));
typedef short bf16x4 __attribute__((ext_vector_type(4)));
typedef float f32x4 __attribute__((ext_vector_type(4)));
typedef float f32x16 __attribute__((ext_vector_type(16)));
typedef unsigned u32x4 __attribute__((ext_vector_type(4)));
typedef unsigned u32x2 __attribute__((ext_vector_type(2)));

constexpr int BATCH = 8, SEQ = 4096, DM = 1024, MTOK = BATCH * SEQ, DFF = 2816, DEPTH = 2, NIN = 4888;
constexpr int NTHR = 512, NWAVE = 8;
constexpr float EPS = 1e-6f, LOG2E = 1.4426950408889634f;
constexpr float QSCALE = 0.125f * LOG2E;
constexpr size_t MiB = 1u << 20;
constexpr size_t WS_BIAS = 0;
constexpr size_t WS_PRM = 64 * 1024;
constexpr size_t WS_CB1 = 68 * 1024;
constexpr size_t WS_W13 = 1 * MiB;
constexpr size_t W13_SZ = (size_t)5632 * 1024 * 2;
constexpr size_t WS_W2 = 45 * MiB;
constexpr size_t W2_SZ = (size_t)1024 * 2816 * 2;
constexpr size_t WS_WIN = 68 * MiB;
constexpr size_t WIN_SZ = (size_t)5120 * 1024 * 2;
constexpr size_t WS_PAB = 88 * MiB;
constexpr size_t PAB_SZ = (size_t)2048 * 1024 * 2;
constexpr size_t WS_WO = 96 * MiB;
constexpr size_t WO_SZ = (size_t)1024 * 1024 * 2;
constexpr size_t WS_CW1 = 100 * MiB;
constexpr size_t CW1_SZ = (size_t)128 * 2048 * 2;
constexpr size_t WS_CW2 = 102 * MiB;
constexpr size_t CW2_SZ = (size_t)64 * 128 * 2;
constexpr size_t WS_KCN = 103 * MiB;
constexpr size_t WS_VCT = WS_KCN + 512 * 1024;
constexpr size_t WS_XN = 104 * MiB;
constexpr size_t WS_Z = 168 * MiB;
constexpr size_t Z_DQ = WS_Z, Z_DK = WS_Z + 32 * MiB, Z_DVT = WS_Z + 64 * MiB, Z_NQ = WS_Z + 96 * MiB;
constexpr size_t Z_KCR = WS_Z + 128 * MiB, Z_VCR = WS_Z + 136 * MiB, Z_KSEL = WS_Z + 144 * MiB, Z_VSELT = WS_Z + 152 * MiB;
constexpr size_t Z_KWIN = WS_Z + 160 * MiB, Z_VWINT = WS_Z + 168 * MiB, Z_NG = WS_Z + 176 * MiB, Z_MG = WS_Z + 180 * MiB;
constexpr size_t WS_MERGED = WS_Z;
constexpr size_t WS_HID = WS_Z;
constexpr size_t WS_SS = WS_Z + 308 * MiB;
constexpr size_t WS_END = WS_SS + 2 * MiB;
constexpr int LDS_BYTES = 147456;
constexpr int KP = 144, VP = 136;
constexpr int DA_STAGE = 2 * 64 * KP + 128 * VP;
constexpr int NS_STAGE = 64 * KP + 64 * VP;
constexpr int L_BIAS = 73728;
constexpr int TBN = 1216;
constexpr int L_IMP = L_BIAS + 4 * TBN * 4;
constexpr int L_SEL = L_IMP + 16384;
constexpr int L_WSF = L_SEL + 1024;
constexpr int L_END = L_WSF + 8 * 256;

struct Params {
    const float* in[30];
    float* out;
    unsigned char* ws;
};

constexpr int L_PTAB = LDS_BYTES - 1024;
__device__ __forceinline__ const float* ld_ptr(const LAS unsigned char* lds, int i) {
    unsigned a = L_PTAB + 8 * i; asm volatile("" : "+v"(a));
    const LAS unsigned* t = (const LAS unsigned*)(lds + a);
    const unsigned lo = __builtin_amdgcn_readfirstlane(t[0]), hi = __builtin_amdgcn_readfirstlane(t[1]);
    return (const float*)(((unsigned long long)hi << 32) | lo);
}
#define INP(i) ld_ptr(lds, (i))
#define OUTP ((float*)ld_ptr(lds, 30))
#define WSP ((unsigned char*)ld_ptr(lds, 31))

__device__ __forceinline__ unsigned f2bf(float f) { unsigned u = __builtin_bit_cast(unsigned, f); return (u + 0x7fffu + ((u >> 16) & 1u)) >> 16; }
__device__ __forceinline__ unsigned pk2(float lo, float hi) { return f2bf(lo) | (f2bf(hi) << 16); }
__device__ __forceinline__ float sigmoidf_(float x) { return __builtin_amdgcn_rcpf(1.0f + __builtin_amdgcn_exp2f(-x * LOG2E)); }
__device__ __forceinline__ int otid() { int t = threadIdx.x; asm volatile("" : "+v"(t)); return t; }
__device__ __forceinline__ int crow(int r, int hi) { return (r & 3) + 8 * (r >> 2) + 4 * hi; }


struct RowScale {
    const float* ss;
    __device__ __forceinline__ void rs_issue(const pg8::Unit& u, int tid, f32x4& pa, f32x4& pb) const {
        const float* p = ss + (size_t)(u.pm * 256 + (tid >> 1)) * 16 + (tid & 1) * 8; pa = GLD(f32x4, p); pb = GLD(f32x4, p + 4); }
    __device__ __forceinline__ void rs_write(int tid, const f32x4& pa, const f32x4& pb, LAS float* tab) const {
        float t = ((pa.x + pa.y) + (pa.z + pa.w)) + ((pb.x + pb.y) + (pb.z + pb.w)); t += __shfl_xor(t, 1);
        if (!(tid & 1)) tab[tid >> 1] = __builtin_amdgcn_rsqf(t * (1.f / DM) + EPS); }
};
struct EpiSwiGLU : RowScale {
    static constexpr bool PERM = true, AFTER_DRAIN = false, ROWSCALE = true;
    bf16_t* H;
    __device__ __forceinline__ void operator()(const f32x4 (&acc)[2][2][4][2], const pg8::Unit& u, int wr, int wc, int fr, int fq, const LAS float* rst) const {
        const int row0 = u.pm * 256 + wr * 64 + fr, col = u.pn * 128 + wc * 32 + 8 * fq;
#pragma unroll
        for (int ai = 0; ai < 2; ++ai)
#pragma unroll
            for (int m = 0; m < 4; ++m) {
                float h[8];
                const float rs = rst[ai * 128 + wr * 64 + m * 16 + fr];
#pragma unroll
                for (int n = 0; n < 2; ++n)
#pragma unroll
                    for (int e = 0; e < 4; ++e) { const float g = acc[ai][0][m][n][e] * rs, up = acc[ai][1][m][n][e] * rs; h[n * 4 + e] = g * sigmoidf_(g) * up; }
                u32x4 w; w.x = pg8::cvt_pk_bf16(h[0], h[1]); w.y = pg8::cvt_pk_bf16(h[2], h[3]); w.z = pg8::cvt_pk_bf16(h[4], h[5]); w.w = pg8::cvt_pk_bf16(h[6], h[7]);
                GST(u32x4, H + (size_t)(row0 + ai * 128 + m * 16) * DFF + col, w);
            }
    }
};
template <bool BF32, bool OF32> struct EpiResidT {
    static constexpr bool PERM = false, AFTER_DRAIN = false, ROWSCALE = false;
    const void* base; void* out; float alpha; float* ss;
    __device__ __forceinline__ void operator()(const f32x4 (&acc)[2][2][4][2], const pg8::Unit& u, int wr, int wc, int fr, int fq) const {
        const int row0 = u.pm * 256 + wr * 64 + fr, col0 = u.pn * 256 + wc * 32 + 4 * fq;
#pragma unroll
        for (int ai = 0; ai < 2; ++ai) {
            f32x4 bv[4][2][2];
#pragma unroll
            for (int m = 0; m < 4; ++m) {
                const size_t off = (size_t)(row0 + ai * 128 + m * 16) * DM + col0;
#pragma unroll
                for (int bj = 0; bj < 2; ++bj)
#pragma unroll
                    for (int n = 0; n < 2; ++n) {
                        if (BF32) bv[m][bj][n] = GLD(f32x4, (const float*)base + off + bj * 128 + n * 16);
                        else { const u32x2 w = GLD(u32x2, (const bf16_t*)base + off + bj * 128 + n * 16);
                               bv[m][bj][n] = (f32x4){__builtin_bit_cast(float, w.x << 16), __builtin_bit_cast(float, w.x & 0xffff0000u), __builtin_bit_cast(float, w.y << 16), __builtin_bit_cast(float, w.y & 0xffff0000u)}; }
                    }
            }
#pragma unroll
            for (int m = 0; m < 4; ++m) {
                const int row = row0 + ai * 128 + m * 16;
                const size_t off = (size_t)row * DM + col0;
                float sq = 0.f;
#pragma unroll
                for (int bj = 0; bj < 2; ++bj)
#pragma unroll
                    for (int n = 0; n < 2; ++n) {
                        const f32x4 o = bv[m][bj][n] + acc[ai][bj][m][n] * alpha;
                        sq += (o.x * o.x + o.y * o.y) + (o.z * o.z + o.w * o.w);
                        if (OF32) GST(f32x4, (float*)out + off + bj * 128 + n * 16, o);
                        else { u32x2 w; w.x = pg8::cvt_pk_bf16(o.x, o.y); w.y = pg8::cvt_pk_bf16(o.z, o.w); GST(u32x2, (bf16_t*)out + off + bj * 128 + n * 16, w); }
                    }
                if (!OF32) { sq += __shfl_xor(sq, 16); sq += __shfl_xor(sq, 32); if (fq == 0) GST(float, ss + (size_t)row * 16 + u.pn * 4 + wc, sq); }
            }
        }
    }
};
struct EpiMerge {
    static constexpr bool PERM = true, AFTER_DRAIN = false, ROWSCALE = false;
    const bf16_t* MG; bf16_t* O;
    __device__ __forceinline__ void operator()(const f32x4 (&acc)[2][2][4][2], const pg8::Unit& u, int wr, int wc, int fr, int fq) const {
        const int row0 = u.pm * 256 + wr * 64 + fr, col = u.pn * 128 + wc * 32 + 8 * fq;
#pragma unroll
        for (int ai = 0; ai < 2; ++ai) {
            u32x4 g0[4], g1[4];
#pragma unroll
            for (int m = 0; m < 4; ++m) { const int row = row0 + ai * 128 + m * 16; g0[m] = GLD(u32x4, MG + (size_t)row * 2048 + col); g1[m] = GLD(u32x4, MG + (size_t)row * 2048 + 1024 + col); }
#pragma unroll
            for (int m = 0; m < 4; ++m) {
                const int row = row0 + ai * 128 + m * 16;
                float h[8];
#pragma unroll
                for (int i = 0; i < 8; ++i) {
                    const unsigned w0 = g0[m][i >> 1], w1 = g1[m][i >> 1];
                    const float a0 = __builtin_bit_cast(float, (i & 1) ? (w0 & 0xffff0000u) : (w0 << 16)), a1 = __builtin_bit_cast(float, (i & 1) ? (w1 & 0xffff0000u) : (w1 << 16));
                    h[i] = a0 * acc[ai][0][m][i >> 2][i & 3] + a1 * acc[ai][1][m][i >> 2][i & 3];
                }
                u32x4 w; w.x = pg8::cvt_pk_bf16(h[0], h[1]); w.y = pg8::cvt_pk_bf16(h[2], h[3]); w.z = pg8::cvt_pk_bf16(h[4], h[5]); w.w = pg8::cvt_pk_bf16(h[6], h[7]);
                GST(u32x4, O + (size_t)row * DM + col, w);
            }
        }
    }
};
struct EpiZ : RowScale {
    static constexpr bool PERM = true, AFTER_DRAIN = false, ROWSCALE = true;
    unsigned char* ws; const float *gq, *gk, *gnq, *gnk;
    __device__ __forceinline__ void operator()(const f32x4 (&acc)[2][2][4][2], const pg8::Unit& u, int wr, int wc, int fr, int fq, const LAS float* rst) const {
        const int ch = 4 * u.pn + wc;
        if (ch >= 77) return;
        const int row0 = u.pm * 256 + wr * 64 + fr;
        int kind, nh = 8, hd = 0, nd = 64, dbase = 0; size_t dst = 0; const float* gain = nullptr; float scale = 1.f;
        if (ch < 8) { kind = 0; dst = Z_DQ; hd = ch; gain = gq; scale = QSCALE; }
        else if (ch < 16) { kind = 0; dst = Z_DK; hd = ch - 8; gain = gk; }
        else if (ch < 24) { kind = 2; dst = Z_DVT; nh = 4; hd = (ch - 16) >> 1; nd = 128; dbase = ((ch - 16) & 1) * 64; }
        else if (ch < 32) { kind = 0; dst = Z_NQ; hd = ch - 24; gain = gnq; scale = QSCALE; }
        else if (ch < 34) { kind = 1; dst = Z_KCR; nh = 2; hd = ch - 32; }
        else if (ch < 36) { kind = 1; dst = Z_VCR; nh = 2; hd = ch - 34; }
        else if (ch < 38) { kind = 0; dst = Z_KSEL; nh = 2; hd = ch - 36; gain = gnk + 64; }
        else if (ch < 40) { kind = 2; dst = Z_VSELT; nh = 2; hd = ch - 38; }
        else if (ch < 42) { kind = 0; dst = Z_KWIN; nh = 2; hd = ch - 40; gain = gnk + 128; }
        else if (ch < 44) { kind = 2; dst = Z_VWINT; nh = 2; hd = ch - 42; }
        else if (ch < 76) { kind = 3; }
        else { kind = 4; }
        if (kind == 0 || kind == 1) {
            float gv[16];
#pragma unroll
            for (int i = 0; i < 16; ++i) gv[i] = (kind == 0) ? gain[(i >> 3) * 32 + 8 * fq + (i & 7)] * scale : 1.f;
#pragma unroll
            for (int ai = 0; ai < 2; ++ai)
#pragma unroll
                for (int m = 0; m < 4; ++m) {
                    const int row = row0 + ai * 128 + m * 16, b = row >> 12, s = row & 4095;
                    float v[16];
                    const float rrs = rst[ai * 128 + wr * 64 + m * 16 + fr];
#pragma unroll
                    for (int i = 0; i < 16; ++i) v[i] = acc[ai][i >> 3][m][(i >> 2) & 1][i & 3] * rrs;
                    float rs = 1.f;
                    if (kind == 0) {
                        float ss = 0.f;
#pragma unroll
                        for (int i = 0; i < 16; ++i) ss += v[i] * v[i];
                        ss += __shfl_xor(ss, 16); ss += __shfl_xor(ss, 32);
                        rs = __builtin_amdgcn_rsqf(ss * (1.f / 64.f) + EPS);
                    }
#pragma unroll
                    for (int i = 0; i < 16; ++i) v[i] *= rs * gv[i];
                    bf16_t* d = (bf16_t*)(ws + dst) + ((size_t)(b * nh + hd) * SEQ + s) * 64 + 8 * fq;
                    u32x4 w0, w1;
                    w0.x = pg8::cvt_pk_bf16(v[0], v[1]); w0.y = pg8::cvt_pk_bf16(v[2], v[3]); w0.z = pg8::cvt_pk_bf16(v[4], v[5]); w0.w = pg8::cvt_pk_bf16(v[6], v[7]);
                    w1.x = pg8::cvt_pk_bf16(v[8], v[9]); w1.y = pg8::cvt_pk_bf16(v[10], v[11]); w1.z = pg8::cvt_pk_bf16(v[12], v[13]); w1.w = pg8::cvt_pk_bf16(v[14], v[15]);
                    GST(u32x4, d, w0); GST(u32x4, d + 32, w1);
                }
        } else if (kind == 2) {
#pragma unroll
            for (int ai = 0; ai < 2; ++ai)
#pragma unroll
                for (int m = 0; m < 4; ++m) {
                    const int row = row0 + ai * 128 + m * 16, b = row >> 12, s = row & 4095;
                    bf16_t* d = (bf16_t*)(ws + dst) + ((size_t)(b * nh + hd) * nd + dbase + 8 * fq) * SEQ + s;
                    const float rrs = rst[ai * 128 + wr * 64 + m * 16 + fr];
#pragma unroll
                    for (int i = 0; i < 16; ++i) GST(bf16_t, d + (size_t)((i >> 3) * 32 + (i & 7)) * SEQ, (bf16_t)f2bf(acc[ai][i >> 3][m][(i >> 2) & 1][i & 3] * rrs));
                }
        } else if (kind == 3) {
            const int col = (ch - 44) * 64 + 8 * fq;
#pragma unroll
            for (int ai = 0; ai < 2; ++ai)
#pragma unroll
                for (int m = 0; m < 4; ++m) {
                    const int row = row0 + ai * 128 + m * 16;
                    float v[16];
                    const float rrs = rst[ai * 128 + wr * 64 + m * 16 + fr];
#pragma unroll
                    for (int i = 0; i < 16; ++i) v[i] = sigmoidf_(acc[ai][i >> 3][m][(i >> 2) & 1][i & 3] * rrs);
                    bf16_t* d = (bf16_t*)(ws + Z_MG) + (size_t)row * 2048 + col;
                    u32x4 w0, w1;
                    w0.x = pg8::cvt_pk_bf16(v[0], v[1]); w0.y = pg8::cvt_pk_bf16(v[2], v[3]); w0.z = pg8::cvt_pk_bf16(v[4], v[5]); w0.w = pg8::cvt_pk_bf16(v[6], v[7]);
                    w1.x = pg8::cvt_pk_bf16(v[8], v[9]); w1.y = pg8::cvt_pk_bf16(v[10], v[11]); w1.z = pg8::cvt_pk_bf16(v[12], v[13]); w1.w = pg8::cvt_pk_bf16(v[14], v[15]);
                    GST(u32x4, d, w0); GST(u32x4, d + 32, w1);
                }
        } else {
            if (fq < 3) {
#pragma unroll
                for (int ai = 0; ai < 2; ++ai)
#pragma unroll
                    for (int m = 0; m < 4; ++m) {
                        const int row = row0 + ai * 128 + m * 16;
                        float* d = (float*)(ws + Z_NG) + (size_t)row * 24 + 8 * fq;
                        const float rrs = rst[ai * 128 + wr * 64 + m * 16 + fr];
#pragma unroll
                        for (int i = 0; i < 8; ++i) GST(float, d + i, sigmoidf_(acc[ai][0][m][i >> 2][i & 3] * rrs));
                    }
            }
        }
    }
};

__device__ __forceinline__ void tr_item(const float* src, int ld, int c0, int nvalid, int k0, bf16_t* dst, int Kdst, LAS float* scr, int lane, const float* rsc = nullptr) {
    const int n = lane & 31;
#pragma unroll
    for (int i = 0; i < 32; ++i) { const int kk = 2 * i + (lane >> 5); scr[kk * 33 + n] = (src && n < nvalid) ? GLD(float, src + (size_t)(k0 + kk) * ld + c0 + n) * (rsc ? GLD(float, rsc + k0 + kk) : 1.f) : 0.f; }
    asm volatile("s_waitcnt lgkmcnt(0)" ::: "memory");
    const int c = lane & 7;
#pragma unroll
    for (int j = 0; j < 4; ++j) { const int nn = (lane >> 3) + 8 * j; const LAS float* s = scr + (8 * c) * 33 + nn;
        u32x4 o; o.x = pk2(s[0 * 33], s[1 * 33]); o.y = pk2(s[2 * 33], s[3 * 33]); o.z = pk2(s[4 * 33], s[5 * 33]); o.w = pk2(s[6 * 33], s[7 * 33]);
        GST(u32x4, dst + (size_t)nn * Kdst + 8 * c, o); }
    asm volatile("s_waitcnt lgkmcnt(0)" ::: "memory");
}
__device__ __forceinline__ int zchunk_src(int ch) {
    if (ch < 32) return ch * 64;
    if (ch < 44) return 2048 + (ch - 32) * 64;
    if (ch < 76) return 2840 + (ch - 44) * 64;
    return 2816;
}
__device__ __forceinline__ int t5_bucket(int n) {
    if (n < 16) return n;
    int b = 16;
    b += (n >= 21); b += (n >= 27); b += (n >= 35); b += (n >= 46); b += (n >= 59); b += (n >= 77); b += (n >= 99); b += (n >= 128);
    b += (n >= 166); b += (n >= 216); b += (n >= 280); b += (n >= 363); b += (n >= 470); b += (n >= 609); b += (n >= 790);
    return b;
}
__device__ __forceinline__ void prologue(const Params& P, LAS unsigned char* lds) {
    const int tid = otid(), lane = tid & 63, wave = tid >> 6;
    LAS float* scr = (LAS float*)(lds + wave * 16384);
    const int gw = blockIdx.x * NWAVE + wave, NGW = gridDim.x * NWAVE;
    unsigned char* ws = WSP;
    constexpr int I13 = 176 * 16, I2 = 32 * 44, IIN = 160 * 16, IPAB = 64 * 16, IWO = 32 * 16, IC1 = 4 * 32, IC2 = 2 * 2;
    constexpr int PER_L = 2 * I13 + 2 * I2 + IIN + IPAB + IWO + 2 * IC1 + 2 * IC2;
    for (int it = gw; it < DEPTH * PER_L; it += NGW) {
        const int l = it / PER_L; int r = it % PER_L;
        if (r < 2 * I13) {
            const int f = r / I13; r %= I13; const int gi = r / 16, kb = r % 16;
            const int t = gi >> 3, bj = (gi >> 2) & 1, sub = gi & 3;
            const float* src = (f ? (bj ? INP(12) : INP(11)) : (bj ? INP(9) : INP(8))) + (size_t)l * DM * DFF;
            tr_item(src, DFF, 128 * t + 32 * sub, 32, 64 * kb, (bf16_t*)(ws + WS_W13 + (size_t)(l * 2 + f) * W13_SZ) + (size_t)(32 * gi) * DM + 64 * kb, DM, scr, lane, (f ? INP(7) : INP(5)) + l * DM);
            continue;
        }
        r -= 2 * I13;
        if (r < 2 * I2) {
            const int f = r / I2; r %= I2; const int gi = r / 44, kb = r % 44;
            const float* src = (f ? INP(13) : INP(10)) + (size_t)l * DFF * DM;
            tr_item(src, DM, 32 * gi, 32, 64 * kb, (bf16_t*)(ws + WS_W2 + (size_t)(l * 2 + f) * W2_SZ) + (size_t)(32 * gi) * DFF + 64 * kb, DFF, scr, lane);
            continue;
        }
        r -= 2 * I2;
        if (r < IIN) {
            const int gi = r / 16, kb = r % 16;
            const int t = gi >> 3, bj = (gi >> 2) & 1, wc = gi & 3, ch = 4 * t + wc;
            int nvalid = 32; if (ch == 76) nvalid = bj ? 0 : 24; if (ch > 76) nvalid = 0;
            const float* src = nvalid ? INP(1) + (size_t)l * DM * NIN : nullptr;
            tr_item(src, NIN, zchunk_src(ch) + 32 * bj, nvalid, 64 * kb, (bf16_t*)(ws + WS_WIN + (size_t)l * WIN_SZ) + (size_t)(32 * gi) * DM + 64 * kb, DM, scr, lane, INP(6) + l * DM);
            continue;
        }
        r -= IIN;
        if (r < IPAB) {
            const int gi = r / 16, kb = r % 16;
            const int t = gi >> 3, bj = (gi >> 2) & 1, sub = gi & 3;
            const float* src = nullptr; int k0 = 0;
            if (bj == 0 && kb < 8) { src = INP(2) + (size_t)l * 512 * DM; k0 = 64 * kb; }
            if (bj == 1 && kb >= 8) { src = INP(3) + (size_t)l * 512 * DM; k0 = 64 * (kb - 8); }
            tr_item(src, DM, 128 * t + 32 * sub, 32, k0, (bf16_t*)(ws + WS_PAB + (size_t)l * PAB_SZ) + (size_t)(32 * gi) * DM + 64 * kb, DM, scr, lane);
            continue;
        }
        r -= IPAB;
        if (r < IWO) {
            const int gi = r / 16, kb = r % 16;
            tr_item(INP(4) + (size_t)l * DM * DM, DM, 32 * gi, 32, 64 * kb, (bf16_t*)(ws + WS_WO + (size_t)l * WO_SZ) + (size_t)(32 * gi) * DM + 64 * kb, DM, scr, lane);
            continue;
        }
        r -= IWO;
        if (r < 2 * IC1) {
            const int kv = r / IC1; r %= IC1; const int gi = r / 32, kb = r % 32;
            tr_item((kv ? INP(27) : INP(24)) + (size_t)l * 2048 * 128, 128, 32 * gi, 32, 64 * kb, (bf16_t*)(ws + WS_CW1 + (size_t)(l * 2 + kv) * CW1_SZ) + (size_t)(32 * gi) * 2048 + 64 * kb, 2048, scr, lane);
            continue;
        }
        r -= 2 * IC1;
        {
            const int kv = r / IC2; r %= IC2; const int gi = r / 2, kb = r % 2;
            tr_item((kv ? INP(28) : INP(25)) + (size_t)l * 128 * 64, 64, 32 * gi, 32, 64 * kb, (bf16_t*)(ws + WS_CW2 + (size_t)(l * 2 + kv) * CW2_SZ) + (size_t)(32 * gi) * 128 + 64 * kb, 128, scr, lane);
        }
    }
    const int gt = blockIdx.x * NTHR + tid, NGT = gridDim.x * NTHR;
    for (int i = gt; i < 12 * 1024; i += NGT) { const int h = i >> 10, d = i & 1023; ((float*)(ws + WS_BIAS))[i] = INP(29)[t5_bucket(d) * 12 + h] * LOG2E; }
    if (blockIdx.x == (gridDim.x > 1 ? 1 : 0) && wave < DEPTH) {
        const int l = wave;
        float a = INP(16)[l * 64 + lane] * INP(17)[l * 64 + lane], b = INP(18)[l * 64 + lane] * INP(19)[l * 64 + lane];
        float mq = fabsf(INP(14)[l * 64 + lane]), mk = fabsf(INP(15)[l * 64 + lane]), mnq = fabsf(INP(21)[l * 64 + lane]);
        float mnk = fmaxf(fmaxf(fabsf(INP(22)[l * 192 + lane]), fabsf(INP(22)[l * 192 + 64 + lane])), fabsf(INP(22)[l * 192 + 128 + lane]));
        float mb = 0.f; for (int i = lane; i < 32 * 12; i += 64) mb = fmaxf(mb, fabsf(INP(29)[i]));
#pragma unroll
        for (int o = 1; o < 64; o <<= 1) { a += __shfl_xor(a, o); b += __shfl_xor(b, o); mq = fmaxf(mq, __shfl_xor(mq, o)); mk = fmaxf(mk, __shfl_xor(mk, o)); mnq = fmaxf(mnq, __shfl_xor(mnq, o)); mnk = fmaxf(mnk, __shfl_xor(mnk, o)); mb = fmaxf(mb, __shfl_xor(mb, o)); }
        if (lane == 0) {
            float* prm = (float*)(ws + WS_PRM) + l * 8;
            const float lam_init = 0.8f - 0.6f * expf(-0.3f * (float)l);
            prm[0] = expf(a) - expf(b) + lam_init;
            prm[1] = (8.f * mq * mk * 1.02f + mb) * LOG2E;
            prm[2] = (8.f * mnq * mnk * 1.02f + mb) * LOG2E;
            prm[3] = 1.0f - lam_init;
        }
    }
    for (int wi = blockIdx.x; wi < 32; wi += gridDim.x) {
        const int lk = wi >> 3, n = (wi & 7) * 16 + (tid & 15), ks = tid >> 4, l = lk >> 1, kv = lk & 1;
        const float* pe = (kv ? INP(26) : INP(23)) + (size_t)l * 2048; const float* w1 = (kv ? INP(27) : INP(24)) + (size_t)l * 2048 * 128;
        float sacc = 0.f;
#pragma unroll 16
        for (int k = 64 * ks; k < 64 * ks + 64; ++k) sacc += GLD(float, pe + k) * GLD(float, w1 + (size_t)k * 128 + n);
        LAS float* red = (LAS float*)lds;
        __syncthreads();
        red[tid] = sacc;
        __syncthreads();
        if (tid < 16) { float t = 0.f; for (int i = 0; i < 32; ++i) t += red[i * 16 + tid]; ((float*)(ws + WS_CB1))[lk * 128 + (wi & 7) * 16 + tid] = t; }
        __syncthreads();
    }
}

template <bool INBF16, bool COPYRAW>
__device__ __forceinline__ void rmsnorm_phase(const void* x, const float* g, bf16_t* o, bf16_t* xraw = nullptr) {
    const int tid = otid(), lane = tid & 63, wave = tid >> 6;
    const int gw = blockIdx.x * NWAVE + wave, NGW = gridDim.x * NWAVE;
    f32x4 gv[4];
#pragma unroll
    for (int j = 0; j < 4; ++j) gv[j] = GLD(f32x4, (const f32x4*)g + lane + 64 * j);
    constexpr int RB = 4;
    for (int m0 = gw; m0 < MTOK; m0 += NGW * RB) {
        f32x4 v[RB][4]; float s[RB];
#pragma unroll
        for (int r = 0; r < RB; ++r) { const int m = m0 + r * NGW; const size_t ro = (size_t)(m < MTOK ? m : m0) * DM;
#pragma unroll
            for (int j = 0; j < 4; ++j) {
                if (!INBF16) v[r][j] = GLD(f32x4, (const f32x4*)((const float*)x + ro) + lane + 64 * j);
                else { const u32x2 w = GLD(u32x2, (const u32x2*)((const bf16_t*)x + ro) + lane + 64 * j);
                       if (COPYRAW && m < MTOK) GST(u32x2, (u32x2*)(xraw + ro) + lane + 64 * j, w);
                       v[r][j] = (f32x4){__builtin_bit_cast(float, w.x << 16), __builtin_bit_cast(float, w.x & 0xffff0000u), __builtin_bit_cast(float, w.y << 16), __builtin_bit_cast(float, w.y & 0xffff0000u)}; }
            } }
#pragma unroll
        for (int r = 0; r < RB; ++r) { s[r] = 0.f;
#pragma unroll
            for (int j = 0; j < 4; ++j) s[r] += (v[r][j].x * v[r][j].x + v[r][j].y * v[r][j].y) + (v[r][j].z * v[r][j].z + v[r][j].w * v[r][j].w); }
#pragma unroll
        for (int of = 1; of < 64; of <<= 1) {
#pragma unroll
            for (int r = 0; r < RB; ++r) s[r] += __shfl_xor(s[r], of); }
#pragma unroll
        for (int r = 0; r < RB; ++r) { const int m = m0 + r * NGW;
            if (m < MTOK) {
                const float rs = __builtin_amdgcn_rsqf(s[r] * (1.f / DM) + EPS);
                u32x2* o8 = (u32x2*)(o + (size_t)m * DM) + lane;
#pragma unroll
                for (int j = 0; j < 4; ++j) { u32x2 w; w.x = pk2(v[r][j].x * rs * gv[j].x, v[r][j].y * rs * gv[j].y); w.y = pk2(v[r][j].z * rs * gv[j].z, v[r][j].w * rs * gv[j].w); GST(u32x2, o8 + 64 * j, w); }
            }
        }
    }
}

__device__ __forceinline__ void xprep_phase(const float* x, bf16_t* o, float* ss) {
    const int tid = otid(), lane = tid & 63, wave = tid >> 6;
    const int gw = blockIdx.x * NWAVE + wave, NGW = gridDim.x * NWAVE;
    for (int m = gw; m < MTOK; m += NGW) {
        const f32x4* xr = (const f32x4*)(x + (size_t)m * DM) + lane;
        f32x4 v[4]; float s = 0.f;
#pragma unroll
        for (int j = 0; j < 4; ++j) { v[j] = GLD(f32x4, xr + 64 * j); s += (v[j].x * v[j].x + v[j].y * v[j].y) + (v[j].z * v[j].z + v[j].w * v[j].w); }
#pragma unroll
        for (int of = 1; of < 64; of <<= 1) s += __shfl_xor(s, of);
        u32x2* o8 = (u32x2*)(o + (size_t)m * DM) + lane;
#pragma unroll
        for (int j = 0; j < 4; ++j) { u32x2 w; w.x = pk2(v[j].x, v[j].y); w.y = pk2(v[j].z, v[j].w); GST(u32x2, o8 + 64 * j, w); }
        if (lane < 16) GST(float, ss + (size_t)m * 16 + lane, lane == 0 ? s : 0.f);
    }
}

__device__ __forceinline__ float gelu_tanh(float x) {
    const float y = 0.7978845608028654f * (x + 0.044715f * x * x * x);
    const float e = __builtin_amdgcn_exp2f(2.f * LOG2E * y);
    const float t = 1.f - 2.f * __builtin_amdgcn_rcpf(e + 1.f);
    return 0.5f * x * (1.f + t);
}
__device__ __forceinline__ void compress_phase(const Params& P, int l, LAS unsigned char* lds) {
    const int tid = otid(), lane = tid & 63, wave = tid >> 6, fr = lane & 15, kq = lane >> 4;
    unsigned char* ws = WSP;
    LAS bf16_t* Hs = (LAS bf16_t*)lds;
    LAS float* Os = (LAS float*)(lds + 8704);
    LAS unsigned char* As = lds + 17408;
    for (int unit = blockIdx.x; unit < 2 * 16 * 8; unit += gridDim.x) {
        const int kv = unit >> 7, bg = (unit >> 3) & 15, c0 = 32 * (unit & 7);
        const bf16_t* src = (const bf16_t*)(ws + (kv ? Z_VCR : Z_KCR)) + (size_t)bg * SEQ * 64;
        for (int i = tid; i < 33 * 128; i += NTHR) {
            const int j = i >> 7, pc = i & 127;
            u32x4 v = {0u, 0u, 0u, 0u};
            if (c0 + j <= 255) v = GLD(u32x4, (const unsigned char*)(src + (size_t)1024 * (c0 + j)) + pc * 16);
            *(LAS u32x4*)(As + j * 2064 + pc * 16) = v;
        }
        __syncthreads();
        const bf16_t* bp = (const bf16_t*)(ws + WS_CW1 + (size_t)(l * 2 + kv) * CW1_SZ) + (size_t)(16 * wave + fr) * 2048 + 8 * kq;
        f32x4 acc0 = {0.f, 0.f, 0.f, 0.f}, acc1 = {0.f, 0.f, 0.f, 0.f};
#pragma unroll
        for (int kb = 0; kb < 4; ++kb) {
            bf16x8 bfr[16];
#pragma unroll
            for (int i = 0; i < 16; ++i) bfr[i] = GLD(bf16x8, bp + 32 * (16 * kb + i));
#pragma unroll
            for (int i = 0; i < 16; ++i) {
                const int k = 32 * (16 * kb + i) + 8 * kq;
                const LAS unsigned char* ar = As + (fr + (k >> 10)) * 2064 + (k & 1023) * 2;
                const bf16x8 a0 = *(const LAS bf16x8*)ar, a1 = *(const LAS bf16x8*)(ar + 16 * 2064);
                acc0 = __builtin_amdgcn_mfma_f32_16x16x32_bf16(a0, bfr[i], acc0, 0, 0, 0);
                acc1 = __builtin_amdgcn_mfma_f32_16x16x32_bf16(a1, bfr[i], acc1, 0, 0, 0);
            }
        }
        const float cb = ((const float*)(ws + WS_CB1))[(l * 2 + kv) * 128 + 16 * wave + fr];
#pragma unroll
        for (int i = 0; i < 4; ++i) { Hs[(4 * kq + i) * 136 + 16 * wave + fr] = (bf16_t)f2bf(gelu_tanh(acc0[i] + cb)); Hs[(16 + 4 * kq + i) * 136 + 16 * wave + fr] = (bf16_t)f2bf(gelu_tanh(acc1[i] + cb)); }
        __syncthreads();
        {
            const int mt = wave >> 2, ns = wave & 3;
            const bf16_t* b2 = (const bf16_t*)(ws + WS_CW2 + (size_t)(l * 2 + kv) * CW2_SZ) + (size_t)(16 * ns + fr) * 128 + 8 * kq;
            f32x4 a2 = {0.f, 0.f, 0.f, 0.f};
#pragma unroll
            for (int kk = 0; kk < 4; ++kk) { const bf16x8 a = *(const LAS bf16x8*)(Hs + (16 * mt + fr) * 136 + 32 * kk + 8 * kq), b = GLD(bf16x8, b2 + 32 * kk); a2 = __builtin_amdgcn_mfma_f32_16x16x32_bf16(a, b, a2, 0, 0, 0); }
#pragma unroll
            for (int i = 0; i < 4; ++i) Os[(16 * mt + 4 * kq + i) * 65 + 16 * ns + fr] = a2[i];
        }
        __syncthreads();
#pragma unroll
        for (int rep = 0; rep < 4; ++rep) {
            const int e = tid + NTHR * rep, row = e >> 6, d = e & 63, c = c0 + row;
            const float val = Os[row * 65 + d];
            if (kv == 0) {
                float ss = 0.f;
#pragma unroll 16
                for (int j = 0; j < 64; ++j) { const float t = Os[row * 65 + j]; ss += t * t; }
                const float o = val * __builtin_amdgcn_rsqf(ss * (1.f / 64.f) + EPS) * GLD(float, INP(22) + l * 192 + d);
                GST(bf16_t, (bf16_t*)(ws + WS_KCN) + ((size_t)bg * 256 + c) * 64 + d, (c < 255) ? (bf16_t)f2bf(o) : (bf16_t)0);
            } else {
                GST(bf16_t, (bf16_t*)(ws + WS_VCT) + ((size_t)bg * 64 + d) * 256 + c, (c < 255) ? (bf16_t)f2bf(val) : (bf16_t)0);
            }
        }
        __syncthreads();
    }
}

__device__ __forceinline__ void qk_tile(f32x16& p0, f32x16& p1, const LAS unsigned char* Kl, const bf16x8 (&qf)[4], int r32, int hi) {
    const LAS unsigned char* kb = Kl + r32 * KP + hi * 16;
    bf16x8 a[8];
#pragma unroll
    for (int d0 = 0; d0 < 4; ++d0) { a[2 * d0] = *(const LAS bf16x8*)(kb + d0 * 32); a[2 * d0 + 1] = *(const LAS bf16x8*)(kb + 32 * KP + d0 * 32); }
    __builtin_amdgcn_s_setprio(1);
#pragma unroll
    for (int d0 = 0; d0 < 4; ++d0) {
        p0 = __builtin_amdgcn_mfma_f32_32x32x16_bf16(a[2 * d0], qf[d0], p0, 0, 0, 0);
        p1 = __builtin_amdgcn_mfma_f32_32x32x16_bf16(a[2 * d0 + 1], qf[d0], p1, 0, 0, 0);
    }
    __builtin_amdgcn_s_setprio(0);
}
template <int STRIDE, bool WINDOW, int MODE>
__device__ __forceinline__ void score_exp(f32x16& p0, f32x16& p1, int dl, const LAS float* tb, float cfar, bool rowsel) {
    const LAS float* tl = tb + 128 + (dl < 1087 ? dl : 1087) - 59;
#pragma unroll
    for (int blk = 0; blk < 2; ++blk) {
        f32x16& p = blk ? p1 : p0;
#pragma unroll
        for (int r = 0; r < 16; ++r) {
            const int c = (r & 3) + 8 * (r >> 2) + 32 * blk;
            const int dist = dl - STRIDE * c;
            float e;
            if (MODE == 0) e = __builtin_amdgcn_exp2f(p[r] + cfar);
            else {
                float bias;
                if (STRIDE == 1) bias = tl[59 - c];
                else bias = tb[128 + min((unsigned)dist, 1023u)];
                e = __builtin_amdgcn_exp2f(p[r] + bias);
                if (MODE == 2) { bool valid = dist >= 0; if (WINDOW) valid = valid && (dist < 512); e = valid ? e : 0.f; }
            }
            p[r] = rowsel ? e : 0.f;
        }
    }
}
template <int STRIDE, bool WINDOW>
__device__ __forceinline__ void score_exp_sel(f32x16& p0, f32x16& p1, int dl, const LAS float* tb, float cfar, bool rowsel, int dmin, int dmax) {
    if (!WINDOW && dmin >= 790) score_exp<STRIDE, WINDOW, 0>(p0, p1, dl, tb, cfar, rowsel);
    else if (dmin >= 0 && (!WINDOW || dmax < 512)) score_exp<STRIDE, WINDOW, 1>(p0, p1, dl, tb, cfar, rowsel);
    else score_exp<STRIDE, WINDOW, 2>(p0, p1, dl, tb, cfar, rowsel);
}
__device__ __forceinline__ float sum32(const f32x16& p0, const f32x16& p1) {
    float a = 0.f, b = 0.f;
#pragma unroll
    for (int r = 0; r < 16; ++r) { a += p0[r]; b += p1[r]; }
    return a + b;
}
template <int NDB>
__device__ __forceinline__ void pv_tile(f32x16 (&o)[NDB], const f32x16& p0, const f32x16& p1, const LAS unsigned char* Vl, int r32, int hi) {
    const LAS unsigned char* vbase = Vl + r32 * VP + hi * 8;
    bf16x4 vf[2][NDB][2];
#define PV_LOAD(st, buf) do { _Pragma("unroll") for (int db = 0; db < NDB; ++db) { const LAS unsigned char* vp = vbase + db * 32 * VP + (st) * 32; vf[buf][db][0] = *(const LAS bf16x4*)vp; vf[buf][db][1] = *(const LAS bf16x4*)(vp + 16); } } while (0)
    PV_LOAD(0, 0);
#pragma unroll
    for (int st = 0; st < 4; ++st) {
        if (st + 1 < 4) PV_LOAD(st + 1, (st + 1) & 1);
        const f32x16& p = (st >> 1) ? p1 : p0; const int s8 = 8 * (st & 1);
        u32x4 w; w.x = pg8::cvt_pk_bf16(p[s8 + 0], p[s8 + 1]); w.y = pg8::cvt_pk_bf16(p[s8 + 2], p[s8 + 3]); w.z = pg8::cvt_pk_bf16(p[s8 + 4], p[s8 + 5]); w.w = pg8::cvt_pk_bf16(p[s8 + 6], p[s8 + 7]);
        const bf16x8 pa = __builtin_bit_cast(bf16x8, w);
        __builtin_amdgcn_s_setprio(1);
#pragma unroll
        for (int db = 0; db < NDB; ++db) {
            const bf16x4 lo = vf[st & 1][db][0], hi4 = vf[st & 1][db][1];
            const bf16x8 vb = {lo[0], lo[1], lo[2], lo[3], hi4[0], hi4[1], hi4[2], hi4[3]};
            o[db] = __builtin_amdgcn_mfma_f32_32x32x16_bf16(pa, vb, o[db], 0, 0, 0);
        }
        __builtin_amdgcn_s_setprio(0);
    }
#undef PV_LOAD
}
__device__ __forceinline__ u32x4 ldk(const bf16_t* g, int tid) { return GLD(u32x4, (const unsigned char*)g + tid * 16); }
__device__ __forceinline__ void stk(LAS unsigned char* Kl, u32x4 v, int tid) { *(LAS u32x4*)(Kl + (tid >> 3) * KP + (tid & 7) * 16) = v; }
__device__ __forceinline__ u32x4 ldv(const bf16_t* g, size_t rs, int row, int tid) { return GLD(u32x4, (const unsigned char*)(g + (size_t)row * rs) + (tid & 7) * 16); }
__device__ __forceinline__ void stv(LAS unsigned char* Vl, u32x4 v, int row, int tid) { LAS unsigned char* p = Vl + row * VP + (tid & 7) * 16; *(LAS u32x2*)p = (u32x2){v.x, v.y}; *(LAS u32x2*)(p + 8) = (u32x2){v.z, v.w}; }

__device__ __forceinline__ void da_unit(const Params& P, int l, int b, int h, int qb, LAS unsigned char* lds, bool load_tab) {
    const int tid = otid(), lane = tid & 63, wave = __builtin_amdgcn_readfirstlane(tid >> 6), r32 = lane & 31, hi = lane >> 5;
    const int c = wave >> 2, qsub = wave & 3, q0 = qb * 128, qw0 = q0 + 32 * qsub;
    unsigned char* ws = WSP;
    const float* prm = (const float*)(ws + WS_PRM) + l * 8;
    const float lam = prm[0], Mb = prm[1], onem = prm[3];
    LAS float* biasL = (LAS float*)(lds + L_BIAS);
    const float* bg = (const float*)(ws + WS_BIAS) + h * 1024;
    if (load_tab) for (int i = tid; i < TBN; i += NTHR) { const int d = i - 128; biasL[i] = GLD(float, bg + (d < 0 ? 0 : (d > 1023 ? 1023 : d))) - Mb; }
    const float cfar = bg[1023] - Mb;
    const bf16_t* Qp = (const bf16_t*)(ws + Z_DQ) + ((size_t)(b * 8 + h * 2 + c) * SEQ + qw0 + r32) * 64 + hi * 8;
    bf16x8 qf[4];
#pragma unroll
    for (int d0 = 0; d0 < 4; ++d0) qf[d0] = GLD(bf16x8, Qp + d0 * 16);
    const bf16_t* K1g = (const bf16_t*)(ws + Z_DK) + (size_t)(b * 8 + h * 2) * SEQ * 64;
    const bf16_t* K2g = K1g + (size_t)SEQ * 64;
    const bf16_t* Vg = (const bf16_t*)(ws + Z_DVT) + (size_t)(b * 4 + h) * 128 * SEQ;
    const int NT = (q0 + 128) / 64;
    f32x16 o[4];
#pragma unroll
    for (int i = 0; i < 4; ++i) o[i] = (f32x16){};
    float lsum = 0.f;
    u32x4 rk1, rk2, rv0, rv1;
#define DA_LOAD(t) do { rk1 = ldk(K1g + (size_t)(t) * 4096, tid); rk2 = ldk(K2g + (size_t)(t) * 4096, tid); rv0 = ldv(Vg + (t) * 64, SEQ, tid >> 3, tid); rv1 = ldv(Vg + (t) * 64, SEQ, 64 + (tid >> 3), tid); } while (0)
#define DA_STORE(sb) do { LAS unsigned char* st_ = lds + (sb) * DA_STAGE; stk(st_, rk1, tid); stk(st_ + 64 * KP, rk2, tid); stv(st_ + 128 * KP, rv0, tid >> 3, tid); stv(st_ + 128 * KP, rv1, 64 + (tid >> 3), tid); } while (0)
    DA_LOAD(0); DA_STORE(0);
    __syncthreads();
    for (int t = 0; t < NT; ++t) {
        if (t + 1 < NT) DA_LOAD(t + 1);
        if (64 * t <= qw0 + 31) {
            const LAS unsigned char* st = lds + (t & 1) * DA_STAGE;
            f32x16 p0 = (f32x16){}, p1 = (f32x16){};
            qk_tile(p0, p1, st + c * 64 * KP, qf, r32, hi);
            const int dl = qw0 + r32 - 64 * t - 4 * hi;
            score_exp_sel<1, false>(p0, p1, dl, biasL, cfar, true, qw0 - (64 * t + 63), qw0 + 31 - 64 * t);
            lsum += sum32(p0, p1);
            pv_tile<4>(o, p0, p1, st + 128 * KP, r32, hi);
        }
        if (t + 1 < NT) DA_STORE((t + 1) & 1);
        __syncthreads();
    }
#undef DA_LOAD
#undef DA_STORE
    lsum += __shfl_xor(lsum, 32);
    LAS float* wsf = (LAS float*)(lds + L_WSF) + wave * 64;
    if (hi == 0) wsf[r32] = (lsum > 0.f) ? 1.0f / lsum : 0.f;
    asm volatile("s_waitcnt lgkmcnt(0)" ::: "memory");
    float li[16];
#pragma unroll
    for (int r = 0; r < 16; ++r) li[r] = wsf[crow(r, hi)];
    LAS float* X = (LAS float*)lds;
    if (c == 1) {
#pragma unroll
        for (int db = 0; db < 4; ++db)
#pragma unroll
            for (int r = 0; r < 16; ++r) X[(32 * qsub + crow(r, hi)) * 132 + r32 + 32 * db] = o[db][r] * li[r];
    }
    __syncthreads();
    if (c == 0) {
        const float* sg = INP(20) + l * 128;
        float gsub[4];
#pragma unroll
        for (int db = 0; db < 4; ++db) gsub[db] = sg[r32 + 32 * db] * onem;
#pragma unroll
        for (int r = 0; r < 16; ++r) {
            float y[4], ss = 0.f;
#pragma unroll
            for (int db = 0; db < 4; ++db) { y[db] = o[db][r] * li[r] - lam * X[(32 * qsub + crow(r, hi)) * 132 + r32 + 32 * db]; ss += y[db] * y[db]; }
            ss += __shfl_xor(ss, 1); ss += __shfl_xor(ss, 2); ss += __shfl_xor(ss, 4); ss += __shfl_xor(ss, 8); ss += __shfl_xor(ss, 16);
            const float rs = __builtin_amdgcn_rsqf(ss * (1.f / 128.f) + EPS);
            bf16_t* d = (bf16_t*)(ws + WS_XN) + (size_t)(b * SEQ + qw0 + crow(r, hi)) * DM + h * 128 + r32;
#pragma unroll
            for (int db = 0; db < 4; ++db) GST(bf16_t, d + 32 * db, (bf16_t)f2bf(y[db] * rs * gsub[db]));
        }
    }
    __syncthreads();
}

__device__ __forceinline__ void nsa_unit(const Params& P, int l, int b, int g, int u, LAS unsigned char* lds, bool load_tab) {
    const int tid = otid(), lane = tid & 63, wave = __builtin_amdgcn_readfirstlane(tid >> 6), r32 = lane & 31, hi = lane >> 5;
    const int qi = r32 >> 2, p = r32 & 3, qw0 = 64 * u + 8 * wave, qpos = qw0 + qi, head = g * 4 + p;
    unsigned char* ws = WSP;
    const float Mb = ((const float*)(ws + WS_PRM))[l * 8 + 2];
    LAS float* biasL = (LAS float*)(lds + L_BIAS);
    LAS float* imp = (LAS float*)(lds + L_IMP);
    LAS unsigned* selw = (LAS unsigned*)(lds + L_SEL);
    LAS float* wsf = (LAS float*)(lds + L_WSF) + wave * 64;
    const float* bgl = (const float*)(ws + WS_BIAS) + (size_t)(4 + g * 4) * 1024;
    if (load_tab) for (int i = tid; i < 4 * TBN; i += NTHR) { const int hh = i / TBN, d = i % TBN - 128; biasL[i] = GLD(float, bgl + hh * 1024 + (d < 0 ? 0 : (d > 1023 ? 1023 : d))) - Mb; }
    if (tid == 0) { unsigned z = 0u; asm volatile("" : "+v"(z)); selw[128] = z; selw[129] = z; }
    const LAS float* tb = biasL + p * TBN;
    const float cfar = bgl[p * 1024 + 1023] - Mb;
    const bf16_t* Qp = (const bf16_t*)(ws + Z_NQ) + ((size_t)(b * 8 + head) * SEQ + qpos) * 64 + hi * 8;
    bf16x8 qf[4];
#pragma unroll
    for (int d0 = 0; d0 < 4; ++d0) qf[d0] = GLD(bf16x8, Qp + d0 * 16);
    const float* ngp = (const float*)(ws + Z_NG) + (size_t)(b * SEQ + qpos) * 24 + head * 3;
    const float gate_c = GLD(float, ngp), gate_s = GLD(float, ngp + 1), gate_w = GLD(float, ngp + 2);
    f32x16 oc[2]; oc[0] = (f32x16){}; oc[1] = (f32x16){};
    f32x16 o[2];
    u32x4 rk, rv;
    const int bgi = b * 2 + g;
#define NS_STORE(sb) do { LAS unsigned char* st_ = lds + (sb) * NS_STAGE; stk(st_, rk, tid); stv(st_ + 64 * KP, rv, tid >> 3, tid); } while (0)
#define NS_FOLD(gate) do { lsum += __shfl_xor(lsum, 32); if (hi == 0) wsf[r32] = (lsum > 0.f) ? (gate) / lsum : 0.f; asm volatile("s_waitcnt lgkmcnt(0)" ::: "memory"); \
        _Pragma("unroll") for (int r = 0; r < 16; ++r) { const float f_ = wsf[crow(r, hi)]; oc[0][r] += f_ * o[0][r]; oc[1][r] += f_ * o[1][r]; } asm volatile("s_waitcnt lgkmcnt(0)" ::: "memory"); } while (0)
    {
        const bf16_t* Kg = (const bf16_t*)(ws + WS_KCN) + (size_t)bgi * 256 * 64;
        const bf16_t* Vg = (const bf16_t*)(ws + WS_VCT) + (size_t)bgi * 64 * 256;
        const int ntc = (4 * u + 2) / 64 + 1;
        {
            u32x4 ck[4], cv[4];
#pragma unroll
            for (int tc = 0; tc < 4; ++tc) if (tc < ntc) { ck[tc] = ldk(Kg + (size_t)tc * 4096, tid); cv[tc] = ldv(Vg + tc * 64, 256, tid >> 3, tid); }
#pragma unroll
            for (int tc = 0; tc < 4; ++tc) if (tc < ntc) { LAS unsigned char* st_ = lds + tc * NS_STAGE; stk(st_, ck[tc], tid); stv(st_ + 64 * KP, cv[tc], tid >> 3, tid); }
        }
        __syncthreads();
        float lsum = 0.f;
        for (int tc = 0; tc < ntc; ++tc) {
            const LAS unsigned char* st = lds + tc * NS_STAGE;
            f32x16 p0 = (f32x16){}, p1 = (f32x16){};
            qk_tile(p0, p1, st, qf, r32, hi);
            const int dl = qpos - 31 - 16 * (64 * tc + 4 * hi);
            score_exp_sel<16, false>(p0, p1, dl, tb, cfar, true, qw0 - 31 - 16 * (64 * tc + 63), qw0 + 7 - 31 - 16 * 64 * tc);
            lsum += sum32(p0, p1);
        }
        const float lt = lsum + __shfl_xor(lsum, 32);
        const float linv = (lt > 0.f) ? 1.0f / lt : 0.f;
        o[0] = (f32x16){}; o[1] = (f32x16){};
        float carry = 0.f;
        for (int tc = 0; tc < ntc; ++tc) {
            const LAS unsigned char* st = lds + tc * NS_STAGE;
            f32x16 p0 = (f32x16){}, p1 = (f32x16){};
            qk_tile(p0, p1, st, qf, r32, hi);
            const int dl = qpos - 31 - 16 * (64 * tc + 4 * hi);
            score_exp_sel<16, false>(p0, p1, dl, tb, cfar, true, qw0 - 31 - 16 * (64 * tc + 63), qw0 + 7 - 31 - 16 * 64 * tc);
            float Qs[2][4], PL[2][4];
#pragma unroll
            for (int blk = 0; blk < 2; ++blk)
#pragma unroll
                for (int m = 0; m < 4; ++m) { const f32x16& pp = blk ? p1 : p0; Qs[blk][m] = (pp[4 * m] + pp[4 * m + 1]) + (pp[4 * m + 2] + pp[4 * m + 3]); PL[blk][m] = __shfl_xor(pp[4 * m + 3], 32); }
#pragma unroll
            for (int blk = 0; blk < 2; ++blk)
#pragma unroll
                for (int m = 0; m < 4; ++m) {
                    const float prev = (m > 0) ? PL[blk][m - 1] : (blk ? PL[0][3] : carry);
                    float e = (Qs[blk][m] + (hi ? PL[blk][m] : prev)) * linv;
                    e += __shfl_xor(e, 1); e += __shfl_xor(e, 2);
                    if (p == 0) imp[(8 * wave + qi) * 64 + 16 * tc + 8 * blk + 2 * m + hi] = e;
                }
            carry = PL[1][3];
            pv_tile<2>(o, p0, p1, st + 64 * KP, r32, hi);
        }
        NS_FOLD(gate_c);
    }
    __syncthreads();
    {
        const int ql = lane >> 3, sub = lane & 7, q = 8 * wave + ql;
        unsigned long long m;
        if (u < 8) m = (2ull << u) - 1ull;
        else {
            m = 1ull | (1ull << u) | (1ull << (u - 1));
            float v[8];
#pragma unroll
            for (int i = 0; i < 8; ++i) { const int j = sub + 8 * i; v[i] = (j >= 1 && j <= u - 2) ? imp[q * 64 + j] : -1.f; }
            for (int k = 0; k < 5; ++k) {
                float bv = v[0]; int bj = sub;
#pragma unroll
                for (int i = 1; i < 8; ++i) if (v[i] > bv) { bv = v[i]; bj = sub + 8 * i; }
#pragma unroll
                for (int of = 1; of < 8; of <<= 1) { const float ov = __shfl_xor(bv, of); const int oj = __shfl_xor(bj, of); if (ov > bv || (ov == bv && oj < bj)) { bv = ov; bj = oj; } }
                m |= 1ull << bj;
#pragma unroll
                for (int i = 0; i < 8; ++i) if (bj == sub + 8 * i) v[i] = -2.f;
            }
        }
        if (sub == 0) { selw[2 * q] = (unsigned)m; selw[2 * q + 1] = (unsigned)(m >> 32); atomicOr((unsigned*)&selw[128], (unsigned)m); atomicOr((unsigned*)&selw[129], (unsigned)(m >> 32)); }
    }
    __syncthreads();
    asm volatile("" : "+v"(oc[0]), "+v"(oc[1]));
    u32x4 rk2, rv2;
#define NS_LOADA(Kg_, Vg_, j_) do { rk = ldk((Kg_) + (size_t)(j_) * 4096, tid); rv = ldv((Vg_) + (j_) * 64, SEQ, tid >> 3, tid); } while (0)
#define NS_LOADB(Kg_, Vg_, j_) do { rk2 = ldk((Kg_) + (size_t)(j_) * 4096, tid); rv2 = ldv((Vg_) + (j_) * 64, SEQ, tid >> 3, tid); } while (0)
#define NS_STOREA(sb) do { LAS unsigned char* st_ = lds + (sb) * NS_STAGE; stk(st_, rk, tid); stv(st_ + 64 * KP, rv, tid >> 3, tid); } while (0)
#define NS_STOREB(sb) do { LAS unsigned char* st_ = lds + (sb) * NS_STAGE; stk(st_, rk2, tid); stv(st_ + 64 * KP, rv2, tid >> 3, tid); } while (0)
    {
        const unsigned long long un = (unsigned long long)selw[128] | ((unsigned long long)selw[129] << 32);
        const unsigned long long mine = (unsigned long long)selw[2 * (8 * wave + qi)] | ((unsigned long long)selw[2 * (8 * wave + qi) + 1] << 32);
        const bf16_t* Kg = (const bf16_t*)(ws + Z_KSEL) + (size_t)bgi * SEQ * 64;
        const bf16_t* Vg = (const bf16_t*)(ws + Z_VSELT) + (size_t)bgi * 64 * SEQ;
        o[0] = (f32x16){}; o[1] = (f32x16){};
        float lsum = 0.f;
        unsigned long long rem = un;
#define NS_NEXTJ(var, has) do { has = (rem != 0ull); var = 0; if (has) { var = __builtin_ctzll(rem); rem &= rem - 1; } } while (0)
        int jc, j1, j2; bool h1, h2;
        NS_NEXTJ(jc, h1);
        NS_NEXTJ(j1, h1);
        NS_LOADA(Kg, Vg, jc); if (h1) NS_LOADB(Kg, Vg, j1);
        NS_STOREA(0);
        __syncthreads();
        int sc = 0;
#define NS_SEL_STEP(LOADF, STOREN) { \
            NS_NEXTJ(j2, h2); if (h2) LOADF(Kg, Vg, j2); \
            const bool rowsel = (mine >> jc) & 1ull; \
            if (__any(rowsel)) { \
                const LAS unsigned char* st = lds + sc * NS_STAGE; \
                f32x16 p0 = (f32x16){}, p1 = (f32x16){}; \
                qk_tile(p0, p1, st, qf, r32, hi); \
                const int dl = qpos - 64 * jc - 4 * hi; \
                score_exp_sel<1, false>(p0, p1, dl, tb, cfar, rowsel, qw0 - (64 * jc + 63), qw0 + 7 - 64 * jc); \
                lsum += sum32(p0, p1); \
                pv_tile<2>(o, p0, p1, st + 64 * KP, r32, hi); \
            } \
            const int sn = (sc == 2) ? 0 : sc + 1; \
            if (h1) STOREN(sn); \
            __syncthreads(); \
            if (!h1) break; \
            jc = j1; j1 = j2; h1 = h2; sc = sn; }
        for (;;) { NS_SEL_STEP(NS_LOADA, NS_STOREB) NS_SEL_STEP(NS_LOADB, NS_STOREA) }
#undef NS_SEL_STEP
#undef NS_NEXTJ
        NS_FOLD(gate_s);
        asm volatile("" : "+v"(oc[0]), "+v"(oc[1]));
    }
    {
        const bf16_t* Kg = (const bf16_t*)(ws + Z_KWIN) + (size_t)bgi * SEQ * 64;
        const bf16_t* Vg = (const bf16_t*)(ws + Z_VWINT) + (size_t)bgi * 64 * SEQ;
        o[0] = (f32x16){}; o[1] = (f32x16){};
        float lsum = 0.f;
        const int t0 = (u >= 8) ? u - 8 : 0;
        int t = t0, sc = 0;
        NS_LOADA(Kg, Vg, t0); if (t0 + 1 <= u) NS_LOADB(Kg, Vg, t0 + 1);
        NS_STOREA(0);
        __syncthreads();
#define NS_WIN_STEP(LOADF, STOREN) { \
            if (t + 2 <= u) LOADF(Kg, Vg, t + 2); \
            { \
                const LAS unsigned char* st = lds + sc * NS_STAGE; \
                f32x16 p0 = (f32x16){}, p1 = (f32x16){}; \
                qk_tile(p0, p1, st, qf, r32, hi); \
                const int dl = qpos - 64 * t - 4 * hi; \
                score_exp_sel<1, true>(p0, p1, dl, tb, cfar, true, qw0 - (64 * t + 63), qw0 + 7 - 64 * t); \
                lsum += sum32(p0, p1); \
                pv_tile<2>(o, p0, p1, st + 64 * KP, r32, hi); \
            } \
            const int sn = (sc == 2) ? 0 : sc + 1; \
            if (t + 1 <= u) STOREN(sn); \
            __syncthreads(); \
            if (t + 1 > u) break; \
            ++t; sc = sn; }
        for (;;) { NS_WIN_STEP(NS_LOADA, NS_STOREB) NS_WIN_STEP(NS_LOADB, NS_STOREA) }
#undef NS_WIN_STEP
        NS_FOLD(gate_w);
    }
#undef NS_LOADA
#undef NS_LOADB
#undef NS_STOREA
#undef NS_STOREB
#undef NS_STORE
#undef NS_FOLD
#pragma unroll
    for (int r = 0; r < 16; ++r) {
        const int row = crow(r, hi), q = qw0 + (row >> 2), pp = row & 3;
        bf16_t* d = (bf16_t*)(ws + WS_XN) + (size_t)(b * SEQ + q) * DM + 512 + (g * 4 + pp) * 64 + r32;
        GST(bf16_t, d, (bf16_t)f2bf(oc[0][r])); GST(bf16_t, d + 32, (bf16_t)f2bf(oc[1][r]));
    }
    __syncthreads();
}

__device__ __forceinline__ void attention_phase(const Params& P, int l, LAS unsigned char* lds) {
    int tab_key = -1;
    for (int it = blockIdx.x; it < 2048; it += gridDim.x) {
        const int c = it & 255, sl = (it >> 8) & 3;
        if (it < 1024) { const int bh = c & 31, xg = c >> 5; const int qb = (sl == 0) ? 31 - xg : (sl == 1) ? 23 - xg : (sl == 2) ? 8 + xg : xg;
            da_unit(P, l, bh >> 2, bh & 3, qb, lds, tab_key != (bh & 3)); tab_key = bh & 3; }
        else { const int bg = c & 15, ug = c >> 4; const int u = (sl == 0) ? 63 - ug : (sl == 1) ? 47 - ug : (sl == 2) ? 16 + ug : ug;
            nsa_unit(P, l, bg >> 1, bg & 1, u, lds, tab_key != 4 + (bg & 1)); tab_key = 4 + (bg & 1); }
    }
}

constexpr size_t WS_BAR = 72 * 1024;
#define RLX_AGENT __ATOMIC_RELAXED, __HIP_MEMORY_SCOPE_AGENT
#define XB_TMO      128
#define XB_XCNT(j)  (256  + 64 * (j))
#define XB_XSUB(j)  (1280 + 64 * (j))
#define XB_XGEN(j)  (2304 + 64 * (j))
#define XB_TOP      3328
#define XB_TOPGEN   3392
#define XCD_BAR_WORDS 3456
#define XB_SPIN_CAP (1u << 18)

__device__ __forceinline__ unsigned xb_ld(unsigned* p)              { return __hip_atomic_load(p, __ATOMIC_RELAXED, __HIP_MEMORY_SCOPE_AGENT); }
__device__ __forceinline__ unsigned xb_add(unsigned* p, unsigned v) { return __hip_atomic_fetch_add(p, v, __ATOMIC_RELAXED, __HIP_MEMORY_SCOPE_AGENT); }
__device__ __forceinline__ unsigned xb_xcc_id() { return (unsigned)__builtin_amdgcn_s_getreg((3 << 11) | 20) & 0xFu; }
#define XB_SPIN(cond, bar) do { unsigned _sp = 0; while (cond) { __builtin_amdgcn_s_sleep(1); \
    if ((++_sp & 255u) == 0u) { if (xb_ld(&(bar)[XB_TMO])) break; if (_sp > XB_SPIN_CAP) { atomicAdd(&(bar)[XB_TMO], 1u); break; } } } } while (0)

struct XcdBarrier {
    unsigned* bar; unsigned x;
    volatile LAS unsigned* st;
};

__device__ __forceinline__ XcdBarrier xcd_barrier_post(unsigned* bar, volatile LAS unsigned* st) {
    XcdBarrier b; b.bar = bar; b.x = xb_xcc_id(); b.st = st;
    if (threadIdx.x == 0) (void)xb_add(&bar[XB_XCNT(b.x)], 1u);
    return b;
}
__device__ __forceinline__ void xcd_barrier_complete(unsigned* bar, unsigned x, unsigned& nloc, unsigned& nx) {
    const unsigned G = gridDim.x * gridDim.y * gridDim.z;
    unsigned sum, cnt, mine, sp = 0u;
    for (;;) {
        sum = 0u; cnt = 0u; mine = 0u;
#pragma unroll
        for (unsigned j = 0; j < 16; ++j) { const unsigned c = xb_ld(&bar[XB_XCNT(j)]); sum += c; cnt += (c > 0u) ? 1u : 0u; mine = (j == x) ? c : mine; }
        if (sum == G) break;
        __builtin_amdgcn_s_sleep(1);
        if ((++sp & 255u) == 0u) { if (xb_ld(&bar[XB_TMO])) break; if (sp > XB_SPIN_CAP) { atomicAdd(&bar[XB_TMO], 1u); break; } }
    }
    nloc = mine > 0u ? mine : 1u; nx = cnt > 0u ? cnt : 1u;
}

__device__ __forceinline__ void xcd_barrier(const XcdBarrier& b) {
    asm volatile("s_waitcnt vmcnt(0)" ::: "memory");
    __syncthreads();
    if (threadIdx.x == 0) {
        unsigned* bar = b.bar;
        __builtin_amdgcn_s_waitcnt(0);
        unsigned nloc = b.st[0], nx = b.st[1];
        if (nloc == 0u) { xcd_barrier_complete(bar, b.x, nloc, nx); b.st[0] = nloc; b.st[1] = nx; }
        const unsigned old = xb_add(&bar[XB_XSUB(b.x)], 1u);
        const unsigned gen = old / nloc;
        if (old + 1u == (gen + 1u) * nloc) {
            __builtin_amdgcn_fence(__ATOMIC_RELEASE, "agent");
            asm volatile("s_waitcnt vmcnt(0)" ::: "memory");
            const unsigned og = xb_add(&bar[XB_TOP], 1u);
            const unsigned tg = og / nx;
            if (og + 1u == (tg + 1u) * nx) xb_add(&bar[XB_TOPGEN], 1u);
            else XB_SPIN(xb_ld(&bar[XB_TOPGEN]) == tg, bar);
            __builtin_amdgcn_fence(__ATOMIC_ACQUIRE, "agent");
            xb_add(&bar[XB_XGEN(b.x)], 1u);
            asm volatile("s_waitcnt vmcnt(0)" ::: "memory");
        } else {
            XB_SPIN(xb_ld(&bar[XB_XGEN(b.x)]) == gen, bar);
            __builtin_amdgcn_fence(__ATOMIC_ACQUIRE, "agent");
            asm volatile("s_waitcnt vmcnt(0)" ::: "memory");
        }
    }
    __syncthreads();
}

__global__ void __launch_bounds__(NTHR, 2) hybrid_fwd(Params P) {
    extern __shared__ __attribute__((aligned(16))) unsigned char lds_raw[];
    LAS unsigned char* lds = (LAS unsigned char*)lds_raw;
    cg::grid_group grid = cg::this_grid();
#define GSYNC() do { XcdBarrier xb_; xb_.bar = (unsigned*)(WSP + WS_BAR); xb_.x = xb_xcc_id(); xb_.st = (volatile LAS unsigned*)(lds + L_PTAB + 384); xcd_barrier(xb_); } while (0)
    if (threadIdx.x == 0) {
        LAS unsigned long long* pt = (LAS unsigned long long*)(lds + L_PTAB);
#pragma unroll
        for (int i = 0; i < 30; ++i) pt[i] = (unsigned long long)P.in[i];
        pt[30] = (unsigned long long)P.out; pt[31] = (unsigned long long)P.ws;
        *(LAS unsigned*)(lds + L_PTAB + 384) = 0u; *(LAS unsigned*)(lds + L_PTAB + 388) = 0u;
    }
    __syncthreads();
    (void)xcd_barrier_post((unsigned*)(WSP + WS_BAR), (volatile LAS unsigned*)(lds + L_PTAB + 384));
    const int G = gridDim.x, bx = blockIdx.x;
#define ws WSP
#define XN ((bf16_t*)(WSP + WS_XN))
#define HID ((bf16_t*)(WSP + WS_HID))
#define MERGED ((bf16_t*)(WSP + WS_MERGED))
#define XB ((bf16_t*)OUTP)
#define XS ((bf16_t*)(WSP + WS_Z + 192 * MiB))
#define SSP ((float*)(WSP + WS_SS))

#if defined(PROBE_PHASE)
    int n_stamp = 0;
#define STAMP() do { if (blockIdx.x == 0 && threadIdx.x == 0) ((LAS unsigned long long*)(lds + L_PTAB + 512))[n_stamp] = __builtin_amdgcn_s_memrealtime(); ++n_stamp; } while (0)
#else
#define STAMP() do {} while (0)
#endif
    if (P.out == nullptr) grid.sync();
    STAMP();
    prologue(P, lds);
    xprep_phase(INP(0), (bf16_t*)OUTP, (float*)(WSP + WS_SS));
#if defined(DUP_PRO)
    prologue(P, lds);
#endif
    GSYNC(); STAMP();
#pragma unroll
    for (int l = 0; l < DEPTH; ++l) {
        const float* xin = (l == 0) ? INP(0) : OUTP;
        { pg8::Gemm g{XB, (const bf16_t*)(ws + WS_W13 + (size_t)(l * 2 + 0) * W13_SZ), MTOK, 5632, DM}; pg8::StaticOrder S; S.init(MTOK, 5632, G, bx);
          EpiSwiGLU E{{SSP}, HID}; pg8::gemm_phase<EpiSwiGLU, pg8::StaticOrder, true, true>(lds, g, S, E);
#if defined(DUP_G1)
          pg8::gemm_phase<EpiSwiGLU, pg8::StaticOrder, true, true>(lds, g, S, E);
#endif
        }
        GSYNC(); STAMP();
        { pg8::Gemm g{HID, (const bf16_t*)(ws + WS_W2 + (size_t)(l * 2 + 0) * W2_SZ), MTOK, DM, DFF}; pg8::StaticOrder S; S.init(MTOK, DM, G, bx);
          if (l == 0) { EpiResidT<true, false> E{xin, XB, 0.5f, SSP}; pg8::gemm_phase<EpiResidT<true, false>, pg8::StaticOrder, true, true>(lds, g, S, E); }
          else { EpiResidT<false, false> E{XB, XB, 0.5f, SSP}; pg8::gemm_phase<EpiResidT<false, false>, pg8::StaticOrder, true, true>(lds, g, S, E); } }
        GSYNC(); STAMP();
#if defined(STOP_AFTER) && STOP_AFTER == 1
        return;
#endif
        { pg8::Gemm g{XB, (const bf16_t*)(ws + WS_WIN + (size_t)l * WIN_SZ), MTOK, 5120, DM}; pg8::StaticOrder S; S.init(MTOK, 5120, G, bx);
          EpiZ E{{SSP}, ws, INP(14) + l * 64, INP(15) + l * 64, INP(21) + l * 64, INP(22) + l * 192}; pg8::gemm_phase<EpiZ, pg8::StaticOrder, true, true>(lds, g, S, E);
#if defined(DUP_G3)
          pg8::gemm_phase<EpiZ, pg8::StaticOrder, true, true>(lds, g, S, E);
#endif
        }
        GSYNC(); STAMP();
#if defined(DUMP_Z)
        { const unsigned short* z = (const unsigned short*)(WSP + WS_Z); float* o = OUTP;
          for (size_t i = (size_t)blockIdx.x * NTHR + threadIdx.x; i < (size_t)MTOK * DM; i += (size_t)gridDim.x * NTHR) {
              unsigned v = (unsigned)z[i * 4 + (i & 3)] << 16; if ((v & 0x7f800000u) == 0x7f800000u) v = 0u; o[i] = __builtin_bit_cast(float, v); }
          return; }
#endif
        compress_phase(P, l, lds);
#if defined(DUP_CMP)
        for (int rep_ = 0; rep_ < 4; ++rep_) compress_phase(P, l, lds);
#endif
        GSYNC(); STAMP();
        attention_phase(P, l, lds);
#if defined(DUP_ATT)
        attention_phase(P, l, lds);
#endif
        GSYNC(); STAMP();
        { pg8::Gemm g{XN, (const bf16_t*)(ws + WS_PAB + (size_t)l * PAB_SZ), MTOK, 2048, DM}; pg8::StaticOrder S; S.init(MTOK, 2048, G, bx);
          EpiMerge E{(const bf16_t*)(ws + Z_MG), MERGED}; pg8::gemm_phase<EpiMerge, pg8::StaticOrder, true, true>(lds, g, S, E); }
        GSYNC(); STAMP();
        { pg8::Gemm g{MERGED, (const bf16_t*)(ws + WS_WO + (size_t)l * WO_SZ), MTOK, DM, DM}; pg8::StaticOrder S; S.init(MTOK, DM, G, bx);
          EpiResidT<false, false> E{XB, (l + 1 < DEPTH) ? XB : XS, 1.0f, SSP}; pg8::gemm_phase<EpiResidT<false, false>, pg8::StaticOrder, true, true>(lds, g, S, E); }
        GSYNC(); STAMP();
#if defined(STOP_AFTER) && STOP_AFTER == 2
        return;
#endif
        { pg8::Gemm g{(l + 1 < DEPTH) ? XB : XS, (const bf16_t*)(ws + WS_W13 + (size_t)(l * 2 + 1) * W13_SZ), MTOK, 5632, DM}; pg8::StaticOrder S; S.init(MTOK, 5632, G, bx);
          EpiSwiGLU E{{SSP}, HID}; pg8::gemm_phase<EpiSwiGLU, pg8::StaticOrder, true, true>(lds, g, S, E); }
        GSYNC(); STAMP();
        { pg8::Gemm g{HID, (const bf16_t*)(ws + WS_W2 + (size_t)(l * 2 + 1) * W2_SZ), MTOK, DM, DFF}; pg8::StaticOrder S; S.init(MTOK, DM, G, bx);
          if (l + 1 < DEPTH) { EpiResidT<false, false> E{XB, XB, 0.5f, SSP}; pg8::gemm_phase<EpiResidT<false, false>, pg8::StaticOrder, true, true>(lds, g, S, E); }
          else { EpiResidT<false, true> E{XS, OUTP, 0.5f, nullptr}; pg8::gemm_phase<EpiResidT<false, true>, pg8::StaticOrder, true, true>(lds, g, S, E); } }
        if (l + 1 < DEPTH) { GSYNC(); STAMP(); }
    }
#if defined(PROBE_PHASE)
    GSYNC(); STAMP();
    if (blockIdx.x == 0 && threadIdx.x == 0) { const LAS unsigned long long* t = (const LAS unsigned long long*)(lds + L_PTAB + 512); const float ns = (float)(t[PROBE_PHASE + 1] - t[PROBE_PHASE]) * 10.0f; OUTP[0] = exp2f(rintf(log2f(ns) * 4.f) * 0.25f); }
#endif
#undef ws
#undef XN
#undef HID
#undef MERGED
#undef XB
#undef XS
#undef SSP
}

extern "C" void kernel_launch(void* const* d_in, const int* in_sizes, int n_in, void* d_out, int out_size, void* d_ws, size_t ws_size, hipStream_t stream) {
    static int grid = 0;
    if (grid == 0) {
        if (n_in != 30 || out_size != MTOK * DM || ws_size < WS_END) { fprintf(stderr, "kernel_launch: unexpected problem (n_in %d out %d ws %zu, need %zu)\n", n_in, out_size, ws_size, (size_t)WS_END); grid = -1; return; }
        int dev = 0, cus = 0, per_cu = 0;
        (void)hipGetDevice(&dev);
        (void)hipDeviceGetAttribute(&cus, hipDeviceAttributeMultiprocessorCount, dev);
        if (hipFuncSetAttribute((const void*)hybrid_fwd, hipFuncAttributeMaxDynamicSharedMemorySize, LDS_BYTES) != hipSuccess) { fprintf(stderr, "kernel_launch: hipFuncSetAttribute failed\n"); grid = -1; return; }
        if (hipOccupancyMaxActiveBlocksPerMultiprocessor(&per_cu, (const void*)hybrid_fwd, NTHR, LDS_BYTES) != hipSuccess || per_cu < 1) { fprintf(stderr, "kernel_launch: occupancy query gave %d\n", per_cu); per_cu = 1; }
        (void)hipGetLastError();
        grid = cus * (per_cu > 1 ? 1 : per_cu);
        if (grid <= 0) grid = 256;
    }
    if (grid < 0) return;
    Params p{};
    for (int i = 0; i < 30; ++i) p.in[i] = (const float*)d_in[i];
    p.out = (float*)d_out; p.ws = (unsigned char*)d_ws;
    (void)hipMemsetAsync((unsigned char*)d_ws + WS_BAR, 0, 16384, stream);
    void* args[] = {&p};
    hipError_t e = hipLaunchCooperativeKernel((const void*)hybrid_fwd, dim3(grid), dim3(NTHR), args, LDS_BYTES, stream);
    if (e != hipSuccess) fprintf(stderr, "cooperative launch failed: %s (grid %d)\n", hipGetErrorString(e), grid);
}
```

```cpp
#include <hip/hip_runtime.h>
#include <hip/hip_cooperative_groups.h>
#include <cstdio>
#include <cstdint>
namespace cg = cooperative_groups;
namespace pg8 {
#define PG8_LAS __attribute__((address_space(3)))
typedef unsigned short bf16_t;
typedef short bf16x8 __attribute__((ext_vector_type(8)));
typedef float f32x4 __attribute__((ext_vector_type(4)));
typedef unsigned u32x4 __attribute__((ext_vector_type(4)));
constexpr int BM = 256, BK = 64, HALF = 128, HTB = HALF * BK * 2  , STAGE_BYTES = 8 * HTB, NXCD = 8, WGM = 8;

__host__ __device__ __forceinline__ int lds_byte(int r, int c) { const int st = (r >> 4) * 2 + (c >> 5), rr = r & 15, cc = c & 31, ob = rr * 64 + cc * 2; return st * 1024 + (ob ^ (((ob >> 9) & 1) << 5)); }
__host__ __device__ __forceinline__ void stage_rc(int b, int& R, int& C) { const int st = b / 1024, sb = b % 1024, swz = sb ^ (((sb >> 9) & 1) << 5); R = (st >> 1) * 16 + swz / 64; C = (st & 1) * 32 + (swz % 64) / 2; }
__host__ __device__ __forceinline__ int perm32(int rho) { const int n = rho >> 4, i = rho & 15; return 8 * (i >> 2) + 4 * n + (i & 3); }

struct Unit { int pm, pn; };
struct Gemm { const bf16_t* A; const bf16_t* Bt; int M, N, K; };

struct StaticOrder {
    int nM, nN, nwg, G, c;
    __host__ __device__ void init(int M, int N, int G_, int c_) { nM = M / BM; nN = N / BM; nwg = nM * nN; G = G_; c = c_; }
    __host__ __device__ bool next(int i, Unit& u) const {
        const long L = (long)i * G + c; if (L >= nwg) return false;
        int wgid = (int)L; { const int q = nwg / NXCD, r = nwg % NXCD, xcd = wgid % NXCD, off = wgid / NXCD; wgid = (xcd < r ? xcd * (q + 1) : r * (q + 1) + (xcd - r) * q) + off; }
        const int nig = WGM * nN, gid = wgid / nig, fm = gid * WGM, gsz = (nM - fm) < WGM ? (nM - fm) : WGM;
        u.pm = fm + ((wgid % nig) % gsz); u.pn = (wgid % nig) / gsz; return true;
    }
    __device__ __forceinline__ void a_ready(const Unit&) const {}
    __device__ __forceinline__ void done(const Unit&) const {}
};

typedef float f32x2_t __attribute__((ext_vector_type(2))); typedef __bf16 bf16x2_t __attribute__((ext_vector_type(2)));
__device__ __forceinline__ unsigned cvt_pk_bf16(float lo, float hi) { f32x2_t v = {lo, hi}; bf16x2_t b = __builtin_convertvector(v, bf16x2_t); return __builtin_bit_cast(unsigned, b); }
template <class Epi, class Sched, bool ALIGN_EPI = false, bool SP2 = false>
__device__ __forceinline__ void gemm_phase(PG8_LAS unsigned char* lds, const Gemm g, const Sched& S, const Epi& E) {
    int tid_ = threadIdx.x; asm volatile("" : "+v"(tid_)); const int tid = tid_, wid = __builtin_amdgcn_readfirstlane(tid >> 6), lane = tid & 63, wr = wid >> 2, wc = wid & 3, fr = lane & 15, fq = lane >> 4;
    const int K = g.K, nt = K / BK;
    unsigned voffA[2], voffB[2];
#pragma unroll
    for (int i = 0; i < 2; ++i) { int R, C; stage_rc(tid * 16 + i * 8192, R, C); const int Rb = Epi::PERM ? ((R & ~31) + perm32(R & 31)) : R;
        voffA[i] = (unsigned)(R * K + C) * 2u; voffB[i] = (unsigned)(Rb * K + C) * 2u; }
    const size_t kstep = (size_t)(BK * 2);
    const size_t hstep = (size_t)HALF * K * 2;
    const size_t tstep = 2 * hstep;
    const unsigned ldsw = (unsigned)wid * 1024u;
    const int aoff = lds_byte(wr * 64 + fr, fq * 8), boff = lds_byte(wc * 32 + fr, fq * 8);
#define PG8_SA(b, h) (((b) * 2 + (h)) * HTB)
#define PG8_SB(b, h) ((4 + (b) * 2 + (h)) * HTB)
#define PG8_STAGE(bufoff, gbase, voff) do { _Pragma("unroll") for (int _i = 0; _i < 2; ++_i) \
        __builtin_amdgcn_global_load_lds((const unsigned*)((const char*)(gbase) + (voff)[_i]), (PG8_LAS unsigned*)(lds + (bufoff) + ldsw + _i * 8192), 16, 0, 0); } while (0)
#define PG8_LDA(dst, b, h) do { _Pragma("unroll") for (int m = 0; m < 4; ++m) _Pragma("unroll") for (int k = 0; k < 2; ++k) dst[m][k] = *(const PG8_LAS bf16x8*)(lds + PG8_SA(b, h) + aoff + m * 2048 + k * 1024); } while (0)
#define PG8_LDB(dst, b, h) do { _Pragma("unroll") for (int n = 0; n < 2; ++n) _Pragma("unroll") for (int k = 0; k < 2; ++k) dst[n][k] = *(const PG8_LAS bf16x8*)(lds + PG8_SB(b, h) + boff + n * 2048 + k * 1024); } while (0)
#define PG8_MMA(ai, bj, At, Bt) do { __builtin_amdgcn_s_setprio(1); _Pragma("unroll") for (int m = 0; m < 4; ++m) _Pragma("unroll") for (int n = 0; n < 2; ++n) _Pragma("unroll") for (int k = 0; k < 2; ++k) \
        acc[ai][bj][m][n] = __builtin_amdgcn_mfma_f32_16x16x32_bf16(Bt[n][k], At[m][k], acc[ai][bj][m][n], 0, 0, 0); __builtin_amdgcn_s_setprio(0); } while (0)
#define PG8_WAIT_V(n) asm volatile("s_waitcnt vmcnt(" #n ")" ::: "memory")
#define PG8_WAIT_L(n) asm volatile("s_waitcnt lgkmcnt(" #n ")" ::: "memory")
#define PG8_BAR __builtin_amdgcn_s_barrier()
#define PG8_SCHED __builtin_amdgcn_sched_barrier(0)
    Unit cur, nxt; int ui = 0;
    if (!S.next(0, cur)) return;
    f32x4 acc[2][2][4][2];
#pragma unroll
    for (int a = 0; a < 2; ++a)
#pragma unroll
        for (int b = 0; b < 2; ++b)
#pragma unroll
            for (int m = 0; m < 4; ++m)
#pragma unroll
                for (int n = 0; n < 2; ++n) acc[a][b][m][n] = (f32x4){0.f, 0.f, 0.f, 0.f};
    bf16x8 At[4][2], B0[2][2], B1[2][2];
    const char* cA = (const char*)g.A + (size_t)cur.pm * tstep; const char* cB = (const char*)g.Bt + (size_t)cur.pn * tstep;
    S.a_ready(cur);
    if constexpr (Epi::ROWSCALE) {
        int pmB = -1, pmC = -1, pmD = -1; Unit uu;
        for (int i = 1; S.next(i, uu); ++i) if (uu.pm != cur.pm && uu.pm != pmB && uu.pm != pmC && uu.pm != pmD) { if (pmB < 0) pmB = uu.pm; else if (pmC < 0) pmC = uu.pm; else if (pmD < 0) pmD = uu.pm; }
        f32x4 a0, b0, a1, b1, a2, b2, a3, b3; Unit t0 = cur, t1 = cur, t2 = cur, t3 = cur; t1.pm = pmB < 0 ? cur.pm : pmB; t2.pm = pmC < 0 ? cur.pm : pmC; t3.pm = pmD < 0 ? cur.pm : pmD;
        E.rs_issue(t0, tid, a0, b0); E.rs_issue(t1, tid, a1, b1); E.rs_issue(t2, tid, a2, b2); E.rs_issue(t3, tid, a3, b3);
        E.rs_write(tid, a3, b3, (PG8_LAS float*)(lds + STAGE_BYTES + ((t3.pm >> 3) & 3) * 1024));
        E.rs_write(tid, a2, b2, (PG8_LAS float*)(lds + STAGE_BYTES + ((t2.pm >> 3) & 3) * 1024));
        E.rs_write(tid, a1, b1, (PG8_LAS float*)(lds + STAGE_BYTES + ((t1.pm >> 3) & 3) * 1024));
        E.rs_write(tid, a0, b0, (PG8_LAS float*)(lds + STAGE_BYTES + ((t0.pm >> 3) & 3) * 1024));
    }
    if constexpr (SP2) {
        PG8_STAGE(PG8_SB(0, 0), cB, voffB); PG8_STAGE(PG8_SB(0, 1), cB + hstep, voffB); PG8_STAGE(PG8_SA(0, 0), cA, voffA); PG8_STAGE(PG8_SA(0, 1), cA + hstep, voffA);
        if (wr == 1) PG8_BAR;
        PG8_WAIT_V(2); PG8_BAR;
        PG8_STAGE(PG8_SB(1, 0), cB + kstep, voffB); PG8_STAGE(PG8_SA(1, 0), cA + kstep, voffA); PG8_STAGE(PG8_SB(1, 1), cB + hstep + kstep, voffB);
        PG8_WAIT_V(6); PG8_BAR;
    } else {
        PG8_STAGE(PG8_SB(0, 0), cB, voffB); PG8_STAGE(PG8_SA(0, 0), cA, voffA); PG8_STAGE(PG8_SB(0, 1), cB + hstep, voffB); PG8_STAGE(PG8_SA(0, 1), cA + hstep, voffA);
        if (wr == 1) PG8_BAR;
        PG8_WAIT_V(4); PG8_BAR;
        PG8_STAGE(PG8_SB(1, 0), cB + kstep, voffB); PG8_STAGE(PG8_SA(1, 0), cA + kstep, voffA); PG8_STAGE(PG8_SB(1, 1), cB + hstep + kstep, voffB);
        PG8_WAIT_V(6); PG8_BAR;
    }
    for (;;) {
        const bool has_next = S.next(ui + 1, nxt);
        const char* nA = has_next ? (const char*)g.A + (size_t)nxt.pm * tstep : cA; const char* nB = has_next ? (const char*)g.Bt + (size_t)nxt.pn * tstep : cB;
        for (int t = 0; t < nt; t += 2) {
            const bool last = (t == nt - 2);
            const char* a1 = cA + (size_t)(t + 1) * kstep;
            const char* a2 = last ? nA : cA + (size_t)(t + 2) * kstep; const char* b2 = last ? nB : cB + (size_t)(t + 2) * kstep;
            const char* a3 = a2 + kstep; const char* b3 = b2 + kstep;
            if (last && has_next) S.a_ready(nxt);
            if constexpr (SP2) {
            PG8_LDB(B0, 0, 0); PG8_LDB(B1, 0, 1); PG8_SCHED; PG8_LDA(At, 0, 0); PG8_STAGE(PG8_SA(1, 1), a1 + hstep, voffA);
            PG8_WAIT_V(8); PG8_WAIT_L(0); PG8_BAR; PG8_MMA(0, 0, At, B0); PG8_MMA(0, 1, At, B1); PG8_BAR; PG8_SCHED;
            PG8_LDA(At, 0, 1); PG8_STAGE(PG8_SB(0, 0), b2, voffB); PG8_STAGE(PG8_SB(0, 1), b2 + hstep, voffB); PG8_STAGE(PG8_SA(0, 0), a2, voffA);
            PG8_WAIT_V(8); PG8_WAIT_L(0); PG8_BAR; PG8_MMA(1, 0, At, B0); PG8_MMA(1, 1, At, B1); PG8_BAR; PG8_SCHED;
            PG8_LDB(B0, 1, 0); PG8_LDB(B1, 1, 1); PG8_SCHED; PG8_LDA(At, 1, 0); PG8_STAGE(PG8_SA(0, 1), a2 + hstep, voffA);
            PG8_WAIT_V(8); PG8_WAIT_L(0); PG8_BAR; PG8_MMA(0, 0, At, B0); PG8_MMA(0, 1, At, B1); PG8_BAR; PG8_SCHED;
            PG8_LDA(At, 1, 1); PG8_STAGE(PG8_SB(1, 0), b3, voffB); PG8_STAGE(PG8_SB(1, 1), b3 + hstep, voffB); PG8_STAGE(PG8_SA(1, 0), a3, voffA);
            PG8_WAIT_V(8); PG8_WAIT_L(0); PG8_BAR; PG8_MMA(1, 0, At, B0); PG8_MMA(1, 1, At, B1); PG8_BAR; PG8_SCHED;
            } else {
            PG8_LDB(B0, 0, 0); PG8_SCHED; PG8_LDA(At, 0, 0); PG8_STAGE(PG8_SA(1, 1), a1 + hstep, voffA);
            PG8_WAIT_L(8); PG8_BAR; PG8_WAIT_L(0); PG8_MMA(0, 0, At, B0); PG8_BAR; PG8_SCHED;
            PG8_LDB(B1, 0, 1); PG8_STAGE(PG8_SB(0, 0), b2, voffB);
            PG8_BAR; PG8_WAIT_L(0); PG8_MMA(0, 1, At, B1); PG8_BAR;
            PG8_LDA(At, 0, 1); PG8_STAGE(PG8_SA(0, 0), a2, voffA);
            PG8_BAR; PG8_WAIT_L(0); PG8_MMA(1, 0, At, B0); PG8_BAR; PG8_SCHED;
            PG8_STAGE(PG8_SB(0, 1), b2 + hstep, voffB);
            PG8_WAIT_V(6); PG8_BAR; PG8_MMA(1, 1, At, B1); PG8_BAR;
            PG8_LDB(B0, 1, 0); PG8_SCHED; PG8_LDA(At, 1, 0); PG8_STAGE(PG8_SA(0, 1), a2 + hstep, voffA);
            PG8_WAIT_L(8); PG8_BAR; PG8_WAIT_L(0); PG8_MMA(0, 0, At, B0); PG8_BAR; PG8_SCHED;
            PG8_LDB(B1, 1, 1); PG8_STAGE(PG8_SB(1, 0), b3, voffB);
            PG8_BAR; PG8_WAIT_L(0); PG8_MMA(0, 1, At, B1); PG8_BAR;
            PG8_LDA(At, 1, 1); PG8_STAGE(PG8_SA(1, 0), a3, voffA);
            PG8_BAR; PG8_WAIT_L(0); PG8_MMA(1, 0, At, B0); PG8_BAR; PG8_SCHED;
            PG8_STAGE(PG8_SB(1, 1), b3 + hstep, voffB);
            PG8_WAIT_V(6); PG8_BAR; PG8_MMA(1, 1, At, B1); PG8_BAR;
            }
        }
        if constexpr (ALIGN_EPI) { if (wr == 0) PG8_BAR; }
        if constexpr (!Epi::AFTER_DRAIN) {
            if constexpr (Epi::ROWSCALE) E(acc, cur, wr, wc, fr, fq, (const PG8_LAS float*)(lds + STAGE_BYTES + ((cur.pm >> 3) & 3) * 1024));
            else E(acc, cur, wr, wc, fr, fq);
            S.done(cur); }
        if (!has_next) break;
#pragma unroll
        for (int a = 0; a < 2; ++a)
#pragma unroll
            for (int b = 0; b < 2; ++b)
#pragma unroll
                for (int m = 0; m < 4; ++m)
#pragma unroll
                    for (int n = 0; n < 2; ++n) acc[a][b][m][n] = (f32x4){0.f, 0.f, 0.f, 0.f};
        cur = nxt; cA = nA; cB = nB; ++ui;
        if constexpr (ALIGN_EPI) { if (wr == 1) PG8_BAR; }
    }
    PG8_WAIT_V(0);
    if constexpr (!ALIGN_EPI) { if (wr == 0) PG8_BAR; }
    PG8_BAR;
    if constexpr (Epi::AFTER_DRAIN) { E.fused(acc, cur, wr, wc, fr, fq, lds, wid, lane); S.done(cur); }
#undef PG8_SA
#undef PG8_SB
#undef PG8_STAGE
#undef PG8_LDA
#undef PG8_LDB
#undef PG8_MMA
#undef PG8_WAIT_V
#undef PG8_WAIT_L
#undef PG8_BAR
#undef PG8_SCHED
}
}

#define LAS __attribute__((address_space(3)))
#define GAS __attribute__((address_space(1)))
#define GLD(T, p) (*(const GAS T*)(p))
#define GST(T, p, v) (*(GAS T*)(p) = (v))
typedef unsigned short bf16_t;
typedef short bf16x8 __attribute__((ext_vector_type(8)));
typedef short bf16x4 __attribute__((ext_vector_type(4)));
typedef float f32x4 __attribute__((ext_vector_type(4)));
typedef float f32x16 __attribute__((ext_vector_type(16)));
typedef unsigned u32x4 __attribute__((ext_vector_type(4)));
typedef unsigned u32x2 __attribute__((ext_vector_type(2)));

constexpr int BATCH = 8, SEQ = 4096, DM = 1024, MTOK = BATCH * SEQ, DFF = 2816, DEPTH = 2, NIN = 4888;
constexpr int NTHR = 512, NWAVE = 8;
constexpr float EPS = 1e-6f, LOG2E = 1.4426950408889634f;
constexpr float QSCALE = 0.125f * LOG2E;
constexpr size_t MiB = 1u << 20;
constexpr size_t WS_BIAS = 0;
constexpr size_t WS_PRM = 64 * 1024;
constexpr size_t WS_CB1 = 68 * 1024;
constexpr size_t WS_W13 = 1 * MiB;
constexpr size_t W13_SZ = (size_t)5632 * 1024 * 2;
constexpr size_t WS_W2 = 45 * MiB;
constexpr size_t W2_SZ = (size_t)1024 * 2816 * 2;
constexpr size_t WS_WIN = 68 * MiB;
constexpr size_t WIN_SZ = (size_t)5120 * 1024 * 2;
constexpr size_t WS_PAB = 88 * MiB;
constexpr size_t PAB_SZ = (size_t)2048 * 1024 * 2;
constexpr size_t WS_WO = 96 * MiB;
constexpr size_t WO_SZ = (size_t)1024 * 1024 * 2;
constexpr size_t WS_CW1 = 100 * MiB;
constexpr size_t CW1_SZ = (size_t)128 * 2048 * 2;
constexpr size_t WS_CW2 = 102 * MiB;
constexpr size_t CW2_SZ = (size_t)64 * 128 * 2;
constexpr size_t WS_KCN = 103 * MiB;
constexpr size_t WS_VCT = WS_KCN + 512 * 1024;
constexpr size_t WS_XN = 104 * MiB;
constexpr size_t WS_Z = 168 * MiB;
constexpr size_t Z_DQ = WS_Z, Z_DK = WS_Z + 32 * MiB, Z_DVT = WS_Z + 64 * MiB, Z_NQ = WS_Z + 96 * MiB;
constexpr size_t Z_KCR = WS_Z + 128 * MiB, Z_VCR = WS_Z + 136 * MiB, Z_KSEL = WS_Z + 144 * MiB, Z_VSELT = WS_Z + 152 * MiB;
constexpr size_t Z_KWIN = WS_Z + 160 * MiB, Z_VWINT = WS_Z + 168 * MiB, Z_NG = WS_Z + 176 * MiB, Z_MG = WS_Z + 180 * MiB;
constexpr size_t WS_MERGED = WS_Z;
constexpr size_t WS_HID = WS_Z;
constexpr size_t WS_SS = WS_Z + 308 * MiB;
constexpr size_t WS_END = WS_SS + 2 * MiB;
constexpr int LDS_BYTES = 147456;
constexpr int KP = 144, VP = 136;
constexpr int DA_STAGE = 2 * 64 * KP + 128 * VP;
constexpr int NS_STAGE = 64 * KP + 64 * VP;
constexpr int L_BIAS = 73728;
constexpr int TBN = 1216;
constexpr int L_IMP = L_BIAS + 4 * TBN * 4;
constexpr int L_SEL = L_IMP + 16384;
constexpr int L_WSF = L_SEL + 1024;
constexpr int L_END = L_WSF + 8 * 256;

struct Params {
    const float* in[30];
    float* out;
    unsigned char* ws;
};

constexpr int L_PTAB = LDS_BYTES - 1024;
__device__ __forceinline__ const float* ld_ptr(const LAS unsigned char* lds, int i) {
    unsigned a = L_PTAB + 8 * i; asm volatile("" : "+v"(a));
    const LAS unsigned* t = (const LAS unsigned*)(lds + a);
    const unsigned lo = __builtin_amdgcn_readfirstlane(t[0]), hi = __builtin_amdgcn_readfirstlane(t[1]);
    return (const float*)(((unsigned long long)hi << 32) | lo);
}
#define INP(i) ld_ptr(lds, (i))
#define OUTP ((float*)ld_ptr(lds, 30))
#define WSP ((unsigned char*)ld_ptr(lds, 31))

__device__ __forceinline__ unsigned f2bf(float f) { unsigned u = __builtin_bit_cast(unsigned, f); return (u + 0x7fffu + ((u >> 16) & 1u)) >> 16; }
__device__ __forceinline__ unsigned pk2(float lo, float hi) { return f2bf(lo) | (f2bf(hi) << 16); }
__device__ __forceinline__ float sigmoidf_(float x) { return __builtin_amdgcn_rcpf(1.0f + __builtin_amdgcn_exp2f(-x * LOG2E)); }
__device__ __forceinline__ int otid() { int t = threadIdx.x; asm volatile("" : "+v"(t)); return t; }
__device__ __forceinline__ int crow(int r, int hi) { return (r & 3) + 8 * (r >> 2) + 4 * hi; }


struct RowScale {
    const float* ss;
    __device__ __forceinline__ void rs_issue(const pg8::Unit& u, int tid, f32x4& pa, f32x4& pb) const {
        const float* p = ss + (size_t)(u.pm * 256 + (tid >> 1)) * 16 + (tid & 1) * 8; pa = GLD(f32x4, p); pb = GLD(f32x4, p + 4); }
    __device__ __forceinline__ void rs_write(int tid, const f32x4& pa, const f32x4& pb, LAS float* tab) const {
        float t = ((pa.x + pa.y) + (pa.z + pa.w)) + ((pb.x + pb.y) + (pb.z + pb.w)); t += __shfl_xor(t, 1);
        if (!(tid & 1)) tab[tid >> 1] = __builtin_amdgcn_rsqf(t * (1.f / DM) + EPS); }
};
struct EpiSwiGLU : RowScale {
    static constexpr bool PERM = true, AFTER_DRAIN = false, ROWSCALE = true;
    bf16_t* H;
    __device__ __forceinline__ void operator()(const f32x4 (&acc)[2][2][4][2], const pg8::Unit& u, int wr, int wc, int fr, int fq, const LAS float* rst) const {
        const int row0 = u.pm * 256 + wr * 64 + fr, col = u.pn * 128 + wc * 32 + 8 * fq;
#pragma unroll
        for (int ai = 0; ai < 2; ++ai)
#pragma unroll
            for (int m = 0; m < 4; ++m) {
                float h[8];
                const float rs = rst[ai * 128 + wr * 64 + m * 16 + fr];
#pragma unroll
                for (int n = 0; n < 2; ++n)
#pragma unroll
                    for (int e = 0; e < 4; ++e) { const float g = acc[ai][0][m][n][e] * rs, up = acc[ai][1][m][n][e] * rs; h[n * 4 + e] = g * sigmoidf_(g) * up; }
                u32x4 w; w.x = pg8::cvt_pk_bf16(h[0], h[1]); w.y = pg8::cvt_pk_bf16(h[2], h[3]); w.z = pg8::cvt_pk_bf16(h[4], h[5]); w.w = pg8::cvt_pk_bf16(h[6], h[7]);
                GST(u32x4, H + (size_t)(row0 + ai * 128 + m * 16) * DFF + col, w);
            }
    }
};
template <bool BF32, bool OF32> struct EpiResidT {
    static constexpr bool PERM = false, AFTER_DRAIN = false, ROWSCALE = false;
    const void* base; void* out; float alpha; float* ss;
    __device__ __forceinline__ void operator()(const f32x4 (&acc)[2][2][4][2], const pg8::Unit& u, int wr, int wc, int fr, int fq) const {
        const int row0 = u.pm * 256 + wr * 64 + fr, col0 = u.pn * 256 + wc * 32 + 4 * fq;
#pragma unroll
        for (int ai = 0; ai < 2; ++ai) {
            f32x4 bv[4][2][2];
#pragma unroll
            for (int m = 0; m < 4; ++m) {
                const size_t off = (size_t)(row0 + ai * 128 + m * 16) * DM + col0;
#pragma unroll
                for (int bj = 0; bj < 2; ++bj)
#pragma unroll
                    for (int n = 0; n < 2; ++n) {
                        if (BF32) bv[m][bj][n] = GLD(f32x4, (const float*)base + off + bj * 128 + n * 16);
                        else { const u32x2 w = GLD(u32x2, (const bf16_t*)base + off + bj * 128 + n * 16);
                               bv[m][bj][n] = (f32x4){__builtin_bit_cast(float, w.x << 16), __builtin_bit_cast(float, w.x & 0xffff0000u), __builtin_bit_cast(float, w.y << 16), __builtin_bit_cast(float, w.y & 0xffff0000u)}; }
                    }
            }
#pragma unroll
            for (int m = 0; m < 4; ++m) {
                const int row = row0 + ai * 128 + m * 16;
                const size_t off = (size_t)row * DM + col0;
                float sq = 0.f;
#pragma unroll
                for (int bj = 0; bj < 2; ++bj)
#pragma unroll
                    for (int n = 0; n < 2; ++n) {
                        const f32x4 o = bv[m][bj][n] + acc[ai][bj][m][n] * alpha;
                        sq += (o.x * o.x + o.y * o.y) + (o.z * o.z + o.w * o.w);
                        if (OF32) GST(f32x4, (float*)out + off + bj * 128 + n * 16, o);
                        else { u32x2 w; w.x = pg8::cvt_pk_bf16(o.x, o.y); w.y = pg8::cvt_pk_bf16(o.z, o.w); GST(u32x2, (bf16_t*)out + off + bj * 128 + n * 16, w); }
                    }
                if (!OF32) { sq += __shfl_xor(sq, 16); sq += __shfl_xor(sq, 32); if (fq == 0) GST(float, ss + (size_t)row * 16 + u.pn * 4 + wc, sq); }
            }
        }
    }
};
struct EpiMerge {
    static constexpr bool PERM = true, AFTER_DRAIN = false, ROWSCALE = false;
    const unsigned char* MG; bf16_t* O;
    __device__ __forceinline__ void operator()(const f32x4 (&acc)[2][2][4][2], const pg8::Unit& u, int wr, int wc, int fr, int fq) const {
        const int row0 = u.pm * 256 + wr * 64 + fr, col = u.pn * 128 + wc * 32 + 8 * fq;
#pragma unroll
        for (int ai = 0; ai < 2; ++ai) {
            u32x2 g0[4], g1[4];
#pragma unroll
            for (int m = 0; m < 4; ++m) { const int row = row0 + ai * 128 + m * 16; g0[m] = GLD(u32x2, MG + (size_t)row * 2048 + col); g1[m] = GLD(u32x2, MG + (size_t)row * 2048 + 1024 + col); }
#pragma unroll
            for (int m = 0; m < 4; ++m) {
                const int row = row0 + ai * 128 + m * 16;
                float h[8];
#pragma unroll
                for (int i = 0; i < 8; ++i) {
                    const unsigned w0 = g0[m][i >> 2], w1 = g1[m][i >> 2];
                    const float a0 = (float)((w0 >> (8 * (i & 3))) & 0xffu) * (1.f / 255.f), a1 = (float)((w1 >> (8 * (i & 3))) & 0xffu) * (1.f / 255.f);
                    h[i] = a0 * acc[ai][0][m][i >> 2][i & 3] + a1 * acc[ai][1][m][i >> 2][i & 3];
                }
                u32x4 w; w.x = pg8::cvt_pk_bf16(h[0], h[1]); w.y = pg8::cvt_pk_bf16(h[2], h[3]); w.z = pg8::cvt_pk_bf16(h[4], h[5]); w.w = pg8::cvt_pk_bf16(h[6], h[7]);
                GST(u32x4, O + (size_t)row * DM + col, w);
            }
        }
    }
};
struct EpiZ : RowScale {
    static constexpr bool PERM = true, AFTER_DRAIN = false, ROWSCALE = true;
    unsigned char* ws; const float *gq, *gk, *gnq, *gnk;
    __device__ __forceinline__ void operator()(const f32x4 (&acc)[2][2][4][2], const pg8::Unit& u, int wr, int wc, int fr, int fq, const LAS float* rst) const {
        const int ch = 4 * u.pn + wc;
        if (ch >= 77) return;
        const int row0 = u.pm * 256 + wr * 64 + fr;
        int kind, nh = 8, hd = 0, nd = 64, dbase = 0; size_t dst = 0; const float* gain = nullptr; float scale = 1.f;
        if (ch < 8) { kind = 0; dst = Z_DQ; hd = ch; gain = gq; scale = QSCALE; }
        else if (ch < 16) { kind = 0; dst = Z_DK; hd = ch - 8; gain = gk; }
        else if (ch < 24) { kind = 2; dst = Z_DVT; nh = 4; hd = (ch - 16) >> 1; nd = 128; dbase = ((ch - 16) & 1) * 64; }
        else if (ch < 32) { kind = 0; dst = Z_NQ; hd = ch - 24; gain = gnq; scale = QSCALE; }
        else if (ch < 34) { kind = 1; dst = Z_KCR; nh = 2; hd = ch - 32; }
        else if (ch < 36) { kind = 1; dst = Z_VCR; nh = 2; hd = ch - 34; }
        else if (ch < 38) { kind = 0; dst = Z_KSEL; nh = 2; hd = ch - 36; gain = gnk + 64; }
        else if (ch < 40) { kind = 2; dst = Z_VSELT; nh = 2; hd = ch - 38; }
        else if (ch < 42) { kind = 0; dst = Z_KWIN; nh = 2; hd = ch - 40; gain = gnk + 128; }
        else if (ch < 44) { kind = 2; dst = Z_VWINT; nh = 2; hd = ch - 42; }
        else if (ch < 76) { kind = 3; }
        else { kind = 4; }
        if (kind == 0 || kind == 1) {
            float gv[16];
#pragma unroll
            for (int i = 0; i < 16; ++i) gv[i] = (kind == 0) ? gain[(i >> 3) * 32 + 8 * fq + (i & 7)] * scale : 1.f;
#pragma unroll
            for (int ai = 0; ai < 2; ++ai)
#pragma unroll
                for (int m = 0; m < 4; ++m) {
                    const int row = row0 + ai * 128 + m * 16, b = row >> 12, s = row & 4095;
                    float v[16];
                    const float rrs = rst[ai * 128 + wr * 64 + m * 16 + fr];
#pragma unroll
                    for (int i = 0; i < 16; ++i) v[i] = acc[ai][i >> 3][m][(i >> 2) & 1][i & 3] * rrs;
                    float rs = 1.f;
                    if (kind == 0) {
                        float ss = 0.f;
#pragma unroll
                        for (int i = 0; i < 16; ++i) ss += v[i] * v[i];
                        ss += __shfl_xor(ss, 16); ss += __shfl_xor(ss, 32);
                        rs = __builtin_amdgcn_rsqf(ss * (1.f / 64.f) + EPS);
                    }
#pragma unroll
                    for (int i = 0; i < 16; ++i) v[i] *= rs * gv[i];
                    bf16_t* d = (bf16_t*)(ws + dst) + ((size_t)(b * nh + hd) * SEQ + s) * 64 + 8 * fq;
                    u32x4 w0, w1;
                    w0.x = pg8::cvt_pk_bf16(v[0], v[1]); w0.y = pg8::cvt_pk_bf16(v[2], v[3]); w0.z = pg8::cvt_pk_bf16(v[4], v[5]); w0.w = pg8::cvt_pk_bf16(v[6], v[7]);
                    w1.x = pg8::cvt_pk_bf16(v[8], v[9]); w1.y = pg8::cvt_pk_bf16(v[10], v[11]); w1.z = pg8::cvt_pk_bf16(v[12], v[13]); w1.w = pg8::cvt_pk_bf16(v[14], v[15]);
                    GST(u32x4, d, w0); GST(u32x4, d + 32, w1);
                }
        } else if (kind == 2) {
#pragma unroll
            for (int ai = 0; ai < 2; ++ai)
#pragma unroll
                for (int m = 0; m < 4; ++m) {
                    const int row = row0 + ai * 128 + m * 16, b = row >> 12, s = row & 4095;
                    bf16_t* d = (bf16_t*)(ws + dst) + ((size_t)(b * nh + hd) * nd + dbase + 8 * fq) * SEQ + s;
                    const float rrs = rst[ai * 128 + wr * 64 + m * 16 + fr];
#pragma unroll
                    for (int i = 0; i < 16; ++i) GST(bf16_t, d + (size_t)((i >> 3) * 32 + (i & 7)) * SEQ, (bf16_t)f2bf(acc[ai][i >> 3][m][(i >> 2) & 1][i & 3] * rrs));
                }
        } else if (kind == 3) {
            const int col = (ch - 44) * 64 + 8 * fq;
#pragma unroll
            for (int ai = 0; ai < 2; ++ai)
#pragma unroll
                for (int m = 0; m < 4; ++m) {
                    const int row = row0 + ai * 128 + m * 16;
                    float v[16];
                    const float rrs = rst[ai * 128 + wr * 64 + m * 16 + fr];
#pragma unroll
                    for (int i = 0; i < 16; ++i) v[i] = sigmoidf_(acc[ai][i >> 3][m][(i >> 2) & 1][i & 3] * rrs);
                    unsigned char* d = (unsigned char*)(ws + Z_MG) + (size_t)row * 2048 + col;
                    unsigned q[16];
#pragma unroll
                    for (int i = 0; i < 16; ++i) q[i] = (unsigned)__builtin_rintf(v[i] * 255.f);
                    u32x2 w0, w1;
                    w0.x = q[0] | (q[1] << 8) | (q[2] << 16) | (q[3] << 24); w0.y = q[4] | (q[5] << 8) | (q[6] << 16) | (q[7] << 24);
                    w1.x = q[8] | (q[9] << 8) | (q[10] << 16) | (q[11] << 24); w1.y = q[12] | (q[13] << 8) | (q[14] << 16) | (q[15] << 24);
                    GST(u32x2, d, w0); GST(u32x2, d + 32, w1);
                }
        } else {
            if (fq < 3) {
#pragma unroll
                for (int ai = 0; ai < 2; ++ai)
#pragma unroll
                    for (int m = 0; m < 4; ++m) {
                        const int row = row0 + ai * 128 + m * 16;
                        float* d = (float*)(ws + Z_NG) + (size_t)row * 24 + 8 * fq;
                        const float rrs = rst[ai * 128 + wr * 64 + m * 16 + fr];
#pragma unroll
                        for (int i = 0; i < 8; ++i) GST(float, d + i, sigmoidf_(acc[ai][0][m][i >> 2][i & 3] * rrs));
                    }
            }
        }
    }
};

__device__ __forceinline__ void tr_item(const float* src, int ld, int c0, int nvalid, int k0, bf16_t* dst, int Kdst, LAS float* scr, int lane, const float* rsc = nullptr) {
    const int n = lane & 31;
#pragma unroll
    for (int i = 0; i < 32; ++i) { const int kk = 2 * i + (lane >> 5); scr[kk * 33 + n] = (src && n < nvalid) ? GLD(float, src + (size_t)(k0 + kk) * ld + c0 + n) * (rsc ? GLD(float, rsc + k0 + kk) : 1.f) : 0.f; }
    asm volatile("s_waitcnt lgkmcnt(0)" ::: "memory");
    const int c = lane & 7;
#pragma unroll
    for (int j = 0; j < 4; ++j) { const int nn = (lane >> 3) + 8 * j; const LAS float* s = scr + (8 * c) * 33 + nn;
        u32x4 o; o.x = pk2(s[0 * 33], s[1 * 33]); o.y = pk2(s[2 * 33], s[3 * 33]); o.z = pk2(s[4 * 33], s[5 * 33]); o.w = pk2(s[6 * 33], s[7 * 33]);
        GST(u32x4, dst + (size_t)nn * Kdst + 8 * c, o); }
    asm volatile("s_waitcnt lgkmcnt(0)" ::: "memory");
}
__device__ __forceinline__ int zchunk_src(int ch) {
    if (ch < 32) return ch * 64;
    if (ch < 44) return 2048 + (ch - 32) * 64;
    if (ch < 76) return 2840 + (ch - 44) * 64;
    return 2816;
}
__device__ __forceinline__ int t5_bucket(int n) {
    if (n < 16) return n;
    int b = 16;
    b += (n >= 21); b += (n >= 27); b += (n >= 35); b += (n >= 46); b += (n >= 59); b += (n >= 77); b += (n >= 99); b += (n >= 128);
    b += (n >= 166); b += (n >= 216); b += (n >= 280); b += (n >= 363); b += (n >= 470); b += (n >= 609); b += (n >= 790);
    return b;
}
__device__ __forceinline__ void prologue(const Params& P, LAS unsigned char* lds) {
    const int tid = otid(), lane = tid & 63, wave = tid >> 6;
    LAS float* scr = (LAS float*)(lds + wave * 16384);
    const int gw = blockIdx.x * NWAVE + wave, NGW = gridDim.x * NWAVE;
    unsigned char* ws = WSP;
    constexpr int I13 = 176 * 16, I2 = 32 * 44, IIN = 160 * 16, IPAB = 64 * 16, IWO = 32 * 16, IC1 = 4 * 32, IC2 = 2 * 2;
    constexpr int PER_L = 2 * I13 + 2 * I2 + IIN + IPAB + IWO + 2 * IC1 + 2 * IC2;
    for (int it = gw; it < DEPTH * PER_L; it += NGW) {
        const int l = it / PER_L; int r = it % PER_L;
        if (r < 2 * I13) {
            const int f = r / I13; r %= I13; const int gi = r / 16, kb = r % 16;
            const int t = gi >> 3, bj = (gi >> 2) & 1, sub = gi & 3;
            const float* src = (f ? (bj ? INP(12) : INP(11)) : (bj ? INP(9) : INP(8))) + (size_t)l * DM * DFF;
            tr_item(src, DFF, 128 * t + 32 * sub, 32, 64 * kb, (bf16_t*)(ws + WS_W13 + (size_t)(l * 2 + f) * W13_SZ) + (size_t)(32 * gi) * DM + 64 * kb, DM, scr, lane, (f ? INP(7) : INP(5)) + l * DM);
            continue;
        }
        r -= 2 * I13;
        if (r < 2 * I2) {
            const int f = r / I2; r %= I2; const int gi = r / 44, kb = r % 44;
            const float* src = (f ? INP(13) : INP(10)) + (size_t)l * DFF * DM;
            tr_item(src, DM, 32 * gi, 32, 64 * kb, (bf16_t*)(ws + WS_W2 + (size_t)(l * 2 + f) * W2_SZ) + (size_t)(32 * gi) * DFF + 64 * kb, DFF, scr, lane);
            continue;
        }
        r -= 2 * I2;
        if (r < IIN) {
            const int gi = r / 16, kb = r % 16;
            const int t = gi >> 3, bj = (gi >> 2) & 1, wc = gi & 3, ch = 4 * t + wc;
            int nvalid = 32; if (ch == 76) nvalid = bj ? 0 : 24; if (ch > 76) nvalid = 0;
            const float* src = nvalid ? INP(1) + (size_t)l * DM * NIN : nullptr;
            tr_item(src, NIN, zchunk_src(ch) + 32 * bj, nvalid, 64 * kb, (bf16_t*)(ws + WS_WIN + (size_t)l * WIN_SZ) + (size_t)(32 * gi) * DM + 64 * kb, DM, scr, lane, INP(6) + l * DM);
            continue;
        }
        r -= IIN;
        if (r < IPAB) {
            const int gi = r / 16, kb = r % 16;
            const int t = gi >> 3, bj = (gi >> 2) & 1, sub = gi & 3;
            const float* src = nullptr; int k0 = 0;
            if (bj == 0 && kb < 8) { src = INP(2) + (size_t)l * 512 * DM; k0 = 64 * kb; }
            if (bj == 1 && kb >= 8) { src = INP(3) + (size_t)l * 512 * DM; k0 = 64 * (kb - 8); }
            tr_item(src, DM, 128 * t + 32 * sub, 32, k0, (bf16_t*)(ws + WS_PAB + (size_t)l * PAB_SZ) + (size_t)(32 * gi) * DM + 64 * kb, DM, scr, lane);
            continue;
        }
        r -= IPAB;
        if (r < IWO) {
            const int gi = r / 16, kb = r % 16;
            tr_item(INP(4) + (size_t)l * DM * DM, DM, 32 * gi, 32, 64 * kb, (bf16_t*)(ws + WS_WO + (size_t)l * WO_SZ) + (size_t)(32 * gi) * DM + 64 * kb, DM, scr, lane);
            continue;
        }
        r -= IWO;
        if (r < 2 * IC1) {
            const int kv = r / IC1; r %= IC1; const int gi = r / 32, kb = r % 32;
            tr_item((kv ? INP(27) : INP(24)) + (size_t)l * 2048 * 128, 128, 32 * gi, 32, 64 * kb, (bf16_t*)(ws + WS_CW1 + (size_t)(l * 2 + kv) * CW1_SZ) + (size_t)(32 * gi) * 2048 + 64 * kb, 2048, scr, lane);
            continue;
        }
        r -= 2 * IC1;
        {
            const int kv = r / IC2; r %= IC2; const int gi = r / 2, kb = r % 2;
            tr_item((kv ? INP(28) : INP(25)) + (size_t)l * 128 * 64, 64, 32 * gi, 32, 64 * kb, (bf16_t*)(ws + WS_CW2 + (size_t)(l * 2 + kv) * CW2_SZ) + (size_t)(32 * gi) * 128 + 64 * kb, 128, scr, lane);
        }
    }
    const int gt = blockIdx.x * NTHR + tid, NGT = gridDim.x * NTHR;
    for (int i = gt; i < 12 * 1024; i += NGT) { const int h = i >> 10, d = i & 1023; ((float*)(ws + WS_BIAS))[i] = INP(29)[t5_bucket(d) * 12 + h] * LOG2E; }
    if (blockIdx.x == (gridDim.x > 1 ? 1 : 0) && wave < DEPTH) {
        const int l = wave;
        float a = INP(16)[l * 64 + lane] * INP(17)[l * 64 + lane], b = INP(18)[l * 64 + lane] * INP(19)[l * 64 + lane];
        float mq = fabsf(INP(14)[l * 64 + lane]), mk = fabsf(INP(15)[l * 64 + lane]), mnq = fabsf(INP(21)[l * 64 + lane]);
        float mnk = fmaxf(fmaxf(fabsf(INP(22)[l * 192 + lane]), fabsf(INP(22)[l * 192 + 64 + lane])), fabsf(INP(22)[l * 192 + 128 + lane]));
        float mb = 0.f; for (int i = lane; i < 32 * 12; i += 64) mb = fmaxf(mb, fabsf(INP(29)[i]));
#pragma unroll
        for (int o = 1; o < 64; o <<= 1) { a += __shfl_xor(a, o); b += __shfl_xor(b, o); mq = fmaxf(mq, __shfl_xor(mq, o)); mk = fmaxf(mk, __shfl_xor(mk, o)); mnq = fmaxf(mnq, __shfl_xor(mnq, o)); mnk = fmaxf(mnk, __shfl_xor(mnk, o)); mb = fmaxf(mb, __shfl_xor(mb, o)); }
        if (lane == 0) {
            float* prm = (float*)(ws + WS_PRM) + l * 8;
            const float lam_init = 0.8f - 0.6f * expf(-0.3f * (float)l);
            prm[0] = expf(a) - expf(b) + lam_init;
            prm[1] = (8.f * mq * mk * 1.02f + mb) * LOG2E;
            prm[2] = (8.f * mnq * mnk * 1.02f + mb) * LOG2E;
            prm[3] = 1.0f - lam_init;
        }
    }
    for (int wi = blockIdx.x; wi < 32; wi += gridDim.x) {
        const int lk = wi >> 3, n = (wi & 7) * 16 + (tid & 15), ks = tid >> 4, l = lk >> 1, kv = lk & 1;
        const float* pe = (kv ? INP(26) : INP(23)) + (size_t)l * 2048; const float* w1 = (kv ? INP(27) : INP(24)) + (size_t)l * 2048 * 128;
        float sacc = 0.f;
#pragma unroll 16
        for (int k = 64 * ks; k < 64 * ks + 64; ++k) sacc += GLD(float, pe + k) * GLD(float, w1 + (size_t)k * 128 + n);
        LAS float* red = (LAS float*)lds;
        __syncthreads();
        red[tid] = sacc;
        __syncthreads();
        if (tid < 16) { float t = 0.f; for (int i = 0; i < 32; ++i) t += red[i * 16 + tid]; ((float*)(ws + WS_CB1))[lk * 128 + (wi & 7) * 16 + tid] = t; }
        __syncthreads();
    }
}

template <bool INBF16, bool COPYRAW>
__device__ __forceinline__ void rmsnorm_phase(const void* x, const float* g, bf16_t* o, bf16_t* xraw = nullptr) {
    const int tid = otid(), lane = tid & 63, wave = tid >> 6;
    const int gw = blockIdx.x * NWAVE + wave, NGW = gridDim.x * NWAVE;
    f32x4 gv[4];
#pragma unroll
    for (int j = 0; j < 4; ++j) gv[j] = GLD(f32x4, (const f32x4*)g + lane + 64 * j);
    constexpr int RB = 4;
    for (int m0 = gw; m0 < MTOK; m0 += NGW * RB) {
        f32x4 v[RB][4]; float s[RB];
#pragma unroll
        for (int r = 0; r < RB; ++r) { const int m = m0 + r * NGW; const size_t ro = (size_t)(m < MTOK ? m : m0) * DM;
#pragma unroll
            for (int j = 0; j < 4; ++j) {
                if (!INBF16) v[r][j] = GLD(f32x4, (const f32x4*)((const float*)x + ro) + lane + 64 * j);
                else { const u32x2 w = GLD(u32x2, (const u32x2*)((const bf16_t*)x + ro) + lane + 64 * j);
                       if (COPYRAW && m < MTOK) GST(u32x2, (u32x2*)(xraw + ro) + lane + 64 * j, w);
                       v[r][j] = (f32x4){__builtin_bit_cast(float, w.x << 16), __builtin_bit_cast(float, w.x & 0xffff0000u), __builtin_bit_cast(float, w.y << 16), __builtin_bit_cast(float, w.y & 0xffff0000u)}; }
            } }
#pragma unroll
        for (int r = 0; r < RB; ++r) { s[r] = 0.f;
#pragma unroll
            for (int j = 0; j < 4; ++j) s[r] += (v[r][j].x * v[r][j].x + v[r][j].y * v[r][j].y) + (v[r][j].z * v[r][j].z + v[r][j].w * v[r][j].w); }
#pragma unroll
        for (int of = 1; of < 64; of <<= 1) {
#pragma unroll
            for (int r = 0; r < RB; ++r) s[r] += __shfl_xor(s[r], of); }
#pragma unroll
        for (int r = 0; r < RB; ++r) { const int m = m0 + r * NGW;
            if (m < MTOK) {
                const float rs = __builtin_amdgcn_rsqf(s[r] * (1.f / DM) + EPS);
                u32x2* o8 = (u32x2*)(o + (size_t)m * DM) + lane;
#pragma unroll
                for (int j = 0; j < 4; ++j) { u32x2 w; w.x = pk2(v[r][j].x * rs * gv[j].x, v[r][j].y * rs * gv[j].y); w.y = pk2(v[r][j].z * rs * gv[j].z, v[r][j].w * rs * gv[j].w); GST(u32x2, o8 + 64 * j, w); }
            }
        }
    }
}

__device__ __forceinline__ void xprep_phase(const float* x, bf16_t* o, float* ss) {
    const int tid = otid(), lane = tid & 63, wave = tid >> 6;
    const int gw = blockIdx.x * NWAVE + wave, NGW = gridDim.x * NWAVE;
    for (int m = gw; m < MTOK; m += NGW) {
        const f32x4* xr = (const f32x4*)(x + (size_t)m * DM) + lane;
        f32x4 v[4]; float s = 0.f;
#pragma unroll
        for (int j = 0; j < 4; ++j) { v[j] = GLD(f32x4, xr + 64 * j); s += (v[j].x * v[j].x + v[j].y * v[j].y) + (v[j].z * v[j].z + v[j].w * v[j].w); }
#pragma unroll
        for (int of = 1; of < 64; of <<= 1) s += __shfl_xor(s, of);
        u32x2* o8 = (u32x2*)(o + (size_t)m * DM) + lane;
#pragma unroll
        for (int j = 0; j < 4; ++j) { u32x2 w; w.x = pk2(v[j].x, v[j].y); w.y = pk2(v[j].z, v[j].w); GST(u32x2, o8 + 64 * j, w); }
        if (lane < 16) GST(float, ss + (size_t)m * 16 + lane, lane == 0 ? s : 0.f);
    }
}

__device__ __forceinline__ float gelu_tanh(float x) {
    const float y = 0.7978845608028654f * (x + 0.044715f * x * x * x);
    const float e = __builtin_amdgcn_exp2f(2.f * LOG2E * y);
    const float t = 1.f - 2.f * __builtin_amdgcn_rcpf(e + 1.f);
    return 0.5f * x * (1.f + t);
}
__device__ __forceinline__ void compress_phase(const Params& P, int l, LAS unsigned char* lds) {
    const int tid = otid(), lane = tid & 63, wave = tid >> 6, fr = lane & 15, kq = lane >> 4;
    unsigned char* ws = WSP;
    LAS bf16_t* Hs = (LAS bf16_t*)lds;
    LAS float* Os = (LAS float*)(lds + 8704);
    LAS unsigned char* As = lds + 17408;
    for (int unit = blockIdx.x; unit < 2 * 16 * 8; unit += gridDim.x) {
        const int kv = unit >> 7, bg = (unit >> 3) & 15, c0 = 32 * (unit & 7);
        const bf16_t* src = (const bf16_t*)(ws + (kv ? Z_VCR : Z_KCR)) + (size_t)bg * SEQ * 64;
        for (int i = tid; i < 33 * 128; i += NTHR) {
            const int j = i >> 7, pc = i & 127;
            u32x4 v = {0u, 0u, 0u, 0u};
            if (c0 + j <= 255) v = GLD(u32x4, (const unsigned char*)(src + (size_t)1024 * (c0 + j)) + pc * 16);
            *(LAS u32x4*)(As + j * 2064 + pc * 16) = v;
        }
        __syncthreads();
        const bf16_t* bp = (const bf16_t*)(ws + WS_CW1 + (size_t)(l * 2 + kv) * CW1_SZ) + (size_t)(16 * wave + fr) * 2048 + 8 * kq;
        f32x4 acc0 = {0.f, 0.f, 0.f, 0.f}, acc1 = {0.f, 0.f, 0.f, 0.f};
#pragma unroll
        for (int kb = 0; kb < 4; ++kb) {
            bf16x8 bfr[16];
#pragma unroll
            for (int i = 0; i < 16; ++i) bfr[i] = GLD(bf16x8, bp + 32 * (16 * kb + i));
#pragma unroll
            for (int i = 0; i < 16; ++i) {
                const int k = 32 * (16 * kb + i) + 8 * kq;
                const LAS unsigned char* ar = As + (fr + (k >> 10)) * 2064 + (k & 1023) * 2;
                const bf16x8 a0 = *(const LAS bf16x8*)ar, a1 = *(const LAS bf16x8*)(ar + 16 * 2064);
                acc0 = __builtin_amdgcn_mfma_f32_16x16x32_bf16(a0, bfr[i], acc0, 0, 0, 0);
                acc1 = __builtin_amdgcn_mfma_f32_16x16x32_bf16(a1, bfr[i], acc1, 0, 0, 0);
            }
        }
        const float cb = ((const float*)(ws + WS_CB1))[(l * 2 + kv) * 128 + 16 * wave + fr];
#pragma unroll
        for (int i = 0; i < 4; ++i) { Hs[(4 * kq + i) * 136 + 16 * wave + fr] = (bf16_t)f2bf(gelu_tanh(acc0[i] + cb)); Hs[(16 + 4 * kq + i) * 136 + 16 * wave + fr] = (bf16_t)f2bf(gelu_tanh(acc1[i] + cb)); }
        __syncthreads();
        {
            const int mt = wave >> 2, ns = wave & 3;
            const bf16_t* b2 = (const bf16_t*)(ws + WS_CW2 + (size_t)(l * 2 + kv) * CW2_SZ) + (size_t)(16 * ns + fr) * 128 + 8 * kq;
            f32x4 a2 = {0.f, 0.f, 0.f, 0.f};
#pragma unroll
            for (int kk = 0; kk < 4; ++kk) { const bf16x8 a = *(const LAS bf16x8*)(Hs + (16 * mt + fr) * 136 + 32 * kk + 8 * kq), b = GLD(bf16x8, b2 + 32 * kk); a2 = __builtin_amdgcn_mfma_f32_16x16x32_bf16(a, b, a2, 0, 0, 0); }
#pragma unroll
            for (int i = 0; i < 4; ++i) Os[(16 * mt + 4 * kq + i) * 65 + 16 * ns + fr] = a2[i];
        }
        __syncthreads();
#pragma unroll
        for (int rep = 0; rep < 4; ++rep) {
            const int e = tid + NTHR * rep, row = e >> 6, d = e & 63, c = c0 + row;
            const float val = Os[row * 65 + d];
            if (kv == 0) {
                float ss = 0.f;
#pragma unroll 16
                for (int j = 0; j < 64; ++j) { const float t = Os[row * 65 + j]; ss += t * t; }
                const float o = val * __builtin_amdgcn_rsqf(ss * (1.f / 64.f) + EPS) * GLD(float, INP(22) + l * 192 + d);
                GST(bf16_t, (bf16_t*)(ws + WS_KCN) + ((size_t)bg * 256 + c) * 64 + d, (c < 255) ? (bf16_t)f2bf(o) : (bf16_t)0);
            } else {
                GST(bf16_t, (bf16_t*)(ws + WS_VCT) + ((size_t)bg * 64 + d) * 256 + c, (c < 255) ? (bf16_t)f2bf(val) : (bf16_t)0);
            }
        }
        __syncthreads();
    }
}

__device__ __forceinline__ void qk_tile(f32x16& p0, f32x16& p1, const LAS unsigned char* Kl, const bf16x8 (&qf)[4], int r32, int hi) {
    const LAS unsigned char* kb = Kl + r32 * KP + hi * 16;
    bf16x8 a[8];
#pragma unroll
    for (int d0 = 0; d0 < 4; ++d0) { a[2 * d0] = *(const LAS bf16x8*)(kb + d0 * 32); a[2 * d0 + 1] = *(const LAS bf16x8*)(kb + 32 * KP + d0 * 32); }
    __builtin_amdgcn_s_setprio(1);
#pragma unroll
    for (int d0 = 0; d0 < 4; ++d0) {
        p0 = __builtin_amdgcn_mfma_f32_32x32x16_bf16(a[2 * d0], qf[d0], p0, 0, 0, 0);
        p1 = __builtin_amdgcn_mfma_f32_32x32x16_bf16(a[2 * d0 + 1], qf[d0], p1, 0, 0, 0);
    }
    __builtin_amdgcn_s_setprio(0);
}
template <int STRIDE, bool WINDOW, int MODE>
__device__ __forceinline__ void score_exp(f32x16& p0, f32x16& p1, int dl, const LAS float* tb, float cfar, bool rowsel) {
    const LAS float* tl = tb + 128 + (dl < 1087 ? dl : 1087) - 59;
#pragma unroll
    for (int blk = 0; blk < 2; ++blk) {
        f32x16& p = blk ? p1 : p0;
#pragma unroll
        for (int r = 0; r < 16; ++r) {
            const int c = (r & 3) + 8 * (r >> 2) + 32 * blk;
            const int dist = dl - STRIDE * c;
            float e;
            if (MODE == 0) e = __builtin_amdgcn_exp2f(p[r] + cfar);
            else {
                float bias;
                if (STRIDE == 1) bias = tl[59 - c];
                else bias = tb[128 + min((unsigned)dist, 1023u)];
                e = __builtin_amdgcn_exp2f(p[r] + bias);
                if (MODE == 2) { bool valid = dist >= 0; if (WINDOW) valid = valid && (dist < 512); e = valid ? e : 0.f; }
            }
            p[r] = rowsel ? e : 0.f;
        }
    }
}
template <int STRIDE, bool WINDOW>
__device__ __forceinline__ void score_exp_sel(f32x16& p0, f32x16& p1, int dl, const LAS float* tb, float cfar, bool rowsel, int dmin, int dmax) {
    if (!WINDOW && dmin >= 790) score_exp<STRIDE, WINDOW, 0>(p0, p1, dl, tb, cfar, rowsel);
    else if (dmin >= 0 && (!WINDOW || dmax < 512)) score_exp<STRIDE, WINDOW, 1>(p0, p1, dl, tb, cfar, rowsel);
    else score_exp<STRIDE, WINDOW, 2>(p0, p1, dl, tb, cfar, rowsel);
}
__device__ __forceinline__ float sum32(const f32x16& p0, const f32x16& p1) {
    float a = 0.f, b = 0.f;
#pragma unroll
    for (int r = 0; r < 16; ++r) { a += p0[r]; b += p1[r]; }
    return a + b;
}
template <int NDB>
__device__ __forceinline__ void pv_tile(f32x16 (&o)[NDB], const f32x16& p0, const f32x16& p1, const LAS unsigned char* Vl, int r32, int hi) {
    const LAS unsigned char* vbase = Vl + r32 * VP + hi * 8;
    bf16x4 vf[2][NDB][2];
#define PV_LOAD(st, buf) do { _Pragma("unroll") for (int db = 0; db < NDB; ++db) { const LAS unsigned char* vp = vbase + db * 32 * VP + (st) * 32; vf[buf][db][0] = *(const LAS bf16x4*)vp; vf[buf][db][1] = *(const LAS bf16x4*)(vp + 16); } } while (0)
    PV_LOAD(0, 0);
#pragma unroll
    for (int st = 0; st < 4; ++st) {
        if (st + 1 < 4) PV_LOAD(st + 1, (st + 1) & 1);
        const f32x16& p = (st >> 1) ? p1 : p0; const int s8 = 8 * (st & 1);
        u32x4 w; w.x = pg8::cvt_pk_bf16(p[s8 + 0], p[s8 + 1]); w.y = pg8::cvt_pk_bf16(p[s8 + 2], p[s8 + 3]); w.z = pg8::cvt_pk_bf16(p[s8 + 4], p[s8 + 5]); w.w = pg8::cvt_pk_bf16(p[s8 + 6], p[s8 + 7]);
        const bf16x8 pa = __builtin_bit_cast(bf16x8, w);
        __builtin_amdgcn_s_setprio(1);
#pragma unroll
        for (int db = 0; db < NDB; ++db) {
            const bf16x4 lo = vf[st & 1][db][0], hi4 = vf[st & 1][db][1];
            const bf16x8 vb = {lo[0], lo[1], lo[2], lo[3], hi4[0], hi4[1], hi4[2], hi4[3]};
            o[db] = __builtin_amdgcn_mfma_f32_32x32x16_bf16(pa, vb, o[db], 0, 0, 0);
        }
        __builtin_amdgcn_s_setprio(0);
    }
#undef PV_LOAD
}
__device__ __forceinline__ u32x4 ldk(const bf16_t* g, int tid) { return GLD(u32x4, (const unsigned char*)g + tid * 16); }
__device__ __forceinline__ void stk(LAS unsigned char* Kl, u32x4 v, int tid) { *(LAS u32x4*)(Kl + (tid >> 3) * KP + (tid & 7) * 16) = v; }
__device__ __forceinline__ u32x4 ldv(const bf16_t* g, size_t rs, int row, int tid) { return GLD(u32x4, (const unsigned char*)(g + (size_t)row * rs) + (tid & 7) * 16); }
__device__ __forceinline__ void stv(LAS unsigned char* Vl, u32x4 v, int row, int tid) { LAS unsigned char* p = Vl + row * VP + (tid & 7) * 16; *(LAS u32x2*)p = (u32x2){v.x, v.y}; *(LAS u32x2*)(p + 8) = (u32x2){v.z, v.w}; }

__device__ __forceinline__ void da_unit(const Params& P, int l, int b, int h, int qb, LAS unsigned char* lds, bool load_tab) {
    const int tid = otid(), lane = tid & 63, wave = __builtin_amdgcn_readfirstlane(tid >> 6), r32 = lane & 31, hi = lane >> 5;
    const int c = wave >> 2, qsub = wave & 3, q0 = qb * 128, qw0 = q0 + 32 * qsub;
    unsigned char* ws = WSP;
    const float* prm = (const float*)(ws + WS_PRM) + l * 8;
    const float lam = prm[0], Mb = prm[1], onem = prm[3];
    LAS float* biasL = (LAS float*)(lds + L_BIAS);
    const float* bg = (const float*)(ws + WS_BIAS) + h * 1024;
    if (load_tab) for (int i = tid; i < TBN; i += NTHR) { const int d = i - 128; biasL[i] = GLD(float, bg + (d < 0 ? 0 : (d > 1023 ? 1023 : d))) - Mb; }
    const float cfar = bg[1023] - Mb;
    const bf16_t* Qp = (const bf16_t*)(ws + Z_DQ) + ((size_t)(b * 8 + h * 2 + c) * SEQ + qw0 + r32) * 64 + hi * 8;
    bf16x8 qf[4];
#pragma unroll
    for (int d0 = 0; d0 < 4; ++d0) qf[d0] = GLD(bf16x8, Qp + d0 * 16);
    const bf16_t* K1g = (const bf16_t*)(ws + Z_DK) + (size_t)(b * 8 + h * 2) * SEQ * 64;
    const bf16_t* K2g = K1g + (size_t)SEQ * 64;
    const bf16_t* Vg = (const bf16_t*)(ws + Z_DVT) + (size_t)(b * 4 + h) * 128 * SEQ;
    const int NT = (q0 + 128) / 64;
    f32x16 o[4];
#pragma unroll
    for (int i = 0; i < 4; ++i) o[i] = (f32x16){};
    float lsum = 0.f;
    u32x4 rk1, rk2, rv0, rv1;
#define DA_LOAD(t) do { rk1 = ldk(K1g + (size_t)(t) * 4096, tid); rk2 = ldk(K2g + (size_t)(t) * 4096, tid); rv0 = ldv(Vg + (t) * 64, SEQ, tid >> 3, tid); rv1 = ldv(Vg + (t) * 64, SEQ, 64 + (tid >> 3), tid); } while (0)
#define DA_STORE(sb) do { LAS unsigned char* st_ = lds + (sb) * DA_STAGE; stk(st_, rk1, tid); stk(st_ + 64 * KP, rk2, tid); stv(st_ + 128 * KP, rv0, tid >> 3, tid); stv(st_ + 128 * KP, rv1, 64 + (tid >> 3), tid); } while (0)
    DA_LOAD(0); DA_STORE(0);
    __syncthreads();
    for (int t = 0; t < NT; ++t) {
        if (t + 1 < NT) DA_LOAD(t + 1);
        if (64 * t <= qw0 + 31) {
            const LAS unsigned char* st = lds + (t & 1) * DA_STAGE;
            f32x16 p0 = (f32x16){}, p1 = (f32x16){};
            qk_tile(p0, p1, st + c * 64 * KP, qf, r32, hi);
            const int dl = qw0 + r32 - 64 * t - 4 * hi;
            score_exp_sel<1, false>(p0, p1, dl, biasL, cfar, true, qw0 - (64 * t + 63), qw0 + 31 - 64 * t);
            lsum += sum32(p0, p1);
            pv_tile<4>(o, p0, p1, st + 128 * KP, r32, hi);
        }
        if (t + 1 < NT) DA_STORE((t + 1) & 1);
        __syncthreads();
    }
#undef DA_LOAD
#undef DA_STORE
    lsum += __shfl_xor(lsum, 32);
    LAS float* wsf = (LAS float*)(lds + L_WSF) + wave * 64;
    if (hi == 0) wsf[r32] = (lsum > 0.f) ? 1.0f / lsum : 0.f;
    asm volatile("s_waitcnt lgkmcnt(0)" ::: "memory");
    float li[16];
#pragma unroll
    for (int r = 0; r < 16; ++r) li[r] = wsf[crow(r, hi)];
    LAS float* X = (LAS float*)lds;
    if (c == 1) {
#pragma unroll
        for (int db = 0; db < 4; ++db)
#pragma unroll
            for (int r = 0; r < 16; ++r) X[(32 * qsub + crow(r, hi)) * 132 + r32 + 32 * db] = o[db][r] * li[r];
    }
    __syncthreads();
    if (c == 0) {
        const float* sg = INP(20) + l * 128;
        float gsub[4];
#pragma unroll
        for (int db = 0; db < 4; ++db) gsub[db] = sg[r32 + 32 * db] * onem;
#pragma unroll
        for (int r = 0; r < 16; ++r) {
            float y[4], ss = 0.f;
#pragma unroll
            for (int db = 0; db < 4; ++db) { y[db] = o[db][r] * li[r] - lam * X[(32 * qsub + crow(r, hi)) * 132 + r32 + 32 * db]; ss += y[db] * y[db]; }
            ss += __shfl_xor(ss, 1); ss += __shfl_xor(ss, 2); ss += __shfl_xor(ss, 4); ss += __shfl_xor(ss, 8); ss += __shfl_xor(ss, 16);
            const float rs = __builtin_amdgcn_rsqf(ss * (1.f / 128.f) + EPS);
            bf16_t* d = (bf16_t*)(ws + WS_XN) + (size_t)(b * SEQ + qw0 + crow(r, hi)) * DM + h * 128 + r32;
#pragma unroll
            for (int db = 0; db < 4; ++db) GST(bf16_t, d + 32 * db, (bf16_t)f2bf(y[db] * rs * gsub[db]));
        }
    }
    __syncthreads();
}

__device__ __forceinline__ void nsa_unit(const Params& P, int l, int b, int g, int u, LAS unsigned char* lds, bool load_tab) {
    const int tid = otid(), lane = tid & 63, wave = __builtin_amdgcn_readfirstlane(tid >> 6), r32 = lane & 31, hi = lane >> 5;
    const int qi = r32 >> 2, p = r32 & 3, qw0 = 64 * u + 8 * wave, qpos = qw0 + qi, head = g * 4 + p;
    unsigned char* ws = WSP;
    const float Mb = ((const float*)(ws + WS_PRM))[l * 8 + 2];
    LAS float* biasL = (LAS float*)(lds + L_BIAS);
    LAS float* imp = (LAS float*)(lds + L_IMP);
    LAS unsigned* selw = (LAS unsigned*)(lds + L_SEL);
    LAS float* wsf = (LAS float*)(lds + L_WSF) + wave * 64;
    const float* bgl = (const float*)(ws + WS_BIAS) + (size_t)(4 + g * 4) * 1024;
    if (load_tab) for (int i = tid; i < 4 * TBN; i += NTHR) { const int hh = i / TBN, d = i % TBN - 128; biasL[i] = GLD(float, bgl + hh * 1024 + (d < 0 ? 0 : (d > 1023 ? 1023 : d))) - Mb; }
    if (tid == 0) { unsigned z = 0u; asm volatile("" : "+v"(z)); selw[128] = z; selw[129] = z; }
    const LAS float* tb = biasL + p * TBN;
    const float cfar = bgl[p * 1024 + 1023] - Mb;
    const bf16_t* Qp = (const bf16_t*)(ws + Z_NQ) + ((size_t)(b * 8 + head) * SEQ + qpos) * 64 + hi * 8;
    bf16x8 qf[4];
#pragma unroll
    for (int d0 = 0; d0 < 4; ++d0) qf[d0] = GLD(bf16x8, Qp + d0 * 16);
    const float* ngp = (const float*)(ws + Z_NG) + (size_t)(b * SEQ + qpos) * 24 + head * 3;
    const float gate_c = GLD(float, ngp), gate_s = GLD(float, ngp + 1), gate_w = GLD(float, ngp + 2);
    f32x16 oc[2]; oc[0] = (f32x16){}; oc[1] = (f32x16){};
    f32x16 o[2];
    u32x4 rk, rv;
    const int bgi = b * 2 + g;
#define NS_STORE(sb) do { LAS unsigned char* st_ = lds + (sb) * NS_STAGE; stk(st_, rk, tid); stv(st_ + 64 * KP, rv, tid >> 3, tid); } while (0)
#define NS_FOLD(gate) do { lsum += __shfl_xor(lsum, 32); if (hi == 0) wsf[r32] = (lsum > 0.f) ? (gate) / lsum : 0.f; asm volatile("s_waitcnt lgkmcnt(0)" ::: "memory"); \
        _Pragma("unroll") for (int r = 0; r < 16; ++r) { const float f_ = wsf[crow(r, hi)]; oc[0][r] += f_ * o[0][r]; oc[1][r] += f_ * o[1][r]; } asm volatile("s_waitcnt lgkmcnt(0)" ::: "memory"); } while (0)
    {
        const bf16_t* Kg = (const bf16_t*)(ws + WS_KCN) + (size_t)bgi * 256 * 64;
        const bf16_t* Vg = (const bf16_t*)(ws + WS_VCT) + (size_t)bgi * 64 * 256;
        const int ntc = (4 * u + 2) / 64 + 1;
        {
            u32x4 ck[4], cv[4];
#pragma unroll
            for (int tc = 0; tc < 4; ++tc) if (tc < ntc) { ck[tc] = ldk(Kg + (size_t)tc * 4096, tid); cv[tc] = ldv(Vg + tc * 64, 256, tid >> 3, tid); }
#pragma unroll
            for (int tc = 0; tc < 4; ++tc) if (tc < ntc) { LAS unsigned char* st_ = lds + tc * NS_STAGE; stk(st_, ck[tc], tid); stv(st_ + 64 * KP, cv[tc], tid >> 3, tid); }
        }
        __syncthreads();
        float lsum = 0.f;
        for (int tc = 0; tc < ntc; ++tc) {
            const LAS unsigned char* st = lds + tc * NS_STAGE;
            f32x16 p0 = (f32x16){}, p1 = (f32x16){};
            qk_tile(p0, p1, st, qf, r32, hi);
            const int dl = qpos - 31 - 16 * (64 * tc + 4 * hi);
            score_exp_sel<16, false>(p0, p1, dl, tb, cfar, true, qw0 - 31 - 16 * (64 * tc + 63), qw0 + 7 - 31 - 16 * 64 * tc);
            lsum += sum32(p0, p1);
        }
        const float lt = lsum + __shfl_xor(lsum, 32);
        const float linv = (lt > 0.f) ? 1.0f / lt : 0.f;
        o[0] = (f32x16){}; o[1] = (f32x16){};
        float carry = 0.f;
        for (int tc = 0; tc < ntc; ++tc) {
            const LAS unsigned char* st = lds + tc * NS_STAGE;
            f32x16 p0 = (f32x16){}, p1 = (f32x16){};
            qk_tile(p0, p1, st, qf, r32, hi);
            const int dl = qpos - 31 - 16 * (64 * tc + 4 * hi);
            score_exp_sel<16, false>(p0, p1, dl, tb, cfar, true, qw0 - 31 - 16 * (64 * tc + 63), qw0 + 7 - 31 - 16 * 64 * tc);
            float Qs[2][4], PL[2][4];
#pragma unroll
            for (int blk = 0; blk < 2; ++blk)
#pragma unroll
                for (int m = 0; m < 4; ++m) { const f32x16& pp = blk ? p1 : p0; Qs[blk][m] = (pp[4 * m] + pp[4 * m + 1]) + (pp[4 * m + 2] + pp[4 * m + 3]); PL[blk][m] = __shfl_xor(pp[4 * m + 3], 32); }
#pragma unroll
            for (int blk = 0; blk < 2; ++blk)
#pragma unroll
                for (int m = 0; m < 4; ++m) {
                    const float prev = (m > 0) ? PL[blk][m - 1] : (blk ? PL[0][3] : carry);
                    float e = (Qs[blk][m] + (hi ? PL[blk][m] : prev)) * linv;
                    e += __shfl_xor(e, 1); e += __shfl_xor(e, 2);
                    if (p == 0) imp[(8 * wave + qi) * 64 + 16 * tc + 8 * blk + 2 * m + hi] = e;
                }
            carry = PL[1][3];
            pv_tile<2>(o, p0, p1, st + 64 * KP, r32, hi);
        }
        NS_FOLD(gate_c);
    }
    __syncthreads();
    {
        const int ql = lane >> 3, sub = lane & 7, q = 8 * wave + ql;
        unsigned long long m;
        if (u < 8) m = (2ull << u) - 1ull;
        else {
            m = 1ull | (1ull << u) | (1ull << (u - 1));
            float v[8];
#pragma unroll
            for (int i = 0; i < 8; ++i) { const int j = sub + 8 * i; v[i] = (j >= 1 && j <= u - 2) ? imp[q * 64 + j] : -1.f; }
            for (int k = 0; k < 5; ++k) {
                float bv = v[0]; int bj = sub;
#pragma unroll
                for (int i = 1; i < 8; ++i) if (v[i] > bv) { bv = v[i]; bj = sub + 8 * i; }
#pragma unroll
                for (int of = 1; of < 8; of <<= 1) { const float ov = __shfl_xor(bv, of); const int oj = __shfl_xor(bj, of); if (ov > bv || (ov == bv && oj < bj)) { bv = ov; bj = oj; } }
                m |= 1ull << bj;
#pragma unroll
                for (int i = 0; i < 8; ++i) if (bj == sub + 8 * i) v[i] = -2.f;
            }
        }
        if (sub == 0) { selw[2 * q] = (unsigned)m; selw[2 * q + 1] = (unsigned)(m >> 32); atomicOr((unsigned*)&selw[128], (unsigned)m); atomicOr((unsigned*)&selw[129], (unsigned)(m >> 32)); }
    }
    __syncthreads();
    asm volatile("" : "+v"(oc[0]), "+v"(oc[1]));
    u32x4 rk2, rv2;
#define NS_LOADA(Kg_, Vg_, j_) do { rk = ldk((Kg_) + (size_t)(j_) * 4096, tid); rv = ldv((Vg_) + (j_) * 64, SEQ, tid >> 3, tid); } while (0)
#define NS_LOADB(Kg_, Vg_, j_) do { rk2 = ldk((Kg_) + (size_t)(j_) * 4096, tid); rv2 = ldv((Vg_) + (j_) * 64, SEQ, tid >> 3, tid); } while (0)
#define NS_STOREA(sb) do { LAS unsigned char* st_ = lds + (sb) * NS_STAGE; stk(st_, rk, tid); stv(st_ + 64 * KP, rv, tid >> 3, tid); } while (0)
#define NS_STOREB(sb) do { LAS unsigned char* st_ = lds + (sb) * NS_STAGE; stk(st_, rk2, tid); stv(st_ + 64 * KP, rv2, tid >> 3, tid); } while (0)
    {
        const unsigned long long un = (unsigned long long)selw[128] | ((unsigned long long)selw[129] << 32);
        const unsigned long long mine = (unsigned long long)selw[2 * (8 * wave + qi)] | ((unsigned long long)selw[2 * (8 * wave + qi) + 1] << 32);
        const bf16_t* Kg = (const bf16_t*)(ws + Z_KSEL) + (size_t)bgi * SEQ * 64;
        const bf16_t* Vg = (const bf16_t*)(ws + Z_VSELT) + (size_t)bgi * 64 * SEQ;
        o[0] = (f32x16){}; o[1] = (f32x16){};
        float lsum = 0.f;
        unsigned long long rem = un;
#define NS_NEXTJ(var, has) do { has = (rem != 0ull); var = 0; if (has) { var = __builtin_ctzll(rem); rem &= rem - 1; } } while (0)
        int jc, j1, j2; bool h1, h2;
        NS_NEXTJ(jc, h1);
        NS_NEXTJ(j1, h1);
        NS_LOADA(Kg, Vg, jc); if (h1) NS_LOADB(Kg, Vg, j1);
        NS_STOREA(0);
        __syncthreads();
        int sc = 0;
#define NS_SEL_STEP(LOADF, STOREN) { \
            NS_NEXTJ(j2, h2); if (h2) LOADF(Kg, Vg, j2); \
            const bool rowsel = (mine >> jc) & 1ull; \
            if (__any(rowsel)) { \
                const LAS unsigned char* st = lds + sc * NS_STAGE; \
                f32x16 p0 = (f32x16){}, p1 = (f32x16){}; \
                qk_tile(p0, p1, st, qf, r32, hi); \
                const int dl = qpos - 64 * jc - 4 * hi; \
                score_exp_sel<1, false>(p0, p1, dl, tb, cfar, rowsel, qw0 - (64 * jc + 63), qw0 + 7 - 64 * jc); \
                lsum += sum32(p0, p1); \
                pv_tile<2>(o, p0, p1, st + 64 * KP, r32, hi); \
            } \
            const int sn = (sc == 2) ? 0 : sc + 1; \
            if (h1) STOREN(sn); \
            __syncthreads(); \
            if (!h1) break; \
            jc = j1; j1 = j2; h1 = h2; sc = sn; }
        for (;;) { NS_SEL_STEP(NS_LOADA, NS_STOREB) NS_SEL_STEP(NS_LOADB, NS_STOREA) }
#undef NS_SEL_STEP
#undef NS_NEXTJ
        NS_FOLD(gate_s);
        asm volatile("" : "+v"(oc[0]), "+v"(oc[1]));
    }
    {
        const bf16_t* Kg = (const bf16_t*)(ws + Z_KWIN) + (size_t)bgi * SEQ * 64;
        const bf16_t* Vg = (const bf16_t*)(ws + Z_VWINT) + (size_t)bgi * 64 * SEQ;
        o[0] = (f32x16){}; o[1] = (f32x16){};
        float lsum = 0.f;
        const int t0 = (u >= 8) ? u - 8 : 0;
        int t = t0, sc = 0;
        NS_LOADA(Kg, Vg, t0); if (t0 + 1 <= u) NS_LOADB(Kg, Vg, t0 + 1);
        NS_STOREA(0);
        __syncthreads();
#define NS_WIN_STEP(LOADF, STOREN) { \
            if (t + 2 <= u) LOADF(Kg, Vg, t + 2); \
            { \
                const LAS unsigned char* st = lds + sc * NS_STAGE; \
                f32x16 p0 = (f32x16){}, p1 = (f32x16){}; \
                qk_tile(p0, p1, st, qf, r32, hi); \
                const int dl = qpos - 64 * t - 4 * hi; \
                score_exp_sel<1, true>(p0, p1, dl, tb, cfar, true, qw0 - (64 * t + 63), qw0 + 7 - 64 * t); \
                lsum += sum32(p0, p1); \
                pv_tile<2>(o, p0, p1, st + 64 * KP, r32, hi); \
            } \
            const int sn = (sc == 2) ? 0 : sc + 1; \
            if (t + 1 <= u) STOREN(sn); \
            __syncthreads(); \
            if (t + 1 > u) break; \
            ++t; sc = sn; }
        for (;;) { NS_WIN_STEP(NS_LOADA, NS_STOREB) NS_WIN_STEP(NS_LOADB, NS_STOREA) }
#undef NS_WIN_STEP
        NS_FOLD(gate_w);
    }
#undef NS_LOADA
#undef NS_LOADB
#undef NS_STOREA
#undef NS_STOREB
#undef NS_STORE
#undef NS_FOLD
#pragma unroll
    for (int r = 0; r < 16; ++r) {
        const int row = crow(r, hi), q = qw0 + (row >> 2), pp = row & 3;
        bf16_t* d = (bf16_t*)(ws + WS_XN) + (size_t)(b * SEQ + q) * DM + 512 + (g * 4 + pp) * 64 + r32;
        GST(bf16_t, d, (bf16_t)f2bf(oc[0][r])); GST(bf16_t, d + 32, (bf16_t)f2bf(oc[1][r]));
    }
    __syncthreads();
}

__device__ __forceinline__ void attention_phase(const Params& P, int l, LAS unsigned char* lds) {
    int tab_key = -1;
    for (int it = blockIdx.x; it < 2048; it += gridDim.x) {
        const int c = it & 255, sl = (it >> 8) & 3;
        if (it < 1024) { const int bh = c & 31, xg = c >> 5; const int qb = (sl == 0) ? 31 - xg : (sl == 1) ? 23 - xg : (sl == 2) ? 8 + xg : xg;
            da_unit(P, l, bh >> 2, bh & 3, qb, lds, tab_key != (bh & 3)); tab_key = bh & 3; }
        else { const int bg = c & 15, ug = c >> 4; const int u = (sl == 0) ? 63 - ug : (sl == 1) ? 47 - ug : (sl == 2) ? 16 + ug : ug;
            nsa_unit(P, l, bg >> 1, bg & 1, u, lds, tab_key != 4 + (bg & 1)); tab_key = 4 + (bg & 1); }
    }
}

constexpr size_t WS_BAR = 72 * 1024;
#define RLX_AGENT __ATOMIC_RELAXED, __HIP_MEMORY_SCOPE_AGENT
#define XB_TMO      128
#define XB_XCNT(j)  (256  + 64 * (j))
#define XB_XSUB(j)  (1280 + 64 * (j))
#define XB_XGEN(j)  (2304 + 64 * (j))
#define XB_TOP      3328
#define XB_TOPGEN   3392
#define XCD_BAR_WORDS 3456
#define XB_SPIN_CAP (1u << 18)

__device__ __forceinline__ unsigned xb_ld(unsigned* p)              { return __hip_atomic_load(p, __ATOMIC_RELAXED, __HIP_MEMORY_SCOPE_AGENT); }
__device__ __forceinline__ unsigned xb_add(unsigned* p, unsigned v) { return __hip_atomic_fetch_add(p, v, __ATOMIC_RELAXED, __HIP_MEMORY_SCOPE_AGENT); }
__device__ __forceinline__ unsigned xb_xcc_id() { return (unsigned)__builtin_amdgcn_s_getreg((3 << 11) | 20) & 0xFu; }
#define XB_SPIN(cond, bar) do { unsigned _sp = 0; while (cond) { __builtin_amdgcn_s_sleep(1); \
    if ((++_sp & 255u) == 0u) { if (xb_ld(&(bar)[XB_TMO])) break; if (_sp > XB_SPIN_CAP) { atomicAdd(&(bar)[XB_TMO], 1u); break; } } } } while (0)

struct XcdBarrier {
    unsigned* bar; unsigned x;
    volatile LAS unsigned* st;
};

__device__ __forceinline__ XcdBarrier xcd_barrier_post(unsigned* bar, volatile LAS unsigned* st) {
    XcdBarrier b; b.bar = bar; b.x = xb_xcc_id(); b.st = st;
    if (threadIdx.x == 0) (void)xb_add(&bar[XB_XCNT(b.x)], 1u);
    return b;
}
__device__ __forceinline__ void xcd_barrier_complete(unsigned* bar, unsigned x, unsigned& nloc, unsigned& nx) {
    const unsigned G = gridDim.x * gridDim.y * gridDim.z;
    unsigned sum, cnt, mine, sp = 0u;
    for (;;) {
        sum = 0u; cnt = 0u; mine = 0u;
#pragma unroll
        for (unsigned j = 0; j < 16; ++j) { const unsigned c = xb_ld(&bar[XB_XCNT(j)]); sum += c; cnt += (c > 0u) ? 1u : 0u; mine = (j == x) ? c : mine; }
        if (sum == G) break;
        __builtin_amdgcn_s_sleep(1);
        if ((++sp & 255u) == 0u) { if (xb_ld(&bar[XB_TMO])) break; if (sp > XB_SPIN_CAP) { atomicAdd(&bar[XB_TMO], 1u); break; } }
    }
    nloc = mine > 0u ? mine : 1u; nx = cnt > 0u ? cnt : 1u;
}

__device__ __forceinline__ void xcd_barrier(const XcdBarrier& b) {
    asm volatile("s_waitcnt vmcnt(0)" ::: "memory");
    __syncthreads();
    if (threadIdx.x == 0) {
        unsigned* bar = b.bar;
        __builtin_amdgcn_s_waitcnt(0);
        unsigned nloc = b.st[0], nx = b.st[1];
        if (nloc == 0u) { xcd_barrier_complete(bar, b.x, nloc, nx); b.st[0] = nloc; b.st[1] = nx; }
        const unsigned old = xb_add(&bar[XB_XSUB(b.x)], 1u);
        const unsigned gen = old / nloc;
        if (old + 1u == (gen + 1u) * nloc) {
            __builtin_amdgcn_fence(__ATOMIC_RELEASE, "agent");
            asm volatile("s_waitcnt vmcnt(0)" ::: "memory");
            const unsigned og = xb_add(&bar[XB_TOP], 1u);
            const unsigned tg = og / nx;
            if (og + 1u == (tg + 1u) * nx) xb_add(&bar[XB_TOPGEN], 1u);
            else XB_SPIN(xb_ld(&bar[XB_TOPGEN]) == tg, bar);
            __builtin_amdgcn_fence(__ATOMIC_ACQUIRE, "agent");
            xb_add(&bar[XB_XGEN(b.x)], 1u);
            asm volatile("s_waitcnt vmcnt(0)" ::: "memory");
        } else {
            XB_SPIN(xb_ld(&bar[XB_XGEN(b.x)]) == gen, bar);
            __builtin_amdgcn_fence(__ATOMIC_ACQUIRE, "agent");
            asm volatile("s_waitcnt vmcnt(0)" ::: "memory");
        }
    }
    __syncthreads();
}

__global__ void __launch_bounds__(NTHR, 2) hybrid_fwd(Params P) {
    extern __shared__ __attribute__((aligned(16))) unsigned char lds_raw[];
    LAS unsigned char* lds = (LAS unsigned char*)lds_raw;
    cg::grid_group grid = cg::this_grid();
#define GSYNC() do { XcdBarrier xb_; xb_.bar = (unsigned*)(WSP + WS_BAR); xb_.x = xb_xcc_id(); xb_.st = (volatile LAS unsigned*)(lds + L_PTAB + 384); xcd_barrier(xb_); } while (0)
    if (threadIdx.x == 0) {
        LAS unsigned long long* pt = (LAS unsigned long long*)(lds + L_PTAB);
#pragma unroll
        for (int i = 0; i < 30; ++i) pt[i] = (unsigned long long)P.in[i];
        pt[30] = (unsigned long long)P.out; pt[31] = (unsigned long long)P.ws;
        *(LAS unsigned*)(lds + L_PTAB + 384) = 0u; *(LAS unsigned*)(lds + L_PTAB + 388) = 0u;
    }
    __syncthreads();
    (void)xcd_barrier_post((unsigned*)(WSP + WS_BAR), (volatile LAS unsigned*)(lds + L_PTAB + 384));
    const int G = gridDim.x, bx = blockIdx.x;
#define ws WSP
#define XN ((bf16_t*)(WSP + WS_XN))
#define HID ((bf16_t*)(WSP + WS_HID))
#define MERGED ((bf16_t*)(WSP + WS_MERGED))
#define XB ((bf16_t*)OUTP)
#define XS ((bf16_t*)(WSP + WS_Z + 192 * MiB))
#define SSP ((float*)(WSP + WS_SS))

#define STAMP() do {} while (0)
    if (P.out == nullptr) grid.sync();
    STAMP();
    prologue(P, lds);
    xprep_phase(INP(0), (bf16_t*)OUTP, (float*)(WSP + WS_SS));
    GSYNC(); STAMP();
#pragma unroll
    for (int l = 0; l < DEPTH; ++l) {
        const float* xin = (l == 0) ? INP(0) : OUTP;
        { pg8::Gemm g{XB, (const bf16_t*)(ws + WS_W13 + (size_t)(l * 2 + 0) * W13_SZ), MTOK, 5632, DM}; pg8::StaticOrder S; S.init(MTOK, 5632, G, bx);
          EpiSwiGLU E{{SSP}, HID}; pg8::gemm_phase<EpiSwiGLU, pg8::StaticOrder, true, true>(lds, g, S, E);
        }
        GSYNC(); STAMP();
        { pg8::Gemm g{HID, (const bf16_t*)(ws + WS_W2 + (size_t)(l * 2 + 0) * W2_SZ), MTOK, DM, DFF}; pg8::StaticOrder S; S.init(MTOK, DM, G, bx);
          if (l == 0) { EpiResidT<true, false> E{xin, XB, 0.5f, SSP}; pg8::gemm_phase<EpiResidT<true, false>, pg8::StaticOrder, true, true>(lds, g, S, E); }
          else { EpiResidT<false, false> E{XB, XB, 0.5f, SSP}; pg8::gemm_phase<EpiResidT<false, false>, pg8::StaticOrder, true, true>(lds, g, S, E); } }
        GSYNC(); STAMP();
        { pg8::Gemm g{XB, (const bf16_t*)(ws + WS_WIN + (size_t)l * WIN_SZ), MTOK, 5120, DM}; pg8::StaticOrder S; S.init(MTOK, 5120, G, bx);
          EpiZ E{{SSP}, ws, INP(14) + l * 64, INP(15) + l * 64, INP(21) + l * 64, INP(22) + l * 192}; pg8::gemm_phase<EpiZ, pg8::StaticOrder, true, true>(lds, g, S, E);
        }
        GSYNC(); STAMP();
        compress_phase(P, l, lds);
        GSYNC(); STAMP();
        attention_phase(P, l, lds);
        GSYNC(); STAMP();
        { pg8::Gemm g{XN, (const bf16_t*)(ws + WS_PAB + (size_t)l * PAB_SZ), MTOK, 2048, DM}; pg8::StaticOrder S; S.init(MTOK, 2048, G, bx);
          EpiMerge E{(const unsigned char*)(ws + Z_MG), MERGED}; pg8::gemm_phase<EpiMerge, pg8::StaticOrder, true, true>(lds, g, S, E); }
        GSYNC(); STAMP();
        { pg8::Gemm g{MERGED, (const bf16_t*)(ws + WS_WO + (size_t)l * WO_SZ), MTOK, DM, DM}; pg8::StaticOrder S; S.init(MTOK, DM, G, bx);
          EpiResidT<false, false> E{XB, (l + 1 < DEPTH) ? XB : XS, 1.0f, SSP}; pg8::gemm_phase<EpiResidT<false, false>, pg8::StaticOrder, true, true>(lds, g, S, E); }
        GSYNC(); STAMP();
        { pg8::Gemm g{(l + 1 < DEPTH) ? XB : XS, (const bf16_t*)(ws + WS_W13 + (size_t)(l * 2 + 1) * W13_SZ), MTOK, 5632, DM}; pg8::StaticOrder S; S.init(MTOK, 5632, G, bx);
          EpiSwiGLU E{{SSP}, HID}; pg8::gemm_phase<EpiSwiGLU, pg8::StaticOrder, true, true>(lds, g, S, E); }
        GSYNC(); STAMP();
        { pg8::Gemm g{HID, (const bf16_t*)(ws + WS_W2 + (size_t)(l * 2 + 1) * W2_SZ), MTOK, DM, DFF}; pg8::StaticOrder S; S.init(MTOK, DM, G, bx);
          if (l + 1 < DEPTH) { EpiResidT<false, false> E{XB, XB, 0.5f, SSP}; pg8::gemm_phase<EpiResidT<false, false>, pg8::StaticOrder, true, true>(lds, g, S, E); }
          else { EpiResidT<false, true> E{XS, OUTP, 0.5f, nullptr}; pg8::gemm_phase<EpiResidT<false, true>, pg8::StaticOrder, true, true>(lds, g, S, E); } }
        if (l + 1 < DEPTH) { GSYNC(); STAMP(); }
    }
#undef ws
#undef XN
#undef HID
#undef MERGED
#undef XB
#undef XS
#undef SSP
}

extern "C" void kernel_launch(void* const* d_in, const int* in_sizes, int n_in, void* d_out, int out_size, void* d_ws, size_t ws_size, hipStream_t stream) {
    static int grid = 0;
    if (grid == 0) {
        if (n_in != 30 || out_size != MTOK * DM || ws_size < WS_END) { fprintf(stderr, "kernel_launch: unexpected problem (n_in %d out %d ws %zu, need %zu)\n", n_in, out_size, ws_size, (size_t)WS_END); grid = -1; return; }
        int dev = 0, cus = 0, per_cu = 0;
        (void)hipGetDevice(&dev);
        (void)hipDeviceGetAttribute(&cus, hipDeviceAttributeMultiprocessorCount, dev);
        if (hipFuncSetAttribute((const void*)hybrid_fwd, hipFuncAttributeMaxDynamicSharedMemorySize, LDS_BYTES) != hipSuccess) { fprintf(stderr, "kernel_launch: hipFuncSetAttribute failed\n"); grid = -1; return; }
        if (hipOccupancyMaxActiveBlocksPerMultiprocessor(&per_cu, (const void*)hybrid_fwd, NTHR, LDS_BYTES) != hipSuccess || per_cu < 1) { fprintf(stderr, "kernel_launch: occupancy query gave %d\n", per_cu); per_cu = 1; }
        (void)hipGetLastError();
        grid = cus * (per_cu > 1 ? 1 : per_cu);
        if (grid <= 0) grid = 256;
    }
    if (grid < 0) return;
    Params p{};
    for (int i = 0; i < 30; ++i) p.in[i] = (const float*)d_in[i];
    p.out = (float*)d_out; p.ws = (unsigned char*)d_ws;
    (void)hipMemsetAsync((unsigned char*)d_ws + WS_BAR, 0, 16384, stream);
    void* args[] = {&p};
    hipError_t e = hipLaunchCooperativeKernel((const void*)hybrid_fwd, dim3(grid), dim3(NTHR), args, LDS_BYTES, stream);
    if (e != hipSuccess) fprintf(stderr, "cooperative launch failed: %s (grid %d)\n", hipGetErrorString(e), grid);
}
```

```cpp
#include <hip/hip_runtime.h>
#include <hip/hip_cooperative_groups.h>
#include <cstdio>
#include <cstdint>
namespace cg = cooperative_groups;
namespace pg8 {
#define PG8_LAS __attribute__((address_space(3)))
typedef unsigned short bf16_t;
typedef short bf16x8 __attribute__((ext_vector_type(8)));
typedef float f32x4 __attribute__((ext_vector_type(4)));
typedef unsigned u32x4 __attribute__((ext_vector_type(4)));
constexpr int BM = 256, BK = 64, HALF = 128, HTB = HALF * BK * 2  , STAGE_BYTES = 8 * HTB, NXCD = 8, WGM = 8;

__host__ __device__ __forceinline__ int lds_byte(int r, int c) { const int st = (r >> 4) * 2 + (c >> 5), rr = r & 15, cc = c & 31, ob = rr * 64 + cc * 2; return st * 1024 + (ob ^ (((ob >> 9) & 1) << 5)); }
__host__ __device__ __forceinline__ void stage_rc(int b, int& R, int& C) { const int st = b / 1024, sb = b % 1024, swz = sb ^ (((sb >> 9) & 1) << 5); R = (st >> 1) * 16 + swz / 64; C = (st & 1) * 32 + (swz % 64) / 2; }
__host__ __device__ __forceinline__ int perm32(int rho) { const int n = rho >> 4, i = rho & 15; return 8 * (i >> 2) + 4 * n + (i & 3); }

struct Unit { int pm, pn; };
struct Gemm { const bf16_t* A; const bf16_t* Bt; int M, N, K; };

struct StaticOrder {
    int nM, nN, nwg, G, c;
    __host__ __device__ void init(int M, int N, int G_, int c_) { nM = M / BM; nN = N / BM; nwg = nM * nN; G = G_; c = c_; }
    __host__ __device__ bool next(int i, Unit& u) const {
        const long L = (long)i * G + c; if (L >= nwg) return false;
        int wgid = (int)L; { const int q = nwg / NXCD, r = nwg % NXCD, xcd = wgid % NXCD, off = wgid / NXCD; wgid = (xcd < r ? xcd * (q + 1) : r * (q + 1) + (xcd - r) * q) + off; }
        const int nig = WGM * nN, gid = wgid / nig, fm = gid * WGM, gsz = (nM - fm) < WGM ? (nM - fm) : WGM;
        u.pm = fm + ((wgid % nig) % gsz); u.pn = (wgid % nig) / gsz; return true;
    }
    __device__ __forceinline__ void a_ready(const Unit&) const {}
    __device__ __forceinline__ void done(const Unit&) const {}
};

typedef float f32x2_t __attribute__((ext_vector_type(2))); typedef __bf16 bf16x2_t __attribute__((ext_vector_type(2)));
__device__ __forceinline__ unsigned cvt_pk_bf16(float lo, float hi) { f32x2_t v = {lo, hi}; bf16x2_t b = __builtin_convertvector(v, bf16x2_t); return __builtin_bit_cast(unsigned, b); }
template <class Epi, class Sched, bool ALIGN_EPI = false, bool SP2 = false>
__device__ __forceinline__ void gemm_phase(PG8_LAS unsigned char* lds, const Gemm g, const Sched& S, const Epi& E) {
    int tid_ = threadIdx.x; asm volatile("" : "+v"(tid_)); const int tid = tid_, wid = __builtin_amdgcn_readfirstlane(tid >> 6), lane = tid & 63, wr = wid >> 2, wc = wid & 3, fr = lane & 15, fq = lane >> 4;
    const int K = g.K, nt = K / BK;
    unsigned voffA[2], voffB[2];
#pragma unroll
    for (int i = 0; i < 2; ++i) { int R, C; stage_rc(tid * 16 + i * 8192, R, C); const int Rb = Epi::PERM ? ((R & ~31) + perm32(R & 31)) : R;
        voffA[i] = (unsigned)(R * K + C) * 2u; voffB[i] = (unsigned)(Rb * K + C) * 2u; }
    const size_t kstep = (size_t)(BK * 2);
    const size_t hstep = (size_t)HALF * K * 2;
    const size_t tstep = 2 * hstep;
    const unsigned ldsw = (unsigned)wid * 1024u;
    const int aoff = lds_byte(wr * 64 + fr, fq * 8), boff = lds_byte(wc * 32 + fr, fq * 8);
#define PG8_SA(b, h) (((b) * 2 + (h)) * HTB)
#define PG8_SB(b, h) ((4 + (b) * 2 + (h)) * HTB)
#define PG8_STAGE(bufoff, gbase, voff) do { _Pragma("unroll") for (int _i = 0; _i < 2; ++_i) \
        __builtin_amdgcn_global_load_lds((const unsigned*)((const char*)(gbase) + (voff)[_i]), (PG8_LAS unsigned*)(lds + (bufoff) + ldsw + _i * 8192), 16, 0, 0); } while (0)
#define PG8_LDA(dst, b, h) do { _Pragma("unroll") for (int m = 0; m < 4; ++m) _Pragma("unroll") for (int k = 0; k < 2; ++k) dst[m][k] = *(const PG8_LAS bf16x8*)(lds + PG8_SA(b, h) + aoff + m * 2048 + k * 1024); } while (0)
#define PG8_LDB(dst, b, h) do { _Pragma("unroll") for (int n = 0; n < 2; ++n) _Pragma("unroll") for (int k = 0; k < 2; ++k) dst[n][k] = *(const PG8_LAS bf16x8*)(lds + PG8_SB(b, h) + boff + n * 2048 + k * 1024); } while (0)
#define PG8_MMA(ai, bj, At, Bt) do { __builtin_amdgcn_s_setprio(1); _Pragma("unroll") for (int m = 0; m < 4; ++m) _Pragma("unroll") for (int n = 0; n < 2; ++n) _Pragma("unroll") for (int k = 0; k < 2; ++k) \
        acc[ai][bj][m][n] = __builtin_amdgcn_mfma_f32_16x16x32_bf16(Bt[n][k], At[m][k], acc[ai][bj][m][n], 0, 0, 0); __builtin_amdgcn_s_setprio(0); } while (0)
#define PG8_WAIT_V(n) asm volatile("s_waitcnt vmcnt(" #n ")" ::: "memory")
#define PG8_WAIT_L(n) asm volatile("s_waitcnt lgkmcnt(" #n ")" ::: "memory")
#define PG8_BAR __builtin_amdgcn_s_barrier()
#define PG8_SCHED __builtin_amdgcn_sched_barrier(0)
    Unit cur, nxt; int ui = 0;
    if (!S.next(0, cur)) return;
    f32x4 acc[2][2][4][2];
#pragma unroll
    for (int a = 0; a < 2; ++a)
#pragma unroll
        for (int b = 0; b < 2; ++b)
#pragma unroll
            for (int m = 0; m < 4; ++m)
#pragma unroll
                for (int n = 0; n < 2; ++n) acc[a][b][m][n] = (f32x4){0.f, 0.f, 0.f, 0.f};
    bf16x8 At[4][2], B0[2][2], B1[2][2];
    const char* cA = (const char*)g.A + (size_t)cur.pm * tstep; const char* cB = (const char*)g.Bt + (size_t)cur.pn * tstep;
    S.a_ready(cur);
    if constexpr (Epi::ROWSCALE) {
        int pmB = -1, pmC = -1, pmD = -1; Unit uu;
        for (int i = 1; S.next(i, uu); ++i) if (uu.pm != cur.pm && uu.pm != pmB && uu.pm != pmC && uu.pm != pmD) { if (pmB < 0) pmB = uu.pm; else if (pmC < 0) pmC = uu.pm; else if (pmD < 0) pmD = uu.pm; }
        f32x4 a0, b0, a1, b1, a2, b2, a3, b3; Unit t0 = cur, t1 = cur, t2 = cur, t3 = cur; t1.pm = pmB < 0 ? cur.pm : pmB; t2.pm = pmC < 0 ? cur.pm : pmC; t3.pm = pmD < 0 ? cur.pm : pmD;
        E.rs_issue(t0, tid, a0, b0); E.rs_issue(t1, tid, a1, b1); E.rs_issue(t2, tid, a2, b2); E.rs_issue(t3, tid, a3, b3);
        E.rs_write(tid, a3, b3, (PG8_LAS float*)(lds + STAGE_BYTES + ((t3.pm >> 3) & 3) * 1024));
        E.rs_write(tid, a2, b2, (PG8_LAS float*)(lds + STAGE_BYTES + ((t2.pm >> 3) & 3) * 1024));
        E.rs_write(tid, a1, b1, (PG8_LAS float*)(lds + STAGE_BYTES + ((t1.pm >> 3) & 3) * 1024));
        E.rs_write(tid, a0, b0, (PG8_LAS float*)(lds + STAGE_BYTES + ((t0.pm >> 3) & 3) * 1024));
    }
    if constexpr (SP2) {
        PG8_STAGE(PG8_SB(0, 0), cB, voffB); PG8_STAGE(PG8_SB(0, 1), cB + hstep, voffB); PG8_STAGE(PG8_SA(0, 0), cA, voffA); PG8_STAGE(PG8_SA(0, 1), cA + hstep, voffA);
        if (wr == 1) PG8_BAR;
        PG8_WAIT_V(2); PG8_BAR;
        PG8_STAGE(PG8_SB(1, 0), cB + kstep, voffB); PG8_STAGE(PG8_SA(1, 0), cA + kstep, voffA); PG8_STAGE(PG8_SB(1, 1), cB + hstep + kstep, voffB);
        PG8_WAIT_V(6); PG8_BAR;
    } else {
        PG8_STAGE(PG8_SB(0, 0), cB, voffB); PG8_STAGE(PG8_SA(0, 0), cA, voffA); PG8_STAGE(PG8_SB(0, 1), cB + hstep, voffB); PG8_STAGE(PG8_SA(0, 1), cA + hstep, voffA);
        if (wr == 1) PG8_BAR;
        PG8_WAIT_V(4); PG8_BAR;
        PG8_STAGE(PG8_SB(1, 0), cB + kstep, voffB); PG8_STAGE(PG8_SA(1, 0), cA + kstep, voffA); PG8_STAGE(PG8_SB(1, 1), cB + hstep + kstep, voffB);
        PG8_WAIT_V(6); PG8_BAR;
    }
    for (;;) {
        const bool has_next = S.next(ui + 1, nxt);
        const char* nA = has_next ? (const char*)g.A + (size_t)nxt.pm * tstep : cA; const char* nB = has_next ? (const char*)g.Bt + (size_t)nxt.pn * tstep : cB;
        for (int t = 0; t < nt; t += 2) {
            const bool last = (t == nt - 2);
            const char* a1 = cA + (size_t)(t + 1) * kstep;
            const char* a2 = last ? nA : cA + (size_t)(t + 2) * kstep; const char* b2 = last ? nB : cB + (size_t)(t + 2) * kstep;
            const char* a3 = a2 + kstep; const char* b3 = b2 + kstep;
            if (last && has_next) S.a_ready(nxt);
            if constexpr (SP2) {
            PG8_LDB(B0, 0, 0); PG8_LDB(B1, 0, 1); PG8_SCHED; PG8_LDA(At, 0, 0); PG8_STAGE(PG8_SA(1, 1), a1 + hstep, voffA);
            PG8_WAIT_V(8); PG8_WAIT_L(0); PG8_BAR; PG8_MMA(0, 0, At, B0); PG8_MMA(0, 1, At, B1); PG8_BAR; PG8_SCHED;
            PG8_LDA(At, 0, 1); PG8_STAGE(PG8_SB(0, 0), b2, voffB); PG8_STAGE(PG8_SB(0, 1), b2 + hstep, voffB); PG8_STAGE(PG8_SA(0, 0), a2, voffA);
            PG8_WAIT_V(8); PG8_WAIT_L(0); PG8_BAR; PG8_MMA(1, 0, At, B0); PG8_MMA(1, 1, At, B1); PG8_BAR; PG8_SCHED;
            PG8_LDB(B0, 1, 0); PG8_LDB(B1, 1, 1); PG8_SCHED; PG8_LDA(At, 1, 0); PG8_STAGE(PG8_SA(0, 1), a2 + hstep, voffA);
            PG8_WAIT_V(8); PG8_WAIT_L(0); PG8_BAR; PG8_MMA(0, 0, At, B0); PG8_MMA(0, 1, At, B1); PG8_BAR; PG8_SCHED;
            PG8_LDA(At, 1, 1); PG8_STAGE(PG8_SB(1, 0), b3, voffB); PG8_STAGE(PG8_SB(1, 1), b3 + hstep, voffB); PG8_STAGE(PG8_SA(1, 0), a3, voffA);
            PG8_WAIT_V(8); PG8_WAIT_L(0); PG8_BAR; PG8_MMA(1, 0, At, B0); PG8_MMA(1, 1, At, B1); PG8_BAR; PG8_SCHED;
            } else {
            PG8_LDB(B0, 0, 0); PG8_SCHED; PG8_LDA(At, 0, 0); PG8_STAGE(PG8_SA(1, 1), a1 + hstep, voffA);
            PG8_WAIT_L(8); PG8_BAR; PG8_WAIT_L(0); PG8_MMA(0, 0, At, B0); PG8_BAR; PG8_SCHED;
            PG8_LDB(B1, 0, 1); PG8_STAGE(PG8_SB(0, 0), b2, voffB);
            PG8_BAR; PG8_WAIT_L(0); PG8_MMA(0, 1, At, B1); PG8_BAR;
            PG8_LDA(At, 0, 1); PG8_STAGE(PG8_SA(0, 0), a2, voffA);
            PG8_BAR; PG8_WAIT_L(0); PG8_MMA(1, 0, At, B0); PG8_BAR; PG8_SCHED;
            PG8_STAGE(PG8_SB(0, 1), b2 + hstep, voffB);
            PG8_WAIT_V(6); PG8_BAR; PG8_MMA(1, 1, At, B1); PG8_BAR;
            PG8_LDB(B0, 1, 0); PG8_SCHED; PG8_LDA(At, 1, 0); PG8_STAGE(PG8_SA(0, 1), a2 + hstep, voffA);
            PG8_WAIT_L(8); PG8_BAR; PG8_WAIT_L(0); PG8_MMA(0, 0, At, B0); PG8_BAR; PG8_SCHED;
            PG8_LDB(B1, 1, 1); PG8_STAGE(PG8_SB(1, 0), b3, voffB);
            PG8_BAR; PG8_WAIT_L(0); PG8_MMA(0, 1, At, B1); PG8_BAR;
            PG8_LDA(At, 1, 1); PG8_STAGE(PG8_SA(1, 0), a3, voffA);
            PG8_BAR; PG8_WAIT_L(0); PG8_MMA(1, 0, At, B0); PG8_BAR; PG8_SCHED;
            PG8_STAGE(PG8_SB(1, 1), b3 + hstep, voffB);
            PG8_WAIT_V(6); PG8_BAR; PG8_MMA(1, 1, At, B1); PG8_BAR;
            }
        }
        if constexpr (ALIGN_EPI) { if (wr == 0) PG8_BAR; }
        if constexpr (!Epi::AFTER_DRAIN) {
            if constexpr (Epi::ROWSCALE) E(acc, cur, wr, wc, fr, fq, (const PG8_LAS float*)(lds + STAGE_BYTES + ((cur.pm >> 3) & 3) * 1024));
            else if constexpr (Epi::CHAIN) { if (ui & 1) E(acc, cur, wr, wc, fr, fq); else E.chain(acc, cur, wr, wc, fr, fq); }
            else E(acc, cur, wr, wc, fr, fq);
            S.done(cur); }
        if (!has_next) break;
        if (!(Epi::CHAIN && !(ui & 1)))
#pragma unroll
        for (int a = 0; a < 2; ++a)
#pragma unroll
            for (int b = 0; b < 2; ++b)
#pragma unroll
                for (int m = 0; m < 4; ++m)
#pragma unroll
                    for (int n = 0; n < 2; ++n) acc[a][b][m][n] = (f32x4){0.f, 0.f, 0.f, 0.f};
        cur = nxt; cA = nA; cB = nB; ++ui;
        if constexpr (ALIGN_EPI) { if (wr == 1) PG8_BAR; }
    }
    PG8_WAIT_V(0);
    if constexpr (!ALIGN_EPI) { if (wr == 0) PG8_BAR; }
    PG8_BAR;
    if constexpr (Epi::AFTER_DRAIN) { E.fused(acc, cur, wr, wc, fr, fq, lds, wid, lane); S.done(cur); }
#undef PG8_SA
#undef PG8_SB
#undef PG8_STAGE
#undef PG8_LDA
#undef PG8_LDB
#undef PG8_MMA
#undef PG8_WAIT_V
#undef PG8_WAIT_L
#undef PG8_BAR
#undef PG8_SCHED
}
}

#define LAS __attribute__((address_space(3)))
#define GAS __attribute__((address_space(1)))
#define GLD(T, p) (*(const GAS T*)(p))
#define GST(T, p, v) (*(GAS T*)(p) = (v))
typedef unsigned short bf16_t;
typedef short bf16x8 __attribute__((ext_vector_type(8)));
typedef short bf16x4 __attribute__((ext_vector_type(4)));
typedef float f32x4 __attribute__((ext_vector_type(4)));
typedef float f32x16 __attribute__((ext_vector_type(16)));
typedef unsigned u32x4 __attribute__((ext_vector_type(4)));
typedef unsigned u32x2 __attribute__((ext_vector_type(2)));

constexpr int BATCH = 8, SEQ = 4096, DM = 1024, MTOK = BATCH * SEQ, DFF = 2816, DEPTH = 2, NIN = 4888;
constexpr int NTHR = 512, NWAVE = 8;
constexpr float EPS = 1e-6f, LOG2E = 1.4426950408889634f;
constexpr float QSCALE = 0.125f * LOG2E;
constexpr size_t MiB = 1u << 20;
constexpr size_t WS_BIAS = 0;
constexpr size_t WS_PRM = 64 * 1024;
constexpr size_t WS_CB1 = 68 * 1024;
constexpr size_t WS_W13 = 1 * MiB;
constexpr size_t W13_SZ = (size_t)5632 * 1024 * 2;
constexpr size_t WS_W2 = 45 * MiB;
constexpr size_t W2_SZ = (size_t)1024 * 2816 * 2;
constexpr size_t WS_WIN = 68 * MiB;
constexpr size_t WIN_SZ = (size_t)5120 * 1024 * 2;
constexpr size_t WS_PAB = 88 * MiB;
constexpr size_t PAB_SZ = (size_t)2048 * 1024 * 2;
constexpr size_t WS_WO = 96 * MiB;
constexpr size_t WO_SZ = (size_t)1024 * 1024 * 2;
constexpr size_t WS_CW1 = 100 * MiB;
constexpr size_t CW1_SZ = (size_t)128 * 2048 * 2;
constexpr size_t WS_CW2 = 102 * MiB;
constexpr size_t CW2_SZ = (size_t)64 * 128 * 2;
constexpr size_t WS_KCN = 103 * MiB;
constexpr size_t WS_VCT = WS_KCN + 512 * 1024;
constexpr size_t WS_XN = 104 * MiB;
constexpr size_t WS_Z = 168 * MiB;
constexpr size_t Z_DQ = WS_Z, Z_DK = WS_Z + 32 * MiB, Z_DVT = WS_Z + 64 * MiB, Z_NQ = WS_Z + 96 * MiB;
constexpr size_t Z_KCR = WS_Z + 128 * MiB, Z_VCR = WS_Z + 136 * MiB, Z_KSEL = WS_Z + 144 * MiB, Z_VSELT = WS_Z + 152 * MiB;
constexpr size_t Z_KWIN = WS_Z + 160 * MiB, Z_VWINT = WS_Z + 168 * MiB, Z_NG = WS_Z + 176 * MiB, Z_MG = WS_Z + 180 * MiB;
constexpr size_t WS_MERGED = WS_Z;
constexpr size_t WS_HID = WS_Z;
constexpr size_t WS_SS = WS_Z + 308 * MiB;
constexpr size_t WS_END = WS_SS + 2 * MiB;
constexpr int LDS_BYTES = 147456;
constexpr int KP = 144, VP = 136;
constexpr int DA_STAGE = 2 * 64 * KP + 128 * VP;
constexpr int NS_STAGE = 64 * KP + 64 * VP;
constexpr int L_BIAS = 73728;
constexpr int TBN = 1216;
constexpr int L_IMP = L_BIAS + 4 * TBN * 4;
constexpr int L_SEL = L_IMP + 16384;
constexpr int L_WSF = L_SEL + 1024;
constexpr int L_END = L_WSF + 8 * 256;

struct Params {
    const float* in[30];
    float* out;
    unsigned char* ws;
};

constexpr int L_PTAB = LDS_BYTES - 1024;
__device__ __forceinline__ const float* ld_ptr(const LAS unsigned char* lds, int i) {
    unsigned a = L_PTAB + 8 * i; asm volatile("" : "+v"(a));
    const LAS unsigned* t = (const LAS unsigned*)(lds + a);
    const unsigned lo = __builtin_amdgcn_readfirstlane(t[0]), hi = __builtin_amdgcn_readfirstlane(t[1]);
    return (const float*)(((unsigned long long)hi << 32) | lo);
}
#define INP(i) ld_ptr(lds, (i))
#define OUTP ((float*)ld_ptr(lds, 30))
#define WSP ((unsigned char*)ld_ptr(lds, 31))

__device__ __forceinline__ unsigned f2bf(float f) { unsigned u = __builtin_bit_cast(unsigned, f); return (u + 0x7fffu + ((u >> 16) & 1u)) >> 16; }
__device__ __forceinline__ unsigned pk2(float lo, float hi) { return f2bf(lo) | (f2bf(hi) << 16); }
__device__ __forceinline__ float sigmoidf_(float x) { return __builtin_amdgcn_rcpf(1.0f + __builtin_amdgcn_exp2f(-x * LOG2E)); }
__device__ __forceinline__ int otid() { int t = threadIdx.x; asm volatile("" : "+v"(t)); return t; }
__device__ __forceinline__ int crow(int r, int hi) { return (r & 3) + 8 * (r >> 2) + 4 * hi; }


struct RowScale {
    const float* ss;
    __device__ __forceinline__ void rs_issue(const pg8::Unit& u, int tid, f32x4& pa, f32x4& pb) const {
        const float* p = ss + (size_t)(u.pm * 256 + (tid >> 1)) * 16 + (tid & 1) * 8; pa = GLD(f32x4, p); pb = GLD(f32x4, p + 4); }
    __device__ __forceinline__ void rs_write(int tid, const f32x4& pa, const f32x4& pb, LAS float* tab) const {
        float t = ((pa.x + pa.y) + (pa.z + pa.w)) + ((pb.x + pb.y) + (pb.z + pb.w)); t += __shfl_xor(t, 1);
        if (!(tid & 1)) tab[tid >> 1] = __builtin_amdgcn_rsqf(t * (1.f / DM) + EPS); }
};
struct EpiSwiGLU : RowScale {
    static constexpr bool PERM = true, AFTER_DRAIN = false, ROWSCALE = true, CHAIN = false;
    bf16_t* H;
    __device__ __forceinline__ void operator()(const f32x4 (&acc)[2][2][4][2], const pg8::Unit& u, int wr, int wc, int fr, int fq, const LAS float* rst) const {
        const int row0 = u.pm * 256 + wr * 64 + fr, col = u.pn * 128 + wc * 32 + 8 * fq;
#pragma unroll
        for (int ai = 0; ai < 2; ++ai)
#pragma unroll
            for (int m = 0; m < 4; ++m) {
                float h[8];
                const float rs = rst[ai * 128 + wr * 64 + m * 16 + fr];
#pragma unroll
                for (int n = 0; n < 2; ++n)
#pragma unroll
                    for (int e = 0; e < 4; ++e) { const float g = acc[ai][0][m][n][e] * rs, up = acc[ai][1][m][n][e] * rs; h[n * 4 + e] = g * sigmoidf_(g) * up; }
                u32x4 w; w.x = pg8::cvt_pk_bf16(h[0], h[1]); w.y = pg8::cvt_pk_bf16(h[2], h[3]); w.z = pg8::cvt_pk_bf16(h[4], h[5]); w.w = pg8::cvt_pk_bf16(h[6], h[7]);
                GST(u32x4, H + (size_t)(row0 + ai * 128 + m * 16) * DFF + col, w);
            }
    }
};
template <bool BF32, bool OF32> struct EpiResidT {
    static constexpr bool PERM = false, AFTER_DRAIN = false, ROWSCALE = false, CHAIN = false;
    const void* base; void* out; float alpha; float* ss;
    __device__ __forceinline__ void operator()(const f32x4 (&acc)[2][2][4][2], const pg8::Unit& u, int wr, int wc, int fr, int fq) const {
        const int row0 = u.pm * 256 + wr * 64 + fr, col0 = u.pn * 256 + wc * 32 + 4 * fq;
#pragma unroll
        for (int ai = 0; ai < 2; ++ai) {
            f32x4 bv[4][2][2];
#pragma unroll
            for (int m = 0; m < 4; ++m) {
                const size_t off = (size_t)(row0 + ai * 128 + m * 16) * DM + col0;
#pragma unroll
                for (int bj = 0; bj < 2; ++bj)
#pragma unroll
                    for (int n = 0; n < 2; ++n) {
                        if (BF32) bv[m][bj][n] = GLD(f32x4, (const float*)base + off + bj * 128 + n * 16);
                        else { const u32x2 w = GLD(u32x2, (const bf16_t*)base + off + bj * 128 + n * 16);
                               bv[m][bj][n] = (f32x4){__builtin_bit_cast(float, w.x << 16), __builtin_bit_cast(float, w.x & 0xffff0000u), __builtin_bit_cast(float, w.y << 16), __builtin_bit_cast(float, w.y & 0xffff0000u)}; }
                    }
            }
#pragma unroll
            for (int m = 0; m < 4; ++m) {
                const int row = row0 + ai * 128 + m * 16;
                const size_t off = (size_t)row * DM + col0;
                float sq = 0.f;
#pragma unroll
                for (int bj = 0; bj < 2; ++bj)
#pragma unroll
                    for (int n = 0; n < 2; ++n) {
                        const f32x4 o = bv[m][bj][n] + acc[ai][bj][m][n] * alpha;
                        sq += (o.x * o.x + o.y * o.y) + (o.z * o.z + o.w * o.w);
                        if (OF32) GST(f32x4, (float*)out + off + bj * 128 + n * 16, o);
                        else { u32x2 w; w.x = pg8::cvt_pk_bf16(o.x, o.y); w.y = pg8::cvt_pk_bf16(o.z, o.w); GST(u32x2, (bf16_t*)out + off + bj * 128 + n * 16, w); }
                    }
                if (!OF32) { sq += __shfl_xor(sq, 16); sq += __shfl_xor(sq, 32); if (fq == 0) GST(float, ss + (size_t)row * 16 + u.pn * 4 + wc, sq); }
            }
        }
    }
};
struct PairOrder {
    pg8::StaticOrder S;
    __device__ void init(int G_, int c_) { S.init(MTOK, DM, G_, c_); }
    __device__ bool next(int i, pg8::Unit& u) const { if (!S.next(i >> 1, u)) return false; if (i & 1) { u.pm += MTOK / 256; u.pn += DM / 256; } return true; }
    __device__ __forceinline__ void a_ready(const pg8::Unit&) const {}
    __device__ __forceinline__ void done(const pg8::Unit&) const {}
};
struct EpiMerge {
    static constexpr bool PERM = true, AFTER_DRAIN = false, ROWSCALE = false, CHAIN = true;
    const unsigned char* MG; bf16_t* O;
    __device__ __forceinline__ void chain(f32x4 (&acc)[2][2][4][2], const pg8::Unit& u, int wr, int wc, int fr, int fq) const {
        const int row0 = u.pm * 256 + wr * 64 + fr, col0 = u.pn * 256 + wc * 32 + 8 * fq;
#pragma unroll
        for (int ai = 0; ai < 2; ++ai) {
            u32x2 g0[4][2], g1[4][2];
#pragma unroll
            for (int m = 0; m < 4; ++m)
#pragma unroll
                for (int bj = 0; bj < 2; ++bj) { const unsigned char* p = MG + (size_t)(row0 + ai * 128 + m * 16) * 2048 + col0 + bj * 128; g0[m][bj] = GLD(u32x2, p); g1[m][bj] = GLD(u32x2, p + 1024); }
#pragma unroll
            for (int m = 0; m < 4; ++m)
#pragma unroll
                for (int bj = 0; bj < 2; ++bj)
#pragma unroll
                    for (int i = 0; i < 8; ++i) {
                        const unsigned q0 = (g0[m][bj][i >> 2] >> (8 * (i & 3))) & 0xffu, q1 = (g1[m][bj][i >> 2] >> (8 * (i & 3))) & 0xffu;
                        acc[ai][bj][m][i >> 2][i & 3] *= (float)q0 * __builtin_amdgcn_rcpf((float)(q1 ? q1 : 1u));
                    }
        }
    }
    __device__ __forceinline__ void operator()(const f32x4 (&acc)[2][2][4][2], const pg8::Unit& u, int wr, int wc, int fr, int fq) const {
        const int row0 = (u.pm - MTOK / 256) * 256 + wr * 64 + fr, col0 = (u.pn - DM / 256) * 256 + wc * 32 + 8 * fq;
#pragma unroll
        for (int ai = 0; ai < 2; ++ai) {
            u32x2 g1[4][2];
#pragma unroll
            for (int m = 0; m < 4; ++m)
#pragma unroll
                for (int bj = 0; bj < 2; ++bj) g1[m][bj] = GLD(u32x2, MG + (size_t)(row0 + ai * 128 + m * 16) * 2048 + 1024 + col0 + bj * 128);
#pragma unroll
            for (int m = 0; m < 4; ++m)
#pragma unroll
                for (int bj = 0; bj < 2; ++bj) {
                    float h[8];
#pragma unroll
                    for (int i = 0; i < 8; ++i) { const unsigned q1 = (g1[m][bj][i >> 2] >> (8 * (i & 3))) & 0xffu; h[i] = acc[ai][bj][m][i >> 2][i & 3] * ((float)(q1 ? q1 : 1u) * (1.f / 255.f)); }
                    u32x4 w; w.x = pg8::cvt_pk_bf16(h[0], h[1]); w.y = pg8::cvt_pk_bf16(h[2], h[3]); w.z = pg8::cvt_pk_bf16(h[4], h[5]); w.w = pg8::cvt_pk_bf16(h[6], h[7]);
                    GST(u32x4, O + (size_t)(row0 + ai * 128 + m * 16) * DM + col0 + bj * 128, w);
                }
        }
    }
};
struct EpiZ : RowScale {
    static constexpr bool PERM = true, AFTER_DRAIN = false, ROWSCALE = true, CHAIN = false;
    unsigned char* ws; const float *gq, *gk, *gnq, *gnk;
    __device__ __forceinline__ void operator()(const f32x4 (&acc)[2][2][4][2], const pg8::Unit& u, int wr, int wc, int fr, int fq, const LAS float* rst) const {
        const int ch = 4 * u.pn + wc;
        if (ch >= 77) return;
        const int row0 = u.pm * 256 + wr * 64 + fr;
        int kind, nh = 8, hd = 0, nd = 64, dbase = 0; size_t dst = 0; const float* gain = nullptr; float scale = 1.f;
        if (ch < 8) { kind = 0; dst = Z_DQ; hd = ch; gain = gq; scale = QSCALE; }
        else if (ch < 16) { kind = 0; dst = Z_DK; hd = ch - 8; gain = gk; }
        else if (ch < 24) { kind = 2; dst = Z_DVT; nh = 4; hd = (ch - 16) >> 1; nd = 128; dbase = ((ch - 16) & 1) * 64; }
        else if (ch < 32) { kind = 0; dst = Z_NQ; hd = ch - 24; gain = gnq; scale = QSCALE; }
        else if (ch < 34) { kind = 1; dst = Z_KCR; nh = 2; hd = ch - 32; }
        else if (ch < 36) { kind = 1; dst = Z_VCR; nh = 2; hd = ch - 34; }
        else if (ch < 38) { kind = 0; dst = Z_KSEL; nh = 2; hd = ch - 36; gain = gnk + 64; }
        else if (ch < 40) { kind = 2; dst = Z_VSELT; nh = 2; hd = ch - 38; }
        else if (ch < 42) { kind = 0; dst = Z_KWIN; nh = 2; hd = ch - 40; gain = gnk + 128; }
        else if (ch < 44) { kind = 2; dst = Z_VWINT; nh = 2; hd = ch - 42; }
        else if (ch < 76) { kind = 3; }
        else { kind = 4; }
        if (kind == 0 || kind == 1) {
            float gv[16];
#pragma unroll
            for (int i = 0; i < 16; ++i) gv[i] = (kind == 0) ? gain[(i >> 3) * 32 + 8 * fq + (i & 7)] * scale : 1.f;
#pragma unroll
            for (int ai = 0; ai < 2; ++ai)
#pragma unroll
                for (int m = 0; m < 4; ++m) {
                    const int row = row0 + ai * 128 + m * 16, b = row >> 12, s = row & 4095;
                    float v[16];
                    const float rrs = rst[ai * 128 + wr * 64 + m * 16 + fr];
#pragma unroll
                    for (int i = 0; i < 16; ++i) v[i] = acc[ai][i >> 3][m][(i >> 2) & 1][i & 3] * rrs;
                    float rs = 1.f;
                    if (kind == 0) {
                        float ss = 0.f;
#pragma unroll
                        for (int i = 0; i < 16; ++i) ss += v[i] * v[i];
                        ss += __shfl_xor(ss, 16); ss += __shfl_xor(ss, 32);
                        rs = __builtin_amdgcn_rsqf(ss * (1.f / 64.f) + EPS);
                    }
#pragma unroll
                    for (int i = 0; i < 16; ++i) v[i] *= rs * gv[i];
                    bf16_t* d = (bf16_t*)(ws + dst) + ((size_t)(b * nh + hd) * SEQ + s) * 64 + 8 * fq;
                    u32x4 w0, w1;
                    w0.x = pg8::cvt_pk_bf16(v[0], v[1]); w0.y = pg8::cvt_pk_bf16(v[2], v[3]); w0.z = pg8::cvt_pk_bf16(v[4], v[5]); w0.w = pg8::cvt_pk_bf16(v[6], v[7]);
                    w1.x = pg8::cvt_pk_bf16(v[8], v[9]); w1.y = pg8::cvt_pk_bf16(v[10], v[11]); w1.z = pg8::cvt_pk_bf16(v[12], v[13]); w1.w = pg8::cvt_pk_bf16(v[14], v[15]);
                    GST(u32x4, d, w0); GST(u32x4, d + 32, w1);
                }
        } else if (kind == 2) {
#pragma unroll
            for (int ai = 0; ai < 2; ++ai)
#pragma unroll
                for (int m = 0; m < 4; ++m) {
                    const int row = row0 + ai * 128 + m * 16, b = row >> 12, s = row & 4095;
                    bf16_t* d = (bf16_t*)(ws + dst) + ((size_t)(b * nh + hd) * nd + dbase + 8 * fq) * SEQ + s;
                    const float rrs = rst[ai * 128 + wr * 64 + m * 16 + fr];
#pragma unroll
                    for (int i = 0; i < 16; ++i) GST(bf16_t, d + (size_t)((i >> 3) * 32 + (i & 7)) * SEQ, (bf16_t)f2bf(acc[ai][i >> 3][m][(i >> 2) & 1][i & 3] * rrs));
                }
        } else if (kind == 3) {
            const int col = (ch - 44) * 64 + 8 * fq;
#pragma unroll
            for (int ai = 0; ai < 2; ++ai)
#pragma unroll
                for (int m = 0; m < 4; ++m) {
                    const int row = row0 + ai * 128 + m * 16;
                    float v[16];
                    const float rrs = rst[ai * 128 + wr * 64 + m * 16 + fr];
#pragma unroll
                    for (int i = 0; i < 16; ++i) v[i] = sigmoidf_(acc[ai][i >> 3][m][(i >> 2) & 1][i & 3] * rrs);
                    unsigned char* d = (unsigned char*)(ws + Z_MG) + (size_t)row * 2048 + col;
                    unsigned q[16];
#pragma unroll
                    for (int i = 0; i < 16; ++i) q[i] = (unsigned)__builtin_rintf(v[i] * 255.f);
                    u32x2 w0, w1;
                    w0.x = q[0] | (q[1] << 8) | (q[2] << 16) | (q[3] << 24); w0.y = q[4] | (q[5] << 8) | (q[6] << 16) | (q[7] << 24);
                    w1.x = q[8] | (q[9] << 8) | (q[10] << 16) | (q[11] << 24); w1.y = q[12] | (q[13] << 8) | (q[14] << 16) | (q[15] << 24);
                    GST(u32x2, d, w0); GST(u32x2, d + 32, w1);
                }
        } else {
            if (fq < 3) {
#pragma unroll
                for (int ai = 0; ai < 2; ++ai)
#pragma unroll
                    for (int m = 0; m < 4; ++m) {
                        const int row = row0 + ai * 128 + m * 16;
                        float* d = (float*)(ws + Z_NG) + (size_t)row * 24 + 8 * fq;
                        const float rrs = rst[ai * 128 + wr * 64 + m * 16 + fr];
#pragma unroll
                        for (int i = 0; i < 8; ++i) GST(float, d + i, sigmoidf_(acc[ai][0][m][i >> 2][i & 3] * rrs));
                    }
            }
        }
    }
};

__device__ __forceinline__ void tr_item(const float* src, int ld, int c0, int nvalid, int k0, bf16_t* dst, int Kdst, LAS float* scr, int lane, const float* rsc = nullptr) {
    const int n = lane & 31;
#pragma unroll
    for (int i = 0; i < 32; ++i) { const int kk = 2 * i + (lane >> 5); scr[kk * 33 + n] = (src && n < nvalid) ? GLD(float, src + (size_t)(k0 + kk) * ld + c0 + n) * (rsc ? GLD(float, rsc + k0 + kk) : 1.f) : 0.f; }
    asm volatile("s_waitcnt lgkmcnt(0)" ::: "memory");
    const int c = lane & 7;
#pragma unroll
    for (int j = 0; j < 4; ++j) { const int nn = (lane >> 3) + 8 * j; const LAS float* s = scr + (8 * c) * 33 + nn;
        u32x4 o; o.x = pk2(s[0 * 33], s[1 * 33]); o.y = pk2(s[2 * 33], s[3 * 33]); o.z = pk2(s[4 * 33], s[5 * 33]); o.w = pk2(s[6 * 33], s[7 * 33]);
        GST(u32x4, dst + (size_t)nn * Kdst + 8 * c, o); }
    asm volatile("s_waitcnt lgkmcnt(0)" ::: "memory");
}
__device__ __forceinline__ int zchunk_src(int ch) {
    if (ch < 32) return ch * 64;
    if (ch < 44) return 2048 + (ch - 32) * 64;
    if (ch < 76) return 2840 + (ch - 44) * 64;
    return 2816;
}
__device__ __forceinline__ int t5_bucket(int n) {
    if (n < 16) return n;
    int b = 16;
    b += (n >= 21); b += (n >= 27); b += (n >= 35); b += (n >= 46); b += (n >= 59); b += (n >= 77); b += (n >= 99); b += (n >= 128);
    b += (n >= 166); b += (n >= 216); b += (n >= 280); b += (n >= 363); b += (n >= 470); b += (n >= 609); b += (n >= 790);
    return b;
}
__device__ __forceinline__ void prologue(const Params& P, LAS unsigned char* lds) {
    const int tid = otid(), lane = tid & 63, wave = tid >> 6;
    LAS float* scr = (LAS float*)(lds + wave * 16384);
    const int gw = blockIdx.x * NWAVE + wave, NGW = gridDim.x * NWAVE;
    unsigned char* ws = WSP;
    constexpr int I13 = 176 * 16, I2 = 32 * 44, IIN = 160 * 16, IPAB = 64 * 8, IWO = 32 * 16, IC1 = 4 * 32, IC2 = 2 * 2;
    constexpr int PER_L = 2 * I13 + 2 * I2 + IIN + IPAB + IWO + 2 * IC1 + 2 * IC2;
    for (int it = gw; it < DEPTH * PER_L; it += NGW) {
        const int l = it / PER_L; int r = it % PER_L;
        if (r < 2 * I13) {
            const int f = r / I13; r %= I13; const int gi = r / 16, kb = r % 16;
            const int t = gi >> 3, bj = (gi >> 2) & 1, sub = gi & 3;
            const float* src = (f ? (bj ? INP(12) : INP(11)) : (bj ? INP(9) : INP(8))) + (size_t)l * DM * DFF;
            tr_item(src, DFF, 128 * t + 32 * sub, 32, 64 * kb, (bf16_t*)(ws + WS_W13 + (size_t)(l * 2 + f) * W13_SZ) + (size_t)(32 * gi) * DM + 64 * kb, DM, scr, lane, (f ? INP(7) : INP(5)) + l * DM);
            continue;
        }
        r -= 2 * I13;
        if (r < 2 * I2) {
            const int f = r / I2; r %= I2; const int gi = r / 44, kb = r % 44;
            const float* src = (f ? INP(13) : INP(10)) + (size_t)l * DFF * DM;
            tr_item(src, DM, 32 * gi, 32, 64 * kb, (bf16_t*)(ws + WS_W2 + (size_t)(l * 2 + f) * W2_SZ) + (size_t)(32 * gi) * DFF + 64 * kb, DFF, scr, lane);
            continue;
        }
        r -= 2 * I2;
        if (r < IIN) {
            const int gi = r / 16, kb = r % 16;
            const int t = gi >> 3, bj = (gi >> 2) & 1, wc = gi & 3, ch = 4 * t + wc;
            int nvalid = 32; if (ch == 76) nvalid = bj ? 0 : 24; if (ch > 76) nvalid = 0;
            const float* src = nvalid ? INP(1) + (size_t)l * DM * NIN : nullptr;
            tr_item(src, NIN, zchunk_src(ch) + 32 * bj, nvalid, 64 * kb, (bf16_t*)(ws + WS_WIN + (size_t)l * WIN_SZ) + (size_t)(32 * gi) * DM + 64 * kb, DM, scr, lane, INP(6) + l * DM);
            continue;
        }
        r -= IIN;
        if (r < IPAB) {
            const int gi = r / 8, kb = r % 8;
            const float* src = (gi < 32 ? INP(2) : INP(3)) + (size_t)l * 512 * DM;
            tr_item(src, DM, 32 * (gi & 31), 32, 64 * kb, (bf16_t*)(ws + WS_PAB + (size_t)l * PAB_SZ) + (size_t)(32 * gi) * 512 + 64 * kb, 512, scr, lane);
            continue;
        }
        r -= IPAB;
        if (r < IWO) {
            const int gi = r / 16, kb = r % 16;
            tr_item(INP(4) + (size_t)l * DM * DM, DM, 32 * gi, 32, 64 * kb, (bf16_t*)(ws + WS_WO + (size_t)l * WO_SZ) + (size_t)(32 * gi) * DM + 64 * kb, DM, scr, lane);
            continue;
        }
        r -= IWO;
        if (r < 2 * IC1) {
            const int kv = r / IC1; r %= IC1; const int gi = r / 32, kb = r % 32;
            tr_item((kv ? INP(27) : INP(24)) + (size_t)l * 2048 * 128, 128, 32 * gi, 32, 64 * kb, (bf16_t*)(ws + WS_CW1 + (size_t)(l * 2 + kv) * CW1_SZ) + (size_t)(32 * gi) * 2048 + 64 * kb, 2048, scr, lane);
            continue;
        }
        r -= 2 * IC1;
        {
            const int kv = r / IC2; r %= IC2; const int gi = r / 2, kb = r % 2;
            tr_item((kv ? INP(28) : INP(25)) + (size_t)l * 128 * 64, 64, 32 * gi, 32, 64 * kb, (bf16_t*)(ws + WS_CW2 + (size_t)(l * 2 + kv) * CW2_SZ) + (size_t)(32 * gi) * 128 + 64 * kb, 128, scr, lane);
        }
    }
    const int gt = blockIdx.x * NTHR + tid, NGT = gridDim.x * NTHR;
    for (int i = gt; i < 12 * 1024; i += NGT) { const int h = i >> 10, d = i & 1023; ((float*)(ws + WS_BIAS))[i] = INP(29)[t5_bucket(d) * 12 + h] * LOG2E; }
    if (blockIdx.x == (gridDim.x > 1 ? 1 : 0) && wave < DEPTH) {
        const int l = wave;
        float a = INP(16)[l * 64 + lane] * INP(17)[l * 64 + lane], b = INP(18)[l * 64 + lane] * INP(19)[l * 64 + lane];
        float mq = fabsf(INP(14)[l * 64 + lane]), mk = fabsf(INP(15)[l * 64 + lane]), mnq = fabsf(INP(21)[l * 64 + lane]);
        float mnk = fmaxf(fmaxf(fabsf(INP(22)[l * 192 + lane]), fabsf(INP(22)[l * 192 + 64 + lane])), fabsf(INP(22)[l * 192 + 128 + lane]));
        float mb = 0.f; for (int i = lane; i < 32 * 12; i += 64) mb = fmaxf(mb, fabsf(INP(29)[i]));
#pragma unroll
        for (int o = 1; o < 64; o <<= 1) { a += __shfl_xor(a, o); b += __shfl_xor(b, o); mq = fmaxf(mq, __shfl_xor(mq, o)); mk = fmaxf(mk, __shfl_xor(mk, o)); mnq = fmaxf(mnq, __shfl_xor(mnq, o)); mnk = fmaxf(mnk, __shfl_xor(mnk, o)); mb = fmaxf(mb, __shfl_xor(mb, o)); }
        if (lane == 0) {
            float* prm = (float*)(ws + WS_PRM) + l * 8;
            const float lam_init = 0.8f - 0.6f * expf(-0.3f * (float)l);
            prm[0] = expf(a) - expf(b) + lam_init;
            prm[1] = (8.f * mq * mk * 1.02f + mb) * LOG2E;
            prm[2] = (8.f * mnq * mnk * 1.02f + mb) * LOG2E;
            prm[3] = 1.0f - lam_init;
        }
    }
    for (int wi = blockIdx.x; wi < 32; wi += gridDim.x) {
        const int lk = wi >> 3, n = (wi & 7) * 16 + (tid & 15), ks = tid >> 4, l = lk >> 1, kv = lk & 1;
        const float* pe = (kv ? INP(26) : INP(23)) + (size_t)l * 2048; const float* w1 = (kv ? INP(27) : INP(24)) + (size_t)l * 2048 * 128;
        float sacc = 0.f;
#pragma unroll 16
        for (int k = 64 * ks; k < 64 * ks + 64; ++k) sacc += GLD(float, pe + k) * GLD(float, w1 + (size_t)k * 128 + n);
        LAS float* red = (LAS float*)lds;
        __syncthreads();
        red[tid] = sacc;
        __syncthreads();
        if (tid < 16) { float t = 0.f; for (int i = 0; i < 32; ++i) t += red[i * 16 + tid]; ((float*)(ws + WS_CB1))[lk * 128 + (wi & 7) * 16 + tid] = t; }
        __syncthreads();
    }
}

template <bool INBF16, bool COPYRAW>
__device__ __forceinline__ void rmsnorm_phase(const void* x, const float* g, bf16_t* o, bf16_t* xraw = nullptr) {
    const int tid = otid(), lane = tid & 63, wave = tid >> 6;
    const int gw = blockIdx.x * NWAVE + wave, NGW = gridDim.x * NWAVE;
    f32x4 gv[4];
#pragma unroll
    for (int j = 0; j < 4; ++j) gv[j] = GLD(f32x4, (const f32x4*)g + lane + 64 * j);
    constexpr int RB = 4;
    for (int m0 = gw; m0 < MTOK; m0 += NGW * RB) {
        f32x4 v[RB][4]; float s[RB];
#pragma unroll
        for (int r = 0; r < RB; ++r) { const int m = m0 + r * NGW; const size_t ro = (size_t)(m < MTOK ? m : m0) * DM;
#pragma unroll
            for (int j = 0; j < 4; ++j) {
                if (!INBF16) v[r][j] = GLD(f32x4, (const f32x4*)((const float*)x + ro) + lane + 64 * j);
                else { const u32x2 w = GLD(u32x2, (const u32x2*)((const bf16_t*)x + ro) + lane + 64 * j);
                       if (COPYRAW && m < MTOK) GST(u32x2, (u32x2*)(xraw + ro) + lane + 64 * j, w);
                       v[r][j] = (f32x4){__builtin_bit_cast(float, w.x << 16), __builtin_bit_cast(float, w.x & 0xffff0000u), __builtin_bit_cast(float, w.y << 16), __builtin_bit_cast(float, w.y & 0xffff0000u)}; }
            } }
#pragma unroll
        for (int r = 0; r < RB; ++r) { s[r] = 0.f;
#pragma unroll
            for (int j = 0; j < 4; ++j) s[r] += (v[r][j].x * v[r][j].x + v[r][j].y * v[r][j].y) + (v[r][j].z * v[r][j].z + v[r][j].w * v[r][j].w); }
#pragma unroll
        for (int of = 1; of < 64; of <<= 1) {
#pragma unroll
            for (int r = 0; r < RB; ++r) s[r] += __shfl_xor(s[r], of); }
#pragma unroll
        for (int r = 0; r < RB; ++r) { const int m = m0 + r * NGW;
            if (m < MTOK) {
                const float rs = __builtin_amdgcn_rsqf(s[r] * (1.f / DM) + EPS);
                u32x2* o8 = (u32x2*)(o + (size_t)m * DM) + lane;
#pragma unroll
                for (int j = 0; j < 4; ++j) { u32x2 w; w.x = pk2(v[r][j].x * rs * gv[j].x, v[r][j].y * rs * gv[j].y); w.y = pk2(v[r][j].z * rs * gv[j].z, v[r][j].w * rs * gv[j].w); GST(u32x2, o8 + 64 * j, w); }
            }
        }
    }
}

__device__ __forceinline__ void xprep_phase(const float* x, bf16_t* o, float* ss) {
    const int tid = otid(), lane = tid & 63, wave = tid >> 6;
    const int gw = blockIdx.x * NWAVE + wave, NGW = gridDim.x * NWAVE;
    for (int m = gw; m < MTOK; m += NGW) {
        const f32x4* xr = (const f32x4*)(x + (size_t)m * DM) + lane;
        f32x4 v[4]; float s = 0.f;
#pragma unroll
        for (int j = 0; j < 4; ++j) { v[j] = GLD(f32x4, xr + 64 * j); s += (v[j].x * v[j].x + v[j].y * v[j].y) + (v[j].z * v[j].z + v[j].w * v[j].w); }
#pragma unroll
        for (int of = 1; of < 64; of <<= 1) s += __shfl_xor(s, of);
        u32x2* o8 = (u32x2*)(o + (size_t)m * DM) + lane;
#pragma unroll
        for (int j = 0; j < 4; ++j) { u32x2 w; w.x = pk2(v[j].x, v[j].y); w.y = pk2(v[j].z, v[j].w); GST(u32x2, o8 + 64 * j, w); }
        if (lane < 16) GST(float, ss + (size_t)m * 16 + lane, lane == 0 ? s : 0.f);
    }
}

__device__ __forceinline__ float gelu_tanh(float x) {
    const float y = 0.7978845608028654f * (x + 0.044715f * x * x * x);
    const float e = __builtin_amdgcn_exp2f(2.f * LOG2E * y);
    const float t = 1.f - 2.f * __builtin_amdgcn_rcpf(e + 1.f);
    return 0.5f * x * (1.f + t);
}
__device__ __forceinline__ void compress_phase(const Params& P, int l, LAS unsigned char* lds) {
    const int tid = otid(), lane = tid & 63, wave = tid >> 6, fr = lane & 15, kq = lane >> 4;
    unsigned char* ws = WSP;
    LAS bf16_t* Hs = (LAS bf16_t*)lds;
    LAS float* Os = (LAS float*)(lds + 8704);
    LAS unsigned char* As = lds + 17408;
    for (int unit = blockIdx.x; unit < 2 * 16 * 8; unit += gridDim.x) {
        const int kv = unit >> 7, bg = (unit >> 3) & 15, c0 = 32 * (unit & 7);
        const bf16_t* src = (const bf16_t*)(ws + (kv ? Z_VCR : Z_KCR)) + (size_t)bg * SEQ * 64;
        for (int i = tid; i < 33 * 128; i += NTHR) {
            const int j = i >> 7, pc = i & 127;
            u32x4 v = {0u, 0u, 0u, 0u};
            if (c0 + j <= 255) v = GLD(u32x4, (const unsigned char*)(src + (size_t)1024 * (c0 + j)) + pc * 16);
            *(LAS u32x4*)(As + j * 2064 + pc * 16) = v;
        }
        __syncthreads();
        const bf16_t* bp = (const bf16_t*)(ws + WS_CW1 + (size_t)(l * 2 + kv) * CW1_SZ) + (size_t)(16 * wave + fr) * 2048 + 8 * kq;
        f32x4 acc0 = {0.f, 0.f, 0.f, 0.f}, acc1 = {0.f, 0.f, 0.f, 0.f};
#pragma unroll
        for (int kb = 0; kb < 4; ++kb) {
            bf16x8 bfr[16];
#pragma unroll
            for (int i = 0; i < 16; ++i) bfr[i] = GLD(bf16x8, bp + 32 * (16 * kb + i));
#pragma unroll
            for (int i = 0; i < 16; ++i) {
                const int k = 32 * (16 * kb + i) + 8 * kq;
                const LAS unsigned char* ar = As + (fr + (k >> 10)) * 2064 + (k & 1023) * 2;
                const bf16x8 a0 = *(const LAS bf16x8*)ar, a1 = *(const LAS bf16x8*)(ar + 16 * 2064);
                acc0 = __builtin_amdgcn_mfma_f32_16x16x32_bf16(a0, bfr[i], acc0, 0, 0, 0);
                acc1 = __builtin_amdgcn_mfma_f32_16x16x32_bf16(a1, bfr[i], acc1, 0, 0, 0);
            }
        }
        const float cb = ((const float*)(ws + WS_CB1))[(l * 2 + kv) * 128 + 16 * wave + fr];
#pragma unroll
        for (int i = 0; i < 4; ++i) { Hs[(4 * kq + i) * 136 + 16 * wave + fr] = (bf16_t)f2bf(gelu_tanh(acc0[i] + cb)); Hs[(16 + 4 * kq + i) * 136 + 16 * wave + fr] = (bf16_t)f2bf(gelu_tanh(acc1[i] + cb)); }
        __syncthreads();
        {
            const int mt = wave >> 2, ns = wave & 3;
            const bf16_t* b2 = (const bf16_t*)(ws + WS_CW2 + (size_t)(l * 2 + kv) * CW2_SZ) + (size_t)(16 * ns + fr) * 128 + 8 * kq;
            f32x4 a2 = {0.f, 0.f, 0.f, 0.f};
#pragma unroll
            for (int kk = 0; kk < 4; ++kk) { const bf16x8 a = *(const LAS bf16x8*)(Hs + (16 * mt + fr) * 136 + 32 * kk + 8 * kq), b = GLD(bf16x8, b2 + 32 * kk); a2 = __builtin_amdgcn_mfma_f32_16x16x32_bf16(a, b, a2, 0, 0, 0); }
#pragma unroll
            for (int i = 0; i < 4; ++i) Os[(16 * mt + 4 * kq + i) * 65 + 16 * ns + fr] = a2[i];
        }
        __syncthreads();
#pragma unroll
        for (int rep = 0; rep < 4; ++rep) {
            const int e = tid + NTHR * rep, row = e >> 6, d = e & 63, c = c0 + row;
            const float val = Os[row * 65 + d];
            if (kv == 0) {
                float ss = 0.f;
#pragma unroll 16
                for (int j = 0; j < 64; ++j) { const float t = Os[row * 65 + j]; ss += t * t; }
                const float o = val * __builtin_amdgcn_rsqf(ss * (1.f / 64.f) + EPS) * GLD(float, INP(22) + l * 192 + d);
                GST(bf16_t, (bf16_t*)(ws + WS_KCN) + ((size_t)bg * 256 + c) * 64 + d, (c < 255) ? (bf16_t)f2bf(o) : (bf16_t)0);
            } else {
                GST(bf16_t, (bf16_t*)(ws + WS_VCT) + ((size_t)bg * 64 + d) * 256 + c, (c < 255) ? (bf16_t)f2bf(val) : (bf16_t)0);
            }
        }
        __syncthreads();
    }
}

__device__ __forceinline__ void qk_tile(f32x16& p0, f32x16& p1, const LAS unsigned char* Kl, const bf16x8 (&qf)[4], int r32, int hi) {
    const LAS unsigned char* kb = Kl + r32 * KP + hi * 16;
    bf16x8 a[8];
#pragma unroll
    for (int d0 = 0; d0 < 4; ++d0) { a[2 * d0] = *(const LAS bf16x8*)(kb + d0 * 32); a[2 * d0 + 1] = *(const LAS bf16x8*)(kb + 32 * KP + d0 * 32); }
    __builtin_amdgcn_s_setprio(1);
#pragma unroll
    for (int d0 = 0; d0 < 4; ++d0) {
        p0 = __builtin_amdgcn_mfma_f32_32x32x16_bf16(a[2 * d0], qf[d0], p0, 0, 0, 0);
        p1 = __builtin_amdgcn_mfma_f32_32x32x16_bf16(a[2 * d0 + 1], qf[d0], p1, 0, 0, 0);
    }
    __builtin_amdgcn_s_setprio(0);
}
template <int STRIDE, bool WINDOW, int MODE>
__device__ __forceinline__ void score_exp(f32x16& p0, f32x16& p1, int dl, const LAS float* tb, float cfar, bool rowsel) {
    const LAS float* tl = tb + 128 + (dl < 1087 ? dl : 1087) - 59;
#pragma unroll
    for (int blk = 0; blk < 2; ++blk) {
        f32x16& p = blk ? p1 : p0;
#pragma unroll
        for (int r = 0; r < 16; ++r) {
            const int c = (r & 3) + 8 * (r >> 2) + 32 * blk;
            const int dist = dl - STRIDE * c;
            float e;
            if (MODE == 0) e = __builtin_amdgcn_exp2f(p[r] + cfar);
            else {
                float bias;
                if (STRIDE == 1) bias = tl[59 - c];
                else bias = tb[128 + min((unsigned)dist, 1023u)];
                e = __builtin_amdgcn_exp2f(p[r] + bias);
                if (MODE == 2) { bool valid = dist >= 0; if (WINDOW) valid = valid && (dist < 512); e = valid ? e : 0.f; }
            }
            p[r] = rowsel ? e : 0.f;
        }
    }
}
template <int STRIDE, bool WINDOW>
__device__ __forceinline__ void score_exp_sel(f32x16& p0, f32x16& p1, int dl, const LAS float* tb, float cfar, bool rowsel, int dmin, int dmax) {
    if (!WINDOW && dmin >= 790) score_exp<STRIDE, WINDOW, 0>(p0, p1, dl, tb, cfar, rowsel);
    else if (dmin >= 0 && (!WINDOW || dmax < 512)) score_exp<STRIDE, WINDOW, 1>(p0, p1, dl, tb, cfar, rowsel);
    else score_exp<STRIDE, WINDOW, 2>(p0, p1, dl, tb, cfar, rowsel);
}
__device__ __forceinline__ float sum32(const f32x16& p0, const f32x16& p1) {
    float a = 0.f, b = 0.f;
#pragma unroll
    for (int r = 0; r < 16; ++r) { a += p0[r]; b += p1[r]; }
    return a + b;
}
template <int NDB>
__device__ __forceinline__ void pv_tile(f32x16 (&o)[NDB], const f32x16& p0, const f32x16& p1, const LAS unsigned char* Vl, int r32, int hi) {
    const LAS unsigned char* vbase = Vl + r32 * VP + hi * 8;
    bf16x4 vf[2][NDB][2];
#define PV_LOAD(st, buf) do { _Pragma("unroll") for (int db = 0; db < NDB; ++db) { const LAS unsigned char* vp = vbase + db * 32 * VP + (st) * 32; vf[buf][db][0] = *(const LAS bf16x4*)vp; vf[buf][db][1] = *(const LAS bf16x4*)(vp + 16); } } while (0)
    PV_LOAD(0, 0);
#pragma unroll
    for (int st = 0; st < 4; ++st) {
        if (st + 1 < 4) PV_LOAD(st + 1, (st + 1) & 1);
        const f32x16& p = (st >> 1) ? p1 : p0; const int s8 = 8 * (st & 1);
        u32x4 w; w.x = pg8::cvt_pk_bf16(p[s8 + 0], p[s8 + 1]); w.y = pg8::cvt_pk_bf16(p[s8 + 2], p[s8 + 3]); w.z = pg8::cvt_pk_bf16(p[s8 + 4], p[s8 + 5]); w.w = pg8::cvt_pk_bf16(p[s8 + 6], p[s8 + 7]);
        const bf16x8 pa = __builtin_bit_cast(bf16x8, w);
        __builtin_amdgcn_s_setprio(1);
#pragma unroll
        for (int db = 0; db < NDB; ++db) {
            const bf16x4 lo = vf[st & 1][db][0], hi4 = vf[st & 1][db][1];
            const bf16x8 vb = {lo[0], lo[1], lo[2], lo[3], hi4[0], hi4[1], hi4[2], hi4[3]};
            o[db] = __builtin_amdgcn_mfma_f32_32x32x16_bf16(pa, vb, o[db], 0, 0, 0);
        }
        __builtin_amdgcn_s_setprio(0);
    }
#undef PV_LOAD
}
__device__ __forceinline__ u32x4 ldk(const bf16_t* g, int tid) { return GLD(u32x4, (const unsigned char*)g + tid * 16); }
__device__ __forceinline__ void stk(LAS unsigned char* Kl, u32x4 v, int tid) { *(LAS u32x4*)(Kl + (tid >> 3) * KP + (tid & 7) * 16) = v; }
__device__ __forceinline__ u32x4 ldv(const bf16_t* g, size_t rs, int row, int tid) { return GLD(u32x4, (const unsigned char*)(g + (size_t)row * rs) + (tid & 7) * 16); }
__device__ __forceinline__ void stv(LAS unsigned char* Vl, u32x4 v, int row, int tid) { LAS unsigned char* p = Vl + row * VP + (tid & 7) * 16; *(LAS u32x2*)p = (u32x2){v.x, v.y}; *(LAS u32x2*)(p + 8) = (u32x2){v.z, v.w}; }

__device__ __forceinline__ void da_unit(const Params& P, int l, int b, int h, int qb, LAS unsigned char* lds, bool load_tab) {
    const int tid = otid(), lane = tid & 63, wave = __builtin_amdgcn_readfirstlane(tid >> 6), r32 = lane & 31, hi = lane >> 5;
    const int c = wave >> 2, qsub = wave & 3, q0 = qb * 128, qw0 = q0 + 32 * qsub;
    unsigned char* ws = WSP;
    const float* prm = (const float*)(ws + WS_PRM) + l * 8;
    const float lam = prm[0], Mb = prm[1], onem = prm[3];
    LAS float* biasL = (LAS float*)(lds + L_BIAS);
    const float* bg = (const float*)(ws + WS_BIAS) + h * 1024;
    if (load_tab) for (int i = tid; i < TBN; i += NTHR) { const int d = i - 128; biasL[i] = GLD(float, bg + (d < 0 ? 0 : (d > 1023 ? 1023 : d))) - Mb; }
    const float cfar = bg[1023] - Mb;
    const bf16_t* Qp = (const bf16_t*)(ws + Z_DQ) + ((size_t)(b * 8 + h * 2 + c) * SEQ + qw0 + r32) * 64 + hi * 8;
    bf16x8 qf[4];
#pragma unroll
    for (int d0 = 0; d0 < 4; ++d0) qf[d0] = GLD(bf16x8, Qp + d0 * 16);
    const bf16_t* K1g = (const bf16_t*)(ws + Z_DK) + (size_t)(b * 8 + h * 2) * SEQ * 64;
    const bf16_t* K2g = K1g + (size_t)SEQ * 64;
    const bf16_t* Vg = (const bf16_t*)(ws + Z_DVT) + (size_t)(b * 4 + h) * 128 * SEQ;
    const int NT = (q0 + 128) / 64;
    f32x16 o[4];
#pragma unroll
    for (int i = 0; i < 4; ++i) o[i] = (f32x16){};
    float lsum = 0.f;
    u32x4 rk1, rk2, rv0, rv1;
#define DA_LOAD(t) do { rk1 = ldk(K1g + (size_t)(t) * 4096, tid); rk2 = ldk(K2g + (size_t)(t) * 4096, tid); rv0 = ldv(Vg + (t) * 64, SEQ, tid >> 3, tid); rv1 = ldv(Vg + (t) * 64, SEQ, 64 + (tid >> 3), tid); } while (0)
#define DA_STORE(sb) do { LAS unsigned char* st_ = lds + (sb) * DA_STAGE; stk(st_, rk1, tid); stk(st_ + 64 * KP, rk2, tid); stv(st_ + 128 * KP, rv0, tid >> 3, tid); stv(st_ + 128 * KP, rv1, 64 + (tid >> 3), tid); } while (0)
    DA_LOAD(0); DA_STORE(0);
    __syncthreads();
    for (int t = 0; t < NT; ++t) {
        if (t + 1 < NT) DA_LOAD(t + 1);
        if (64 * t <= qw0 + 31) {
            const LAS unsigned char* st = lds + (t & 1) * DA_STAGE;
            f32x16 p0 = (f32x16){}, p1 = (f32x16){};
            qk_tile(p0, p1, st + c * 64 * KP, qf, r32, hi);
            const int dl = qw0 + r32 - 64 * t - 4 * hi;
            score_exp_sel<1, false>(p0, p1, dl, biasL, cfar, true, qw0 - (64 * t + 63), qw0 + 31 - 64 * t);
            lsum += sum32(p0, p1);
            pv_tile<4>(o, p0, p1, st + 128 * KP, r32, hi);
        }
        if (t + 1 < NT) DA_STORE((t + 1) & 1);
        __syncthreads();
    }
#undef DA_LOAD
#undef DA_STORE
    lsum += __shfl_xor(lsum, 32);
    LAS float* wsf = (LAS float*)(lds + L_WSF) + wave * 64;
    if (hi == 0) wsf[r32] = (lsum > 0.f) ? 1.0f / lsum : 0.f;
    asm volatile("s_waitcnt lgkmcnt(0)" ::: "memory");
    float li[16];
#pragma unroll
    for (int r = 0; r < 16; ++r) li[r] = wsf[crow(r, hi)];
    LAS float* X = (LAS float*)lds;
    if (c == 1) {
#pragma unroll
        for (int db = 0; db < 4; ++db)
#pragma unroll
            for (int r = 0; r < 16; ++r) X[(32 * qsub + crow(r, hi)) * 132 + r32 + 32 * db] = o[db][r] * li[r];
    }
    __syncthreads();
    if (c == 0) {
        const float* sg = INP(20) + l * 128;
        float gsub[4];
#pragma unroll
        for (int db = 0; db < 4; ++db) gsub[db] = sg[r32 + 32 * db] * onem;
#pragma unroll
        for (int r = 0; r < 16; ++r) {
            float y[4], ss = 0.f;
#pragma unroll
            for (int db = 0; db < 4; ++db) { y[db] = o[db][r] * li[r] - lam * X[(32 * qsub + crow(r, hi)) * 132 + r32 + 32 * db]; ss += y[db] * y[db]; }
            ss += __shfl_xor(ss, 1); ss += __shfl_xor(ss, 2); ss += __shfl_xor(ss, 4); ss += __shfl_xor(ss, 8); ss += __shfl_xor(ss, 16);
            const float rs = __builtin_amdgcn_rsqf(ss * (1.f / 128.f) + EPS);
            bf16_t* d = (bf16_t*)(ws + WS_XN) + (size_t)(b * SEQ + qw0 + crow(r, hi)) * 512 + h * 128 + r32;
#pragma unroll
            for (int db = 0; db < 4; ++db) GST(bf16_t, d + 32 * db, (bf16_t)f2bf(y[db] * rs * gsub[db]));
        }
    }
    __syncthreads();
}

__device__ __forceinline__ void nsa_unit(const Params& P, int l, int b, int g, int u, LAS unsigned char* lds, bool load_tab) {
    const int tid = otid(), lane = tid & 63, wave = __builtin_amdgcn_readfirstlane(tid >> 6), r32 = lane & 31, hi = lane >> 5;
    const int qi = r32 >> 2, p = r32 & 3, qw0 = 64 * u + 8 * wave, qpos = qw0 + qi, head = g * 4 + p;
    unsigned char* ws = WSP;
    const float Mb = ((const float*)(ws + WS_PRM))[l * 8 + 2];
    LAS float* biasL = (LAS float*)(lds + L_BIAS);
    LAS float* imp = (LAS float*)(lds + L_IMP);
    LAS unsigned* selw = (LAS unsigned*)(lds + L_SEL);
    LAS float* wsf = (LAS float*)(lds + L_WSF) + wave * 64;
    const float* bgl = (const float*)(ws + WS_BIAS) + (size_t)(4 + g * 4) * 1024;
    if (load_tab) for (int i = tid; i < 4 * TBN; i += NTHR) { const int hh = i / TBN, d = i % TBN - 128; biasL[i] = GLD(float, bgl + hh * 1024 + (d < 0 ? 0 : (d > 1023 ? 1023 : d))) - Mb; }
    if (tid == 0) { unsigned z = 0u; asm volatile("" : "+v"(z)); selw[128] = z; selw[129] = z; }
    const LAS float* tb = biasL + p * TBN;
    const float cfar = bgl[p * 1024 + 1023] - Mb;
    const bf16_t* Qp = (const bf16_t*)(ws + Z_NQ) + ((size_t)(b * 8 + head) * SEQ + qpos) * 64 + hi * 8;
    bf16x8 qf[4];
#pragma unroll
    for (int d0 = 0; d0 < 4; ++d0) qf[d0] = GLD(bf16x8, Qp + d0 * 16);
    const float* ngp = (const float*)(ws + Z_NG) + (size_t)(b * SEQ + qpos) * 24 + head * 3;
    const float gate_c = GLD(float, ngp), gate_s = GLD(float, ngp + 1), gate_w = GLD(float, ngp + 2);
    f32x16 oc[2]; oc[0] = (f32x16){}; oc[1] = (f32x16){};
    f32x16 o[2];
    u32x4 rk, rv;
    const int bgi = b * 2 + g;
#define NS_STORE(sb) do { LAS unsigned char* st_ = lds + (sb) * NS_STAGE; stk(st_, rk, tid); stv(st_ + 64 * KP, rv, tid >> 3, tid); } while (0)
#define NS_FOLD(gate) do { lsum += __shfl_xor(lsum, 32); if (hi == 0) wsf[r32] = (lsum > 0.f) ? (gate) / lsum : 0.f; asm volatile("s_waitcnt lgkmcnt(0)" ::: "memory"); \
        _Pragma("unroll") for (int r = 0; r < 16; ++r) { const float f_ = wsf[crow(r, hi)]; oc[0][r] += f_ * o[0][r]; oc[1][r] += f_ * o[1][r]; } asm volatile("s_waitcnt lgkmcnt(0)" ::: "memory"); } while (0)
    {
        const bf16_t* Kg = (const bf16_t*)(ws + WS_KCN) + (size_t)bgi * 256 * 64;
        const bf16_t* Vg = (const bf16_t*)(ws + WS_VCT) + (size_t)bgi * 64 * 256;
        const int ntc = (4 * u + 2) / 64 + 1;
        {
            u32x4 ck[4], cv[4];
#pragma unroll
            for (int tc = 0; tc < 4; ++tc) if (tc < ntc) { ck[tc] = ldk(Kg + (size_t)tc * 4096, tid); cv[tc] = ldv(Vg + tc * 64, 256, tid >> 3, tid); }
#pragma unroll
            for (int tc = 0; tc < 4; ++tc) if (tc < ntc) { LAS unsigned char* st_ = lds + tc * NS_STAGE; stk(st_, ck[tc], tid); stv(st_ + 64 * KP, cv[tc], tid >> 3, tid); }
        }
        __syncthreads();
        float lsum = 0.f;
        for (int tc = 0; tc < ntc; ++tc) {
            const LAS unsigned char* st = lds + tc * NS_STAGE;
            f32x16 p0 = (f32x16){}, p1 = (f32x16){};
            qk_tile(p0, p1, st, qf, r32, hi);
            const int dl = qpos - 31 - 16 * (64 * tc + 4 * hi);
            score_exp_sel<16, false>(p0, p1, dl, tb, cfar, true, qw0 - 31 - 16 * (64 * tc + 63), qw0 + 7 - 31 - 16 * 64 * tc);
            lsum += sum32(p0, p1);
        }
        const float lt = lsum + __shfl_xor(lsum, 32);
        const float linv = (lt > 0.f) ? 1.0f / lt : 0.f;
        o[0] = (f32x16){}; o[1] = (f32x16){};
        float carry = 0.f;
        for (int tc = 0; tc < ntc; ++tc) {
            const LAS unsigned char* st = lds + tc * NS_STAGE;
            f32x16 p0 = (f32x16){}, p1 = (f32x16){};
            qk_tile(p0, p1, st, qf, r32, hi);
            const int dl = qpos - 31 - 16 * (64 * tc + 4 * hi);
            score_exp_sel<16, false>(p0, p1, dl, tb, cfar, true, qw0 - 31 - 16 * (64 * tc + 63), qw0 + 7 - 31 - 16 * 64 * tc);
            float Qs[2][4], PL[2][4];
#pragma unroll
            for (int blk = 0; blk < 2; ++blk)
#pragma unroll
                for (int m = 0; m < 4; ++m) { const f32x16& pp = blk ? p1 : p0; Qs[blk][m] = (pp[4 * m] + pp[4 * m + 1]) + (pp[4 * m + 2] + pp[4 * m + 3]); PL[blk][m] = __shfl_xor(pp[4 * m + 3], 32); }
#pragma unroll
            for (int blk = 0; blk < 2; ++blk)
#pragma unroll
                for (int m = 0; m < 4; ++m) {
                    const float prev = (m > 0) ? PL[blk][m - 1] : (blk ? PL[0][3] : carry);
                    float e = (Qs[blk][m] + (hi ? PL[blk][m] : prev)) * linv;
                    e += __shfl_xor(e, 1); e += __shfl_xor(e, 2);
                    if (p == 0) imp[(8 * wave + qi) * 64 + 16 * tc + 8 * blk + 2 * m + hi] = e;
                }
            carry = PL[1][3];
            pv_tile<2>(o, p0, p1, st + 64 * KP, r32, hi);
        }
        NS_FOLD(gate_c);
    }
    __syncthreads();
    {
        const int ql = lane >> 3, sub = lane & 7, q = 8 * wave + ql;
        unsigned long long m;
        if (u < 8) m = (2ull << u) - 1ull;
        else {
            m = 1ull | (1ull << u) | (1ull << (u - 1));
            float v[8];
#pragma unroll
            for (int i = 0; i < 8; ++i) { const int j = sub + 8 * i; v[i] = (j >= 1 && j <= u - 2) ? imp[q * 64 + j] : -1.f; }
            for (int k = 0; k < 5; ++k) {
                float bv = v[0]; int bj = sub;
#pragma unroll
                for (int i = 1; i < 8; ++i) if (v[i] > bv) { bv = v[i]; bj = sub + 8 * i; }
#pragma unroll
                for (int of = 1; of < 8; of <<= 1) { const float ov = __shfl_xor(bv, of); const int oj = __shfl_xor(bj, of); if (ov > bv || (ov == bv && oj < bj)) { bv = ov; bj = oj; } }
                m |= 1ull << bj;
#pragma unroll
                for (int i = 0; i < 8; ++i) if (bj == sub + 8 * i) v[i] = -2.f;
            }
        }
        if (sub == 0) { selw[2 * q] = (unsigned)m; selw[2 * q + 1] = (unsigned)(m >> 32); atomicOr((unsigned*)&selw[128], (unsigned)m); atomicOr((unsigned*)&selw[129], (unsigned)(m >> 32)); }
    }
    __syncthreads();
    asm volatile("" : "+v"(oc[0]), "+v"(oc[1]));
    u32x4 rk2, rv2;
#define NS_LOADA(Kg_, Vg_, j_) do { rk = ldk((Kg_) + (size_t)(j_) * 4096, tid); rv = ldv((Vg_) + (j_) * 64, SEQ, tid >> 3, tid); } while (0)
#define NS_LOADB(Kg_, Vg_, j_) do { rk2 = ldk((Kg_) + (size_t)(j_) * 4096, tid); rv2 = ldv((Vg_) + (j_) * 64, SEQ, tid >> 3, tid); } while (0)
#define NS_STOREA(sb) do { LAS unsigned char* st_ = lds + (sb) * NS_STAGE; stk(st_, rk, tid); stv(st_ + 64 * KP, rv, tid >> 3, tid); } while (0)
#define NS_STOREB(sb) do { LAS unsigned char* st_ = lds + (sb) * NS_STAGE; stk(st_, rk2, tid); stv(st_ + 64 * KP, rv2, tid >> 3, tid); } while (0)
    {
        const unsigned long long un = (unsigned long long)selw[128] | ((unsigned long long)selw[129] << 32);
        const unsigned long long mine = (unsigned long long)selw[2 * (8 * wave + qi)] | ((unsigned long long)selw[2 * (8 * wave + qi) + 1] << 32);
        const bf16_t* Kg = (const bf16_t*)(ws + Z_KSEL) + (size_t)bgi * SEQ * 64;
        const bf16_t* Vg = (const bf16_t*)(ws + Z_VSELT) + (size_t)bgi * 64 * SEQ;
        o[0] = (f32x16){}; o[1] = (f32x16){};
        float lsum = 0.f;
        unsigned long long rem = un;
#define NS_NEXTJ(var, has) do { has = (rem != 0ull); var = 0; if (has) { var = __builtin_ctzll(rem); rem &= rem - 1; } } while (0)
        int jc, j1, j2; bool h1, h2;
        NS_NEXTJ(jc, h1);
        NS_NEXTJ(j1, h1);
        NS_LOADA(Kg, Vg, jc); if (h1) NS_LOADB(Kg, Vg, j1);
        NS_STOREA(0);
        __syncthreads();
        int sc = 0;
#define NS_SEL_STEP(LOADF, STOREN) { \
            NS_NEXTJ(j2, h2); if (h2) LOADF(Kg, Vg, j2); \
            const bool rowsel = (mine >> jc) & 1ull; \
            if (__any(rowsel)) { \
                const LAS unsigned char* st = lds + sc * NS_STAGE; \
                f32x16 p0 = (f32x16){}, p1 = (f32x16){}; \
                qk_tile(p0, p1, st, qf, r32, hi); \
                const int dl = qpos - 64 * jc - 4 * hi; \
                score_exp_sel<1, false>(p0, p1, dl, tb, cfar, rowsel, qw0 - (64 * jc + 63), qw0 + 7 - 64 * jc); \
                lsum += sum32(p0, p1); \
                pv_tile<2>(o, p0, p1, st + 64 * KP, r32, hi); \
            } \
            const int sn = (sc == 2) ? 0 : sc + 1; \
            if (h1) STOREN(sn); \
            __syncthreads(); \
            if (!h1) break; \
            jc = j1; j1 = j2; h1 = h2; sc = sn; }
        for (;;) { NS_SEL_STEP(NS_LOADA, NS_STOREB) NS_SEL_STEP(NS_LOADB, NS_STOREA) }
#undef NS_SEL_STEP
#undef NS_NEXTJ
        NS_FOLD(gate_s);
        asm volatile("" : "+v"(oc[0]), "+v"(oc[1]));
    }
    {
        const bf16_t* Kg = (const bf16_t*)(ws + Z_KWIN) + (size_t)bgi * SEQ * 64;
        const bf16_t* Vg = (const bf16_t*)(ws + Z_VWINT) + (size_t)bgi * 64 * SEQ;
        o[0] = (f32x16){}; o[1] = (f32x16){};
        float lsum = 0.f;
        const int t0 = (u >= 8) ? u - 8 : 0;
        int t = t0, sc = 0;
        NS_LOADA(Kg, Vg, t0); if (t0 + 1 <= u) NS_LOADB(Kg, Vg, t0 + 1);
        NS_STOREA(0);
        __syncthreads();
#define NS_WIN_STEP(LOADF, STOREN) { \
            if (t + 2 <= u) LOADF(Kg, Vg, t + 2); \
            { \
                const LAS unsigned char* st = lds + sc * NS_STAGE; \
                f32x16 p0 = (f32x16){}, p1 = (f32x16){}; \
                qk_tile(p0, p1, st, qf, r32, hi); \
                const int dl = qpos - 64 * t - 4 * hi; \
                score_exp_sel<1, true>(p0, p1, dl, tb, cfar, true, qw0 - (64 * t + 63), qw0 + 7 - 64 * t); \
                lsum += sum32(p0, p1); \
                pv_tile<2>(o, p0, p1, st + 64 * KP, r32, hi); \
            } \
            const int sn = (sc == 2) ? 0 : sc + 1; \
            if (t + 1 <= u) STOREN(sn); \
            __syncthreads(); \
            if (t + 1 > u) break; \
            ++t; sc = sn; }
        for (;;) { NS_WIN_STEP(NS_LOADA, NS_STOREB) NS_WIN_STEP(NS_LOADB, NS_STOREA) }
#undef NS_WIN_STEP
        NS_FOLD(gate_w);
    }
#undef NS_LOADA
#undef NS_LOADB
#undef NS_STOREA
#undef NS_STOREB
#undef NS_STORE
#undef NS_FOLD
#pragma unroll
    for (int r = 0; r < 16; ++r) {
        const int row = crow(r, hi), q = qw0 + (row >> 2), pp = row & 3;
        bf16_t* d = (bf16_t*)(ws + WS_XN) + (size_t)(MTOK + b * SEQ + q) * 512 + (g * 4 + pp) * 64 + r32;
        GST(bf16_t, d, (bf16_t)f2bf(oc[0][r])); GST(bf16_t, d + 32, (bf16_t)f2bf(oc[1][r]));
    }
    __syncthreads();
}

__device__ __forceinline__ void attention_phase(const Params& P, int l, LAS unsigned char* lds) {
    int tab_key = -1;
    for (int it = blockIdx.x; it < 2048; it += gridDim.x) {
        const int c = it & 255, sl = (it >> 8) & 3;
        if (it < 1024) { const int bh = c & 31, xg = c >> 5; const int qb = (sl == 0) ? 31 - xg : (sl == 1) ? 23 - xg : (sl == 2) ? 8 + xg : xg;
            da_unit(P, l, bh >> 2, bh & 3, qb, lds, tab_key != (bh & 3)); tab_key = bh & 3; }
        else { const int bg = c & 15, ug = c >> 4; const int u = (sl == 0) ? 63 - ug : (sl == 1) ? 47 - ug : (sl == 2) ? 16 + ug : ug;
            nsa_unit(P, l, bg >> 1, bg & 1, u, lds, tab_key != 4 + (bg & 1)); tab_key = 4 + (bg & 1); }
    }
}

constexpr size_t WS_BAR = 72 * 1024;
#define RLX_AGENT __ATOMIC_RELAXED, __HIP_MEMORY_SCOPE_AGENT
#define XB_TMO      128
#define XB_XCNT(j)  (256  + 64 * (j))
#define XB_XSUB(j)  (1280 + 64 * (j))
#define XB_XGEN(j)  (2304 + 64 * (j))
#define XB_TOP      3328
#define XB_TOPGEN   3392
#define XCD_BAR_WORDS 3456
#define XB_SPIN_CAP (1u << 18)

__device__ __forceinline__ unsigned xb_ld(unsigned* p)              { return __hip_atomic_load(p, __ATOMIC_RELAXED, __HIP_MEMORY_SCOPE_AGENT); }
__device__ __forceinline__ unsigned xb_add(unsigned* p, unsigned v) { return __hip_atomic_fetch_add(p, v, __ATOMIC_RELAXED, __HIP_MEMORY_SCOPE_AGENT); }
__device__ __forceinline__ unsigned xb_xcc_id() { return (unsigned)__builtin_amdgcn_s_getreg((3 << 11) | 20) & 0xFu; }
#define XB_SPIN(cond, bar) do { unsigned _sp = 0; while (cond) { __builtin_amdgcn_s_sleep(1); \
    if ((++_sp & 255u) == 0u) { if (xb_ld(&(bar)[XB_TMO])) break; if (_sp > XB_SPIN_CAP) { atomicAdd(&(bar)[XB_TMO], 1u); break; } } } } while (0)

struct XcdBarrier {
    unsigned* bar; unsigned x;
    volatile LAS unsigned* st;
};

__device__ __forceinline__ XcdBarrier xcd_barrier_post(unsigned* bar, volatile LAS unsigned* st) {
    XcdBarrier b; b.bar = bar; b.x = xb_xcc_id(); b.st = st;
    if (threadIdx.x == 0) (void)xb_add(&bar[XB_XCNT(b.x)], 1u);
    return b;
}
__device__ __forceinline__ void xcd_barrier_complete(unsigned* bar, unsigned x, unsigned& nloc, unsigned& nx) {
    const unsigned G = gridDim.x * gridDim.y * gridDim.z;
    unsigned sum, cnt, mine, sp = 0u;
    for (;;) {
        sum = 0u; cnt = 0u; mine = 0u;
#pragma unroll
        for (unsigned j = 0; j < 16; ++j) { const unsigned c = xb_ld(&bar[XB_XCNT(j)]); sum += c; cnt += (c > 0u) ? 1u : 0u; mine = (j == x) ? c : mine; }
        if (sum == G) break;
        __builtin_amdgcn_s_sleep(1);
        if ((++sp & 255u) == 0u) { if (xb_ld(&bar[XB_TMO])) break; if (sp > XB_SPIN_CAP) { atomicAdd(&bar[XB_TMO], 1u); break; } }
    }
    nloc = mine > 0u ? mine : 1u; nx = cnt > 0u ? cnt : 1u;
}

__device__ __forceinline__ void xcd_barrier(const XcdBarrier& b) {
    asm volatile("s_waitcnt vmcnt(0)" ::: "memory");
    __syncthreads();
    if (threadIdx.x == 0) {
        unsigned* bar = b.bar;
        __builtin_amdgcn_s_waitcnt(0);
        unsigned nloc = b.st[0], nx = b.st[1];
        if (nloc == 0u) { xcd_barrier_complete(bar, b.x, nloc, nx); b.st[0] = nloc; b.st[1] = nx; }
        const unsigned old = xb_add(&bar[XB_XSUB(b.x)], 1u);
        const unsigned gen = old / nloc;
        if (old + 1u == (gen + 1u) * nloc) {
            __builtin_amdgcn_fence(__ATOMIC_RELEASE, "agent");
            asm volatile("s_waitcnt vmcnt(0)" ::: "memory");
            const unsigned og = xb_add(&bar[XB_TOP], 1u);
            const unsigned tg = og / nx;
            if (og + 1u == (tg + 1u) * nx) xb_add(&bar[XB_TOPGEN], 1u);
            else XB_SPIN(xb_ld(&bar[XB_TOPGEN]) == tg, bar);
            __builtin_amdgcn_fence(__ATOMIC_ACQUIRE, "agent");
            xb_add(&bar[XB_XGEN(b.x)], 1u);
            asm volatile("s_waitcnt vmcnt(0)" ::: "memory");
        } else {
            XB_SPIN(xb_ld(&bar[XB_XGEN(b.x)]) == gen, bar);
            __builtin_amdgcn_fence(__ATOMIC_ACQUIRE, "agent");
            asm volatile("s_waitcnt vmcnt(0)" ::: "memory");
        }
    }
    __syncthreads();
}

__global__ void __launch_bounds__(NTHR, 2) hybrid_fwd(Params P) {
    extern __shared__ __attribute__((aligned(16))) unsigned char lds_raw[];
    LAS unsigned char* lds = (LAS unsigned char*)lds_raw;
    cg::grid_group grid = cg::this_grid();
#define GSYNC() do { XcdBarrier xb_; xb_.bar = (unsigned*)(WSP + WS_BAR); xb_.x = xb_xcc_id(); xb_.st = (volatile LAS unsigned*)(lds + L_PTAB + 384); xcd_barrier(xb_); } while (0)
    if (threadIdx.x == 0) {
        LAS unsigned long long* pt = (LAS unsigned long long*)(lds + L_PTAB);
#pragma unroll
        for (int i = 0; i < 30; ++i) pt[i] = (unsigned long long)P.in[i];
        pt[30] = (unsigned long long)P.out; pt[31] = (unsigned long long)P.ws;
        *(LAS unsigned*)(lds + L_PTAB + 384) = 0u; *(LAS unsigned*)(lds + L_PTAB + 388) = 0u;
    }
    __syncthreads();
    (void)xcd_barrier_post((unsigned*)(WSP + WS_BAR), (volatile LAS unsigned*)(lds + L_PTAB + 384));
    const int G = gridDim.x, bx = blockIdx.x;
#define ws WSP
#define XN ((bf16_t*)(WSP + WS_XN))
#define HID ((bf16_t*)(WSP + WS_HID))
#define MERGED ((bf16_t*)(WSP + WS_MERGED))
#define XB ((bf16_t*)OUTP)
#define XS ((bf16_t*)(WSP + WS_Z + 192 * MiB))
#define SSP ((float*)(WSP + WS_SS))

#define STAMP() do {} while (0)
    if (P.out == nullptr) grid.sync();
    STAMP();
    prologue(P, lds);
    xprep_phase(INP(0), (bf16_t*)OUTP, (float*)(WSP + WS_SS));
    GSYNC(); STAMP();
#pragma unroll
    for (int l = 0; l < DEPTH; ++l) {
        const float* xin = (l == 0) ? INP(0) : OUTP;
        { pg8::Gemm g{XB, (const bf16_t*)(ws + WS_W13 + (size_t)(l * 2 + 0) * W13_SZ), MTOK, 5632, DM}; pg8::StaticOrder S; S.init(MTOK, 5632, G, bx);
          EpiSwiGLU E{{SSP}, HID}; pg8::gemm_phase<EpiSwiGLU, pg8::StaticOrder, true, true>(lds, g, S, E);
        }
        GSYNC(); STAMP();
        { pg8::Gemm g{HID, (const bf16_t*)(ws + WS_W2 + (size_t)(l * 2 + 0) * W2_SZ), MTOK, DM, DFF}; pg8::StaticOrder S; S.init(MTOK, DM, G, bx);
          if (l == 0) { EpiResidT<true, false> E{xin, XB, 0.5f, SSP}; pg8::gemm_phase<EpiResidT<true, false>, pg8::StaticOrder, true, true>(lds, g, S, E); }
          else { EpiResidT<false, false> E{XB, XB, 0.5f, SSP}; pg8::gemm_phase<EpiResidT<false, false>, pg8::StaticOrder, true, true>(lds, g, S, E); } }
        GSYNC(); STAMP();
        { pg8::Gemm g{XB, (const bf16_t*)(ws + WS_WIN + (size_t)l * WIN_SZ), MTOK, 5120, DM}; pg8::StaticOrder S; S.init(MTOK, 5120, G, bx);
          EpiZ E{{SSP}, ws, INP(14) + l * 64, INP(15) + l * 64, INP(21) + l * 64, INP(22) + l * 192}; pg8::gemm_phase<EpiZ, pg8::StaticOrder, true, true>(lds, g, S, E);
        }
        GSYNC(); STAMP();
        compress_phase(P, l, lds);
        GSYNC(); STAMP();
        attention_phase(P, l, lds);
        GSYNC(); STAMP();
        { pg8::Gemm g{XN, (const bf16_t*)(ws + WS_PAB + (size_t)l * PAB_SZ), 2 * MTOK, 2048, 512}; PairOrder S; S.init(G, bx);
          EpiMerge E{(const unsigned char*)(ws + Z_MG), MERGED}; pg8::gemm_phase<EpiMerge, PairOrder, true, true>(lds, g, S, E); }
        GSYNC(); STAMP();
        { pg8::Gemm g{MERGED, (const bf16_t*)(ws + WS_WO + (size_t)l * WO_SZ), MTOK, DM, DM}; pg8::StaticOrder S; S.init(MTOK, DM, G, bx);
          EpiResidT<false, false> E{XB, (l + 1 < DEPTH) ? XB : XS, 1.0f, SSP}; pg8::gemm_phase<EpiResidT<false, false>, pg8::StaticOrder, true, true>(lds, g, S, E); }
        GSYNC(); STAMP();
        { pg8::Gemm g{(l + 1 < DEPTH) ? XB : XS, (const bf16_t*)(ws + WS_W13 + (size_t)(l * 2 + 1) * W13_SZ), MTOK, 5632, DM}; pg8::StaticOrder S; S.init(MTOK, 5632, G, bx);
          EpiSwiGLU E{{SSP}, HID}; pg8::gemm_phase<EpiSwiGLU, pg8::StaticOrder, true, true>(lds, g, S, E); }
        GSYNC(); STAMP();
        { pg8::Gemm g{HID, (const bf16_t*)(ws + WS_W2 + (size_t)(l * 2 + 1) * W2_SZ), MTOK, DM, DFF}; pg8::StaticOrder S; S.init(MTOK, DM, G, bx);
          if (l + 1 < DEPTH) { EpiResidT<false, false> E{XB, XB, 0.5f, SSP}; pg8::gemm_phase<EpiResidT<false, false>, pg8::StaticOrder, true, true>(lds, g, S, E); }
          else { EpiResidT<false, true> E{XS, OUTP, 0.5f, nullptr}; pg8::gemm_phase<EpiResidT<false, true>, pg8::StaticOrder, true, true>(lds, g, S, E); } }
        if (l + 1 < DEPTH) { GSYNC(); STAMP(); }
    }
#undef ws
#undef XN
#undef HID
#undef MERGED
#undef XB
#undef XS
#undef SSP
}

extern "C" void kernel_launch(void* const* d_in, const int* in_sizes, int n_in, void* d_out, int out_size, void* d_ws, size_t ws_size, hipStream_t stream) {
    static int grid = 0;
    if (grid == 0) {
        if (n_in != 30 || out_size != MTOK * DM || ws_size < WS_END) { fprintf(stderr, "kernel_launch: unexpected problem (n_in %d out %d ws %zu, need %zu)\n", n_in, out_size, ws_size, (size_t)WS_END); grid = -1; return; }
        int dev = 0, cus = 0, per_cu = 0;
        (void)hipGetDevice(&dev);
        (void)hipDeviceGetAttribute(&cus, hipDeviceAttributeMultiprocessorCount, dev);
        if (hipFuncSetAttribute((const void*)hybrid_fwd, hipFuncAttributeMaxDynamicSharedMemorySize, LDS_BYTES) != hipSuccess) { fprintf(stderr, "kernel_launch: hipFuncSetAttribute failed\n"); grid = -1; return; }
        if (hipOccupancyMaxActiveBlocksPerMultiprocessor(&per_cu, (const void*)hybrid_fwd, NTHR, LDS_BYTES) != hipSuccess || per_cu < 1) { fprintf(stderr, "kernel_launch: occupancy query gave %d\n", per_cu); per_cu = 1; }
        (void)hipGetLastError();
        grid = cus * (per_cu > 1 ? 1 : per_cu);
        if (grid <= 0) grid = 256;
    }
    if (grid < 0) return;
    Params p{};
    for (int i = 0; i < 30; ++i) p.in[i] = (const float*)d_in[i];
    p.out = (float*)d_out; p.ws = (unsigned char*)d_ws;
    (void)hipMemsetAsync((unsigned char*)d_ws + WS_BAR, 0, 16384, stream);
    void* args[] = {&p};
    hipError_t e = hipLaunchCooperativeKernel((const void*)hybrid_fwd, dim3(grid), dim3(NTHR), args, LDS_BYTES, stream);
    if (e != hipSuccess) fprintf(stderr, "cooperative launch failed: %s (grid %d)\n", hipGetErrorString(e), grid);
}
```

```cpp
#include <hip/hip_runtime.h>
#include <hip/hip_cooperative_groups.h>
#include <cstdio>
#include <cstdint>
namespace cg = cooperative_groups;
namespace pg8 {
#define PG8_LAS __attribute__((address_space(3)))
typedef unsigned short bf16_t;
typedef short bf16x8 __attribute__((ext_vector_type(8)));
typedef float f32x4 __attribute__((ext_vector_type(4)));
typedef unsigned u32x4 __attribute__((ext_vector_type(4)));
constexpr int BM = 256, BK = 64, HALF = 128, HTB = HALF * BK * 2  , STAGE_BYTES = 8 * HTB, NXCD = 8, WGM = 8;

__host__ __device__ __forceinline__ int lds_byte(int r, int c) { const int st = (r >> 4) * 2 + (c >> 5), rr = r & 15, cc = c & 31, ob = rr * 64 + cc * 2; return st * 1024 + (ob ^ (((ob >> 9) & 1) << 5)); }
__host__ __device__ __forceinline__ void stage_rc(int b, int& R, int& C) { const int st = b / 1024, sb = b % 1024, swz = sb ^ (((sb >> 9) & 1) << 5); R = (st >> 1) * 16 + swz / 64; C = (st & 1) * 32 + (swz % 64) / 2; }
__host__ __device__ __forceinline__ int perm32(int rho) { const int n = rho >> 4, i = rho & 15; return 8 * (i >> 2) + 4 * n + (i & 3); }

struct Unit { int pm, pn; };
struct Gemm { const bf16_t* A; const bf16_t* Bt; int M, N, K; };

struct StaticOrder {
    int nM, nN, nwg, G, c;
    __host__ __device__ void init(int M, int N, int G_, int c_) { nM = M / BM; nN = N / BM; nwg = nM * nN; G = G_; c = c_; }
    __host__ __device__ bool next(int i, Unit& u) const {
        const long L = (long)i * G + c; if (L >= nwg) return false;
        int wgid = (int)L; { const int q = nwg / NXCD, r = nwg % NXCD, xcd = wgid % NXCD, off = wgid / NXCD; wgid = (xcd < r ? xcd * (q + 1) : r * (q + 1) + (xcd - r) * q) + off; }
        const int nig = WGM * nN, gid = wgid / nig, fm = gid * WGM, gsz = (nM - fm) < WGM ? (nM - fm) : WGM;
        u.pm = fm + ((wgid % nig) % gsz); u.pn = (wgid % nig) / gsz; return true;
    }
    __device__ __forceinline__ void a_ready(const Unit&) const {}
    __device__ __forceinline__ void done(const Unit&) const {}
};

typedef float f32x2_t __attribute__((ext_vector_type(2))); typedef __bf16 bf16x2_t __attribute__((ext_vector_type(2)));
__device__ __forceinline__ unsigned cvt_pk_bf16(float lo, float hi) { f32x2_t v = {lo, hi}; bf16x2_t b = __builtin_convertvector(v, bf16x2_t); return __builtin_bit_cast(unsigned, b); }
template <class Epi, class Sched, bool ALIGN_EPI = false, bool SP2 = false>
__device__ __forceinline__ void gemm_phase(PG8_LAS unsigned char* lds, const Gemm g, const Sched& S, const Epi& E) {
    int tid_ = threadIdx.x; asm volatile("" : "+v"(tid_)); const int tid = tid_, wid = __builtin_amdgcn_readfirstlane(tid >> 6), lane = tid & 63, wr = wid >> 2, wc = wid & 3, fr = lane & 15, fq = lane >> 4;
    const int K = g.K, nt = K / BK;
    unsigned voffA[2], voffB[2];
#pragma unroll
    for (int i = 0; i < 2; ++i) { int R, C; stage_rc(tid * 16 + i * 8192, R, C); const int Rb = Epi::PERM ? ((R & ~31) + perm32(R & 31)) : R;
        voffA[i] = (unsigned)(R * K + C) * 2u; voffB[i] = (unsigned)(Rb * K + C) * 2u; }
    const size_t kstep = (size_t)(BK * 2);
    const size_t hstep = (size_t)HALF * K * 2;
    const size_t tstep = 2 * hstep;
    const unsigned ldsw = (unsigned)wid * 1024u;
    const int aoff = lds_byte(wr * 64 + fr, fq * 8), boff = lds_byte(wc * 32 + fr, fq * 8);
#define PG8_SA(b, h) (((b) * 2 + (h)) * HTB)
#define PG8_SB(b, h) ((4 + (b) * 2 + (h)) * HTB)
#define PG8_STAGE(bufoff, gbase, voff) do { _Pragma("unroll") for (int _i = 0; _i < 2; ++_i) \
        __builtin_amdgcn_global_load_lds((const unsigned*)((const char*)(gbase) + (voff)[_i]), (PG8_LAS unsigned*)(lds + (bufoff) + ldsw + _i * 8192), 16, 0, 0); } while (0)
#define PG8_LDA(dst, b, h) do { _Pragma("unroll") for (int m = 0; m < 4; ++m) _Pragma("unroll") for (int k = 0; k < 2; ++k) dst[m][k] = *(const PG8_LAS bf16x8*)(lds + PG8_SA(b, h) + aoff + m * 2048 + k * 1024); } while (0)
#define PG8_LDB(dst, b, h) do { _Pragma("unroll") for (int n = 0; n < 2; ++n) _Pragma("unroll") for (int k = 0; k < 2; ++k) dst[n][k] = *(const PG8_LAS bf16x8*)(lds + PG8_SB(b, h) + boff + n * 2048 + k * 1024); } while (0)
#define PG8_MMA(ai, bj, At, Bt) do { __builtin_amdgcn_s_setprio(1); _Pragma("unroll") for (int m = 0; m < 4; ++m) _Pragma("unroll") for (int n = 0; n < 2; ++n) _Pragma("unroll") for (int k = 0; k < 2; ++k) \
        acc[ai][bj][m][n] = __builtin_amdgcn_mfma_f32_16x16x32_bf16(Bt[n][k], At[m][k], acc[ai][bj][m][n], 0, 0, 0); __builtin_amdgcn_s_setprio(0); } while (0)
#define PG8_WAIT_V(n) asm volatile("s_waitcnt vmcnt(" #n ")" ::: "memory")
#define PG8_WAIT_L(n) asm volatile("s_waitcnt lgkmcnt(" #n ")" ::: "memory")
#define PG8_BAR __builtin_amdgcn_s_barrier()
#define PG8_SCHED __builtin_amdgcn_sched_barrier(0)
    Unit cur, nxt; int ui = 0;
    if (!S.next(0, cur)) return;
    f32x4 acc[2][2][4][2];
#pragma unroll
    for (int a = 0; a < 2; ++a)
#pragma unroll
        for (int b = 0; b < 2; ++b)
#pragma unroll
            for (int m = 0; m < 4; ++m)
#pragma unroll
                for (int n = 0; n < 2; ++n) acc[a][b][m][n] = (f32x4){0.f, 0.f, 0.f, 0.f};
    bf16x8 At[4][2], B0[2][2], B1[2][2];
    const char* cA = (const char*)g.A + (size_t)cur.pm * tstep; const char* cB = (const char*)g.Bt + (size_t)cur.pn * tstep;
    S.a_ready(cur);
    if constexpr (Epi::ROWSCALE) {
        int pmB = -1, pmC = -1, pmD = -1; Unit uu;
        for (int i = 1; S.next(i, uu); ++i) if (uu.pm != cur.pm && uu.pm != pmB && uu.pm != pmC && uu.pm != pmD) { if (pmB < 0) pmB = uu.pm; else if (pmC < 0) pmC = uu.pm; else if (pmD < 0) pmD = uu.pm; }
        f32x4 a0, b0, a1, b1, a2, b2, a3, b3; Unit t0 = cur, t1 = cur, t2 = cur, t3 = cur; t1.pm = pmB < 0 ? cur.pm : pmB; t2.pm = pmC < 0 ? cur.pm : pmC; t3.pm = pmD < 0 ? cur.pm : pmD;
        E.rs_issue(t0, tid, a0, b0); E.rs_issue(t1, tid, a1, b1); E.rs_issue(t2, tid, a2, b2); E.rs_issue(t3, tid, a3, b3);
        E.rs_write(tid, a3, b3, (PG8_LAS float*)(lds + STAGE_BYTES + ((t3.pm >> 3) & 3) * 1024));
        E.rs_write(tid, a2, b2, (PG8_LAS float*)(lds + STAGE_BYTES + ((t2.pm >> 3) & 3) * 1024));
        E.rs_write(tid, a1, b1, (PG8_LAS float*)(lds + STAGE_BYTES + ((t1.pm >> 3) & 3) * 1024));
        E.rs_write(tid, a0, b0, (PG8_LAS float*)(lds + STAGE_BYTES + ((t0.pm >> 3) & 3) * 1024));
    }
    if constexpr (SP2) {
        PG8_STAGE(PG8_SB(0, 0), cB, voffB); PG8_STAGE(PG8_SB(0, 1), cB + hstep, voffB); PG8_STAGE(PG8_SA(0, 0), cA, voffA); PG8_STAGE(PG8_SA(0, 1), cA + hstep, voffA);
        if (wr == 1) PG8_BAR;
        PG8_WAIT_V(2); PG8_BAR;
        PG8_STAGE(PG8_SB(1, 0), cB + kstep, voffB); PG8_STAGE(PG8_SA(1, 0), cA + kstep, voffA); PG8_STAGE(PG8_SB(1, 1), cB + hstep + kstep, voffB);
        PG8_WAIT_V(6); PG8_BAR;
    } else {
        PG8_STAGE(PG8_SB(0, 0), cB, voffB); PG8_STAGE(PG8_SA(0, 0), cA, voffA); PG8_STAGE(PG8_SB(0, 1), cB + hstep, voffB); PG8_STAGE(PG8_SA(0, 1), cA + hstep, voffA);
        if (wr == 1) PG8_BAR;
        PG8_WAIT_V(4); PG8_BAR;
        PG8_STAGE(PG8_SB(1, 0), cB + kstep, voffB); PG8_STAGE(PG8_SA(1, 0), cA + kstep, voffA); PG8_STAGE(PG8_SB(1, 1), cB + hstep + kstep, voffB);
        PG8_WAIT_V(6); PG8_BAR;
    }
    for (;;) {
        const bool has_next = S.next(ui + 1, nxt);
        const char* nA = has_next ? (const char*)g.A + (size_t)nxt.pm * tstep : cA; const char* nB = has_next ? (const char*)g.Bt + (size_t)nxt.pn * tstep : cB;
        for (int t = 0; t < nt; t += 2) {
            const bool last = (t == nt - 2);
            const char* a1 = cA + (size_t)(t + 1) * kstep;
            const char* a2 = last ? nA : cA + (size_t)(t + 2) * kstep; const char* b2 = last ? nB : cB + (size_t)(t + 2) * kstep;
            const char* a3 = a2 + kstep; const char* b3 = b2 + kstep;
            if (last && has_next) S.a_ready(nxt);
            if constexpr (SP2) {
            PG8_LDB(B0, 0, 0); PG8_LDB(B1, 0, 1); PG8_SCHED; PG8_LDA(At, 0, 0); PG8_STAGE(PG8_SA(1, 1), a1 + hstep, voffA);
            PG8_WAIT_V(8); PG8_WAIT_L(0); PG8_BAR; PG8_MMA(0, 0, At, B0); PG8_MMA(0, 1, At, B1); PG8_BAR; PG8_SCHED;
            PG8_LDA(At, 0, 1); PG8_STAGE(PG8_SB(0, 0), b2, voffB); PG8_STAGE(PG8_SB(0, 1), b2 + hstep, voffB); PG8_STAGE(PG8_SA(0, 0), a2, voffA);
            PG8_WAIT_V(8); PG8_WAIT_L(0); PG8_BAR; PG8_MMA(1, 0, At, B0); PG8_MMA(1, 1, At, B1); PG8_BAR; PG8_SCHED;
            PG8_LDB(B0, 1, 0); PG8_LDB(B1, 1, 1); PG8_SCHED; PG8_LDA(At, 1, 0); PG8_STAGE(PG8_SA(0, 1), a2 + hstep, voffA);
            PG8_WAIT_V(8); PG8_WAIT_L(0); PG8_BAR; PG8_MMA(0, 0, At, B0); PG8_MMA(0, 1, At, B1); PG8_BAR; PG8_SCHED;
            PG8_LDA(At, 1, 1); PG8_STAGE(PG8_SB(1, 0), b3, voffB); PG8_STAGE(PG8_SB(1, 1), b3 + hstep, voffB); PG8_STAGE(PG8_SA(1, 0), a3, voffA);
            PG8_WAIT_V(8); PG8_WAIT_L(0); PG8_BAR; PG8_MMA(1, 0, At, B0); PG8_MMA(1, 1, At, B1); PG8_BAR; PG8_SCHED;
            } else {
            PG8_LDB(B0, 0, 0); PG8_SCHED; PG8_LDA(At, 0, 0); PG8_STAGE(PG8_SA(1, 1), a1 + hstep, voffA);
            PG8_WAIT_L(8); PG8_BAR; PG8_WAIT_L(0); PG8_MMA(0, 0, At, B0); PG8_BAR; PG8_SCHED;
            PG8_LDB(B1, 0, 1); PG8_STAGE(PG8_SB(0, 0), b2, voffB);
            PG8_BAR; PG8_WAIT_L(0); PG8_MMA(0, 1, At, B1); PG8_BAR;
            PG8_LDA(At, 0, 1); PG8_STAGE(PG8_SA(0, 0), a2, voffA);
            PG8_BAR; PG8_WAIT_L(0); PG8_MMA(1, 0, At, B0); PG8_BAR; PG8_SCHED;
            PG8_STAGE(PG8_SB(0, 1), b2 + hstep, voffB);
            PG8_WAIT_V(6); PG8_BAR; PG8_MMA(1, 1, At, B1); PG8_BAR;
            PG8_LDB(B0, 1, 0); PG8_SCHED; PG8_LDA(At, 1, 0); PG8_STAGE(PG8_SA(0, 1), a2 + hstep, voffA);
            PG8_WAIT_L(8); PG8_BAR; PG8_WAIT_L(0); PG8_MMA(0, 0, At, B0); PG8_BAR; PG8_SCHED;
            PG8_LDB(B1, 1, 1); PG8_STAGE(PG8_SB(1, 0), b3, voffB);
            PG8_BAR; PG8_WAIT_L(0); PG8_MMA(0, 1, At, B1); PG8_BAR;
            PG8_LDA(At, 1, 1); PG8_STAGE(PG8_SA(1, 0), a3, voffA);
            PG8_BAR; PG8_WAIT_L(0); PG8_MMA(1, 0, At, B0); PG8_BAR; PG8_SCHED;
            PG8_STAGE(PG8_SB(1, 1), b3 + hstep, voffB);
            PG8_WAIT_V(6); PG8_BAR; PG8_MMA(1, 1, At, B1); PG8_BAR;
            }
        }
        if constexpr (ALIGN_EPI) { if (wr == 0) PG8_BAR; }
        if constexpr (!Epi::AFTER_DRAIN) {
            if constexpr (Epi::ROWSCALE) E(acc, cur, wr, wc, fr, fq, (const PG8_LAS float*)(lds + STAGE_BYTES + ((cur.pm >> 3) & 3) * 1024));
            else if constexpr (Epi::CHAIN) { if (ui & 1) E(acc, cur, wr, wc, fr, fq); else E.chain(acc, cur, wr, wc, fr, fq); }
            else E(acc, cur, wr, wc, fr, fq);
            S.done(cur); }
        if (!has_next) break;
        if (!(Epi::CHAIN && !(ui & 1)))
#pragma unroll
        for (int a = 0; a < 2; ++a)
#pragma unroll
            for (int b = 0; b < 2; ++b)
#pragma unroll
                for (int m = 0; m < 4; ++m)
#pragma unroll
                    for (int n = 0; n < 2; ++n) acc[a][b][m][n] = (f32x4){0.f, 0.f, 0.f, 0.f};
        cur = nxt; cA = nA; cB = nB; ++ui;
        if constexpr (ALIGN_EPI) { if (wr == 1) PG8_BAR; }
    }
    PG8_WAIT_V(0);
    if constexpr (!ALIGN_EPI) { if (wr == 0) PG8_BAR; }
    PG8_BAR;
    if constexpr (Epi::AFTER_DRAIN) { E.fused(acc, cur, wr, wc, fr, fq, lds, wid, lane); S.done(cur); }
#undef PG8_SA
#undef PG8_SB
#undef PG8_STAGE
#undef PG8_LDA
#undef PG8_LDB
#undef PG8_MMA
#undef PG8_WAIT_V
#undef PG8_WAIT_L
#undef PG8_BAR
#undef PG8_SCHED
}
}

#define LAS __attribute__((address_space(3)))
#define GAS __attribute__((address_space(1)))
#define GLD(T, p) (*(const GAS T*)(p))
#define GST(T, p, v) (*(GAS T*)(p) = (v))
typedef unsigned short bf16_t;
typedef short bf16x8 __attribute__((ext_vector_type(8)));
typedef short bf16x4 __attribute__((ext_vector_type(4)));
typedef float f32x4 __attribute__((ext_vector_type(4)));
typedef float f32x16 __attribute__((ext_vector_type(16)));
typedef unsigned u32x4 __attribute__((ext_vector_type(4)));
typedef unsigned u32x2 __attribute__((ext_vector_type(2)));

constexpr int BATCH = 8, SEQ = 4096, DM = 1024, MTOK = BATCH * SEQ, DFF = 2816, DEPTH = 2, NIN = 4888;
constexpr int NTHR = 512, NWAVE = 8;
constexpr float EPS = 1e-6f, LOG2E = 1.4426950408889634f;
constexpr float QSCALE = 0.125f * LOG2E;
constexpr size_t MiB = 1u << 20;
constexpr size_t WS_BIAS = 0;
constexpr size_t WS_PRM = 64 * 1024;
constexpr size_t WS_CB1 = 68 * 1024;
constexpr size_t WS_W13 = 1 * MiB;
constexpr size_t W13_SZ = (size_t)5632 * 1024 * 2;
constexpr size_t WS_W2 = 45 * MiB;
constexpr size_t W2_SZ = (size_t)1024 * 2816 * 2;
constexpr size_t WS_WIN = 68 * MiB;
constexpr size_t WIN_SZ = (size_t)5120 * 1024 * 2;
constexpr size_t WS_PAB = 88 * MiB;
constexpr size_t PAB_SZ = (size_t)2048 * 1024 * 2;
constexpr size_t WS_WO = 96 * MiB;
constexpr size_t WO_SZ = (size_t)1024 * 1024 * 2;
constexpr size_t WS_CW1 = 100 * MiB;
constexpr size_t CW1_SZ = (size_t)128 * 2048 * 2;
constexpr size_t WS_CW2 = 102 * MiB;
constexpr size_t CW2_SZ = (size_t)64 * 128 * 2;
constexpr size_t WS_KCN = 103 * MiB;
constexpr size_t WS_VCT = WS_KCN + 512 * 1024;
constexpr size_t WS_XN = 104 * MiB;
constexpr size_t WS_Z = 168 * MiB;
constexpr size_t Z_DQ = WS_Z, Z_DK = WS_Z + 32 * MiB, Z_DVT = WS_Z + 64 * MiB, Z_NQ = WS_Z + 96 * MiB;
constexpr size_t Z_KCR = WS_Z + 128 * MiB, Z_VCR = WS_Z + 136 * MiB, Z_KSEL = WS_Z + 144 * MiB, Z_VSELT = WS_Z + 152 * MiB;
constexpr size_t Z_KWIN = WS_Z + 160 * MiB, Z_VWINT = WS_Z + 168 * MiB, Z_NG = WS_Z + 176 * MiB, Z_MG = WS_Z + 180 * MiB;
constexpr size_t WS_MERGED = WS_Z;
constexpr size_t WS_HID = WS_Z;
constexpr size_t WS_SS = WS_Z + 308 * MiB;
constexpr size_t WS_END = WS_SS + 2 * MiB;
constexpr int LDS_BYTES = 147456;
constexpr int KP = 144, VP = 136;
constexpr int DA_STAGE = 2 * 64 * KP + 128 * VP;
constexpr int NS_STAGE = 64 * KP + 64 * VP;
constexpr int L_BIAS = 73728;
constexpr int TBN = 1216;
constexpr int L_IMP = L_BIAS + 4 * TBN * 4;
constexpr int L_SEL = L_IMP + 16384;
constexpr int L_WSF = L_SEL + 1024;
constexpr int L_END = L_WSF + 8 * 256;

struct Params {
    const float* in[30];
    float* out;
    unsigned char* ws;
};

constexpr int L_PTAB = LDS_BYTES - 1024;
__device__ __forceinline__ const float* ld_ptr(const LAS unsigned char* lds, int i) {
    unsigned a = L_PTAB + 8 * i; asm volatile("" : "+v"(a));
    const LAS unsigned* t = (const LAS unsigned*)(lds + a);
    const unsigned lo = __builtin_amdgcn_readfirstlane(t[0]), hi = __builtin_amdgcn_readfirstlane(t[1]);
    return (const float*)(((unsigned long long)hi << 32) | lo);
}
#define INP(i) ld_ptr(lds, (i))
#define OUTP ((float*)ld_ptr(lds, 30))
#define WSP ((unsigned char*)ld_ptr(lds, 31))

__device__ __forceinline__ unsigned f2bf(float f) { unsigned u = __builtin_bit_cast(unsigned, f); return (u + 0x7fffu + ((u >> 16) & 1u)) >> 16; }
__device__ __forceinline__ unsigned pk2(float lo, float hi) { return f2bf(lo) | (f2bf(hi) << 16); }
__device__ __forceinline__ float sigmoidf_(float x) { return __builtin_amdgcn_rcpf(1.0f + __builtin_amdgcn_exp2f(-x * LOG2E)); }
__device__ __forceinline__ int otid() { int t = threadIdx.x; asm volatile("" : "+v"(t)); return t; }
__device__ __forceinline__ int crow(int r, int hi) { return (r & 3) + 8 * (r >> 2) + 4 * hi; }


struct RowScale {
    const float* ss;
    __device__ __forceinline__ void rs_issue(const pg8::Unit& u, int tid, f32x4& pa, f32x4& pb) const {
        const float* p = ss + (size_t)(u.pm * 256 + (tid >> 1)) * 16 + (tid & 1) * 8; pa = GLD(f32x4, p); pb = GLD(f32x4, p + 4); }
    __device__ __forceinline__ void rs_write(int tid, const f32x4& pa, const f32x4& pb, LAS float* tab) const {
        float t = ((pa.x + pa.y) + (pa.z + pa.w)) + ((pb.x + pb.y) + (pb.z + pb.w)); t += __shfl_xor(t, 1);
        if (!(tid & 1)) tab[tid >> 1] = __builtin_amdgcn_rsqf(t * (1.f / DM) + EPS); }
};
struct EpiSwiGLU : RowScale {
    static constexpr bool PERM = true, AFTER_DRAIN = false, ROWSCALE = true, CHAIN = false;
    bf16_t* H;
    __device__ __forceinline__ void operator()(const f32x4 (&acc)[2][2][4][2], const pg8::Unit& u, int wr, int wc, int fr, int fq, const LAS float* rst) const {
        const int row0 = u.pm * 256 + wr * 64 + fr, col = u.pn * 128 + wc * 32 + 8 * fq;
#pragma unroll
        for (int ai = 0; ai < 2; ++ai)
#pragma unroll
            for (int m = 0; m < 4; ++m) {
                float h[8];
                const float rs = rst[ai * 128 + wr * 64 + m * 16 + fr];
#pragma unroll
                for (int n = 0; n < 2; ++n)
#pragma unroll
                    for (int e = 0; e < 4; ++e) { const float g = acc[ai][0][m][n][e] * rs, up = acc[ai][1][m][n][e] * rs; h[n * 4 + e] = g * sigmoidf_(g) * up; }
                u32x4 w; w.x = pg8::cvt_pk_bf16(h[0], h[1]); w.y = pg8::cvt_pk_bf16(h[2], h[3]); w.z = pg8::cvt_pk_bf16(h[4], h[5]); w.w = pg8::cvt_pk_bf16(h[6], h[7]);
                GST(u32x4, H + (size_t)(row0 + ai * 128 + m * 16) * DFF + col, w);
            }
    }
};
template <bool BF32, bool OF32> struct EpiResidT {
    static constexpr bool PERM = false, AFTER_DRAIN = false, ROWSCALE = false, CHAIN = false;
    const void* base; void* out; float alpha; float* ss;
    __device__ __forceinline__ void operator()(const f32x4 (&acc)[2][2][4][2], const pg8::Unit& u, int wr, int wc, int fr, int fq) const {
        const int row0 = u.pm * 256 + wr * 64 + fr, col0 = u.pn * 256 + wc * 32 + 4 * fq;
#pragma unroll
        for (int ai = 0; ai < 2; ++ai) {
            f32x4 bv[4][2][2];
#pragma unroll
            for (int m = 0; m < 4; ++m) {
                const size_t off = (size_t)(row0 + ai * 128 + m * 16) * DM + col0;
#pragma unroll
                for (int bj = 0; bj < 2; ++bj)
#pragma unroll
                    for (int n = 0; n < 2; ++n) {
                        if (BF32) bv[m][bj][n] = GLD(f32x4, (const float*)base + off + bj * 128 + n * 16);
                        else { const u32x2 w = GLD(u32x2, (const bf16_t*)base + off + bj * 128 + n * 16);
                               bv[m][bj][n] = (f32x4){__builtin_bit_cast(float, w.x << 16), __builtin_bit_cast(float, w.x & 0xffff0000u), __builtin_bit_cast(float, w.y << 16), __builtin_bit_cast(float, w.y & 0xffff0000u)}; }
                    }
            }
#pragma unroll
            for (int m = 0; m < 4; ++m) {
                const int row = row0 + ai * 128 + m * 16;
                const size_t off = (size_t)row * DM + col0;
                float sq = 0.f;
#pragma unroll
                for (int bj = 0; bj < 2; ++bj)
#pragma unroll
                    for (int n = 0; n < 2; ++n) {
                        const f32x4 o = bv[m][bj][n] + acc[ai][bj][m][n] * alpha;
                        sq += (o.x * o.x + o.y * o.y) + (o.z * o.z + o.w * o.w);
                        if (OF32) GST(f32x4, (float*)out + off + bj * 128 + n * 16, o);
                        else { u32x2 w; w.x = pg8::cvt_pk_bf16(o.x, o.y); w.y = pg8::cvt_pk_bf16(o.z, o.w); GST(u32x2, (bf16_t*)out + off + bj * 128 + n * 16, w); }
                    }
                if (!OF32) { sq += __shfl_xor(sq, 16); sq += __shfl_xor(sq, 32); if (fq == 0) GST(float, ss + (size_t)row * 16 + u.pn * 4 + wc, sq); }
            }
        }
    }
};
struct PairOrder {
    pg8::StaticOrder S;
    __device__ void init(int G_, int c_) { S.init(MTOK, DM, G_, c_); }
    __device__ bool next(int i, pg8::Unit& u) const { if (!S.next(i >> 1, u)) return false; if (i & 1) { u.pm += MTOK / 256; u.pn += DM / 256; } return true; }
    __device__ __forceinline__ void a_ready(const pg8::Unit&) const {}
    __device__ __forceinline__ void done(const pg8::Unit&) const {}
};
struct EpiMerge {
    static constexpr bool PERM = true, AFTER_DRAIN = false, ROWSCALE = false, CHAIN = true;
    const unsigned char* MG; bf16_t* O;
    __device__ __forceinline__ void chain(f32x4 (&acc)[2][2][4][2], const pg8::Unit& u, int wr, int wc, int fr, int fq) const {
        const int row0 = u.pm * 256 + wr * 64 + fr, col0 = u.pn * 256 + wc * 32 + 8 * fq;
#pragma unroll
        for (int ai = 0; ai < 2; ++ai) {
            u32x2 g0[4][2], g1[4][2];
#pragma unroll
            for (int m = 0; m < 4; ++m)
#pragma unroll
                for (int bj = 0; bj < 2; ++bj) { const unsigned char* p = MG + (size_t)(row0 + ai * 128 + m * 16) * 2048 + col0 + bj * 128; g0[m][bj] = GLD(u32x2, p); g1[m][bj] = GLD(u32x2, p + 1024); }
#pragma unroll
            for (int m = 0; m < 4; ++m)
#pragma unroll
                for (int bj = 0; bj < 2; ++bj)
#pragma unroll
                    for (int i = 0; i < 8; ++i) {
                        const unsigned q0 = (g0[m][bj][i >> 2] >> (8 * (i & 3))) & 0xffu, q1 = (g1[m][bj][i >> 2] >> (8 * (i & 3))) & 0xffu;
                        acc[ai][bj][m][i >> 2][i & 3] *= (float)q0 * __builtin_amdgcn_rcpf((float)(q1 ? q1 : 1u));
                    }
        }
    }
    __device__ __forceinline__ void operator()(const f32x4 (&acc)[2][2][4][2], const pg8::Unit& u, int wr, int wc, int fr, int fq) const {
        const int row0 = (u.pm - MTOK / 256) * 256 + wr * 64 + fr, col0 = (u.pn - DM / 256) * 256 + wc * 32 + 8 * fq;
#pragma unroll
        for (int ai = 0; ai < 2; ++ai) {
            u32x2 g1[4][2];
#pragma unroll
            for (int m = 0; m < 4; ++m)
#pragma unroll
                for (int bj = 0; bj < 2; ++bj) g1[m][bj] = GLD(u32x2, MG + (size_t)(row0 + ai * 128 + m * 16) * 2048 + 1024 + col0 + bj * 128);
#pragma unroll
            for (int m = 0; m < 4; ++m)
#pragma unroll
                for (int bj = 0; bj < 2; ++bj) {
                    float h[8];
#pragma unroll
                    for (int i = 0; i < 8; ++i) { const unsigned q1 = (g1[m][bj][i >> 2] >> (8 * (i & 3))) & 0xffu; h[i] = acc[ai][bj][m][i >> 2][i & 3] * ((float)(q1 ? q1 : 1u) * (1.f / 255.f)); }
                    u32x4 w; w.x = pg8::cvt_pk_bf16(h[0], h[1]); w.y = pg8::cvt_pk_bf16(h[2], h[3]); w.z = pg8::cvt_pk_bf16(h[4], h[5]); w.w = pg8::cvt_pk_bf16(h[6], h[7]);
                    GST(u32x4, O + (size_t)(row0 + ai * 128 + m * 16) * DM + col0 + bj * 128, w);
                }
        }
    }
};
struct EpiZ : RowScale {
    static constexpr bool PERM = true, AFTER_DRAIN = false, ROWSCALE = true, CHAIN = false;
    unsigned char* ws; const float *gq, *gk, *gnq, *gnk;
    __device__ __forceinline__ void operator()(const f32x4 (&acc)[2][2][4][2], const pg8::Unit& u, int wr, int wc, int fr, int fq, const LAS float* rst) const {
        const int ch = 4 * u.pn + wc;
        if (ch >= 77) return;
        const int row0 = u.pm * 256 + wr * 64 + fr;
        int kind, nh = 8, hd = 0, nd = 64, dbase = 0; size_t dst = 0; const float* gain = nullptr; float scale = 1.f;
        if (ch < 8) { kind = 0; dst = Z_DQ; hd = ch; gain = gq; scale = QSCALE; }
        else if (ch < 16) { kind = 0; dst = Z_DK; hd = ch - 8; gain = gk; }
        else if (ch < 24) { kind = 2; dst = Z_DVT; nh = 4; hd = (ch - 16) >> 1; nd = 128; dbase = ((ch - 16) & 1) * 64; }
        else if (ch < 32) { kind = 0; dst = Z_NQ; hd = ch - 24; gain = gnq; scale = QSCALE; }
        else if (ch < 34) { kind = 1; dst = Z_KCR; nh = 2; hd = ch - 32; }
        else if (ch < 36) { kind = 1; dst = Z_VCR; nh = 2; hd = ch - 34; }
        else if (ch < 38) { kind = 0; dst = Z_KSEL; nh = 2; hd = ch - 36; gain = gnk + 64; }
        else if (ch < 40) { kind = 2; dst = Z_VSELT; nh = 2; hd = ch - 38; }
        else if (ch < 42) { kind = 0; dst = Z_KWIN; nh = 2; hd = ch - 40; gain = gnk + 128; }
        else if (ch < 44) { kind = 2; dst = Z_VWINT; nh = 2; hd = ch - 42; }
        else if (ch < 76) { kind = 3; }
        else { kind = 4; }
        if (kind == 0 || kind == 1) {
            float gv[16];
#pragma unroll
            for (int i = 0; i < 16; ++i) gv[i] = (kind == 0) ? gain[(i >> 3) * 32 + 8 * fq + (i & 7)] * scale : 1.f;
#pragma unroll
            for (int ai = 0; ai < 2; ++ai)
#pragma unroll
                for (int m = 0; m < 4; ++m) {
                    const int row = row0 + ai * 128 + m * 16, b = row >> 12, s = row & 4095;
                    float v[16];
                    const float rrs = rst[ai * 128 + wr * 64 + m * 16 + fr];
#pragma unroll
                    for (int i = 0; i < 16; ++i) v[i] = acc[ai][i >> 3][m][(i >> 2) & 1][i & 3] * rrs;
                    float rs = 1.f;
                    if (kind == 0) {
                        float ss = 0.f;
#pragma unroll
                        for (int i = 0; i < 16; ++i) ss += v[i] * v[i];
                        ss += __shfl_xor(ss, 16); ss += __shfl_xor(ss, 32);
                        rs = __builtin_amdgcn_rsqf(ss * (1.f / 64.f) + EPS);
                    }
#pragma unroll
                    for (int i = 0; i < 16; ++i) v[i] *= rs * gv[i];
                    bf16_t* d = (bf16_t*)(ws + dst) + ((size_t)(b * nh + hd) * SEQ + s) * 64 + 8 * fq;
                    u32x4 w0, w1;
                    w0.x = pg8::cvt_pk_bf16(v[0], v[1]); w0.y = pg8::cvt_pk_bf16(v[2], v[3]); w0.z = pg8::cvt_pk_bf16(v[4], v[5]); w0.w = pg8::cvt_pk_bf16(v[6], v[7]);
                    w1.x = pg8::cvt_pk_bf16(v[8], v[9]); w1.y = pg8::cvt_pk_bf16(v[10], v[11]); w1.z = pg8::cvt_pk_bf16(v[12], v[13]); w1.w = pg8::cvt_pk_bf16(v[14], v[15]);
                    GST(u32x4, d, w0); GST(u32x4, d + 32, w1);
                }
        } else if (kind == 2) {
#pragma unroll
            for (int ai = 0; ai < 2; ++ai)
#pragma unroll
                for (int m = 0; m < 4; ++m) {
                    const int row = row0 + ai * 128 + m * 16, b = row >> 12, s = row & 4095;
                    bf16_t* d = (bf16_t*)(ws + dst) + ((size_t)(b * nh + hd) * nd + dbase + 8 * fq) * SEQ + s;
                    const float rrs = rst[ai * 128 + wr * 64 + m * 16 + fr];
#pragma unroll
                    for (int i = 0; i < 16; ++i) GST(bf16_t, d + (size_t)((i >> 3) * 32 + (i & 7)) * SEQ, (bf16_t)f2bf(acc[ai][i >> 3][m][(i >> 2) & 1][i & 3] * rrs));
                }
        } else if (kind == 3) {
            const int col = (ch - 44) * 64 + 8 * fq;
#pragma unroll
            for (int ai = 0; ai < 2; ++ai)
#pragma unroll
                for (int m = 0; m < 4; ++m) {
                    const int row = row0 + ai * 128 + m * 16;
                    float v[16];
                    const float rrs = rst[ai * 128 + wr * 64 + m * 16 + fr];
#pragma unroll
                    for (int i = 0; i < 16; ++i) v[i] = sigmoidf_(acc[ai][i >> 3][m][(i >> 2) & 1][i & 3] * rrs);
                    unsigned char* d = (unsigned char*)(ws + Z_MG) + (size_t)row * 2048 + col;
                    unsigned q[16];
#pragma unroll
                    for (int i = 0; i < 16; ++i) q[i] = (unsigned)__builtin_rintf(v[i] * 255.f);
                    u32x2 w0, w1;
                    w0.x = q[0] | (q[1] << 8) | (q[2] << 16) | (q[3] << 24); w0.y = q[4] | (q[5] << 8) | (q[6] << 16) | (q[7] << 24);
                    w1.x = q[8] | (q[9] << 8) | (q[10] << 16) | (q[11] << 24); w1.y = q[12] | (q[13] << 8) | (q[14] << 16) | (q[15] << 24);
                    GST(u32x2, d, w0); GST(u32x2, d + 32, w1);
                }
        } else {
            if (fq < 3) {
#pragma unroll
                for (int ai = 0; ai < 2; ++ai)
#pragma unroll
                    for (int m = 0; m < 4; ++m) {
                        const int row = row0 + ai * 128 + m * 16;
                        float* d = (float*)(ws + Z_NG) + (size_t)row * 24 + 8 * fq;
                        const float rrs = rst[ai * 128 + wr * 64 + m * 16 + fr];
#pragma unroll
                        for (int i = 0; i < 8; ++i) GST(float, d + i, sigmoidf_(acc[ai][0][m][i >> 2][i & 3] * rrs));
                    }
            }
        }
    }
};

__device__ __forceinline__ void tr_item(const float* src, int ld, int c0, int nvalid, int k0, bf16_t* dst, int Kdst, LAS float* scr, int lane, const float* rsc = nullptr) {
    const int n = lane & 31;
#pragma unroll
    for (int i = 0; i < 32; ++i) { const int kk = 2 * i + (lane >> 5); scr[kk * 33 + n] = (src && n < nvalid) ? GLD(float, src + (size_t)(k0 + kk) * ld + c0 + n) * (rsc ? GLD(float, rsc + k0 + kk) : 1.f) : 0.f; }
    asm volatile("s_waitcnt lgkmcnt(0)" ::: "memory");
    const int c = lane & 7;
#pragma unroll
    for (int j = 0; j < 4; ++j) { const int nn = (lane >> 3) + 8 * j; const LAS float* s = scr + (8 * c) * 33 + nn;
        u32x4 o; o.x = pk2(s[0 * 33], s[1 * 33]); o.y = pk2(s[2 * 33], s[3 * 33]); o.z = pk2(s[4 * 33], s[5 * 33]); o.w = pk2(s[6 * 33], s[7 * 33]);
        GST(u32x4, dst + (size_t)nn * Kdst + 8 * c, o); }
    asm volatile("s_waitcnt lgkmcnt(0)" ::: "memory");
}
__device__ __forceinline__ int zchunk_src(int ch) {
    if (ch < 32) return ch * 64;
    if (ch < 44) return 2048 + (ch - 32) * 64;
    if (ch < 76) return 2840 + (ch - 44) * 64;
    return 2816;
}
__device__ __forceinline__ int t5_bucket(int n) {
    if (n < 16) return n;
    int b = 16;
    b += (n >= 21); b += (n >= 27); b += (n >= 35); b += (n >= 46); b += (n >= 59); b += (n >= 77); b += (n >= 99); b += (n >= 128);
    b += (n >= 166); b += (n >= 216); b += (n >= 280); b += (n >= 363); b += (n >= 470); b += (n >= 609); b += (n >= 790);
    return b;
}
__device__ __forceinline__ void prologue(const Params& P, LAS unsigned char* lds) {
    const int tid = otid(), lane = tid & 63, wave = tid >> 6;
    LAS float* scr = (LAS float*)(lds + wave * 16384);
    const int gw = blockIdx.x * NWAVE + wave, NGW = gridDim.x * NWAVE;
    unsigned char* ws = WSP;
    constexpr int I13 = 176 * 16, I2 = 32 * 44, IIN = 160 * 16, IPAB = 64 * 8, IWO = 32 * 16, IC1 = 4 * 32, IC2 = 2 * 2;
    constexpr int PER_L = 2 * I13 + 2 * I2 + IIN + IPAB + IWO + 2 * IC1 + 2 * IC2;
    for (int it = gw; it < DEPTH * PER_L; it += NGW) {
        const int l = it / PER_L; int r = it % PER_L;
        if (r < 2 * I13) {
            const int f = r / I13; r %= I13; const int gi = r / 16, kb = r % 16;
            const int t = gi >> 3, bj = (gi >> 2) & 1, sub = gi & 3;
            const float* src = (f ? (bj ? INP(12) : INP(11)) : (bj ? INP(9) : INP(8))) + (size_t)l * DM * DFF;
            tr_item(src, DFF, 128 * t + 32 * sub, 32, 64 * kb, (bf16_t*)(ws + WS_W13 + (size_t)(l * 2 + f) * W13_SZ) + (size_t)(32 * gi) * DM + 64 * kb, DM, scr, lane, (f ? INP(7) : INP(5)) + l * DM);
            continue;
        }
        r -= 2 * I13;
        if (r < 2 * I2) {
            const int f = r / I2; r %= I2; const int gi = r / 44, kb = r % 44;
            const float* src = (f ? INP(13) : INP(10)) + (size_t)l * DFF * DM;
            tr_item(src, DM, 32 * gi, 32, 64 * kb, (bf16_t*)(ws + WS_W2 + (size_t)(l * 2 + f) * W2_SZ) + (size_t)(32 * gi) * DFF + 64 * kb, DFF, scr, lane);
            continue;
        }
        r -= 2 * I2;
        if (r < IIN) {
            const int gi = r / 16, kb = r % 16;
            const int t = gi >> 3, bj = (gi >> 2) & 1, wc = gi & 3, ch = 4 * t + wc;
            int nvalid = 32; if (ch == 76) nvalid = bj ? 0 : 24; if (ch > 76) nvalid = 0;
            const float* src = nvalid ? INP(1) + (size_t)l * DM * NIN : nullptr;
            tr_item(src, NIN, zchunk_src(ch) + 32 * bj, nvalid, 64 * kb, (bf16_t*)(ws + WS_WIN + (size_t)l * WIN_SZ) + (size_t)(32 * gi) * DM + 64 * kb, DM, scr, lane, INP(6) + l * DM);
            continue;
        }
        r -= IIN;
        if (r < IPAB) {
            const int gi = r / 8, kb = r % 8;
            const float* src = (gi < 32 ? INP(2) : INP(3)) + (size_t)l * 512 * DM;
            tr_item(src, DM, 32 * (gi & 31), 32, 64 * kb, (bf16_t*)(ws + WS_PAB + (size_t)l * PAB_SZ) + (size_t)(32 * gi) * 512 + 64 * kb, 512, scr, lane);
            continue;
        }
        r -= IPAB;
        if (r < IWO) {
            const int gi = r / 16, kb = r % 16;
            tr_item(INP(4) + (size_t)l * DM * DM, DM, 32 * gi, 32, 64 * kb, (bf16_t*)(ws + WS_WO + (size_t)l * WO_SZ) + (size_t)(32 * gi) * DM + 64 * kb, DM, scr, lane);
            continue;
        }
        r -= IWO;
        if (r < 2 * IC1) {
            const int kv = r / IC1; r %= IC1; const int gi = r / 32, kb = r % 32;
            tr_item((kv ? INP(27) : INP(24)) + (size_t)l * 2048 * 128, 128, 32 * gi, 32, 64 * kb, (bf16_t*)(ws + WS_CW1 + (size_t)(l * 2 + kv) * CW1_SZ) + (size_t)(32 * gi) * 2048 + 64 * kb, 2048, scr, lane);
            continue;
        }
        r -= 2 * IC1;
        {
            const int kv = r / IC2; r %= IC2; const int gi = r / 2, kb = r % 2;
            tr_item((kv ? INP(28) : INP(25)) + (size_t)l * 128 * 64, 64, 32 * gi, 32, 64 * kb, (bf16_t*)(ws + WS_CW2 + (size_t)(l * 2 + kv) * CW2_SZ) + (size_t)(32 * gi) * 128 + 64 * kb, 128, scr, lane);
        }
    }
    const int gt = blockIdx.x * NTHR + tid, NGT = gridDim.x * NTHR;
    for (int i = gt; i < 12 * 1024; i += NGT) { const int h = i >> 10, d = i & 1023; ((float*)(ws + WS_BIAS))[i] = INP(29)[t5_bucket(d) * 12 + h] * LOG2E; }
    if (blockIdx.x == (gridDim.x > 1 ? 1 : 0) && wave < DEPTH) {
        const int l = wave;
        float a = INP(16)[l * 64 + lane] * INP(17)[l * 64 + lane], b = INP(18)[l * 64 + lane] * INP(19)[l * 64 + lane];
        float mq = fabsf(INP(14)[l * 64 + lane]), mk = fabsf(INP(15)[l * 64 + lane]), mnq = fabsf(INP(21)[l * 64 + lane]);
        float mnk = fmaxf(fmaxf(fabsf(INP(22)[l * 192 + lane]), fabsf(INP(22)[l * 192 + 64 + lane])), fabsf(INP(22)[l * 192 + 128 + lane]));
        float mb = 0.f; for (int i = lane; i < 32 * 12; i += 64) mb = fmaxf(mb, fabsf(INP(29)[i]));
#pragma unroll
        for (int o = 1; o < 64; o <<= 1) { a += __shfl_xor(a, o); b += __shfl_xor(b, o); mq = fmaxf(mq, __shfl_xor(mq, o)); mk = fmaxf(mk, __shfl_xor(mk, o)); mnq = fmaxf(mnq, __shfl_xor(mnq, o)); mnk = fmaxf(mnk, __shfl_xor(mnk, o)); mb = fmaxf(mb, __shfl_xor(mb, o)); }
        if (lane == 0) {
            float* prm = (float*)(ws + WS_PRM) + l * 8;
            const float lam_init = 0.8f - 0.6f * expf(-0.3f * (float)l);
            prm[0] = expf(a) - expf(b) + lam_init;
            prm[1] = (8.f * mq * mk * 1.02f + mb) * LOG2E;
            prm[2] = (8.f * mnq * mnk * 1.02f + mb) * LOG2E;
            prm[3] = 1.0f - lam_init;
        }
    }
    for (int wi = blockIdx.x; wi < 32; wi += gridDim.x) {
        const int lk = wi >> 3, n = (wi & 7) * 16 + (tid & 15), ks = tid >> 4, l = lk >> 1, kv = lk & 1;
        const float* pe = (kv ? INP(26) : INP(23)) + (size_t)l * 2048; const float* w1 = (kv ? INP(27) : INP(24)) + (size_t)l * 2048 * 128;
        float sacc = 0.f;
#pragma unroll 16
        for (int k = 64 * ks; k < 64 * ks + 64; ++k) sacc += GLD(float, pe + k) * GLD(float, w1 + (size_t)k * 128 + n);
        LAS float* red = (LAS float*)lds;
        __syncthreads();
        red[tid] = sacc;
        __syncthreads();
        if (tid < 16) { float t = 0.f; for (int i = 0; i < 32; ++i) t += red[i * 16 + tid]; ((float*)(ws + WS_CB1))[lk * 128 + (wi & 7) * 16 + tid] = t; }
        __syncthreads();
    }
}

template <bool INBF16, bool COPYRAW>
__device__ __forceinline__ void rmsnorm_phase(const void* x, const float* g, bf16_t* o, bf16_t* xraw = nullptr) {
    const int tid = otid(), lane = tid & 63, wave = tid >> 6;
    const int gw = blockIdx.x * NWAVE + wave, NGW = gridDim.x * NWAVE;
    f32x4 gv[4];
#pragma unroll
    for (int j = 0; j < 4; ++j) gv[j] = GLD(f32x4, (const f32x4*)g + lane + 64 * j);
    constexpr int RB = 4;
    for (int m0 = gw; m0 < MTOK; m0 += NGW * RB) {
        f32x4 v[RB][4]; float s[RB];
#pragma unroll
        for (int r = 0; r < RB; ++r) { const int m = m0 + r * NGW; const size_t ro = (size_t)(m < MTOK ? m : m0) * DM;
#pragma unroll
            for (int j = 0; j < 4; ++j) {
                if (!INBF16) v[r][j] = GLD(f32x4, (const f32x4*)((const float*)x + ro) + lane + 64 * j);
                else { const u32x2 w = GLD(u32x2, (const u32x2*)((const bf16_t*)x + ro) + lane + 64 * j);
                       if (COPYRAW && m < MTOK) GST(u32x2, (u32x2*)(xraw + ro) + lane + 64 * j, w);
                       v[r][j] = (f32x4){__builtin_bit_cast(float, w.x << 16), __builtin_bit_cast(float, w.x & 0xffff0000u), __builtin_bit_cast(float, w.y << 16), __builtin_bit_cast(float, w.y & 0xffff0000u)}; }
            } }
#pragma unroll
        for (int r = 0; r < RB; ++r) { s[r] = 0.f;
#pragma unroll
            for (int j = 0; j < 4; ++j) s[r] += (v[r][j].x * v[r][j].x + v[r][j].y * v[r][j].y) + (v[r][j].z * v[r][j].z + v[r][j].w * v[r][j].w); }
#pragma unroll
        for (int of = 1; of < 64; of <<= 1) {
#pragma unroll
            for (int r = 0; r < RB; ++r) s[r] += __shfl_xor(s[r], of); }
#pragma unroll
        for (int r = 0; r < RB; ++r) { const int m = m0 + r * NGW;
            if (m < MTOK) {
                const float rs = __builtin_amdgcn_rsqf(s[r] * (1.f / DM) + EPS);
                u32x2* o8 = (u32x2*)(o + (size_t)m * DM) + lane;
#pragma unroll
                for (int j = 0; j < 4; ++j) { u32x2 w; w.x = pk2(v[r][j].x * rs * gv[j].x, v[r][j].y * rs * gv[j].y); w.y = pk2(v[r][j].z * rs * gv[j].z, v[r][j].w * rs * gv[j].w); GST(u32x2, o8 + 64 * j, w); }
            }
        }
    }
}

__device__ __forceinline__ void xprep_phase(const float* x, bf16_t* o, float* ss) {
    const int tid = otid(), lane = tid & 63, wave = tid >> 6;
    const int gw = blockIdx.x * NWAVE + wave, NGW = gridDim.x * NWAVE;
    for (int m = gw; m < MTOK; m += NGW) {
        const f32x4* xr = (const f32x4*)(x + (size_t)m * DM) + lane;
        f32x4 v[4]; float s = 0.f;
#pragma unroll
        for (int j = 0; j < 4; ++j) { v[j] = GLD(f32x4, xr + 64 * j); s += (v[j].x * v[j].x + v[j].y * v[j].y) + (v[j].z * v[j].z + v[j].w * v[j].w); }
#pragma unroll
        for (int of = 1; of < 64; of <<= 1) s += __shfl_xor(s, of);
        u32x2* o8 = (u32x2*)(o + (size_t)m * DM) + lane;
#pragma unroll
        for (int j = 0; j < 4; ++j) { u32x2 w; w.x = pk2(v[j].x, v[j].y); w.y = pk2(v[j].z, v[j].w); GST(u32x2, o8 + 64 * j, w); }
        if (lane < 16) GST(float, ss + (size_t)m * 16 + lane, lane == 0 ? s : 0.f);
    }
}

__device__ __forceinline__ float gelu_tanh(float x) {
    const float y = 0.7978845608028654f * (x + 0.044715f * x * x * x);
    const float e = __builtin_amdgcn_exp2f(2.f * LOG2E * y);
    const float t = 1.f - 2.f * __builtin_amdgcn_rcpf(e + 1.f);
    return 0.5f * x * (1.f + t);
}
__device__ __forceinline__ void compress_phase(const Params& P, int l, LAS unsigned char* lds) {
    const int tid = otid(), lane = tid & 63, wave = tid >> 6, fr = lane & 15, kq = lane >> 4;
    unsigned char* ws = WSP;
    LAS bf16_t* Hs = (LAS bf16_t*)lds;
    LAS float* Os = (LAS float*)(lds + 8704);
    LAS unsigned char* As = lds + 17408;
    for (int unit = blockIdx.x; unit < 2 * 16 * 8; unit += gridDim.x) {
        const int kv = unit >> 7, bg = (unit >> 3) & 15, c0 = 32 * (unit & 7);
        const bf16_t* src = (const bf16_t*)(ws + (kv ? Z_VCR : Z_KCR)) + (size_t)bg * SEQ * 64;
        for (int i = tid; i < 33 * 128; i += NTHR) {
            const int j = i >> 7, pc = i & 127;
            u32x4 v = {0u, 0u, 0u, 0u};
            if (c0 + j <= 255) v = GLD(u32x4, (const unsigned char*)(src + (size_t)1024 * (c0 + j)) + pc * 16);
            *(LAS u32x4*)(As + j * 2064 + pc * 16) = v;
        }
        __syncthreads();
        const bf16_t* bp = (const bf16_t*)(ws + WS_CW1 + (size_t)(l * 2 + kv) * CW1_SZ) + (size_t)(16 * wave + fr) * 2048 + 8 * kq;
        f32x4 acc0 = {0.f, 0.f, 0.f, 0.f}, acc1 = {0.f, 0.f, 0.f, 0.f};
#pragma unroll
        for (int kb = 0; kb < 4; ++kb) {
            bf16x8 bfr[16];
#pragma unroll
            for (int i = 0; i < 16; ++i) bfr[i] = GLD(bf16x8, bp + 32 * (16 * kb + i));
#pragma unroll
            for (int i = 0; i < 16; ++i) {
                const int k = 32 * (16 * kb + i) + 8 * kq;
                const LAS unsigned char* ar = As + (fr + (k >> 10)) * 2064 + (k & 1023) * 2;
                const bf16x8 a0 = *(const LAS bf16x8*)ar, a1 = *(const LAS bf16x8*)(ar + 16 * 2064);
                acc0 = __builtin_amdgcn_mfma_f32_16x16x32_bf16(a0, bfr[i], acc0, 0, 0, 0);
                acc1 = __builtin_amdgcn_mfma_f32_16x16x32_bf16(a1, bfr[i], acc1, 0, 0, 0);
            }
        }
        const float cb = ((const float*)(ws + WS_CB1))[(l * 2 + kv) * 128 + 16 * wave + fr];
#pragma unroll
        for (int i = 0; i < 4; ++i) { Hs[(4 * kq + i) * 136 + 16 * wave + fr] = (bf16_t)f2bf(gelu_tanh(acc0[i] + cb)); Hs[(16 + 4 * kq + i) * 136 + 16 * wave + fr] = (bf16_t)f2bf(gelu_tanh(acc1[i] + cb)); }
        __syncthreads();
        {
            const int mt = wave >> 2, ns = wave & 3;
            const bf16_t* b2 = (const bf16_t*)(ws + WS_CW2 + (size_t)(l * 2 + kv) * CW2_SZ) + (size_t)(16 * ns + fr) * 128 + 8 * kq;
            f32x4 a2 = {0.f, 0.f, 0.f, 0.f};
#pragma unroll
            for (int kk = 0; kk < 4; ++kk) { const bf16x8 a = *(const LAS bf16x8*)(Hs + (16 * mt + fr) * 136 + 32 * kk + 8 * kq), b = GLD(bf16x8, b2 + 32 * kk); a2 = __builtin_amdgcn_mfma_f32_16x16x32_bf16(a, b, a2, 0, 0, 0); }
#pragma unroll
            for (int i = 0; i < 4; ++i) Os[(16 * mt + 4 * kq + i) * 65 + 16 * ns + fr] = a2[i];
        }
        __syncthreads();
#pragma unroll
        for (int rep = 0; rep < 4; ++rep) {
            const int e = tid + NTHR * rep, row = e >> 6, d = e & 63, c = c0 + row;
            const float val = Os[row * 65 + d];
            if (kv == 0) {
                float ss = 0.f;
#pragma unroll 16
                for (int j = 0; j < 64; ++j) { const float t = Os[row * 65 + j]; ss += t * t; }
                const float o = val * __builtin_amdgcn_rsqf(ss * (1.f / 64.f) + EPS) * GLD(float, INP(22) + l * 192 + d);
                GST(bf16_t, (bf16_t*)(ws + WS_KCN) + ((size_t)bg * 256 + c) * 64 + d, (c < 255) ? (bf16_t)f2bf(o) : (bf16_t)0);
            } else {
                GST(bf16_t, (bf16_t*)(ws + WS_VCT) + ((size_t)bg * 64 + d) * 256 + c, (c < 255) ? (bf16_t)f2bf(val) : (bf16_t)0);
            }
        }
        __syncthreads();
    }
}

__device__ __forceinline__ void qk_tile(f32x16& p0, f32x16& p1, const LAS unsigned char* Kl, const bf16x8 (&qf)[4], int r32, int hi) {
    const LAS unsigned char* kb = Kl + r32 * KP + hi * 16;
    bf16x8 a[8];
#pragma unroll
    for (int d0 = 0; d0 < 4; ++d0) { a[2 * d0] = *(const LAS bf16x8*)(kb + d0 * 32); a[2 * d0 + 1] = *(const LAS bf16x8*)(kb + 32 * KP + d0 * 32); }
    __builtin_amdgcn_s_setprio(1);
#pragma unroll
    for (int d0 = 0; d0 < 4; ++d0) {
        p0 = __builtin_amdgcn_mfma_f32_32x32x16_bf16(a[2 * d0], qf[d0], p0, 0, 0, 0);
        p1 = __builtin_amdgcn_mfma_f32_32x32x16_bf16(a[2 * d0 + 1], qf[d0], p1, 0, 0, 0);
    }
    __builtin_amdgcn_s_setprio(0);
}
template <int STRIDE, bool WINDOW, int MODE>
__device__ __forceinline__ void score_exp(f32x16& p0, f32x16& p1, int dl, const LAS float* tb, float cfar, bool rowsel) {
    const LAS float* tl = tb + 128 + (dl < 1087 ? dl : 1087) - 59;
#pragma unroll
    for (int blk = 0; blk < 2; ++blk) {
        f32x16& p = blk ? p1 : p0;
#pragma unroll
        for (int r = 0; r < 16; ++r) {
            const int c = (r & 3) + 8 * (r >> 2) + 32 * blk;
            const int dist = dl - STRIDE * c;
            float e;
            if (MODE == 0) e = __builtin_amdgcn_exp2f(p[r] + cfar);
            else {
                float bias;
                if (STRIDE == 1) bias = tl[59 - c];
                else bias = tb[128 + min((unsigned)dist, 1023u)];
                e = __builtin_amdgcn_exp2f(p[r] + bias);
                if (MODE == 2) { bool valid = dist >= 0; if (WINDOW) valid = valid && (dist < 512); e = valid ? e : 0.f; }
            }
            p[r] = rowsel ? e : 0.f;
        }
    }
}
template <int STRIDE, bool WINDOW>
__device__ __forceinline__ void score_exp_sel(f32x16& p0, f32x16& p1, int dl, const LAS float* tb, float cfar, bool rowsel, int dmin, int dmax) {
    if (!WINDOW && dmin >= 790) score_exp<STRIDE, WINDOW, 0>(p0, p1, dl, tb, cfar, rowsel);
    else if (dmin >= 0 && (!WINDOW || dmax < 512)) score_exp<STRIDE, WINDOW, 1>(p0, p1, dl, tb, cfar, rowsel);
    else score_exp<STRIDE, WINDOW, 2>(p0, p1, dl, tb, cfar, rowsel);
}
template <int STRIDE, bool WINDOW, int MODE>
__device__ __forceinline__ void qk_score_m(f32x16& p0, f32x16& p1, const LAS unsigned char* Kl, const bf16x8 (&qf)[4], int r32, int hi, int dl, const LAS float* tb, float cfar, bool rowsel) {
    const LAS float* tl = tb + 128 + (dl < 1087 ? dl : 1087) - 59;
#pragma unroll
    for (int blk = 0; blk < 2; ++blk) {
        f32x16& p = blk ? p1 : p0;
#pragma unroll
        for (int r = 0; r < 16; ++r) {
            const int c = (r & 3) + 8 * (r >> 2) + 32 * blk;
            if (MODE == 0) p[r] = cfar;
            else if (STRIDE == 1) p[r] = tl[59 - c];
            else p[r] = tb[128 + min((unsigned)(dl - STRIDE * c), 1023u)];
        }
    }
    qk_tile(p0, p1, Kl, qf, r32, hi);
#pragma unroll
    for (int blk = 0; blk < 2; ++blk) {
        f32x16& p = blk ? p1 : p0;
#pragma unroll
        for (int r = 0; r < 16; ++r) {
            const int dist = dl - STRIDE * ((r & 3) + 8 * (r >> 2) + 32 * blk);
            float e = __builtin_amdgcn_exp2f(p[r]);
            if (MODE == 2) { bool valid = dist >= 0; if (WINDOW) valid = valid && (dist < 512); e = valid ? e : 0.f; }
            p[r] = rowsel ? e : 0.f;
        }
    }
}
template <int STRIDE, bool WINDOW>
__device__ __forceinline__ void qk_score(f32x16& p0, f32x16& p1, const LAS unsigned char* Kl, const bf16x8 (&qf)[4], int r32, int hi, int dl, const LAS float* tb, float cfar, bool rowsel, int dmin, int dmax) {
    if (!WINDOW && dmin >= 790) qk_score_m<STRIDE, WINDOW, 0>(p0, p1, Kl, qf, r32, hi, dl, tb, cfar, rowsel);
    else if (dmin >= 0 && (!WINDOW || dmax < 512)) qk_score_m<STRIDE, WINDOW, 1>(p0, p1, Kl, qf, r32, hi, dl, tb, cfar, rowsel);
    else qk_score_m<STRIDE, WINDOW, 2>(p0, p1, Kl, qf, r32, hi, dl, tb, cfar, rowsel);
}
__device__ __forceinline__ float sum32(const f32x16& p0, const f32x16& p1) {
    float a = 0.f, b = 0.f;
#pragma unroll
    for (int r = 0; r < 16; ++r) { a += p0[r]; b += p1[r]; }
    return a + b;
}
template <int NDB>
__device__ __forceinline__ void pv_tile(f32x16 (&o)[NDB], const f32x16& p0, const f32x16& p1, const LAS unsigned char* Vl, int r32, int hi) {
    const LAS unsigned char* vbase = Vl + r32 * VP + hi * 8;
    bf16x4 vf[2][NDB][2];
#define PV_LOAD(st, buf) do { _Pragma("unroll") for (int db = 0; db < NDB; ++db) { const LAS unsigned char* vp = vbase + db * 32 * VP + (st) * 32; vf[buf][db][0] = *(const LAS bf16x4*)vp; vf[buf][db][1] = *(const LAS bf16x4*)(vp + 16); } } while (0)
    PV_LOAD(0, 0);
#pragma unroll
    for (int st = 0; st < 4; ++st) {
        if (st + 1 < 4) PV_LOAD(st + 1, (st + 1) & 1);
        const f32x16& p = (st >> 1) ? p1 : p0; const int s8 = 8 * (st & 1);
        u32x4 w; w.x = pg8::cvt_pk_bf16(p[s8 + 0], p[s8 + 1]); w.y = pg8::cvt_pk_bf16(p[s8 + 2], p[s8 + 3]); w.z = pg8::cvt_pk_bf16(p[s8 + 4], p[s8 + 5]); w.w = pg8::cvt_pk_bf16(p[s8 + 6], p[s8 + 7]);
        const bf16x8 pa = __builtin_bit_cast(bf16x8, w);
        __builtin_amdgcn_s_setprio(1);
#pragma unroll
        for (int db = 0; db < NDB; ++db) {
            const bf16x4 lo = vf[st & 1][db][0], hi4 = vf[st & 1][db][1];
            const bf16x8 vb = {lo[0], lo[1], lo[2], lo[3], hi4[0], hi4[1], hi4[2], hi4[3]};
            o[db] = __builtin_amdgcn_mfma_f32_32x32x16_bf16(pa, vb, o[db], 0, 0, 0);
        }
        __builtin_amdgcn_s_setprio(0);
    }
#undef PV_LOAD
}
__device__ __forceinline__ u32x4 ldk(const bf16_t* g, int tid) { return GLD(u32x4, (const unsigned char*)g + tid * 16); }
__device__ __forceinline__ void stk(LAS unsigned char* Kl, u32x4 v, int tid) { *(LAS u32x4*)(Kl + (tid >> 3) * KP + (tid & 7) * 16) = v; }
__device__ __forceinline__ u32x4 ldv(const bf16_t* g, size_t rs, int row, int tid) { return GLD(u32x4, (const unsigned char*)(g + (size_t)row * rs) + (tid & 7) * 16); }
__device__ __forceinline__ void stv(LAS unsigned char* Vl, u32x4 v, int row, int tid) { LAS unsigned char* p = Vl + row * VP + (tid & 7) * 16; *(LAS u32x2*)p = (u32x2){v.x, v.y}; *(LAS u32x2*)(p + 8) = (u32x2){v.z, v.w}; }

__device__ __forceinline__ void da_unit(const Params& P, int l, int b, int h, int qb, LAS unsigned char* lds, bool load_tab) {
    const int tid = otid(), lane = tid & 63, wave = __builtin_amdgcn_readfirstlane(tid >> 6), r32 = lane & 31, hi = lane >> 5;
    const int c = wave >> 2, qsub = wave & 3, q0 = qb * 128, qw0 = q0 + 32 * qsub;
    unsigned char* ws = WSP;
    const float* prm = (const float*)(ws + WS_PRM) + l * 8;
    const float lam = prm[0], Mb = prm[1], onem = prm[3];
    LAS float* biasL = (LAS float*)(lds + L_BIAS);
    const float* bg = (const float*)(ws + WS_BIAS) + h * 1024;
    if (load_tab) for (int i = tid; i < TBN; i += NTHR) { const int d = i - 128; biasL[i] = GLD(float, bg + (d < 0 ? 0 : (d > 1023 ? 1023 : d))) - Mb; }
    const float cfar = bg[1023] - Mb;
    const bf16_t* Qp = (const bf16_t*)(ws + Z_DQ) + ((size_t)(b * 8 + h * 2 + c) * SEQ + qw0 + r32) * 64 + hi * 8;
    bf16x8 qf[4];
#pragma unroll
    for (int d0 = 0; d0 < 4; ++d0) qf[d0] = GLD(bf16x8, Qp + d0 * 16);
    const bf16_t* K1g = (const bf16_t*)(ws + Z_DK) + (size_t)(b * 8 + h * 2) * SEQ * 64;
    const bf16_t* K2g = K1g + (size_t)SEQ * 64;
    const bf16_t* Vg = (const bf16_t*)(ws + Z_DVT) + (size_t)(b * 4 + h) * 128 * SEQ;
    const int NT = (q0 + 128) / 64;
    f32x16 o[4];
#pragma unroll
    for (int i = 0; i < 4; ++i) o[i] = (f32x16){};
    float lsum = 0.f;
    u32x4 rk1, rk2, rv0, rv1;
#define DA_LOAD(t) do { rk1 = ldk(K1g + (size_t)(t) * 4096, tid); rk2 = ldk(K2g + (size_t)(t) * 4096, tid); rv0 = ldv(Vg + (t) * 64, SEQ, tid >> 3, tid); rv1 = ldv(Vg + (t) * 64, SEQ, 64 + (tid >> 3), tid); } while (0)
#define DA_STORE(sb) do { LAS unsigned char* st_ = lds + (sb) * DA_STAGE; stk(st_, rk1, tid); stk(st_ + 64 * KP, rk2, tid); stv(st_ + 128 * KP, rv0, tid >> 3, tid); stv(st_ + 128 * KP, rv1, 64 + (tid >> 3), tid); } while (0)
    DA_LOAD(0); DA_STORE(0);
    __syncthreads();
    for (int t = 0; t < NT; ++t) {
        if (t + 1 < NT) DA_LOAD(t + 1);
        if (64 * t <= qw0 + 31) {
            const LAS unsigned char* st = lds + (t & 1) * DA_STAGE;
            f32x16 p0, p1;
            const int dl = qw0 + r32 - 64 * t - 4 * hi;
            qk_score<1, false>(p0, p1, st + c * 64 * KP, qf, r32, hi, dl, biasL, cfar, true, qw0 - (64 * t + 63), qw0 + 31 - 64 * t);
            lsum += sum32(p0, p1);
            pv_tile<4>(o, p0, p1, st + 128 * KP, r32, hi);
        }
        if (t + 1 < NT) DA_STORE((t + 1) & 1);
        __syncthreads();
    }
#undef DA_LOAD
#undef DA_STORE
    lsum += __shfl_xor(lsum, 32);
    LAS float* wsf = (LAS float*)(lds + L_WSF) + wave * 64;
    if (hi == 0) wsf[r32] = (lsum > 0.f) ? 1.0f / lsum : 0.f;
    asm volatile("s_waitcnt lgkmcnt(0)" ::: "memory");
    float li[16];
#pragma unroll
    for (int r = 0; r < 16; ++r) li[r] = wsf[crow(r, hi)];
    LAS float* X = (LAS float*)lds;
    if (c == 1) {
#pragma unroll
        for (int db = 0; db < 4; ++db)
#pragma unroll
            for (int r = 0; r < 16; ++r) X[(32 * qsub + crow(r, hi)) * 132 + r32 + 32 * db] = o[db][r] * li[r];
    }
    __syncthreads();
    if (c == 0) {
        const float* sg = INP(20) + l * 128;
        float gsub[4];
#pragma unroll
        for (int db = 0; db < 4; ++db) gsub[db] = sg[r32 + 32 * db] * onem;
#pragma unroll
        for (int r = 0; r < 16; ++r) {
            float y[4], ss = 0.f;
#pragma unroll
            for (int db = 0; db < 4; ++db) { y[db] = o[db][r] * li[r] - lam * X[(32 * qsub + crow(r, hi)) * 132 + r32 + 32 * db]; ss += y[db] * y[db]; }
            ss += __shfl_xor(ss, 1); ss += __shfl_xor(ss, 2); ss += __shfl_xor(ss, 4); ss += __shfl_xor(ss, 8); ss += __shfl_xor(ss, 16);
            const float rs = __builtin_amdgcn_rsqf(ss * (1.f / 128.f) + EPS);
            bf16_t* d = (bf16_t*)(ws + WS_XN) + (size_t)(b * SEQ + qw0 + crow(r, hi)) * 512 + h * 128 + r32;
#pragma unroll
            for (int db = 0; db < 4; ++db) GST(bf16_t, d + 32 * db, (bf16_t)f2bf(y[db] * rs * gsub[db]));
        }
    }
    __syncthreads();
}

__device__ __forceinline__ void nsa_unit(const Params& P, int l, int b, int g, int u, LAS unsigned char* lds, bool load_tab) {
    const int tid = otid(), lane = tid & 63, wave = __builtin_amdgcn_readfirstlane(tid >> 6), r32 = lane & 31, hi = lane >> 5;
    const int qi = r32 >> 2, p = r32 & 3, qw0 = 64 * u + 8 * wave, qpos = qw0 + qi, head = g * 4 + p;
    unsigned char* ws = WSP;
    const float Mb = ((const float*)(ws + WS_PRM))[l * 8 + 2];
    LAS float* biasL = (LAS float*)(lds + L_BIAS);
    LAS float* imp = (LAS float*)(lds + L_IMP);
    LAS unsigned* selw = (LAS unsigned*)(lds + L_SEL);
    LAS float* wsf = (LAS float*)(lds + L_WSF) + wave * 64;
    const float* bgl = (const float*)(ws + WS_BIAS) + (size_t)(4 + g * 4) * 1024;
    if (load_tab) for (int i = tid; i < 4 * TBN; i += NTHR) { const int hh = i / TBN, d = i % TBN - 128; biasL[i] = GLD(float, bgl + hh * 1024 + (d < 0 ? 0 : (d > 1023 ? 1023 : d))) - Mb; }
    if (tid == 0) { unsigned z = 0u; asm volatile("" : "+v"(z)); selw[128] = z; selw[129] = z; }
    const LAS float* tb = biasL + p * TBN;
    const float cfar = bgl[p * 1024 + 1023] - Mb;
    const bf16_t* Qp = (const bf16_t*)(ws + Z_NQ) + ((size_t)(b * 8 + head) * SEQ + qpos) * 64 + hi * 8;
    bf16x8 qf[4];
#pragma unroll
    for (int d0 = 0; d0 < 4; ++d0) qf[d0] = GLD(bf16x8, Qp + d0 * 16);
    const float* ngp = (const float*)(ws + Z_NG) + (size_t)(b * SEQ + qpos) * 24 + head * 3;
    const float gate_c = GLD(float, ngp), gate_s = GLD(float, ngp + 1), gate_w = GLD(float, ngp + 2);
    f32x16 oc[2]; oc[0] = (f32x16){}; oc[1] = (f32x16){};
    f32x16 o[2];
    u32x4 rk, rv;
    const int bgi = b * 2 + g;
#define NS_STORE(sb) do { LAS unsigned char* st_ = lds + (sb) * NS_STAGE; stk(st_, rk, tid); stv(st_ + 64 * KP, rv, tid >> 3, tid); } while (0)
#define NS_FOLD(gate) do { lsum += __shfl_xor(lsum, 32); if (hi == 0) wsf[r32] = (lsum > 0.f) ? (gate) / lsum : 0.f; asm volatile("s_waitcnt lgkmcnt(0)" ::: "memory"); \
        _Pragma("unroll") for (int r = 0; r < 16; ++r) { const float f_ = wsf[crow(r, hi)]; oc[0][r] += f_ * o[0][r]; oc[1][r] += f_ * o[1][r]; } asm volatile("s_waitcnt lgkmcnt(0)" ::: "memory"); } while (0)
    {
        const bf16_t* Kg = (const bf16_t*)(ws + WS_KCN) + (size_t)bgi * 256 * 64;
        const bf16_t* Vg = (const bf16_t*)(ws + WS_VCT) + (size_t)bgi * 64 * 256;
        const int ntc = (4 * u + 2) / 64 + 1;
        {
            u32x4 ck[4], cv[4];
#pragma unroll
            for (int tc = 0; tc < 4; ++tc) if (tc < ntc) { ck[tc] = ldk(Kg + (size_t)tc * 4096, tid); cv[tc] = ldv(Vg + tc * 64, 256, tid >> 3, tid); }
#pragma unroll
            for (int tc = 0; tc < 4; ++tc) if (tc < ntc) { LAS unsigned char* st_ = lds + tc * NS_STAGE; stk(st_, ck[tc], tid); stv(st_ + 64 * KP, cv[tc], tid >> 3, tid); }
        }
        __syncthreads();
        float lsum = 0.f;
        for (int tc = 0; tc < ntc; ++tc) {
            const LAS unsigned char* st = lds + tc * NS_STAGE;
            f32x16 p0, p1;
            const int dl = qpos - 31 - 16 * (64 * tc + 4 * hi);
            qk_score<16, false>(p0, p1, st, qf, r32, hi, dl, tb, cfar, true, qw0 - 31 - 16 * (64 * tc + 63), qw0 + 7 - 31 - 16 * 64 * tc);
            lsum += sum32(p0, p1);
        }
        const float lt = lsum + __shfl_xor(lsum, 32);
        const float linv = (lt > 0.f) ? 1.0f / lt : 0.f;
        o[0] = (f32x16){}; o[1] = (f32x16){};
        float carry = 0.f;
        for (int tc = 0; tc < ntc; ++tc) {
            const LAS unsigned char* st = lds + tc * NS_STAGE;
            f32x16 p0, p1;
            const int dl = qpos - 31 - 16 * (64 * tc + 4 * hi);
            qk_score<16, false>(p0, p1, st, qf, r32, hi, dl, tb, cfar, true, qw0 - 31 - 16 * (64 * tc + 63), qw0 + 7 - 31 - 16 * 64 * tc);
            float Qs[2][4], PL[2][4];
#pragma unroll
            for (int blk = 0; blk < 2; ++blk)
#pragma unroll
                for (int m = 0; m < 4; ++m) { const f32x16& pp = blk ? p1 : p0; Qs[blk][m] = (pp[4 * m] + pp[4 * m + 1]) + (pp[4 * m + 2] + pp[4 * m + 3]); PL[blk][m] = __shfl_xor(pp[4 * m + 3], 32); }
#pragma unroll
            for (int blk = 0; blk < 2; ++blk)
#pragma unroll
                for (int m = 0; m < 4; ++m) {
                    const float prev = (m > 0) ? PL[blk][m - 1] : (blk ? PL[0][3] : carry);
                    float e = (Qs[blk][m] + (hi ? PL[blk][m] : prev)) * linv;
                    e += __shfl_xor(e, 1); e += __shfl_xor(e, 2);
                    if (p == 0) imp[(8 * wave + qi) * 64 + 16 * tc + 8 * blk + 2 * m + hi] = e;
                }
            carry = PL[1][3];
            pv_tile<2>(o, p0, p1, st + 64 * KP, r32, hi);
        }
        NS_FOLD(gate_c);
    }
    __syncthreads();
    {
        const int ql = lane >> 3, sub = lane & 7, q = 8 * wave + ql;
        unsigned long long m;
        if (u < 8) m = (2ull << u) - 1ull;
        else {
            m = 1ull | (1ull << u) | (1ull << (u - 1));
            float v[8];
#pragma unroll
            for (int i = 0; i < 8; ++i) { const int j = sub + 8 * i; v[i] = (j >= 1 && j <= u - 2) ? imp[q * 64 + j] : -1.f; }
            for (int k = 0; k < 5; ++k) {
                float bv = v[0]; int bj = sub;
#pragma unroll
                for (int i = 1; i < 8; ++i) if (v[i] > bv) { bv = v[i]; bj = sub + 8 * i; }
#pragma unroll
                for (int of = 1; of < 8; of <<= 1) { const float ov = __shfl_xor(bv, of); const int oj = __shfl_xor(bj, of); if (ov > bv || (ov == bv && oj < bj)) { bv = ov; bj = oj; } }
                m |= 1ull << bj;
#pragma unroll
                for (int i = 0; i < 8; ++i) if (bj == sub + 8 * i) v[i] = -2.f;
            }
        }
        if (sub == 0) { selw[2 * q] = (unsigned)m; selw[2 * q + 1] = (unsigned)(m >> 32); atomicOr((unsigned*)&selw[128], (unsigned)m); atomicOr((unsigned*)&selw[129], (unsigned)(m >> 32)); }
    }
    __syncthreads();
    asm volatile("" : "+v"(oc[0]), "+v"(oc[1]));
    u32x4 rk2, rv2;
#define NS_LOADA(Kg_, Vg_, j_) do { rk = ldk((Kg_) + (size_t)(j_) * 4096, tid); rv = ldv((Vg_) + (j_) * 64, SEQ, tid >> 3, tid); } while (0)
#define NS_LOADB(Kg_, Vg_, j_) do { rk2 = ldk((Kg_) + (size_t)(j_) * 4096, tid); rv2 = ldv((Vg_) + (j_) * 64, SEQ, tid >> 3, tid); } while (0)
#define NS_STOREA(sb) do { LAS unsigned char* st_ = lds + (sb) * NS_STAGE; stk(st_, rk, tid); stv(st_ + 64 * KP, rv, tid >> 3, tid); } while (0)
#define NS_STOREB(sb) do { LAS unsigned char* st_ = lds + (sb) * NS_STAGE; stk(st_, rk2, tid); stv(st_ + 64 * KP, rv2, tid >> 3, tid); } while (0)
    {
        const unsigned long long un = (unsigned long long)selw[128] | ((unsigned long long)selw[129] << 32);
        const unsigned long long mine = (unsigned long long)selw[2 * (8 * wave + qi)] | ((unsigned long long)selw[2 * (8 * wave + qi) + 1] << 32);
        const bf16_t* Kg = (const bf16_t*)(ws + Z_KSEL) + (size_t)bgi * SEQ * 64;
        const bf16_t* Vg = (const bf16_t*)(ws + Z_VSELT) + (size_t)bgi * 64 * SEQ;
        o[0] = (f32x16){}; o[1] = (f32x16){};
        float lsum = 0.f;
        unsigned long long rem = un;
#define NS_NEXTJ(var, has) do { has = (rem != 0ull); var = 0; if (has) { var = __builtin_ctzll(rem); rem &= rem - 1; } } while (0)
        int jc, j1, j2; bool h1, h2;
        NS_NEXTJ(jc, h1);
        NS_NEXTJ(j1, h1);
        NS_LOADA(Kg, Vg, jc); if (h1) NS_LOADB(Kg, Vg, j1);
        NS_STOREA(0);
        __syncthreads();
        int sc = 0;
#define NS_SEL_STEP(LOADF, STOREN) { \
            NS_NEXTJ(j2, h2); if (h2) LOADF(Kg, Vg, j2); \
            const bool rowsel = (mine >> jc) & 1ull; \
            if (__any(rowsel)) { \
                const LAS unsigned char* st = lds + sc * NS_STAGE; \
                f32x16 p0, p1; \
                const int dl = qpos - 64 * jc - 4 * hi; \
                qk_score<1, false>(p0, p1, st, qf, r32, hi, dl, tb, cfar, rowsel, qw0 - (64 * jc + 63), qw0 + 7 - 64 * jc); \
                lsum += sum32(p0, p1); \
                pv_tile<2>(o, p0, p1, st + 64 * KP, r32, hi); \
            } \
            const int sn = (sc == 2) ? 0 : sc + 1; \
            if (h1) STOREN(sn); \
            __syncthreads(); \
            if (!h1) break; \
            jc = j1; j1 = j2; h1 = h2; sc = sn; }
        for (;;) { NS_SEL_STEP(NS_LOADA, NS_STOREB) NS_SEL_STEP(NS_LOADB, NS_STOREA) }
#undef NS_SEL_STEP
#undef NS_NEXTJ
        NS_FOLD(gate_s);
        asm volatile("" : "+v"(oc[0]), "+v"(oc[1]));
    }
    {
        const bf16_t* Kg = (const bf16_t*)(ws + Z_KWIN) + (size_t)bgi * SEQ * 64;
        const bf16_t* Vg = (const bf16_t*)(ws + Z_VWINT) + (size_t)bgi * 64 * SEQ;
        o[0] = (f32x16){}; o[1] = (f32x16){};
        float lsum = 0.f;
        const int t0 = (u >= 8) ? u - 8 : 0;
        int t = t0, sc = 0;
        NS_LOADA(Kg, Vg, t0); if (t0 + 1 <= u) NS_LOADB(Kg, Vg, t0 + 1);
        NS_STOREA(0);
        __syncthreads();
#define NS_WIN_STEP(LOADF, STOREN) { \
            if (t + 2 <= u) LOADF(Kg, Vg, t + 2); \
            { \
                const LAS unsigned char* st = lds + sc * NS_STAGE; \
                f32x16 p0, p1; \
                const int dl = qpos - 64 * t - 4 * hi; \
                qk_score<1, true>(p0, p1, st, qf, r32, hi, dl, tb, cfar, true, qw0 - (64 * t + 63), qw0 + 7 - 64 * t); \
                lsum += sum32(p0, p1); \
                pv_tile<2>(o, p0, p1, st + 64 * KP, r32, hi); \
            } \
            const int sn = (sc == 2) ? 0 : sc + 1; \
            if (t + 1 <= u) STOREN(sn); \
            __syncthreads(); \
            if (t + 1 > u) break; \
            ++t; sc = sn; }
        for (;;) { NS_WIN_STEP(NS_LOADA, NS_STOREB) NS_WIN_STEP(NS_LOADB, NS_STOREA) }
#undef NS_WIN_STEP
        NS_FOLD(gate_w);
    }
#undef NS_LOADA
#undef NS_LOADB
#undef NS_STOREA
#undef NS_STOREB
#undef NS_STORE
#undef NS_FOLD
#pragma unroll
    for (int r = 0; r < 16; ++r) {
        const int row = crow(r, hi), q = qw0 + (row >> 2), pp = row & 3;
        bf16_t* d = (bf16_t*)(ws + WS_XN) + (size_t)(MTOK + b * SEQ + q) * 512 + (g * 4 + pp) * 64 + r32;
        GST(bf16_t, d, (bf16_t)f2bf(oc[0][r])); GST(bf16_t, d + 32, (bf16_t)f2bf(oc[1][r]));
    }
    __syncthreads();
}

__device__ __forceinline__ void attention_phase(const Params& P, int l, LAS unsigned char* lds) {
    int tab_key = -1;
    for (int it = blockIdx.x; it < 2048; it += gridDim.x) {
        const int c = it & 255, sl = (it >> 8) & 3;
        if (it < 1024) { const int bh = c & 31, xg = c >> 5; const int qb = (sl == 0) ? 31 - xg : (sl == 1) ? 23 - xg : (sl == 2) ? 8 + xg : xg;
            da_unit(P, l, bh >> 2, bh & 3, qb, lds, tab_key != (bh & 3)); tab_key = bh & 3; }
        else { const int bg = c & 15, ug = c >> 4; const int u = (sl == 0) ? 63 - ug : (sl == 1) ? 47 - ug : (sl == 2) ? 16 + ug : ug;
            nsa_unit(P, l, bg >> 1, bg & 1, u, lds, tab_key != 4 + (bg & 1)); tab_key = 4 + (bg & 1); }
    }
}

constexpr size_t WS_BAR = 72 * 1024;
#define RLX_AGENT __ATOMIC_RELAXED, __HIP_MEMORY_SCOPE_AGENT
#define XB_TMO      128
#define XB_XCNT(j)  (256  + 64 * (j))
#define XB_XSUB(j)  (1280 + 64 * (j))
#define XB_XGEN(j)  (2304 + 64 * (j))
#define XB_TOP      3328
#define XB_TOPGEN   3392
#define XCD_BAR_WORDS 3456
#define XB_SPIN_CAP (1u << 18)

__device__ __forceinline__ unsigned xb_ld(unsigned* p)              { return __hip_atomic_load(p, __ATOMIC_RELAXED, __HIP_MEMORY_SCOPE_AGENT); }
__device__ __forceinline__ unsigned xb_add(unsigned* p, unsigned v) { return __hip_atomic_fetch_add(p, v, __ATOMIC_RELAXED, __HIP_MEMORY_SCOPE_AGENT); }
__device__ __forceinline__ unsigned xb_xcc_id() { return (unsigned)__builtin_amdgcn_s_getreg((3 << 11) | 20) & 0xFu; }
#define XB_SPIN(cond, bar) do { unsigned _sp = 0; while (cond) { __builtin_amdgcn_s_sleep(1); \
    if ((++_sp & 255u) == 0u) { if (xb_ld(&(bar)[XB_TMO])) break; if (_sp > XB_SPIN_CAP) { atomicAdd(&(bar)[XB_TMO], 1u); break; } } } } while (0)

struct XcdBarrier {
    unsigned* bar; unsigned x;
    volatile LAS unsigned* st;
};

__device__ __forceinline__ XcdBarrier xcd_barrier_post(unsigned* bar, volatile LAS unsigned* st) {
    XcdBarrier b; b.bar = bar; b.x = xb_xcc_id(); b.st = st;
    if (threadIdx.x == 0) (void)xb_add(&bar[XB_XCNT(b.x)], 1u);
    return b;
}
__device__ __forceinline__ void xcd_barrier_complete(unsigned* bar, unsigned x, unsigned& nloc, unsigned& nx) {
    const unsigned G = gridDim.x * gridDim.y * gridDim.z;
    unsigned sum, cnt, mine, sp = 0u;
    for (;;) {
        sum = 0u; cnt = 0u; mine = 0u;
#pragma unroll
        for (unsigned j = 0; j < 16; ++j) { const unsigned c = xb_ld(&bar[XB_XCNT(j)]); sum += c; cnt += (c > 0u) ? 1u : 0u; mine = (j == x) ? c : mine; }
        if (sum == G) break;
        __builtin_amdgcn_s_sleep(1);
        if ((++sp & 255u) == 0u) { if (xb_ld(&bar[XB_TMO])) break; if (sp > XB_SPIN_CAP) { atomicAdd(&bar[XB_TMO], 1u); break; } }
    }
    nloc = mine > 0u ? mine : 1u; nx = cnt > 0u ? cnt : 1u;
}

__device__ __forceinline__ void xcd_barrier(const XcdBarrier& b) {
    asm volatile("s_waitcnt vmcnt(0)" ::: "memory");
    __syncthreads();
    if (threadIdx.x == 0) {
        unsigned* bar = b.bar;
        __builtin_amdgcn_s_waitcnt(0);
        unsigned nloc = b.st[0], nx = b.st[1];
        if (nloc == 0u) { xcd_barrier_complete(bar, b.x, nloc, nx); b.st[0] = nloc; b.st[1] = nx; }
        const unsigned old = xb_add(&bar[XB_XSUB(b.x)], 1u);
        const unsigned gen = old / nloc;
        if (old + 1u == (gen + 1u) * nloc) {
            __builtin_amdgcn_fence(__ATOMIC_RELEASE, "agent");
            asm volatile("s_waitcnt vmcnt(0)" ::: "memory");
            const unsigned og = xb_add(&bar[XB_TOP], 1u);
            const unsigned tg = og / nx;
            if (og + 1u == (tg + 1u) * nx) xb_add(&bar[XB_TOPGEN], 1u);
            else XB_SPIN(xb_ld(&bar[XB_TOPGEN]) == tg, bar);
            __builtin_amdgcn_fence(__ATOMIC_ACQUIRE, "agent");
            xb_add(&bar[XB_XGEN(b.x)], 1u);
            asm volatile("s_waitcnt vmcnt(0)" ::: "memory");
        } else {
            XB_SPIN(xb_ld(&bar[XB_XGEN(b.x)]) == gen, bar);
            __builtin_amdgcn_fence(__ATOMIC_ACQUIRE, "agent");
            asm volatile("s_waitcnt vmcnt(0)" ::: "memory");
        }
    }
    __syncthreads();
}

#define GSYNC() do { XcdBarrier xb_; xb_.bar = (unsigned*)(WSP + WS_BAR); xb_.x = xb_xcc_id(); xb_.st = (volatile LAS unsigned*)(lds + L_PTAB + 384); xcd_barrier(xb_); } while (0)
#define ws WSP
#define XN ((bf16_t*)(WSP + WS_XN))
#define HID ((bf16_t*)(WSP + WS_HID))
#define MERGED ((bf16_t*)(WSP + WS_MERGED))
#define XB ((bf16_t*)OUTP)
#define XS ((bf16_t*)(WSP + WS_Z + 192 * MiB))
#define SSP ((float*)(WSP + WS_SS))
#define STAMP() do {} while (0)
template <int L> __device__ __forceinline__ void layer_fwd(const Params& P, LAS unsigned char* lds) {
    constexpr int l = L;
    const int G = gridDim.x, bx = blockIdx.x;

        const float* xin = (l == 0) ? INP(0) : OUTP;
        { pg8::Gemm g{XB, (const bf16_t*)(ws + WS_W13 + (size_t)(l * 2 + 0) * W13_SZ), MTOK, 5632, DM}; pg8::StaticOrder S; S.init(MTOK, 5632, G, bx);
          EpiSwiGLU E{{SSP}, HID}; pg8::gemm_phase<EpiSwiGLU, pg8::StaticOrder, true, true>(lds, g, S, E);
        }
        GSYNC(); STAMP();
        { pg8::Gemm g{HID, (const bf16_t*)(ws + WS_W2 + (size_t)(l * 2 + 0) * W2_SZ), MTOK, DM, DFF}; pg8::StaticOrder S; S.init(MTOK, DM, G, bx);
          if (l == 0) { EpiResidT<true, false> E{xin, XB, 0.5f, SSP}; pg8::gemm_phase<EpiResidT<true, false>, pg8::StaticOrder, true, true>(lds, g, S, E); }
          else { EpiResidT<false, false> E{XB, XB, 0.5f, SSP}; pg8::gemm_phase<EpiResidT<false, false>, pg8::StaticOrder, true, true>(lds, g, S, E); } }
        GSYNC(); STAMP();
        { pg8::Gemm g{XB, (const bf16_t*)(ws + WS_WIN + (size_t)l * WIN_SZ), MTOK, 5120, DM}; pg8::StaticOrder S; S.init(MTOK, 5120, G, bx);
          EpiZ E{{SSP}, ws, INP(14) + l * 64, INP(15) + l * 64, INP(21) + l * 64, INP(22) + l * 192}; pg8::gemm_phase<EpiZ, pg8::StaticOrder, true, true>(lds, g, S, E);
        }
        GSYNC(); STAMP();
        compress_phase(P, l, lds);
        GSYNC(); STAMP();
        attention_phase(P, l, lds);
        GSYNC(); STAMP();
        { pg8::Gemm g{XN, (const bf16_t*)(ws + WS_PAB + (size_t)l * PAB_SZ), 2 * MTOK, 2048, 512}; PairOrder S; S.init(G, bx);
          EpiMerge E{(const unsigned char*)(ws + Z_MG), MERGED}; pg8::gemm_phase<EpiMerge, PairOrder, true, true>(lds, g, S, E); }
        GSYNC(); STAMP();
        { pg8::Gemm g{MERGED, (const bf16_t*)(ws + WS_WO + (size_t)l * WO_SZ), MTOK, DM, DM}; pg8::StaticOrder S; S.init(MTOK, DM, G, bx);
          EpiResidT<false, false> E{XB, (l + 1 < DEPTH) ? XB : XS, 1.0f, SSP}; pg8::gemm_phase<EpiResidT<false, false>, pg8::StaticOrder, true, true>(lds, g, S, E); }
        GSYNC(); STAMP();
        { pg8::Gemm g{(l + 1 < DEPTH) ? XB : XS, (const bf16_t*)(ws + WS_W13 + (size_t)(l * 2 + 1) * W13_SZ), MTOK, 5632, DM}; pg8::StaticOrder S; S.init(MTOK, 5632, G, bx);
          EpiSwiGLU E{{SSP}, HID}; pg8::gemm_phase<EpiSwiGLU, pg8::StaticOrder, true, true>(lds, g, S, E); }
        GSYNC(); STAMP();
        { pg8::Gemm g{HID, (const bf16_t*)(ws + WS_W2 + (size_t)(l * 2 + 1) * W2_SZ), MTOK, DM, DFF}; pg8::StaticOrder S; S.init(MTOK, DM, G, bx);
          if (l + 1 < DEPTH) { EpiResidT<false, false> E{XB, XB, 0.5f, SSP}; pg8::gemm_phase<EpiResidT<false, false>, pg8::StaticOrder, true, true>(lds, g, S, E); }
          else { EpiResidT<false, true> E{XS, OUTP, 0.5f, nullptr}; pg8::gemm_phase<EpiResidT<false, true>, pg8::StaticOrder, true, true>(lds, g, S, E); } }
        if (l + 1 < DEPTH) { GSYNC(); STAMP(); }
    }
#undef ws
#undef XN
#undef HID
#undef MERGED
#undef XB
#undef XS
#undef SSP

#define GSYNC() do { XcdBarrier xb_; xb_.bar = (unsigned*)(WSP + WS_BAR); xb_.x = xb_xcc_id(); xb_.st = (volatile LAS unsigned*)(lds + L_PTAB + 384); xcd_barrier(xb_); } while (0)
#define STAMP() do {} while (0)
__global__ void __launch_bounds__(NTHR, 2) hybrid_fwd(Params P) {
    extern __shared__ __attribute__((aligned(16))) unsigned char lds_raw[];
    LAS unsigned char* lds = (LAS unsigned char*)lds_raw;
    cg::grid_group grid = cg::this_grid();
    if (threadIdx.x == 0) {
        LAS unsigned long long* pt = (LAS unsigned long long*)(lds + L_PTAB);
#pragma unroll
        for (int i = 0; i < 30; ++i) pt[i] = (unsigned long long)P.in[i];
        pt[30] = (unsigned long long)P.out; pt[31] = (unsigned long long)P.ws;
        *(LAS unsigned*)(lds + L_PTAB + 384) = 0u; *(LAS unsigned*)(lds + L_PTAB + 388) = 0u;
    }
    __syncthreads();
    (void)xcd_barrier_post((unsigned*)(WSP + WS_BAR), (volatile LAS unsigned*)(lds + L_PTAB + 384));
    const int G = gridDim.x, bx = blockIdx.x;

    if (P.out == nullptr) grid.sync();
    STAMP();
    prologue(P, lds);
    xprep_phase(INP(0), (bf16_t*)OUTP, (float*)(WSP + WS_SS));
    GSYNC(); STAMP();
    layer_fwd<0>(P, lds);
    layer_fwd<1>(P, lds);
}

extern "C" void kernel_launch(void* const* d_in, const int* in_sizes, int n_in, void* d_out, int out_size, void* d_ws, size_t ws_size, hipStream_t stream) {
    static int grid = 0;
    if (grid == 0) {
        if (n_in != 30 || out_size != MTOK * DM || ws_size < WS_END) { fprintf(stderr, "kernel_launch: unexpected problem (n_in %d out %d ws %zu, need %zu)\n", n_in, out_size, ws_size, (size_t)WS_END); grid = -1; return; }
        int dev = 0, cus = 0, per_cu = 0;
        (void)hipGetDevice(&dev);
        (void)hipDeviceGetAttribute(&cus, hipDeviceAttributeMultiprocessorCount, dev);
        if (hipFuncSetAttribute((const void*)hybrid_fwd, hipFuncAttributeMaxDynamicSharedMemorySize, LDS_BYTES) != hipSuccess) { fprintf(stderr, "kernel_launch: hipFuncSetAttribute failed\n"); grid = -1; return; }
        if (hipOccupancyMaxActiveBlocksPerMultiprocessor(&per_cu, (const void*)hybrid_fwd, NTHR, LDS_BYTES) != hipSuccess || per_cu < 1) { fprintf(stderr, "kernel_launch: occupancy query gave %d\n", per_cu); per_cu = 1; }
        (void)hipGetLastError();
        grid = cus * (per_cu > 1 ? 1 : per_cu);
        if (grid <= 0) grid = 256;
    }
    if (grid < 0) return;
    Params p{};
    for (int i = 0; i < 30; ++i) p.in[i] = (const float*)d_in[i];
    p.out = (float*)d_out; p.ws = (unsigned char*)d_ws;
    (void)hipMemsetAsync((unsigned char*)d_ws + WS_BAR, 0, 16384, stream);
    void* args[] = {&p};
    hipError_t e = hipLaunchCooperativeKernel((const void*)hybrid_fwd, dim3(grid), dim3(NTHR), args, LDS_BYTES, stream);
    if (e != hipSuccess) fprintf(stderr, "cooperative launch failed: %s (grid %d)\n", hipGetErrorString(e), grid);
}
```

```cpp
#include <hip/hip_runtime.h>
#include <hip/hip_cooperative_groups.h>
#include <cstdio>
#include <cstdint>
namespace cg = cooperative_groups;
namespace pg8 {
#define PG8_LAS __attribute__((address_space(3)))
typedef unsigned short bf16_t;
typedef short bf16x8 __attribute__((ext_vector_type(8)));
typedef float f32x4 __attribute__((ext_vector_type(4)));
typedef unsigned u32x4 __attribute__((ext_vector_type(4)));
constexpr int BM = 256, BK = 64, HALF = 128, HTB = HALF * BK * 2  , STAGE_BYTES = 8 * HTB, NXCD = 8, WGM = 8;

__host__ __device__ __forceinline__ int lds_byte(int r, int c) { const int st = (r >> 4) * 2 + (c >> 5), rr = r & 15, cc = c & 31, ob = rr * 64 + cc * 2; return st * 1024 + (ob ^ (((ob >> 9) & 1) << 5)); }
__host__ __device__ __forceinline__ void stage_rc(int b, int& R, int& C) { const int st = b / 1024, sb = b % 1024, swz = sb ^ (((sb >> 9) & 1) << 5); R = (st >> 1) * 16 + swz / 64; C = (st & 1) * 32 + (swz % 64) / 2; }
__host__ __device__ __forceinline__ int perm32(int rho) { const int n = rho >> 4, i = rho & 15; return 8 * (i >> 2) + 4 * n + (i & 3); }

struct Unit { int pm, pn; };
struct Gemm { const bf16_t* A; const bf16_t* Bt; int M, N, K; };

struct StaticOrder {
    int nM, nN, nwg, G, c;
    __host__ __device__ void init(int M, int N, int G_, int c_) { nM = M / BM; nN = N / BM; nwg = nM * nN; G = G_; c = c_; }
    __host__ __device__ bool next(int i, Unit& u) const {
        const long L = (long)i * G + c; if (L >= nwg) return false;
        int wgid = (int)L; { const int q = nwg / NXCD, r = nwg % NXCD, xcd = wgid % NXCD, off = wgid / NXCD; wgid = (xcd < r ? xcd * (q + 1) : r * (q + 1) + (xcd - r) * q) + off; }
        const int nig = WGM * nN, gid = wgid / nig, fm = gid * WGM, gsz = (nM - fm) < WGM ? (nM - fm) : WGM;
        u.pm = fm + ((wgid % nig) % gsz); u.pn = (wgid % nig) / gsz; return true;
    }
    __device__ __forceinline__ void a_ready(const Unit&) const {}
    __device__ __forceinline__ void done(const Unit&) const {}
};

typedef float f32x2_t __attribute__((ext_vector_type(2))); typedef __bf16 bf16x2_t __attribute__((ext_vector_type(2)));
__device__ __forceinline__ unsigned cvt_pk_bf16(float lo, float hi) { f32x2_t v = {lo, hi}; bf16x2_t b = __builtin_convertvector(v, bf16x2_t); return __builtin_bit_cast(unsigned, b); }
template <class Epi, class Sched, bool ALIGN_EPI = false, bool SP2 = false>
__device__ __forceinline__ void gemm_phase(PG8_LAS unsigned char* lds, const Gemm g, const Sched& S, const Epi& E) {
    int tid_ = threadIdx.x; asm volatile("" : "+v"(tid_)); const int tid = tid_, wid = __builtin_amdgcn_readfirstlane(tid >> 6), lane = tid & 63, wr = wid >> 2, wc = wid & 3, fr = lane & 15, fq = lane >> 4;
    const int K = g.K, nt = K / BK;
    unsigned voffA[2], voffB[2];
#pragma unroll
    for (int i = 0; i < 2; ++i) { int R, C; stage_rc(tid * 16 + i * 8192, R, C); const int Rb = Epi::PERM ? ((R & ~31) + perm32(R & 31)) : R;
        voffA[i] = (unsigned)(R * K + C) * 2u; voffB[i] = (unsigned)(Rb * K + C) * 2u; }
    const size_t kstep = (size_t)(BK * 2);
    const size_t hstep = (size_t)HALF * K * 2;
    const size_t tstep = 2 * hstep;
    const unsigned ldsw = (unsigned)wid * 1024u;
    const int aoff = lds_byte(wr * 64 + fr, fq * 8), boff = lds_byte(wc * 32 + fr, fq * 8);
#define PG8_SA(b, h) (((b) * 2 + (h)) * HTB)
#define PG8_SB(b, h) ((4 + (b) * 2 + (h)) * HTB)
#define PG8_STAGE(bufoff, gbase, voff) do { _Pragma("unroll") for (int _i = 0; _i < 2; ++_i) \
        __builtin_amdgcn_global_load_lds((const unsigned*)((const char*)(gbase) + (voff)[_i]), (PG8_LAS unsigned*)(lds + (bufoff) + ldsw + _i * 8192), 16, 0, 0); } while (0)
#define PG8_LDA(dst, b, h) do { _Pragma("unroll") for (int m = 0; m < 4; ++m) _Pragma("unroll") for (int k = 0; k < 2; ++k) dst[m][k] = *(const PG8_LAS bf16x8*)(lds + PG8_SA(b, h) + aoff + m * 2048 + k * 1024); } while (0)
#define PG8_LDB(dst, b, h) do { _Pragma("unroll") for (int n = 0; n < 2; ++n) _Pragma("unroll") for (int k = 0; k < 2; ++k) dst[n][k] = *(const PG8_LAS bf16x8*)(lds + PG8_SB(b, h) + boff + n * 2048 + k * 1024); } while (0)
#define PG8_MMA(ai, bj, At, Bt) do { __builtin_amdgcn_s_setprio(1); _Pragma("unroll") for (int m = 0; m < 4; ++m) _Pragma("unroll") for (int n = 0; n < 2; ++n) _Pragma("unroll") for (int k = 0; k < 2; ++k) \
        acc[ai][bj][m][n] = __builtin_amdgcn_mfma_f32_16x16x32_bf16(Bt[n][k], At[m][k], acc[ai][bj][m][n], 0, 0, 0); __builtin_amdgcn_s_setprio(0); } while (0)
#define PG8_WAIT_V(n) asm volatile("s_waitcnt vmcnt(" #n ")" ::: "memory")
#define PG8_WAIT_L(n) asm volatile("s_waitcnt lgkmcnt(" #n ")" ::: "memory")
#define PG8_BAR __builtin_amdgcn_s_barrier()
#define PG8_SCHED __builtin_amdgcn_sched_barrier(0)
    Unit cur, nxt; int ui = 0;
    if (!S.next(0, cur)) return;
    f32x4 acc[2][2][4][2];
#pragma unroll
    for (int a = 0; a < 2; ++a)
#pragma unroll
        for (int b = 0; b < 2; ++b)
#pragma unroll
            for (int m = 0; m < 4; ++m)
#pragma unroll
                for (int n = 0; n < 2; ++n) acc[a][b][m][n] = (f32x4){0.f, 0.f, 0.f, 0.f};
    bf16x8 At[4][2], B0[2][2], B1[2][2];
    const char* cA = (const char*)g.A + (size_t)cur.pm * tstep; const char* cB = (const char*)g.Bt + (size_t)cur.pn * tstep;
    S.a_ready(cur);
    if constexpr (Epi::ROWSCALE) {
        int pmB = -1, pmC = -1, pmD = -1; Unit uu;
        for (int i = 1; S.next(i, uu); ++i) if (uu.pm != cur.pm && uu.pm != pmB && uu.pm != pmC && uu.pm != pmD) { if (pmB < 0) pmB = uu.pm; else if (pmC < 0) pmC = uu.pm; else if (pmD < 0) pmD = uu.pm; }
        f32x4 a0, b0, a1, b1, a2, b2, a3, b3; Unit t0 = cur, t1 = cur, t2 = cur, t3 = cur; t1.pm = pmB < 0 ? cur.pm : pmB; t2.pm = pmC < 0 ? cur.pm : pmC; t3.pm = pmD < 0 ? cur.pm : pmD;
        E.rs_issue(t0, tid, a0, b0); E.rs_issue(t1, tid, a1, b1); E.rs_issue(t2, tid, a2, b2); E.rs_issue(t3, tid, a3, b3);
        E.rs_write(tid, a3, b3, (PG8_LAS float*)(lds + STAGE_BYTES + ((t3.pm >> 3) & 3) * 1024));
        E.rs_write(tid, a2, b2, (PG8_LAS float*)(lds + STAGE_BYTES + ((t2.pm >> 3) & 3) * 1024));
        E.rs_write(tid, a1, b1, (PG8_LAS float*)(lds + STAGE_BYTES + ((t1.pm >> 3) & 3) * 1024));
        E.rs_write(tid, a0, b0, (PG8_LAS float*)(lds + STAGE_BYTES + ((t0.pm >> 3) & 3) * 1024));
    }
    if constexpr (SP2) {
        PG8_STAGE(PG8_SB(0, 0), cB, voffB); PG8_STAGE(PG8_SB(0, 1), cB + hstep, voffB); PG8_STAGE(PG8_SA(0, 0), cA, voffA); PG8_STAGE(PG8_SA(0, 1), cA + hstep, voffA);
        if (wr == 1) PG8_BAR;
        PG8_WAIT_V(2); PG8_BAR;
        PG8_STAGE(PG8_SB(1, 0), cB + kstep, voffB); PG8_STAGE(PG8_SA(1, 0), cA + kstep, voffA); PG8_STAGE(PG8_SB(1, 1), cB + hstep + kstep, voffB);
        PG8_WAIT_V(6); PG8_BAR;
    } else {
        PG8_STAGE(PG8_SB(0, 0), cB, voffB); PG8_STAGE(PG8_SA(0, 0), cA, voffA); PG8_STAGE(PG8_SB(0, 1), cB + hstep, voffB); PG8_STAGE(PG8_SA(0, 1), cA + hstep, voffA);
        if (wr == 1) PG8_BAR;
        PG8_WAIT_V(4); PG8_BAR;
        PG8_STAGE(PG8_SB(1, 0), cB + kstep, voffB); PG8_STAGE(PG8_SA(1, 0), cA + kstep, voffA); PG8_STAGE(PG8_SB(1, 1), cB + hstep + kstep, voffB);
        PG8_WAIT_V(6); PG8_BAR;
    }
    for (;;) {
        const bool has_next = S.next(ui + 1, nxt);
        const char* nA = has_next ? (const char*)g.A + (size_t)nxt.pm * tstep : cA; const char* nB = has_next ? (const char*)g.Bt + (size_t)nxt.pn * tstep : cB;
        for (int t = 0; t < nt; t += 2) {
            const bool last = (t == nt - 2);
            const char* a1 = cA + (size_t)(t + 1) * kstep;
            const char* a2 = last ? nA : cA + (size_t)(t + 2) * kstep; const char* b2 = last ? nB : cB + (size_t)(t + 2) * kstep;
            const char* a3 = a2 + kstep; const char* b3 = b2 + kstep;
            if (last && has_next) S.a_ready(nxt);
            if constexpr (SP2) {
            PG8_LDB(B0, 0, 0); PG8_LDB(B1, 0, 1); PG8_SCHED; PG8_LDA(At, 0, 0); PG8_STAGE(PG8_SA(1, 1), a1 + hstep, voffA);
            PG8_WAIT_V(8); PG8_WAIT_L(0); PG8_BAR; PG8_MMA(0, 0, At, B0); PG8_MMA(0, 1, At, B1); PG8_BAR; PG8_SCHED;
            PG8_LDA(At, 0, 1); PG8_STAGE(PG8_SB(0, 0), b2, voffB); PG8_STAGE(PG8_SB(0, 1), b2 + hstep, voffB); PG8_STAGE(PG8_SA(0, 0), a2, voffA);
            PG8_WAIT_V(8); PG8_WAIT_L(0); PG8_BAR; PG8_MMA(1, 0, At, B0); PG8_MMA(1, 1, At, B1); PG8_BAR; PG8_SCHED;
            PG8_LDB(B0, 1, 0); PG8_LDB(B1, 1, 1); PG8_SCHED; PG8_LDA(At, 1, 0); PG8_STAGE(PG8_SA(0, 1), a2 + hstep, voffA);
            PG8_WAIT_V(8); PG8_WAIT_L(0); PG8_BAR; PG8_MMA(0, 0, At, B0); PG8_MMA(0, 1, At, B1); PG8_BAR; PG8_SCHED;
            PG8_LDA(At, 1, 1); PG8_STAGE(PG8_SB(1, 0), b3, voffB); PG8_STAGE(PG8_SB(1, 1), b3 + hstep, voffB); PG8_STAGE(PG8_SA(1, 0), a3, voffA);
            PG8_WAIT_V(8); PG8_WAIT_L(0); PG8_BAR; PG8_MMA(1, 0, At, B0); PG8_MMA(1, 1, At, B1); PG8_BAR; PG8_SCHED;
            } else {
            PG8_LDB(B0, 0, 0); PG8_SCHED; PG8_LDA(At, 0, 0); PG8_STAGE(PG8_SA(1, 1), a1 + hstep, voffA);
            PG8_WAIT_L(8); PG8_BAR; PG8_WAIT_L(0); PG8_MMA(0, 0, At, B0); PG8_BAR; PG8_SCHED;
            PG8_LDB(B1, 0, 1); PG8_STAGE(PG8_SB(0, 0), b2, voffB);
            PG8_BAR; PG8_WAIT_L(0); PG8_MMA(0, 1, At, B1); PG8_BAR;
            PG8_LDA(At, 0, 1); PG8_STAGE(PG8_SA(0, 0), a2, voffA);
            PG8_BAR; PG8_WAIT_L(0); PG8_MMA(1, 0, At, B0); PG8_BAR; PG8_SCHED;
            PG8_STAGE(PG8_SB(0, 1), b2 + hstep, voffB);
            PG8_WAIT_V(6); PG8_BAR; PG8_MMA(1, 1, At, B1); PG8_BAR;
            PG8_LDB(B0, 1, 0); PG8_SCHED; PG8_LDA(At, 1, 0); PG8_STAGE(PG8_SA(0, 1), a2 + hstep, voffA);
            PG8_WAIT_L(8); PG8_BAR; PG8_WAIT_L(0); PG8_MMA(0, 0, At, B0); PG8_BAR; PG8_SCHED;
            PG8_LDB(B1, 1, 1); PG8_STAGE(PG8_SB(1, 0), b3, voffB);
            PG8_BAR; PG8_WAIT_L(0); PG8_MMA(0, 1, At, B1); PG8_BAR;
            PG8_LDA(At, 1, 1); PG8_STAGE(PG8_SA(1, 0), a3, voffA);
            PG8_BAR; PG8_WAIT_L(0); PG8_MMA(1, 0, At, B0); PG8_BAR; PG8_SCHED;
            PG8_STAGE(PG8_SB(1, 1), b3 + hstep, voffB);
            PG8_WAIT_V(6); PG8_BAR; PG8_MMA(1, 1, At, B1); PG8_BAR;
            }
        }
        if constexpr (ALIGN_EPI) { if (wr == 0) PG8_BAR; }
        if constexpr (!Epi::AFTER_DRAIN) {
            if constexpr (Epi::ROWSCALE) E(acc, cur, wr, wc, fr, fq, (const PG8_LAS float*)(lds + STAGE_BYTES + ((cur.pm >> 3) & 3) * 1024));
            else if constexpr (Epi::CHAIN) { if (ui & 1) E(acc, cur, wr, wc, fr, fq); else E.chain(acc, cur, wr, wc, fr, fq); }
            else E(acc, cur, wr, wc, fr, fq);
            S.done(cur); }
        if (!has_next) break;
        if (!(Epi::CHAIN && !(ui & 1)))
#pragma unroll
        for (int a = 0; a < 2; ++a)
#pragma unroll
            for (int b = 0; b < 2; ++b)
#pragma unroll
                for (int m = 0; m < 4; ++m)
#pragma unroll
                    for (int n = 0; n < 2; ++n) acc[a][b][m][n] = (f32x4){0.f, 0.f, 0.f, 0.f};
        cur = nxt; cA = nA; cB = nB; ++ui;
        if constexpr (ALIGN_EPI) { if (wr == 1) PG8_BAR; }
    }
    PG8_WAIT_V(0);
    if constexpr (!ALIGN_EPI) { if (wr == 0) PG8_BAR; }
    PG8_BAR;
    if constexpr (Epi::AFTER_DRAIN) { E.fused(acc, cur, wr, wc, fr, fq, lds, wid, lane); S.done(cur); }
#undef PG8_SA
#undef PG8_SB
#undef PG8_STAGE
#undef PG8_LDA
#undef PG8_LDB
#undef PG8_MMA
#undef PG8_WAIT_V
#undef PG8_WAIT_L
#undef PG8_BAR
#undef PG8_SCHED
}
}

#define LAS __attribute__((address_space(3)))
#define GAS __attribute__((address_space(1)))
#define GLD(T, p) (*(const GAS T*)(p))
#define GST(T, p, v) (*(GAS T*)(p) = (v))
typedef unsigned short bf16_t;
typedef short bf16x8 __attribute__((ext_vector_type(8)));
typedef short bf16x4 __attribute__((ext_vector_type(4)));
typedef float f32x4 __attribute__((ext_vector_type(4)));
typedef float f32x16 __attribute__((ext_vector_type(16)));
typedef unsigned u32x4 __attribute__((ext_vector_type(4)));
typedef unsigned u32x2 __attribute__((ext_vector_type(2)));

constexpr int BATCH = 8, SEQ = 4096, DM = 1024, MTOK = BATCH * SEQ, DFF = 2816, DEPTH = 2, NIN = 4888;
constexpr int NTHR = 512, NWAVE = 8;
constexpr float EPS = 1e-6f, LOG2E = 1.4426950408889634f;
constexpr float QSCALE = 0.125f * LOG2E;
constexpr size_t MiB = 1u << 20;
constexpr size_t WS_BIAS = 0;
constexpr size_t WS_PRM = 64 * 1024;
constexpr size_t WS_CB1 = 68 * 1024;
constexpr size_t WS_W13 = 1 * MiB;
constexpr size_t W13_SZ = (size_t)5632 * 1024 * 2;
constexpr size_t WS_W2 = 45 * MiB;
constexpr size_t W2_SZ = (size_t)1024 * 2816 * 2;
constexpr size_t WS_WIN = 68 * MiB;
constexpr size_t WIN_SZ = (size_t)5120 * 1024 * 2;
constexpr size_t WS_PAB = 88 * MiB;
constexpr size_t PAB_SZ = (size_t)2048 * 1024 * 2;
constexpr size_t WS_WO = 96 * MiB;
constexpr size_t WO_SZ = (size_t)1024 * 1024 * 2;
constexpr size_t WS_CW1 = 100 * MiB;
constexpr size_t CW1_SZ = (size_t)128 * 2048 * 2;
constexpr size_t WS_CW2 = 102 * MiB;
constexpr size_t CW2_SZ = (size_t)64 * 128 * 2;
constexpr size_t WS_KCN = 103 * MiB;
constexpr size_t WS_VCT = WS_KCN + 512 * 1024;
constexpr size_t WS_XN = 104 * MiB;
constexpr size_t WS_Z = 168 * MiB;
constexpr size_t Z_DQ = WS_Z, Z_DK = WS_Z + 32 * MiB, Z_DVT = WS_Z + 64 * MiB, Z_NQ = WS_Z + 96 * MiB;
constexpr size_t Z_KCR = WS_Z + 128 * MiB, Z_VCR = WS_Z + 136 * MiB, Z_KSEL = WS_Z + 144 * MiB, Z_VSELT = WS_Z + 152 * MiB;
constexpr size_t Z_KWIN = WS_Z + 160 * MiB, Z_VWINT = WS_Z + 168 * MiB, Z_NG = WS_Z + 176 * MiB, Z_MG = WS_Z + 180 * MiB;
constexpr size_t WS_MERGED = WS_Z;
constexpr size_t WS_HID = WS_Z;
constexpr size_t WS_SS = WS_Z + 308 * MiB;
constexpr size_t WS_END = WS_SS + 2 * MiB;
constexpr int LDS_BYTES = 147456;
constexpr int KP = 144, VP = 136;
constexpr int DA_STAGE = 2 * 64 * KP + 128 * VP;
constexpr int NS_STAGE = 64 * KP + 64 * VP;
constexpr int L_BIAS = 73728;
constexpr int TBN = 1216;
constexpr int L_IMP = L_BIAS + 4 * TBN * 4;
constexpr int L_SEL = L_IMP + 16384;
constexpr int L_WSF = L_SEL + 1024;
constexpr int L_END = L_WSF + 8 * 256;

struct Params {
    const float* in[30];
    float* out;
    unsigned char* ws;
};

constexpr int L_PTAB = LDS_BYTES - 1024;
__device__ __forceinline__ const float* ld_ptr(const LAS unsigned char* lds, int i) {
    unsigned a = L_PTAB + 8 * i; asm volatile("" : "+v"(a));
    const LAS unsigned* t = (const LAS unsigned*)(lds + a);
    const unsigned lo = __builtin_amdgcn_readfirstlane(t[0]), hi = __builtin_amdgcn_readfirstlane(t[1]);
    return (const float*)(((unsigned long long)hi << 32) | lo);
}
#define INP(i) ld_ptr(lds, (i))
#define OUTP ((float*)ld_ptr(lds, 30))
#define WSP ((unsigned char*)ld_ptr(lds, 31))

__device__ __forceinline__ unsigned f2bf(float f) { unsigned u = __builtin_bit_cast(unsigned, f); return (u + 0x7fffu + ((u >> 16) & 1u)) >> 16; }
__device__ __forceinline__ unsigned pk2(float lo, float hi) { return f2bf(lo) | (f2bf(hi) << 16); }
__device__ __forceinline__ float sigmoidf_(float x) { return __builtin_amdgcn_rcpf(1.0f + __builtin_amdgcn_exp2f(-x * LOG2E)); }
__device__ __forceinline__ int otid() { int t = threadIdx.x; asm volatile("" : "+v"(t)); return t; }
__device__ __forceinline__ int crow(int r, int hi) { return (r & 3) + 8 * (r >> 2) + 4 * hi; }


struct RowScale {
    const float* ss;
    __device__ __forceinline__ void rs_issue(const pg8::Unit& u, int tid, f32x4& pa, f32x4& pb) const {
        const float* p = ss + (size_t)(u.pm * 256 + (tid >> 1)) * 16 + (tid & 1) * 8; pa = GLD(f32x4, p); pb = GLD(f32x4, p + 4); }
    __device__ __forceinline__ void rs_write(int tid, const f32x4& pa, const f32x4& pb, LAS float* tab) const {
        float t = ((pa.x + pa.y) + (pa.z + pa.w)) + ((pb.x + pb.y) + (pb.z + pb.w)); t += __shfl_xor(t, 1);
        if (!(tid & 1)) tab[tid >> 1] = __builtin_amdgcn_rsqf(t * (1.f / DM) + EPS); }
};
struct EpiSwiGLU : RowScale {
    static constexpr bool PERM = true, AFTER_DRAIN = false, ROWSCALE = true, CHAIN = false;
    bf16_t* H;
    __device__ __forceinline__ void operator()(const f32x4 (&acc)[2][2][4][2], const pg8::Unit& u, int wr, int wc, int fr, int fq, const LAS float* rst) const {
        const int row0 = u.pm * 256 + wr * 64 + fr, col = u.pn * 128 + wc * 32 + 8 * fq;
#pragma unroll
        for (int ai = 0; ai < 2; ++ai)
#pragma unroll
            for (int m = 0; m < 4; ++m) {
                float h[8];
                const float rs = rst[ai * 128 + wr * 64 + m * 16 + fr];
#pragma unroll
                for (int n = 0; n < 2; ++n)
#pragma unroll
                    for (int e = 0; e < 4; ++e) { const float g = acc[ai][0][m][n][e] * rs, up = acc[ai][1][m][n][e] * rs; h[n * 4 + e] = g * sigmoidf_(g) * up; }
                u32x4 w; w.x = pg8::cvt_pk_bf16(h[0], h[1]); w.y = pg8::cvt_pk_bf16(h[2], h[3]); w.z = pg8::cvt_pk_bf16(h[4], h[5]); w.w = pg8::cvt_pk_bf16(h[6], h[7]);
                GST(u32x4, H + (size_t)(row0 + ai * 128 + m * 16) * DFF + col, w);
            }
    }
};
template <bool BF32, bool OF32> struct EpiResidT {
    static constexpr bool PERM = false, AFTER_DRAIN = false, ROWSCALE = false, CHAIN = false;
    const void* base; void* out; float alpha; float* ss;
    __device__ __forceinline__ void operator()(const f32x4 (&acc)[2][2][4][2], const pg8::Unit& u, int wr, int wc, int fr, int fq) const {
        const int row0 = u.pm * 256 + wr * 64 + fr, col0 = u.pn * 256 + wc * 32 + 4 * fq;
#pragma unroll
        for (int ai = 0; ai < 2; ++ai) {
            f32x4 bv[4][2][2];
#pragma unroll
            for (int m = 0; m < 4; ++m) {
                const size_t off = (size_t)(row0 + ai * 128 + m * 16) * DM + col0;
#pragma unroll
                for (int bj = 0; bj < 2; ++bj)
#pragma unroll
                    for (int n = 0; n < 2; ++n) {
                        if (BF32) bv[m][bj][n] = GLD(f32x4, (const float*)base + off + bj * 128 + n * 16);
                        else { const u32x2 w = GLD(u32x2, (const bf16_t*)base + off + bj * 128 + n * 16);
                               bv[m][bj][n] = (f32x4){__builtin_bit_cast(float, w.x << 16), __builtin_bit_cast(float, w.x & 0xffff0000u), __builtin_bit_cast(float, w.y << 16), __builtin_bit_cast(float, w.y & 0xffff0000u)}; }
                    }
            }
#pragma unroll
            for (int m = 0; m < 4; ++m) {
                const int row = row0 + ai * 128 + m * 16;
                const size_t off = (size_t)row * DM + col0;
                float sq = 0.f;
#pragma unroll
                for (int bj = 0; bj < 2; ++bj)
#pragma unroll
                    for (int n = 0; n < 2; ++n) {
                        const f32x4 o = bv[m][bj][n] + acc[ai][bj][m][n] * alpha;
                        sq += (o.x * o.x + o.y * o.y) + (o.z * o.z + o.w * o.w);
                        if (OF32) GST(f32x4, (float*)out + off + bj * 128 + n * 16, o);
                        else { u32x2 w; w.x = pg8::cvt_pk_bf16(o.x, o.y); w.y = pg8::cvt_pk_bf16(o.z, o.w); GST(u32x2, (bf16_t*)out + off + bj * 128 + n * 16, w); }
                    }
                if (!OF32) { sq += __shfl_xor(sq, 16); sq += __shfl_xor(sq, 32); if (fq == 0) GST(float, ss + (size_t)row * 16 + u.pn * 4 + wc, sq); }
            }
        }
    }
};
struct PairOrder {
    pg8::StaticOrder S;
    __device__ void init(int G_, int c_) { S.init(MTOK, DM, G_, c_); }
    __device__ bool next(int i, pg8::Unit& u) const { if (!S.next(i >> 1, u)) return false; if (i & 1) { u.pm += MTOK / 256; u.pn += DM / 256; } return true; }
    __device__ __forceinline__ void a_ready(const pg8::Unit&) const {}
    __device__ __forceinline__ void done(const pg8::Unit&) const {}
};
struct EpiMerge {
    static constexpr bool PERM = true, AFTER_DRAIN = false, ROWSCALE = false, CHAIN = true;
    const unsigned char* MG; bf16_t* O;
    __device__ __forceinline__ void chain(f32x4 (&acc)[2][2][4][2], const pg8::Unit& u, int wr, int wc, int fr, int fq) const {
        const int row0 = u.pm * 256 + wr * 64 + fr, col0 = u.pn * 256 + wc * 32 + 8 * fq;
#pragma unroll
        for (int ai = 0; ai < 2; ++ai) {
            u32x2 g0[4][2], g1[4][2];
#pragma unroll
            for (int m = 0; m < 4; ++m)
#pragma unroll
                for (int bj = 0; bj < 2; ++bj) { const unsigned char* p = MG + (size_t)(row0 + ai * 128 + m * 16) * 2048 + col0 + bj * 128; g0[m][bj] = GLD(u32x2, p); g1[m][bj] = GLD(u32x2, p + 1024); }
#pragma unroll
            for (int m = 0; m < 4; ++m)
#pragma unroll
                for (int bj = 0; bj < 2; ++bj)
#pragma unroll
                    for (int i = 0; i < 8; ++i) {
                        const unsigned q0 = (g0[m][bj][i >> 2] >> (8 * (i & 3))) & 0xffu, q1 = (g1[m][bj][i >> 2] >> (8 * (i & 3))) & 0xffu;
                        acc[ai][bj][m][i >> 2][i & 3] *= (float)q0 * __builtin_amdgcn_rcpf((float)(q1 ? q1 : 1u));
                    }
        }
    }
    __device__ __forceinline__ void operator()(const f32x4 (&acc)[2][2][4][2], const pg8::Unit& u, int wr, int wc, int fr, int fq) const {
        const int row0 = (u.pm - MTOK / 256) * 256 + wr * 64 + fr, col0 = (u.pn - DM / 256) * 256 + wc * 32 + 8 * fq;
#pragma unroll
        for (int ai = 0; ai < 2; ++ai) {
            u32x2 g1[4][2];
#pragma unroll
            for (int m = 0; m < 4; ++m)
#pragma unroll
                for (int bj = 0; bj < 2; ++bj) g1[m][bj] = GLD(u32x2, MG + (size_t)(row0 + ai * 128 + m * 16) * 2048 + 1024 + col0 + bj * 128);
#pragma unroll
            for (int m = 0; m < 4; ++m)
#pragma unroll
                for (int bj = 0; bj < 2; ++bj) {
                    float h[8];
#pragma unroll
                    for (int i = 0; i < 8; ++i) { const unsigned q1 = (g1[m][bj][i >> 2] >> (8 * (i & 3))) & 0xffu; h[i] = acc[ai][bj][m][i >> 2][i & 3] * ((float)(q1 ? q1 : 1u) * (1.f / 255.f)); }
                    u32x4 w; w.x = pg8::cvt_pk_bf16(h[0], h[1]); w.y = pg8::cvt_pk_bf16(h[2], h[3]); w.z = pg8::cvt_pk_bf16(h[4], h[5]); w.w = pg8::cvt_pk_bf16(h[6], h[7]);
                    GST(u32x4, O + (size_t)(row0 + ai * 128 + m * 16) * DM + col0 + bj * 128, w);
                }
        }
    }
};
struct EpiZ : RowScale {
    static constexpr bool PERM = true, AFTER_DRAIN = false, ROWSCALE = true, CHAIN = false;
    unsigned char* ws; const float *gq, *gk, *gnq, *gnk;
    __device__ __forceinline__ void operator()(const f32x4 (&acc)[2][2][4][2], const pg8::Unit& u, int wr, int wc, int fr, int fq, const LAS float* rst) const {
        const int ch = 4 * u.pn + wc;
        if (ch >= 77) return;
        const int row0 = u.pm * 256 + wr * 64 + fr;
        int kind, nh = 8, hd = 0, nd = 64, dbase = 0; size_t dst = 0; const float* gain = nullptr; float scale = 1.f;
        if (ch < 8) { kind = 0; dst = Z_DQ; hd = ch; gain = gq; scale = QSCALE; }
        else if (ch < 16) { kind = 0; dst = Z_DK; hd = ch - 8; gain = gk; }
        else if (ch < 24) { kind = 2; dst = Z_DVT; nh = 4; hd = (ch - 16) >> 1; nd = 128; dbase = ((ch - 16) & 1) * 64; }
        else if (ch < 32) { kind = 0; dst = Z_NQ; hd = ch - 24; gain = gnq; scale = QSCALE; }
        else if (ch < 34) { kind = 1; dst = Z_KCR; nh = 2; hd = ch - 32; }
        else if (ch < 36) { kind = 1; dst = Z_VCR; nh = 2; hd = ch - 34; }
        else if (ch < 38) { kind = 0; dst = Z_KSEL; nh = 2; hd = ch - 36; gain = gnk + 64; }
        else if (ch < 40) { kind = 2; dst = Z_VSELT; nh = 2; hd = ch - 38; }
        else if (ch < 42) { kind = 0; dst = Z_KWIN; nh = 2; hd = ch - 40; gain = gnk + 128; }
        else if (ch < 44) { kind = 2; dst = Z_VWINT; nh = 2; hd = ch - 42; }
        else if (ch < 76) { kind = 3; }
        else { kind = 4; }
        if (kind == 0 || kind == 1) {
            float gv[16];
#pragma unroll
            for (int i = 0; i < 16; ++i) gv[i] = (kind == 0) ? gain[(i >> 3) * 32 + 8 * fq + (i & 7)] * scale : 1.f;
#pragma unroll
            for (int ai = 0; ai < 2; ++ai)
#pragma unroll
                for (int m = 0; m < 4; ++m) {
                    const int row = row0 + ai * 128 + m * 16, b = row >> 12, s = row & 4095;
                    float v[16];
                    const float rrs = rst[ai * 128 + wr * 64 + m * 16 + fr];
#pragma unroll
                    for (int i = 0; i < 16; ++i) v[i] = acc[ai][i >> 3][m][(i >> 2) & 1][i & 3] * rrs;
                    float rs = 1.f;
                    if (kind == 0) {
                        float ss = 0.f;
#pragma unroll
                        for (int i = 0; i < 16; ++i) ss += v[i] * v[i];
                        ss += __shfl_xor(ss, 16); ss += __shfl_xor(ss, 32);
                        rs = __builtin_amdgcn_rsqf(ss * (1.f / 64.f) + EPS);
                    }
#pragma unroll
                    for (int i = 0; i < 16; ++i) v[i] *= rs * gv[i];
                    bf16_t* d = (bf16_t*)(ws + dst) + ((size_t)(b * nh + hd) * SEQ + s) * 64 + 8 * fq;
                    u32x4 w0, w1;
                    w0.x = pg8::cvt_pk_bf16(v[0], v[1]); w0.y = pg8::cvt_pk_bf16(v[2], v[3]); w0.z = pg8::cvt_pk_bf16(v[4], v[5]); w0.w = pg8::cvt_pk_bf16(v[6], v[7]);
                    w1.x = pg8::cvt_pk_bf16(v[8], v[9]); w1.y = pg8::cvt_pk_bf16(v[10], v[11]); w1.z = pg8::cvt_pk_bf16(v[12], v[13]); w1.w = pg8::cvt_pk_bf16(v[14], v[15]);
                    GST(u32x4, d, w0); GST(u32x4, d + 32, w1);
                }
        } else if (kind == 2) {
#pragma unroll
            for (int ai = 0; ai < 2; ++ai)
#pragma unroll
                for (int m = 0; m < 4; ++m) {
                    const int row = row0 + ai * 128 + m * 16, b = row >> 12, s = row & 4095;
                    bf16_t* d = (bf16_t*)(ws + dst) + ((size_t)(b * nh + hd) * nd + dbase + 8 * fq) * SEQ + s;
                    const float rrs = rst[ai * 128 + wr * 64 + m * 16 + fr];
#pragma unroll
                    for (int i = 0; i < 16; ++i) GST(bf16_t, d + (size_t)((i >> 3) * 32 + (i & 7)) * SEQ, (bf16_t)f2bf(acc[ai][i >> 3][m][(i >> 2) & 1][i & 3] * rrs));
                }
        } else if (kind == 3) {
            const int col = (ch - 44) * 64 + 8 * fq;
#pragma unroll
            for (int ai = 0; ai < 2; ++ai)
#pragma unroll
                for (int m = 0; m < 4; ++m) {
                    const int row = row0 + ai * 128 + m * 16;
                    float v[16];
                    const float rrs = rst[ai * 128 + wr * 64 + m * 16 + fr];
#pragma unroll
                    for (int i = 0; i < 16; ++i) v[i] = sigmoidf_(acc[ai][i >> 3][m][(i >> 2) & 1][i & 3] * rrs);
                    unsigned char* d = (unsigned char*)(ws + Z_MG) + (size_t)row * 2048 + col;
                    unsigned q[16];
#pragma unroll
                    for (int i = 0; i < 16; ++i) q[i] = (unsigned)__builtin_rintf(v[i] * 255.f);
                    u32x2 w0, w1;
                    w0.x = q[0] | (q[1] << 8) | (q[2] << 16) | (q[3] << 24); w0.y = q[4] | (q[5] << 8) | (q[6] << 16) | (q[7] << 24);
                    w1.x = q[8] | (q[9] << 8) | (q[10] << 16) | (q[11] << 24); w1.y = q[12] | (q[13] << 8) | (q[14] << 16) | (q[15] << 24);
                    GST(u32x2, d, w0); GST(u32x2, d + 32, w1);
                }
        } else {
            if (fq < 3) {
#pragma unroll
                for (int ai = 0; ai < 2; ++ai)
#pragma unroll
                    for (int m = 0; m < 4; ++m) {
                        const int row = row0 + ai * 128 + m * 16;
                        float* d = (float*)(ws + Z_NG) + (size_t)row * 24 + 8 * fq;
                        const float rrs = rst[ai * 128 + wr * 64 + m * 16 + fr];
#pragma unroll
                        for (int i = 0; i < 8; ++i) GST(float, d + i, sigmoidf_(acc[ai][0][m][i >> 2][i & 3] * rrs));
                    }
            }
        }
    }
};

__device__ __forceinline__ void tr_item(const float* src, int ld, int c0, int nvalid, int k0, bf16_t* dst, int Kdst, LAS float* scr, int lane, const float* rsc = nullptr) {
    const int n = lane & 31;
#pragma unroll
    for (int i = 0; i < 32; ++i) { const int kk = 2 * i + (lane >> 5); scr[kk * 33 + n] = (src && n < nvalid) ? GLD(float, src + (size_t)(k0 + kk) * ld + c0 + n) * (rsc ? GLD(float, rsc + k0 + kk) : 1.f) : 0.f; }
    asm volatile("s_waitcnt lgkmcnt(0)" ::: "memory");
    const int c = lane & 7;
#pragma unroll
    for (int j = 0; j < 4; ++j) { const int nn = (lane >> 3) + 8 * j; const LAS float* s = scr + (8 * c) * 33 + nn;
        u32x4 o; o.x = pk2(s[0 * 33], s[1 * 33]); o.y = pk2(s[2 * 33], s[3 * 33]); o.z = pk2(s[4 * 33], s[5 * 33]); o.w = pk2(s[6 * 33], s[7 * 33]);
        GST(u32x4, dst + (size_t)nn * Kdst + 8 * c, o); }
    asm volatile("s_waitcnt lgkmcnt(0)" ::: "memory");
}
__device__ __forceinline__ int zchunk_src(int ch) {
    if (ch < 32) return ch * 64;
    if (ch < 44) return 2048 + (ch - 32) * 64;
    if (ch < 76) return 2840 + (ch - 44) * 64;
    return 2816;
}
__device__ __forceinline__ int t5_bucket(int n) {
    if (n < 16) return n;
    int b = 16;
    b += (n >= 21); b += (n >= 27); b += (n >= 35); b += (n >= 46); b += (n >= 59); b += (n >= 77); b += (n >= 99); b += (n >= 128);
    b += (n >= 166); b += (n >= 216); b += (n >= 280); b += (n >= 363); b += (n >= 470); b += (n >= 609); b += (n >= 790);
    return b;
}
__device__ __forceinline__ void prologue(const Params& P, LAS unsigned char* lds) {
    const int tid = otid(), lane = tid & 63, wave = tid >> 6;
    LAS float* scr = (LAS float*)(lds + wave * 16384);
    const int gw = blockIdx.x * NWAVE + wave, NGW = gridDim.x * NWAVE;
    unsigned char* ws = WSP;
    constexpr int I13 = 176 * 16, I2 = 32 * 44, IIN = 160 * 16, IPAB = 64 * 8, IWO = 32 * 16, IC1 = 4 * 32, IC2 = 2 * 2;
    constexpr int PER_L = 2 * I13 + 2 * I2 + IIN + IPAB + IWO + 2 * IC1 + 2 * IC2;
    for (int it = gw; it < DEPTH * PER_L; it += NGW) {
        const int l = it / PER_L; int r = it % PER_L;
        if (r < 2 * I13) {
            const int f = r / I13; r %= I13; const int gi = r / 16, kb = r % 16;
            const int t = gi >> 3, bj = (gi >> 2) & 1, sub = gi & 3;
            const float* src = (f ? (bj ? INP(12) : INP(11)) : (bj ? INP(9) : INP(8))) + (size_t)l * DM * DFF;
            tr_item(src, DFF, 128 * t + 32 * sub, 32, 64 * kb, (bf16_t*)(ws + WS_W13 + (size_t)(l * 2 + f) * W13_SZ) + (size_t)(32 * gi) * DM + 64 * kb, DM, scr, lane, (f ? INP(7) : INP(5)) + l * DM);
            continue;
        }
        r -= 2 * I13;
        if (r < 2 * I2) {
            const int f = r / I2; r %= I2; const int gi = r / 44, kb = r % 44;
            const float* src = (f ? INP(13) : INP(10)) + (size_t)l * DFF * DM;
            tr_item(src, DM, 32 * gi, 32, 64 * kb, (bf16_t*)(ws + WS_W2 + (size_t)(l * 2 + f) * W2_SZ) + (size_t)(32 * gi) * DFF + 64 * kb, DFF, scr, lane);
            continue;
        }
        r -= 2 * I2;
        if (r < IIN) {
            const int gi = r / 16, kb = r % 16;
            const int t = gi >> 3, bj = (gi >> 2) & 1, wc = gi & 3, ch = 4 * t + wc;
            int nvalid = 32; if (ch == 76) nvalid = bj ? 0 : 24; if (ch > 76) nvalid = 0;
            const float* src = nvalid ? INP(1) + (size_t)l * DM * NIN : nullptr;
            tr_item(src, NIN, zchunk_src(ch) + 32 * bj, nvalid, 64 * kb, (bf16_t*)(ws + WS_WIN + (size_t)l * WIN_SZ) + (size_t)(32 * gi) * DM + 64 * kb, DM, scr, lane, INP(6) + l * DM);
            continue;
        }
        r -= IIN;
        if (r < IPAB) {
            const int gi = r / 8, kb = r % 8;
            const float* src = (gi < 32 ? INP(2) : INP(3)) + (size_t)l * 512 * DM;
            tr_item(src, DM, 32 * (gi & 31), 32, 64 * kb, (bf16_t*)(ws + WS_PAB + (size_t)l * PAB_SZ) + (size_t)(32 * gi) * 512 + 64 * kb, 512, scr, lane);
            continue;
        }
        r -= IPAB;
        if (r < IWO) {
            const int gi = r / 16, kb = r % 16;
            tr_item(INP(4) + (size_t)l * DM * DM, DM, 32 * gi, 32, 64 * kb, (bf16_t*)(ws + WS_WO + (size_t)l * WO_SZ) + (size_t)(32 * gi) * DM + 64 * kb, DM, scr, lane);
            continue;
        }
        r -= IWO;
        if (r < 2 * IC1) {
            const int kv = r / IC1; r %= IC1; const int gi = r / 32, kb = r % 32;
            tr_item((kv ? INP(27) : INP(24)) + (size_t)l * 2048 * 128, 128, 32 * gi, 32, 64 * kb, (bf16_t*)(ws + WS_CW1 + (size_t)(l * 2 + kv) * CW1_SZ) + (size_t)(32 * gi) * 2048 + 64 * kb, 2048, scr, lane);
            continue;
        }
        r -= 2 * IC1;
        {
            const int kv = r / IC2; r %= IC2; const int gi = r / 2, kb = r % 2;
            tr_item((kv ? INP(28) : INP(25)) + (size_t)l * 128 * 64, 64, 32 * gi, 32, 64 * kb, (bf16_t*)(ws + WS_CW2 + (size_t)(l * 2 + kv) * CW2_SZ) + (size_t)(32 * gi) * 128 + 64 * kb, 128, scr, lane);
        }
    }
    const int gt = blockIdx.x * NTHR + tid, NGT = gridDim.x * NTHR;
    for (int i = gt; i < 12 * 1024; i += NGT) { const int h = i >> 10, d = i & 1023; ((float*)(ws + WS_BIAS))[i] = INP(29)[t5_bucket(d) * 12 + h] * LOG2E; }
    if (blockIdx.x == (gridDim.x > 1 ? 1 : 0) && wave < DEPTH) {
        const int l = wave;
        float a = INP(16)[l * 64 + lane] * INP(17)[l * 64 + lane], b = INP(18)[l * 64 + lane] * INP(19)[l * 64 + lane];
        float mq = fabsf(INP(14)[l * 64 + lane]), mk = fabsf(INP(15)[l * 64 + lane]), mnq = fabsf(INP(21)[l * 64 + lane]);
        float mnk = fmaxf(fmaxf(fabsf(INP(22)[l * 192 + lane]), fabsf(INP(22)[l * 192 + 64 + lane])), fabsf(INP(22)[l * 192 + 128 + lane]));
        float mb = 0.f; for (int i = lane; i < 32 * 12; i += 64) mb = fmaxf(mb, fabsf(INP(29)[i]));
#pragma unroll
        for (int o = 1; o < 64; o <<= 1) { a += __shfl_xor(a, o); b += __shfl_xor(b, o); mq = fmaxf(mq, __shfl_xor(mq, o)); mk = fmaxf(mk, __shfl_xor(mk, o)); mnq = fmaxf(mnq, __shfl_xor(mnq, o)); mnk = fmaxf(mnk, __shfl_xor(mnk, o)); mb = fmaxf(mb, __shfl_xor(mb, o)); }
        if (lane == 0) {
            float* prm = (float*)(ws + WS_PRM) + l * 8;
            const float lam_init = 0.8f - 0.6f * expf(-0.3f * (float)l);
            prm[0] = expf(a) - expf(b) + lam_init;
            prm[1] = (8.f * mq * mk * 1.02f + mb) * LOG2E;
            prm[2] = (8.f * mnq * mnk * 1.02f + mb) * LOG2E;
            prm[3] = 1.0f - lam_init;
        }
    }
    for (int wi = blockIdx.x; wi < 32; wi += gridDim.x) {
        const int lk = wi >> 3, n = (wi & 7) * 16 + (tid & 15), ks = tid >> 4, l = lk >> 1, kv = lk & 1;
        const float* pe = (kv ? INP(26) : INP(23)) + (size_t)l * 2048; const float* w1 = (kv ? INP(27) : INP(24)) + (size_t)l * 2048 * 128;
        float sacc = 0.f;
#pragma unroll 16
        for (int k = 64 * ks; k < 64 * ks + 64; ++k) sacc += GLD(float, pe + k) * GLD(float, w1 + (size_t)k * 128 + n);
        LAS float* red = (LAS float*)lds;
        __syncthreads();
        red[tid] = sacc;
        __syncthreads();
        if (tid < 16) { float t = 0.f; for (int i = 0; i < 32; ++i) t += red[i * 16 + tid]; ((float*)(ws + WS_CB1))[lk * 128 + (wi & 7) * 16 + tid] = t; }
        __syncthreads();
    }
}

template <bool INBF16, bool COPYRAW>
__device__ __forceinline__ void rmsnorm_phase(const void* x, const float* g, bf16_t* o, bf16_t* xraw = nullptr) {
    const int tid = otid(), lane = tid & 63, wave = tid >> 6;
    const int gw = blockIdx.x * NWAVE + wave, NGW = gridDim.x * NWAVE;
    f32x4 gv[4];
#pragma unroll
    for (int j = 0; j < 4; ++j) gv[j] = GLD(f32x4, (const f32x4*)g + lane + 64 * j);
    constexpr int RB = 4;
    for (int m0 = gw; m0 < MTOK; m0 += NGW * RB) {
        f32x4 v[RB][4]; float s[RB];
#pragma unroll
        for (int r = 0; r < RB; ++r) { const int m = m0 + r * NGW; const size_t ro = (size_t)(m < MTOK ? m : m0) * DM;
#pragma unroll
            for (int j = 0; j < 4; ++j) {
                if (!INBF16) v[r][j] = GLD(f32x4, (const f32x4*)((const float*)x + ro) + lane + 64 * j);
                else { const u32x2 w = GLD(u32x2, (const u32x2*)((const bf16_t*)x + ro) + lane + 64 * j);
                       if (COPYRAW && m < MTOK) GST(u32x2, (u32x2*)(xraw + ro) + lane + 64 * j, w);
                       v[r][j] = (f32x4){__builtin_bit_cast(float, w.x << 16), __builtin_bit_cast(float, w.x & 0xffff0000u), __builtin_bit_cast(float, w.y << 16), __builtin_bit_cast(float, w.y & 0xffff0000u)}; }
            } }
#pragma unroll
        for (int r = 0; r < RB; ++r) { s[r] = 0.f;
#pragma unroll
            for (int j = 0; j < 4; ++j) s[r] += (v[r][j].x * v[r][j].x + v[r][j].y * v[r][j].y) + (v[r][j].z * v[r][j].z + v[r][j].w * v[r][j].w); }
#pragma unroll
        for (int of = 1; of < 64; of <<= 1) {
#pragma unroll
            for (int r = 0; r < RB; ++r) s[r] += __shfl_xor(s[r], of); }
#pragma unroll
        for (int r = 0; r < RB; ++r) { const int m = m0 + r * NGW;
            if (m < MTOK) {
                const float rs = __builtin_amdgcn_rsqf(s[r] * (1.f / DM) + EPS);
                u32x2* o8 = (u32x2*)(o + (size_t)m * DM) + lane;
#pragma unroll
                for (int j = 0; j < 4; ++j) { u32x2 w; w.x = pk2(v[r][j].x * rs * gv[j].x, v[r][j].y * rs * gv[j].y); w.y = pk2(v[r][j].z * rs * gv[j].z, v[r][j].w * rs * gv[j].w); GST(u32x2, o8 + 64 * j, w); }
            }
        }
    }
}

__device__ __forceinline__ void xprep_phase(const float* x, bf16_t* o, float* ss) {
    const int tid = otid(), lane = tid & 63, wave = tid >> 6;
    const int gw = blockIdx.x * NWAVE + wave, NGW = gridDim.x * NWAVE;
    for (int m = gw; m < MTOK; m += NGW) {
        const f32x4* xr = (const f32x4*)(x + (size_t)m * DM) + lane;
        f32x4 v[4]; float s = 0.f;
#pragma unroll
        for (int j = 0; j < 4; ++j) { v[j] = GLD(f32x4, xr + 64 * j); s += (v[j].x * v[j].x + v[j].y * v[j].y) + (v[j].z * v[j].z + v[j].w * v[j].w); }
#pragma unroll
        for (int of = 1; of < 64; of <<= 1) s += __shfl_xor(s, of);
        u32x2* o8 = (u32x2*)(o + (size_t)m * DM) + lane;
#pragma unroll
        for (int j = 0; j < 4; ++j) { u32x2 w; w.x = pk2(v[j].x, v[j].y); w.y = pk2(v[j].z, v[j].w); GST(u32x2, o8 + 64 * j, w); }
        if (lane < 16) GST(float, ss + (size_t)m * 16 + lane, lane == 0 ? s : 0.f);
    }
}

__device__ __forceinline__ float gelu_tanh(float x) {
    const float y = 0.7978845608028654f * (x + 0.044715f * x * x * x);
    const float e = __builtin_amdgcn_exp2f(2.f * LOG2E * y);
    const float t = 1.f - 2.f * __builtin_amdgcn_rcpf(e + 1.f);
    return 0.5f * x * (1.f + t);
}
__device__ __forceinline__ void compress_phase(const Params& P, int l, LAS unsigned char* lds) {
    const int tid = otid(), lane = tid & 63, wave = tid >> 6, fr = lane & 15, kq = lane >> 4;
    unsigned char* ws = WSP;
    LAS bf16_t* Hs = (LAS bf16_t*)lds;
    LAS float* Os = (LAS float*)(lds + 8704);
    LAS unsigned char* As = lds + 17408;
    for (int unit = blockIdx.x; unit < 2 * 16 * 8; unit += gridDim.x) {
        const int kv = unit >> 7, bg = (unit >> 3) & 15, c0 = 32 * (unit & 7);
        const bf16_t* src = (const bf16_t*)(ws + (kv ? Z_VCR : Z_KCR)) + (size_t)bg * SEQ * 64;
        for (int i = tid; i < 33 * 128; i += NTHR) {
            const int j = i >> 7, pc = i & 127;
            u32x4 v = {0u, 0u, 0u, 0u};
            if (c0 + j <= 255) v = GLD(u32x4, (const unsigned char*)(src + (size_t)1024 * (c0 + j)) + pc * 16);
            *(LAS u32x4*)(As + j * 2064 + pc * 16) = v;
        }
        __syncthreads();
        const bf16_t* bp = (const bf16_t*)(ws + WS_CW1 + (size_t)(l * 2 + kv) * CW1_SZ) + (size_t)(16 * wave + fr) * 2048 + 8 * kq;
        f32x4 acc0 = {0.f, 0.f, 0.f, 0.f}, acc1 = {0.f, 0.f, 0.f, 0.f};
#pragma unroll
        for (int kb = 0; kb < 4; ++kb) {
            bf16x8 bfr[16];
#pragma unroll
            for (int i = 0; i < 16; ++i) bfr[i] = GLD(bf16x8, bp + 32 * (16 * kb + i));
#pragma unroll
            for (int i = 0; i < 16; ++i) {
                const int k = 32 * (16 * kb + i) + 8 * kq;
                const LAS unsigned char* ar = As + (fr + (k >> 10)) * 2064 + (k & 1023) * 2;
                const bf16x8 a0 = *(const LAS bf16x8*)ar, a1 = *(const LAS bf16x8*)(ar + 16 * 2064);
                acc0 = __builtin_amdgcn_mfma_f32_16x16x32_bf16(a0, bfr[i], acc0, 0, 0, 0);
                acc1 = __builtin_amdgcn_mfma_f32_16x16x32_bf16(a1, bfr[i], acc1, 0, 0, 0);
            }
        }
        const float cb = ((const float*)(ws + WS_CB1))[(l * 2 + kv) * 128 + 16 * wave + fr];
#pragma unroll
        for (int i = 0; i < 4; ++i) { Hs[(4 * kq + i) * 136 + 16 * wave + fr] = (bf16_t)f2bf(gelu_tanh(acc0[i] + cb)); Hs[(16 + 4 * kq + i) * 136 + 16 * wave + fr] = (bf16_t)f2bf(gelu_tanh(acc1[i] + cb)); }
        __syncthreads();
        {
            const int mt = wave >> 2, ns = wave & 3;
            const bf16_t* b2 = (const bf16_t*)(ws + WS_CW2 + (size_t)(l * 2 + kv) * CW2_SZ) + (size_t)(16 * ns + fr) * 128 + 8 * kq;
            f32x4 a2 = {0.f, 0.f, 0.f, 0.f};
#pragma unroll
            for (int kk = 0; kk < 4; ++kk) { const bf16x8 a = *(const LAS bf16x8*)(Hs + (16 * mt + fr) * 136 + 32 * kk + 8 * kq), b = GLD(bf16x8, b2 + 32 * kk); a2 = __builtin_amdgcn_mfma_f32_16x16x32_bf16(a, b, a2, 0, 0, 0); }
#pragma unroll
            for (int i = 0; i < 4; ++i) Os[(16 * mt + 4 * kq + i) * 65 + 16 * ns + fr] = a2[i];
        }
        __syncthreads();
#pragma unroll
        for (int rep = 0; rep < 4; ++rep) {
            const int e = tid + NTHR * rep, row = e >> 6, d = e & 63, c = c0 + row;
            const float val = Os[row * 65 + d];
            if (kv == 0) {
                float ss = 0.f;
#pragma unroll 16
                for (int j = 0; j < 64; ++j) { const float t = Os[row * 65 + j]; ss += t * t; }
                const float o = val * __builtin_amdgcn_rsqf(ss * (1.f / 64.f) + EPS) * GLD(float, INP(22) + l * 192 + d);
                GST(bf16_t, (bf16_t*)(ws + WS_KCN) + ((size_t)bg * 256 + c) * 64 + d, (c < 255) ? (bf16_t)f2bf(o) : (bf16_t)0);
            } else {
                GST(bf16_t, (bf16_t*)(ws + WS_VCT) + ((size_t)bg * 64 + d) * 256 + c, (c < 255) ? (bf16_t)f2bf(val) : (bf16_t)0);
            }
        }
        __syncthreads();
    }
}

__device__ __forceinline__ void qk_tile(f32x16& p0, f32x16& p1, const LAS unsigned char* Kl, const bf16x8 (&qf)[4], int r32, int hi) {
    const LAS unsigned char* kb = Kl + r32 * KP + hi * 16;
    bf16x8 a[8];
#pragma unroll
    for (int d0 = 0; d0 < 4; ++d0) { a[2 * d0] = *(const LAS bf16x8*)(kb + d0 * 32); a[2 * d0 + 1] = *(const LAS bf16x8*)(kb + 32 * KP + d0 * 32); }
    __builtin_amdgcn_s_setprio(1);
#pragma unroll
    for (int d0 = 0; d0 < 4; ++d0) {
        p0 = __builtin_amdgcn_mfma_f32_32x32x16_bf16(a[2 * d0], qf[d0], p0, 0, 0, 0);
        p1 = __builtin_amdgcn_mfma_f32_32x32x16_bf16(a[2 * d0 + 1], qf[d0], p1, 0, 0, 0);
    }
    __builtin_amdgcn_s_setprio(0);
}
template <int STRIDE, bool WINDOW, int MODE>
__device__ __forceinline__ void score_exp(f32x16& p0, f32x16& p1, int dl, const LAS float* tb, float cfar, bool rowsel) {
    const LAS float* tl = tb + 128 + (dl < 1087 ? dl : 1087) - 59;
#pragma unroll
    for (int blk = 0; blk < 2; ++blk) {
        f32x16& p = blk ? p1 : p0;
#pragma unroll
        for (int r = 0; r < 16; ++r) {
            const int c = (r & 3) + 8 * (r >> 2) + 32 * blk;
            const int dist = dl - STRIDE * c;
            float e;
            if (MODE == 0) e = __builtin_amdgcn_exp2f(p[r] + cfar);
            else {
                float bias;
                if (STRIDE == 1) bias = tl[59 - c];
                else bias = tb[128 + min((unsigned)dist, 1023u)];
                e = __builtin_amdgcn_exp2f(p[r] + bias);
                if (MODE == 2) { bool valid = dist >= 0; if (WINDOW) valid = valid && (dist < 512); e = valid ? e : 0.f; }
            }
            p[r] = rowsel ? e : 0.f;
        }
    }
}
template <int STRIDE, bool WINDOW>
__device__ __forceinline__ void score_exp_sel(f32x16& p0, f32x16& p1, int dl, const LAS float* tb, float cfar, bool rowsel, int dmin, int dmax) {
    if (!WINDOW && dmin >= 790) score_exp<STRIDE, WINDOW, 0>(p0, p1, dl, tb, cfar, rowsel);
    else if (dmin >= 0 && (!WINDOW || dmax < 512)) score_exp<STRIDE, WINDOW, 1>(p0, p1, dl, tb, cfar, rowsel);
    else score_exp<STRIDE, WINDOW, 2>(p0, p1, dl, tb, cfar, rowsel);
}
template <int STRIDE, bool WINDOW, int MODE>
__device__ __forceinline__ void qk_score_m(f32x16& p0, f32x16& p1, const LAS unsigned char* Kl, const bf16x8 (&qf)[4], int r32, int hi, int dl, const LAS float* tb, float cfar, bool rowsel) {
    const LAS float* tl = tb + 128 + (dl < 1087 ? dl : 1087) - 59;
#pragma unroll
    for (int blk = 0; blk < 2; ++blk) {
        f32x16& p = blk ? p1 : p0;
#pragma unroll
        for (int r = 0; r < 16; ++r) {
            const int c = (r & 3) + 8 * (r >> 2) + 32 * blk;
            if (MODE == 0) p[r] = cfar;
            else if (STRIDE == 1) p[r] = tl[59 - c];
            else p[r] = tb[128 + min((unsigned)(dl - STRIDE * c), 1023u)];
        }
    }
    qk_tile(p0, p1, Kl, qf, r32, hi);
#pragma unroll
    for (int blk = 0; blk < 2; ++blk) {
        f32x16& p = blk ? p1 : p0;
#pragma unroll
        for (int r = 0; r < 16; ++r) {
            const int dist = dl - STRIDE * ((r & 3) + 8 * (r >> 2) + 32 * blk);
            float e = __builtin_amdgcn_exp2f(p[r]);
            if (MODE == 2) { bool valid = dist >= 0; if (WINDOW) valid = valid && (dist < 512); e = valid ? e : 0.f; }
            p[r] = rowsel ? e : 0.f;
        }
    }
}
template <int STRIDE, bool WINDOW>
__device__ __forceinline__ void qk_score(f32x16& p0, f32x16& p1, const LAS unsigned char* Kl, const bf16x8 (&qf)[4], int r32, int hi, int dl, const LAS float* tb, float cfar, bool rowsel, int dmin, int dmax) {
    if (!WINDOW && dmin >= 790) qk_score_m<STRIDE, WINDOW, 0>(p0, p1, Kl, qf, r32, hi, dl, tb, cfar, rowsel);
    else if (dmin >= 0 && (!WINDOW || dmax < 512)) qk_score_m<STRIDE, WINDOW, 1>(p0, p1, Kl, qf, r32, hi, dl, tb, cfar, rowsel);
    else qk_score_m<STRIDE, WINDOW, 2>(p0, p1, Kl, qf, r32, hi, dl, tb, cfar, rowsel);
}
__device__ __forceinline__ float sum32(const f32x16& p0, const f32x16& p1) {
    float a = 0.f, b = 0.f;
#pragma unroll
    for (int r = 0; r < 16; ++r) { a += p0[r]; b += p1[r]; }
    return a + b;
}
template <int NDB>
__device__ __forceinline__ void pv_tile(f32x16 (&o)[NDB], const f32x16& p0, const f32x16& p1, const LAS unsigned char* Vl, int r32, int hi) {
    const LAS unsigned char* vbase = Vl + r32 * VP + hi * 8;
    bf16x4 vf[2][NDB][2];
#define PV_LOAD(st, buf) do { _Pragma("unroll") for (int db = 0; db < NDB; ++db) { const LAS unsigned char* vp = vbase + db * 32 * VP + (st) * 32; vf[buf][db][0] = *(const LAS bf16x4*)vp; vf[buf][db][1] = *(const LAS bf16x4*)(vp + 16); } } while (0)
    PV_LOAD(0, 0);
#pragma unroll
    for (int st = 0; st < 4; ++st) {
        if (st + 1 < 4) PV_LOAD(st + 1, (st + 1) & 1);
        const f32x16& p = (st >> 1) ? p1 : p0; const int s8 = 8 * (st & 1);
        u32x4 w; w.x = pg8::cvt_pk_bf16(p[s8 + 0], p[s8 + 1]); w.y = pg8::cvt_pk_bf16(p[s8 + 2], p[s8 + 3]); w.z = pg8::cvt_pk_bf16(p[s8 + 4], p[s8 + 5]); w.w = pg8::cvt_pk_bf16(p[s8 + 6], p[s8 + 7]);
        const bf16x8 pa = __builtin_bit_cast(bf16x8, w);
        __builtin_amdgcn_s_setprio(1);
#pragma unroll
        for (int db = 0; db < NDB; ++db) {
            const bf16x4 lo = vf[st & 1][db][0], hi4 = vf[st & 1][db][1];
            const bf16x8 vb = {lo[0], lo[1], lo[2], lo[3], hi4[0], hi4[1], hi4[2], hi4[3]};
            o[db] = __builtin_amdgcn_mfma_f32_32x32x16_bf16(pa, vb, o[db], 0, 0, 0);
        }
        __builtin_amdgcn_s_setprio(0);
    }
#undef PV_LOAD
}
__device__ __forceinline__ u32x4 ldk(const bf16_t* g, int tid) { return GLD(u32x4, (const unsigned char*)g + tid * 16); }
__device__ __forceinline__ void stk(LAS unsigned char* Kl, u32x4 v, int tid) { *(LAS u32x4*)(Kl + (tid >> 3) * KP + (tid & 7) * 16) = v; }
__device__ __forceinline__ u32x4 ldv(const bf16_t* g, size_t rs, int row, int tid) { return GLD(u32x4, (const unsigned char*)(g + (size_t)row * rs) + (tid & 7) * 16); }
__device__ __forceinline__ void stv(LAS unsigned char* Vl, u32x4 v, int row, int tid) { LAS unsigned char* p = Vl + row * VP + (tid & 7) * 16; *(LAS u32x2*)p = (u32x2){v.x, v.y}; *(LAS u32x2*)(p + 8) = (u32x2){v.z, v.w}; }

__device__ __forceinline__ void da_unit(const Params& P, int l, int b, int h, int qb, LAS unsigned char* lds, bool load_tab) {
    const int tid = otid(), lane = tid & 63, wave = __builtin_amdgcn_readfirstlane(tid >> 6), r32 = lane & 31, hi = lane >> 5;
    const int c = wave >> 2, qsub = wave & 3, q0 = qb * 128, qw0 = q0 + 32 * qsub;
    unsigned char* ws = WSP;
    const float* prm = (const float*)(ws + WS_PRM) + l * 8;
    const float lam = prm[0], Mb = prm[1], onem = prm[3];
    LAS float* biasL = (LAS float*)(lds + L_BIAS);
    const float* bg = (const float*)(ws + WS_BIAS) + h * 1024;
    if (load_tab) for (int i = tid; i < TBN; i += NTHR) { const int d = i - 128; biasL[i] = GLD(float, bg + (d < 0 ? 0 : (d > 1023 ? 1023 : d))) - Mb; }
    const float cfar = bg[1023] - Mb;
    const bf16_t* Qp = (const bf16_t*)(ws + Z_DQ) + ((size_t)(b * 8 + h * 2 + c) * SEQ + qw0 + r32) * 64 + hi * 8;
    bf16x8 qf[4];
#pragma unroll
    for (int d0 = 0; d0 < 4; ++d0) qf[d0] = GLD(bf16x8, Qp + d0 * 16);
    const bf16_t* K1g = (const bf16_t*)(ws + Z_DK) + (size_t)(b * 8 + h * 2) * SEQ * 64;
    const bf16_t* K2g = K1g + (size_t)SEQ * 64;
    const bf16_t* Vg = (const bf16_t*)(ws + Z_DVT) + (size_t)(b * 4 + h) * 128 * SEQ;
    const int NT = (q0 + 128) / 64;
    f32x16 o[4];
#pragma unroll
    for (int i = 0; i < 4; ++i) o[i] = (f32x16){};
    float lsum = 0.f;
    u32x4 rk1, rk2, rv0, rv1;
#define DA_LOAD(t) do { rk1 = ldk(K1g + (size_t)(t) * 4096, tid); rk2 = ldk(K2g + (size_t)(t) * 4096, tid); rv0 = ldv(Vg + (t) * 64, SEQ, tid >> 3, tid); rv1 = ldv(Vg + (t) * 64, SEQ, 64 + (tid >> 3), tid); } while (0)
#define DA_STORE(sb) do { LAS unsigned char* st_ = lds + (sb) * DA_STAGE; stk(st_, rk1, tid); stk(st_ + 64 * KP, rk2, tid); stv(st_ + 128 * KP, rv0, tid >> 3, tid); stv(st_ + 128 * KP, rv1, 64 + (tid >> 3), tid); } while (0)
    DA_LOAD(0); DA_STORE(0);
    __syncthreads();
    for (int t = 0; t < NT; ++t) {
        if (t + 1 < NT) DA_LOAD(t + 1);
        if (64 * t <= qw0 + 31) {
            const LAS unsigned char* st = lds + (t & 1) * DA_STAGE;
            f32x16 p0, p1;
            const int dl = qw0 + r32 - 64 * t - 4 * hi;
            qk_score<1, false>(p0, p1, st + c * 64 * KP, qf, r32, hi, dl, biasL, cfar, true, qw0 - (64 * t + 63), qw0 + 31 - 64 * t);
            lsum += sum32(p0, p1);
            pv_tile<4>(o, p0, p1, st + 128 * KP, r32, hi);
        }
        if (t + 1 < NT) DA_STORE((t + 1) & 1);
        __syncthreads();
    }
#undef DA_LOAD
#undef DA_STORE
    lsum += __shfl_xor(lsum, 32);
    LAS float* wsf = (LAS float*)(lds + L_WSF) + wave * 64;
    if (hi == 0) wsf[r32] = (lsum > 0.f) ? 1.0f / lsum : 0.f;
    asm volatile("s_waitcnt lgkmcnt(0)" ::: "memory");
    float li[16];
#pragma unroll
    for (int r = 0; r < 16; ++r) li[r] = wsf[crow(r, hi)];
    LAS float* X = (LAS float*)lds;
    if (c == 1) {
#pragma unroll
        for (int db = 0; db < 4; ++db)
#pragma unroll
            for (int r = 0; r < 16; ++r) X[(32 * qsub + crow(r, hi)) * 132 + r32 + 32 * db] = o[db][r] * li[r];
    }
    __syncthreads();
    if (c == 0) {
        const float* sg = INP(20) + l * 128;
        float gsub[4];
#pragma unroll
        for (int db = 0; db < 4; ++db) gsub[db] = sg[r32 + 32 * db] * onem;
#pragma unroll
        for (int r = 0; r < 16; ++r) {
            float y[4], ss = 0.f;
#pragma unroll
            for (int db = 0; db < 4; ++db) { y[db] = o[db][r] * li[r] - lam * X[(32 * qsub + crow(r, hi)) * 132 + r32 + 32 * db]; ss += y[db] * y[db]; }
            ss += __shfl_xor(ss, 1); ss += __shfl_xor(ss, 2); ss += __shfl_xor(ss, 4); ss += __shfl_xor(ss, 8); ss += __shfl_xor(ss, 16);
            const float rs = __builtin_amdgcn_rsqf(ss * (1.f / 128.f) + EPS);
            bf16_t* d = (bf16_t*)(ws + WS_XN) + (size_t)(b * SEQ + qw0 + crow(r, hi)) * 512 + h * 128 + r32;
#pragma unroll
            for (int db = 0; db < 4; ++db) GST(bf16_t, d + 32 * db, (bf16_t)f2bf(y[db] * rs * gsub[db]));
        }
    }
    __syncthreads();
}

__device__ __forceinline__ void nsa_unit(const Params& P, int l, int b, int g, int u, LAS unsigned char* lds, bool load_tab) {
    const int tid = otid(), lane = tid & 63, wave = __builtin_amdgcn_readfirstlane(tid >> 6), r32 = lane & 31, hi = lane >> 5;
    const int qi = r32 >> 2, p = r32 & 3, qw0 = 64 * u + 8 * wave, qpos = qw0 + qi, head = g * 4 + p;
    unsigned char* ws = WSP;
    const float Mb = ((const float*)(ws + WS_PRM))[l * 8 + 2];
    LAS float* biasL = (LAS float*)(lds + L_BIAS);
    LAS float* imp = (LAS float*)(lds + L_IMP);
    LAS unsigned* selw = (LAS unsigned*)(lds + L_SEL);
    LAS float* wsf = (LAS float*)(lds + L_WSF) + wave * 64;
    const float* bgl = (const float*)(ws + WS_BIAS) + (size_t)(4 + g * 4) * 1024;
    if (load_tab) for (int i = tid; i < 4 * TBN; i += NTHR) { const int hh = i / TBN, d = i % TBN - 128; biasL[i] = GLD(float, bgl + hh * 1024 + (d < 0 ? 0 : (d > 1023 ? 1023 : d))) - Mb; }
    if (tid == 0) { unsigned z = 0u; asm volatile("" : "+v"(z)); selw[128] = z; selw[129] = z; }
    const LAS float* tb = biasL + p * TBN;
    const float cfar = bgl[p * 1024 + 1023] - Mb;
    const bf16_t* Qp = (const bf16_t*)(ws + Z_NQ) + ((size_t)(b * 8 + head) * SEQ + qpos) * 64 + hi * 8;
    bf16x8 qf[4];
#pragma unroll
    for (int d0 = 0; d0 < 4; ++d0) qf[d0] = GLD(bf16x8, Qp + d0 * 16);
    const float* ngp = (const float*)(ws + Z_NG) + (size_t)(b * SEQ + qpos) * 24 + head * 3;
    const float gate_c = GLD(float, ngp), gate_s = GLD(float, ngp + 1), gate_w = GLD(float, ngp + 2);
    f32x16 oc[2]; oc[0] = (f32x16){}; oc[1] = (f32x16){};
    f32x16 o[2];
    u32x4 rk, rv;
    const int bgi = b * 2 + g;
#define NS_STORE(sb) do { LAS unsigned char* st_ = lds + (sb) * NS_STAGE; stk(st_, rk, tid); stv(st_ + 64 * KP, rv, tid >> 3, tid); } while (0)
#define NS_FOLD(gate) do { lsum += __shfl_xor(lsum, 32); if (hi == 0) wsf[r32] = (lsum > 0.f) ? (gate) / lsum : 0.f; asm volatile("s_waitcnt lgkmcnt(0)" ::: "memory"); \
        _Pragma("unroll") for (int r = 0; r < 16; ++r) { const float f_ = wsf[crow(r, hi)]; oc[0][r] += f_ * o[0][r]; oc[1][r] += f_ * o[1][r]; } asm volatile("s_waitcnt lgkmcnt(0)" ::: "memory"); } while (0)
    {
        const bf16_t* Kg = (const bf16_t*)(ws + WS_KCN) + (size_t)bgi * 256 * 64;
        const bf16_t* Vg = (const bf16_t*)(ws + WS_VCT) + (size_t)bgi * 64 * 256;
        const int ntc = (4 * u + 2) / 64 + 1;
        {
            u32x4 ck[4], cv[4];
#pragma unroll
            for (int tc = 0; tc < 4; ++tc) if (tc < ntc) { ck[tc] = ldk(Kg + (size_t)tc * 4096, tid); cv[tc] = ldv(Vg + tc * 64, 256, tid >> 3, tid); }
#pragma unroll
            for (int tc = 0; tc < 4; ++tc) if (tc < ntc) { LAS unsigned char* st_ = lds + tc * NS_STAGE; stk(st_, ck[tc], tid); stv(st_ + 64 * KP, cv[tc], tid >> 3, tid); }
        }
        __syncthreads();
        float lsum = 0.f;
        for (int tc = 0; tc < ntc; ++tc) {
            const LAS unsigned char* st = lds + tc * NS_STAGE;
            f32x16 p0, p1;
            const int dl = qpos - 31 - 16 * (64 * tc + 4 * hi);
            qk_score<16, false>(p0, p1, st, qf, r32, hi, dl, tb, cfar, true, qw0 - 31 - 16 * (64 * tc + 63), qw0 + 7 - 31 - 16 * 64 * tc);
            lsum += sum32(p0, p1);
        }
        const float lt = lsum + __shfl_xor(lsum, 32);
        const float linv = (lt > 0.f) ? 1.0f / lt : 0.f;
        o[0] = (f32x16){}; o[1] = (f32x16){};
        float carry = 0.f;
        for (int tc = 0; tc < ntc; ++tc) {
            const LAS unsigned char* st = lds + tc * NS_STAGE;
            f32x16 p0, p1;
            const int dl = qpos - 31 - 16 * (64 * tc + 4 * hi);
            qk_score<16, false>(p0, p1, st, qf, r32, hi, dl, tb, cfar, true, qw0 - 31 - 16 * (64 * tc + 63), qw0 + 7 - 31 - 16 * 64 * tc);
            float Qs[2][4], PL[2][4];
#pragma unroll
            for (int blk = 0; blk < 2; ++blk)
#pragma unroll
                for (int m = 0; m < 4; ++m) { const f32x16& pp = blk ? p1 : p0; Qs[blk][m] = (pp[4 * m] + pp[4 * m + 1]) + (pp[4 * m + 2] + pp[4 * m + 3]); PL[blk][m] = __shfl_xor(pp[4 * m + 3], 32); }
#pragma unroll
            for (int blk = 0; blk < 2; ++blk)
#pragma unroll
                for (int m = 0; m < 4; ++m) {
                    const float prev = (m > 0) ? PL[blk][m - 1] : (blk ? PL[0][3] : carry);
                    float e = (Qs[blk][m] + (hi ? PL[blk][m] : prev)) * linv;
                    e += __shfl_xor(e, 1); e += __shfl_xor(e, 2);
                    if (p == 0) imp[(8 * wave + qi) * 64 + 16 * tc + 8 * blk + 2 * m + hi] = e;
                }
            carry = PL[1][3];
            pv_tile<2>(o, p0, p1, st + 64 * KP, r32, hi);
        }
        NS_FOLD(gate_c);
    }
    __syncthreads();
    {
        const int ql = lane >> 3, sub = lane & 7, q = 8 * wave + ql;
        unsigned long long m;
        if (u < 8) m = (2ull << u) - 1ull;
        else {
            m = 1ull | (1ull << u) | (1ull << (u - 1));
            float v[8];
#pragma unroll
            for (int i = 0; i < 8; ++i) { const int j = sub + 8 * i; v[i] = (j >= 1 && j <= u - 2) ? imp[q * 64 + j] : -1.f; }
            for (int k = 0; k < 5; ++k) {
                float bv = v[0]; int bj = sub;
#pragma unroll
                for (int i = 1; i < 8; ++i) if (v[i] > bv) { bv = v[i]; bj = sub + 8 * i; }
#pragma unroll
                for (int of = 1; of < 8; of <<= 1) { const float ov = __shfl_xor(bv, of); const int oj = __shfl_xor(bj, of); if (ov > bv || (ov == bv && oj < bj)) { bv = ov; bj = oj; } }
                m |= 1ull << bj;
#pragma unroll
                for (int i = 0; i < 8; ++i) if (bj == sub + 8 * i) v[i] = -2.f;
            }
        }
        if (sub == 0) { selw[2 * q] = (unsigned)m; selw[2 * q + 1] = (unsigned)(m >> 32); atomicOr((unsigned*)&selw[128], (unsigned)m); atomicOr((unsigned*)&selw[129], (unsigned)(m >> 32)); }
    }
    __syncthreads();
    asm volatile("" : "+v"(oc[0]), "+v"(oc[1]));
    u32x4 rk2, rv2;
#define NS_LOADA(Kg_, Vg_, j_) do { rk = ldk((Kg_) + (size_t)(j_) * 4096, tid); rv = ldv((Vg_) + (j_) * 64, SEQ, tid >> 3, tid); } while (0)
#define NS_LOADB(Kg_, Vg_, j_) do { rk2 = ldk((Kg_) + (size_t)(j_) * 4096, tid); rv2 = ldv((Vg_) + (j_) * 64, SEQ, tid >> 3, tid); } while (0)
#define NS_STOREA(sb) do { LAS unsigned char* st_ = lds + (sb) * NS_STAGE; stk(st_, rk, tid); stv(st_ + 64 * KP, rv, tid >> 3, tid); } while (0)
#define NS_STOREB(sb) do { LAS unsigned char* st_ = lds + (sb) * NS_STAGE; stk(st_, rk2, tid); stv(st_ + 64 * KP, rv2, tid >> 3, tid); } while (0)
    {
        const unsigned long long un = (unsigned long long)selw[128] | ((unsigned long long)selw[129] << 32);
        const unsigned long long mine = (unsigned long long)selw[2 * (8 * wave + qi)] | ((unsigned long long)selw[2 * (8 * wave + qi) + 1] << 32);
        const bf16_t* Kg = (const bf16_t*)(ws + Z_KSEL) + (size_t)bgi * SEQ * 64;
        const bf16_t* Vg = (const bf16_t*)(ws + Z_VSELT) + (size_t)bgi * 64 * SEQ;
        o[0] = (f32x16){}; o[1] = (f32x16){};
        float lsum = 0.f;
        unsigned long long rem = un;
#define NS_NEXTJ(var, has) do { has = (rem != 0ull); var = 0; if (has) { var = __builtin_ctzll(rem); rem &= rem - 1; } } while (0)
        int jc, j1, j2; bool h1, h2;
        NS_NEXTJ(jc, h1);
        NS_NEXTJ(j1, h1);
        NS_LOADA(Kg, Vg, jc); if (h1) NS_LOADB(Kg, Vg, j1);
        NS_STOREA(0);
        __syncthreads();
        int sc = 0;
#define NS_SEL_STEP(LOADF, STOREN) { \
            NS_NEXTJ(j2, h2); if (h2) LOADF(Kg, Vg, j2); \
            const bool rowsel = (mine >> jc) & 1ull; \
            if (__any(rowsel)) { \
                const LAS unsigned char* st = lds + sc * NS_STAGE; \
                f32x16 p0, p1; \
                const int dl = qpos - 64 * jc - 4 * hi; \
                qk_score<1, false>(p0, p1, st, qf, r32, hi, dl, tb, cfar, rowsel, qw0 - (64 * jc + 63), qw0 + 7 - 64 * jc); \
                lsum += sum32(p0, p1); \
                pv_tile<2>(o, p0, p1, st + 64 * KP, r32, hi); \
            } \
            const int sn = (sc == 2) ? 0 : sc + 1; \
            if (h1) STOREN(sn); \
            __syncthreads(); \
            if (!h1) break; \
            jc = j1; j1 = j2; h1 = h2; sc = sn; }
        for (;;) { NS_SEL_STEP(NS_LOADA, NS_STOREB) NS_SEL_STEP(NS_LOADB, NS_STOREA) }
#undef NS_SEL_STEP
#undef NS_NEXTJ
        NS_FOLD(gate_s);
        asm volatile("" : "+v"(oc[0]), "+v"(oc[1]));
    }
    {
        const bf16_t* Kg = (const bf16_t*)(ws + Z_KWIN) + (size_t)bgi * SEQ * 64;
        const bf16_t* Vg = (const bf16_t*)(ws + Z_VWINT) + (size_t)bgi * 64 * SEQ;
        o[0] = (f32x16){}; o[1] = (f32x16){};
        float lsum = 0.f;
        const int t0 = (u >= 8) ? u - 8 : 0;
        int t = t0, sc = 0;
        NS_LOADA(Kg, Vg, t0); if (t0 + 1 <= u) NS_LOADB(Kg, Vg, t0 + 1);
        NS_STOREA(0);
        __syncthreads();
#define NS_WIN_STEP(LOADF, STOREN) { \
            if (t + 2 <= u) LOADF(Kg, Vg, t + 2); \
            { \
                const LAS unsigned char* st = lds + sc * NS_STAGE; \
                f32x16 p0, p1; \
                const int dl = qpos - 64 * t - 4 * hi; \
                qk_score<1, true>(p0, p1, st, qf, r32, hi, dl, tb, cfar, true, qw0 - (64 * t + 63), qw0 + 7 - 64 * t); \
                lsum += sum32(p0, p1); \
                pv_tile<2>(o, p0, p1, st + 64 * KP, r32, hi); \
            } \
            const int sn = (sc == 2) ? 0 : sc + 1; \
            if (t + 1 <= u) STOREN(sn); \
            __syncthreads(); \
            if (t + 1 > u) break; \
            ++t; sc = sn; }
        for (;;) { NS_WIN_STEP(NS_LOADA, NS_STOREB) NS_WIN_STEP(NS_LOADB, NS_STOREA) }
#undef NS_WIN_STEP
        NS_FOLD(gate_w);
    }
#undef NS_LOADA
#undef NS_LOADB
#undef NS_STOREA
#undef NS_STOREB
#undef NS_STORE
#undef NS_FOLD
#pragma unroll
    for (int r = 0; r < 16; ++r) {
        const int row = crow(r, hi), q = qw0 + (row >> 2), pp = row & 3;
        bf16_t* d = (bf16_t*)(ws + WS_XN) + (size_t)(MTOK + b * SEQ + q) * 512 + (g * 4 + pp) * 64 + r32;
        GST(bf16_t, d, (bf16_t)f2bf(oc[0][r])); GST(bf16_t, d + 32, (bf16_t)f2bf(oc[1][r]));
    }
    __syncthreads();
}

__device__ __forceinline__ void attention_phase(const Params& P, int l, LAS unsigned char* lds) {
    int tab_key = -1;
    for (int it = blockIdx.x; it < 1024; it += gridDim.x) {
        const int c = it & 255, sl = (it >> 8) & 3;
        const int bh = c & 31, xg = c >> 5; const int qb = (sl == 0) ? 31 - xg : (sl == 1) ? 23 - xg : (sl == 2) ? 8 + xg : xg;
        da_unit(P, l, bh >> 2, bh & 3, qb, lds, tab_key != (bh & 3)); tab_key = bh & 3;
    }
    {
        const int q = blockIdx.x & 7;
        unsigned* ctr = (unsigned*)(WSP + 72 * 1024) + 3520 + 32 * (l * 8 + q);
        LAS unsigned* qslot = (LAS unsigned*)(lds + L_SEL + 768);
        unsigned nxt = 0u;
        if (threadIdx.x == 0) nxt = __hip_atomic_fetch_add(ctr, 1u, __ATOMIC_RELAXED, __HIP_MEMORY_SCOPE_AGENT);
        for (;;) {
            if (threadIdx.x == 0) qslot[0] = nxt;
            __syncthreads();
            const unsigned idx = qslot[0];
            if (idx >= 128u) break;
            if (threadIdx.x == 0) nxt = __hip_atomic_fetch_add(ctr, 1u, __ATOMIC_RELAXED, __HIP_MEMORY_SCOPE_AGENT);
            const int u = 63 - (int)(idx >> 1), bg = q + 8 * (int)(idx & 1u);
            nsa_unit(P, l, bg >> 1, bg & 1, u, lds, tab_key != 4 + (bg & 1)); tab_key = 4 + (bg & 1);
        }
    }
}

constexpr size_t WS_BAR = 72 * 1024;
#define RLX_AGENT __ATOMIC_RELAXED, __HIP_MEMORY_SCOPE_AGENT
#define XB_TMO      128
#define XB_XCNT(j)  (256  + 64 * (j))
#define XB_XSUB(j)  (1280 + 64 * (j))
#define XB_XGEN(j)  (2304 + 64 * (j))
#define XB_TOP      3328
#define XB_TOPGEN   3392
#define XCD_BAR_WORDS 3456
#define XB_SPIN_CAP (1u << 18)

__device__ __forceinline__ unsigned xb_ld(unsigned* p)              { return __hip_atomic_load(p, __ATOMIC_RELAXED, __HIP_MEMORY_SCOPE_AGENT); }
__device__ __forceinline__ unsigned xb_add(unsigned* p, unsigned v) { return __hip_atomic_fetch_add(p, v, __ATOMIC_RELAXED, __HIP_MEMORY_SCOPE_AGENT); }
__device__ __forceinline__ unsigned xb_xcc_id() { return (unsigned)__builtin_amdgcn_s_getreg((3 << 11) | 20) & 0xFu; }
#define XB_SPIN(cond, bar) do { unsigned _sp = 0; while (cond) { __builtin_amdgcn_s_sleep(1); \
    if ((++_sp & 255u) == 0u) { if (xb_ld(&(bar)[XB_TMO])) break; if (_sp > XB_SPIN_CAP) { atomicAdd(&(bar)[XB_TMO], 1u); break; } } } } while (0)

struct XcdBarrier {
    unsigned* bar; unsigned x;
    volatile LAS unsigned* st;
};

__device__ __forceinline__ XcdBarrier xcd_barrier_post(unsigned* bar, volatile LAS unsigned* st) {
    XcdBarrier b; b.bar = bar; b.x = xb_xcc_id(); b.st = st;
    if (threadIdx.x == 0) (void)xb_add(&bar[XB_XCNT(b.x)], 1u);
    return b;
}
__device__ __forceinline__ void xcd_barrier_complete(unsigned* bar, unsigned x, unsigned& nloc, unsigned& nx) {
    const unsigned G = gridDim.x * gridDim.y * gridDim.z;
    unsigned sum, cnt, mine, sp = 0u;
    for (;;) {
        sum = 0u; cnt = 0u; mine = 0u;
#pragma unroll
        for (unsigned j = 0; j < 16; ++j) { const unsigned c = xb_ld(&bar[XB_XCNT(j)]); sum += c; cnt += (c > 0u) ? 1u : 0u; mine = (j == x) ? c : mine; }
        if (sum == G) break;
        __builtin_amdgcn_s_sleep(1);
        if ((++sp & 255u) == 0u) { if (xb_ld(&bar[XB_TMO])) break; if (sp > XB_SPIN_CAP) { atomicAdd(&bar[XB_TMO], 1u); break; } }
    }
    nloc = mine > 0u ? mine : 1u; nx = cnt > 0u ? cnt : 1u;
}

__device__ __forceinline__ void xcd_barrier(const XcdBarrier& b) {
    asm volatile("s_waitcnt vmcnt(0)" ::: "memory");
    __syncthreads();
    if (threadIdx.x == 0) {
        unsigned* bar = b.bar;
        __builtin_amdgcn_s_waitcnt(0);
        unsigned nloc = b.st[0], nx = b.st[1];
        if (nloc == 0u) { xcd_barrier_complete(bar, b.x, nloc, nx); b.st[0] = nloc; b.st[1] = nx; }
        const unsigned old = xb_add(&bar[XB_XSUB(b.x)], 1u);
        const unsigned gen = old / nloc;
        if (old + 1u == (gen + 1u) * nloc) {
            __builtin_amdgcn_fence(__ATOMIC_RELEASE, "agent");
            asm volatile("s_waitcnt vmcnt(0)" ::: "memory");
            const unsigned og = xb_add(&bar[XB_TOP], 1u);
            const unsigned tg = og / nx;
            if (og + 1u == (tg + 1u) * nx) xb_add(&bar[XB_TOPGEN], 1u);
            else XB_SPIN(xb_ld(&bar[XB_TOPGEN]) == tg, bar);
            __builtin_amdgcn_fence(__ATOMIC_ACQUIRE, "agent");
            xb_add(&bar[XB_XGEN(b.x)], 1u);
            asm volatile("s_waitcnt vmcnt(0)" ::: "memory");
        } else {
            XB_SPIN(xb_ld(&bar[XB_XGEN(b.x)]) == gen, bar);
            __builtin_amdgcn_fence(__ATOMIC_ACQUIRE, "agent");
            asm volatile("s_waitcnt vmcnt(0)" ::: "memory");
        }
    }
    __syncthreads();
}

#define GSYNC() do { XcdBarrier xb_; xb_.bar = (unsigned*)(WSP + WS_BAR); xb_.x = xb_xcc_id(); xb_.st = (volatile LAS unsigned*)(lds + L_PTAB + 384); xcd_barrier(xb_); } while (0)
#define ws WSP
#define XN ((bf16_t*)(WSP + WS_XN))
#define HID ((bf16_t*)(WSP + WS_HID))
#define MERGED ((bf16_t*)(WSP + WS_MERGED))
#define XB ((bf16_t*)OUTP)
#define XS ((bf16_t*)(WSP + WS_Z + 192 * MiB))
#define SSP ((float*)(WSP + WS_SS))
#define STAMP() do {} while (0)
template <int L> __device__ __forceinline__ void layer_fwd(const Params& P, LAS unsigned char* lds) {
    constexpr int l = L;
    const int G = gridDim.x, bx = blockIdx.x;

        const float* xin = (l == 0) ? INP(0) : OUTP;
        { pg8::Gemm g{XB, (const bf16_t*)(ws + WS_W13 + (size_t)(l * 2 + 0) * W13_SZ), MTOK, 5632, DM}; pg8::StaticOrder S; S.init(MTOK, 5632, G, bx);
          EpiSwiGLU E{{SSP}, HID}; pg8::gemm_phase<EpiSwiGLU, pg8::StaticOrder, true, true>(lds, g, S, E);
        }
        GSYNC(); STAMP();
        { pg8::Gemm g{HID, (const bf16_t*)(ws + WS_W2 + (size_t)(l * 2 + 0) * W2_SZ), MTOK, DM, DFF}; pg8::StaticOrder S; S.init(MTOK, DM, G, bx);
          if (l == 0) { EpiResidT<true, false> E{xin, XB, 0.5f, SSP}; pg8::gemm_phase<EpiResidT<true, false>, pg8::StaticOrder, true, true>(lds, g, S, E); }
          else { EpiResidT<false, false> E{XB, XB, 0.5f, SSP}; pg8::gemm_phase<EpiResidT<false, false>, pg8::StaticOrder, true, true>(lds, g, S, E); } }
        GSYNC(); STAMP();
        { pg8::Gemm g{XB, (const bf16_t*)(ws + WS_WIN + (size_t)l * WIN_SZ), MTOK, 5120, DM}; pg8::StaticOrder S; S.init(MTOK, 5120, G, bx);
          EpiZ E{{SSP}, ws, INP(14) + l * 64, INP(15) + l * 64, INP(21) + l * 64, INP(22) + l * 192}; pg8::gemm_phase<EpiZ, pg8::StaticOrder, true, true>(lds, g, S, E);
        }
        GSYNC(); STAMP();
        compress_phase(P, l, lds);
        GSYNC(); STAMP();
        attention_phase(P, l, lds);
        GSYNC(); STAMP();
        { pg8::Gemm g{XN, (const bf16_t*)(ws + WS_PAB + (size_t)l * PAB_SZ), 2 * MTOK, 2048, 512}; PairOrder S; S.init(G, bx);
          EpiMerge E{(const unsigned char*)(ws + Z_MG), MERGED}; pg8::gemm_phase<EpiMerge, PairOrder, true, true>(lds, g, S, E); }
        GSYNC(); STAMP();
        { pg8::Gemm g{MERGED, (const bf16_t*)(ws + WS_WO + (size_t)l * WO_SZ), MTOK, DM, DM}; pg8::StaticOrder S; S.init(MTOK, DM, G, bx);
          EpiResidT<false, false> E{XB, (l + 1 < DEPTH) ? XB : XS, 1.0f, SSP}; pg8::gemm_phase<EpiResidT<false, false>, pg8::StaticOrder, true, true>(lds, g, S, E); }
        GSYNC(); STAMP();
        { pg8::Gemm g{(l + 1 < DEPTH) ? XB : XS, (const bf16_t*)(ws + WS_W13 + (size_t)(l * 2 + 1) * W13_SZ), MTOK, 5632, DM}; pg8::StaticOrder S; S.init(MTOK, 5632, G, bx);
          EpiSwiGLU E{{SSP}, HID}; pg8::gemm_phase<EpiSwiGLU, pg8::StaticOrder, true, true>(lds, g, S, E); }
        GSYNC(); STAMP();
        { pg8::Gemm g{HID, (const bf16_t*)(ws + WS_W2 + (size_t)(l * 2 + 1) * W2_SZ), MTOK, DM, DFF}; pg8::StaticOrder S; S.init(MTOK, DM, G, bx);
          if (l + 1 < DEPTH) { EpiResidT<false, false> E{XB, XB, 0.5f, SSP}; pg8::gemm_phase<EpiResidT<false, false>, pg8::StaticOrder, true, true>(lds, g, S, E); }
          else { EpiResidT<false, true> E{XS, OUTP, 0.5f, nullptr}; pg8::gemm_phase<EpiResidT<false, true>, pg8::StaticOrder, true, true>(lds, g, S, E); } }
        if (l + 1 < DEPTH) { GSYNC(); STAMP(); }
    }
#undef ws
#undef XN
#undef HID
#undef MERGED
#undef XB
#undef XS
#undef SSP

#define GSYNC() do { XcdBarrier xb_; xb_.bar = (unsigned*)(WSP + WS_BAR); xb_.x = xb_xcc_id(); xb_.st = (volatile LAS unsigned*)(lds + L_PTAB + 384); xcd_barrier(xb_); } while (0)
#define STAMP() do {} while (0)
__global__ void __launch_bounds__(NTHR, 2) hybrid_fwd(Params P) {
    extern __shared__ __attribute__((aligned(16))) unsigned char lds_raw[];
    LAS unsigned char* lds = (LAS unsigned char*)lds_raw;
    cg::grid_group grid = cg::this_grid();
    if (threadIdx.x == 0) {
        LAS unsigned long long* pt = (LAS unsigned long long*)(lds + L_PTAB);
#pragma unroll
        for (int i = 0; i < 30; ++i) pt[i] = (unsigned long long)P.in[i];
        pt[30] = (unsigned long long)P.out; pt[31] = (unsigned long long)P.ws;
        *(LAS unsigned*)(lds + L_PTAB + 384) = 0u; *(LAS unsigned*)(lds + L_PTAB + 388) = 0u;
    }
    __syncthreads();
    (void)xcd_barrier_post((unsigned*)(WSP + WS_BAR), (volatile LAS unsigned*)(lds + L_PTAB + 384));
    const int G = gridDim.x, bx = blockIdx.x;

    if (P.out == nullptr) grid.sync();
    STAMP();
    prologue(P, lds);
    xprep_phase(INP(0), (bf16_t*)OUTP, (float*)(WSP + WS_SS));
    GSYNC(); STAMP();
    layer_fwd<0>(P, lds);
    layer_fwd<1>(P, lds);
}

extern "C" void kernel_launch(void* const* d_in, const int* in_sizes, int n_in, void* d_out, int out_size, void* d_ws, size_t ws_size, hipStream_t stream) {
    static int grid = 0;
    if (grid == 0) {
        if (n_in != 30 || out_size != MTOK * DM || ws_size < WS_END) { fprintf(stderr, "kernel_launch: unexpected problem (n_in %d out %d ws %zu, need %zu)\n", n_in, out_size, ws_size, (size_t)WS_END); grid = -1; return; }
        int dev = 0, cus = 0, per_cu = 0;
        (void)hipGetDevice(&dev);
        (void)hipDeviceGetAttribute(&cus, hipDeviceAttributeMultiprocessorCount, dev);
        if (hipFuncSetAttribute((const void*)hybrid_fwd, hipFuncAttributeMaxDynamicSharedMemorySize, LDS_BYTES) != hipSuccess) { fprintf(stderr, "kernel_launch: hipFuncSetAttribute failed\n"); grid = -1; return; }
        if (hipOccupancyMaxActiveBlocksPerMultiprocessor(&per_cu, (const void*)hybrid_fwd, NTHR, LDS_BYTES) != hipSuccess || per_cu < 1) { fprintf(stderr, "kernel_launch: occupancy query gave %d\n", per_cu); per_cu = 1; }
        (void)hipGetLastError();
        grid = cus * (per_cu > 1 ? 1 : per_cu);
        if (grid <= 0) grid = 256;
    }
    if (grid < 0) return;
    Params p{};
    for (int i = 0; i < 30; ++i) p.in[i] = (const float*)d_in[i];
    p.out = (float*)d_out; p.ws = (unsigned char*)d_ws;
    (void)hipMemsetAsync((unsigned char*)d_ws + WS_BAR, 0, 16384, stream);
    void* args[] = {&p};
    hipError_t e = hipLaunchCooperativeKernel((const void*)hybrid_fwd, dim3(grid), dim3(NTHR), args, LDS_BYTES, stream);
    if (e != hipSuccess) fprintf(stderr, "cooperative launch failed: %s (grid %d)\n", hipGetErrorString(e), grid);
}
```
